# Optimizing an MI355X kernel written in HIP

```python
import math
import jax, jax.numpy as jnp
from jax import lax
import numpy as np

D_MODEL = 1024
BATCH = 16
SEQ = 2048
DEPTH = 1

PLE_DIM = 256
RWKV_HEADS = 8
RWKV_HEAD_DIM = 64
RWKV_WIDTH = RWKV_HEADS * RWKV_HEAD_DIM
DECAY_LORA = 64
AAA_LORA = 64
GATE_LORA = 128
RWKV_COLS = 3 * RWKV_WIDTH + DECAY_LORA + AAA_LORA + GATE_LORA
S5_GROUPS = 16
S5_GROUP_CH = 16
S5_WIDTH = S5_GROUPS * S5_GROUP_CH
S5_STATE = 64
IN_COLS = RWKV_COLS + S5_WIDTH + 2 * D_MODEL
N_GROUPS = 4
EXPERTS_PER_GROUP = 8
N_EXPERTS = N_GROUPS * EXPERTS_PER_GROUP
TOP_K = 2
D_EXPERT = 256

NORM_EPS = 1e-6
GN_EPS = 64e-5

kernel_name = "hybrid_rwkv7_s5_hmoe_block"


def rms_norm(x, g):
    xf = x.astype(jnp.float32)
    y = xf * lax.rsqrt(jnp.mean(xf * xf, axis=-1, keepdims=True) + NORM_EPS)
    return (y * g.astype(jnp.float32)).astype(x.dtype)


def wkv7_scan(r, decay, k, v, a, b):
    bsz, _, h, n = r.shape

    def step(state, xs):
        r_t, w_t, k_t, v_t, a_t, b_t = xs
        sa = jnp.einsum('bhvk,bhk->bhv', state, a_t)
        state = (state * w_t[:, :, None, :]
                 + sa[..., :, None] * b_t[:, :, None, :]
                 + v_t[..., :, None] * k_t[:, :, None, :])
        return state, jnp.einsum('bhvk,bhk->bhv', state, r_t)

    xs = tuple(jnp.swapaxes(t, 0, 1) for t in (r, decay, k, v, a, b))
    state0 = jnp.zeros((bsz, h, n, n), jnp.float32)
    _, y = lax.scan(step, state0, xs)
    return jnp.swapaxes(y, 0, 1)


def rwkv7_branch(cols, w0, w_up, a0, a_up, g_up, k_k, k_a, r_k, ln_g, ln_b):
    bsz, s, _ = cols.shape
    W = RWKV_WIDTH
    r, k, v, wd, ad, gd = jnp.split(
        cols, [W, 2 * W, 3 * W, 3 * W + DECAY_LORA, 3 * W + DECAY_LORA + AAA_LORA], axis=-1)
    w_log = -jax.nn.softplus(-(w0 + jnp.tanh(wd) @ w_up)) - 0.5
    decay = jnp.exp(-jnp.exp(w_log.astype(jnp.float32)))
    a = jax.nn.sigmoid(a0 + ad @ a_up)
    g = jax.nn.sigmoid(gd) @ g_up
    heads = lambda t: t.astype(jnp.float32).reshape(bsz, s, RWKV_HEADS, RWKV_HEAD_DIM)
    kk = heads(k * k_k)
    kk = kk / jnp.maximum(jnp.sqrt(jnp.sum(kk * kk, axis=-1, keepdims=True)), 1e-12)
    k = k * (1.0 + (a - 1.0) * k_a)
    r_h, k_h, v_h, a_h, w_h = heads(r), heads(k), heads(v), heads(a), heads(decay)
    y = wkv7_scan(r_h, w_h, k_h, v_h, -kk, kk * a_h)
    mu = jnp.mean(y, axis=-1, keepdims=True)
    var = jnp.mean(jnp.square(y - mu), axis=-1, keepdims=True)
    y = ((y - mu) * lax.rsqrt(var + GN_EPS)).reshape(bsz, s, W)
    y = y * ln_g.astype(jnp.float32) + ln_b.astype(jnp.float32)
    bonus = jnp.sum(r_h * k_h * r_k.astype(jnp.float32), axis=-1, keepdims=True) * v_h
    y = y + bonus.reshape(bsz, s, W)
    return (y * g.astype(jnp.float32)).astype(cols.dtype)


def complex_linear_combine(e1, e2):
    a1r, a1i, b1r, b1i = e1
    a2r, a2i, b2r, b2i = e2
    ar = a2r * a1r - a2i * a1i
    ai = a2r * a1i + a2i * a1r
    br = a2r * b1r - a2i * b1i + b2r
    bi = a2r * b1i + a2i * b1r + b2i
    return ar, ai, br, bi


def s5_branch(u, lam_re, lam_im, log_dt, b_re, b_im, c_re, c_im, d_skip, glu_w, glu_b):
    bsz, s, _ = u.shape
    uf = u.astype(jnp.float32).reshape(bsz, s, S5_GROUPS, S5_GROUP_CH)
    dt = jnp.exp(log_dt.astype(jnp.float32))[:, None]
    lr, li = lam_re.astype(jnp.float32), lam_im.astype(jnp.float32)
    mag = jnp.exp(lr * dt)
    lb_re, lb_im = mag * jnp.cos(li * dt), mag * jnp.sin(li * dt)
    den = lr * lr + li * li
    nr, ni = lb_re - 1.0, lb_im
    coef_re = (nr * lr + ni * li) / den
    coef_im = (ni * lr - nr * li) / den
    br, bi = b_re.astype(jnp.float32), b_im.astype(jnp.float32)
    bb_re = coef_re[..., None] * br - coef_im[..., None] * bi
    bb_im = coef_re[..., None] * bi + coef_im[..., None] * br
    bu_re = jnp.einsum('bsgc,gnc->bsgn', uf, bb_re)
    bu_im = jnp.einsum('bsgc,gnc->bsgn', uf, bb_im)
    a_re = jnp.broadcast_to(lb_re, bu_re.shape)
    a_im = jnp.broadcast_to(lb_im, bu_im.shape)
    _, _, x_re, x_im = lax.associative_scan(
        complex_linear_combine, (a_re, a_im, bu_re, bu_im), axis=1)
    y = (jnp.einsum('bsgn,gcn->bsgc', x_re, c_re.astype(jnp.float32))
         - jnp.einsum('bsgn,gcn->bsgc', x_im, c_im.astype(jnp.float32))
         + d_skip.astype(jnp.float32) * uf)
    z = jax.nn.gelu(y.reshape(bsz, s, S5_WIDTH)).astype(u.dtype)
    return z * jax.nn.sigmoid(z @ glu_w + glu_b)


def hier_moe(h, rg_w, rg_b, re_w, re_b, w_gate, w_up, w_down):
    bsz, s, dm = h.shape
    t = h.reshape(-1, dm)
    tn = t.shape[0]
    g_prob = jax.nn.softmax((t @ rg_w + rg_b).astype(jnp.float32), axis=-1)
    g_p, g_idx = lax.top_k(g_prob, 1)
    e_logits = (t @ re_w + re_b).astype(jnp.float32).reshape(tn, N_GROUPS, EXPERTS_PER_GROUP)
    e_in_group = jnp.take_along_axis(e_logits, g_idx[:, :, None], axis=1)[:, 0]
    e_top, e_idx = lax.top_k(e_in_group, TOP_K)
    e_w = jax.nn.softmax(e_top, axis=-1) * g_p
    expert_id = g_idx * EXPERTS_PER_GROUP + e_idx
    comb = jnp.sum(jax.nn.one_hot(expert_id, N_EXPERTS, dtype=jnp.float32) * e_w[..., None],
                   axis=1)
    out = jnp.zeros((tn, dm), jnp.float32)
    for e in range(N_EXPERTS):
        hid = jax.nn.silu(t @ w_gate[e]) * (t @ w_up[e])
        out = out + comb[:, e:e + 1] * (hid @ w_down[e]).astype(jnp.float32)
    return out.reshape(bsz, s, dm).astype(h.dtype)


def setup_inputs(seed: int = 0) -> dict:
    key = jax.random.key(seed)
    ks = iter(jax.random.split(key, 48))
    L, D = DEPTH, D_MODEL
    nrm = lambda shape, std: std * jax.random.normal(next(ks), shape, jnp.float32)
    unif = lambda shape, lo, hi: jax.random.uniform(next(ks), shape, jnp.float32, lo, hi)
    n_idx = jnp.arange(S5_STATE, dtype=jnp.float32)
    return {
        "x": nrm((BATCH, SEQ, D), 1.0),
        "p": nrm((L, BATCH, SEQ, PLE_DIM), 1.0),
        "mix_norm": 1.0 + nrm((L, D), 0.02),
        "w_in": nrm((L, D, IN_COLS), D ** -0.5),
        "mu_shift": unif((L, RWKV_COLS), 0.0, 1.0),
        "rk_w0": unif((L, RWKV_WIDTH), -6.0, 1.0),
        "rk_w_up": nrm((L, DECAY_LORA, RWKV_WIDTH), DECAY_LORA ** -0.5),
        "rk_a0": nrm((L, RWKV_WIDTH), 0.1),
        "rk_a_up": nrm((L, AAA_LORA, RWKV_WIDTH), AAA_LORA ** -0.5),
        "rk_g_up": nrm((L, GATE_LORA, RWKV_WIDTH), GATE_LORA ** -0.5),
        "rk_k_k": 0.85 + nrm((L, RWKV_WIDTH), 0.02),
        "rk_k_a": 1.0 + nrm((L, RWKV_WIDTH), 0.02),
        "rk_r_k": nrm((L, RWKV_HEADS, RWKV_HEAD_DIM), 0.1),
        "rk_ln_g": 1.0 + nrm((L, RWKV_WIDTH), 0.02),
        "rk_ln_b": nrm((L, RWKV_WIDTH), 0.02),
        "s5_lam_re": -0.5 + nrm((L, S5_GROUPS, S5_STATE), 0.01),
        "s5_lam_im": math.pi * n_idx + nrm((L, S5_GROUPS, S5_STATE), 0.01),
        "s5_log_dt": unif((L, S5_GROUPS), math.log(1e-3), math.log(1e-1)),
        "s5_b_re": nrm((L, S5_GROUPS, S5_STATE, S5_GROUP_CH), (0.5 / S5_GROUP_CH) ** 0.5),
        "s5_b_im": nrm((L, S5_GROUPS, S5_STATE, S5_GROUP_CH), (0.5 / S5_GROUP_CH) ** 0.5),
        "s5_c_re": nrm((L, S5_GROUPS, S5_GROUP_CH, S5_STATE), 0.5 ** 0.5),
        "s5_c_im": nrm((L, S5_GROUPS, S5_GROUP_CH, S5_STATE), 0.5 ** 0.5),
        "s5_d": nrm((L, S5_GROUPS, S5_GROUP_CH), 1.0),
        "s5_glu_w": nrm((L, S5_WIDTH, S5_WIDTH), S5_WIDTH ** -0.5),
        "s5_glu_b": nrm((L, S5_WIDTH), 0.02),
        "w_branch_a": nrm((L, RWKV_WIDTH, D), RWKV_WIDTH ** -0.5),
        "w_branch_b": nrm((L, S5_WIDTH, D), S5_WIDTH ** -0.5),
        "w_out": nrm((L, D, D), D ** -0.5),
        "ffn_norm": 1.0 + nrm((L, D), 0.02),
        "router_group_w": nrm((L, D, N_GROUPS), D ** -0.5),
        "router_group_b": nrm((L, N_GROUPS), 0.01),
        "router_expert_w": nrm((L, D, N_EXPERTS), D ** -0.5),
        "router_expert_b": nrm((L, N_EXPERTS), 0.01),
        "exp_w_gate": nrm((L, N_EXPERTS, D, D_EXPERT), D ** -0.5),
        "exp_w_up": nrm((L, N_EXPERTS, D, D_EXPERT), D ** -0.5),
        "exp_w_down": nrm((L, N_EXPERTS, D_EXPERT, D), D_EXPERT ** -0.5),
        "ple_norm": 1.0 + nrm((L, D), 0.02),
        "ple_gate_w": nrm((L, D, D), D ** -0.5),
        "ple_proj": nrm((L, PLE_DIM, D), PLE_DIM ** -0.5),
        "final_norm": 1.0 + nrm((D,), 0.02),
    }


def reference(x, p, mix_norm, w_in, mu_shift, rk_w0, rk_w_up, rk_a0, rk_a_up, rk_g_up,
              rk_k_k, rk_k_a, rk_r_k, rk_ln_g, rk_ln_b, s5_lam_re, s5_lam_im, s5_log_dt,
              s5_b_re, s5_b_im, s5_c_re, s5_c_im, s5_d, s5_glu_w, s5_glu_b,
              w_branch_a, w_branch_b, w_out, ffn_norm, router_group_w, router_group_b,
              router_expert_w, router_expert_b, exp_w_gate, exp_w_up, exp_w_down,
              ple_norm, ple_gate_w, ple_proj, final_norm):
    for i in range(DEPTH):
        h = rms_norm(x, mix_norm[i])
        cols = h @ w_in[i]
        c_rwkv, u_s5, gate_a, gate_b = jnp.split(
            cols, [RWKV_COLS, RWKV_COLS + S5_WIDTH, RWKV_COLS + S5_WIDTH + D_MODEL], axis=-1)
        prev = jnp.pad(c_rwkv, ((0, 0), (1, 0), (0, 0)))[:, :-1]
        c_rwkv = c_rwkv + (prev - c_rwkv) * mu_shift[i]
        y_a = rwkv7_branch(c_rwkv, rk_w0[i], rk_w_up[i], rk_a0[i], rk_a_up[i], rk_g_up[i],
                           rk_k_k[i], rk_k_a[i], rk_r_k[i], rk_ln_g[i], rk_ln_b[i]) @ w_branch_a[i]
        y_b = s5_branch(u_s5, s5_lam_re[i], s5_lam_im[i], s5_log_dt[i], s5_b_re[i], s5_b_im[i],
                        s5_c_re[i], s5_c_im[i], s5_d[i], s5_glu_w[i], s5_glu_b[i]) @ w_branch_b[i]
        merged = jax.nn.sigmoid(gate_a) * y_a + jax.nn.sigmoid(gate_b) * y_b
        x = x + merged @ w_out[i]
        x = x + hier_moe(rms_norm(x, ffn_norm[i]), router_group_w[i], router_group_b[i],
                         router_expert_w[i], router_expert_b[i],
                         exp_w_gate[i], exp_w_up[i], exp_w_down[i])
        hp = rms_norm(x, ple_norm[i])
        x = x + jax.nn.sigmoid(hp @ ple_gate_w[i]) * (p[i] @ ple_proj[i])
    return rms_norm(x, final_norm)
```

```cpp
#include <hip/hip_runtime.h>
#include <hip/hip_cooperative_groups.h>
#include <cstdio>
#include <cstdint>
namespace cg = cooperative_groups;

#ifndef MK_N_LAUNCHES
#define MK_N_LAUNCHES 20
#endif

#define LAS __attribute__((address_space(3)))
typedef unsigned short bf16_t;
typedef short bf16x8 __attribute__((ext_vector_type(8)));
typedef float f32x4 __attribute__((ext_vector_type(4)));
typedef float f32x2 __attribute__((ext_vector_type(2)));
typedef unsigned u32x4 __attribute__((ext_vector_type(4)));
typedef unsigned u32x2 __attribute__((ext_vector_type(2)));

constexpr int T = 32768, DM = 1024, SEQ = 2048, NBATCH = 16, INC = 4096;
constexpr int C_R = 0, C_K = 512, C_V = 1024, C_WD = 1536, C_U = 1792, C_GA = 2048, C_GB = 3072;
constexpr int S5L = 32, S5NCH = 64, S5K = 640, S5N = 512, S5ROWS = 1024;
constexpr int NEXP = 32, DEXP = 256, MOE_ROWS_MAX = 2 * T + NEXP * 256;
constexpr int NPHASE = 20;

constexpr size_t MiB = (size_t)1 << 20, KiB = 1024;
constexpr size_t WS_CTL = 0;
constexpr size_t WS_WIN = 1 * MiB, WS_WBA = 9 * MiB, WS_WBB = 10 * MiB, WS_WOUT = 11 * MiB, WS_WPG = 13 * MiB, WS_WPP = 15 * MiB;
constexpr size_t WS_WLORA = 16 * MiB, WS_WGLU = 17 * MiB, WS_WR = 17 * MiB + 512 * KiB, WS_LAML = 17 * MiB + 768 * KiB;
constexpr size_t WS_KG = 18 * MiB, WS_W1 = 19 * MiB, WS_TZ = 23 * MiB, WS_WGU = 33 * MiB, WS_WD = 65 * MiB;
constexpr size_t WS_A = 82 * MiB;
constexpr size_t WS_HID = WS_A + 144 * MiB, WS_G = WS_A + 128 * MiB;
constexpr size_t WS_B = 338 * MiB;
constexpr size_t WS_UG = 402 * MiB, WS_E = 422 * MiB, WS_BON = 430 * MiB, WS_RWKV = 431 * MiB, WS_Z = 463 * MiB, WS_S5O = 479 * MiB;
constexpr size_t WS_ROUTE = 495 * MiB, WS_POS = 495 * MiB + 512 * KiB, WS_ROWW = 496 * MiB, WS_BC = 496 * MiB + 512 * KiB, WS_OFF = 496 * MiB + 768 * KiB;
constexpr size_t WS_HP = WS_RWKV;
constexpr size_t WS_P16 = WS_UG;
constexpr size_t WS_END = 497 * MiB;

constexpr int LDS_BYTES = 147456;
constexpr int MISC_OFF = 131072;

struct Args { const float* in[40]; float* out; unsigned char* ws; int ph_lo, ph_hi; };

#define LDS_WAIT() asm volatile("s_waitcnt lgkmcnt(0)" ::: "memory")
#define VM_WAIT() asm volatile("s_waitcnt vmcnt(0)" ::: "memory")
__device__ __forceinline__ unsigned f2bf(float f) { unsigned u = __builtin_bit_cast(unsigned, f); return (u + 0x7fffu + ((u >> 16) & 1u)) >> 16; }
__device__ __forceinline__ unsigned pk2(float lo, float hi) { return f2bf(lo) | (f2bf(hi) << 16); }
typedef __bf16 bf16x2_t __attribute__((ext_vector_type(2)));
__device__ __forceinline__ unsigned cvt_pk_bf16(float lo, float hi) { const f32x2 v = {lo, hi}; const bf16x2_t b = __builtin_convertvector(v, bf16x2_t); return __builtin_bit_cast(unsigned, b); }
__device__ __forceinline__ float bflo(unsigned w) { return __builtin_bit_cast(float, w << 16); }
__device__ __forceinline__ float bfhi(unsigned w) { return __builtin_bit_cast(float, w & 0xffff0000u); }
__device__ __forceinline__ void unpack8(u32x4 w, float (&v)[8]) { v[0] = bflo(w.x); v[1] = bfhi(w.x); v[2] = bflo(w.y); v[3] = bfhi(w.y); v[4] = bflo(w.z); v[5] = bfhi(w.z); v[6] = bflo(w.w); v[7] = bfhi(w.w); }
__device__ __forceinline__ void unpack4(u32x2 w, float (&v)[4]) { v[0] = bflo(w.x); v[1] = bfhi(w.x); v[2] = bflo(w.y); v[3] = bfhi(w.y); }
__device__ __forceinline__ u32x4 pack8(const float (&v)[8]) { u32x4 w; w.x = cvt_pk_bf16(v[0], v[1]); w.y = cvt_pk_bf16(v[2], v[3]); w.z = cvt_pk_bf16(v[4], v[5]); w.w = cvt_pk_bf16(v[6], v[7]); return w; }
__device__ __forceinline__ float sigmoidf_(float x) { return __builtin_amdgcn_rcpf(1.0f + __expf(-x)); }
__device__ __forceinline__ float tanhf_(float x) { return 1.0f - 2.0f * __builtin_amdgcn_rcpf(1.0f + __expf(2.0f * x)); }
__device__ __forceinline__ float gelu_tanh(float y) { return 0.5f * y * (1.0f + tanhf_(0.7978845608028654f * (y + 0.044715f * y * y * y))); }
__device__ __forceinline__ float wave_sum(float v) {
#pragma unroll
    for (int o = 1; o < 64; o <<= 1) v += __shfl_xor(v, o);
    return v;
}
__device__ __forceinline__ float dpp_f(float x, const int ctrl_sel) {
    int xi = __builtin_bit_cast(int, x), r;
    if (ctrl_sel == 0) r = __builtin_amdgcn_update_dpp(0, xi, 0xB1, 0xf, 0xf, true);
    else if (ctrl_sel == 1) r = __builtin_amdgcn_update_dpp(0, xi, 0x4E, 0xf, 0xf, true);
    else if (ctrl_sel == 2) r = __builtin_amdgcn_update_dpp(0, xi, 0x141, 0xf, 0xf, true);
    else r = __builtin_amdgcn_update_dpp(0, xi, 0x140, 0xf, 0xf, true);
    return __builtin_bit_cast(float, r);
}
__device__ __forceinline__ float row16_sum(float x) {
    x += dpp_f(x, 0); x += dpp_f(x, 1); x += dpp_f(x, 2); x += dpp_f(x, 3); return x;
}

namespace pg8 {
constexpr int BM = 256, BK = 64, HALF = 128, HTB = HALF * BK * 2, STAGE_BYTES = 8 * HTB, NXCD = 8, WGM = 8;
__host__ __device__ __forceinline__ int lds_byte(int r, int c) { const int st = (r >> 4) * 2 + (c >> 5), rr = r & 15, cc = c & 31, ob = rr * 64 + cc * 2; return st * 1024 + (ob ^ (((ob >> 9) & 1) << 5)); }
__host__ __device__ __forceinline__ void stage_rc(int b, int& R, int& C) { const int st = b / 1024, sb = b % 1024, swz = sb ^ (((sb >> 9) & 1) << 5); R = (st >> 1) * 16 + swz / 64; C = (st & 1) * 32 + (swz % 64) / 2; }
__host__ __device__ __forceinline__ int perm32(int rho) { const int n = rho >> 4, i = rho & 15; return 8 * (i >> 2) + 4 * n + (i & 3); }

struct Unit { int pm, pn, aux; const char* A; const char* B; };

struct StaticOrder {
    int nM, nN, nwg, G, c;
    __device__ __forceinline__ void init(int M, int N, int G_, int c_) { nM = M / BM; nN = N / BM; nwg = nM * nN; G = G_; c = c_; }
    __device__ __forceinline__ bool next(int i, int& pm, int& pn) const {
        const long L = (long)i * G + c; if (L >= nwg) return false;
        int wgid = (int)L; { const int q = nwg / NXCD, r = nwg % NXCD, xcd = wgid % NXCD, off = wgid / NXCD; wgid = (xcd < r ? xcd * (q + 1) : r * (q + 1) + (xcd - r) * q) + off; }
        const int nig = WGM * nN, gid = wgid / nig, fm = gid * WGM, gsz = (nM - fm) < WGM ? (nM - fm) : WGM;
        pm = fm + ((wgid % nig) % gsz); pn = (wgid % nig) / gsz; return true;
    }
};
struct DenseSched {
    const char* A; const char* B; int lda, ldb; StaticOrder so;
    __device__ __forceinline__ void init(const void* A_, int lda_, const void* B_, int ldb_, int M, int N, int G, int c) { A = (const char*)A_; B = (const char*)B_; lda = lda_; ldb = ldb_; so.init(M, N, G, c); }
    __device__ __forceinline__ bool next(int i, Unit& u) const {
        int pm, pn; if (!so.next(i, pm, pn)) return false;
        u.pm = pm; u.pn = pn; u.aux = 0; u.A = A + (size_t)pm * BM * lda * 2; u.B = B + (size_t)pn * BM * ldb * 2; return true;
    }
};
struct GroupSched {
    const char* A; const char* B; int lda, ldb, nM, nN, ngroups, G, c; size_t aStride, bStride;
    __device__ __forceinline__ bool next(int i, Unit& u) const {
        const int L = i * G + c; if (L >= ngroups * nM * nN) return false;
        const int g = L / (nM * nN), r = L % (nM * nN), pm = r % nM, pn = r / nM;
        u.pm = pm; u.pn = pn; u.aux = g; u.A = A + g * aStride + (size_t)pm * BM * lda * 2; u.B = B + g * bStride + (size_t)pn * BM * ldb * 2; return true;
    }
};
struct MoeSched {
    const int* off; const char* A; const char* B; int lda, ldb, NPN, G, c; size_t bStride;
    __device__ __forceinline__ bool next(int i, Unit& u) const {
        const int nTiles = off[NEXP] >> 8; const int L = i * G + c; if (L >= nTiles * NPN) return false;
        const int tile = L / NPN, pn = L % NPN, row = tile << 8; int e = 0;
        for (int k = 1; k < NEXP; ++k) e += (off[k] <= row) ? 1 : 0;
        u.pm = tile; u.pn = pn; u.aux = e; u.A = A + (size_t)tile * BM * lda * 2; u.B = B + e * bStride + (size_t)pn * BM * ldb * 2; return true;
    }
};

template <class F> struct EpiRow8 {
    F f;
    __device__ __forceinline__ void operator()(const f32x4 (&acc)[2][2][4][2], const Unit& u, int wr, int wc, int fr, int fq) const {
#pragma unroll
        for (int ai = 0; ai < 2; ++ai)
#pragma unroll
            for (int m = 0; m < 4; ++m) { const int r = ai * HALF + wr * 64 + m * 16 + fr;
#pragma unroll
                for (int bj = 0; bj < 2; ++bj) { const int c = bj * HALF + wc * 32 + 8 * fq;
                    float v[8] = {acc[ai][bj][m][0][0], acc[ai][bj][m][0][1], acc[ai][bj][m][0][2], acc[ai][bj][m][0][3], acc[ai][bj][m][1][0], acc[ai][bj][m][1][1], acc[ai][bj][m][1][2], acc[ai][bj][m][1][3]};
                    f(u, r, c, v); } }
    }
};
struct EpiMoeUp {
    bf16_t* HID;
    __device__ __forceinline__ void operator()(const f32x4 (&acc)[2][2][4][2], const Unit& u, int wr, int wc, int fr, int fq) const {
#pragma unroll
        for (int ai = 0; ai < 2; ++ai)
#pragma unroll
            for (int m = 0; m < 4; ++m) { const int r = u.pm * BM + ai * HALF + wr * 64 + m * 16 + fr; const int hc = u.pn * HALF + wc * 32 + 8 * fq;
                float o[8];
#pragma unroll
                for (int n = 0; n < 2; ++n)
#pragma unroll
                    for (int k = 0; k < 4; ++k) { const float g = acc[ai][0][m][n][k], up = acc[ai][1][m][n][k]; o[4 * n + k] = g * sigmoidf_(g) * up; }
                *(u32x4*)(HID + (size_t)r * DEXP + hc) = pack8(o); }
    }
};

template <class Epi, class Sched, bool ALIGN_EPI>
__device__ __forceinline__ void gemm_phase(LAS unsigned char* lds, const int K, const int lda, const int ldb, const Sched& S, const Epi& E) {
    const int tid = threadIdx.x, wid = __builtin_amdgcn_readfirstlane(tid >> 6), lane = tid & 63, wr = wid >> 2, wc = wid & 3, fr = lane & 15, fq = lane >> 4;
    const int nt = K / BK;
    unsigned voffA[2], voffB[2];
#pragma unroll
    for (int i = 0; i < 2; ++i) { int R, C; stage_rc(tid * 16 + i * 8192, R, C); const int Rb = (R & ~31) + perm32(R & 31);
        voffA[i] = (unsigned)(R * lda + C) * 2u; voffB[i] = (unsigned)(Rb * ldb + C) * 2u; }
    const size_t kstep = (size_t)(BK * 2);
    const size_t hstepA = (size_t)HALF * lda * 2, hstepB = (size_t)HALF * ldb * 2;
    const unsigned ldsw = (unsigned)wid * 1024u;
    const int aoff = lds_byte(wr * 64 + fr, fq * 8), boff = lds_byte(wc * 32 + fr, fq * 8);
#define PG8_SA(b, h) (((b) * 2 + (h)) * HTB)
#define PG8_SB(b, h) ((4 + (b) * 2 + (h)) * HTB)
#define PG8_STAGE(bufoff, gbase, voff) do { _Pragma("unroll") for (int _i = 0; _i < 2; ++_i) \
        __builtin_amdgcn_global_load_lds((const unsigned*)((const char*)(gbase) + (voff)[_i]), (LAS unsigned*)(lds + (bufoff) + ldsw + _i * 8192), 16, 0, 0); } while (0)
#define PG8_LDA(dst, b, h) do { _Pragma("unroll") for (int m = 0; m < 4; ++m) _Pragma("unroll") for (int k = 0; k < 2; ++k) dst[m][k] = *(const LAS bf16x8*)(lds + PG8_SA(b, h) + aoff + m * 2048 + k * 1024); } while (0)
#define PG8_LDB(dst, b, h) do { _Pragma("unroll") for (int n = 0; n < 2; ++n) _Pragma("unroll") for (int k = 0; k < 2; ++k) dst[n][k] = *(const LAS bf16x8*)(lds + PG8_SB(b, h) + boff + n * 2048 + k * 1024); } while (0)
#define PG8_MMA(ai, bj, At, Bt) do { __builtin_amdgcn_s_setprio(1); _Pragma("unroll") for (int m = 0; m < 4; ++m) _Pragma("unroll") for (int n = 0; n < 2; ++n) _Pragma("unroll") for (int k = 0; k < 2; ++k) \
        acc[ai][bj][m][n] = __builtin_amdgcn_mfma_f32_16x16x32_bf16(Bt[n][k], At[m][k], acc[ai][bj][m][n], 0, 0, 0); __builtin_amdgcn_s_setprio(0); } while (0)
#define PG8_WAIT_V(n) asm volatile("s_waitcnt vmcnt(" #n ")" ::: "memory")
#define PG8_WAIT_L(n) asm volatile("s_waitcnt lgkmcnt(" #n ")" ::: "memory")
#define PG8_BAR __builtin_amdgcn_s_barrier()
#define PG8_SCHED __builtin_amdgcn_sched_barrier(0)
    Unit cur, nxt; int ui = 0;
    if (!S.next(0, cur)) return;
    f32x4 acc[2][2][4][2];
#pragma unroll
    for (int a = 0; a < 2; ++a)
#pragma unroll
        for (int b = 0; b < 2; ++b)
#pragma unroll
            for (int m = 0; m < 4; ++m)
#pragma unroll
                for (int n = 0; n < 2; ++n) acc[a][b][m][n] = (f32x4){0.f, 0.f, 0.f, 0.f};
    bf16x8 At[4][2], B0[2][2], B1[2][2];
    const char* cA = cur.A; const char* cB = cur.B;
    PG8_STAGE(PG8_SB(0, 0), cB, voffB); PG8_STAGE(PG8_SB(0, 1), cB + hstepB, voffB); PG8_STAGE(PG8_SA(0, 0), cA, voffA); PG8_STAGE(PG8_SA(0, 1), cA + hstepA, voffA);
    if (wr == 1) PG8_BAR;
    PG8_WAIT_V(2); PG8_BAR;
    PG8_STAGE(PG8_SB(1, 0), cB + kstep, voffB); PG8_STAGE(PG8_SA(1, 0), cA + kstep, voffA); PG8_STAGE(PG8_SB(1, 1), cB + hstepB + kstep, voffB);
    PG8_WAIT_V(6); PG8_BAR;
    for (;;) {
        const bool has_next = S.next(ui + 1, nxt);
        const char* nA = has_next ? nxt.A : cA; const char* nB = has_next ? nxt.B : cB;
#pragma unroll 1
        for (int t = 0; t < nt; t += 2) {
            const bool last = (t == nt - 2);
            const char* a1 = cA + (size_t)(t + 1) * kstep;
            const char* a2 = last ? nA : cA + (size_t)(t + 2) * kstep; const char* b2 = last ? nB : cB + (size_t)(t + 2) * kstep;
            const char* a3 = a2 + kstep; const char* b3 = b2 + kstep;
            PG8_LDB(B0, 0, 0); PG8_LDB(B1, 0, 1); PG8_SCHED; PG8_LDA(At, 0, 0); PG8_STAGE(PG8_SA(1, 1), a1 + hstepA, voffA);
            PG8_WAIT_V(8); PG8_WAIT_L(0); PG8_BAR; PG8_MMA(0, 0, At, B0); PG8_MMA(0, 1, At, B1); PG8_BAR; PG8_SCHED;
            PG8_LDA(At, 0, 1); PG8_STAGE(PG8_SB(0, 0), b2, voffB); PG8_STAGE(PG8_SB(0, 1), b2 + hstepB, voffB); PG8_STAGE(PG8_SA(0, 0), a2, voffA);
            PG8_WAIT_V(8); PG8_WAIT_L(0); PG8_BAR; PG8_MMA(1, 0, At, B0); PG8_MMA(1, 1, At, B1); PG8_BAR; PG8_SCHED;
            PG8_LDB(B0, 1, 0); PG8_LDB(B1, 1, 1); PG8_SCHED; PG8_LDA(At, 1, 0); PG8_STAGE(PG8_SA(0, 1), a2 + hstepA, voffA);
            PG8_WAIT_V(8); PG8_WAIT_L(0); PG8_BAR; PG8_MMA(0, 0, At, B0); PG8_MMA(0, 1, At, B1); PG8_BAR; PG8_SCHED;
            PG8_LDA(At, 1, 1); PG8_STAGE(PG8_SB(1, 0), b3, voffB); PG8_STAGE(PG8_SB(1, 1), b3 + hstepB, voffB); PG8_STAGE(PG8_SA(1, 0), a3, voffA);
            PG8_WAIT_V(8); PG8_WAIT_L(0); PG8_BAR; PG8_MMA(1, 0, At, B0); PG8_MMA(1, 1, At, B1); PG8_BAR; PG8_SCHED;
        }
        if constexpr (ALIGN_EPI) { if (wr == 0) PG8_BAR; }
        E(acc, cur, wr, wc, fr, fq);
        if (!has_next) break;
#pragma unroll
        for (int a = 0; a < 2; ++a)
#pragma unroll
            for (int b = 0; b < 2; ++b)
#pragma unroll
                for (int m = 0; m < 4; ++m)
#pragma unroll
                    for (int n = 0; n < 2; ++n) acc[a][b][m][n] = (f32x4){0.f, 0.f, 0.f, 0.f};
        cur = nxt; cA = nA; cB = nB; ++ui;
        if constexpr (ALIGN_EPI) { if (wr == 1) PG8_BAR; }
    }
    PG8_WAIT_V(0);
    if constexpr (!ALIGN_EPI) { if (wr == 0) PG8_BAR; }
    PG8_BAR;
#undef PG8_SA
#undef PG8_SB
#undef PG8_STAGE
#undef PG8_LDA
#undef PG8_LDB
#undef PG8_MMA
#undef PG8_WAIT_V
#undef PG8_WAIT_L
#undef PG8_BAR
#undef PG8_SCHED
}
}
using pg8::Unit;

struct F_Cols { bf16_t* C; int ldc;
    __device__ __forceinline__ void operator()(const Unit& u, int r, int c, float (&v)[8]) const {
        *(u32x4*)(C + (size_t)(u.pm * 256 + r) * ldc + u.pn * 256 + c) = pack8(v); } };
struct F_Lora { bf16_t* O; const float* w0; const float* a0;
    __device__ __forceinline__ void operator()(const Unit& u, int r, int c, float (&v)[8]) const {
        const int gc = u.pn * 256 + c; const int ty = u.pn >> 1;
        if (ty == 0) {
#pragma unroll
            for (int i = 0; i < 8; ++i) v[i] = 0.6065306597126334f * sigmoidf_(v[i] + w0[gc + i]);
        } else if (ty == 1) {
#pragma unroll
            for (int i = 0; i < 8; ++i) v[i] = sigmoidf_(v[i] + a0[gc - 512 + i]);
        }
        *(u32x4*)(O + (size_t)(u.pm * 256 + r) * 1536 + gc) = pack8(v); } };
struct F_S5a { float* E;
    __device__ __forceinline__ void operator()(const Unit& u, int r, int c, float (&v)[8]) const {
        if (c < 128) { float* p = E + ((size_t)u.aux * S5ROWS + u.pm * 256 + r) * 128 + c;
            *(f32x4*)p = (f32x4){v[0], v[1], v[2], v[3]}; *(f32x4*)(p + 4) = (f32x4){v[4], v[5], v[6], v[7]}; } } };
struct F_S5c { const bf16_t* COLS; const float* Dsk; bf16_t* Z;
    __device__ __forceinline__ void operator()(const Unit& u, int r, int c, float (&v)[8]) const {
        const int row = u.pm * 256 + r, col = u.pn * 256 + c; const int b = row >> 6, ch = row & 63, j = col >> 4, c0 = col & 15;
        const int t = b * SEQ + ch * S5L + j, chan = u.aux * 16 + c0;
        float uu[8]; unpack8(*(const u32x4*)(COLS + (size_t)t * INC + C_U + chan), uu);
#pragma unroll
        for (int i = 0; i < 8; ++i) v[i] = gelu_tanh(v[i] + Dsk[chan + i] * uu[i]);
        *(u32x4*)(Z + (size_t)t * 256 + chan) = pack8(v); } };
struct F_Glu { const bf16_t* Z; const float* gb; bf16_t* O;
    __device__ __forceinline__ void operator()(const Unit& u, int r, int c, float (&v)[8]) const {
        const size_t t = (size_t)u.pm * 256 + r; float z[8]; unpack8(*(const u32x4*)(Z + t * 256 + c), z);
#pragma unroll
        for (int i = 0; i < 8; ++i) v[i] = z[i] * sigmoidf_(v[i] + gb[c + i]);
        *(u32x4*)(O + t * 256 + c) = pack8(v); } };
struct F_BrA { const bf16_t* COLS; float* PART;
    __device__ __forceinline__ void operator()(const Unit& u, int r, int c, float (&v)[8]) const {
        const size_t t = (size_t)u.pm * 256 + r; const int col = u.pn * 256 + c; float g[8]; unpack8(*(const u32x4*)(COLS + t * INC + C_GA + col), g);
#pragma unroll
        for (int i = 0; i < 8; ++i) v[i] *= sigmoidf_(g[i]);
        float* p = PART + t * DM + col; *(f32x4*)p = (f32x4){v[0], v[1], v[2], v[3]}; *(f32x4*)(p + 4) = (f32x4){v[4], v[5], v[6], v[7]}; } };
struct F_BrB { const bf16_t* COLS; const float* PART; bf16_t* MG;
    __device__ __forceinline__ void operator()(const Unit& u, int r, int c, float (&v)[8]) const {
        const size_t t = (size_t)u.pm * 256 + r; const int col = u.pn * 256 + c; float g[8]; unpack8(*(const u32x4*)(COLS + t * INC + C_GB + col), g);
        const float* p = PART + t * DM + col; const f32x4 p0 = *(const f32x4*)p, p1 = *(const f32x4*)(p + 4);
        const float pp[8] = {p0[0], p0[1], p0[2], p0[3], p1[0], p1[1], p1[2], p1[3]};
#pragma unroll
        for (int i = 0; i < 8; ++i) v[i] = pp[i] + v[i] * sigmoidf_(g[i]);
        *(u32x4*)(MG + t * DM + col) = pack8(v); } };
struct F_Res { const float* X; float* O;
    __device__ __forceinline__ void operator()(const Unit& u, int r, int c, float (&v)[8]) const {
        const size_t o = ((size_t)u.pm * 256 + r) * DM + u.pn * 256 + c; const f32x4 x0 = *(const f32x4*)(X + o), x1 = *(const f32x4*)(X + o + 4);
        *(f32x4*)(O + o) = (f32x4){x0[0] + v[0], x0[1] + v[1], x0[2] + v[2], x0[3] + v[3]}; *(f32x4*)(O + o + 4) = (f32x4){x1[0] + v[4], x1[1] + v[5], x1[2] + v[6], x1[3] + v[7]}; } };
struct F_MoeDown { const float* ROWW; bf16_t* YM;
    __device__ __forceinline__ void operator()(const Unit& u, int r, int c, float (&v)[8]) const {
        const size_t row = (size_t)u.pm * 256 + r; const float w = ROWW[row];
#pragma unroll
        for (int i = 0; i < 8; ++i) v[i] *= w;
        *(u32x4*)(YM + row * DM + u.pn * 256 + c) = pack8(v); } };
struct F_PleG { bf16_t* G;
    __device__ __forceinline__ void operator()(const Unit& u, int r, int c, float (&v)[8]) const {
#pragma unroll
        for (int i = 0; i < 8; ++i) v[i] = sigmoidf_(v[i]);
        *(u32x4*)(G + ((size_t)u.pm * 256 + r) * DM + u.pn * 256 + c) = pack8(v); } };
struct F_PleP { const bf16_t* G; const float* X; float* XO;
    __device__ __forceinline__ void operator()(const Unit& u, int r, int c, float (&v)[8]) const {
        const size_t o = ((size_t)u.pm * 256 + r) * DM + u.pn * 256 + c; float g[8]; unpack8(*(const u32x4*)(G + o), g);
        const f32x4 x0 = *(const f32x4*)(X + o), x1 = *(const f32x4*)(X + o + 4);
#ifdef EXP_NOG
        for (int i = 0; i < 8; ++i) g[i] = 0.5f;
#endif
#ifdef EXP_NOACC
        for (int i = 0; i < 8; ++i) v[i] = 1.0f;
#endif
        *(f32x4*)(XO + o) = (f32x4){x0[0] + g[0] * v[0], x0[1] + g[1] * v[1], x0[2] + g[2] * v[2], x0[3] + g[3] * v[3]};
        *(f32x4*)(XO + o + 4) = (f32x4){x1[0] + g[4] * v[4], x1[1] + g[5] * v[5], x1[2] + g[6] * v[6], x1[3] + g[7] * v[7]}; } };

enum { I_X = 0, I_P, I_MIXN, I_WIN, I_MU, I_W0, I_WUP, I_A0, I_AUP, I_GUP, I_KK, I_KA, I_RK, I_LNG, I_LNB, I_LRE, I_LIM, I_LDT, I_BRE, I_BIM, I_CRE, I_CIM, I_SD, I_GLUW, I_GLUB,
       I_WBA, I_WBB, I_WOUT, I_FFNN, I_RGW, I_RGB, I_REW, I_REB, I_EG, I_EU, I_ED, I_PLEN, I_PLEG, I_PLEP, I_FINN };

__device__ __forceinline__ void transpose_item(const float* __restrict__ W, int ldw, const float* __restrict__ kscale, int k0, int n0, bf16_t* WT, int ldt, int dst_row0, int dst_k0, LAS float* scr, int lane) {
#pragma unroll 8
    for (int i = 0; i < 32; ++i) { const int kk = 2 * i + (lane >> 5); float v = W[(size_t)(k0 + kk) * ldw + n0 + (lane & 31)]; if (kscale) v *= kscale[k0 + kk]; scr[kk * 33 + (lane & 31)] = v; }
    LDS_WAIT();
    const int c = lane & 7;
#pragma unroll
    for (int j = 0; j < 4; ++j) { const int n = (lane >> 3) + 8 * j; const LAS float* s = scr + (8 * c) * 33 + n;
        u32x4 o; o.x = pk2(s[0 * 33], s[1 * 33]); o.y = pk2(s[2 * 33], s[3 * 33]); o.z = pk2(s[4 * 33], s[5 * 33]); o.w = pk2(s[6 * 33], s[7 * 33]);
        *(u32x4*)(WT + (size_t)(dst_row0 + n) * ldt + dst_k0 + 8 * c) = o; }
    LDS_WAIT();
}
__device__ __forceinline__ void dsincos_reduced(double x, double& s, double& c) {
    const double x2 = x * x; double ts = 1.0, tc = 1.0;
#pragma unroll 1
    for (int k = 14; k >= 1; --k) { ts = 1.0 - ts * x2 / (double)((2 * k) * (2 * k + 1)); tc = 1.0 - tc * x2 / (double)((2 * k - 1) * (2 * k)); }
    s = x * ts; c = tc;
}
__device__ __forceinline__ double dexp_(double x) {
    const double ln2 = 0.6931471805599453094; const double kf = __builtin_rint(x / ln2); const double r = x - kf * ln2;
    double t = 1.0;
#pragma unroll 1
    for (int k = 18; k >= 1; --k) t = 1.0 + t * r / (double)k;
    const int ki = (int)kf; const long long bits = (long long)(1023 + ki) << 52;
    return t * __builtin_bit_cast(double, bits);
}

__device__ __forceinline__ void phase0(const Args& a, LAS unsigned char* lds) {
    const int tid = threadIdx.x, lane = tid & 63, wave = tid >> 6, G = gridDim.x;
    const int gw = blockIdx.x * 8 + wave, NGW = G * 8;
    unsigned char* ws = a.ws;
    LAS float* scr = (LAS float*)(lds + wave * 16384);
    constexpr int N_WIN = 16 * 128, N_WBA = 8 * 32, N_WBB = 4 * 32, N_WOUT = 16 * 32, N_WPG = 16 * 32, N_WPP = 4 * 32, N_GLU = 4 * 8, N_EG = 32 * 128, N_EU = 32 * 128, N_ED = 32 * 128;
    constexpr int N_ITEMS = N_WIN + N_WBA + N_WBB + N_WOUT + N_WPG + N_WPP + N_GLU + N_EG + N_EU + N_ED;
    for (int it = gw; it < N_ITEMS; it += NGW) {
        int r = it;
        if (r < N_WIN) { transpose_item(a.in[I_WIN], INC, a.in[I_MIXN], 64 * (r / 128), 32 * (r % 128), (bf16_t*)(ws + WS_WIN), 1024, 32 * (r % 128), 64 * (r / 128), scr, lane); continue; } r -= N_WIN;
        if (r < N_WBA) { transpose_item(a.in[I_WBA], 1024, nullptr, 64 * (r / 32), 32 * (r % 32), (bf16_t*)(ws + WS_WBA), 512, 32 * (r % 32), 64 * (r / 32), scr, lane); continue; } r -= N_WBA;
        if (r < N_WBB) { transpose_item(a.in[I_WBB], 1024, nullptr, 64 * (r / 32), 32 * (r % 32), (bf16_t*)(ws + WS_WBB), 256, 32 * (r % 32), 64 * (r / 32), scr, lane); continue; } r -= N_WBB;
        if (r < N_WOUT) { transpose_item(a.in[I_WOUT], 1024, nullptr, 64 * (r / 32), 32 * (r % 32), (bf16_t*)(ws + WS_WOUT), 1024, 32 * (r % 32), 64 * (r / 32), scr, lane); continue; } r -= N_WOUT;
        if (r < N_WPG) { transpose_item(a.in[I_PLEG], 1024, a.in[I_PLEN], 64 * (r / 32), 32 * (r % 32), (bf16_t*)(ws + WS_WPG), 1024, 32 * (r % 32), 64 * (r / 32), scr, lane); continue; } r -= N_WPG;
        if (r < N_WPP) { transpose_item(a.in[I_PLEP], 1024, nullptr, 64 * (r / 32), 32 * (r % 32), (bf16_t*)(ws + WS_WPP), 256, 32 * (r % 32), 64 * (r / 32), scr, lane); continue; } r -= N_WPP;
        if (r < N_GLU) { transpose_item(a.in[I_GLUW], 256, nullptr, 64 * (r / 8), 32 * (r % 8), (bf16_t*)(ws + WS_WGLU), 256, 32 * (r % 8), 64 * (r / 8), scr, lane); continue; } r -= N_GLU;
        if (r < N_EG + N_EU) { const int up = r >= N_EG ? 1 : 0; if (up) r -= N_EG; const int e = r / 128, q = r % 128, k0 = 64 * (q / 8), n0 = 32 * (q % 8);
            transpose_item(a.in[up ? I_EU : I_EG] + (size_t)e * 1024 * 256, 256, a.in[I_FFNN], k0, n0, (bf16_t*)(ws + WS_WGU), 1024, e * 512 + (n0 / 128) * 256 + up * 128 + (n0 % 128), k0, scr, lane); continue; } r -= N_EG + N_EU;
        { const int e = r / 128, q = r % 128, k0 = 64 * (q / 32), n0 = 32 * (q % 32);
            transpose_item(a.in[I_ED] + (size_t)e * 256 * 1024, 1024, nullptr, k0, n0, (bf16_t*)(ws + WS_WD) + (size_t)e * 1024 * 256, 256, n0, k0, scr, lane); }
    }
    {
        const int gt = blockIdx.x * 512 + tid, NT = G * 512;
        bf16_t* WL = (bf16_t*)(ws + WS_WLORA); bf16_t* WR = (bf16_t*)(ws + WS_WR);
        for (int c = gt; c < 1536 * 32 + 48 * 128; c += NT) {
            float v[8];
            if (c < 1536 * 32) { const int n = c >> 5, k0 = (c & 31) * 8;
#pragma unroll
                for (int i = 0; i < 8; ++i) { const int k = k0 + i; float x = 0.f;
                    if (n < 512) { if (k < 64) x = a.in[I_WUP][k * 512 + n]; }
                    else if (n < 1024) { if (k >= 64 && k < 128) x = a.in[I_AUP][(k - 64) * 512 + (n - 512)]; }
                    else { if (k >= 128) x = a.in[I_GUP][(k - 128) * 512 + (n - 1024)]; }
                    v[i] = x; }
                u32x4 o; o.x = pk2(v[0], v[1]); o.y = pk2(v[2], v[3]); o.z = pk2(v[4], v[5]); o.w = pk2(v[6], v[7]); *(u32x4*)(WL + (size_t)n * 256 + k0) = o;
            } else { const int cc = c - 1536 * 32, j = cc >> 7, k0 = (cc & 127) * 8;
#pragma unroll
                for (int i = 0; i < 8; ++i) { const int k = k0 + i; float x = 0.f;
                    if (j < 4) x = a.in[I_RGW][k * 4 + j] * a.in[I_FFNN][k]; else if (j < 36) x = a.in[I_REW][k * 32 + (j - 4)] * a.in[I_FFNN][k];
                    v[i] = x; }
                u32x4 o; o.x = pk2(v[0], v[1]); o.y = pk2(v[2], v[3]); o.z = pk2(v[4], v[5]); o.w = pk2(v[6], v[7]); *(u32x4*)(WR + (size_t)j * 1024 + k0) = o; }
        }
    }
    {
        bf16_t* HN = (bf16_t*)a.out;
        for (int m = gw; m < T; m += NGW) {
            const f32x4* xr = (const f32x4*)(a.in[I_X] + (size_t)m * DM) + lane; f32x4 v[4]; float s = 0.f;
#pragma unroll
            for (int j = 0; j < 4; ++j) { v[j] = xr[64 * j]; s += (v[j][0] * v[j][0] + v[j][1] * v[j][1]) + (v[j][2] * v[j][2] + v[j][3] * v[j][3]); }
            const float rs = 1.0f / sqrtf(wave_sum(s) * (1.0f / DM) + 1e-6f);
            u32x2* o = (u32x2*)(HN + (size_t)m * DM) + lane;
#pragma unroll
            for (int j = 0; j < 4; ++j) { u32x2 w; w.x = pk2(v[j][0] * rs, v[j][1] * rs); w.y = pk2(v[j][2] * rs, v[j][3] * rs); o[64 * j] = w; }
        }
    }
    const int sg = (int)blockIdx.x - (G - 16);
    if (sg >= 0 && sg < 16) {
        __syncthreads();
        const int g = sg;
        LAS float* Pre = (LAS float*)lds;
        LAS float* Pim = Pre + 33 * 64;
        LAS float* Bre = Pim + 33 * 64;
        LAS float* Bim = Bre + 64 * 16;
        LAS float* Cre = Bim + 64 * 16;
        LAS float* Cim = Cre + 16 * 64;
        if (tid < 64) {
            const int n = tid; const double lr = (double)a.in[I_LRE][g * 64 + n], li = (double)a.in[I_LIM][g * 64 + n];
            const double dt = dexp_((double)a.in[I_LDT][g]);
            const double mag = dexp_(lr * dt); double ang = li * dt; const double twopi = 6.283185307179586477; ang -= __builtin_rint(ang / twopi) * twopi;
            double sn, cs; dsincos_reduced(ang, sn, cs);
            const double lre = mag * cs, lim = mag * sn;
            const double nr = lre - 1.0, ni = lim, den = lr * lr + li * li;
            const double cfr = (nr * lr + ni * li) / den, cfi = (ni * lr - nr * li) / den;
            for (int c = 0; c < 16; ++c) { const double br = (double)a.in[I_BRE][(g * 64 + n) * 16 + c], bi = (double)a.in[I_BIM][(g * 64 + n) * 16 + c];
                Bre[n * 16 + c] = (float)(cfr * br - cfi * bi); Bim[n * 16 + c] = (float)(cfr * bi + cfi * br); }
            double pr = 1.0, pi = 0.0;
            for (int tau = 0; tau <= 32; ++tau) { Pre[tau * 64 + n] = (float)pr; Pim[tau * 64 + n] = (float)pi; const double t2 = pr * lre - pi * lim; pi = pr * lim + pi * lre; pr = t2; }
            ((f32x2*)(ws + WS_LAML))[g * 64 + n] = (f32x2){Pre[32 * 64 + n], Pim[32 * 64 + n]};
        }
        for (int i = tid; i < 1024; i += 512) { Cre[i] = a.in[I_CRE][g * 1024 + i]; Cim[i] = a.in[I_CIM][g * 1024 + i]; }
        __syncthreads();
        float* KG = (float*)(ws + WS_KG) + (size_t)g * 32 * 256;
        for (int e = tid; e < 32 * 256; e += 512) { const int tau = e >> 8, co = (e >> 4) & 15, ci = e & 15; float s = 0.f;
            for (int n = 0; n < 64; ++n) { const float pr = Pre[tau * 64 + n], pi = Pim[tau * 64 + n], br = Bre[n * 16 + ci], bi = Bim[n * 16 + ci];
                const float qr = pr * br - pi * bi, qi = pr * bi + pi * br; s += Cre[co * 64 + n] * qr - Cim[co * 64 + n] * qi; }
            KG[e] = s; }
        bf16_t* TZ = (bf16_t*)(ws + WS_TZ) + (size_t)g * S5N * S5K;
        for (int e = tid; e < 512 * 16; e += 512) { const int row = e >> 4, m0 = (e & 15) * 8, j = row >> 4, co = row & 15; float v[8];
#pragma unroll
            for (int i = 0; i < 8; ++i) { const int m = m0 + i, n = m & 63; const float pr = Pre[(j + 1) * 64 + n], pi = Pim[(j + 1) * 64 + n], cr = Cre[co * 64 + n], ci = Cim[co * 64 + n];
                v[i] = (m < 64) ? (cr * pr - ci * pi) : -(cr * pi + ci * pr); }
            u32x4 o; o.x = pk2(v[0], v[1]); o.y = pk2(v[2], v[3]); o.z = pk2(v[4], v[5]); o.w = pk2(v[6], v[7]); *(u32x4*)(TZ + (size_t)row * S5K + 512 + m0) = o; }
        bf16_t* W1 = (bf16_t*)(ws + WS_W1) + (size_t)g * 256 * 512;
        for (int e = tid; e < 256 * 64; e += 512) { const int m = e >> 6, s = (e & 63) >> 1, ci0 = (e & 1) * 8; float v[8];
#pragma unroll
            for (int i = 0; i < 8; ++i) { float x = 0.f;
                if (m < 128) { const int n = m & 63; const float pr = Pre[(31 - s) * 64 + n], pi = Pim[(31 - s) * 64 + n], br = Bre[n * 16 + ci0 + i], bi = Bim[n * 16 + ci0 + i];
                    x = (m < 64) ? (pr * br - pi * bi) : (pr * bi + pi * br); }
                v[i] = x; }
            u32x4 o; o.x = pk2(v[0], v[1]); o.y = pk2(v[2], v[3]); o.z = pk2(v[4], v[5]); o.w = pk2(v[6], v[7]); *(u32x4*)(W1 + (size_t)m * 512 + s * 16 + ci0) = o; }
        __syncthreads();
    }
}

__device__ __forceinline__ void phase2(const Args& a) {
    const int gt = blockIdx.x * 512 + threadIdx.x, NT = gridDim.x * 512;
    unsigned char* ws = a.ws;
    const bf16_t* COLS = (const bf16_t*)(ws + WS_A); bf16_t* LIN = (bf16_t*)(ws + WS_Z); bf16_t* UG = (bf16_t*)(ws + WS_UG);
    const float* mu = a.in[I_MU];
    for (int p = gt; p < T * 64; p += NT) {
        const int t = p >> 6, q = p & 63;
        if (q < 32) {
            const int c8 = q * 8, src = C_WD + c8; float cur[8], prv[8], o[8];
            unpack8(*(const u32x4*)(COLS + (size_t)t * INC + src), cur);
            if ((t & (SEQ - 1)) != 0) unpack8(*(const u32x4*)(COLS + (size_t)(t - 1) * INC + src), prv);
            else {
#pragma unroll
                for (int i = 0; i < 8; ++i) prv[i] = 0.f; }
#pragma unroll
            for (int i = 0; i < 8; ++i) { const float xs = cur[i] + (prv[i] - cur[i]) * mu[src + i]; o[i] = (c8 < 64) ? tanhf_(xs) : ((c8 < 128) ? xs : sigmoidf_(xs)); }
            *(u32x4*)(LIN + (size_t)t * 256 + c8) = pack8(o);
        } else {
            const int qq = q - 32, g = qq >> 1, c0 = (qq & 1) * 8; const int b = t >> 11, s = t & (SEQ - 1), ch = s >> 5, j = s & 31;
            *(u32x4*)(UG + ((size_t)g * S5ROWS + b * S5NCH + ch) * S5K + j * 16 + c0) = *(const u32x4*)(COLS + (size_t)t * INC + C_U + g * 16 + c0);
        }
    }
    const float* KG = (const float*)(ws + WS_KG); bf16_t* TZ = (bf16_t*)(ws + WS_TZ);
    for (int p = gt; p < 16 * 512 * 64; p += NT) {
        const int g = p >> 15, row = (p >> 6) & 511, kc = p & 63, j = row >> 4, co = row & 15, s = kc >> 1, ci0 = (kc & 1) * 8;
        u32x4 o = (u32x4){0u, 0u, 0u, 0u};
        if (s <= j) { const float* k = KG + (((size_t)g * 32 + (j - s)) * 16 + co) * 16 + ci0; const f32x4 k0 = *(const f32x4*)k, k1 = *(const f32x4*)(k + 4);
            o.x = pk2(k0[0], k0[1]); o.y = pk2(k0[2], k0[3]); o.z = pk2(k1[0], k1[1]); o.w = pk2(k1[2], k1[3]); }
        *(u32x4*)(TZ + ((size_t)g * S5N + row) * S5K + kc * 8) = o;
    }
}

__device__ __forceinline__ void phase4(const Args& a, LAS unsigned char* lds) {
    const int tid = threadIdx.x, lane = tid & 63, wave = tid >> 6;
    unsigned char* ws = a.ws;
    for (int item = blockIdx.x; item < 256; item += gridDim.x) {
        if (tid < 64) {
            const int b = item >> 4, g = item & 15, n = tid;
            const f32x2 lamL = ((const f32x2*)(ws + WS_LAML))[g * 64 + n];
            const float* E = (const float*)(ws + WS_E) + ((size_t)g * S5ROWS + b * S5NCH) * 128;
            bf16_t* UG = (bf16_t*)(ws + WS_UG) + ((size_t)g * S5ROWS + b * S5NCH) * S5K + 512;
            float xr = 0.f, xi = 0.f;
#pragma unroll 8
            for (int ch = 0; ch < S5NCH; ++ch) {
                UG[(size_t)ch * S5K + n] = (bf16_t)f2bf(xr); UG[(size_t)ch * S5K + 64 + n] = (bf16_t)f2bf(xi);
                const float er = E[ch * 128 + n], ei = E[ch * 128 + 64 + n];
                const float nr = lamL[0] * xr - lamL[1] * xi + er, ni = lamL[0] * xi + lamL[1] * xr + ei; xr = nr; xi = ni;
            }
        }
    }
    const bf16_t* COLS = (const bf16_t*)(ws + WS_A); const bf16_t* LORA = (const bf16_t*)a.out;
    float* Y = (float*)(ws + WS_B); float* BON = (float*)(ws + WS_BON);
    LAS float* Wb = (LAS float*)lds;
    LAS float* Ab = Wb + 2048; LAS float* Bb = Ab + 2048; LAS float* Kb = Bb + 2048; LAS float* Rb = Kb + 2048; LAS float* Vb = Rb + 2048;
    LAS float* Yb = Vb + 2048;
    for (int item = blockIdx.x; item < 256; item += gridDim.x) {
        const int bh = item >> 1, half = item & 1, b = bh >> 3, h = bh & 7;
        const int pj = tid >> 4, pq = tid & 15, hc = h * 64 + 4 * pq;
        float mur[4], muk[4], muv[4], kk4[4], ka4[4], rk4[4];
#pragma unroll
        for (int i = 0; i < 4; ++i) { mur[i] = a.in[I_MU][C_R + hc + i]; muk[i] = a.in[I_MU][C_K + hc + i]; muv[i] = a.in[I_MU][C_V + hc + i];
            kk4[i] = a.in[I_KK][hc + i]; ka4[i] = a.in[I_KA][hc + i]; rk4[i] = a.in[I_RK][hc + i]; }
        const int rr = lane >> 4, cl = lane & 15, row = 4 * wave + rr;
        float S0 = 0.f, S1 = 0.f, S2 = 0.f, S3 = 0.f;
        u32x2 rc, rp, kc, kp, vc, vp, e4, a4;
        const u32x2 zero2 = (u32x2){0u, 0u};
        __syncthreads();
#define WKV_LOAD(chunk) do { const int s_ = (chunk) * 32 + pj; const size_t t_ = (size_t)b * SEQ + s_; const bf16_t* cb_ = COLS + t_ * INC + hc; \
            rc = *(const u32x2*)(cb_ + C_R); kc = *(const u32x2*)(cb_ + C_K); vc = *(const u32x2*)(cb_ + C_V); \
            if (s_ > 0) { rp = *(const u32x2*)(cb_ - INC + C_R); kp = *(const u32x2*)(cb_ - INC + C_K); vp = *(const u32x2*)(cb_ - INC + C_V); } else { rp = zero2; kp = zero2; vp = zero2; } \
            e4 = *(const u32x2*)(LORA + t_ * 1536 + hc); a4 = *(const u32x2*)(LORA + t_ * 1536 + 512 + hc); } while (0)
#define WKV_PREP(chunk) do { float r_[4], rq_[4], k_[4], kq_[4], v_[4], vq_[4], e_[4], aa_[4]; unpack4(rc, r_); unpack4(rp, rq_); unpack4(kc, k_); unpack4(kp, kq_); unpack4(vc, v_); unpack4(vp, vq_); unpack4(e4, e_); unpack4(a4, aa_); \
            float kkv_[4], k2_[4], ss_ = 0.f, bon_ = 0.f; \
            _Pragma("unroll") for (int i = 0; i < 4; ++i) { r_[i] += (rq_[i] - r_[i]) * mur[i]; k_[i] += (kq_[i] - k_[i]) * muk[i]; v_[i] += (vq_[i] - v_[i]) * muv[i]; \
                kkv_[i] = k_[i] * kk4[i]; ss_ += kkv_[i] * kkv_[i]; k2_[i] = k_[i] * (1.0f + (aa_[i] - 1.0f) * ka4[i]); bon_ += r_[i] * k2_[i] * rk4[i]; } \
            ss_ = row16_sum(ss_); bon_ = row16_sum(bon_); const float inv_ = 1.0f / fmaxf(sqrtf(ss_), 1e-12f); \
            if (pq == 0 && half == 0) BON[((size_t)b * SEQ + (chunk) * 32 + pj) * 8 + h] = bon_; \
            const int o_ = pj * 64 + 4 * pq; \
            *(LAS f32x4*)(Wb + o_) = (f32x4){__expf(-e_[0]), __expf(-e_[1]), __expf(-e_[2]), __expf(-e_[3])}; \
            *(LAS f32x4*)(Ab + o_) = (f32x4){-kkv_[0] * inv_, -kkv_[1] * inv_, -kkv_[2] * inv_, -kkv_[3] * inv_}; \
            *(LAS f32x4*)(Bb + o_) = (f32x4){kkv_[0] * inv_ * aa_[0], kkv_[1] * inv_ * aa_[1], kkv_[2] * inv_ * aa_[2], kkv_[3] * inv_ * aa_[3]}; \
            *(LAS f32x4*)(Kb + o_) = (f32x4){k2_[0], k2_[1], k2_[2], k2_[3]}; \
            *(LAS f32x4*)(Rb + o_) = (f32x4){r_[0], r_[1], r_[2], r_[3]}; \
            *(LAS f32x4*)(Vb + o_) = (f32x4){v_[0], v_[1], v_[2], v_[3]}; } while (0)
        WKV_LOAD(0); WKV_PREP(0);
        __syncthreads();
        for (int chunk = 0; chunk < SEQ / 32; ++chunk) {
            if (chunk + 1 < SEQ / 32) WKV_LOAD(chunk + 1);
#pragma unroll 4
            for (int j = 0; j < 32; ++j) {
                const f32x4 w4 = *(const LAS f32x4*)(Wb + j * 64 + 4 * cl), aa = *(const LAS f32x4*)(Ab + j * 64 + 4 * cl), bb = *(const LAS f32x4*)(Bb + j * 64 + 4 * cl);
                const f32x4 k4 = *(const LAS f32x4*)(Kb + j * 64 + 4 * cl), r4 = *(const LAS f32x4*)(Rb + j * 64 + 4 * cl);
                const float vv = Vb[j * 64 + 32 * half + row];
                float sa = (S0 * aa[0] + S1 * aa[1]) + (S2 * aa[2] + S3 * aa[3]);
                sa = row16_sum(sa);
                S0 = fmaf(sa, bb[0], fmaf(vv, k4[0], S0 * w4[0])); S1 = fmaf(sa, bb[1], fmaf(vv, k4[1], S1 * w4[1]));
                S2 = fmaf(sa, bb[2], fmaf(vv, k4[2], S2 * w4[2])); S3 = fmaf(sa, bb[3], fmaf(vv, k4[3], S3 * w4[3]));
                float y = (S0 * r4[0] + S1 * r4[1]) + (S2 * r4[2] + S3 * r4[3]);
                y = row16_sum(y);
                if (cl == 0) Yb[j * 32 + row] = y;
            }
            __syncthreads();
            { const f32x2 yv = *(const LAS f32x2*)(Yb + pj * 32 + 2 * pq); *(f32x2*)(Y + ((size_t)b * SEQ + chunk * 32 + pj) * 512 + h * 64 + 32 * half + 2 * pq) = yv; }
            if (chunk + 1 < SEQ / 32) WKV_PREP(chunk + 1);
            __syncthreads();
        }
#undef WKV_LOAD
#undef WKV_PREP
    }
}

__device__ __forceinline__ void phase5_post(const Args& a) {
    const int gt = blockIdx.x * 512 + threadIdx.x, NT = gridDim.x * 512;
    unsigned char* ws = a.ws;
    const bf16_t* COLS = (const bf16_t*)(ws + WS_A); const bf16_t* LORA = (const bf16_t*)a.out; const float* Y = (const float*)(ws + WS_B); const float* BON = (const float*)(ws + WS_BON);
    bf16_t* RO = (bf16_t*)(ws + WS_RWKV);
    const int hq = gt & 127, h = hq >> 4, q = hq & 15, hc = h * 64 + 4 * q;
    float lg[4], lb[4], muv[4];
#pragma unroll
    for (int i = 0; i < 4; ++i) { lg[i] = a.in[I_LNG][hc + i]; lb[i] = a.in[I_LNB][hc + i]; muv[i] = a.in[I_MU][C_V + hc + i]; }
    for (int p = gt; p < T * 128; p += NT) {
        const int t = p >> 7;
        const f32x4 y4 = *(const f32x4*)(Y + (size_t)t * 512 + hc);
        float s = (y4[0] + y4[1]) + (y4[2] + y4[3]); s = row16_sum(s); const float mean = s * (1.0f / 64.0f);
        const float d0 = y4[0] - mean, d1 = y4[1] - mean, d2 = y4[2] - mean, d3 = y4[3] - mean;
        float qv = (d0 * d0 + d1 * d1) + (d2 * d2 + d3 * d3); qv = row16_sum(qv); const float rstd = 1.0f / sqrtf(qv * (1.0f / 64.0f) + 64e-5f);
        float vc[4], vp[4], g4[4]; unpack4(*(const u32x2*)(COLS + (size_t)t * INC + C_V + hc), vc);
        if ((t & (SEQ - 1)) != 0) unpack4(*(const u32x2*)(COLS + (size_t)(t - 1) * INC + C_V + hc), vp); else { vp[0] = vp[1] = vp[2] = vp[3] = 0.f; }
        unpack4(*(const u32x2*)(LORA + (size_t)t * 1536 + 1024 + hc), g4);
        const float bon = BON[(size_t)t * 8 + h];
        const float dd[4] = {d0, d1, d2, d3}; float o[4];
#pragma unroll
        for (int i = 0; i < 4; ++i) { const float v = vc[i] + (vp[i] - vc[i]) * muv[i]; o[i] = (dd[i] * rstd * lg[i] + lb[i] + bon * v) * g4[i]; }
        u32x2 w; w.x = cvt_pk_bf16(o[0], o[1]); w.y = cvt_pk_bf16(o[2], o[3]); *(u32x2*)(RO + (size_t)t * 512 + hc) = w;
    }
}

__device__ __forceinline__ void phase9(const Args& a, LAS unsigned char* lds) {
    const int tid = threadIdx.x, lane = tid & 63, wave = tid >> 6;
    unsigned char* ws = a.ws;
    const float* X1 = a.out; const bf16_t* WR = (const bf16_t*)(ws + WS_WR);
    int4* ROUTE = (int4*)(ws + WS_ROUTE); int* BC = (int*)(ws + WS_BC);
    LAS float* LG = (LAS float*)lds + wave * (16 * 49);
    LAS int* cnt = (LAS int*)(lds + 32768);
    for (int vb = blockIdx.x; vb < 256; vb += gridDim.x) {
        __syncthreads();
        if (tid < 32) cnt[tid] = 0;
        __syncthreads();
        const int t0 = vb * 128 + wave * 16;
        const int ar = lane & 15, aq = lane >> 4;
        f32x4 acc0 = (f32x4){0.f, 0.f, 0.f, 0.f}, acc1 = acc0, acc2 = acc0; float ssq = 0.f;
        const float* xrow = X1 + (size_t)(t0 + ar) * DM + 8 * aq;
        const bf16_t* wrow = WR + (size_t)ar * DM + 8 * aq;
#pragma unroll 4
        for (int kb = 0; kb < 32; ++kb) {
            const f32x4 x0 = *(const f32x4*)(xrow + kb * 32), x1 = *(const f32x4*)(xrow + kb * 32 + 4);
            ssq += (x0[0] * x0[0] + x0[1] * x0[1]) + (x0[2] * x0[2] + x0[3] * x0[3]) + (x1[0] * x1[0] + x1[1] * x1[1]) + (x1[2] * x1[2] + x1[3] * x1[3]);
            u32x4 af; af.x = cvt_pk_bf16(x0[0], x0[1]); af.y = cvt_pk_bf16(x0[2], x0[3]); af.z = cvt_pk_bf16(x1[0], x1[1]); af.w = cvt_pk_bf16(x1[2], x1[3]);
            const bf16x8 A = __builtin_bit_cast(bf16x8, af);
            const bf16x8 B0 = *(const bf16x8*)(wrow + kb * 32), B1 = *(const bf16x8*)(wrow + 16 * DM + kb * 32), B2 = *(const bf16x8*)(wrow + 32 * DM + kb * 32);
            acc0 = __builtin_amdgcn_mfma_f32_16x16x32_bf16(A, B0, acc0, 0, 0, 0);
            acc1 = __builtin_amdgcn_mfma_f32_16x16x32_bf16(A, B1, acc1, 0, 0, 0);
            acc2 = __builtin_amdgcn_mfma_f32_16x16x32_bf16(A, B2, acc2, 0, 0, 0);
        }
        ssq += __shfl_xor(ssq, 16); ssq += __shfl_xor(ssq, 32);
        const float rs = 1.0f / sqrtf(ssq * (1.0f / DM) + 1e-6f);
#pragma unroll
        for (int r = 0; r < 4; ++r) { const int row = aq * 4 + r; LG[row * 49 + ar] = acc0[r]; LG[row * 49 + 16 + ar] = acc1[r]; LG[row * 49 + 32 + ar] = acc2[r]; }
        LDS_WAIT();
        if (lane < 16) {
            const int t = t0 + lane; const LAS float* lg = LG + lane * 49;
            float gl[4]; float mx = -3.0e38f; int gi = 0;
#pragma unroll
            for (int j = 0; j < 4; ++j) { gl[j] = lg[j] * rs + a.in[I_RGB][j]; if (gl[j] > mx) { mx = gl[j]; gi = j; } }
            float den = 0.f;
#pragma unroll
            for (int j = 0; j < 4; ++j) den += __expf(gl[j] - mx);
            const float gp = 1.0f / den;
            float b1 = -3.0e38f, b2 = -3.0e38f; int i1 = 0, i2 = 0;
            for (int j = 0; j < 8; ++j) { const float v = lg[4 + gi * 8 + j] * rs + a.in[I_REB][gi * 8 + j];
                if (v > b1) { b2 = b1; i2 = i1; b1 = v; i1 = j; } else if (v > b2) { b2 = v; i2 = j; } }
            const float e2 = __expf(b2 - b1), w1 = gp / (1.0f + e2), w2 = gp * e2 / (1.0f + e2);
            const int e0 = gi * 8 + i1, e1 = gi * 8 + i2;
            const int s0 = atomicAdd((int*)&cnt[e0], 1), s1 = atomicAdd((int*)&cnt[e1], 1);
            int4 rt; rt.x = e0 | (e1 << 8); rt.y = s0 | (s1 << 16); rt.z = __builtin_bit_cast(int, w1); rt.w = __builtin_bit_cast(int, w2);
            ROUTE[t] = rt;
        }
        __syncthreads();
        if (tid < 32) BC[vb * 32 + tid] = cnt[tid];
    }
}

__device__ __forceinline__ void phase10(const Args& a, LAS unsigned char* lds) {
    const int tid = threadIdx.x, lane = tid & 63, wave = tid >> 6;
    unsigned char* ws = a.ws;
    const float* X1 = a.out; const int4* ROUTE = (const int4*)(ws + WS_ROUTE); const int* BC = (const int*)(ws + WS_BC);
    bf16_t* HS = (bf16_t*)(ws + WS_A); float* ROWW = (float*)(ws + WS_ROWW); int2* POS = (int2*)(ws + WS_POS); int* OFF = (int*)(ws + WS_OFF);
    LAS int* ptot = (LAS int*)lds;
    LAS int* pmine = ptot + 512;
    LAS int* base = pmine + 512;
    for (int vb = blockIdx.x; vb < 256; vb += gridDim.x) {
        __syncthreads();
        { const int e = tid & 31, part = tid >> 5; int st = 0, sm = 0;
            for (int k = 0; k < 16; ++k) { const int r = part * 16 + k; const int c = BC[r * 32 + e]; st += c; sm += (r < vb) ? c : 0; }
            ptot[part * 32 + e] = st; pmine[part * 32 + e] = sm; }
        __syncthreads();
        if (tid < 32) { int st = 0, sm = 0; for (int k = 0; k < 16; ++k) { st += ptot[k * 32 + tid]; sm += pmine[k * 32 + tid]; } ptot[tid] = (st + 255) & ~255; pmine[tid] = sm; }
        __syncthreads();
        if (tid < 32) { int off = 0; for (int k = 0; k < tid; ++k) off += ptot[k]; base[tid] = off + pmine[tid];
            if (vb == 0) { OFF[tid] = off; if (tid == 31) OFF[32] = off + ptot[31]; } }
        __syncthreads();
        for (int i = 0; i < 16; ++i) {
            const int t = vb * 128 + wave * 16 + i; const int4 rt = ROUTE[t];
            const int e0 = rt.x & 255, e1 = (rt.x >> 8) & 255, p0 = base[e0] + (rt.y & 0xffff), p1 = base[e1] + ((rt.y >> 16) & 0xffff);
            const f32x4* xr = (const f32x4*)(X1 + (size_t)t * DM) + lane; f32x4 v[4]; float s = 0.f;
#pragma unroll
            for (int j = 0; j < 4; ++j) { v[j] = xr[64 * j]; s += (v[j][0] * v[j][0] + v[j][1] * v[j][1]) + (v[j][2] * v[j][2] + v[j][3] * v[j][3]); }
            const float rs = 1.0f / sqrtf(wave_sum(s) * (1.0f / DM) + 1e-6f);
            u32x2* o0 = (u32x2*)(HS + (size_t)p0 * DM) + lane; u32x2* o1 = (u32x2*)(HS + (size_t)p1 * DM) + lane;
#pragma unroll
            for (int j = 0; j < 4; ++j) { u32x2 w; w.x = pk2(v[j][0] * rs, v[j][1] * rs); w.y = pk2(v[j][2] * rs, v[j][3] * rs); o0[64 * j] = w; o1[64 * j] = w; }
            if (lane == 0) { ROWW[p0] = __builtin_bit_cast(float, rt.z); ROWW[p1] = __builtin_bit_cast(float, rt.w); POS[t] = make_int2(p0, p1); }
        }
    }
}

__device__ __forceinline__ void phase13(const Args& a) {
    const int tid = threadIdx.x, lane = tid & 63, wave = tid >> 6;
    const int gw = blockIdx.x * 8 + wave, NGW = gridDim.x * 8;
    unsigned char* ws = a.ws;
    float* X = a.out; const bf16_t* YM = (const bf16_t*)(ws + WS_A); const int2* POS = (const int2*)(ws + WS_POS); bf16_t* HP = (bf16_t*)(ws + WS_HP); bf16_t* P16 = (bf16_t*)(ws + WS_P16);
    for (int t = gw; t < T; t += NGW) {
        const int2 ps = POS[t];
        f32x4* xr = (f32x4*)(X + (size_t)t * DM) + lane; const u32x2* y0 = (const u32x2*)(YM + (size_t)ps.x * DM) + lane; const u32x2* y1 = (const u32x2*)(YM + (size_t)ps.y * DM) + lane;
        f32x4 v[4]; float s = 0.f;
#pragma unroll
        for (int j = 0; j < 4; ++j) { v[j] = xr[64 * j]; float a0[4], a1[4]; unpack4(y0[64 * j], a0); unpack4(y1[64 * j], a1);
            v[j][0] = (v[j][0] + a0[0]) + a1[0]; v[j][1] = (v[j][1] + a0[1]) + a1[1]; v[j][2] = (v[j][2] + a0[2]) + a1[2]; v[j][3] = (v[j][3] + a0[3]) + a1[3];
            s += (v[j][0] * v[j][0] + v[j][1] * v[j][1]) + (v[j][2] * v[j][2] + v[j][3] * v[j][3]); xr[64 * j] = v[j]; }
        const float rs = 1.0f / sqrtf(wave_sum(s) * (1.0f / DM) + 1e-6f);
        u32x2* o = (u32x2*)(HP + (size_t)t * DM) + lane;
#pragma unroll
        for (int j = 0; j < 4; ++j) { u32x2 w; w.x = pk2(v[j][0] * rs, v[j][1] * rs); w.y = pk2(v[j][2] * rs, v[j][3] * rs); o[64 * j] = w; }
        const f32x4 pv = *((const f32x4*)(a.in[I_P] + (size_t)t * 256) + lane);
        u32x2 w; w.x = pk2(pv[0], pv[1]); w.y = pk2(pv[2], pv[3]); *((u32x2*)(P16 + (size_t)t * 256) + lane) = w;
    }
}
__device__ __forceinline__ void phase15(const Args& a, const float* XS) {
    const int tid = threadIdx.x, lane = tid & 63, wave = tid >> 6;
    const int gw = blockIdx.x * 8 + wave, NGW = gridDim.x * 8;
    float* X = a.out; const f32x4* gn = (const f32x4*)a.in[I_FINN] + lane;
    f32x4 g[4];
#pragma unroll
    for (int j = 0; j < 4; ++j) g[j] = gn[64 * j];
    for (int t = gw; t < T; t += NGW) {
        f32x4* xr = (f32x4*)(X + (size_t)t * DM) + lane; const f32x4* xs = (const f32x4*)(XS + (size_t)t * DM) + lane; f32x4 v[4]; float s = 0.f;
#pragma unroll
        for (int j = 0; j < 4; ++j) { v[j] = xs[64 * j]; s += (v[j][0] * v[j][0] + v[j][1] * v[j][1]) + (v[j][2] * v[j][2] + v[j][3] * v[j][3]); }
        const float rs = 1.0f / sqrtf(wave_sum(s) * (1.0f / DM) + 1e-6f);
#pragma unroll
        for (int j = 0; j < 4; ++j) xr[64 * j] = (f32x4){v[j][0] * rs * g[j][0], v[j][1] * rs * g[j][1], v[j][2] * rs * g[j][2], v[j][3] * rs * g[j][3]};
    }
}


#ifdef PROBE
__device__ __forceinline__ void phase_probe(const Args& a) {
    const int gt = blockIdx.x * 512 + threadIdx.x, NT = gridDim.x * 512;
#if PROBE == 1
    const bf16_t* src = (const bf16_t*)(a.ws + WS_HP); const size_t n = (size_t)T * DM;
#elif PROBE == 2
    const bf16_t* src = (const bf16_t*)(a.ws + WS_WPG); const size_t n = (size_t)1024 * 1024;
#else
    const bf16_t* src = (const bf16_t*)(a.ws + WS_G); const size_t n = (size_t)T * DM;
#endif
    for (size_t i = gt; i < (size_t)T * DM; i += NT) a.out[i] = (i < n) ? __builtin_bit_cast(float, (unsigned)src[i] << 16) : 0.f;
}
#endif
__global__ void __launch_bounds__(512) mega_fwd(Args a) {
    extern __shared__ __attribute__((aligned(16))) unsigned char lds_raw[];
    LAS unsigned char* lds = (LAS unsigned char*)lds_raw;
    unsigned char* ws = a.ws;
    const int G = gridDim.x, c = blockIdx.x;
    const int lo = a.ph_lo, hi = a.ph_hi;
#ifndef PHMASK
#define PHMASK 0xFFFFF
#endif
#define IN(k) ((((PHMASK) >> (k)) & 1) && lo <= (k) && (k) < hi)
#define SEAM(k) do { if (IN(k) && IN((k) + 1)) { cg::this_grid().sync(); } } while (0)
    bf16_t* COLS = (bf16_t*)(ws + WS_A);
    if (IN(0)) { phase0(a, lds); }
    SEAM(0);
    if (IN(1)) {
        pg8::DenseSched S; S.init(a.out, 1024, ws + WS_WIN, 1024, T, INC, G, c);
        pg8::EpiRow8<F_Cols> E{{COLS, INC}};
        pg8::gemm_phase<pg8::EpiRow8<F_Cols>, pg8::DenseSched, true>(lds, 1024, 1024, 1024, S, E);
    }
    SEAM(1);
    if (IN(2)) { phase2(a); }
    SEAM(2);
    if (IN(3)) {
        pg8::DenseSched S; S.init(ws + WS_Z, 256, ws + WS_WLORA, 256, T, 1536, G, c);
        pg8::EpiRow8<F_Lora> E{{(bf16_t*)a.out, a.in[I_W0], a.in[I_A0]}};
        pg8::gemm_phase<pg8::EpiRow8<F_Lora>, pg8::DenseSched, true>(lds, 256, 256, 256, S, E);
    }
    SEAM(3);
    if (IN(4)) {
        pg8::GroupSched S{(const char*)(ws + WS_UG), (const char*)(ws + WS_W1), S5K, 512, 4, 1, 16, G, c, (size_t)S5ROWS * S5K * 2, (size_t)256 * 512 * 2};
        pg8::EpiRow8<F_S5a> E{{(float*)(ws + WS_E)}};
        pg8::gemm_phase<pg8::EpiRow8<F_S5a>, pg8::GroupSched, true>(lds, 512, S5K, 512, S, E);
    }
    SEAM(4);
    if (IN(5)) { phase4(a, lds); }
    SEAM(5);
    if (IN(6)) { phase5_post(a); }
    SEAM(6);
    if (IN(7)) {
        pg8::GroupSched S{(const char*)(ws + WS_UG), (const char*)(ws + WS_TZ), S5K, S5K, 4, 2, 16, G, c, (size_t)S5ROWS * S5K * 2, (size_t)S5N * S5K * 2};
        pg8::EpiRow8<F_S5c> E{{COLS, a.in[I_SD], (bf16_t*)(ws + WS_Z)}};
        pg8::gemm_phase<pg8::EpiRow8<F_S5c>, pg8::GroupSched, true>(lds, S5K, S5K, S5K, S, E);
    }
    SEAM(7);
    if (IN(8)) {
        pg8::DenseSched S; S.init(ws + WS_Z, 256, ws + WS_WGLU, 256, T, 256, G, c);
        pg8::EpiRow8<F_Glu> E{{(const bf16_t*)(ws + WS_Z), a.in[I_GLUB], (bf16_t*)(ws + WS_S5O)}};
        pg8::gemm_phase<pg8::EpiRow8<F_Glu>, pg8::DenseSched, true>(lds, 256, 256, 256, S, E);
    }
    SEAM(8);
    if (IN(9)) {
        pg8::DenseSched S; S.init(ws + WS_RWKV, 512, ws + WS_WBA, 512, T, DM, G, c);
        pg8::EpiRow8<F_BrA> E{{COLS, a.out}};
        pg8::gemm_phase<pg8::EpiRow8<F_BrA>, pg8::DenseSched, true>(lds, 512, 512, 512, S, E);
    }
    SEAM(9);
    if (IN(10)) {
        pg8::DenseSched S; S.init(ws + WS_S5O, 256, ws + WS_WBB, 256, T, DM, G, c);
        pg8::EpiRow8<F_BrB> E{{COLS, a.out, (bf16_t*)(ws + WS_B)}};
        pg8::gemm_phase<pg8::EpiRow8<F_BrB>, pg8::DenseSched, true>(lds, 256, 256, 256, S, E);
    }
    SEAM(10);
    if (IN(11)) {
        pg8::DenseSched S; S.init(ws + WS_B, 1024, ws + WS_WOUT, 1024, T, DM, G, c);
        pg8::EpiRow8<F_Res> E{{a.in[I_X], a.out}};
        pg8::gemm_phase<pg8::EpiRow8<F_Res>, pg8::DenseSched, true>(lds, 1024, 1024, 1024, S, E);
    }
    SEAM(11);
    if (IN(12)) { phase9(a, lds); }
    SEAM(12);
    if (IN(13)) { phase10(a, lds); }
    SEAM(13);
    if (IN(14)) {
        pg8::MoeSched S{(const int*)(ws + WS_OFF), (const char*)(ws + WS_A), (const char*)(ws + WS_WGU), 1024, 1024, 2, G, c, (size_t)512 * 1024 * 2};
        pg8::EpiMoeUp E{(bf16_t*)(ws + WS_HID)};
        pg8::gemm_phase<pg8::EpiMoeUp, pg8::MoeSched, true>(lds, 1024, 1024, 1024, S, E);
    }
    SEAM(14);
    if (IN(15)) {
        pg8::MoeSched S{(const int*)(ws + WS_OFF), (const char*)(ws + WS_HID), (const char*)(ws + WS_WD), 256, 256, 4, G, c, (size_t)1024 * 256 * 2};
        pg8::EpiRow8<F_MoeDown> E{{(const float*)(ws + WS_ROWW), (bf16_t*)(ws + WS_A)}};
        pg8::gemm_phase<pg8::EpiRow8<F_MoeDown>, pg8::MoeSched, true>(lds, 256, 256, 256, S, E);
    }
    SEAM(15);
    if (IN(16)) { phase13(a); }
    SEAM(16);
    if (IN(17)) {
        pg8::DenseSched S; S.init(ws + WS_HP, 1024, ws + WS_WPG, 1024, T, DM, G, c);
        pg8::EpiRow8<F_PleG> E{{(bf16_t*)(ws + WS_G)}};
        pg8::gemm_phase<pg8::EpiRow8<F_PleG>, pg8::DenseSched, true>(lds, 1024, 1024, 1024, S, E);
    }
    SEAM(17);
    if (IN(18)) {
        pg8::DenseSched S; S.init(ws + WS_P16, 256, ws + WS_WPP, 256, T, DM, G, c);
        pg8::EpiRow8<F_PleP> E{{(const bf16_t*)(ws + WS_G), a.out, (float*)(ws + WS_A)}};
        pg8::gemm_phase<pg8::EpiRow8<F_PleP>, pg8::DenseSched, true>(lds, 256, 256, 256, S, E);
    }
    SEAM(18);
#ifdef PROBE
    if (IN(19)) { phase_probe(a); }
#else
    if (IN(19)) { phase15(a, ((PHMASK >> 18) & 1) ? (const float*)(ws + WS_A) : (const float*)a.out); }
#endif
#undef IN
#undef SEAM
}

extern "C" void kernel_launch(void* const* d_in, const int* in_sizes, int n_in, void* d_out, int out_size, void* d_ws, size_t ws_size, hipStream_t stream) {
    static int grid = 0;
    if (grid == 0) {
        if (n_in != 40 || out_size != T * DM || ws_size < WS_END) { fprintf(stderr, "kernel_launch: unexpected problem (n_in %d, out %d, ws %zu < %zu); nothing launched\n", n_in, out_size, ws_size, (size_t)WS_END); grid = -1; return; }
        int dev = 0, cus = 0, per_cu = 0;
        hipGetDevice(&dev); hipDeviceGetAttribute(&cus, hipDeviceAttributeMultiprocessorCount, dev);
        if (hipFuncSetAttribute((const void*)mega_fwd, hipFuncAttributeMaxDynamicSharedMemorySize, LDS_BYTES) != hipSuccess) { fprintf(stderr, "kernel_launch: hipFuncSetAttribute failed\n"); grid = -1; return; }
        if (hipOccupancyMaxActiveBlocksPerMultiprocessor(&per_cu, (const void*)mega_fwd, 512, LDS_BYTES) != hipSuccess || per_cu < 1) { fprintf(stderr, "kernel_launch: occupancy query says %d\n", per_cu); per_cu = 1; }
        (void)hipGetLastError();
        grid = cus * 1;
        if (grid > 256) grid = 256;
    }
    if (grid < 0) return;
    Args a{};
    for (int i = 0; i < 40; ++i) a.in[i] = (const float*)d_in[i];
    a.out = (float*)d_out; a.ws = (unsigned char*)d_ws;
#if MK_N_LAUNCHES == 1
    a.ph_lo = 0; a.ph_hi = NPHASE;
    void* kargs[] = {&a};
    hipError_t e = hipLaunchCooperativeKernel((const void*)mega_fwd, dim3(grid), dim3(512), kargs, LDS_BYTES, stream);
    if (e != hipSuccess) fprintf(stderr, "kernel_launch: cooperative launch failed: %s\n", hipGetErrorString(e));
#else
    for (int k = 0; k < NPHASE; ++k) {
        a.ph_lo = k; a.ph_hi = k + 1;
        hipLaunchKernelGGL(mega_fwd, dim3(grid), dim3(512), LDS_BYTES, stream, a);
    }
#endif
}
```

```cpp
#include <hip/hip_runtime.h>
#include <hip/hip_cooperative_groups.h>
#include <cstdio>
#include <cstdint>
namespace cg = cooperative_groups;

#ifndef MK_N_LAUNCHES
#define MK_N_LAUNCHES 1
#endif

#define LAS __attribute__((address_space(3)))
typedef unsigned short bf16_t;
typedef short bf16x8 __attribute__((ext_vector_type(8)));
typedef float f32x4 __attribute__((ext_vector_type(4)));
typedef float f32x2 __attribute__((ext_vector_type(2)));
typedef unsigned u32x4 __attribute__((ext_vector_type(4)));
typedef unsigned u32x2 __attribute__((ext_vector_type(2)));

constexpr int T = 32768, DM = 1024, SEQ = 2048, NBATCH = 16, INC = 4096;
constexpr int C_R = 0, C_K = 512, C_V = 1024, C_WD = 1536, C_U = 1792, C_GA = 2048, C_GB = 3072;
constexpr int S5L = 32, S5NCH = 64, S5K = 640, S5N = 512, S5ROWS = 1024;
constexpr int NEXP = 32, DEXP = 256, MOE_ROWS_MAX = 2 * T + NEXP * 256;
constexpr int NPHASE = 20;

constexpr size_t MiB = (size_t)1 << 20, KiB = 1024;
constexpr size_t WS_CTL = 0;
constexpr size_t WS_WIN = 1 * MiB, WS_WBA = 9 * MiB, WS_WBB = 10 * MiB, WS_WOUT = 11 * MiB, WS_WPG = 13 * MiB, WS_WPP = 15 * MiB;
constexpr size_t WS_WLORA = 16 * MiB, WS_WGLU = 17 * MiB, WS_WR = 17 * MiB + 512 * KiB, WS_LAML = 17 * MiB + 768 * KiB;
constexpr size_t WS_KG = 18 * MiB, WS_W1 = 19 * MiB, WS_TZ = 23 * MiB, WS_WGU = 33 * MiB, WS_WD = 65 * MiB;
constexpr size_t WS_A = 82 * MiB;
constexpr size_t WS_HID = WS_A + 144 * MiB, WS_G = WS_A + 128 * MiB;
constexpr size_t WS_B = 338 * MiB;
constexpr size_t WS_UG = 402 * MiB, WS_E = 422 * MiB, WS_BON = 430 * MiB, WS_RWKV = 431 * MiB, WS_Z = 463 * MiB, WS_S5O = 479 * MiB;
constexpr size_t WS_ROUTE = 495 * MiB, WS_POS = 495 * MiB + 512 * KiB, WS_ROWW = 496 * MiB, WS_BC = 496 * MiB + 512 * KiB, WS_OFF = 496 * MiB + 768 * KiB;
constexpr size_t WS_HP = WS_RWKV;
constexpr size_t WS_P16 = WS_UG;
constexpr size_t WS_END = 497 * MiB;

constexpr int LDS_BYTES = 147456;
constexpr int MISC_OFF = 131072;

struct Args { const float* in[40]; float* out; unsigned char* ws; int ph_lo, ph_hi; };

#define LDS_WAIT() asm volatile("s_waitcnt lgkmcnt(0)" ::: "memory")
#define VM_WAIT() asm volatile("s_waitcnt vmcnt(0)" ::: "memory")
__device__ __forceinline__ unsigned f2bf(float f) { unsigned u = __builtin_bit_cast(unsigned, f); return (u + 0x7fffu + ((u >> 16) & 1u)) >> 16; }
__device__ __forceinline__ unsigned pk2(float lo, float hi) { return f2bf(lo) | (f2bf(hi) << 16); }
typedef __bf16 bf16x2_t __attribute__((ext_vector_type(2)));
__device__ __forceinline__ unsigned cvt_pk_bf16(float lo, float hi) { const f32x2 v = {lo, hi}; const bf16x2_t b = __builtin_convertvector(v, bf16x2_t); return __builtin_bit_cast(unsigned, b); }
__device__ __forceinline__ float bflo(unsigned w) { return __builtin_bit_cast(float, w << 16); }
__device__ __forceinline__ float bfhi(unsigned w) { return __builtin_bit_cast(float, w & 0xffff0000u); }
__device__ __forceinline__ void unpack8(u32x4 w, float (&v)[8]) { v[0] = bflo(w.x); v[1] = bfhi(w.x); v[2] = bflo(w.y); v[3] = bfhi(w.y); v[4] = bflo(w.z); v[5] = bfhi(w.z); v[6] = bflo(w.w); v[7] = bfhi(w.w); }
__device__ __forceinline__ void unpack4(u32x2 w, float (&v)[4]) { v[0] = bflo(w.x); v[1] = bfhi(w.x); v[2] = bflo(w.y); v[3] = bfhi(w.y); }
__device__ __forceinline__ u32x4 pack8(const float (&v)[8]) { u32x4 w; w.x = cvt_pk_bf16(v[0], v[1]); w.y = cvt_pk_bf16(v[2], v[3]); w.z = cvt_pk_bf16(v[4], v[5]); w.w = cvt_pk_bf16(v[6], v[7]); return w; }
__device__ __forceinline__ float sigmoidf_(float x) { return __builtin_amdgcn_rcpf(1.0f + __expf(-x)); }
__device__ __forceinline__ float tanhf_(float x) { return 1.0f - 2.0f * __builtin_amdgcn_rcpf(1.0f + __expf(2.0f * x)); }
__device__ __forceinline__ float gelu_tanh(float y) { return 0.5f * y * (1.0f + tanhf_(0.7978845608028654f * (y + 0.044715f * y * y * y))); }
__device__ __forceinline__ float wave_sum(float v) {
#pragma unroll
    for (int o = 1; o < 64; o <<= 1) v += __shfl_xor(v, o);
    return v;
}
__device__ __forceinline__ float dpp_f(float x, const int ctrl_sel) {
    int xi = __builtin_bit_cast(int, x), r;
    if (ctrl_sel == 0) r = __builtin_amdgcn_update_dpp(0, xi, 0xB1, 0xf, 0xf, true);
    else if (ctrl_sel == 1) r = __builtin_amdgcn_update_dpp(0, xi, 0x4E, 0xf, 0xf, true);
    else if (ctrl_sel == 2) r = __builtin_amdgcn_update_dpp(0, xi, 0x141, 0xf, 0xf, true);
    else r = __builtin_amdgcn_update_dpp(0, xi, 0x140, 0xf, 0xf, true);
    return __builtin_bit_cast(float, r);
}
__device__ __forceinline__ float row16_sum(float x) {
    x += dpp_f(x, 0); x += dpp_f(x, 1); x += dpp_f(x, 2); x += dpp_f(x, 3); return x;
}

namespace pg8 {
constexpr int BM = 256, BK = 64, HALF = 128, HTB = HALF * BK * 2, STAGE_BYTES = 8 * HTB, NXCD = 8, WGM = 8;
__host__ __device__ __forceinline__ int lds_byte(int r, int c) { const int st = (r >> 4) * 2 + (c >> 5), rr = r & 15, cc = c & 31, ob = rr * 64 + cc * 2; return st * 1024 + (ob ^ (((ob >> 9) & 1) << 5)); }
__host__ __device__ __forceinline__ void stage_rc(int b, int& R, int& C) { const int st = b / 1024, sb = b % 1024, swz = sb ^ (((sb >> 9) & 1) << 5); R = (st >> 1) * 16 + swz / 64; C = (st & 1) * 32 + (swz % 64) / 2; }
__host__ __device__ __forceinline__ int perm32(int rho) { const int n = rho >> 4, i = rho & 15; return 8 * (i >> 2) + 4 * n + (i & 3); }

struct Unit { int pm, pn, aux; const char* A; const char* B; };

struct StaticOrder {
    int nM, nN, nwg, G, c;
    __device__ __forceinline__ void init(int M, int N, int G_, int c_) { nM = M / BM; nN = N / BM; nwg = nM * nN; G = G_; c = c_; }
    __device__ __forceinline__ bool next(int i, int& pm, int& pn) const {
        const long L = (long)i * G + c; if (L >= nwg) return false;
        int wgid = (int)L; { const int q = nwg / NXCD, r = nwg % NXCD, xcd = wgid % NXCD, off = wgid / NXCD; wgid = (xcd < r ? xcd * (q + 1) : r * (q + 1) + (xcd - r) * q) + off; }
        const int nig = WGM * nN, gid = wgid / nig, fm = gid * WGM, gsz = (nM - fm) < WGM ? (nM - fm) : WGM;
        pm = fm + ((wgid % nig) % gsz); pn = (wgid % nig) / gsz; return true;
    }
};
struct DenseSched {
    const char* A; const char* B; int lda, ldb; StaticOrder so;
    __device__ __forceinline__ void init(const void* A_, int lda_, const void* B_, int ldb_, int M, int N, int G, int c) { A = (const char*)A_; B = (const char*)B_; lda = lda_; ldb = ldb_; so.init(M, N, G, c); }
    __device__ __forceinline__ bool next(int i, Unit& u) const {
        int pm, pn; if (!so.next(i, pm, pn)) return false;
        u.pm = pm; u.pn = pn; u.aux = 0; u.A = A + (size_t)pm * BM * lda * 2; u.B = B + (size_t)pn * BM * ldb * 2; return true;
    }
};
struct GroupSched {
    const char* A; const char* B; int lda, ldb, nM, nN, ngroups, G, c; size_t aStride, bStride;
    __device__ __forceinline__ bool next(int i, Unit& u) const {
        const int L = i * G + c; if (L >= ngroups * nM * nN) return false;
        const int g = L / (nM * nN), r = L % (nM * nN), pm = r % nM, pn = r / nM;
        u.pm = pm; u.pn = pn; u.aux = g; u.A = A + g * aStride + (size_t)pm * BM * lda * 2; u.B = B + g * bStride + (size_t)pn * BM * ldb * 2; return true;
    }
};
struct MoeSched {
    const int* off; const char* A; const char* B; int lda, ldb, NPN, G, c; size_t bStride;
    __device__ __forceinline__ bool next(int i, Unit& u) const {
        const int nTiles = off[NEXP] >> 8; const int L = i * G + c; if (L >= nTiles * NPN) return false;
        const int tile = L / NPN, pn = L % NPN, row = tile << 8; int e = 0;
        for (int k = 1; k < NEXP; ++k) e += (off[k] <= row) ? 1 : 0;
        u.pm = tile; u.pn = pn; u.aux = e; u.A = A + (size_t)tile * BM * lda * 2; u.B = B + e * bStride + (size_t)pn * BM * ldb * 2; return true;
    }
};

template <class F> struct EpiRow8 {
    F f;
    __device__ __forceinline__ void operator()(const f32x4 (&acc)[2][2][4][2], const Unit& u, int wr, int wc, int fr, int fq) const {
#pragma unroll
        for (int ai = 0; ai < 2; ++ai)
#pragma unroll
            for (int m = 0; m < 4; ++m) { const int r = ai * HALF + wr * 64 + m * 16 + fr;
#pragma unroll
                for (int bj = 0; bj < 2; ++bj) { const int c = bj * HALF + wc * 32 + 8 * fq;
                    float v[8] = {acc[ai][bj][m][0][0], acc[ai][bj][m][0][1], acc[ai][bj][m][0][2], acc[ai][bj][m][0][3], acc[ai][bj][m][1][0], acc[ai][bj][m][1][1], acc[ai][bj][m][1][2], acc[ai][bj][m][1][3]};
                    f(u, r, c, v); } }
    }
};
struct EpiMoeUp {
    bf16_t* HID;
    __device__ __forceinline__ void operator()(const f32x4 (&acc)[2][2][4][2], const Unit& u, int wr, int wc, int fr, int fq) const {
#pragma unroll
        for (int ai = 0; ai < 2; ++ai)
#pragma unroll
            for (int m = 0; m < 4; ++m) { const int r = u.pm * BM + ai * HALF + wr * 64 + m * 16 + fr; const int hc = u.pn * HALF + wc * 32 + 8 * fq;
                float o[8];
#pragma unroll
                for (int n = 0; n < 2; ++n)
#pragma unroll
                    for (int k = 0; k < 4; ++k) { const float g = acc[ai][0][m][n][k], up = acc[ai][1][m][n][k]; o[4 * n + k] = g * sigmoidf_(g) * up; }
                *(u32x4*)(HID + (size_t)r * DEXP + hc) = pack8(o); }
    }
};

template <class Epi, class Sched, bool ALIGN_EPI>
__device__ __forceinline__ void gemm_phase(LAS unsigned char* lds, const int K, const int lda, const int ldb, const Sched& S, const Epi& E) {
    const int tid = threadIdx.x, wid = __builtin_amdgcn_readfirstlane(tid >> 6), lane = tid & 63, wr = wid >> 2, wc = wid & 3, fr = lane & 15, fq = lane >> 4;
    const int nt = K / BK;
    unsigned voffA[2], voffB[2];
#pragma unroll
    for (int i = 0; i < 2; ++i) { int R, C; stage_rc(tid * 16 + i * 8192, R, C); const int Rb = (R & ~31) + perm32(R & 31);
        voffA[i] = (unsigned)(R * lda + C) * 2u; voffB[i] = (unsigned)(Rb * ldb + C) * 2u; }
    const size_t kstep = (size_t)(BK * 2);
    const size_t hstepA = (size_t)HALF * lda * 2, hstepB = (size_t)HALF * ldb * 2;
    const unsigned ldsw = (unsigned)wid * 1024u;
    const int aoff = lds_byte(wr * 64 + fr, fq * 8), boff = lds_byte(wc * 32 + fr, fq * 8);
#define PG8_SA(b, h) (((b) * 2 + (h)) * HTB)
#define PG8_SB(b, h) ((4 + (b) * 2 + (h)) * HTB)
#define PG8_STAGE(bufoff, gbase, voff) do { _Pragma("unroll") for (int _i = 0; _i < 2; ++_i) \
        __builtin_amdgcn_global_load_lds((const unsigned*)((const char*)(gbase) + (voff)[_i]), (LAS unsigned*)(lds + (bufoff) + ldsw + _i * 8192), 16, 0, 0); } while (0)
#define PG8_LDA(dst, b, h) do { _Pragma("unroll") for (int m = 0; m < 4; ++m) _Pragma("unroll") for (int k = 0; k < 2; ++k) dst[m][k] = *(const LAS bf16x8*)(lds + PG8_SA(b, h) + aoff + m * 2048 + k * 1024); } while (0)
#define PG8_LDB(dst, b, h) do { _Pragma("unroll") for (int n = 0; n < 2; ++n) _Pragma("unroll") for (int k = 0; k < 2; ++k) dst[n][k] = *(const LAS bf16x8*)(lds + PG8_SB(b, h) + boff + n * 2048 + k * 1024); } while (0)
#define PG8_MMA(ai, bj, At, Bt) do { __builtin_amdgcn_s_setprio(1); _Pragma("unroll") for (int m = 0; m < 4; ++m) _Pragma("unroll") for (int n = 0; n < 2; ++n) _Pragma("unroll") for (int k = 0; k < 2; ++k) \
        acc[ai][bj][m][n] = __builtin_amdgcn_mfma_f32_16x16x32_bf16(Bt[n][k], At[m][k], acc[ai][bj][m][n], 0, 0, 0); __builtin_amdgcn_s_setprio(0); } while (0)
#define PG8_WAIT_V(n) asm volatile("s_waitcnt vmcnt(" #n ")" ::: "memory")
#define PG8_WAIT_L(n) asm volatile("s_waitcnt lgkmcnt(" #n ")" ::: "memory")
#define PG8_BAR __builtin_amdgcn_s_barrier()
#define PG8_SCHED __builtin_amdgcn_sched_barrier(0)
    Unit cur, nxt; int ui = 0;
    if (!S.next(0, cur)) return;
    f32x4 acc[2][2][4][2];
#pragma unroll
    for (int a = 0; a < 2; ++a)
#pragma unroll
        for (int b = 0; b < 2; ++b)
#pragma unroll
            for (int m = 0; m < 4; ++m)
#pragma unroll
                for (int n = 0; n < 2; ++n) acc[a][b][m][n] = (f32x4){0.f, 0.f, 0.f, 0.f};
    bf16x8 At[4][2], B0[2][2], B1[2][2];
    const char* cA = cur.A; const char* cB = cur.B;
    PG8_STAGE(PG8_SB(0, 0), cB, voffB); PG8_STAGE(PG8_SB(0, 1), cB + hstepB, voffB); PG8_STAGE(PG8_SA(0, 0), cA, voffA); PG8_STAGE(PG8_SA(0, 1), cA + hstepA, voffA);
    if (wr == 1) PG8_BAR;
    PG8_WAIT_V(2); PG8_BAR;
    PG8_STAGE(PG8_SB(1, 0), cB + kstep, voffB); PG8_STAGE(PG8_SA(1, 0), cA + kstep, voffA); PG8_STAGE(PG8_SB(1, 1), cB + hstepB + kstep, voffB);
    PG8_WAIT_V(6); PG8_BAR;
    for (;;) {
        const bool has_next = S.next(ui + 1, nxt);
        const char* nA = has_next ? nxt.A : cA; const char* nB = has_next ? nxt.B : cB;
#pragma unroll 1
        for (int t = 0; t < nt; t += 2) {
            const bool last = (t == nt - 2);
            const char* a1 = cA + (size_t)(t + 1) * kstep;
            const char* a2 = last ? nA : cA + (size_t)(t + 2) * kstep; const char* b2 = last ? nB : cB + (size_t)(t + 2) * kstep;
            const char* a3 = a2 + kstep; const char* b3 = b2 + kstep;
            PG8_LDB(B0, 0, 0); PG8_LDB(B1, 0, 1); PG8_SCHED; PG8_LDA(At, 0, 0); PG8_STAGE(PG8_SA(1, 1), a1 + hstepA, voffA);
            PG8_WAIT_V(8); PG8_WAIT_L(0); PG8_BAR; PG8_MMA(0, 0, At, B0); PG8_MMA(0, 1, At, B1); PG8_BAR; PG8_SCHED;
            PG8_LDA(At, 0, 1); PG8_STAGE(PG8_SB(0, 0), b2, voffB); PG8_STAGE(PG8_SB(0, 1), b2 + hstepB, voffB); PG8_STAGE(PG8_SA(0, 0), a2, voffA);
            PG8_WAIT_V(8); PG8_WAIT_L(0); PG8_BAR; PG8_MMA(1, 0, At, B0); PG8_MMA(1, 1, At, B1); PG8_BAR; PG8_SCHED;
            PG8_LDB(B0, 1, 0); PG8_LDB(B1, 1, 1); PG8_SCHED; PG8_LDA(At, 1, 0); PG8_STAGE(PG8_SA(0, 1), a2 + hstepA, voffA);
            PG8_WAIT_V(8); PG8_WAIT_L(0); PG8_BAR; PG8_MMA(0, 0, At, B0); PG8_MMA(0, 1, At, B1); PG8_BAR; PG8_SCHED;
            PG8_LDA(At, 1, 1); PG8_STAGE(PG8_SB(1, 0), b3, voffB); PG8_STAGE(PG8_SB(1, 1), b3 + hstepB, voffB); PG8_STAGE(PG8_SA(1, 0), a3, voffA);
            PG8_WAIT_V(8); PG8_WAIT_L(0); PG8_BAR; PG8_MMA(1, 0, At, B0); PG8_MMA(1, 1, At, B1); PG8_BAR; PG8_SCHED;
        }
        if constexpr (ALIGN_EPI) { if (wr == 0) PG8_BAR; }
        E(acc, cur, wr, wc, fr, fq);
        if (!has_next) break;
#pragma unroll
        for (int a = 0; a < 2; ++a)
#pragma unroll
            for (int b = 0; b < 2; ++b)
#pragma unroll
                for (int m = 0; m < 4; ++m)
#pragma unroll
                    for (int n = 0; n < 2; ++n) acc[a][b][m][n] = (f32x4){0.f, 0.f, 0.f, 0.f};
        cur = nxt; cA = nA; cB = nB; ++ui;
        if constexpr (ALIGN_EPI) { if (wr == 1) PG8_BAR; }
    }
    PG8_WAIT_V(0);
    if constexpr (!ALIGN_EPI) { if (wr == 0) PG8_BAR; }
    PG8_BAR;
#undef PG8_SA
#undef PG8_SB
#undef PG8_STAGE
#undef PG8_LDA
#undef PG8_LDB
#undef PG8_MMA
#undef PG8_WAIT_V
#undef PG8_WAIT_L
#undef PG8_BAR
#undef PG8_SCHED
}
}
using pg8::Unit;

struct F_Cols { bf16_t* C; int ldc;
    __device__ __forceinline__ void operator()(const Unit& u, int r, int c, float (&v)[8]) const {
        *(u32x4*)(C + (size_t)(u.pm * 256 + r) * ldc + u.pn * 256 + c) = pack8(v); } };
struct F_Lora { bf16_t* O; const float* w0; const float* a0;
    __device__ __forceinline__ void operator()(const Unit& u, int r, int c, float (&v)[8]) const {
        const int gc = u.pn * 256 + c; const int ty = u.pn >> 1;
        if (ty == 0) {
#pragma unroll
            for (int i = 0; i < 8; ++i) v[i] = 0.6065306597126334f * sigmoidf_(v[i] + w0[gc + i]);
        } else if (ty == 1) {
#pragma unroll
            for (int i = 0; i < 8; ++i) v[i] = sigmoidf_(v[i] + a0[gc - 512 + i]);
        }
        *(u32x4*)(O + (size_t)(u.pm * 256 + r) * 1536 + gc) = pack8(v); } };
struct F_S5a { float* E;
    __device__ __forceinline__ void operator()(const Unit& u, int r, int c, float (&v)[8]) const {
        if (c < 128) { float* p = E + ((size_t)u.aux * S5ROWS + u.pm * 256 + r) * 128 + c;
            *(f32x4*)p = (f32x4){v[0], v[1], v[2], v[3]}; *(f32x4*)(p + 4) = (f32x4){v[4], v[5], v[6], v[7]}; } } };
struct F_S5c { const bf16_t* COLS; const float* Dsk; bf16_t* Z;
    __device__ __forceinline__ void operator()(const Unit& u, int r, int c, float (&v)[8]) const {
        const int row = u.pm * 256 + r, col = u.pn * 256 + c; const int b = row >> 6, ch = row & 63, j = col >> 4, c0 = col & 15;
        const int t = b * SEQ + ch * S5L + j, chan = u.aux * 16 + c0;
        float uu[8]; unpack8(*(const u32x4*)(COLS + (size_t)t * INC + C_U + chan), uu);
#pragma unroll
        for (int i = 0; i < 8; ++i) v[i] = gelu_tanh(v[i] + Dsk[chan + i] * uu[i]);
        *(u32x4*)(Z + (size_t)t * 256 + chan) = pack8(v); } };
struct F_Glu { const bf16_t* Z; const float* gb; bf16_t* O;
    __device__ __forceinline__ void operator()(const Unit& u, int r, int c, float (&v)[8]) const {
        const size_t t = (size_t)u.pm * 256 + r; float z[8]; unpack8(*(const u32x4*)(Z + t * 256 + c), z);
#pragma unroll
        for (int i = 0; i < 8; ++i) v[i] = z[i] * sigmoidf_(v[i] + gb[c + i]);
        *(u32x4*)(O + t * 256 + c) = pack8(v); } };
struct F_BrA { const bf16_t* COLS; float* PART;
    __device__ __forceinline__ void operator()(const Unit& u, int r, int c, float (&v)[8]) const {
        const size_t t = (size_t)u.pm * 256 + r; const int col = u.pn * 256 + c; float g[8]; unpack8(*(const u32x4*)(COLS + t * INC + C_GA + col), g);
#pragma unroll
        for (int i = 0; i < 8; ++i) v[i] *= sigmoidf_(g[i]);
        float* p = PART + t * DM + col; *(f32x4*)p = (f32x4){v[0], v[1], v[2], v[3]}; *(f32x4*)(p + 4) = (f32x4){v[4], v[5], v[6], v[7]}; } };
struct F_BrB { const bf16_t* COLS; const float* PART; bf16_t* MG;
    __device__ __forceinline__ void operator()(const Unit& u, int r, int c, float (&v)[8]) const {
        const size_t t = (size_t)u.pm * 256 + r; const int col = u.pn * 256 + c; float g[8]; unpack8(*(const u32x4*)(COLS + t * INC + C_GB + col), g);
        const float* p = PART + t * DM + col; const f32x4 p0 = *(const f32x4*)p, p1 = *(const f32x4*)(p + 4);
        const float pp[8] = {p0[0], p0[1], p0[2], p0[3], p1[0], p1[1], p1[2], p1[3]};
#pragma unroll
        for (int i = 0; i < 8; ++i) v[i] = pp[i] + v[i] * sigmoidf_(g[i]);
        *(u32x4*)(MG + t * DM + col) = pack8(v); } };
struct F_Res { const float* X; float* O;
    __device__ __forceinline__ void operator()(const Unit& u, int r, int c, float (&v)[8]) const {
        const size_t o = ((size_t)u.pm * 256 + r) * DM + u.pn * 256 + c; const f32x4 x0 = *(const f32x4*)(X + o), x1 = *(const f32x4*)(X + o + 4);
        *(f32x4*)(O + o) = (f32x4){x0[0] + v[0], x0[1] + v[1], x0[2] + v[2], x0[3] + v[3]}; *(f32x4*)(O + o + 4) = (f32x4){x1[0] + v[4], x1[1] + v[5], x1[2] + v[6], x1[3] + v[7]}; } };
struct F_MoeDown { const float* ROWW; bf16_t* YM;
    __device__ __forceinline__ void operator()(const Unit& u, int r, int c, float (&v)[8]) const {
        const size_t row = (size_t)u.pm * 256 + r; const float w = ROWW[row];
#pragma unroll
        for (int i = 0; i < 8; ++i) v[i] *= w;
        *(u32x4*)(YM + row * DM + u.pn * 256 + c) = pack8(v); } };
struct F_PleG { bf16_t* G;
    __device__ __forceinline__ void operator()(const Unit& u, int r, int c, float (&v)[8]) const {
#pragma unroll
        for (int i = 0; i < 8; ++i) v[i] = sigmoidf_(v[i]);
        *(u32x4*)(G + ((size_t)u.pm * 256 + r) * DM + u.pn * 256 + c) = pack8(v); } };
struct F_PleP { const bf16_t* G; const float* X; float* XO;
    __device__ __forceinline__ void operator()(const Unit& u, int r, int c, float (&v)[8]) const {
        const size_t o = ((size_t)u.pm * 256 + r) * DM + u.pn * 256 + c; float g[8]; unpack8(*(const u32x4*)(G + o), g);
        const f32x4 x0 = *(const f32x4*)(X + o), x1 = *(const f32x4*)(X + o + 4);
#ifdef EXP_NOG
        for (int i = 0; i < 8; ++i) g[i] = 0.5f;
#endif
#ifdef EXP_NOACC
        for (int i = 0; i < 8; ++i) v[i] = 1.0f;
#endif
        *(f32x4*)(XO + o) = (f32x4){x0[0] + g[0] * v[0], x0[1] + g[1] * v[1], x0[2] + g[2] * v[2], x0[3] + g[3] * v[3]};
        *(f32x4*)(XO + o + 4) = (f32x4){x1[0] + g[4] * v[4], x1[1] + g[5] * v[5], x1[2] + g[6] * v[6], x1[3] + g[7] * v[7]}; } };

enum { I_X = 0, I_P, I_MIXN, I_WIN, I_MU, I_W0, I_WUP, I_A0, I_AUP, I_GUP, I_KK, I_KA, I_RK, I_LNG, I_LNB, I_LRE, I_LIM, I_LDT, I_BRE, I_BIM, I_CRE, I_CIM, I_SD, I_GLUW, I_GLUB,
       I_WBA, I_WBB, I_WOUT, I_FFNN, I_RGW, I_RGB, I_REW, I_REB, I_EG, I_EU, I_ED, I_PLEN, I_PLEG, I_PLEP, I_FINN };

__device__ __forceinline__ void transpose_item(const float* __restrict__ W, int ldw, const float* __restrict__ kscale, int k0, int n0, bf16_t* WT, int ldt, int dst_row0, int dst_k0, LAS float* scr, int lane) {
#pragma unroll 8
    for (int i = 0; i < 32; ++i) { const int kk = 2 * i + (lane >> 5); float v = W[(size_t)(k0 + kk) * ldw + n0 + (lane & 31)]; if (kscale) v *= kscale[k0 + kk]; scr[kk * 33 + (lane & 31)] = v; }
    LDS_WAIT();
    const int c = lane & 7;
#pragma unroll
    for (int j = 0; j < 4; ++j) { const int n = (lane >> 3) + 8 * j; const LAS float* s = scr + (8 * c) * 33 + n;
        u32x4 o; o.x = pk2(s[0 * 33], s[1 * 33]); o.y = pk2(s[2 * 33], s[3 * 33]); o.z = pk2(s[4 * 33], s[5 * 33]); o.w = pk2(s[6 * 33], s[7 * 33]);
        *(u32x4*)(WT + (size_t)(dst_row0 + n) * ldt + dst_k0 + 8 * c) = o; }
    LDS_WAIT();
}
__device__ __forceinline__ void dsincos_reduced(double x, double& s, double& c) {
    const double x2 = x * x; double ts = 1.0, tc = 1.0;
#pragma unroll 1
    for (int k = 14; k >= 1; --k) { ts = 1.0 - ts * x2 / (double)((2 * k) * (2 * k + 1)); tc = 1.0 - tc * x2 / (double)((2 * k - 1) * (2 * k)); }
    s = x * ts; c = tc;
}
__device__ __forceinline__ double dexp_(double x) {
    const double ln2 = 0.6931471805599453094; const double kf = __builtin_rint(x / ln2); const double r = x - kf * ln2;
    double t = 1.0;
#pragma unroll 1
    for (int k = 18; k >= 1; --k) t = 1.0 + t * r / (double)k;
    const int ki = (int)kf; const long long bits = (long long)(1023 + ki) << 52;
    return t * __builtin_bit_cast(double, bits);
}

__device__ __forceinline__ void phase0(const Args& a, LAS unsigned char* lds) {
    const int tid = threadIdx.x, lane = tid & 63, wave = tid >> 6, G = gridDim.x;
    const int gw = blockIdx.x * 8 + wave, NGW = G * 8;
    unsigned char* ws = a.ws;
    LAS float* scr = (LAS float*)(lds + wave * 16384);
    constexpr int N_WIN = 16 * 128, N_WBA = 8 * 32, N_WBB = 4 * 32, N_WOUT = 16 * 32, N_WPG = 16 * 32, N_WPP = 4 * 32, N_GLU = 4 * 8, N_EG = 32 * 128, N_EU = 32 * 128, N_ED = 32 * 128;
    constexpr int N_ITEMS = N_WIN + N_WBA + N_WBB + N_WOUT + N_WPG + N_WPP + N_GLU + N_EG + N_EU + N_ED;
    for (int it = gw; it < N_ITEMS; it += NGW) {
        int r = it;
        if (r < N_WIN) { transpose_item(a.in[I_WIN], INC, a.in[I_MIXN], 64 * (r / 128), 32 * (r % 128), (bf16_t*)(ws + WS_WIN), 1024, 32 * (r % 128), 64 * (r / 128), scr, lane); continue; } r -= N_WIN;
        if (r < N_WBA) { transpose_item(a.in[I_WBA], 1024, nullptr, 64 * (r / 32), 32 * (r % 32), (bf16_t*)(ws + WS_WBA), 512, 32 * (r % 32), 64 * (r / 32), scr, lane); continue; } r -= N_WBA;
        if (r < N_WBB) { transpose_item(a.in[I_WBB], 1024, nullptr, 64 * (r / 32), 32 * (r % 32), (bf16_t*)(ws + WS_WBB), 256, 32 * (r % 32), 64 * (r / 32), scr, lane); continue; } r -= N_WBB;
        if (r < N_WOUT) { transpose_item(a.in[I_WOUT], 1024, nullptr, 64 * (r / 32), 32 * (r % 32), (bf16_t*)(ws + WS_WOUT), 1024, 32 * (r % 32), 64 * (r / 32), scr, lane); continue; } r -= N_WOUT;
        if (r < N_WPG) { transpose_item(a.in[I_PLEG], 1024, a.in[I_PLEN], 64 * (r / 32), 32 * (r % 32), (bf16_t*)(ws + WS_WPG), 1024, 32 * (r % 32), 64 * (r / 32), scr, lane); continue; } r -= N_WPG;
        if (r < N_WPP) { transpose_item(a.in[I_PLEP], 1024, nullptr, 64 * (r / 32), 32 * (r % 32), (bf16_t*)(ws + WS_WPP), 256, 32 * (r % 32), 64 * (r / 32), scr, lane); continue; } r -= N_WPP;
        if (r < N_GLU) { transpose_item(a.in[I_GLUW], 256, nullptr, 64 * (r / 8), 32 * (r % 8), (bf16_t*)(ws + WS_WGLU), 256, 32 * (r % 8), 64 * (r / 8), scr, lane); continue; } r -= N_GLU;
        if (r < N_EG + N_EU) { const int up = r >= N_EG ? 1 : 0; if (up) r -= N_EG; const int e = r / 128, q = r % 128, k0 = 64 * (q / 8), n0 = 32 * (q % 8);
            transpose_item(a.in[up ? I_EU : I_EG] + (size_t)e * 1024 * 256, 256, a.in[I_FFNN], k0, n0, (bf16_t*)(ws + WS_WGU), 1024, e * 512 + (n0 / 128) * 256 + up * 128 + (n0 % 128), k0, scr, lane); continue; } r -= N_EG + N_EU;
        { const int e = r / 128, q = r % 128, k0 = 64 * (q / 32), n0 = 32 * (q % 32);
            transpose_item(a.in[I_ED] + (size_t)e * 256 * 1024, 1024, nullptr, k0, n0, (bf16_t*)(ws + WS_WD) + (size_t)e * 1024 * 256, 256, n0, k0, scr, lane); }
    }
    {
        const int gt = blockIdx.x * 512 + tid, NT = G * 512;
        bf16_t* WL = (bf16_t*)(ws + WS_WLORA); bf16_t* WR = (bf16_t*)(ws + WS_WR);
        for (int c = gt; c < 1536 * 32 + 48 * 128; c += NT) {
            float v[8];
            if (c < 1536 * 32) { const int n = c >> 5, k0 = (c & 31) * 8;
#pragma unroll
                for (int i = 0; i < 8; ++i) { const int k = k0 + i; float x = 0.f;
                    if (n < 512) { if (k < 64) x = a.in[I_WUP][k * 512 + n]; }
                    else if (n < 1024) { if (k >= 64 && k < 128) x = a.in[I_AUP][(k - 64) * 512 + (n - 512)]; }
                    else { if (k >= 128) x = a.in[I_GUP][(k - 128) * 512 + (n - 1024)]; }
                    v[i] = x; }
                u32x4 o; o.x = pk2(v[0], v[1]); o.y = pk2(v[2], v[3]); o.z = pk2(v[4], v[5]); o.w = pk2(v[6], v[7]); *(u32x4*)(WL + (size_t)n * 256 + k0) = o;
            } else { const int cc = c - 1536 * 32, j = cc >> 7, k0 = (cc & 127) * 8;
#pragma unroll
                for (int i = 0; i < 8; ++i) { const int k = k0 + i; float x = 0.f;
                    if (j < 4) x = a.in[I_RGW][k * 4 + j] * a.in[I_FFNN][k]; else if (j < 36) x = a.in[I_REW][k * 32 + (j - 4)] * a.in[I_FFNN][k];
                    v[i] = x; }
                u32x4 o; o.x = pk2(v[0], v[1]); o.y = pk2(v[2], v[3]); o.z = pk2(v[4], v[5]); o.w = pk2(v[6], v[7]); *(u32x4*)(WR + (size_t)j * 1024 + k0) = o; }
        }
    }
    {
        bf16_t* HN = (bf16_t*)a.out;
        for (int m = gw; m < T; m += NGW) {
            const f32x4* xr = (const f32x4*)(a.in[I_X] + (size_t)m * DM) + lane; f32x4 v[4]; float s = 0.f;
#pragma unroll
            for (int j = 0; j < 4; ++j) { v[j] = xr[64 * j]; s += (v[j][0] * v[j][0] + v[j][1] * v[j][1]) + (v[j][2] * v[j][2] + v[j][3] * v[j][3]); }
            const float rs = 1.0f / sqrtf(wave_sum(s) * (1.0f / DM) + 1e-6f);
            u32x2* o = (u32x2*)(HN + (size_t)m * DM) + lane;
#pragma unroll
            for (int j = 0; j < 4; ++j) { u32x2 w; w.x = pk2(v[j][0] * rs, v[j][1] * rs); w.y = pk2(v[j][2] * rs, v[j][3] * rs); o[64 * j] = w; }
        }
    }
    const int sg = (int)blockIdx.x - (G - 16);
    if (sg >= 0 && sg < 16) {
        __syncthreads();
        const int g = sg;
        LAS float* Pre = (LAS float*)lds;
        LAS float* Pim = Pre + 33 * 64;
        LAS float* Bre = Pim + 33 * 64;
        LAS float* Bim = Bre + 64 * 16;
        LAS float* Cre = Bim + 64 * 16;
        LAS float* Cim = Cre + 16 * 64;
        if (tid < 64) {
            const int n = tid; const double lr = (double)a.in[I_LRE][g * 64 + n], li = (double)a.in[I_LIM][g * 64 + n];
            const double dt = dexp_((double)a.in[I_LDT][g]);
            const double mag = dexp_(lr * dt); double ang = li * dt; const double twopi = 6.283185307179586477; ang -= __builtin_rint(ang / twopi) * twopi;
            double sn, cs; dsincos_reduced(ang, sn, cs);
            const double lre = mag * cs, lim = mag * sn;
            const double nr = lre - 1.0, ni = lim, den = lr * lr + li * li;
            const double cfr = (nr * lr + ni * li) / den, cfi = (ni * lr - nr * li) / den;
            for (int c = 0; c < 16; ++c) { const double br = (double)a.in[I_BRE][(g * 64 + n) * 16 + c], bi = (double)a.in[I_BIM][(g * 64 + n) * 16 + c];
                Bre[n * 16 + c] = (float)(cfr * br - cfi * bi); Bim[n * 16 + c] = (float)(cfr * bi + cfi * br); }
            double pr = 1.0, pi = 0.0;
            for (int tau = 0; tau <= 32; ++tau) { Pre[tau * 64 + n] = (float)pr; Pim[tau * 64 + n] = (float)pi; const double t2 = pr * lre - pi * lim; pi = pr * lim + pi * lre; pr = t2; }
            ((f32x2*)(ws + WS_LAML))[g * 64 + n] = (f32x2){Pre[32 * 64 + n], Pim[32 * 64 + n]};
        }
        for (int i = tid; i < 1024; i += 512) { Cre[i] = a.in[I_CRE][g * 1024 + i]; Cim[i] = a.in[I_CIM][g * 1024 + i]; }
        __syncthreads();
        float* KG = (float*)(ws + WS_KG) + (size_t)g * 32 * 256;
        for (int e = tid; e < 32 * 256; e += 512) { const int tau = e >> 8, co = (e >> 4) & 15, ci = e & 15; float s = 0.f;
            for (int n = 0; n < 64; ++n) { const float pr = Pre[tau * 64 + n], pi = Pim[tau * 64 + n], br = Bre[n * 16 + ci], bi = Bim[n * 16 + ci];
                const float qr = pr * br - pi * bi, qi = pr * bi + pi * br; s += Cre[co * 64 + n] * qr - Cim[co * 64 + n] * qi; }
            KG[e] = s; }
        bf16_t* TZ = (bf16_t*)(ws + WS_TZ) + (size_t)g * S5N * S5K;
        for (int e = tid; e < 512 * 16; e += 512) { const int row = e >> 4, m0 = (e & 15) * 8, j = row >> 4, co = row & 15; float v[8];
#pragma unroll
            for (int i = 0; i < 8; ++i) { const int m = m0 + i, n = m & 63; const float pr = Pre[(j + 1) * 64 + n], pi = Pim[(j + 1) * 64 + n], cr = Cre[co * 64 + n], ci = Cim[co * 64 + n];
                v[i] = (m < 64) ? (cr * pr - ci * pi) : -(cr * pi + ci * pr); }
            u32x4 o; o.x = pk2(v[0], v[1]); o.y = pk2(v[2], v[3]); o.z = pk2(v[4], v[5]); o.w = pk2(v[6], v[7]); *(u32x4*)(TZ + (size_t)row * S5K + 512 + m0) = o; }
        bf16_t* W1 = (bf16_t*)(ws + WS_W1) + (size_t)g * 256 * 512;
        for (int e = tid; e < 256 * 64; e += 512) { const int m = e >> 6, s = (e & 63) >> 1, ci0 = (e & 1) * 8; float v[8];
#pragma unroll
            for (int i = 0; i < 8; ++i) { float x = 0.f;
                if (m < 128) { const int n = m & 63; const float pr = Pre[(31 - s) * 64 + n], pi = Pim[(31 - s) * 64 + n], br = Bre[n * 16 + ci0 + i], bi = Bim[n * 16 + ci0 + i];
                    x = (m < 64) ? (pr * br - pi * bi) : (pr * bi + pi * br); }
                v[i] = x; }
            u32x4 o; o.x = pk2(v[0], v[1]); o.y = pk2(v[2], v[3]); o.z = pk2(v[4], v[5]); o.w = pk2(v[6], v[7]); *(u32x4*)(W1 + (size_t)m * 512 + s * 16 + ci0) = o; }
        __syncthreads();
    }
}

__device__ __forceinline__ void phase2(const Args& a) {
    const int gt = blockIdx.x * 512 + threadIdx.x, NT = gridDim.x * 512;
    unsigned char* ws = a.ws;
    const bf16_t* COLS = (const bf16_t*)(ws + WS_A); bf16_t* LIN = (bf16_t*)(ws + WS_Z); bf16_t* UG = (bf16_t*)(ws + WS_UG);
    const float* mu = a.in[I_MU];
    for (int p = gt; p < T * 64; p += NT) {
        const int t = p >> 6, q = p & 63;
        if (q < 32) {
            const int c8 = q * 8, src = C_WD + c8; float cur[8], prv[8], o[8];
            unpack8(*(const u32x4*)(COLS + (size_t)t * INC + src), cur);
            if ((t & (SEQ - 1)) != 0) unpack8(*(const u32x4*)(COLS + (size_t)(t - 1) * INC + src), prv);
            else {
#pragma unroll
                for (int i = 0; i < 8; ++i) prv[i] = 0.f; }
#pragma unroll
            for (int i = 0; i < 8; ++i) { const float xs = cur[i] + (prv[i] - cur[i]) * mu[src + i]; o[i] = (c8 < 64) ? tanhf_(xs) : ((c8 < 128) ? xs : sigmoidf_(xs)); }
            *(u32x4*)(LIN + (size_t)t * 256 + c8) = pack8(o);
        } else {
            const int qq = q - 32, g = qq >> 1, c0 = (qq & 1) * 8; const int b = t >> 11, s = t & (SEQ - 1), ch = s >> 5, j = s & 31;
            *(u32x4*)(UG + ((size_t)g * S5ROWS + b * S5NCH + ch) * S5K + j * 16 + c0) = *(const u32x4*)(COLS + (size_t)t * INC + C_U + g * 16 + c0);
        }
    }
    const float* KG = (const float*)(ws + WS_KG); bf16_t* TZ = (bf16_t*)(ws + WS_TZ);
    for (int p = gt; p < 16 * 512 * 64; p += NT) {
        const int g = p >> 15, row = (p >> 6) & 511, kc = p & 63, j = row >> 4, co = row & 15, s = kc >> 1, ci0 = (kc & 1) * 8;
        u32x4 o = (u32x4){0u, 0u, 0u, 0u};
        if (s <= j) { const float* k = KG + (((size_t)g * 32 + (j - s)) * 16 + co) * 16 + ci0; const f32x4 k0 = *(const f32x4*)k, k1 = *(const f32x4*)(k + 4);
            o.x = pk2(k0[0], k0[1]); o.y = pk2(k0[2], k0[3]); o.z = pk2(k1[0], k1[1]); o.w = pk2(k1[2], k1[3]); }
        *(u32x4*)(TZ + ((size_t)g * S5N + row) * S5K + kc * 8) = o;
    }
}

__device__ __forceinline__ void phase4(const Args& a, LAS unsigned char* lds) {
    const int tid = threadIdx.x, lane = tid & 63, wave = tid >> 6;
    unsigned char* ws = a.ws;
    for (int item = blockIdx.x; item < 256; item += gridDim.x) {
        if (tid < 64) {
            const int b = item >> 4, g = item & 15, n = tid;
            const f32x2 lamL = ((const f32x2*)(ws + WS_LAML))[g * 64 + n];
            const float* E = (const float*)(ws + WS_E) + ((size_t)g * S5ROWS + b * S5NCH) * 128;
            bf16_t* UG = (bf16_t*)(ws + WS_UG) + ((size_t)g * S5ROWS + b * S5NCH) * S5K + 512;
            float xr = 0.f, xi = 0.f;
#pragma unroll 8
            for (int ch = 0; ch < S5NCH; ++ch) {
                UG[(size_t)ch * S5K + n] = (bf16_t)f2bf(xr); UG[(size_t)ch * S5K + 64 + n] = (bf16_t)f2bf(xi);
                const float er = E[ch * 128 + n], ei = E[ch * 128 + 64 + n];
                const float nr = lamL[0] * xr - lamL[1] * xi + er, ni = lamL[0] * xi + lamL[1] * xr + ei; xr = nr; xi = ni;
            }
        }
    }
    const bf16_t* COLS = (const bf16_t*)(ws + WS_A); const bf16_t* LORA = (const bf16_t*)a.out;
    float* Y = (float*)(ws + WS_B); float* BON = (float*)(ws + WS_BON);
    LAS float* Wb = (LAS float*)lds;
    LAS float* Ab = Wb + 2048; LAS float* Bb = Ab + 2048; LAS float* Kb = Bb + 2048; LAS float* Rb = Kb + 2048; LAS float* Vb = Rb + 2048;
    LAS float* Yb = Vb + 2048;
    for (int item = blockIdx.x; item < 256; item += gridDim.x) {
        const int bh = item >> 1, half = item & 1, b = bh >> 3, h = bh & 7;
        const int pj = tid >> 4, pq = tid & 15, hc = h * 64 + 4 * pq;
        float mur[4], muk[4], muv[4], kk4[4], ka4[4], rk4[4];
#pragma unroll
        for (int i = 0; i < 4; ++i) { mur[i] = a.in[I_MU][C_R + hc + i]; muk[i] = a.in[I_MU][C_K + hc + i]; muv[i] = a.in[I_MU][C_V + hc + i];
            kk4[i] = a.in[I_KK][hc + i]; ka4[i] = a.in[I_KA][hc + i]; rk4[i] = a.in[I_RK][hc + i]; }
        const int rr = lane >> 4, cl = lane & 15, row = 4 * wave + rr;
        float S0 = 0.f, S1 = 0.f, S2 = 0.f, S3 = 0.f;
        u32x2 rc, rp, kc, kp, vc, vp, e4, a4;
        const u32x2 zero2 = (u32x2){0u, 0u};
        __syncthreads();
#define WKV_LOAD(chunk) do { const int s_ = (chunk) * 32 + pj; const size_t t_ = (size_t)b * SEQ + s_; const bf16_t* cb_ = COLS + t_ * INC + hc; \
            rc = *(const u32x2*)(cb_ + C_R); kc = *(const u32x2*)(cb_ + C_K); vc = *(const u32x2*)(cb_ + C_V); \
            if (s_ > 0) { rp = *(const u32x2*)(cb_ - INC + C_R); kp = *(const u32x2*)(cb_ - INC + C_K); vp = *(const u32x2*)(cb_ - INC + C_V); } else { rp = zero2; kp = zero2; vp = zero2; } \
            e4 = *(const u32x2*)(LORA + t_ * 1536 + hc); a4 = *(const u32x2*)(LORA + t_ * 1536 + 512 + hc); } while (0)
#define WKV_PREP(chunk) do { float r_[4], rq_[4], k_[4], kq_[4], v_[4], vq_[4], e_[4], aa_[4]; unpack4(rc, r_); unpack4(rp, rq_); unpack4(kc, k_); unpack4(kp, kq_); unpack4(vc, v_); unpack4(vp, vq_); unpack4(e4, e_); unpack4(a4, aa_); \
            float kkv_[4], k2_[4], ss_ = 0.f, bon_ = 0.f; \
            _Pragma("unroll") for (int i = 0; i < 4; ++i) { r_[i] += (rq_[i] - r_[i]) * mur[i]; k_[i] += (kq_[i] - k_[i]) * muk[i]; v_[i] += (vq_[i] - v_[i]) * muv[i]; \
                kkv_[i] = k_[i] * kk4[i]; ss_ += kkv_[i] * kkv_[i]; k2_[i] = k_[i] * (1.0f + (aa_[i] - 1.0f) * ka4[i]); bon_ += r_[i] * k2_[i] * rk4[i]; } \
            ss_ = row16_sum(ss_); bon_ = row16_sum(bon_); const float inv_ = 1.0f / fmaxf(sqrtf(ss_), 1e-12f); \
            if (pq == 0 && half == 0) BON[((size_t)b * SEQ + (chunk) * 32 + pj) * 8 + h] = bon_; \
            const int o_ = pj * 64 + 4 * pq; \
            *(LAS f32x4*)(Wb + o_) = (f32x4){__expf(-e_[0]), __expf(-e_[1]), __expf(-e_[2]), __expf(-e_[3])}; \
            *(LAS f32x4*)(Ab + o_) = (f32x4){-kkv_[0] * inv_, -kkv_[1] * inv_, -kkv_[2] * inv_, -kkv_[3] * inv_}; \
            *(LAS f32x4*)(Bb + o_) = (f32x4){kkv_[0] * inv_ * aa_[0], kkv_[1] * inv_ * aa_[1], kkv_[2] * inv_ * aa_[2], kkv_[3] * inv_ * aa_[3]}; \
            *(LAS f32x4*)(Kb + o_) = (f32x4){k2_[0], k2_[1], k2_[2], k2_[3]}; \
            *(LAS f32x4*)(Rb + o_) = (f32x4){r_[0], r_[1], r_[2], r_[3]}; \
            *(LAS f32x4*)(Vb + o_) = (f32x4){v_[0], v_[1], v_[2], v_[3]}; } while (0)
        WKV_LOAD(0); WKV_PREP(0);
        __syncthreads();
        for (int chunk = 0; chunk < SEQ / 32; ++chunk) {
            if (chunk + 1 < SEQ / 32) WKV_LOAD(chunk + 1);
#pragma unroll 4
            for (int j = 0; j < 32; ++j) {
                const f32x4 w4 = *(const LAS f32x4*)(Wb + j * 64 + 4 * cl), aa = *(const LAS f32x4*)(Ab + j * 64 + 4 * cl), bb = *(const LAS f32x4*)(Bb + j * 64 + 4 * cl);
                const f32x4 k4 = *(const LAS f32x4*)(Kb + j * 64 + 4 * cl), r4 = *(const LAS f32x4*)(Rb + j * 64 + 4 * cl);
                const float vv = Vb[j * 64 + 32 * half + row];
                float sa = (S0 * aa[0] + S1 * aa[1]) + (S2 * aa[2] + S3 * aa[3]);
                sa = row16_sum(sa);
                S0 = fmaf(sa, bb[0], fmaf(vv, k4[0], S0 * w4[0])); S1 = fmaf(sa, bb[1], fmaf(vv, k4[1], S1 * w4[1]));
                S2 = fmaf(sa, bb[2], fmaf(vv, k4[2], S2 * w4[2])); S3 = fmaf(sa, bb[3], fmaf(vv, k4[3], S3 * w4[3]));
                float y = (S0 * r4[0] + S1 * r4[1]) + (S2 * r4[2] + S3 * r4[3]);
                y = row16_sum(y);
                if (cl == 0) Yb[j * 32 + row] = y;
            }
            __syncthreads();
            { const f32x2 yv = *(const LAS f32x2*)(Yb + pj * 32 + 2 * pq); *(f32x2*)(Y + ((size_t)b * SEQ + chunk * 32 + pj) * 512 + h * 64 + 32 * half + 2 * pq) = yv; }
            if (chunk + 1 < SEQ / 32) WKV_PREP(chunk + 1);
            __syncthreads();
        }
#undef WKV_LOAD
#undef WKV_PREP
    }
}

__device__ __forceinline__ void phase5_post(const Args& a) {
    const int gt = blockIdx.x * 512 + threadIdx.x, NT = gridDim.x * 512;
    unsigned char* ws = a.ws;
    const bf16_t* COLS = (const bf16_t*)(ws + WS_A); const bf16_t* LORA = (const bf16_t*)a.out; const float* Y = (const float*)(ws + WS_B); const float* BON = (const float*)(ws + WS_BON);
    bf16_t* RO = (bf16_t*)(ws + WS_RWKV);
    const int hq = gt & 127, h = hq >> 4, q = hq & 15, hc = h * 64 + 4 * q;
    float lg[4], lb[4], muv[4];
#pragma unroll
    for (int i = 0; i < 4; ++i) { lg[i] = a.in[I_LNG][hc + i]; lb[i] = a.in[I_LNB][hc + i]; muv[i] = a.in[I_MU][C_V + hc + i]; }
    for (int p = gt; p < T * 128; p += NT) {
        const int t = p >> 7;
        const f32x4 y4 = *(const f32x4*)(Y + (size_t)t * 512 + hc);
        float s = (y4[0] + y4[1]) + (y4[2] + y4[3]); s = row16_sum(s); const float mean = s * (1.0f / 64.0f);
        const float d0 = y4[0] - mean, d1 = y4[1] - mean, d2 = y4[2] - mean, d3 = y4[3] - mean;
        float qv = (d0 * d0 + d1 * d1) + (d2 * d2 + d3 * d3); qv = row16_sum(qv); const float rstd = 1.0f / sqrtf(qv * (1.0f / 64.0f) + 64e-5f);
        float vc[4], vp[4], g4[4]; unpack4(*(const u32x2*)(COLS + (size_t)t * INC + C_V + hc), vc);
        if ((t & (SEQ - 1)) != 0) unpack4(*(const u32x2*)(COLS + (size_t)(t - 1) * INC + C_V + hc), vp); else { vp[0] = vp[1] = vp[2] = vp[3] = 0.f; }
        unpack4(*(const u32x2*)(LORA + (size_t)t * 1536 + 1024 + hc), g4);
        const float bon = BON[(size_t)t * 8 + h];
        const float dd[4] = {d0, d1, d2, d3}; float o[4];
#pragma unroll
        for (int i = 0; i < 4; ++i) { const float v = vc[i] + (vp[i] - vc[i]) * muv[i]; o[i] = (dd[i] * rstd * lg[i] + lb[i] + bon * v) * g4[i]; }
        u32x2 w; w.x = cvt_pk_bf16(o[0], o[1]); w.y = cvt_pk_bf16(o[2], o[3]); *(u32x2*)(RO + (size_t)t * 512 + hc) = w;
    }
}

__device__ __forceinline__ void phase9(const Args& a, LAS unsigned char* lds) {
    const int tid = threadIdx.x, lane = tid & 63, wave = tid >> 6;
    unsigned char* ws = a.ws;
    const float* X1 = a.out; const bf16_t* WR = (const bf16_t*)(ws + WS_WR);
    int4* ROUTE = (int4*)(ws + WS_ROUTE); int* BC = (int*)(ws + WS_BC);
    LAS float* LG = (LAS float*)lds + wave * (16 * 49);
    LAS int* cnt = (LAS int*)(lds + 32768);
    for (int vb = blockIdx.x; vb < 256; vb += gridDim.x) {
        __syncthreads();
        if (tid < 32) cnt[tid] = 0;
        __syncthreads();
        const int t0 = vb * 128 + wave * 16;
        const int ar = lane & 15, aq = lane >> 4;
        f32x4 acc0 = (f32x4){0.f, 0.f, 0.f, 0.f}, acc1 = acc0, acc2 = acc0; float ssq = 0.f;
        const float* xrow = X1 + (size_t)(t0 + ar) * DM + 8 * aq;
        const bf16_t* wrow = WR + (size_t)ar * DM + 8 * aq;
#pragma unroll 4
        for (int kb = 0; kb < 32; ++kb) {
            const f32x4 x0 = *(const f32x4*)(xrow + kb * 32), x1 = *(const f32x4*)(xrow + kb * 32 + 4);
            ssq += (x0[0] * x0[0] + x0[1] * x0[1]) + (x0[2] * x0[2] + x0[3] * x0[3]) + (x1[0] * x1[0] + x1[1] * x1[1]) + (x1[2] * x1[2] + x1[3] * x1[3]);
            u32x4 af; af.x = cvt_pk_bf16(x0[0], x0[1]); af.y = cvt_pk_bf16(x0[2], x0[3]); af.z = cvt_pk_bf16(x1[0], x1[1]); af.w = cvt_pk_bf16(x1[2], x1[3]);
            const bf16x8 A = __builtin_bit_cast(bf16x8, af);
            const bf16x8 B0 = *(const bf16x8*)(wrow + kb * 32), B1 = *(const bf16x8*)(wrow + 16 * DM + kb * 32), B2 = *(const bf16x8*)(wrow + 32 * DM + kb * 32);
            acc0 = __builtin_amdgcn_mfma_f32_16x16x32_bf16(A, B0, acc0, 0, 0, 0);
            acc1 = __builtin_amdgcn_mfma_f32_16x16x32_bf16(A, B1, acc1, 0, 0, 0);
            acc2 = __builtin_amdgcn_mfma_f32_16x16x32_bf16(A, B2, acc2, 0, 0, 0);
        }
        ssq += __shfl_xor(ssq, 16); ssq += __shfl_xor(ssq, 32);
        const float rs = 1.0f / sqrtf(ssq * (1.0f / DM) + 1e-6f);
#pragma unroll
        for (int r = 0; r < 4; ++r) { const int row = aq * 4 + r; LG[row * 49 + ar] = acc0[r]; LG[row * 49 + 16 + ar] = acc1[r]; LG[row * 49 + 32 + ar] = acc2[r]; }
        LDS_WAIT();
        if (lane < 16) {
            const int t = t0 + lane; const LAS float* lg = LG + lane * 49;
            float gl[4]; float mx = -3.0e38f; int gi = 0;
#pragma unroll
            for (int j = 0; j < 4; ++j) { gl[j] = lg[j] * rs + a.in[I_RGB][j]; if (gl[j] > mx) { mx = gl[j]; gi = j; } }
            float den = 0.f;
#pragma unroll
            for (int j = 0; j < 4; ++j) den += __expf(gl[j] - mx);
            const float gp = 1.0f / den;
            float b1 = -3.0e38f, b2 = -3.0e38f; int i1 = 0, i2 = 0;
            for (int j = 0; j < 8; ++j) { const float v = lg[4 + gi * 8 + j] * rs + a.in[I_REB][gi * 8 + j];
                if (v > b1) { b2 = b1; i2 = i1; b1 = v; i1 = j; } else if (v > b2) { b2 = v; i2 = j; } }
            const float e2 = __expf(b2 - b1), w1 = gp / (1.0f + e2), w2 = gp * e2 / (1.0f + e2);
            const int e0 = gi * 8 + i1, e1 = gi * 8 + i2;
            const int s0 = atomicAdd((int*)&cnt[e0], 1), s1 = atomicAdd((int*)&cnt[e1], 1);
            int4 rt; rt.x = e0 | (e1 << 8); rt.y = s0 | (s1 << 16); rt.z = __builtin_bit_cast(int, w1); rt.w = __builtin_bit_cast(int, w2);
            ROUTE[t] = rt;
        }
        __syncthreads();
        if (tid < 32) BC[vb * 32 + tid] = cnt[tid];
    }
}

__device__ __forceinline__ void phase10(const Args& a, LAS unsigned char* lds) {
    const int tid = threadIdx.x, lane = tid & 63, wave = tid >> 6;
    unsigned char* ws = a.ws;
    const float* X1 = a.out; const int4* ROUTE = (const int4*)(ws + WS_ROUTE); const int* BC = (const int*)(ws + WS_BC);
    bf16_t* HS = (bf16_t*)(ws + WS_A); float* ROWW = (float*)(ws + WS_ROWW); int2* POS = (int2*)(ws + WS_POS); int* OFF = (int*)(ws + WS_OFF);
    LAS int* ptot = (LAS int*)lds;
    LAS int* pmine = ptot + 512;
    LAS int* base = pmine + 512;
    for (int vb = blockIdx.x; vb < 256; vb += gridDim.x) {
        __syncthreads();
        { const int e = tid & 31, part = tid >> 5; int st = 0, sm = 0;
            for (int k = 0; k < 16; ++k) { const int r = part * 16 + k; const int c = BC[r * 32 + e]; st += c; sm += (r < vb) ? c : 0; }
            ptot[part * 32 + e] = st; pmine[part * 32 + e] = sm; }
        __syncthreads();
        if (tid < 32) { int st = 0, sm = 0; for (int k = 0; k < 16; ++k) { st += ptot[k * 32 + tid]; sm += pmine[k * 32 + tid]; } ptot[tid] = (st + 255) & ~255; pmine[tid] = sm; }
        __syncthreads();
        if (tid < 32) { int off = 0; for (int k = 0; k < tid; ++k) off += ptot[k]; base[tid] = off + pmine[tid];
            if (vb == 0) { OFF[tid] = off; if (tid == 31) OFF[32] = off + ptot[31]; } }
        __syncthreads();
        for (int i = 0; i < 16; ++i) {
            const int t = vb * 128 + wave * 16 + i; const int4 rt = ROUTE[t];
            const int e0 = rt.x & 255, e1 = (rt.x >> 8) & 255, p0 = base[e0] + (rt.y & 0xffff), p1 = base[e1] + ((rt.y >> 16) & 0xffff);
            const f32x4* xr = (const f32x4*)(X1 + (size_t)t * DM) + lane; f32x4 v[4]; float s = 0.f;
#pragma unroll
            for (int j = 0; j < 4; ++j) { v[j] = xr[64 * j]; s += (v[j][0] * v[j][0] + v[j][1] * v[j][1]) + (v[j][2] * v[j][2] + v[j][3] * v[j][3]); }
            const float rs = 1.0f / sqrtf(wave_sum(s) * (1.0f / DM) + 1e-6f);
            u32x2* o0 = (u32x2*)(HS + (size_t)p0 * DM) + lane; u32x2* o1 = (u32x2*)(HS + (size_t)p1 * DM) + lane;
#pragma unroll
            for (int j = 0; j < 4; ++j) { u32x2 w; w.x = pk2(v[j][0] * rs, v[j][1] * rs); w.y = pk2(v[j][2] * rs, v[j][3] * rs); o0[64 * j] = w; o1[64 * j] = w; }
            if (lane == 0) { ROWW[p0] = __builtin_bit_cast(float, rt.z); ROWW[p1] = __builtin_bit_cast(float, rt.w); POS[t] = make_int2(p0, p1); }
        }
    }
}

__device__ __forceinline__ void phase13(const Args& a) {
    const int tid = threadIdx.x, lane = tid & 63, wave = tid >> 6;
    const int gw = blockIdx.x * 8 + wave, NGW = gridDim.x * 8;
    unsigned char* ws = a.ws;
    float* X = a.out; const bf16_t* YM = (const bf16_t*)(ws + WS_A); const int2* POS = (const int2*)(ws + WS_POS); bf16_t* HP = (bf16_t*)(ws + WS_HP); bf16_t* P16 = (bf16_t*)(ws + WS_P16);
    for (int t = gw; t < T; t += NGW) {
        const int2 ps = POS[t];
        f32x4* xr = (f32x4*)(X + (size_t)t * DM) + lane; const u32x2* y0 = (const u32x2*)(YM + (size_t)ps.x * DM) + lane; const u32x2* y1 = (const u32x2*)(YM + (size_t)ps.y * DM) + lane;
        f32x4 v[4]; float s = 0.f;
#pragma unroll
        for (int j = 0; j < 4; ++j) { v[j] = xr[64 * j]; float a0[4], a1[4]; unpack4(y0[64 * j], a0); unpack4(y1[64 * j], a1);
            v[j][0] = (v[j][0] + a0[0]) + a1[0]; v[j][1] = (v[j][1] + a0[1]) + a1[1]; v[j][2] = (v[j][2] + a0[2]) + a1[2]; v[j][3] = (v[j][3] + a0[3]) + a1[3];
            s += (v[j][0] * v[j][0] + v[j][1] * v[j][1]) + (v[j][2] * v[j][2] + v[j][3] * v[j][3]); xr[64 * j] = v[j]; }
        const float rs = 1.0f / sqrtf(wave_sum(s) * (1.0f / DM) + 1e-6f);
        u32x2* o = (u32x2*)(HP + (size_t)t * DM) + lane;
#pragma unroll
        for (int j = 0; j < 4; ++j) { u32x2 w; w.x = pk2(v[j][0] * rs, v[j][1] * rs); w.y = pk2(v[j][2] * rs, v[j][3] * rs); o[64 * j] = w; }
        const f32x4 pv = *((const f32x4*)(a.in[I_P] + (size_t)t * 256) + lane);
        u32x2 w; w.x = pk2(pv[0], pv[1]); w.y = pk2(pv[2], pv[3]); *((u32x2*)(P16 + (size_t)t * 256) + lane) = w;
    }
}
__device__ __forceinline__ void phase15(const Args& a, const float* XS) {
    const int tid = threadIdx.x, lane = tid & 63, wave = tid >> 6;
    const int gw = blockIdx.x * 8 + wave, NGW = gridDim.x * 8;
    float* X = a.out; const f32x4* gn = (const f32x4*)a.in[I_FINN] + lane;
    f32x4 g[4];
#pragma unroll
    for (int j = 0; j < 4; ++j) g[j] = gn[64 * j];
    for (int t = gw; t < T; t += NGW) {
        f32x4* xr = (f32x4*)(X + (size_t)t * DM) + lane; const f32x4* xs = (const f32x4*)(XS + (size_t)t * DM) + lane; f32x4 v[4]; float s = 0.f;
#pragma unroll
        for (int j = 0; j < 4; ++j) { v[j] = xs[64 * j]; s += (v[j][0] * v[j][0] + v[j][1] * v[j][1]) + (v[j][2] * v[j][2] + v[j][3] * v[j][3]); }
        const float rs = 1.0f / sqrtf(wave_sum(s) * (1.0f / DM) + 1e-6f);
#pragma unroll
        for (int j = 0; j < 4; ++j) xr[64 * j] = (f32x4){v[j][0] * rs * g[j][0], v[j][1] * rs * g[j][1], v[j][2] * rs * g[j][2], v[j][3] * rs * g[j][3]};
    }
}


#ifdef PROBE
__device__ __forceinline__ void phase_probe(const Args& a) {
    const int gt = blockIdx.x * 512 + threadIdx.x, NT = gridDim.x * 512;
#if PROBE == 1
    const bf16_t* src = (const bf16_t*)(a.ws + WS_HP); const size_t n = (size_t)T * DM;
#elif PROBE == 2
    const bf16_t* src = (const bf16_t*)(a.ws + WS_WPG); const size_t n = (size_t)1024 * 1024;
#else
    const bf16_t* src = (const bf16_t*)(a.ws + WS_G); const size_t n = (size_t)T * DM;
#endif
    for (size_t i = gt; i < (size_t)T * DM; i += NT) a.out[i] = (i < n) ? __builtin_bit_cast(float, (unsigned)src[i] << 16) : 0.f;
}
#endif
__global__ void __launch_bounds__(512) mega_fwd(Args a) {
    extern __shared__ __attribute__((aligned(16))) unsigned char lds_raw[];
    LAS unsigned char* lds = (LAS unsigned char*)lds_raw;
    unsigned char* ws = a.ws;
    const int G = gridDim.x, c = blockIdx.x;
    const int lo = a.ph_lo, hi = a.ph_hi;
#ifndef PHMASK
#define PHMASK 0xFFFFF
#endif
#define IN(k) ((((PHMASK) >> (k)) & 1) && lo <= (k) && (k) < hi)
#define SEAM_MASK 0x5FEB7u
#define SEAM(k) do { if (IN(k) && IN((k) + 1)) { if ((SEAM_MASK >> (k)) & 1u) cg::this_grid().sync(); else __syncthreads(); } } while (0)
    bf16_t* COLS = (bf16_t*)(ws + WS_A);
    if (IN(0)) { phase0(a, lds); }
    SEAM(0);
    if (IN(1)) {
        pg8::DenseSched S; S.init(a.out, 1024, ws + WS_WIN, 1024, T, INC, G, c);
        pg8::EpiRow8<F_Cols> E{{COLS, INC}};
        pg8::gemm_phase<pg8::EpiRow8<F_Cols>, pg8::DenseSched, true>(lds, 1024, 1024, 1024, S, E);
    }
    SEAM(1);
    if (IN(2)) { phase2(a); }
    SEAM(2);
    if (IN(3)) {
        pg8::DenseSched S; S.init(ws + WS_Z, 256, ws + WS_WLORA, 256, T, 1536, G, c);
        pg8::EpiRow8<F_Lora> E{{(bf16_t*)a.out, a.in[I_W0], a.in[I_A0]}};
        pg8::gemm_phase<pg8::EpiRow8<F_Lora>, pg8::DenseSched, true>(lds, 256, 256, 256, S, E);
    }
    SEAM(3);
    if (IN(4)) {
        pg8::GroupSched S{(const char*)(ws + WS_UG), (const char*)(ws + WS_W1), S5K, 512, 4, 1, 16, G, c, (size_t)S5ROWS * S5K * 2, (size_t)256 * 512 * 2};
        pg8::EpiRow8<F_S5a> E{{(float*)(ws + WS_E)}};
        pg8::gemm_phase<pg8::EpiRow8<F_S5a>, pg8::GroupSched, true>(lds, 512, S5K, 512, S, E);
    }
    SEAM(4);
    if (IN(5)) { phase4(a, lds); }
    SEAM(5);
    if (IN(6)) { phase5_post(a); }
    SEAM(6);
    if (IN(7)) {
        pg8::GroupSched S{(const char*)(ws + WS_UG), (const char*)(ws + WS_TZ), S5K, S5K, 4, 2, 16, G, c, (size_t)S5ROWS * S5K * 2, (size_t)S5N * S5K * 2};
        pg8::EpiRow8<F_S5c> E{{COLS, a.in[I_SD], (bf16_t*)(ws + WS_Z)}};
        pg8::gemm_phase<pg8::EpiRow8<F_S5c>, pg8::GroupSched, true>(lds, S5K, S5K, S5K, S, E);
    }
    SEAM(7);
    if (IN(8)) {
        pg8::DenseSched S; S.init(ws + WS_Z, 256, ws + WS_WGLU, 256, T, 256, G, c);
        pg8::EpiRow8<F_Glu> E{{(const bf16_t*)(ws + WS_Z), a.in[I_GLUB], (bf16_t*)(ws + WS_S5O)}};
        pg8::gemm_phase<pg8::EpiRow8<F_Glu>, pg8::DenseSched, true>(lds, 256, 256, 256, S, E);
    }
    SEAM(8);
    if (IN(9)) {
        pg8::DenseSched S; S.init(ws + WS_RWKV, 512, ws + WS_WBA, 512, T, DM, G, c);
        pg8::EpiRow8<F_BrA> E{{COLS, a.out}};
        pg8::gemm_phase<pg8::EpiRow8<F_BrA>, pg8::DenseSched, true>(lds, 512, 512, 512, S, E);
    }
    SEAM(9);
    if (IN(10)) {
        pg8::DenseSched S; S.init(ws + WS_S5O, 256, ws + WS_WBB, 256, T, DM, G, c);
        pg8::EpiRow8<F_BrB> E{{COLS, a.out, (bf16_t*)(ws + WS_B)}};
        pg8::gemm_phase<pg8::EpiRow8<F_BrB>, pg8::DenseSched, true>(lds, 256, 256, 256, S, E);
    }
    SEAM(10);
    if (IN(11)) {
        pg8::DenseSched S; S.init(ws + WS_B, 1024, ws + WS_WOUT, 1024, T, DM, G, c);
        pg8::EpiRow8<F_Res> E{{a.in[I_X], a.out}};
        pg8::gemm_phase<pg8::EpiRow8<F_Res>, pg8::DenseSched, true>(lds, 1024, 1024, 1024, S, E);
    }
    SEAM(11);
    if (IN(12)) { phase9(a, lds); }
    SEAM(12);
    if (IN(13)) { phase10(a, lds); }
    SEAM(13);
    if (IN(14)) {
        pg8::MoeSched S{(const int*)(ws + WS_OFF), (const char*)(ws + WS_A), (const char*)(ws + WS_WGU), 1024, 1024, 2, G, c, (size_t)512 * 1024 * 2};
        pg8::EpiMoeUp E{(bf16_t*)(ws + WS_HID)};
        pg8::gemm_phase<pg8::EpiMoeUp, pg8::MoeSched, true>(lds, 1024, 1024, 1024, S, E);
    }
    SEAM(14);
    if (IN(15)) {
        pg8::MoeSched S{(const int*)(ws + WS_OFF), (const char*)(ws + WS_HID), (const char*)(ws + WS_WD), 256, 256, 4, G, c, (size_t)1024 * 256 * 2};
        pg8::EpiRow8<F_MoeDown> E{{(const float*)(ws + WS_ROWW), (bf16_t*)(ws + WS_A)}};
        pg8::gemm_phase<pg8::EpiRow8<F_MoeDown>, pg8::MoeSched, true>(lds, 256, 256, 256, S, E);
    }
    SEAM(15);
    if (IN(16)) { phase13(a); }
    SEAM(16);
    if (IN(17)) {
        pg8::DenseSched S; S.init(ws + WS_HP, 1024, ws + WS_WPG, 1024, T, DM, G, c);
        pg8::EpiRow8<F_PleG> E{{(bf16_t*)(ws + WS_G)}};
        pg8::gemm_phase<pg8::EpiRow8<F_PleG>, pg8::DenseSched, true>(lds, 1024, 1024, 1024, S, E);
    }
    SEAM(17);
    if (IN(18)) {
        pg8::DenseSched S; S.init(ws + WS_P16, 256, ws + WS_WPP, 256, T, DM, G, c);
        pg8::EpiRow8<F_PleP> E{{(const bf16_t*)(ws + WS_G), a.out, (float*)(ws + WS_A)}};
        pg8::gemm_phase<pg8::EpiRow8<F_PleP>, pg8::DenseSched, true>(lds, 256, 256, 256, S, E);
    }
    SEAM(18);
#ifdef PROBE
    if (IN(19)) { phase_probe(a); }
#else
    if (IN(19)) { phase15(a, ((PHMASK >> 18) & 1) ? (const float*)(ws + WS_A) : (const float*)a.out); }
#endif
#undef IN
#undef SEAM
}

extern "C" void kernel_launch(void* const* d_in, const int* in_sizes, int n_in, void* d_out, int out_size, void* d_ws, size_t ws_size, hipStream_t stream) {
    static int grid = 0;
    if (grid == 0) {
        if (n_in != 40 || out_size != T * DM || ws_size < WS_END) { fprintf(stderr, "kernel_launch: unexpected problem (n_in %d, out %d, ws %zu < %zu); nothing launched\n", n_in, out_size, ws_size, (size_t)WS_END); grid = -1; return; }
        int dev = 0, cus = 0, per_cu = 0;
        hipGetDevice(&dev); hipDeviceGetAttribute(&cus, hipDeviceAttributeMultiprocessorCount, dev);
        if (hipFuncSetAttribute((const void*)mega_fwd, hipFuncAttributeMaxDynamicSharedMemorySize, LDS_BYTES) != hipSuccess) { fprintf(stderr, "kernel_launch: hipFuncSetAttribute failed\n"); grid = -1; return; }
        if (hipOccupancyMaxActiveBlocksPerMultiprocessor(&per_cu, (const void*)mega_fwd, 512, LDS_BYTES) != hipSuccess || per_cu < 1) { fprintf(stderr, "kernel_launch: occupancy query says %d\n", per_cu); per_cu = 1; }
        (void)hipGetLastError();
        grid = cus * 1;
        if (grid > 256) grid = 256;
    }
    if (grid < 0) return;
    Args a{};
    for (int i = 0; i < 40; ++i) a.in[i] = (const float*)d_in[i];
    a.out = (float*)d_out; a.ws = (unsigned char*)d_ws;
#if MK_N_LAUNCHES == 1
    a.ph_lo = 0; a.ph_hi = NPHASE;
    void* kargs[] = {&a};
    hipError_t e = hipLaunchCooperativeKernel((const void*)mega_fwd, dim3(grid), dim3(512), kargs, LDS_BYTES, stream);
    if (e != hipSuccess) fprintf(stderr, "kernel_launch: cooperative launch failed: %s\n", hipGetErrorString(e));
#else
    for (int k = 0; k < NPHASE; ++k) {
        a.ph_lo = k; a.ph_hi = k + 1;
        hipLaunchKernelGGL(mega_fwd, dim3(grid), dim3(512), LDS_BYTES, stream, a);
    }
#endif
}
```

```cpp
#include <hip/hip_runtime.h>
#include <hip/hip_cooperative_groups.h>
#include <cstdio>
#include <cstdint>
namespace cg = cooperative_groups;

#ifndef WKV_CHUNKED
#define WKV_CHUNKED 2
#endif
#ifndef MK_N_LAUNCHES
#define MK_N_LAUNCHES 1
#endif

#define LAS __attribute__((address_space(3)))
typedef unsigned short bf16_t;
typedef short bf16x8 __attribute__((ext_vector_type(8)));
typedef float f32x4 __attribute__((ext_vector_type(4)));
typedef float f32x2 __attribute__((ext_vector_type(2)));
typedef unsigned u32x4 __attribute__((ext_vector_type(4)));
typedef unsigned u32x2 __attribute__((ext_vector_type(2)));

constexpr int T = 32768, DM = 1024, SEQ = 2048, NBATCH = 16, INC = 4096;
constexpr int C_R = 0, C_K = 512, C_V = 1024, C_WD = 1536, C_U = 1792, C_GA = 2048, C_GB = 3072;
constexpr int S5L = 32, S5NCH = 64, S5K = 640, S5N = 512, S5ROWS = 1024;
constexpr int NEXP = 32, DEXP = 256, MOE_ROWS_MAX = 2 * T + NEXP * 256;
constexpr int NPHASE = 20;

constexpr size_t MiB = (size_t)1 << 20, KiB = 1024;
constexpr size_t WS_CTL = 0;
constexpr size_t WS_WIN = 1 * MiB, WS_WBA = 9 * MiB, WS_WBB = 10 * MiB, WS_WOUT = 11 * MiB, WS_WPG = 13 * MiB, WS_WPP = 15 * MiB;
constexpr size_t WS_WLORA = 16 * MiB, WS_WGLU = 17 * MiB, WS_WR = 17 * MiB + 512 * KiB, WS_LAML = 17 * MiB + 768 * KiB;
constexpr size_t WS_KG = 18 * MiB, WS_W1 = 19 * MiB, WS_TZ = 23 * MiB, WS_WGU = 33 * MiB, WS_WD = 65 * MiB;
constexpr size_t WS_A = 82 * MiB;
constexpr size_t WS_HID = WS_A + 144 * MiB, WS_G = WS_A + 128 * MiB;
constexpr size_t WS_B = 338 * MiB;
constexpr size_t WS_UG = 402 * MiB, WS_E = 422 * MiB, WS_BON = 430 * MiB, WS_RWKV = 431 * MiB, WS_Z = 463 * MiB, WS_S5O = 479 * MiB;
constexpr size_t WS_ROUTE = 495 * MiB, WS_POS = 495 * MiB + 512 * KiB, WS_ROWW = 496 * MiB, WS_BC = 496 * MiB + 512 * KiB, WS_OFF = 496 * MiB + 768 * KiB;
constexpr size_t WS_HP = WS_RWKV;
constexpr size_t WS_P16 = WS_UG;
constexpr size_t WS_END = 497 * MiB;

constexpr int LDS_BYTES = 163840;
constexpr int MISC_OFF = 163584;

struct Args { const float* in[40]; float* out; unsigned char* ws; int ph_lo, ph_hi; };

#ifndef TIMER_SEL
#define TIMER_SEL 0
#endif
#ifndef TIMER_MULT
#define TIMER_MULT 2
#endif
#ifndef TIMER_PHMASK
#define TIMER_PHMASK 0
#endif
#if TIMER_SEL || TIMER_PHMASK
#define TSTART(id) do { if (((id) == TIMER_SEL || ((id) >= 100 && ((TIMER_PHMASK >> ((id) - 100)) & 1))) && blockIdx.x == 0 && threadIdx.x == 0) { volatile LAS unsigned* t_ = (volatile LAS unsigned*)(lds + MISC_OFF + 64); t_[0] = t_[0] - (unsigned)__builtin_amdgcn_s_memrealtime(); } } while (0)
#define TSTOP(id) do { if (((id) == TIMER_SEL || ((id) >= 100 && ((TIMER_PHMASK >> ((id) - 100)) & 1))) && blockIdx.x == 0 && threadIdx.x == 0) { volatile LAS unsigned* t_ = (volatile LAS unsigned*)(lds + MISC_OFF + 64); t_[0] = t_[0] + (unsigned)__builtin_amdgcn_s_memrealtime(); } } while (0)
#else
#define TSTART(id) do { } while (0)
#define TSTOP(id) do { } while (0)
#endif

#define LDS_WAIT() asm volatile("s_waitcnt lgkmcnt(0)" ::: "memory")
#define VM_WAIT() asm volatile("s_waitcnt vmcnt(0)" ::: "memory")
__device__ __forceinline__ unsigned f2bf(float f) { unsigned u = __builtin_bit_cast(unsigned, f); return (u + 0x7fffu + ((u >> 16) & 1u)) >> 16; }
__device__ __forceinline__ unsigned pk2(float lo, float hi) { return f2bf(lo) | (f2bf(hi) << 16); }
typedef __bf16 bf16x2_t __attribute__((ext_vector_type(2)));
__device__ __forceinline__ unsigned cvt_pk_bf16(float lo, float hi) { const f32x2 v = {lo, hi}; const bf16x2_t b = __builtin_convertvector(v, bf16x2_t); return __builtin_bit_cast(unsigned, b); }
__device__ __forceinline__ float bflo(unsigned w) { return __builtin_bit_cast(float, w << 16); }
__device__ __forceinline__ float bfhi(unsigned w) { return __builtin_bit_cast(float, w & 0xffff0000u); }
__device__ __forceinline__ void unpack8(u32x4 w, float (&v)[8]) { v[0] = bflo(w.x); v[1] = bfhi(w.x); v[2] = bflo(w.y); v[3] = bfhi(w.y); v[4] = bflo(w.z); v[5] = bfhi(w.z); v[6] = bflo(w.w); v[7] = bfhi(w.w); }
__device__ __forceinline__ void unpack4(u32x2 w, float (&v)[4]) { v[0] = bflo(w.x); v[1] = bfhi(w.x); v[2] = bflo(w.y); v[3] = bfhi(w.y); }
__device__ __forceinline__ u32x4 pack8(const float (&v)[8]) { u32x4 w; w.x = cvt_pk_bf16(v[0], v[1]); w.y = cvt_pk_bf16(v[2], v[3]); w.z = cvt_pk_bf16(v[4], v[5]); w.w = cvt_pk_bf16(v[6], v[7]); return w; }
__device__ __forceinline__ float sigmoidf_(float x) { return __builtin_amdgcn_rcpf(1.0f + __expf(-x)); }
__device__ __forceinline__ float tanhf_(float x) { return 1.0f - 2.0f * __builtin_amdgcn_rcpf(1.0f + __expf(2.0f * x)); }
__device__ __forceinline__ float gelu_tanh(float y) { return 0.5f * y * (1.0f + tanhf_(0.7978845608028654f * (y + 0.044715f * y * y * y))); }
__device__ __forceinline__ float wave_sum(float v) {
#pragma unroll
    for (int o = 1; o < 64; o <<= 1) v += __shfl_xor(v, o);
    return v;
}
__device__ __forceinline__ float dpp_f(float x, const int ctrl_sel) {
    int xi = __builtin_bit_cast(int, x), r;
    if (ctrl_sel == 0) r = __builtin_amdgcn_update_dpp(0, xi, 0xB1, 0xf, 0xf, true);
    else if (ctrl_sel == 1) r = __builtin_amdgcn_update_dpp(0, xi, 0x4E, 0xf, 0xf, true);
    else if (ctrl_sel == 2) r = __builtin_amdgcn_update_dpp(0, xi, 0x141, 0xf, 0xf, true);
    else r = __builtin_amdgcn_update_dpp(0, xi, 0x140, 0xf, 0xf, true);
    return __builtin_bit_cast(float, r);
}
__device__ __forceinline__ float row16_sum(float x) {
    x += dpp_f(x, 0); x += dpp_f(x, 1); x += dpp_f(x, 2); x += dpp_f(x, 3); return x;
}


#define XB_TMO      128
#define XB_XCNT(j)  (256  + 64 * (j))
#define XB_XSUB(j)  (1280 + 64 * (j))
#define XB_XGEN(j)  (2304 + 64 * (j))
#define XB_TOP      3328
#define XB_TOPGEN   3392
#define XCD_BAR_WORDS 3456
#define XB_SPIN_CAP (1u << 22)
__device__ __forceinline__ unsigned xb_ld(unsigned* p)              { return __hip_atomic_load(p, __ATOMIC_RELAXED, __HIP_MEMORY_SCOPE_AGENT); }
__device__ __forceinline__ unsigned xb_add(unsigned* p, unsigned v) { return __hip_atomic_fetch_add(p, v, __ATOMIC_RELAXED, __HIP_MEMORY_SCOPE_AGENT); }
__device__ __forceinline__ unsigned xb_xcc_id() { return (unsigned)__builtin_amdgcn_s_getreg((3 << 11) | 20) & 0xFu; }
#define XB_SPIN(cond, bar) do { unsigned _sp = 0; while (cond) { __builtin_amdgcn_s_sleep(1); \
    if ((++_sp & 255u) == 0u) { if (xb_ld(&(bar)[XB_TMO])) break; if (_sp > XB_SPIN_CAP) { atomicAdd(&(bar)[XB_TMO], 1u); break; } } } } while (0)
struct XcdBarrier { unsigned* bar; unsigned x; volatile LAS unsigned* st; };
__device__ __forceinline__ XcdBarrier xcd_barrier_post(unsigned* bar, volatile LAS unsigned* st) {
    XcdBarrier b; b.bar = bar; b.x = xb_xcc_id(); b.st = st;
    if (threadIdx.x == 0) (void)xb_add(&bar[XB_XCNT(b.x)], 1u);
    return b;
}
__device__ __forceinline__ void xcd_barrier_complete(unsigned* bar, unsigned x, unsigned& nloc, unsigned& nx) {
    const unsigned G = gridDim.x * gridDim.y * gridDim.z;
    unsigned sum, cnt, mine, sp = 0u;
    for (;;) {
        sum = 0u; cnt = 0u; mine = 0u;
#pragma unroll
        for (unsigned j = 0; j < 16; ++j) { const unsigned c = xb_ld(&bar[XB_XCNT(j)]); sum += c; cnt += (c > 0u) ? 1u : 0u; mine = (j == x) ? c : mine; }
        if (sum == G) break;
        __builtin_amdgcn_s_sleep(1);
        if ((++sp & 255u) == 0u) { if (xb_ld(&bar[XB_TMO])) break; if (sp > XB_SPIN_CAP) { atomicAdd(&bar[XB_TMO], 1u); break; } }
    }
    nloc = mine > 0u ? mine : 1u; nx = cnt > 0u ? cnt : 1u;
}
__device__ __forceinline__ void xcd_barrier(const XcdBarrier& b) {
    asm volatile("s_waitcnt vmcnt(0)" ::: "memory");
    __syncthreads();
    if (threadIdx.x == 0) {
        unsigned* bar = b.bar;
        __builtin_amdgcn_s_waitcnt(0);
        unsigned nloc = b.st[0], nx = b.st[1];
        if (nloc == 0u) { xcd_barrier_complete(bar, b.x, nloc, nx); b.st[0] = nloc; b.st[1] = nx; }
        const unsigned old = xb_add(&bar[XB_XSUB(b.x)], 1u);
        const unsigned gen = old / nloc;
        if (old + 1u == (gen + 1u) * nloc) {
            __builtin_amdgcn_fence(__ATOMIC_RELEASE, "agent");
            asm volatile("s_waitcnt vmcnt(0)" ::: "memory");
            const unsigned og = xb_add(&bar[XB_TOP], 1u);
            const unsigned tg = og / nx;
            if (og + 1u == (tg + 1u) * nx) xb_add(&bar[XB_TOPGEN], 1u);
            else XB_SPIN(xb_ld(&bar[XB_TOPGEN]) == tg, bar);
            __builtin_amdgcn_fence(__ATOMIC_ACQUIRE, "agent");
            xb_add(&bar[XB_XGEN(b.x)], 1u);
            asm volatile("s_waitcnt vmcnt(0)" ::: "memory");
        } else {
            XB_SPIN(xb_ld(&bar[XB_XGEN(b.x)]) == gen, bar);
            __builtin_amdgcn_fence(__ATOMIC_ACQUIRE, "agent");
            asm volatile("s_waitcnt vmcnt(0)" ::: "memory");
        }
    }
    __syncthreads();
}

namespace pg8 {
constexpr int BM = 256, BK = 64, HALF = 128, HTB = HALF * BK * 2, STAGE_BYTES = 8 * HTB, NXCD = 8, WGM = 8;
__host__ __device__ __forceinline__ int lds_byte(int r, int c) { const int st = (r >> 4) * 2 + (c >> 5), rr = r & 15, cc = c & 31, ob = rr * 64 + cc * 2; return st * 1024 + (ob ^ (((ob >> 9) & 1) << 5)); }
__host__ __device__ __forceinline__ void stage_rc(int b, int& R, int& C) { const int st = b / 1024, sb = b % 1024, swz = sb ^ (((sb >> 9) & 1) << 5); R = (st >> 1) * 16 + swz / 64; C = (st & 1) * 32 + (swz % 64) / 2; }
__host__ __device__ __forceinline__ int perm32(int rho) { const int n = rho >> 4, i = rho & 15; return 8 * (i >> 2) + 4 * n + (i & 3); }

struct Unit { int pm, pn, aux; const char* A; const char* B; };

struct StaticOrder {
    int nM, nN, nwg, G, c;
    __device__ __forceinline__ void init(int M, int N, int G_, int c_) { nM = M / BM; nN = N / BM; nwg = nM * nN; G = G_; c = c_; }
    __device__ __forceinline__ bool next(int i, int& pm, int& pn) const {
        const long L = (long)i * G + c; if (L >= nwg) return false;
        int wgid = (int)L; { const int q = nwg / NXCD, r = nwg % NXCD, xcd = wgid % NXCD, off = wgid / NXCD; wgid = (xcd < r ? xcd * (q + 1) : r * (q + 1) + (xcd - r) * q) + off; }
        const int nig = WGM * nN, gid = wgid / nig, fm = gid * WGM, gsz = (nM - fm) < WGM ? (nM - fm) : WGM;
        pm = fm + ((wgid % nig) % gsz); pn = (wgid % nig) / gsz; return true;
    }
};
struct DenseSched {
    const char* A; const char* B; int lda, ldb; StaticOrder so;
    __device__ __forceinline__ void init(const void* A_, int lda_, const void* B_, int ldb_, int M, int N, int G, int c) { A = (const char*)A_; B = (const char*)B_; lda = lda_; ldb = ldb_; so.init(M, N, G, c); }
    __device__ __forceinline__ bool next(int i, Unit& u) const {
        int pm, pn; if (!so.next(i, pm, pn)) return false;
        u.pm = pm; u.pn = pn; u.aux = 0; u.A = A + (size_t)pm * BM * lda * 2; u.B = B + (size_t)pn * BM * ldb * 2; return true;
    }
};
struct LoraSched {
    const char* A; const char* B; StaticOrder so;
    __device__ __forceinline__ bool next(int i, Unit& u) const {
        int pm, pn; if (!so.next(i, pm, pn)) return false;
        const int k0 = pn < 4 ? 0 : 128;
        u.pm = pm; u.pn = pn; u.aux = 0; u.A = A + ((size_t)pm * BM * 256 + k0) * 2; u.B = B + ((size_t)pn * BM * 256 + k0) * 2; return true;
    }
};
struct GroupSched {
    const char* A; const char* B; int lda, ldb, nM, nN, ngroups, G, c; size_t aStride, bStride;
    __device__ __forceinline__ bool next(int i, Unit& u) const {
        const int L = i * G + c; if (L >= ngroups * nM * nN) return false;
        const int g = L / (nM * nN), r = L % (nM * nN), pm = r % nM, pn = r / nM;
        u.pm = pm; u.pn = pn; u.aux = g; u.A = A + g * aStride + (size_t)pm * BM * lda * 2; u.B = B + g * bStride + (size_t)pn * BM * ldb * 2; return true;
    }
};
struct MoeSched {
    const int* off; const char* A; const char* B; int lda, ldb, NPN, G, c; size_t bStride;
    __device__ __forceinline__ bool next(int i, Unit& u) const {
        const int nTiles = off[NEXP] >> 8; const int L = i * G + c; if (L >= nTiles * NPN) return false;
        const int tile = L / NPN, pn = L % NPN, row = tile << 8; int e = 0;
        for (int k = 1; k < NEXP; ++k) e += (off[k] <= row) ? 1 : 0;
        u.pm = tile; u.pn = pn; u.aux = e; u.A = A + (size_t)tile * BM * lda * 2; u.B = B + e * bStride + (size_t)pn * BM * ldb * 2; return true;
    }
};

template <class F> struct EpiRow8 {
    F f;
    __device__ __forceinline__ void operator()(const f32x4 (&acc)[2][2][4][2], const Unit& u, int wr, int wc, int fr, int fq) const {
#pragma unroll
        for (int ai = 0; ai < 2; ++ai)
#pragma unroll
            for (int m = 0; m < 4; ++m) { const int r = ai * HALF + wr * 64 + m * 16 + fr;
#pragma unroll
                for (int bj = 0; bj < 2; ++bj) { const int c = bj * HALF + wc * 32 + 8 * fq;
                    float v[8] = {acc[ai][bj][m][0][0], acc[ai][bj][m][0][1], acc[ai][bj][m][0][2], acc[ai][bj][m][0][3], acc[ai][bj][m][1][0], acc[ai][bj][m][1][1], acc[ai][bj][m][1][2], acc[ai][bj][m][1][3]};
                    f(u, r, c, v); } }
    }
};
struct EpiMoeUp {
    bf16_t* HID;
    __device__ __forceinline__ void operator()(const f32x4 (&acc)[2][2][4][2], const Unit& u, int wr, int wc, int fr, int fq) const {
#pragma unroll
        for (int ai = 0; ai < 2; ++ai)
#pragma unroll
            for (int m = 0; m < 4; ++m) { const int r = u.pm * BM + ai * HALF + wr * 64 + m * 16 + fr; const int hc = u.pn * HALF + wc * 32 + 8 * fq;
                float o[8];
#pragma unroll
                for (int n = 0; n < 2; ++n)
#pragma unroll
                    for (int k = 0; k < 4; ++k) { const float g = acc[ai][0][m][n][k], up = acc[ai][1][m][n][k]; o[4 * n + k] = g * sigmoidf_(g) * up; }
                *(u32x4*)(HID + (size_t)r * DEXP + hc) = pack8(o); }
    }
};

template <class Epi, class Sched, bool ALIGN_EPI>
__device__ __forceinline__ void gemm_phase(LAS unsigned char* lds, const int K, const int lda, const int ldb, const Sched& S, const Epi& E) {
    const int tid = threadIdx.x, wid = __builtin_amdgcn_readfirstlane(tid >> 6), lane = tid & 63, wr = wid >> 2, wc = wid & 3, fr = lane & 15, fq = lane >> 4;
    const int nt = K / BK;
    unsigned voffA[2], voffB[2];
#pragma unroll
    for (int i = 0; i < 2; ++i) { int R, C; stage_rc(tid * 16 + i * 8192, R, C); const int Rb = (R & ~31) + perm32(R & 31);
        voffA[i] = (unsigned)(R * lda + C) * 2u; voffB[i] = (unsigned)(Rb * ldb + C) * 2u; }
    const size_t kstep = (size_t)(BK * 2);
    const size_t hstepA = (size_t)HALF * lda * 2, hstepB = (size_t)HALF * ldb * 2;
    const unsigned ldsw = (unsigned)wid * 1024u;
    const int aoff = lds_byte(wr * 64 + fr, fq * 8), boff = lds_byte(wc * 32 + fr, fq * 8);
#define PG8_SA(b, h) (((b) * 2 + (h)) * HTB)
#define PG8_SB(b, h) ((4 + (b) * 2 + (h)) * HTB)
#define PG8_STAGE(bufoff, gbase, voff) do { _Pragma("unroll") for (int _i = 0; _i < 2; ++_i) \
        __builtin_amdgcn_global_load_lds((const unsigned*)((const char*)(gbase) + (voff)[_i]), (LAS unsigned*)(lds + (bufoff) + ldsw + _i * 8192), 16, 0, 0); } while (0)
#define PG8_LDA(dst, b, h) do { _Pragma("unroll") for (int m = 0; m < 4; ++m) _Pragma("unroll") for (int k = 0; k < 2; ++k) dst[m][k] = *(const LAS bf16x8*)(lds + PG8_SA(b, h) + aoff + m * 2048 + k * 1024); } while (0)
#define PG8_LDB(dst, b, h) do { _Pragma("unroll") for (int n = 0; n < 2; ++n) _Pragma("unroll") for (int k = 0; k < 2; ++k) dst[n][k] = *(const LAS bf16x8*)(lds + PG8_SB(b, h) + boff + n * 2048 + k * 1024); } while (0)
#define PG8_MMA(ai, bj, At, Bt) do { __builtin_amdgcn_s_setprio(1); _Pragma("unroll") for (int m = 0; m < 4; ++m) _Pragma("unroll") for (int n = 0; n < 2; ++n) _Pragma("unroll") for (int k = 0; k < 2; ++k) \
        acc[ai][bj][m][n] = __builtin_amdgcn_mfma_f32_16x16x32_bf16(Bt[n][k], At[m][k], acc[ai][bj][m][n], 0, 0, 0); __builtin_amdgcn_s_setprio(0); } while (0)
#define PG8_WAIT_V(n) asm volatile("s_waitcnt vmcnt(" #n ")" ::: "memory")
#define PG8_WAIT_L(n) asm volatile("s_waitcnt lgkmcnt(" #n ")" ::: "memory")
#define PG8_BAR __builtin_amdgcn_s_barrier()
#define PG8_SCHED __builtin_amdgcn_sched_barrier(0)
    Unit cur, nxt; int ui = 0;
    if (!S.next(0, cur)) return;
    f32x4 acc[2][2][4][2];
#pragma unroll
    for (int a = 0; a < 2; ++a)
#pragma unroll
        for (int b = 0; b < 2; ++b)
#pragma unroll
            for (int m = 0; m < 4; ++m)
#pragma unroll
                for (int n = 0; n < 2; ++n) acc[a][b][m][n] = (f32x4){0.f, 0.f, 0.f, 0.f};
    bf16x8 At[4][2], B0[2][2], B1[2][2];
    const char* cA = cur.A; const char* cB = cur.B;
    PG8_STAGE(PG8_SB(0, 0), cB, voffB); PG8_STAGE(PG8_SB(0, 1), cB + hstepB, voffB); PG8_STAGE(PG8_SA(0, 0), cA, voffA); PG8_STAGE(PG8_SA(0, 1), cA + hstepA, voffA);
    if (wr == 1) PG8_BAR;
    PG8_WAIT_V(2); PG8_BAR;
    PG8_STAGE(PG8_SB(1, 0), cB + kstep, voffB); PG8_STAGE(PG8_SA(1, 0), cA + kstep, voffA); PG8_STAGE(PG8_SB(1, 1), cB + hstepB + kstep, voffB);
    PG8_WAIT_V(6); PG8_BAR;
    for (;;) {
        const bool has_next = S.next(ui + 1, nxt);
        const char* nA = has_next ? nxt.A : cA; const char* nB = has_next ? nxt.B : cB;
#pragma unroll 1
        for (int t = 0; t < nt; t += 2) {
            const bool last = (t == nt - 2);
            const char* a1 = cA + (size_t)(t + 1) * kstep;
            const char* a2 = last ? nA : cA + (size_t)(t + 2) * kstep; const char* b2 = last ? nB : cB + (size_t)(t + 2) * kstep;
            const char* a3 = a2 + kstep; const char* b3 = b2 + kstep;
            PG8_LDB(B0, 0, 0); PG8_LDB(B1, 0, 1); PG8_SCHED; PG8_LDA(At, 0, 0); PG8_STAGE(PG8_SA(1, 1), a1 + hstepA, voffA);
            PG8_WAIT_V(8); PG8_WAIT_L(0); PG8_BAR; PG8_MMA(0, 0, At, B0); PG8_MMA(0, 1, At, B1); PG8_BAR; PG8_SCHED;
            PG8_LDA(At, 0, 1); PG8_STAGE(PG8_SB(0, 0), b2, voffB); PG8_STAGE(PG8_SB(0, 1), b2 + hstepB, voffB); PG8_STAGE(PG8_SA(0, 0), a2, voffA);
            PG8_WAIT_V(8); PG8_WAIT_L(0); PG8_BAR; PG8_MMA(1, 0, At, B0); PG8_MMA(1, 1, At, B1); PG8_BAR; PG8_SCHED;
            PG8_LDB(B0, 1, 0); PG8_LDB(B1, 1, 1); PG8_SCHED; PG8_LDA(At, 1, 0); PG8_STAGE(PG8_SA(0, 1), a2 + hstepA, voffA);
            PG8_WAIT_V(8); PG8_WAIT_L(0); PG8_BAR; PG8_MMA(0, 0, At, B0); PG8_MMA(0, 1, At, B1); PG8_BAR; PG8_SCHED;
            PG8_LDA(At, 1, 1); PG8_STAGE(PG8_SB(1, 0), b3, voffB); PG8_STAGE(PG8_SB(1, 1), b3 + hstepB, voffB); PG8_STAGE(PG8_SA(1, 0), a3, voffA);
            PG8_WAIT_V(8); PG8_WAIT_L(0); PG8_BAR; PG8_MMA(1, 0, At, B0); PG8_MMA(1, 1, At, B1); PG8_BAR; PG8_SCHED;
        }
        if constexpr (ALIGN_EPI) { if (wr == 0) PG8_BAR; }
        E(acc, cur, wr, wc, fr, fq);
        if (!has_next) break;
#pragma unroll
        for (int a = 0; a < 2; ++a)
#pragma unroll
            for (int b = 0; b < 2; ++b)
#pragma unroll
                for (int m = 0; m < 4; ++m)
#pragma unroll
                    for (int n = 0; n < 2; ++n) acc[a][b][m][n] = (f32x4){0.f, 0.f, 0.f, 0.f};
        cur = nxt; cA = nA; cB = nB; ++ui;
        if constexpr (ALIGN_EPI) { if (wr == 1) PG8_BAR; }
    }
    PG8_WAIT_V(0);
    if constexpr (!ALIGN_EPI) { if (wr == 0) PG8_BAR; }
    PG8_BAR;
#undef PG8_SA
#undef PG8_SB
#undef PG8_STAGE
#undef PG8_LDA
#undef PG8_LDB
#undef PG8_MMA
#undef PG8_WAIT_V
#undef PG8_WAIT_L
#undef PG8_BAR
#undef PG8_SCHED
}

struct Unit2 { int pm, pn; const char* A0; const char* B0; const char* A1; const char* B1; };
template <class Epi, class Sched, bool ALIGN_EPI, int NT0, int NT1>
__device__ __forceinline__ void gemm_phase2(LAS unsigned char* lds, const int lda, const int ldb, const Sched& S, const Epi& E) {
    const int tid = threadIdx.x, wid = __builtin_amdgcn_readfirstlane(tid >> 6), lane = tid & 63, wr = wid >> 2, wc = wid & 3, fr = lane & 15, fq = lane >> 4;
    unsigned voffA[2], voffB[2];
#pragma unroll
    for (int i = 0; i < 2; ++i) { int R, C; stage_rc(tid * 16 + i * 8192, R, C); const int Rb = (R & ~31) + perm32(R & 31);
        voffA[i] = (unsigned)(R * lda + C) * 2u; voffB[i] = (unsigned)(Rb * ldb + C) * 2u; }
    const size_t kstep = (size_t)(BK * 2);
    const size_t hstepA = (size_t)HALF * lda * 2, hstepB = (size_t)HALF * ldb * 2;
    const unsigned ldsw = (unsigned)wid * 1024u;
    const int aoff = lds_byte(wr * 64 + fr, fq * 8), boff = lds_byte(wc * 32 + fr, fq * 8);
#define PG8_SA(b, h) (((b) * 2 + (h)) * HTB)
#define PG8_SB(b, h) ((4 + (b) * 2 + (h)) * HTB)
#define PG8_STAGE(bufoff, gbase, voff) do { _Pragma("unroll") for (int _i = 0; _i < 2; ++_i) \
        __builtin_amdgcn_global_load_lds((const unsigned*)((const char*)(gbase) + (voff)[_i]), (LAS unsigned*)(lds + (bufoff) + ldsw + _i * 8192), 16, 0, 0); } while (0)
#define PG8_LDA(dst, b, h) do { _Pragma("unroll") for (int m = 0; m < 4; ++m) _Pragma("unroll") for (int k = 0; k < 2; ++k) dst[m][k] = *(const LAS bf16x8*)(lds + PG8_SA(b, h) + aoff + m * 2048 + k * 1024); } while (0)
#define PG8_LDB(dst, b, h) do { _Pragma("unroll") for (int n = 0; n < 2; ++n) _Pragma("unroll") for (int k = 0; k < 2; ++k) dst[n][k] = *(const LAS bf16x8*)(lds + PG8_SB(b, h) + boff + n * 2048 + k * 1024); } while (0)
#define PG8_MMA(ai, bj, At, Bt) do { __builtin_amdgcn_s_setprio(1); _Pragma("unroll") for (int m = 0; m < 4; ++m) _Pragma("unroll") for (int n = 0; n < 2; ++n) _Pragma("unroll") for (int k = 0; k < 2; ++k) \
        acc[ai][bj][m][n] = __builtin_amdgcn_mfma_f32_16x16x32_bf16(Bt[n][k], At[m][k], acc[ai][bj][m][n], 0, 0, 0); __builtin_amdgcn_s_setprio(0); } while (0)
#define PG8_WAIT_V(n) asm volatile("s_waitcnt vmcnt(" #n ")" ::: "memory")
#define PG8_WAIT_L(n) asm volatile("s_waitcnt lgkmcnt(" #n ")" ::: "memory")
#define PG8_BAR __builtin_amdgcn_s_barrier()
#define PG8_SCHED __builtin_amdgcn_sched_barrier(0)
#define PG8_KLOOP(NT, cA_, cB_, nA_, nB_) _Pragma("unroll 1") for (int t = 0; t < (NT); t += 2) { \
            const bool last = (t == (NT) - 2); \
            const char* a1 = (cA_) + (size_t)(t + 1) * kstep; \
            const char* a2 = last ? (nA_) : (cA_) + (size_t)(t + 2) * kstep; const char* b2 = last ? (nB_) : (cB_) + (size_t)(t + 2) * kstep; \
            const char* a3 = a2 + kstep; const char* b3 = b2 + kstep; \
            PG8_LDB(B0, 0, 0); PG8_LDB(B1, 0, 1); PG8_SCHED; PG8_LDA(At, 0, 0); PG8_STAGE(PG8_SA(1, 1), a1 + hstepA, voffA); \
            PG8_WAIT_V(8); PG8_WAIT_L(0); PG8_BAR; PG8_MMA(0, 0, At, B0); PG8_MMA(0, 1, At, B1); PG8_BAR; PG8_SCHED; \
            PG8_LDA(At, 0, 1); PG8_STAGE(PG8_SB(0, 0), b2, voffB); PG8_STAGE(PG8_SB(0, 1), b2 + hstepB, voffB); PG8_STAGE(PG8_SA(0, 0), a2, voffA); \
            PG8_WAIT_V(8); PG8_WAIT_L(0); PG8_BAR; PG8_MMA(1, 0, At, B0); PG8_MMA(1, 1, At, B1); PG8_BAR; PG8_SCHED; \
            PG8_LDB(B0, 1, 0); PG8_LDB(B1, 1, 1); PG8_SCHED; PG8_LDA(At, 1, 0); PG8_STAGE(PG8_SA(0, 1), a2 + hstepA, voffA); \
            PG8_WAIT_V(8); PG8_WAIT_L(0); PG8_BAR; PG8_MMA(0, 0, At, B0); PG8_MMA(0, 1, At, B1); PG8_BAR; PG8_SCHED; \
            PG8_LDA(At, 1, 1); PG8_STAGE(PG8_SB(1, 0), b3, voffB); PG8_STAGE(PG8_SB(1, 1), b3 + hstepB, voffB); PG8_STAGE(PG8_SA(1, 0), a3, voffA); \
            PG8_WAIT_V(8); PG8_WAIT_L(0); PG8_BAR; PG8_MMA(1, 0, At, B0); PG8_MMA(1, 1, At, B1); PG8_BAR; PG8_SCHED; }
    Unit2 cur, nxt; int ui = 0;
    if (!S.next(0, cur)) return;
    f32x4 acc[2][2][4][2];
#pragma unroll
    for (int a = 0; a < 2; ++a)
#pragma unroll
        for (int b = 0; b < 2; ++b)
#pragma unroll
            for (int m = 0; m < 4; ++m)
#pragma unroll
                for (int n = 0; n < 2; ++n) acc[a][b][m][n] = (f32x4){0.f, 0.f, 0.f, 0.f};
    bf16x8 At[4][2], B0[2][2], B1[2][2];
    {
        const char* cA = cur.A0; const char* cB = cur.B0;
        PG8_STAGE(PG8_SB(0, 0), cB, voffB); PG8_STAGE(PG8_SB(0, 1), cB + hstepB, voffB); PG8_STAGE(PG8_SA(0, 0), cA, voffA); PG8_STAGE(PG8_SA(0, 1), cA + hstepA, voffA);
        if (wr == 1) PG8_BAR;
        PG8_WAIT_V(2); PG8_BAR;
        PG8_STAGE(PG8_SB(1, 0), cB + kstep, voffB); PG8_STAGE(PG8_SA(1, 0), cA + kstep, voffA); PG8_STAGE(PG8_SB(1, 1), cB + hstepB + kstep, voffB);
        PG8_WAIT_V(6); PG8_BAR;
    }
    for (;;) {
        const bool has_next = S.next(ui + 1, nxt);
        const char* nA = has_next ? nxt.A0 : cur.A0; const char* nB = has_next ? nxt.B0 : cur.B0;
        PG8_KLOOP(NT0, cur.A0, cur.B0, cur.A1, cur.B1)
        E.mid(acc, cur, wr, wc, fr, fq);
        PG8_KLOOP(NT1, cur.A1, cur.B1, nA, nB)
        if constexpr (ALIGN_EPI) { if (wr == 0) PG8_BAR; }
        E.fin(acc, cur, wr, wc, fr, fq);
        if (!has_next) break;
#pragma unroll
        for (int a = 0; a < 2; ++a)
#pragma unroll
            for (int b = 0; b < 2; ++b)
#pragma unroll
                for (int m = 0; m < 4; ++m)
#pragma unroll
                    for (int n = 0; n < 2; ++n) acc[a][b][m][n] = (f32x4){0.f, 0.f, 0.f, 0.f};
        cur = nxt; ++ui;
        if constexpr (ALIGN_EPI) { if (wr == 1) PG8_BAR; }
    }
    PG8_WAIT_V(0);
    if constexpr (!ALIGN_EPI) { if (wr == 0) PG8_BAR; }
    PG8_BAR;
#undef PG8_KLOOP
#undef PG8_SA
#undef PG8_SB
#undef PG8_STAGE
#undef PG8_LDA
#undef PG8_LDB
#undef PG8_MMA
#undef PG8_WAIT_V
#undef PG8_WAIT_L
#undef PG8_BAR
#undef PG8_SCHED
}
struct BrSched {
    const char* A0; const char* B0; const char* A1; const char* B1; StaticOrder so;
    __device__ __forceinline__ bool next(int i, Unit2& u) const {
        int pm, pn; if (!so.next(i, pm, pn)) return false;
        u.pm = pm; u.pn = pn; u.A0 = A0 + (size_t)pm * BM * 512 * 2; u.B0 = B0 + (size_t)pn * BM * 512 * 2; u.A1 = A1 + (size_t)pm * BM * 512 * 2; u.B1 = B1 + (size_t)pn * BM * 512 * 2; return true;
    }
};
struct EpiBr {
    const bf16_t* COLS; bf16_t* MG;
    __device__ __forceinline__ void mid(f32x4 (&acc)[2][2][4][2], const Unit2& u, int wr, int wc, int fr, int fq) const {
#pragma unroll
        for (int ai = 0; ai < 2; ++ai)
#pragma unroll
            for (int m = 0; m < 4; ++m) { const size_t t = (size_t)u.pm * BM + ai * HALF + wr * 64 + m * 16 + fr;
#pragma unroll
                for (int bj = 0; bj < 2; ++bj) { const int col = u.pn * BM + bj * HALF + wc * 32 + 8 * fq; float ga[8], gb[8];
                    unpack8(*(const u32x4*)(COLS + t * INC + C_GA + col), ga); unpack8(*(const u32x4*)(COLS + t * INC + C_GB + col), gb);
#pragma unroll
                    for (int n = 0; n < 2; ++n)
#pragma unroll
                        for (int k = 0; k < 4; ++k) { const float rt_ = sigmoidf_(ga[4 * n + k]) * (1.0f + __expf(-gb[4 * n + k]));
                            asm volatile("v_mul_f32 %0, %0, %1" : "+v"(acc[ai][bj][m][n][k]) : "v"(rt_)); } }
                asm volatile("" ::: "memory"); }
    }
    __device__ __forceinline__ void fin(const f32x4 (&acc)[2][2][4][2], const Unit2& u, int wr, int wc, int fr, int fq) const {
#pragma unroll
        for (int ai = 0; ai < 2; ++ai)
#pragma unroll
            for (int m = 0; m < 4; ++m) { const size_t t = (size_t)u.pm * BM + ai * HALF + wr * 64 + m * 16 + fr;
#pragma unroll
                for (int bj = 0; bj < 2; ++bj) { const int col = u.pn * BM + bj * HALF + wc * 32 + 8 * fq; float gb[8], o[8];
                    unpack8(*(const u32x4*)(COLS + t * INC + C_GB + col), gb);
#pragma unroll
                    for (int n = 0; n < 2; ++n)
#pragma unroll
                        for (int k = 0; k < 4; ++k) o[4 * n + k] = acc[ai][bj][m][n][k] * sigmoidf_(gb[4 * n + k]);
                    *(u32x4*)(MG + t * DM + col) = pack8(o); }
                asm volatile("" ::: "memory"); }
    }
};
}
using pg8::Unit;

struct F_Cols { bf16_t* C; int ldc; bf16_t* UG;
    __device__ __forceinline__ void operator()(const Unit& u, int r, int c, float (&v)[8]) const {
        const u32x4 w = pack8(v); const int t = u.pm * 256 + r;
        *(u32x4*)(C + (size_t)t * ldc + u.pn * 256 + c) = w;
        if (u.pn == 7) { const int g = c >> 4, c0 = c & 15, b = t >> 11, s = t & (SEQ - 1), ch = s >> 5, j = s & 31;
            *(u32x4*)(UG + ((size_t)g * S5ROWS + b * S5NCH + ch) * S5K + j * 16 + c0) = w; } } };
struct F_Lora { bf16_t* O; const float* w0; const float* a0;
    __device__ __forceinline__ void operator()(const Unit& u, int r, int c, float (&v)[8]) const {
        const int gc = u.pn * 256 + c; const int ty = u.pn >> 1;
        if (ty == 0) {
#pragma unroll
            for (int i = 0; i < 8; ++i) v[i] = 0.6065306597126334f * sigmoidf_(v[i] + w0[gc + i]);
        } else if (ty == 1) {
#pragma unroll
            for (int i = 0; i < 8; ++i) v[i] = sigmoidf_(v[i] + a0[gc - 512 + i]);
        }
        *(u32x4*)(O + (size_t)(u.pm * 256 + r) * 1536 + gc) = pack8(v); } };
struct F_S5a { float* E;
    __device__ __forceinline__ void operator()(const Unit& u, int r, int c, float (&v)[8]) const {
        if (c < 128) { float* p = E + ((size_t)u.aux * S5ROWS + u.pm * 256 + r) * 128 + c;
            *(f32x4*)p = (f32x4){v[0], v[1], v[2], v[3]}; *(f32x4*)(p + 4) = (f32x4){v[4], v[5], v[6], v[7]}; } } };
struct F_S5c { const bf16_t* COLS; const float* Dsk; bf16_t* Z;
    __device__ __forceinline__ void operator()(const Unit& u, int r, int c, float (&v)[8]) const {
        const int row = u.pm * 256 + r, col = u.pn * 256 + c; const int b = row >> 6, ch = row & 63, j = col >> 4, c0 = col & 15;
        const int t = b * SEQ + ch * S5L + j, chan = u.aux * 16 + c0;
        float uu[8]; unpack8(*(const u32x4*)(COLS + (size_t)t * INC + C_U + chan), uu);
#pragma unroll
        for (int i = 0; i < 8; ++i) v[i] = gelu_tanh(v[i] + Dsk[chan + i] * uu[i]);
        *(u32x4*)(Z + (size_t)t * 256 + chan) = pack8(v); } };
struct F_Glu { const bf16_t* Z; const float* gb; bf16_t* O;
    __device__ __forceinline__ void operator()(const Unit& u, int r, int c, float (&v)[8]) const {
        const size_t t = (size_t)u.pm * 256 + r; float z[8]; unpack8(*(const u32x4*)(Z + t * 256 + c), z);
#pragma unroll
        for (int i = 0; i < 8; ++i) v[i] = z[i] * sigmoidf_(v[i] + gb[c + i]);
        *(u32x4*)(O + t * 512 + c) = pack8(v); } };
struct F_BrA { const bf16_t* COLS; float* PART;
    __device__ __forceinline__ void operator()(const Unit& u, int r, int c, float (&v)[8]) const {
        const size_t t = (size_t)u.pm * 256 + r; const int col = u.pn * 256 + c; float g[8]; unpack8(*(const u32x4*)(COLS + t * INC + C_GA + col), g);
#pragma unroll
        for (int i = 0; i < 8; ++i) v[i] *= sigmoidf_(g[i]);
        float* p = PART + t * DM + col; *(f32x4*)p = (f32x4){v[0], v[1], v[2], v[3]}; *(f32x4*)(p + 4) = (f32x4){v[4], v[5], v[6], v[7]}; } };
struct F_BrB { const bf16_t* COLS; const float* PART; bf16_t* MG;
    __device__ __forceinline__ void operator()(const Unit& u, int r, int c, float (&v)[8]) const {
        const size_t t = (size_t)u.pm * 256 + r; const int col = u.pn * 256 + c; float g[8]; unpack8(*(const u32x4*)(COLS + t * INC + C_GB + col), g);
        const float* p = PART + t * DM + col; const f32x4 p0 = *(const f32x4*)p, p1 = *(const f32x4*)(p + 4);
        const float pp[8] = {p0[0], p0[1], p0[2], p0[3], p1[0], p1[1], p1[2], p1[3]};
#pragma unroll
        for (int i = 0; i < 8; ++i) v[i] = pp[i] + v[i] * sigmoidf_(g[i]);
        *(u32x4*)(MG + t * DM + col) = pack8(v); } };
struct F_Res { const float* X; float* O;
    __device__ __forceinline__ void operator()(const Unit& u, int r, int c, float (&v)[8]) const {
        const size_t o = ((size_t)u.pm * 256 + r) * DM + u.pn * 256 + c; const f32x4 x0 = *(const f32x4*)(X + o), x1 = *(const f32x4*)(X + o + 4);
        *(f32x4*)(O + o) = (f32x4){x0[0] + v[0], x0[1] + v[1], x0[2] + v[2], x0[3] + v[3]}; *(f32x4*)(O + o + 4) = (f32x4){x1[0] + v[4], x1[1] + v[5], x1[2] + v[6], x1[3] + v[7]}; } };
struct F_MoeDown { const float* ROWW; bf16_t* YM;
    __device__ __forceinline__ void operator()(const Unit& u, int r, int c, float (&v)[8]) const {
        const size_t row = (size_t)u.pm * 256 + r; const float w = ROWW[row];
#pragma unroll
        for (int i = 0; i < 8; ++i) v[i] *= w;
        *(u32x4*)(YM + row * DM + u.pn * 256 + c) = pack8(v); } };
struct F_PleG { bf16_t* G;
    __device__ __forceinline__ void operator()(const Unit& u, int r, int c, float (&v)[8]) const {
#pragma unroll
        for (int i = 0; i < 8; ++i) v[i] = sigmoidf_(v[i]);
        *(u32x4*)(G + ((size_t)u.pm * 256 + r) * DM + u.pn * 256 + c) = pack8(v); } };
struct F_PleP { const bf16_t* G; const float* X; float* XO;
    __device__ __forceinline__ void operator()(const Unit& u, int r, int c, float (&v)[8]) const {
        const size_t o = ((size_t)u.pm * 256 + r) * DM + u.pn * 256 + c; float g[8]; unpack8(*(const u32x4*)(G + o), g);
        const f32x4 x0 = *(const f32x4*)(X + o), x1 = *(const f32x4*)(X + o + 4);
#ifdef EXP_NOG
        for (int i = 0; i < 8; ++i) g[i] = 0.5f;
#endif
#ifdef EXP_NOACC
        for (int i = 0; i < 8; ++i) v[i] = 1.0f;
#endif
        *(f32x4*)(XO + o) = (f32x4){x0[0] + g[0] * v[0], x0[1] + g[1] * v[1], x0[2] + g[2] * v[2], x0[3] + g[3] * v[3]};
        *(f32x4*)(XO + o + 4) = (f32x4){x1[0] + g[4] * v[4], x1[1] + g[5] * v[5], x1[2] + g[6] * v[6], x1[3] + g[7] * v[7]}; } };

enum { I_X = 0, I_P, I_MIXN, I_WIN, I_MU, I_W0, I_WUP, I_A0, I_AUP, I_GUP, I_KK, I_KA, I_RK, I_LNG, I_LNB, I_LRE, I_LIM, I_LDT, I_BRE, I_BIM, I_CRE, I_CIM, I_SD, I_GLUW, I_GLUB,
       I_WBA, I_WBB, I_WOUT, I_FFNN, I_RGW, I_RGB, I_REW, I_REB, I_EG, I_EU, I_ED, I_PLEN, I_PLEG, I_PLEP, I_FINN };

__device__ __forceinline__ void transpose_item(const float* __restrict__ W, int ldw, const float* __restrict__ kscale, int k0, int n0, bf16_t* WT, int ldt, int dst_row0, int dst_k0, LAS float* scr, int lane) {
#pragma unroll 2
    for (int i = 0; i < 32; ++i) { const int kk = 2 * i + (lane >> 5); float v = W[(size_t)(k0 + kk) * ldw + n0 + (lane & 31)]; if (kscale) v *= kscale[k0 + kk]; scr[kk * 33 + (lane & 31)] = v; }
    LDS_WAIT();
    const int c = lane & 7;
#pragma unroll
    for (int j = 0; j < 4; ++j) { const int n = (lane >> 3) + 8 * j; const LAS float* s = scr + (8 * c) * 33 + n;
        u32x4 o; o.x = pk2(s[0 * 33], s[1 * 33]); o.y = pk2(s[2 * 33], s[3 * 33]); o.z = pk2(s[4 * 33], s[5 * 33]); o.w = pk2(s[6 * 33], s[7 * 33]);
        *(u32x4*)(WT + (size_t)(dst_row0 + n) * ldt + dst_k0 + 8 * c) = o; }
    LDS_WAIT();
}

constexpr int N_WBA = 8 * 32, N_WBB = 4 * 32, N_WOUT = 16 * 32, N_WPG = 16 * 32, N_WPP = 4 * 32, N_GLU = 4 * 8, N_EG = 32 * 128, N_EU = 32 * 128, N_ED = 32 * 128;
constexpr int N_LATE = N_WBA + N_WBB + N_WOUT + N_WPG + N_WPP + N_GLU + N_EG + N_EU + N_ED;
struct TrDesc { const float* W; const float* ks; bf16_t* WT; int ldw, k0, n0, ldt, row0; };
__device__ __forceinline__ TrDesc late_desc(const Args& a, int r) {
    unsigned char* ws = a.ws; TrDesc d; d.ks = nullptr;
    if (r < N_WBA) { d.W = a.in[I_WBA]; d.ldw = 1024; d.k0 = 64 * (r / 32); d.n0 = 32 * (r % 32); d.WT = (bf16_t*)(ws + WS_WBA); d.ldt = 512; d.row0 = d.n0; return d; } r -= N_WBA;
    if (r < N_WBB) { d.W = a.in[I_WBB]; d.ldw = 1024; d.k0 = 64 * (r / 32); d.n0 = 32 * (r % 32); d.WT = (bf16_t*)(ws + WS_WBB); d.ldt = 512; d.row0 = d.n0; return d; } r -= N_WBB;
    if (r < N_WOUT) { d.W = a.in[I_WOUT]; d.ldw = 1024; d.k0 = 64 * (r / 32); d.n0 = 32 * (r % 32); d.WT = (bf16_t*)(ws + WS_WOUT); d.ldt = 1024; d.row0 = d.n0; return d; } r -= N_WOUT;
    if (r < N_WPG) { d.W = a.in[I_PLEG]; d.ks = a.in[I_PLEN]; d.ldw = 1024; d.k0 = 64 * (r / 32); d.n0 = 32 * (r % 32); d.WT = (bf16_t*)(ws + WS_WPG); d.ldt = 1024; d.row0 = d.n0; return d; } r -= N_WPG;
    if (r < N_WPP) { d.W = a.in[I_PLEP]; d.ldw = 1024; d.k0 = 64 * (r / 32); d.n0 = 32 * (r % 32); d.WT = (bf16_t*)(ws + WS_WPP); d.ldt = 256; d.row0 = d.n0; return d; } r -= N_WPP;
    if (r < N_GLU) { d.W = a.in[I_GLUW]; d.ldw = 256; d.k0 = 64 * (r / 8); d.n0 = 32 * (r % 8); d.WT = (bf16_t*)(ws + WS_WGLU); d.ldt = 256; d.row0 = d.n0; return d; } r -= N_GLU;
    if (r < N_EG + N_EU) { const int up = r >= N_EG ? 1 : 0; if (up) r -= N_EG; const int e = r / 128, q = r % 128; d.k0 = 64 * (q / 8); d.n0 = 32 * (q % 8);
        d.W = a.in[up ? I_EU : I_EG] + (size_t)e * 1024 * 256; d.ks = a.in[I_FFNN]; d.ldw = 256; d.WT = (bf16_t*)(ws + WS_WGU); d.ldt = 1024; d.row0 = e * 512 + (d.n0 / 128) * 256 + up * 128 + (d.n0 % 128); return d; } r -= N_EG + N_EU;
    { const int e = r / 128, q = r % 128; d.k0 = 64 * (q / 32); d.n0 = 32 * (q % 32); d.W = a.in[I_ED] + (size_t)e * 256 * 1024; d.ldw = 1024; d.WT = (bf16_t*)(ws + WS_WD) + (size_t)e * 1024 * 256; d.ldt = 256; d.row0 = d.n0; return d; }
}
__device__ __forceinline__ void tr_load(const TrDesc& d, float (&tv)[32], int lane) {
#pragma unroll
    for (int i = 0; i < 32; ++i) tv[i] = d.W[(size_t)(d.k0 + 2 * i + (lane >> 5)) * d.ldw + d.n0 + (lane & 31)];
}
__device__ __forceinline__ void tr_store(const TrDesc& d, const float (&tv)[32], LAS float* scr, int lane) {
#pragma unroll
    for (int i = 0; i < 32; ++i) scr[(2 * i + (lane >> 5)) * 33 + (lane & 31)] = tv[i];
    LDS_WAIT();
    const int c = lane & 7; float sc[8];
#pragma unroll
    for (int i = 0; i < 8; ++i) sc[i] = d.ks ? d.ks[d.k0 + 8 * c + i] : 1.0f;
#pragma unroll
    for (int j = 0; j < 4; ++j) { const int n = (lane >> 3) + 8 * j; const LAS float* s = scr + (8 * c) * 33 + n;
        u32x4 o; o.x = pk2(s[0 * 33] * sc[0], s[1 * 33] * sc[1]); o.y = pk2(s[2 * 33] * sc[2], s[3 * 33] * sc[3]); o.z = pk2(s[4 * 33] * sc[4], s[5 * 33] * sc[5]); o.w = pk2(s[6 * 33] * sc[6], s[7 * 33] * sc[7]);
        *(u32x4*)(d.WT + (size_t)(d.row0 + n) * d.ldt + d.k0 + 8 * c) = o; }
    LDS_WAIT();
}
__device__ __forceinline__ void dsincos_reduced(double x, double& s, double& c) {
    const double x2 = x * x;
    double ps = -1.0 / 1.307674368e12  ; ps = ps * x2 + 1.0 / 6227020800.0; ps = ps * x2 - 1.0 / 39916800.0; ps = ps * x2 + 1.0 / 362880.0; ps = ps * x2 - 1.0 / 5040.0; ps = ps * x2 + 1.0 / 120.0; ps = ps * x2 - 1.0 / 6.0;
    double hs = -1.0 / 1.21645100408832e17  ; hs = hs * x2 + 1.0 / 3.55687428096e14  ; ps = ((hs * x2) * x2 * x2 * x2 * x2 * x2 * x2) + ps;
    s = x + x * x2 * ps;
    double pc = 1.0 / 2.0922789888e13  ; pc = pc * x2 - 1.0 / 87178291200.0; pc = pc * x2 + 1.0 / 479001600.0; pc = pc * x2 - 1.0 / 3628800.0; pc = pc * x2 + 1.0 / 40320.0; pc = pc * x2 - 1.0 / 720.0; pc = pc * x2 + 1.0 / 24.0; pc = pc * x2 - 0.5;
    double hc = 1.0 / 2.43290200817664e18  ; hc = hc * x2 - 1.0 / 6.402373705728e15  ; pc = ((hc * x2) * x2 * x2 * x2 * x2 * x2 * x2 * x2) + pc;
    c = 1.0 + x2 * pc;
}
__device__ __forceinline__ double dexp_(double x) {
    const double ln2 = 0.6931471805599453094; const double kf = __builtin_rint(x * 1.4426950408889634074); const double r = x - kf * ln2;
    double t = 1.0 / 6227020800.0; t = t * r + 1.0 / 479001600.0; t = t * r + 1.0 / 39916800.0; t = t * r + 1.0 / 3628800.0; t = t * r + 1.0 / 362880.0; t = t * r + 1.0 / 40320.0; t = t * r + 1.0 / 5040.0;
    t = t * r + 1.0 / 720.0; t = t * r + 1.0 / 120.0; t = t * r + 1.0 / 24.0; t = t * r + 1.0 / 6.0; t = t * r + 0.5; t = t * r + 1.0; t = t * r + 1.0;
    const int ki = (int)kf; const long long bits = (long long)(1023 + ki) << 52;
    return t * __builtin_bit_cast(double, bits);
}

__device__ __forceinline__ void phase0(const Args& a, LAS unsigned char* lds) {
    const int tid = threadIdx.x, lane = tid & 63, wave = tid >> 6, G = gridDim.x;
    const int gw = blockIdx.x * 8 + wave, NGW = G * 8;
    unsigned char* ws = a.ws;
    LAS float* scr = (LAS float*)(lds + wave * 16384);
    for (int it = gw; it < 16 * 128; it += NGW)
        transpose_item(a.in[I_WIN], INC, a.in[I_MIXN], 64 * (it / 128), 32 * (it % 128), (bf16_t*)(ws + WS_WIN), 1024, 32 * (it % 128), 64 * (it / 128), scr, lane);
    {
        const int gt = blockIdx.x * 512 + tid, NT = G * 512;
        bf16_t* WL = (bf16_t*)(ws + WS_WLORA); bf16_t* WR = (bf16_t*)(ws + WS_WR);
        for (int c = gt; c < 1536 * 32 + 48 * 128; c += NT) {
            float v[8];
            if (c < 1536 * 32) { const int n = c >> 5, k0 = (c & 31) * 8;
#pragma unroll
                for (int i = 0; i < 8; ++i) { const int k = k0 + i; float x = 0.f;
                    if (n < 512) { if (k < 64) x = a.in[I_WUP][k * 512 + n]; }
                    else if (n < 1024) { if (k >= 64 && k < 128) x = a.in[I_AUP][(k - 64) * 512 + (n - 512)]; }
                    else { if (k >= 128) x = a.in[I_GUP][(k - 128) * 512 + (n - 1024)]; }
                    v[i] = x; }
                u32x4 o; o.x = pk2(v[0], v[1]); o.y = pk2(v[2], v[3]); o.z = pk2(v[4], v[5]); o.w = pk2(v[6], v[7]); *(u32x4*)(WL + (size_t)n * 256 + k0) = o;
            } else { const int cc = c - 1536 * 32, j = cc >> 7, k0 = (cc & 127) * 8;
#pragma unroll
                for (int i = 0; i < 8; ++i) { const int k = k0 + i; float x = 0.f;
                    if (j < 4) x = a.in[I_RGW][k * 4 + j] * a.in[I_FFNN][k]; else if (j < 36) x = a.in[I_REW][k * 32 + (j - 4)] * a.in[I_FFNN][k];
                    v[i] = x; }
                u32x4 o; o.x = pk2(v[0], v[1]); o.y = pk2(v[2], v[3]); o.z = pk2(v[4], v[5]); o.w = pk2(v[6], v[7]); *(u32x4*)(WR + (size_t)j * 1024 + k0) = o; }
        }
    }
    {
        bf16_t* HN = (bf16_t*)a.out;
        for (int m0 = gw; m0 < T; m0 += 2 * NGW) {
            f32x4 v[2][4]; float s[2] = {0.f, 0.f};
#pragma unroll
            for (int u = 0; u < 2; ++u) { const f32x4* xr = (const f32x4*)(a.in[I_X] + (size_t)(m0 + u * NGW) * DM) + lane;
#pragma unroll
                for (int j = 0; j < 4; ++j) v[u][j] = xr[64 * j]; }
#pragma unroll
            for (int u = 0; u < 2; ++u) {
#pragma unroll
                for (int j = 0; j < 4; ++j) s[u] += (v[u][j][0] * v[u][j][0] + v[u][j][1] * v[u][j][1]) + (v[u][j][2] * v[u][j][2] + v[u][j][3] * v[u][j][3]);
                const float rs = 1.0f / sqrtf(wave_sum(s[u]) * (1.0f / DM) + 1e-6f);
                u32x2* o = (u32x2*)(HN + (size_t)(m0 + u * NGW) * DM) + lane;
#pragma unroll
                for (int j = 0; j < 4; ++j) { u32x2 w; w.x = pk2(v[u][j][0] * rs, v[u][j][1] * rs); w.y = pk2(v[u][j][2] * rs, v[u][j][3] * rs); o[64 * j] = w; }
            }
        }
    }
    for (int vb = blockIdx.x; vb < 256; vb += G) {
        __syncthreads();
        const int g = vb & 15, part = vb >> 4;
        LAS float* Pre = (LAS float*)lds;
        LAS float* Pim = Pre + 33 * 64;
        LAS float* Bre = Pim + 33 * 64;
        LAS float* Bim = Bre + 64 * 16;
        LAS float* Cre = Bim + 64 * 16;
        LAS float* Cim = Cre + 16 * 64;
        if (tid < 64) {
            const int n = tid; const double lr = (double)a.in[I_LRE][g * 64 + n], li = (double)a.in[I_LIM][g * 64 + n];
            const double dt = dexp_((double)a.in[I_LDT][g]);
            const double mag = dexp_(lr * dt); double ang = li * dt; const double twopi = 6.283185307179586477; ang -= __builtin_rint(ang * 0.15915494309189533577) * twopi;
            double sn, cs; dsincos_reduced(ang, sn, cs);
            const double lre = mag * cs, lim = mag * sn;
            const double nr = lre - 1.0, ni = lim, den = lr * lr + li * li; const double rden = 1.0 / den;
            const double cfr = (nr * lr + ni * li) * rden, cfi = (ni * lr - nr * li) * rden;
            for (int c = 0; c < 16; ++c) { const double br = (double)a.in[I_BRE][(g * 64 + n) * 16 + c], bi = (double)a.in[I_BIM][(g * 64 + n) * 16 + c];
                Bre[n * 16 + c] = (float)(cfr * br - cfi * bi); Bim[n * 16 + c] = (float)(cfr * bi + cfi * br); }
            double pr = 1.0, pi = 0.0;
            for (int tau = 0; tau <= 32; ++tau) { Pre[tau * 64 + n] = (float)pr; Pim[tau * 64 + n] = (float)pi; const double t2 = pr * lre - pi * lim; pi = pr * lim + pi * lre; pr = t2; }
            if (part == 0) ((f32x2*)(ws + WS_LAML))[g * 64 + n] = (f32x2){Pre[32 * 64 + n], Pim[32 * 64 + n]};
        }
        for (int i = tid; i < 1024; i += 512) { Cre[i] = a.in[I_CRE][g * 1024 + i]; Cim[i] = a.in[I_CIM][g * 1024 + i]; }
        __syncthreads();
        float* KG = (float*)(ws + WS_KG) + (size_t)g * 32 * 256;
        { const int e = part * 512 + tid; const int tau = e >> 8, co = (e >> 4) & 15, ci = e & 15; float s = 0.f;
            for (int n = 0; n < 64; ++n) { const float pr = Pre[tau * 64 + n], pi = Pim[tau * 64 + n], br = Bre[n * 16 + ci], bi = Bim[n * 16 + ci];
                const float qr = pr * br - pi * bi, qi = pr * bi + pi * br; s += Cre[co * 64 + n] * qr - Cim[co * 64 + n] * qi; }
            KG[e] = s; }
        bf16_t* TZ = (bf16_t*)(ws + WS_TZ) + (size_t)g * S5N * S5K;
        { const int e = part * 512 + tid; const int row = e >> 4, m0 = (e & 15) * 8, j = row >> 4, co = row & 15; float v[8];
#pragma unroll
            for (int i = 0; i < 8; ++i) { const int m = m0 + i, n = m & 63; const float pr = Pre[(j + 1) * 64 + n], pi = Pim[(j + 1) * 64 + n], cr = Cre[co * 64 + n], ci = Cim[co * 64 + n];
                v[i] = (m < 64) ? (cr * pr - ci * pi) : -(cr * pi + ci * pr); }
            u32x4 o; o.x = pk2(v[0], v[1]); o.y = pk2(v[2], v[3]); o.z = pk2(v[4], v[5]); o.w = pk2(v[6], v[7]); *(u32x4*)(TZ + (size_t)row * S5K + 512 + m0) = o; }
        bf16_t* W1 = (bf16_t*)(ws + WS_W1) + (size_t)g * 256 * 512;
        for (int e = part * 1024 + tid; e < part * 1024 + 1024; e += 512) { const int m = e >> 6, s = (e & 63) >> 1, ci0 = (e & 1) * 8; float v[8];
#pragma unroll
            for (int i = 0; i < 8; ++i) { float x = 0.f;
                if (m < 128) { const int n = m & 63; const float pr = Pre[(31 - s) * 64 + n], pi = Pim[(31 - s) * 64 + n], br = Bre[n * 16 + ci0 + i], bi = Bim[n * 16 + ci0 + i];
                    x = (m < 64) ? (pr * br - pi * bi) : (pr * bi + pi * br); }
                v[i] = x; }
            u32x4 o; o.x = pk2(v[0], v[1]); o.y = pk2(v[2], v[3]); o.z = pk2(v[4], v[5]); o.w = pk2(v[6], v[7]); *(u32x4*)(W1 + (size_t)m * 512 + s * 16 + ci0) = o; }
    }
    __syncthreads();
}

__device__ __forceinline__ void phase2(const Args& a) {
    const int gt = blockIdx.x * 512 + threadIdx.x, NT = gridDim.x * 512;
    unsigned char* ws = a.ws;
    const bf16_t* COLS = (const bf16_t*)(ws + WS_A); bf16_t* LIN = (bf16_t*)(ws + WS_Z);
    const float* mu = a.in[I_MU];
    for (int p = gt; p < T * 32; p += NT) {
        const int t = p >> 5, q = p & 31;
        {
            const int c8 = q * 8, src = C_WD + c8; float cur[8], prv[8], o[8];
            unpack8(*(const u32x4*)(COLS + (size_t)t * INC + src), cur);
            if ((t & (SEQ - 1)) != 0) unpack8(*(const u32x4*)(COLS + (size_t)(t - 1) * INC + src), prv);
            else {
#pragma unroll
                for (int i = 0; i < 8; ++i) prv[i] = 0.f; }
#pragma unroll
            for (int i = 0; i < 8; ++i) { const float xs = cur[i] + (prv[i] - cur[i]) * mu[src + i]; o[i] = (c8 < 64) ? tanhf_(xs) : ((c8 < 128) ? xs : sigmoidf_(xs)); }
            *(u32x4*)(LIN + (size_t)t * 256 + c8) = pack8(o);
        }
    }
    const float* KG = (const float*)(ws + WS_KG); bf16_t* TZ = (bf16_t*)(ws + WS_TZ);
    for (int p = gt; p < 16 * 512 * 64; p += NT) {
        const int g = p >> 15, row = (p >> 6) & 511, kc = p & 63, j = row >> 4, co = row & 15, s = kc >> 1, ci0 = (kc & 1) * 8;
        u32x4 o = (u32x4){0u, 0u, 0u, 0u};
        if (s <= j) { const float* k = KG + (((size_t)g * 32 + (j - s)) * 16 + co) * 16 + ci0; const f32x4 k0 = *(const f32x4*)k, k1 = *(const f32x4*)(k + 4);
            o.x = pk2(k0[0], k0[1]); o.y = pk2(k0[2], k0[3]); o.z = pk2(k1[0], k1[1]); o.w = pk2(k1[2], k1[3]); }
        *(u32x4*)(TZ + ((size_t)g * S5N + row) * S5K + kc * 8) = o;
    }
}

__device__ __forceinline__ void phase4(const Args& a, LAS unsigned char* lds) {
    const int tid = threadIdx.x, lane = tid & 63, wave = tid >> 6;
    unsigned char* ws = a.ws;
    TSTART(4); TSTART(1);
    for (int item = blockIdx.x; item < 256; item += gridDim.x) {
        if (tid < 64) {
            const int b = item >> 4, g = item & 15, n = tid;
            const f32x2 lamL = ((const f32x2*)(ws + WS_LAML))[g * 64 + n];
            const float* E = (const float*)(ws + WS_E) + ((size_t)g * S5ROWS + b * S5NCH) * 128;
            bf16_t* UG = (bf16_t*)(ws + WS_UG) + ((size_t)g * S5ROWS + b * S5NCH) * S5K + 512;
            float xr = 0.f, xi = 0.f;
#pragma unroll 2
            for (int ch = 0; ch < S5NCH; ++ch) {
                UG[(size_t)ch * S5K + n] = (bf16_t)f2bf(xr); UG[(size_t)ch * S5K + 64 + n] = (bf16_t)f2bf(xi);
                const float er = E[ch * 128 + n], ei = E[ch * 128 + 64 + n];
                const float nr = lamL[0] * xr - lamL[1] * xi + er, ni = lamL[0] * xi + lamL[1] * xr + ei; xr = nr; xi = ni;
            }
        }
    }
    TSTOP(1);
    const bf16_t* COLS = (const bf16_t*)(ws + WS_A); const bf16_t* LORA = (const bf16_t*)a.out;
    float* Y = (float*)(ws + WS_B); float* BON = (float*)(ws + WS_BON);
    LAS float* VECF = (LAS float*)lds;
    LAS float* VKP = (LAS float*)(lds + 81920);
    LAS float* BETA = (LAS float*)(lds + 98304);
    LAS float* YST = (LAS float*)(lds + 98816);
    for (int item = blockIdx.x; item < 256; item += gridDim.x) {
        const int bh = item >> 1, half = item & 1, b = bh >> 3, h = bh & 7;
        const int pj = tid >> 4, pq = tid & 15, hc = h * 64 + 4 * pq;
        float mur[4], muk[4], muv[4], kk4[4], ka4[4], rk4[4];
#pragma unroll
        for (int i = 0; i < 4; ++i) { mur[i] = a.in[I_MU][C_R + hc + i]; muk[i] = a.in[I_MU][C_K + hc + i]; muv[i] = a.in[I_MU][C_V + hc + i];
            kk4[i] = a.in[I_KK][hc + i]; ka4[i] = a.in[I_KA][hc + i]; rk4[i] = a.in[I_RK][hc + i]; }
        const int rr = lane >> 4, cl = lane & 15;
        const bool vmine = (pq >> 3) == half;
        const int qv = pq & 7;
        u32x2 rc, rp, kc, kp, kn, vc, vp, e4, a4;
        const u32x2 zero2 = (u32x2){0u, 0u};
        __syncthreads();
#define WKV_LOAD(chunk) do { const int s_ = (chunk) * 32 + pj; const size_t t_ = (size_t)b * SEQ + s_; const bf16_t* cb_ = COLS + t_ * INC + hc; \
            rc = *(const u32x2*)(cb_ + C_R); kc = *(const u32x2*)(cb_ + C_K); vc = *(const u32x2*)(cb_ + C_V); \
            if (s_ > 0) { rp = *(const u32x2*)(cb_ - INC + C_R); kp = *(const u32x2*)(cb_ - INC + C_K); vp = *(const u32x2*)(cb_ - INC + C_V); } else { rp = zero2; kp = zero2; vp = zero2; } \
            if (s_ < SEQ - 1) kn = *(const u32x2*)(cb_ + INC + C_K); else kn = zero2; \
            e4 = *(const u32x2*)(LORA + t_ * 1536 + hc); a4 = *(const u32x2*)(LORA + t_ * 1536 + 512 + hc); } while (0)
#define WKV_PREP(chunk, bi) do { float r_[4], rq_[4], k_[4], kq_[4], kx_[4], v_[4], vq_[4], e_[4], aa_[4]; unpack4(rc, r_); unpack4(rp, rq_); unpack4(kc, k_); unpack4(kp, kq_); unpack4(kn, kx_); unpack4(vc, v_); unpack4(vp, vq_); unpack4(e4, e_); unpack4(a4, aa_); \
            float kkv_[4], kkn_[4], k2_[4], ss_ = 0.f, ssn_ = 0.f; \
            _Pragma("unroll") for (int i = 0; i < 4; ++i) { r_[i] += (rq_[i] - r_[i]) * mur[i]; kx_[i] += (k_[i] - kx_[i]) * muk[i]; k_[i] += (kq_[i] - k_[i]) * muk[i]; v_[i] += (vq_[i] - v_[i]) * muv[i]; \
                kkv_[i] = k_[i] * kk4[i]; ss_ += kkv_[i] * kkv_[i]; kkn_[i] = kx_[i] * kk4[i]; ssn_ += kkn_[i] * kkn_[i]; k2_[i] = k_[i] * (1.0f + (aa_[i] - 1.0f) * ka4[i]); } \
            ss_ = row16_sum(ss_); ssn_ = row16_sum(ssn_); \
            const float inv_ = __builtin_amdgcn_rsqf(fmaxf(ss_, 1e-24f)), invn_ = __builtin_amdgcn_rsqf(fmaxf(ssn_, 1e-24f)); \
            float bv_[4], an_[4], w_[4], cv_[4], bon_ = 0.f, beta_ = 0.f, kap_ = 0.f; \
            _Pragma("unroll") for (int i = 0; i < 4; ++i) { bv_[i] = kkv_[i] * inv_ * aa_[i]; an_[i] = -kkn_[i] * invn_; w_[i] = __expf(-e_[i]); cv_[i] = w_[i] * an_[i]; \
                bon_ += r_[i] * k2_[i] * rk4[i]; beta_ += bv_[i] * an_[i]; kap_ += k2_[i] * an_[i]; } \
            bon_ = row16_sum(bon_); beta_ = row16_sum(beta_); kap_ = row16_sum(kap_); \
            if (pq == 0 && half == 0) BON[((size_t)b * SEQ + (chunk) * 32 + pj) * 8 + h] = bon_; \
            LAS float* vf_ = VECF + (bi) * 10240 + pj * 64 + 4 * pq; \
            *(LAS f32x4*)vf_ = (f32x4){w_[0], w_[1], w_[2], w_[3]}; *(LAS f32x4*)(vf_ + 2048) = (f32x4){cv_[0], cv_[1], cv_[2], cv_[3]}; *(LAS f32x4*)(vf_ + 4096) = (f32x4){bv_[0], bv_[1], bv_[2], bv_[3]}; \
            *(LAS f32x4*)(vf_ + 6144) = (f32x4){k2_[0], k2_[1], k2_[2], k2_[3]}; *(LAS f32x4*)(vf_ + 8192) = (f32x4){r_[0], r_[1], r_[2], r_[3]}; \
            if (pq == 0) *(LAS f32x2*)(BETA + ((bi) * 32 + pj) * 2) = (f32x2){beta_, beta_}; \
            if (vmine) { LAS float* kp_ = VKP + ((((bi) * 32 + pj) * 4 + (qv >> 1)) * 4) * 4 + (qv & 1); \
                _Pragma("unroll") for (int i = 0; i < 4; ++i) { kp_[i * 4] = v_[i]; kp_[i * 4 + 2] = v_[i] * kap_; } } } while (0)
        WKV_LOAD(0); WKV_PREP(0, 0);
        __syncthreads();
        float ltv[32];
#pragma unroll
        for (int i = 0; i < 32; ++i) ltv[i] = 0.f;
        f32x2 Q0 = {0.f, 0.f}, Q1 = Q0, Q2 = Q0, Q3 = Q0, SA = Q0, YP = Q0; float yselA = 0.f, yselB = 0.f; const int clp = (cl + 1) & 15;
        for (int chunk = 0; chunk < SEQ / 32; ++chunk) {
            const int bi = chunk & 1;
            TSTART(3);
            if (chunk > 1) { const LAS float* ys = YST + (((chunk - 2) & 3) * 32 + pj) * 33 + 2 * pq;
                *(f32x2*)(Y + ((size_t)b * SEQ + (chunk - 2) * 32 + pj) * 512 + h * 64 + 32 * half + 2 * pq) = (f32x2){ys[0], ys[1]}; }
            if (chunk + 1 < SEQ / 32) WKV_LOAD(chunk + 1);
            TSTOP(3); TSTART(2);
            if (__builtin_amdgcn_readfirstlane(wave) < 4) {
            const LAS float* vecp = VECF + bi * 10240 + 4 * cl; const LAS float* vkp = VKP + ((bi * 32 * 4 + wave) * 4 + rr) * 4; const LAS float* btp = BETA + bi * 64;
            LAS float* ysp = YST + ((chunk & 3) * 32 + cl) * 33 + 8 * wave + rr;
            LAS float* ysp_prev = YST + (((chunk + 3) & 3) * 32 + 16 + cl) * 33 + 8 * wave + rr;
            f32x4 w4 = *(const LAS f32x4*)vecp, c4 = *(const LAS f32x4*)(vecp + 2048), b4 = *(const LAS f32x4*)(vecp + 4096), k4 = *(const LAS f32x4*)(vecp + 6144), r4 = *(const LAS f32x4*)(vecp + 8192);
            f32x4 vk = *(const LAS f32x4*)vkp; f32x2 be = *(const LAS f32x2*)btp;
#pragma unroll 2
            for (int j = 0; j < 32; ++j) {
                const int jn = (j + 1) & 31;
                const f32x4 w4n = *(const LAS f32x4*)(vecp + jn * 64), c4n = *(const LAS f32x4*)(vecp + 2048 + jn * 64), b4n = *(const LAS f32x4*)(vecp + 4096 + jn * 64);
                const f32x4 k4n = *(const LAS f32x4*)(vecp + 6144 + jn * 64), r4n = *(const LAS f32x4*)(vecp + 8192 + jn * 64), vkn = *(const LAS f32x4*)(vkp + jn * 64);
                const f32x2 ben = *(const LAS f32x2*)(btp + jn * 2);
                const f32x2 w01 = __builtin_shufflevector(w4, w4, 0, 1), w23 = __builtin_shufflevector(w4, w4, 2, 3), c01 = __builtin_shufflevector(c4, c4, 0, 1), c23 = __builtin_shufflevector(c4, c4, 2, 3);
                const f32x2 b01 = __builtin_shufflevector(b4, b4, 0, 1), b23 = __builtin_shufflevector(b4, b4, 2, 3), k01 = __builtin_shufflevector(k4, k4, 0, 1), k23 = __builtin_shufflevector(k4, k4, 2, 3);
                const f32x2 r01 = __builtin_shufflevector(r4, r4, 0, 1), r23 = __builtin_shufflevector(r4, r4, 2, 3), VP = __builtin_shufflevector(vk, vk, 0, 1), VK2 = __builtin_shufflevector(vk, vk, 2, 3);
                f32x2 YN;
                asm volatile(
                    "v_pk_mul_f32 v[250:251], %[Q0], %[c01] op_sel_hi:[1,0]\n\t"
                    "v_pk_mul_f32 %[Q0], %[Q0], %[w01] op_sel_hi:[1,0]\n\t"
                    "v_add_f32_dpp %[yA], %[yA], %[yA] quad_perm:[1,0,3,2] row_mask:0xf bank_mask:0xf bound_ctrl:1\n\t"
                    "v_pk_fma_f32 v[250:251], %[Q1], %[c01], v[250:251] op_sel:[0,1,0] op_sel_hi:[1,1,1]\n\t"
                    "v_pk_mul_f32 %[Q1], %[Q1], %[w01] op_sel:[0,1] op_sel_hi:[1,1]\n\t"
                    "v_add_f32_dpp %[yB], %[yB], %[yB] quad_perm:[1,0,3,2] row_mask:0xf bank_mask:0xf bound_ctrl:1\n\t"
                    "v_pk_fma_f32 v[250:251], %[Q2], %[c23], v[250:251] op_sel_hi:[1,0,1]\n\t"
                    "v_pk_mul_f32 %[Q2], %[Q2], %[w23] op_sel_hi:[1,0]\n\t"
                    "v_add_f32_dpp %[yA], %[yA], %[yA] quad_perm:[2,3,0,1] row_mask:0xf bank_mask:0xf bound_ctrl:1\n\t"
                    "v_pk_fma_f32 v[250:251], %[Q3], %[c23], v[250:251] op_sel:[0,1,0] op_sel_hi:[1,1,1]\n\t"
                    "v_pk_mul_f32 %[Q3], %[Q3], %[w23] op_sel:[0,1] op_sel_hi:[1,1]\n\t"
                    "v_add_f32_dpp %[yB], %[yB], %[yB] quad_perm:[2,3,0,1] row_mask:0xf bank_mask:0xf bound_ctrl:1\n\t"
                    "v_pk_fma_f32 %[Q0], %[VP], %[k01], %[Q0] op_sel_hi:[1,0,1]\n\t"
                    "v_add_f32_dpp v250, v250, v250 quad_perm:[1,0,3,2] row_mask:0xf bank_mask:0xf bound_ctrl:1\n\t"
                    "v_pk_fma_f32 %[Q1], %[VP], %[k01], %[Q1] op_sel:[0,1,0] op_sel_hi:[1,1,1]\n\t"
                    "v_add_f32_dpp v251, v251, v251 quad_perm:[1,0,3,2] row_mask:0xf bank_mask:0xf bound_ctrl:1\n\t"
                    "v_pk_fma_f32 %[Q2], %[VP], %[k23], %[Q2] op_sel_hi:[1,0,1]\n\t"
                    "v_add_f32_dpp %[yA], %[yA], %[yA] row_half_mirror row_mask:0xf bank_mask:0xf bound_ctrl:1\n\t"
                    "v_pk_fma_f32 %[Q3], %[VP], %[k23], %[Q3] op_sel:[0,1,0] op_sel_hi:[1,1,1]\n\t"
                    "v_add_f32_dpp v250, v250, v250 quad_perm:[2,3,0,1] row_mask:0xf bank_mask:0xf bound_ctrl:1\n\t"
                    "v_pk_fma_f32 %[Q0], %[SA], %[b01], %[Q0] op_sel_hi:[1,0,1]\n\t"
                    "v_add_f32_dpp v251, v251, v251 quad_perm:[2,3,0,1] row_mask:0xf bank_mask:0xf bound_ctrl:1\n\t"
                    "v_pk_fma_f32 %[Q1], %[SA], %[b01], %[Q1] op_sel:[0,1,0] op_sel_hi:[1,1,1]\n\t"
                    "v_add_f32_dpp %[yB], %[yB], %[yB] row_half_mirror row_mask:0xf bank_mask:0xf bound_ctrl:1\n\t"
                    "v_pk_fma_f32 %[Q2], %[SA], %[b23], %[Q2] op_sel_hi:[1,0,1]\n\t"
                    "v_add_f32_dpp v250, v250, v250 row_half_mirror row_mask:0xf bank_mask:0xf bound_ctrl:1\n\t"
                    "v_pk_fma_f32 %[Q3], %[SA], %[b23], %[Q3] op_sel:[0,1,0] op_sel_hi:[1,1,1]\n\t"
                    "v_add_f32_dpp v251, v251, v251 row_half_mirror row_mask:0xf bank_mask:0xf bound_ctrl:1\n\t"
                    "v_pk_mul_f32 %[YN], %[Q0], %[r01] op_sel_hi:[1,0]\n\t"
                    "v_add_f32_dpp %[yA], %[yA], %[yA] row_mirror row_mask:0xf bank_mask:0xf bound_ctrl:1\n\t"
                    "v_pk_fma_f32 %[YN], %[Q1], %[r01], %[YN] op_sel:[0,1,0] op_sel_hi:[1,1,1]\n\t"
                    "v_add_f32_dpp v250, v250, v250 row_mirror row_mask:0xf bank_mask:0xf bound_ctrl:1\n\t"
                    "v_add_f32_dpp %[yB], %[yB], %[yB] row_mirror row_mask:0xf bank_mask:0xf bound_ctrl:1\n\t"
                    "v_add_f32_dpp v251, v251, v251 row_mirror row_mask:0xf bank_mask:0xf bound_ctrl:1\n\t"
                    "v_pk_fma_f32 %[YN], %[Q2], %[r23], %[YN] op_sel_hi:[1,0,1]\n\t"
                    "s_nop 0\n\t"
                    "v_pk_fma_f32 %[YN], %[Q3], %[r23], %[YN] op_sel:[0,1,0] op_sel_hi:[1,1,1]\n\t"
                    "v_pk_add_f32 v[250:251], v[250:251], %[VK2]\n\t"
                    "s_nop 0\n\t"
                    "v_pk_fma_f32 %[SA], %[SA], %[be], v[250:251]\n\t"
                    : [Q0] "+v"(Q0), [Q1] "+v"(Q1), [Q2] "+v"(Q2), [Q3] "+v"(Q3), [SA] "+v"(SA), [YN] "=&v"(YN), [yA] "+v"(YP[0]), [yB] "+v"(YP[1])
                    : [c01] "v"(c01), [c23] "v"(c23), [w01] "v"(w01), [w23] "v"(w23), [k01] "v"(k01), [k23] "v"(k23), [b01] "v"(b01), [b23] "v"(b23), [r01] "v"(r01), [r23] "v"(r23),
                      [VP] "v"(VP), [VK2] "v"(VK2), [be] "v"(be)
                    : "v250", "v251");
                const bool mine = (j & 15) == clp;
                yselA = mine ? YP[0] : yselA; yselB = mine ? YP[1] : yselB;
                if ((j & 15) == 0) { LAS float* yq = (j == 0) ? ysp_prev : ysp; yq[0] = yselA; yq[4] = yselB; }
                YP = YN;
                w4 = w4n; c4 = c4n; b4 = b4n; k4 = k4n; r4 = r4n; vk = vkn; be = ben;
            }
            }
            else if (item < (int)gridDim.x) {
                const int wv4 = __builtin_amdgcn_readfirstlane(wave) - 4; LAS float* lscr = (LAS float*)(lds + (wv4 < 3 ? 131584 + wv4 * 8448 : 115712));
                const int lit_prev = (chunk - 1) * (int)(gridDim.x * 4) + (int)blockIdx.x * 4 + wv4, lit = lit_prev + (int)(gridDim.x * 4);
                if (chunk > 0 && lit_prev < N_LATE) { const TrDesc d = late_desc(a, lit_prev); tr_store(d, ltv, lscr, lane); }
                if (lit < N_LATE) { const TrDesc d = late_desc(a, lit); tr_load(d, ltv, lane); }
            }
            TSTOP(2); TSTART(3);
            if (chunk + 1 < SEQ / 32) WKV_PREP(chunk + 1, bi ^ 1);
            __syncthreads();
            TSTOP(3);
        }
        if (__builtin_amdgcn_readfirstlane(wave) < 4) {
            const float ya = row16_sum(YP[0]), yb = row16_sum(YP[1]);
            if (cl == 15) { yselA = ya; yselB = yb; }
            LAS float* yq = YST + ((((SEQ / 32) - 1) & 3) * 32 + 16 + cl) * 33 + 8 * wave + rr; yq[0] = yselA; yq[4] = yselB;
        }
        __syncthreads();
#pragma unroll
        for (int cc = SEQ / 32 - 2; cc < SEQ / 32; ++cc) { const LAS float* ys = YST + ((cc & 3) * 32 + pj) * 33 + 2 * pq;
            *(f32x2*)(Y + ((size_t)b * SEQ + cc * 32 + pj) * 512 + h * 64 + 32 * half + 2 * pq) = (f32x2){ys[0], ys[1]}; }
#undef WKV_LOAD
#undef WKV_PREP
    }
    TSTOP(4);
}


__device__ __forceinline__ void late_items_idle(const Args& a, LAS unsigned char* lds, int lo, int hi, int first_idle) {
    if ((int)blockIdx.x < first_idle) return;
    const int lane = threadIdx.x & 63, wave = __builtin_amdgcn_readfirstlane(threadIdx.x >> 6);
    float ltv[32]; LAS float* lscr = (LAS float*)(lds + wave * 16384);
    for (int it = lo + ((int)blockIdx.x - first_idle) * 8 + wave; it < hi; it += ((int)gridDim.x - first_idle) * 8) { const TrDesc d = late_desc(a, it); tr_load(d, ltv, lane); tr_store(d, ltv, lscr, lane); }
}

typedef float f32x16 __attribute__((ext_vector_type(16)));
template <int KSTEPS>
__device__ __forceinline__ f32x16 mm32(f32x16 acc, const LAS bf16_t* A, int lda, const LAS bf16_t* Bt, int ldb, int lane) {
    const int r = lane & 31, h = lane >> 5;
    const LAS bf16_t* ap = A + r * lda + 8 * h; const LAS bf16_t* bp = Bt + r * ldb + 8 * h;
#pragma unroll
    for (int ks = 0; ks < KSTEPS; ++ks) acc = __builtin_amdgcn_mfma_f32_32x32x16_bf16(*(const LAS bf16x8*)(ap + 16 * ks), *(const LAS bf16x8*)(bp + 16 * ks), acc, 0, 0, 0);
    return acc;
}
#define TROW(i, lane) (((i) & 3) + 8 * ((i) >> 2) + 4 * ((lane) >> 5))
__device__ __forceinline__ unsigned short bf1(float f) { return (unsigned short)f2bf(f); }

__device__ __forceinline__ void phase4c(const Args& a, LAS unsigned char* lds) {
    const int tid = threadIdx.x, lane = tid & 63, wave = __builtin_amdgcn_readfirstlane(tid >> 6);
    unsigned char* ws = a.ws;
    TSTART(4); TSTART(1);
    for (int item = blockIdx.x; item < 256; item += gridDim.x) {
        if (tid < 64) {
            const int b = item >> 4, g = item & 15, n = tid;
            const f32x2 lamL = ((const f32x2*)(ws + WS_LAML))[g * 64 + n];
            const float* E = (const float*)(ws + WS_E) + ((size_t)g * S5ROWS + b * S5NCH) * 128;
            bf16_t* UG = (bf16_t*)(ws + WS_UG) + ((size_t)g * S5ROWS + b * S5NCH) * S5K + 512;
            float xr = 0.f, xi = 0.f;
#pragma unroll 8
            for (int ch = 0; ch < S5NCH; ++ch) {
                UG[(size_t)ch * S5K + n] = (bf16_t)f2bf(xr); UG[(size_t)ch * S5K + 64 + n] = (bf16_t)f2bf(xi);
                const float er = E[ch * 128 + n], ei = E[ch * 128 + 64 + n];
                const float nr = lamL[0] * xr - lamL[1] * xi + er, ni = lamL[0] * xi + lamL[1] * xr + ei; xr = nr; xi = ni;
            }
        }
    }
    TSTOP(1);
    if (gridDim.x != 256) { late_items_idle(a, lds, 0, N_LATE, 0); __syncthreads(); }
    const bf16_t* COLS = (const bf16_t*)(ws + WS_A); const bf16_t* LORA = (const bf16_t*)a.out;
    float* Y = (float*)(ws + WS_B); float* BON = (float*)(ws + WS_BON);
    LAS float* CUM = (LAS float*)lds;
    LAS float* PS = (LAS float*)(lds + 8192);
    LAS bf16_t* AT = (LAS bf16_t*)(lds + 10240);
    LAS bf16_t* BT = (LAS bf16_t*)(lds + 14848);
    LAS bf16_t* KT = (LAS bf16_t*)(lds + 19456);
    LAS bf16_t* RT = (LAS bf16_t*)(lds + 24064);
    LAS bf16_t* BTt = (LAS bf16_t*)(lds + 28672);
    LAS bf16_t* VmT = (LAS bf16_t*)(lds + 33792);
    LAS float* NabT = (LAS float*)(lds + 36352);
    LAS float* Nak = (LAS float*)(lds + 40960);
    LAS bf16_t* MbrT = (LAS bf16_t*)(lds + 45184);
    LAS bf16_t* A2 = (LAS bf16_t*)(lds + 47744);
    LAS bf16_t* NT = (LAS bf16_t*)(lds + 52864);
    LAS bf16_t* WyT = (LAS bf16_t*)(lds + 55424);
    LAS bf16_t* WzT = (LAS bf16_t*)(lds + 57984);
    LAS bf16_t* R2T = (LAS bf16_t*)(lds + 63104);
    LAS bf16_t* PpT = (LAS bf16_t*)(lds + 67712);
    LAS float* GC = (LAS float*)(lds + 76928);
    LAS bf16_t* SBF = (LAS bf16_t*)(lds + 77184);
    LAS float* YST = (LAS float*)(lds + 86400);
    for (int item = blockIdx.x; item < 256; item += gridDim.x) {
        const int bh = item >> 1, half = item & 1, b = bh >> 3, h = bh & 7;
        const int pj = tid >> 4, pq = tid & 15, hc = h * 64 + 4 * pq;
        const bool vmine = (pq >> 3) == half;
        u32x2 rc, rp, kc, kp, vc, vp, e4, a4;
        const u32x2 zero2 = (u32x2){0u, 0u};
        f32x16 Sacc;
#pragma unroll
        for (int i = 0; i < 16; ++i) Sacc[i] = 0.f;
        __syncthreads();
        for (int i = tid; i < 2 * 32 * 72 / 2; i += 512) ((LAS unsigned*)SBF)[i] = 0u;
#define WKV_LOAD(chunk) do { const int s_ = (chunk) * 32 + pj; const size_t t_ = (size_t)b * SEQ + s_; const bf16_t* cb_ = COLS + t_ * INC + hc; \
            rc = *(const u32x2*)(cb_ + C_R); kc = *(const u32x2*)(cb_ + C_K); vc = *(const u32x2*)(cb_ + C_V); \
            if (s_ > 0) { rp = *(const u32x2*)(cb_ - INC + C_R); kp = *(const u32x2*)(cb_ - INC + C_K); vp = *(const u32x2*)(cb_ - INC + C_V); } else { rp = zero2; kp = zero2; vp = zero2; } \
            e4 = *(const u32x2*)(LORA + t_ * 1536 + hc); a4 = *(const u32x2*)(LORA + t_ * 1536 + 512 + hc); } while (0)
        WKV_LOAD(0);
        for (int chunk = 0; chunk < SEQ / 32; ++chunk) {
            const int bi = chunk & 1;
            int tid_l = tid; asm volatile("" : "+v"(tid_l));
            const int lane = tid_l & 63, pj = tid_l >> 4, pq = tid_l & 15, tid = tid_l; (void)tid;
            float r_[4], k_[4], v_[4], e_[4], aa_[4], kkn_[4], k2_[4];
            { float rq_[4], kq_[4], vq_[4];
                const f32x4 mur = *(const f32x4*)(a.in[I_MU] + C_R + hc), muk = *(const f32x4*)(a.in[I_MU] + C_K + hc), muv = *(const f32x4*)(a.in[I_MU] + C_V + hc);
                const f32x4 kk4 = *(const f32x4*)(a.in[I_KK] + hc), ka4 = *(const f32x4*)(a.in[I_KA] + hc), rk4 = *(const f32x4*)(a.in[I_RK] + hc); unpack4(rc, r_); unpack4(rp, rq_); unpack4(kc, k_); unpack4(kp, kq_); unpack4(vc, v_); unpack4(vp, vq_); unpack4(e4, e_); unpack4(a4, aa_);
                float ss_ = 0.f, bon_ = 0.f;
#pragma unroll
                for (int i = 0; i < 4; ++i) { r_[i] += (rq_[i] - r_[i]) * mur[i]; k_[i] += (kq_[i] - k_[i]) * muk[i]; v_[i] += (vq_[i] - v_[i]) * muv[i];
                    kkn_[i] = k_[i] * kk4[i]; ss_ += kkn_[i] * kkn_[i]; k2_[i] = k_[i] * (1.0f + (aa_[i] - 1.0f) * ka4[i]); bon_ += r_[i] * k2_[i] * rk4[i]; }
                ss_ = row16_sum(ss_); bon_ = row16_sum(bon_); const float inv_ = __builtin_amdgcn_rsqf(fmaxf(ss_, 1e-24f));
#pragma unroll
                for (int i = 0; i < 4; ++i) kkn_[i] *= inv_;
                if (pq == 0 && half == 0) BON[((size_t)b * SEQ + chunk * 32 + pj) * 8 + h] = bon_;
                *(LAS f32x4*)(CUM + pj * 64 + 4 * pq) = (f32x4){e_[0], e_[1], e_[2], e_[3]}; }
            if (chunk + 1 < SEQ / 32) WKV_LOAD(chunk + 1);
            __syncthreads();
            {
                const int col = tid & 63, qd = tid >> 6; float e0 = CUM[(4 * qd) * 64 + col], e1 = CUM[(4 * qd + 1) * 64 + col], e2 = CUM[(4 * qd + 2) * 64 + col], e3 = CUM[(4 * qd + 3) * 64 + col];
                e1 += e0; e2 += e1; e3 += e2; PS[qd * 64 + col] = e3;
                __syncthreads();
                float base = 0.f;
#pragma unroll
                for (int q2 = 0; q2 < 7; ++q2) base += (q2 < qd) ? PS[q2 * 64 + col] : 0.f;
                CUM[(4 * qd) * 64 + col] = base + e0; CUM[(4 * qd + 1) * 64 + col] = base + e1; CUM[(4 * qd + 2) * 64 + col] = base + e2; CUM[(4 * qd + 3) * 64 + col] = base + e3; }
            __syncthreads();
            {
                const f32x4 cm = *(const LAS f32x4*)(CUM + pj * 64 + 4 * pq); float at_[4], bt_[4], kt_[4], rt_[4], g_[4];
#pragma unroll
                for (int i = 0; i < 4; ++i) { const float g = __expf(-cm[i]), ig = __expf(cm[i]), gp = __expf(e_[i] - cm[i]); g_[i] = g;
                    at_[i] = -kkn_[i] * gp; bt_[i] = kkn_[i] * aa_[i] * ig; kt_[i] = k2_[i] * ig; rt_[i] = r_[i] * g; }
                *(LAS u32x2*)(AT + pj * 72 + 4 * pq) = (u32x2){cvt_pk_bf16(at_[0], at_[1]), cvt_pk_bf16(at_[2], at_[3])};
                *(LAS u32x2*)(BT + pj * 72 + 4 * pq) = (u32x2){cvt_pk_bf16(bt_[0], bt_[1]), cvt_pk_bf16(bt_[2], bt_[3])};
                *(LAS u32x2*)(KT + pj * 72 + 4 * pq) = (u32x2){cvt_pk_bf16(kt_[0], kt_[1]), cvt_pk_bf16(kt_[2], kt_[3])};
                *(LAS u32x2*)(RT + pj * 72 + 4 * pq) = (u32x2){cvt_pk_bf16(rt_[0], rt_[1]), cvt_pk_bf16(rt_[2], rt_[3])};
#pragma unroll
                for (int i = 0; i < 4; ++i) BTt[(4 * pq + i) * 40 + pj] = bf1(bt_[i]);
                if (vmine) {
#pragma unroll
                    for (int i = 0; i < 4; ++i) VmT[(4 * pq - 32 * half + i) * 40 + pj] = bf1(v_[i]); }
                if (pj == 31) *(LAS f32x4*)(GC + 4 * pq) = (f32x4){g_[0], g_[1], g_[2], g_[3]}; }
            __syncthreads();
            f32x16 accw;
#pragma unroll
            for (int i = 0; i < 16; ++i) accw[i] = 0.f;
            if (wave < 4) {
                f32x16 acc;
#pragma unroll
                for (int i = 0; i < 16; ++i) acc[i] = 0.f;
                acc = mm32<4>(acc, (wave & 1) ? KT : BT, 72, (wave & 2) ? RT : AT, 72, lane);
                const int t = lane & 31;
                if (wave == 0) {
#pragma unroll
                    for (int g4 = 0; g4 < 4; ++g4) { const int s0 = 8 * g4 + 4 * (lane >> 5);
#pragma unroll
                        for (int i = 0; i < 4; ++i) NabT[t * 36 + i * 8 + 2 * g4 + (lane >> 5)] = (s0 + i < t) ? acc[4 * g4 + i] : 0.f; }
                } else if (wave == 1) {
#pragma unroll
                    for (int i = 0; i < 16; ++i) { const int s = TROW(i, lane); Nak[s * 33 + t] = (s < t) ? acc[i] : 0.f; }
                } else if (wave == 2) {
#pragma unroll
                    for (int g4 = 0; g4 < 4; ++g4) { const int s0 = 8 * g4 + 4 * (lane >> 5); float o[4];
#pragma unroll
                        for (int i = 0; i < 4; ++i) o[i] = (s0 + i <= t) ? acc[4 * g4 + i] : 0.f;
                        *(LAS u32x2*)(MbrT + t * 40 + s0) = (u32x2){cvt_pk_bf16(o[0], o[1]), cvt_pk_bf16(o[2], o[3])}; }
                } else {
#pragma unroll
                    for (int i = 0; i < 16; ++i) { const int s = TROW(i, lane); accw[i] = (s <= t) ? acc[i] : 0.f; }
                }
            }
            __syncthreads();
            if (wave < 6) {
                const int q = lane & 3, rowi = ((wave & 3) * 64 + lane) >> 2; const bool isA = wave < 4;
                float xq0, xq1, xq2, xq3, xq4, xq5, xq6, xq7;
                if (isA) {
                    xq0 = __builtin_bit_cast(float, (unsigned)AT[(0 + q) * 72 + rowi] << 16);
                    xq1 = __builtin_bit_cast(float, (unsigned)AT[(4 + q) * 72 + rowi] << 16);
                    xq2 = __builtin_bit_cast(float, (unsigned)AT[(8 + q) * 72 + rowi] << 16);
                    xq3 = __builtin_bit_cast(float, (unsigned)AT[(12 + q) * 72 + rowi] << 16);
                    xq4 = __builtin_bit_cast(float, (unsigned)AT[(16 + q) * 72 + rowi] << 16);
                    xq5 = __builtin_bit_cast(float, (unsigned)AT[(20 + q) * 72 + rowi] << 16);
                    xq6 = __builtin_bit_cast(float, (unsigned)AT[(24 + q) * 72 + rowi] << 16);
                    xq7 = __builtin_bit_cast(float, (unsigned)AT[(28 + q) * 72 + rowi] << 16);
                } else {
                    xq0 = Nak[rowi * 33 + 0 + q];
                    xq1 = Nak[rowi * 33 + 4 + q];
                    xq2 = Nak[rowi * 33 + 8 + q];
                    xq3 = Nak[rowi * 33 + 12 + q];
                    xq4 = Nak[rowi * 33 + 16 + q];
                    xq5 = Nak[rowi * 33 + 20 + q];
                    xq6 = Nak[rowi * 33 + 24 + q];
                    xq7 = Nak[rowi * 33 + 28 + q];
                }
                const bool kq0 = q == 0, kq1 = q == 1, kq2 = q == 2, kq3 = q == 3;
                const LAS float* np_ = NabT + q * 8;
                f32x4 n1_0, n2_0, n3_0, n4_0, n5_0, n6_0, n7_0, n8_0, n9_0, n10_0, n11_0, n12_0, n13_0, n14_0, n15_0, n16_0, n17_0, n17_1, n18_0, n18_1, n19_0, n19_1, n20_0, n20_1, n21_0, n21_1, n22_0, n22_1, n23_0, n23_1, n24_0, n24_1, n25_0, n25_1, n26_0, n26_1, n27_0, n27_1, n28_0, n28_1, n29_0, n29_1, n30_0, n30_1, n31_0, n31_1;
                float pe1, pe2, pe3, pe4, pe5, pe6, pe7, pe8, pe9, pe10, pe11, pe12, pe13, pe14, pe15, pe16, pe17, pe18, pe19, pe20, pe21, pe22, pe23, pe24, pe25, pe26, pe27, pe28, pe29, pe30, pe31, pe32;
                n1_0 = *(const LAS f32x4*)(np_ + 1 * 36); n2_0 = *(const LAS f32x4*)(np_ + 2 * 36); pe1 = 0.f;
                { n3_0 = *(const LAS f32x4*)(np_ + 3 * 36); float p = pe1; asm("v_fmac_f32 %0, %1, %2" : "+v"(p) : "v"(xq0), "v"(n1_0[0])); p += dpp_f(p, 0); pe2 = 0.f; p += dpp_f(p, 1); xq0 = kq1 ? (xq0 + p) : xq0; asm volatile("" : "+v"(xq0), "+v"(np_) : "v"(n1_0)); }
                { n4_0 = *(const LAS f32x4*)(np_ + 4 * 36); float p = pe2; asm("v_fmac_f32 %0, %1, %2" : "+v"(p) : "v"(xq0), "v"(n2_0[0])); p += dpp_f(p, 0); pe3 = 0.f; p += dpp_f(p, 1); xq0 = kq2 ? (xq0 + p) : xq0; asm volatile("" : "+v"(xq0), "+v"(np_) : "v"(n2_0)); }
                { n5_0 = *(const LAS f32x4*)(np_ + 5 * 36); float p = pe3; asm("v_fmac_f32 %0, %1, %2" : "+v"(p) : "v"(xq0), "v"(n3_0[0])); p += dpp_f(p, 0); pe4 = 0.f; p += dpp_f(p, 1); xq0 = kq3 ? (xq0 + p) : xq0; asm volatile("" : "+v"(xq0), "+v"(np_) : "v"(n3_0)); }
                { n6_0 = *(const LAS f32x4*)(np_ + 6 * 36); float p = pe4; asm("v_fmac_f32 %0, %1, %2" : "+v"(p) : "v"(xq0), "v"(n4_0[0])); p += dpp_f(p, 0); pe5 = 0.f; asm("v_fmac_f32 %0, %1, %2" : "+v"(pe5) : "v"(xq0), "v"(n5_0[0])); p += dpp_f(p, 1); xq1 = kq0 ? (xq1 + p) : xq1; asm volatile("" : "+v"(xq1), "+v"(np_) : "v"(n4_0)); }
                { n7_0 = *(const LAS f32x4*)(np_ + 7 * 36); float p = pe5; asm("v_fmac_f32 %0, %1, %2" : "+v"(p) : "v"(xq1), "v"(n5_0[1])); p += dpp_f(p, 0); pe6 = 0.f; asm("v_fmac_f32 %0, %1, %2" : "+v"(pe6) : "v"(xq0), "v"(n6_0[0])); p += dpp_f(p, 1); xq1 = kq1 ? (xq1 + p) : xq1; asm volatile("" : "+v"(xq1), "+v"(np_) : "v"(n5_0)); }
                { n8_0 = *(const LAS f32x4*)(np_ + 8 * 36); float p = pe6; asm("v_fmac_f32 %0, %1, %2" : "+v"(p) : "v"(xq1), "v"(n6_0[1])); p += dpp_f(p, 0); pe7 = 0.f; asm("v_fmac_f32 %0, %1, %2" : "+v"(pe7) : "v"(xq0), "v"(n7_0[0])); p += dpp_f(p, 1); xq1 = kq2 ? (xq1 + p) : xq1; asm volatile("" : "+v"(xq1), "+v"(np_) : "v"(n6_0)); }
                { n9_0 = *(const LAS f32x4*)(np_ + 9 * 36); float p = pe7; asm("v_fmac_f32 %0, %1, %2" : "+v"(p) : "v"(xq1), "v"(n7_0[1])); p += dpp_f(p, 0); pe8 = 0.f; asm("v_fmac_f32 %0, %1, %2" : "+v"(pe8) : "v"(xq0), "v"(n8_0[0])); p += dpp_f(p, 1); xq1 = kq3 ? (xq1 + p) : xq1; asm volatile("" : "+v"(xq1), "+v"(np_) : "v"(n7_0)); }
                { n10_0 = *(const LAS f32x4*)(np_ + 10 * 36); float p = pe8; asm("v_fmac_f32 %0, %1, %2" : "+v"(p) : "v"(xq1), "v"(n8_0[1])); p += dpp_f(p, 0); pe9 = 0.f; asm("v_fmac_f32 %0, %1, %2" : "+v"(pe9) : "v"(xq0), "v"(n9_0[0])); asm("v_fmac_f32 %0, %1, %2" : "+v"(pe9) : "v"(xq1), "v"(n9_0[1])); p += dpp_f(p, 1); xq2 = kq0 ? (xq2 + p) : xq2; asm volatile("" : "+v"(xq2), "+v"(np_) : "v"(n8_0)); }
                { n11_0 = *(const LAS f32x4*)(np_ + 11 * 36); float p = pe9; asm("v_fmac_f32 %0, %1, %2" : "+v"(p) : "v"(xq2), "v"(n9_0[2])); p += dpp_f(p, 0); pe10 = 0.f; asm("v_fmac_f32 %0, %1, %2" : "+v"(pe10) : "v"(xq0), "v"(n10_0[0])); asm("v_fmac_f32 %0, %1, %2" : "+v"(pe10) : "v"(xq1), "v"(n10_0[1])); p += dpp_f(p, 1); xq2 = kq1 ? (xq2 + p) : xq2; asm volatile("" : "+v"(xq2), "+v"(np_) : "v"(n9_0)); }
                { n12_0 = *(const LAS f32x4*)(np_ + 12 * 36); float p = pe10; asm("v_fmac_f32 %0, %1, %2" : "+v"(p) : "v"(xq2), "v"(n10_0[2])); p += dpp_f(p, 0); pe11 = 0.f; asm("v_fmac_f32 %0, %1, %2" : "+v"(pe11) : "v"(xq0), "v"(n11_0[0])); asm("v_fmac_f32 %0, %1, %2" : "+v"(pe11) : "v"(xq1), "v"(n11_0[1])); p += dpp_f(p, 1); xq2 = kq2 ? (xq2 + p) : xq2; asm volatile("" : "+v"(xq2), "+v"(np_) : "v"(n10_0)); }
                { n13_0 = *(const LAS f32x4*)(np_ + 13 * 36); float p = pe11; asm("v_fmac_f32 %0, %1, %2" : "+v"(p) : "v"(xq2), "v"(n11_0[2])); p += dpp_f(p, 0); pe12 = 0.f; asm("v_fmac_f32 %0, %1, %2" : "+v"(pe12) : "v"(xq0), "v"(n12_0[0])); asm("v_fmac_f32 %0, %1, %2" : "+v"(pe12) : "v"(xq1), "v"(n12_0[1])); p += dpp_f(p, 1); xq2 = kq3 ? (xq2 + p) : xq2; asm volatile("" : "+v"(xq2), "+v"(np_) : "v"(n11_0)); }
                { n14_0 = *(const LAS f32x4*)(np_ + 14 * 36); float p = pe12; asm("v_fmac_f32 %0, %1, %2" : "+v"(p) : "v"(xq2), "v"(n12_0[2])); p += dpp_f(p, 0); pe13 = 0.f; asm("v_fmac_f32 %0, %1, %2" : "+v"(pe13) : "v"(xq0), "v"(n13_0[0])); asm("v_fmac_f32 %0, %1, %2" : "+v"(pe13) : "v"(xq1), "v"(n13_0[1])); asm("v_fmac_f32 %0, %1, %2" : "+v"(pe13) : "v"(xq2), "v"(n13_0[2])); p += dpp_f(p, 1); xq3 = kq0 ? (xq3 + p) : xq3; asm volatile("" : "+v"(xq3), "+v"(np_) : "v"(n12_0)); }
                { n15_0 = *(const LAS f32x4*)(np_ + 15 * 36); float p = pe13; asm("v_fmac_f32 %0, %1, %2" : "+v"(p) : "v"(xq3), "v"(n13_0[3])); p += dpp_f(p, 0); pe14 = 0.f; asm("v_fmac_f32 %0, %1, %2" : "+v"(pe14) : "v"(xq0), "v"(n14_0[0])); asm("v_fmac_f32 %0, %1, %2" : "+v"(pe14) : "v"(xq1), "v"(n14_0[1])); asm("v_fmac_f32 %0, %1, %2" : "+v"(pe14) : "v"(xq2), "v"(n14_0[2])); p += dpp_f(p, 1); xq3 = kq1 ? (xq3 + p) : xq3; asm volatile("" : "+v"(xq3), "+v"(np_) : "v"(n13_0)); }
                { n16_0 = *(const LAS f32x4*)(np_ + 16 * 36); float p = pe14; asm("v_fmac_f32 %0, %1, %2" : "+v"(p) : "v"(xq3), "v"(n14_0[3])); p += dpp_f(p, 0); pe15 = 0.f; asm("v_fmac_f32 %0, %1, %2" : "+v"(pe15) : "v"(xq0), "v"(n15_0[0])); asm("v_fmac_f32 %0, %1, %2" : "+v"(pe15) : "v"(xq1), "v"(n15_0[1])); asm("v_fmac_f32 %0, %1, %2" : "+v"(pe15) : "v"(xq2), "v"(n15_0[2])); p += dpp_f(p, 1); xq3 = kq2 ? (xq3 + p) : xq3; asm volatile("" : "+v"(xq3), "+v"(np_) : "v"(n14_0)); }
                { n17_0 = *(const LAS f32x4*)(np_ + 17 * 36); n17_1 = *(const LAS f32x4*)(np_ + 17 * 36 + 4); float p = pe15; asm("v_fmac_f32 %0, %1, %2" : "+v"(p) : "v"(xq3), "v"(n15_0[3])); p += dpp_f(p, 0); pe16 = 0.f; asm("v_fmac_f32 %0, %1, %2" : "+v"(pe16) : "v"(xq0), "v"(n16_0[0])); asm("v_fmac_f32 %0, %1, %2" : "+v"(pe16) : "v"(xq1), "v"(n16_0[1])); asm("v_fmac_f32 %0, %1, %2" : "+v"(pe16) : "v"(xq2), "v"(n16_0[2])); p += dpp_f(p, 1); xq3 = kq3 ? (xq3 + p) : xq3; asm volatile("" : "+v"(xq3), "+v"(np_) : "v"(n15_0)); }
                { n18_0 = *(const LAS f32x4*)(np_ + 18 * 36); n18_1 = *(const LAS f32x4*)(np_ + 18 * 36 + 4); float p = pe16; asm("v_fmac_f32 %0, %1, %2" : "+v"(p) : "v"(xq3), "v"(n16_0[3])); p += dpp_f(p, 0); pe17 = 0.f; asm("v_fmac_f32 %0, %1, %2" : "+v"(pe17) : "v"(xq0), "v"(n17_0[0])); asm("v_fmac_f32 %0, %1, %2" : "+v"(pe17) : "v"(xq1), "v"(n17_0[1])); asm("v_fmac_f32 %0, %1, %2" : "+v"(pe17) : "v"(xq2), "v"(n17_0[2])); asm("v_fmac_f32 %0, %1, %2" : "+v"(pe17) : "v"(xq3), "v"(n17_0[3])); p += dpp_f(p, 1); xq4 = kq0 ? (xq4 + p) : xq4; asm volatile("" : "+v"(xq4), "+v"(np_) : "v"(n16_0)); }
                { n19_0 = *(const LAS f32x4*)(np_ + 19 * 36); n19_1 = *(const LAS f32x4*)(np_ + 19 * 36 + 4); float p = pe17; asm("v_fmac_f32 %0, %1, %2" : "+v"(p) : "v"(xq4), "v"(n17_1[0])); p += dpp_f(p, 0); pe18 = 0.f; asm("v_fmac_f32 %0, %1, %2" : "+v"(pe18) : "v"(xq0), "v"(n18_0[0])); asm("v_fmac_f32 %0, %1, %2" : "+v"(pe18) : "v"(xq1), "v"(n18_0[1])); asm("v_fmac_f32 %0, %1, %2" : "+v"(pe18) : "v"(xq2), "v"(n18_0[2])); asm("v_fmac_f32 %0, %1, %2" : "+v"(pe18) : "v"(xq3), "v"(n18_0[3])); p += dpp_f(p, 1); xq4 = kq1 ? (xq4 + p) : xq4; asm volatile("" : "+v"(xq4), "+v"(np_) : "v"(n17_0), "v"(n17_1)); }
                { n20_0 = *(const LAS f32x4*)(np_ + 20 * 36); n20_1 = *(const LAS f32x4*)(np_ + 20 * 36 + 4); float p = pe18; asm("v_fmac_f32 %0, %1, %2" : "+v"(p) : "v"(xq4), "v"(n18_1[0])); p += dpp_f(p, 0); pe19 = 0.f; asm("v_fmac_f32 %0, %1, %2" : "+v"(pe19) : "v"(xq0), "v"(n19_0[0])); asm("v_fmac_f32 %0, %1, %2" : "+v"(pe19) : "v"(xq1), "v"(n19_0[1])); asm("v_fmac_f32 %0, %1, %2" : "+v"(pe19) : "v"(xq2), "v"(n19_0[2])); asm("v_fmac_f32 %0, %1, %2" : "+v"(pe19) : "v"(xq3), "v"(n19_0[3])); p += dpp_f(p, 1); xq4 = kq2 ? (xq4 + p) : xq4; asm volatile("" : "+v"(xq4), "+v"(np_) : "v"(n18_0), "v"(n18_1)); }
                { n21_0 = *(const LAS f32x4*)(np_ + 21 * 36); n21_1 = *(const LAS f32x4*)(np_ + 21 * 36 + 4); float p = pe19; asm("v_fmac_f32 %0, %1, %2" : "+v"(p) : "v"(xq4), "v"(n19_1[0])); p += dpp_f(p, 0); pe20 = 0.f; asm("v_fmac_f32 %0, %1, %2" : "+v"(pe20) : "v"(xq0), "v"(n20_0[0])); asm("v_fmac_f32 %0, %1, %2" : "+v"(pe20) : "v"(xq1), "v"(n20_0[1])); asm("v_fmac_f32 %0, %1, %2" : "+v"(pe20) : "v"(xq2), "v"(n20_0[2])); asm("v_fmac_f32 %0, %1, %2" : "+v"(pe20) : "v"(xq3), "v"(n20_0[3])); p += dpp_f(p, 1); xq4 = kq3 ? (xq4 + p) : xq4; asm volatile("" : "+v"(xq4), "+v"(np_) : "v"(n19_0), "v"(n19_1)); }
                { n22_0 = *(const LAS f32x4*)(np_ + 22 * 36); n22_1 = *(const LAS f32x4*)(np_ + 22 * 36 + 4); float p = pe20; asm("v_fmac_f32 %0, %1, %2" : "+v"(p) : "v"(xq4), "v"(n20_1[0])); p += dpp_f(p, 0); pe21 = 0.f; asm("v_fmac_f32 %0, %1, %2" : "+v"(pe21) : "v"(xq0), "v"(n21_0[0])); asm("v_fmac_f32 %0, %1, %2" : "+v"(pe21) : "v"(xq1), "v"(n21_0[1])); asm("v_fmac_f32 %0, %1, %2" : "+v"(pe21) : "v"(xq2), "v"(n21_0[2])); asm("v_fmac_f32 %0, %1, %2" : "+v"(pe21) : "v"(xq3), "v"(n21_0[3])); asm("v_fmac_f32 %0, %1, %2" : "+v"(pe21) : "v"(xq4), "v"(n21_1[0])); p += dpp_f(p, 1); xq5 = kq0 ? (xq5 + p) : xq5; asm volatile("" : "+v"(xq5), "+v"(np_) : "v"(n20_0), "v"(n20_1)); }
                { n23_0 = *(const LAS f32x4*)(np_ + 23 * 36); n23_1 = *(const LAS f32x4*)(np_ + 23 * 36 + 4); float p = pe21; asm("v_fmac_f32 %0, %1, %2" : "+v"(p) : "v"(xq5), "v"(n21_1[1])); p += dpp_f(p, 0); pe22 = 0.f; asm("v_fmac_f32 %0, %1, %2" : "+v"(pe22) : "v"(xq0), "v"(n22_0[0])); asm("v_fmac_f32 %0, %1, %2" : "+v"(pe22) : "v"(xq1), "v"(n22_0[1])); asm("v_fmac_f32 %0, %1, %2" : "+v"(pe22) : "v"(xq2), "v"(n22_0[2])); asm("v_fmac_f32 %0, %1, %2" : "+v"(pe22) : "v"(xq3), "v"(n22_0[3])); asm("v_fmac_f32 %0, %1, %2" : "+v"(pe22) : "v"(xq4), "v"(n22_1[0])); p += dpp_f(p, 1); xq5 = kq1 ? (xq5 + p) : xq5; asm volatile("" : "+v"(xq5), "+v"(np_) : "v"(n21_0), "v"(n21_1)); }
                { n24_0 = *(const LAS f32x4*)(np_ + 24 * 36); n24_1 = *(const LAS f32x4*)(np_ + 24 * 36 + 4); float p = pe22; asm("v_fmac_f32 %0, %1, %2" : "+v"(p) : "v"(xq5), "v"(n22_1[1])); p += dpp_f(p, 0); pe23 = 0.f; asm("v_fmac_f32 %0, %1, %2" : "+v"(pe23) : "v"(xq0), "v"(n23_0[0])); asm("v_fmac_f32 %0, %1, %2" : "+v"(pe23) : "v"(xq1), "v"(n23_0[1])); asm("v_fmac_f32 %0, %1, %2" : "+v"(pe23) : "v"(xq2), "v"(n23_0[2])); asm("v_fmac_f32 %0, %1, %2" : "+v"(pe23) : "v"(xq3), "v"(n23_0[3])); asm("v_fmac_f32 %0, %1, %2" : "+v"(pe23) : "v"(xq4), "v"(n23_1[0])); p += dpp_f(p, 1); xq5 = kq2 ? (xq5 + p) : xq5; asm volatile("" : "+v"(xq5), "+v"(np_) : "v"(n22_0), "v"(n22_1)); }
                { n25_0 = *(const LAS f32x4*)(np_ + 25 * 36); n25_1 = *(const LAS f32x4*)(np_ + 25 * 36 + 4); float p = pe23; asm("v_fmac_f32 %0, %1, %2" : "+v"(p) : "v"(xq5), "v"(n23_1[1])); p += dpp_f(p, 0); pe24 = 0.f; asm("v_fmac_f32 %0, %1, %2" : "+v"(pe24) : "v"(xq0), "v"(n24_0[0])); asm("v_fmac_f32 %0, %1, %2" : "+v"(pe24) : "v"(xq1), "v"(n24_0[1])); asm("v_fmac_f32 %0, %1, %2" : "+v"(pe24) : "v"(xq2), "v"(n24_0[2])); asm("v_fmac_f32 %0, %1, %2" : "+v"(pe24) : "v"(xq3), "v"(n24_0[3])); asm("v_fmac_f32 %0, %1, %2" : "+v"(pe24) : "v"(xq4), "v"(n24_1[0])); p += dpp_f(p, 1); xq5 = kq3 ? (xq5 + p) : xq5; asm volatile("" : "+v"(xq5), "+v"(np_) : "v"(n23_0), "v"(n23_1)); }
                { n26_0 = *(const LAS f32x4*)(np_ + 26 * 36); n26_1 = *(const LAS f32x4*)(np_ + 26 * 36 + 4); float p = pe24; asm("v_fmac_f32 %0, %1, %2" : "+v"(p) : "v"(xq5), "v"(n24_1[1])); p += dpp_f(p, 0); pe25 = 0.f; asm("v_fmac_f32 %0, %1, %2" : "+v"(pe25) : "v"(xq0), "v"(n25_0[0])); asm("v_fmac_f32 %0, %1, %2" : "+v"(pe25) : "v"(xq1), "v"(n25_0[1])); asm("v_fmac_f32 %0, %1, %2" : "+v"(pe25) : "v"(xq2), "v"(n25_0[2])); asm("v_fmac_f32 %0, %1, %2" : "+v"(pe25) : "v"(xq3), "v"(n25_0[3])); asm("v_fmac_f32 %0, %1, %2" : "+v"(pe25) : "v"(xq4), "v"(n25_1[0])); asm("v_fmac_f32 %0, %1, %2" : "+v"(pe25) : "v"(xq5), "v"(n25_1[1])); p += dpp_f(p, 1); xq6 = kq0 ? (xq6 + p) : xq6; asm volatile("" : "+v"(xq6), "+v"(np_) : "v"(n24_0), "v"(n24_1)); }
                { n27_0 = *(const LAS f32x4*)(np_ + 27 * 36); n27_1 = *(const LAS f32x4*)(np_ + 27 * 36 + 4); float p = pe25; asm("v_fmac_f32 %0, %1, %2" : "+v"(p) : "v"(xq6), "v"(n25_1[2])); p += dpp_f(p, 0); pe26 = 0.f; asm("v_fmac_f32 %0, %1, %2" : "+v"(pe26) : "v"(xq0), "v"(n26_0[0])); asm("v_fmac_f32 %0, %1, %2" : "+v"(pe26) : "v"(xq1), "v"(n26_0[1])); asm("v_fmac_f32 %0, %1, %2" : "+v"(pe26) : "v"(xq2), "v"(n26_0[2])); asm("v_fmac_f32 %0, %1, %2" : "+v"(pe26) : "v"(xq3), "v"(n26_0[3])); asm("v_fmac_f32 %0, %1, %2" : "+v"(pe26) : "v"(xq4), "v"(n26_1[0])); asm("v_fmac_f32 %0, %1, %2" : "+v"(pe26) : "v"(xq5), "v"(n26_1[1])); p += dpp_f(p, 1); xq6 = kq1 ? (xq6 + p) : xq6; asm volatile("" : "+v"(xq6), "+v"(np_) : "v"(n25_0), "v"(n25_1)); }
                { n28_0 = *(const LAS f32x4*)(np_ + 28 * 36); n28_1 = *(const LAS f32x4*)(np_ + 28 * 36 + 4); float p = pe26; asm("v_fmac_f32 %0, %1, %2" : "+v"(p) : "v"(xq6), "v"(n26_1[2])); p += dpp_f(p, 0); pe27 = 0.f; asm("v_fmac_f32 %0, %1, %2" : "+v"(pe27) : "v"(xq0), "v"(n27_0[0])); asm("v_fmac_f32 %0, %1, %2" : "+v"(pe27) : "v"(xq1), "v"(n27_0[1])); asm("v_fmac_f32 %0, %1, %2" : "+v"(pe27) : "v"(xq2), "v"(n27_0[2])); asm("v_fmac_f32 %0, %1, %2" : "+v"(pe27) : "v"(xq3), "v"(n27_0[3])); asm("v_fmac_f32 %0, %1, %2" : "+v"(pe27) : "v"(xq4), "v"(n27_1[0])); asm("v_fmac_f32 %0, %1, %2" : "+v"(pe27) : "v"(xq5), "v"(n27_1[1])); p += dpp_f(p, 1); xq6 = kq2 ? (xq6 + p) : xq6; asm volatile("" : "+v"(xq6), "+v"(np_) : "v"(n26_0), "v"(n26_1)); }
                { n29_0 = *(const LAS f32x4*)(np_ + 29 * 36); n29_1 = *(const LAS f32x4*)(np_ + 29 * 36 + 4); float p = pe27; asm("v_fmac_f32 %0, %1, %2" : "+v"(p) : "v"(xq6), "v"(n27_1[2])); p += dpp_f(p, 0); pe28 = 0.f; asm("v_fmac_f32 %0, %1, %2" : "+v"(pe28) : "v"(xq0), "v"(n28_0[0])); asm("v_fmac_f32 %0, %1, %2" : "+v"(pe28) : "v"(xq1), "v"(n28_0[1])); asm("v_fmac_f32 %0, %1, %2" : "+v"(pe28) : "v"(xq2), "v"(n28_0[2])); asm("v_fmac_f32 %0, %1, %2" : "+v"(pe28) : "v"(xq3), "v"(n28_0[3])); asm("v_fmac_f32 %0, %1, %2" : "+v"(pe28) : "v"(xq4), "v"(n28_1[0])); asm("v_fmac_f32 %0, %1, %2" : "+v"(pe28) : "v"(xq5), "v"(n28_1[1])); p += dpp_f(p, 1); xq6 = kq3 ? (xq6 + p) : xq6; asm volatile("" : "+v"(xq6), "+v"(np_) : "v"(n27_0), "v"(n27_1)); }
                { n30_0 = *(const LAS f32x4*)(np_ + 30 * 36); n30_1 = *(const LAS f32x4*)(np_ + 30 * 36 + 4); float p = pe28; asm("v_fmac_f32 %0, %1, %2" : "+v"(p) : "v"(xq6), "v"(n28_1[2])); p += dpp_f(p, 0); pe29 = 0.f; asm("v_fmac_f32 %0, %1, %2" : "+v"(pe29) : "v"(xq0), "v"(n29_0[0])); asm("v_fmac_f32 %0, %1, %2" : "+v"(pe29) : "v"(xq1), "v"(n29_0[1])); asm("v_fmac_f32 %0, %1, %2" : "+v"(pe29) : "v"(xq2), "v"(n29_0[2])); asm("v_fmac_f32 %0, %1, %2" : "+v"(pe29) : "v"(xq3), "v"(n29_0[3])); asm("v_fmac_f32 %0, %1, %2" : "+v"(pe29) : "v"(xq4), "v"(n29_1[0])); asm("v_fmac_f32 %0, %1, %2" : "+v"(pe29) : "v"(xq5), "v"(n29_1[1])); asm("v_fmac_f32 %0, %1, %2" : "+v"(pe29) : "v"(xq6), "v"(n29_1[2])); p += dpp_f(p, 1); xq7 = kq0 ? (xq7 + p) : xq7; asm volatile("" : "+v"(xq7), "+v"(np_) : "v"(n28_0), "v"(n28_1)); }
                { n31_0 = *(const LAS f32x4*)(np_ + 31 * 36); n31_1 = *(const LAS f32x4*)(np_ + 31 * 36 + 4); float p = pe29; asm("v_fmac_f32 %0, %1, %2" : "+v"(p) : "v"(xq7), "v"(n29_1[3])); p += dpp_f(p, 0); pe30 = 0.f; asm("v_fmac_f32 %0, %1, %2" : "+v"(pe30) : "v"(xq0), "v"(n30_0[0])); asm("v_fmac_f32 %0, %1, %2" : "+v"(pe30) : "v"(xq1), "v"(n30_0[1])); asm("v_fmac_f32 %0, %1, %2" : "+v"(pe30) : "v"(xq2), "v"(n30_0[2])); asm("v_fmac_f32 %0, %1, %2" : "+v"(pe30) : "v"(xq3), "v"(n30_0[3])); asm("v_fmac_f32 %0, %1, %2" : "+v"(pe30) : "v"(xq4), "v"(n30_1[0])); asm("v_fmac_f32 %0, %1, %2" : "+v"(pe30) : "v"(xq5), "v"(n30_1[1])); asm("v_fmac_f32 %0, %1, %2" : "+v"(pe30) : "v"(xq6), "v"(n30_1[2])); p += dpp_f(p, 1); xq7 = kq1 ? (xq7 + p) : xq7; asm volatile("" : "+v"(xq7), "+v"(np_) : "v"(n29_0), "v"(n29_1)); }
                { float p = pe30; asm("v_fmac_f32 %0, %1, %2" : "+v"(p) : "v"(xq7), "v"(n30_1[3])); p += dpp_f(p, 0); pe31 = 0.f; asm("v_fmac_f32 %0, %1, %2" : "+v"(pe31) : "v"(xq0), "v"(n31_0[0])); asm("v_fmac_f32 %0, %1, %2" : "+v"(pe31) : "v"(xq1), "v"(n31_0[1])); asm("v_fmac_f32 %0, %1, %2" : "+v"(pe31) : "v"(xq2), "v"(n31_0[2])); asm("v_fmac_f32 %0, %1, %2" : "+v"(pe31) : "v"(xq3), "v"(n31_0[3])); asm("v_fmac_f32 %0, %1, %2" : "+v"(pe31) : "v"(xq4), "v"(n31_1[0])); asm("v_fmac_f32 %0, %1, %2" : "+v"(pe31) : "v"(xq5), "v"(n31_1[1])); asm("v_fmac_f32 %0, %1, %2" : "+v"(pe31) : "v"(xq6), "v"(n31_1[2])); p += dpp_f(p, 1); xq7 = kq2 ? (xq7 + p) : xq7; asm volatile("" : "+v"(xq7), "+v"(np_) : "v"(n30_0), "v"(n30_1)); }
                { float p = pe31; asm("v_fmac_f32 %0, %1, %2" : "+v"(p) : "v"(xq7), "v"(n31_1[3])); p += dpp_f(p, 0); p += dpp_f(p, 1); xq7 = kq3 ? (xq7 + p) : xq7; asm volatile("" : "+v"(xq7), "+v"(np_) : "v"(n31_0), "v"(n31_1)); }
                LAS bf16_t* dst = isA ? (A2 + rowi * 40 + q) : (NT + rowi * 40 + q);
                dst[0] = bf1(xq0);
                dst[4] = bf1(xq1);
                dst[8] = bf1(xq2);
                dst[12] = bf1(xq3);
                dst[16] = bf1(xq4);
                dst[20] = bf1(xq5);
                dst[24] = bf1(xq6);
                dst[28] = bf1(xq7);
            }
            __syncthreads();
            {
                const int t = lane & 31; f32x16 acc;
#pragma unroll
                for (int i = 0; i < 16; ++i) acc[i] = 0.f;
                if (wave == 0 || wave == 1) {
                    acc = mm32<2>(acc, NT, 40, BTt + 32 * wave * 40, 40, lane); const int k = 32 * wave + t; const float gc = GC[k];
#pragma unroll
                    for (int g4 = 0; g4 < 4; ++g4) { const int s0 = 8 * g4 + 4 * (lane >> 5); float o[4];
#pragma unroll
                        for (int i = 0; i < 4; ++i) o[i] = (acc[4 * g4 + i] + __builtin_bit_cast(float, (unsigned)KT[(s0 + i) * 72 + k] << 16)) * gc;
                        *(LAS u32x2*)(WzT + k * 40 + s0) = (u32x2){cvt_pk_bf16(o[0], o[1]), cvt_pk_bf16(o[2], o[3])}; }
                } else if (wave == 2 || wave == 6) {
                    const int rh = (wave == 6) ? 1 : 0; acc = mm32<2>(acc, A2 + 32 * rh * 40, 40, MbrT, 40, lane);
#pragma unroll
                    for (int g4 = 0; g4 < 4; ++g4) { const int k0 = 32 * rh + 8 * g4 + 4 * (lane >> 5); float o[4]; const u32x2 rv = *(const LAS u32x2*)(RT + t * 72 + k0);
                        o[0] = acc[4 * g4] + bflo(rv.x); o[1] = acc[4 * g4 + 1] + bfhi(rv.x); o[2] = acc[4 * g4 + 2] + bflo(rv.y); o[3] = acc[4 * g4 + 3] + bfhi(rv.y);
                        *(LAS u32x2*)(R2T + t * 72 + k0) = (u32x2){cvt_pk_bf16(o[0], o[1]), cvt_pk_bf16(o[2], o[3])}; }
                } else {
                    if (wave == 3) { accw = mm32<2>(accw, NT, 40, MbrT, 40, lane);
#pragma unroll
                        for (int g4 = 0; g4 < 4; ++g4) { const int s0 = 8 * g4 + 4 * (lane >> 5);
                            *(LAS u32x2*)(WyT + t * 40 + s0) = (u32x2){cvt_pk_bf16(accw[4 * g4], accw[4 * g4 + 1]), cvt_pk_bf16(accw[4 * g4 + 2], accw[4 * g4 + 3])}; } }
                    const int pt = (wave == 3) ? 3 : (wave == 7 ? 2 : wave - 4);
                    const int rh = pt >> 1, ch = pt & 1; acc = mm32<2>(acc, A2 + 32 * rh * 40, 40, BTt + 32 * ch * 40, 40, lane); const int kp = 32 * ch + t; const float gc = GC[kp];
#pragma unroll
                    for (int g4 = 0; g4 < 4; ++g4) { const int k0 = 32 * rh + 8 * g4 + 4 * (lane >> 5);
                        *(LAS u32x2*)(PpT + kp * 72 + k0) = (u32x2){cvt_pk_bf16(acc[4 * g4] * gc, acc[4 * g4 + 1] * gc), cvt_pk_bf16(acc[4 * g4 + 2] * gc, acc[4 * g4 + 3] * gc)}; }
                }
            }
            __syncthreads();
            if (wave < 3) {
                const int t = lane & 31; const LAS bf16_t* Sb = SBF + bi * (32 * 72); f32x16 acc;
#pragma unroll
                for (int i = 0; i < 16; ++i) acc[i] = 0.f;
                if (wave < 2) {
                    acc = mm32<2>(acc, VmT, 40, WzT + 32 * wave * 40, 40, lane);
                    acc = mm32<4>(acc, Sb, 72, PpT + 32 * wave * 72, 72, lane);
                    const float gc = GC[32 * wave + t]; LAS bf16_t* Sn = SBF + (bi ^ 1) * (32 * 72);
#pragma unroll
                    for (int i = 0; i < 16; ++i) { Sacc[i] = fmaf(Sacc[i], gc, acc[i]); Sn[TROW(i, lane) * 72 + 32 * wave + t] = bf1(Sacc[i]); }
                } else {
                    acc = mm32<2>(acc, VmT, 40, WyT, 40, lane);
                    acc = mm32<4>(acc, Sb, 72, R2T, 72, lane);
#pragma unroll
                    for (int i = 0; i < 16; ++i) YST[t * 33 + TROW(i, lane)] = acc[i];
                }
            }
            __syncthreads();
            { const LAS float* ys = YST + pj * 33 + 2 * pq;
                *(f32x2*)(Y + ((size_t)b * SEQ + chunk * 32 + pj) * 512 + h * 64 + 32 * half + 2 * pq) = (f32x2){ys[0], ys[1]}; }
        }
#undef WKV_LOAD
    }
    TSTOP(4);
}


constexpr int STG_R_STRIDE = 10752;
struct WSet { LAS float* CUM; LAS float* PS; LAS bf16_t* AT; LAS bf16_t* BT; LAS bf16_t* KT; LAS bf16_t* RT; LAS bf16_t* BTt; LAS bf16_t* ATt; LAS float* NabT; LAS bf16_t* Nakb; LAS bf16_t* MbrT; LAS bf16_t* Tb; LAS bf16_t* Ut; LAS bf16_t* Wt;
              LAS bf16_t* WyT; LAS bf16_t* WzT; LAS bf16_t* R2T; LAS bf16_t* PpT; LAS float* GC; };
constexpr int WSET_BYTES = 59136;
__device__ __forceinline__ WSet wset(LAS unsigned char* p) {
    WSet s; s.CUM = (LAS float*)p; s.PS = (LAS float*)(p + 8192); s.WyT = (LAS bf16_t*)p; s.WzT = (LAS bf16_t*)(p + 2560);
    s.AT = (LAS bf16_t*)(p + 10240); s.BT = (LAS bf16_t*)(p + 14848); s.PpT = (LAS bf16_t*)(p + 10240); s.KT = (LAS bf16_t*)(p + 19456); s.RT = (LAS bf16_t*)(p + 24064);
    s.BTt = (LAS bf16_t*)(p + 28672); s.ATt = (LAS bf16_t*)(p + 33792); s.NabT = (LAS float*)(p + 38912); s.R2T = (LAS bf16_t*)(p + 38912); s.Nakb = (LAS bf16_t*)(p + 43520); s.MbrT = (LAS bf16_t*)(p + 46080);
    s.Tb = (LAS bf16_t*)(p + 48640); s.Ut = (LAS bf16_t*)(p + 51200); s.Wt = (LAS bf16_t*)(p + 53760); s.GC = (LAS float*)(p + 58880); return s;
}
struct WRaw { u32x2 rc, rp, kc, kp, e4, a4; };
__device__ __forceinline__ void w5_load(WRaw& w, const bf16_t* COLS, const bf16_t* LORA, int b, int chunk, int pj, int hc) {
    const int s_ = chunk * 32 + pj; const size_t t_ = (size_t)b * SEQ + s_; const bf16_t* cb_ = COLS + t_ * INC + hc; const u32x2 z = (u32x2){0u, 0u};
    w.rc = *(const u32x2*)(cb_ + C_R); w.kc = *(const u32x2*)(cb_ + C_K);
    if (s_ > 0) { w.rp = *(const u32x2*)(cb_ - INC + C_R); w.kp = *(const u32x2*)(cb_ - INC + C_K); } else { w.rp = z; w.kp = z; }
    w.e4 = *(const u32x2*)(LORA + t_ * 1536 + hc); w.a4 = *(const u32x2*)(LORA + t_ * 1536 + 512 + hc);
}
struct WConst { f32x4 mur, muk, kk4, ka4, rk4; };
__device__ __forceinline__ void w5_prep_scale(const WConst& cst, const WRaw& w, const WSet& S, float* BON, int b, int h, int chunk, int pj, int pq) {
    float r_[4], rq_[4], k_[4], kq_[4], e_[4], aa_[4], kkn_[4], k2_[4];
    const f32x4 mur = cst.mur, muk = cst.muk, kk4 = cst.kk4, ka4 = cst.ka4, rk4 = cst.rk4;
    unpack4(w.rc, r_); unpack4(w.rp, rq_); unpack4(w.kc, k_); unpack4(w.kp, kq_); unpack4(w.e4, e_); unpack4(w.a4, aa_);
    float ss_ = 0.f, bon_ = 0.f;
#pragma unroll
    for (int i = 0; i < 4; ++i) { r_[i] += (rq_[i] - r_[i]) * mur[i]; k_[i] += (kq_[i] - k_[i]) * muk[i];
        kkn_[i] = k_[i] * kk4[i]; ss_ += kkn_[i] * kkn_[i]; k2_[i] = k_[i] * (1.0f + (aa_[i] - 1.0f) * ka4[i]); bon_ += r_[i] * k2_[i] * rk4[i]; }
    ss_ = row16_sum(ss_); bon_ = row16_sum(bon_); const float inv_ = __builtin_amdgcn_rsqf(fmaxf(ss_, 1e-24f));
    if (pq == 0) BON[((size_t)b * SEQ + chunk * 32 + pj) * 8 + h] = bon_;
    const f32x4 cm = *(const LAS f32x4*)(S.CUM + pj * 64 + 4 * pq); float at_[4], bt_[4], kt_[4], rt_[4], g_[4];
#pragma unroll
    for (int i = 0; i < 4; ++i) { const float kn = kkn_[i] * inv_; const float g = __expf(-cm[i]), ig = __expf(cm[i]), gp = __expf(e_[i] - cm[i]); g_[i] = g;
        at_[i] = -kn * gp; bt_[i] = kn * aa_[i] * ig; kt_[i] = k2_[i] * ig; rt_[i] = r_[i] * g; }
    *(LAS u32x2*)(S.AT + pj * 72 + 4 * pq) = (u32x2){cvt_pk_bf16(at_[0], at_[1]), cvt_pk_bf16(at_[2], at_[3])};
    *(LAS u32x2*)(S.BT + pj * 72 + 4 * pq) = (u32x2){cvt_pk_bf16(bt_[0], bt_[1]), cvt_pk_bf16(bt_[2], bt_[3])};
    *(LAS u32x2*)(S.KT + pj * 72 + 4 * pq) = (u32x2){cvt_pk_bf16(kt_[0], kt_[1]), cvt_pk_bf16(kt_[2], kt_[3])};
    *(LAS u32x2*)(S.RT + pj * 72 + 4 * pq) = (u32x2){cvt_pk_bf16(rt_[0], rt_[1]), cvt_pk_bf16(rt_[2], rt_[3])};
#pragma unroll
    for (int i = 0; i < 4; ++i) { S.BTt[(4 * pq + i) * 40 + pj] = bf1(bt_[i]); S.ATt[(4 * pq + i) * 40 + pj] = bf1(at_[i]); }
    if (pj == 31) *(LAS f32x4*)(S.GC + 4 * pq) = (f32x4){g_[0], g_[1], g_[2], g_[3]};
}
__device__ __forceinline__ void w5_s1(const WSet& S, int tl, f32x16& accw, int lane) {
    f32x16 acc;
#pragma unroll
    for (int i = 0; i < 16; ++i) acc[i] = 0.f;
    const int t = lane & 31, hh = lane >> 5;
    if (tl == 1) {
        acc = mm32<4>(acc, S.AT, 72, S.KT, 72, lane);
#pragma unroll
        for (int g4 = 0; g4 < 4; ++g4) { const int t0 = 8 * g4 + 4 * hh; float o[4];
#pragma unroll
            for (int i = 0; i < 4; ++i) o[i] = (t < t0 + i) ? acc[4 * g4 + i] : 0.f;
            *(LAS u32x2*)(S.Nakb + t * 40 + t0) = (u32x2){cvt_pk_bf16(o[0], o[1]), cvt_pk_bf16(o[2], o[3])}; }
        return;
    }
    acc = mm32<4>(acc, (tl & 1) ? S.KT : S.BT, 72, (tl & 2) ? S.RT : S.AT, 72, lane);
    if (tl == 0) {
#pragma unroll
        for (int g4 = 0; g4 < 4; ++g4) { const int s0 = 8 * g4 + 4 * hh;
#pragma unroll
            for (int i = 0; i < 4; ++i) S.NabT[t * 36 + i * 8 + 2 * g4 + hh] = (s0 + i < t) ? acc[4 * g4 + i] : 0.f; }
    } else if (tl == 2) {
#pragma unroll
        for (int g4 = 0; g4 < 4; ++g4) { const int s0 = 8 * g4 + 4 * hh; float o[4];
#pragma unroll
            for (int i = 0; i < 4; ++i) o[i] = (s0 + i <= t) ? acc[4 * g4 + i] : 0.f;
            *(LAS u32x2*)(S.MbrT + t * 40 + s0) = (u32x2){cvt_pk_bf16(o[0], o[1]), cvt_pk_bf16(o[2], o[3])}; }
    } else {
#pragma unroll
        for (int i = 0; i < 16; ++i) { const int s = TROW(i, lane); accw[i] = (s <= t) ? acc[i] : 0.f; }
    }
}
__device__ __forceinline__ void w5_s2b(const WSet& S, int tl, int lane) {
    f32x16 acc;
#pragma unroll
    for (int i = 0; i < 16; ++i) acc[i] = 0.f;
    const int t = lane & 31, hh = lane >> 5;
    acc = mm32<2>(acc, S.Tb, 40, (tl == 0) ? S.MbrT : (S.BTt + 32 * (tl - 1) * 40), 40, lane);
    LAS bf16_t* o = (tl == 0) ? (S.Ut + t * 40) : (S.Wt + (32 * (tl - 1) + t) * 40);
#pragma unroll
    for (int g4 = 0; g4 < 4; ++g4) { const int s0 = 8 * g4 + 4 * hh;
        *(LAS u32x2*)(o + s0) = (u32x2){cvt_pk_bf16(acc[4 * g4], acc[4 * g4 + 1]), cvt_pk_bf16(acc[4 * g4 + 2], acc[4 * g4 + 3])}; }
}
__device__ __forceinline__ void w5_s3(const WSet& S, int role, f32x16& accw, int lane) {
    const int t = lane & 31, hh = lane >> 5; f32x16 acc;
#pragma unroll
    for (int i = 0; i < 16; ++i) acc[i] = 0.f;
    if (role == 0 || role == 1) {
        acc = mm32<2>(acc, S.Nakb, 40, S.Wt + 32 * role * 40, 40, lane); const int k = 32 * role + t; const float gc = S.GC[k];
#pragma unroll
        for (int g4 = 0; g4 < 4; ++g4) { const int s0 = 8 * g4 + 4 * hh; float o[4];
#pragma unroll
            for (int i = 0; i < 4; ++i) o[i] = (acc[4 * g4 + i] + __builtin_bit_cast(float, (unsigned)S.KT[(s0 + i) * 72 + k] << 16)) * gc;
            *(LAS u32x2*)(S.WzT + k * 40 + s0) = (u32x2){cvt_pk_bf16(o[0], o[1]), cvt_pk_bf16(o[2], o[3])}; }
    } else if (role == 2 || role == 6) {
        const int rh = (role == 6) ? 1 : 0; acc = mm32<2>(acc, S.ATt + 32 * rh * 40, 40, S.Ut, 40, lane);
#pragma unroll
        for (int g4 = 0; g4 < 4; ++g4) { const int k0 = 32 * rh + 8 * g4 + 4 * hh; float o[4]; const u32x2 rv = *(const LAS u32x2*)(S.RT + t * 72 + k0);
            o[0] = acc[4 * g4] + bflo(rv.x); o[1] = acc[4 * g4 + 1] + bfhi(rv.x); o[2] = acc[4 * g4 + 2] + bflo(rv.y); o[3] = acc[4 * g4 + 3] + bfhi(rv.y);
            *(LAS u32x2*)(S.R2T + t * 72 + k0) = (u32x2){cvt_pk_bf16(o[0], o[1]), cvt_pk_bf16(o[2], o[3])}; }
    } else {
        if (role == 3) { accw = mm32<2>(accw, S.Nakb, 40, S.Ut, 40, lane);
#pragma unroll
            for (int g4 = 0; g4 < 4; ++g4) { const int s0 = 8 * g4 + 4 * hh;
                *(LAS u32x2*)(S.WyT + t * 40 + s0) = (u32x2){cvt_pk_bf16(accw[4 * g4], accw[4 * g4 + 1]), cvt_pk_bf16(accw[4 * g4 + 2], accw[4 * g4 + 3])}; } }
        const int pt = (role == 3) ? 3 : (role == 7 ? 2 : role - 4);
        const int rh = pt >> 1, ch = pt & 1; acc = mm32<2>(acc, S.ATt + 32 * rh * 40, 40, S.Wt + 32 * ch * 40, 40, lane); const int kp = 32 * ch + t; const float gc = S.GC[kp];
#pragma unroll
        for (int g4 = 0; g4 < 4; ++g4) { const int k0 = 32 * rh + 8 * g4 + 4 * hh;
            *(LAS u32x2*)(S.PpT + kp * 72 + k0) = (u32x2){cvt_pk_bf16(acc[4 * g4] * gc, acc[4 * g4 + 1] * gc), cvt_pk_bf16(acc[4 * g4 + 2] * gc, acc[4 * g4 + 3] * gc)}; }
    }
}
__device__ __forceinline__ void w5_copyout(const WSet& S, unsigned char* gr, unsigned char* gp, int tid) {
    { const int row = tid >> 3, pc = tid & 7; *(u32x4*)(gp + row * 128 + pc * 16) = *(const LAS u32x4*)((const LAS unsigned char*)S.PpT + row * 144 + pc * 16); }
    if (tid < 256) { const int row = tid >> 3, pc = tid & 7; *(u32x4*)(gr + row * 128 + pc * 16) = *(const LAS u32x4*)((const LAS unsigned char*)S.R2T + row * 144 + pc * 16); }
    else { const int u = tid - 256, row = u >> 2, pc = u & 3; *(u32x4*)(gr + 4096 + row * 64 + pc * 16) = *(const LAS u32x4*)((const LAS unsigned char*)S.WzT + row * 80 + pc * 16); }
    if (tid < 128) { const int row = tid >> 2, pc = tid & 3; *(u32x4*)(gr + 8192 + row * 64 + pc * 16) = *(const LAS u32x4*)((const LAS unsigned char*)S.WyT + row * 80 + pc * 16); }
    else if (tid < 144) { const int pc = tid - 128; *(u32x4*)(gr + 10240 + pc * 16) = *(const LAS u32x4*)((const LAS unsigned char*)S.GC + pc * 16); }
}
__device__ __forceinline__ void wkv5a2(const Args& a, LAS unsigned char* lds, const int round) {
    const int tid = threadIdx.x, wave = __builtin_amdgcn_readfirstlane(tid >> 6);
    unsigned char* ws = a.ws;
    const bf16_t* COLS = (const bf16_t*)(ws + WS_A); const bf16_t* LORA = (const bf16_t*)a.out; float* BON = (float*)(ws + WS_BON);
    unsigned char* STG_R = ws + WS_RWKV; unsigned char* STG_P = (unsigned char*)a.out + 96 * MiB;
    const WSet SA = wset(lds), SB = wset(lds + WSET_BYTES);
    for (int item = blockIdx.x; item < 256; item += gridDim.x) {
        const int bh = item >> 1, sub = item & 1, b = bh >> 3, h = bh & 7;
        const int chunk0 = 32 * round + 16 * sub, chunk_end = chunk0 + 16;
        WRaw wa, wb; WConst cst;
        { const int hc0 = h * 64 + 4 * (tid & 15); cst.mur = *(const f32x4*)(a.in[I_MU] + C_R + hc0); cst.muk = *(const f32x4*)(a.in[I_MU] + C_K + hc0);
          cst.kk4 = *(const f32x4*)(a.in[I_KK] + hc0); cst.ka4 = *(const f32x4*)(a.in[I_KA] + hc0); cst.rk4 = *(const f32x4*)(a.in[I_RK] + hc0); }
        w5_load(wa, COLS, LORA, b, chunk0, tid >> 4, h * 64 + 4 * (tid & 15)); w5_load(wb, COLS, LORA, b, chunk0 + 1, tid >> 4, h * 64 + 4 * (tid & 15));
        __syncthreads();
        for (int chunk = chunk0; chunk < chunk_end; chunk += 2) {
            int tid_l = tid; asm volatile("" : "+v"(tid_l));
            const int lane = tid_l & 63, pj = tid_l >> 4, pq = tid_l & 15, tid = tid_l, hc = h * 64 + 4 * pq; (void)tid;
            { float e_[4]; unpack4(wa.e4, e_); *(LAS f32x4*)(SA.CUM + pj * 64 + 4 * pq) = (f32x4){e_[0], e_[1], e_[2], e_[3]};
              unpack4(wb.e4, e_); *(LAS f32x4*)(SB.CUM + pj * 64 + 4 * pq) = (f32x4){e_[0], e_[1], e_[2], e_[3]}; }
            __syncthreads();
            {
                const int col = tid & 63, qd = tid >> 6;
                float p0 = SA.CUM[(4 * qd) * 64 + col], p1 = SA.CUM[(4 * qd + 1) * 64 + col], p2 = SA.CUM[(4 * qd + 2) * 64 + col], p3 = SA.CUM[(4 * qd + 3) * 64 + col];
                float q0 = SB.CUM[(4 * qd) * 64 + col], q1 = SB.CUM[(4 * qd + 1) * 64 + col], q2 = SB.CUM[(4 * qd + 2) * 64 + col], q3 = SB.CUM[(4 * qd + 3) * 64 + col];
                p1 += p0; p2 += p1; p3 += p2; SA.PS[qd * 64 + col] = p3; q1 += q0; q2 += q1; q3 += q2; SB.PS[qd * 64 + col] = q3;
                __syncthreads();
                float ba = 0.f, bb = 0.f;
#pragma unroll
                for (int q2_ = 0; q2_ < 7; ++q2_) { ba += (q2_ < qd) ? SA.PS[q2_ * 64 + col] : 0.f; bb += (q2_ < qd) ? SB.PS[q2_ * 64 + col] : 0.f; }
                SA.CUM[(4 * qd) * 64 + col] = ba + p0; SA.CUM[(4 * qd + 1) * 64 + col] = ba + p1; SA.CUM[(4 * qd + 2) * 64 + col] = ba + p2; SA.CUM[(4 * qd + 3) * 64 + col] = ba + p3;
                SB.CUM[(4 * qd) * 64 + col] = bb + q0; SB.CUM[(4 * qd + 1) * 64 + col] = bb + q1; SB.CUM[(4 * qd + 2) * 64 + col] = bb + q2; SB.CUM[(4 * qd + 3) * 64 + col] = bb + q3; }
            __syncthreads();
            w5_prep_scale(cst, wa, SA, BON, b, h, chunk, pj, pq);
            w5_prep_scale(cst, wb, SB, BON, b, h, chunk + 1, pj, pq);
            if (chunk + 2 < chunk_end) { w5_load(wa, COLS, LORA, b, chunk + 2, pj, hc); w5_load(wb, COLS, LORA, b, chunk + 3, pj, hc); }
            __syncthreads();
            f32x16 accw;
#pragma unroll
            for (int i = 0; i < 16; ++i) accw[i] = 0.f;
            if (wave < 4) w5_s1(SA, wave, accw, lane); else w5_s1(SB, wave - 4, accw, lane);
            __syncthreads();
            if (wave < 4) {
                const WSet& S_ = (wave >= 2) ? SB : SA;
                const int q = lane & 3, rowi = ((wave & 1) * 64 + lane) >> 2;
                float xq0, xq1, xq2, xq3, xq4, xq5, xq6, xq7;
                xq0 = (0 + q == rowi) ? 1.0f : 0.0f;
                xq1 = (4 + q == rowi) ? 1.0f : 0.0f;
                xq2 = (8 + q == rowi) ? 1.0f : 0.0f;
                xq3 = (12 + q == rowi) ? 1.0f : 0.0f;
                xq4 = (16 + q == rowi) ? 1.0f : 0.0f;
                xq5 = (20 + q == rowi) ? 1.0f : 0.0f;
                xq6 = (24 + q == rowi) ? 1.0f : 0.0f;
                xq7 = (28 + q == rowi) ? 1.0f : 0.0f;
                const bool kq0 = q == 0, kq1 = q == 1, kq2 = q == 2, kq3 = q == 3;
                const LAS float* np_ = S_.NabT + q * 8;
                f32x4 n1_0, n2_0, n3_0, n4_0, n5_0, n6_0, n7_0, n8_0, n9_0, n10_0, n11_0, n12_0, n13_0, n14_0, n15_0, n16_0, n17_0, n17_1, n18_0, n18_1, n19_0, n19_1, n20_0, n20_1, n21_0, n21_1, n22_0, n22_1, n23_0, n23_1, n24_0, n24_1, n25_0, n25_1, n26_0, n26_1, n27_0, n27_1, n28_0, n28_1, n29_0, n29_1, n30_0, n30_1, n31_0, n31_1;
                float pe1, pe2, pe3, pe4, pe5, pe6, pe7, pe8, pe9, pe10, pe11, pe12, pe13, pe14, pe15, pe16, pe17, pe18, pe19, pe20, pe21, pe22, pe23, pe24, pe25, pe26, pe27, pe28, pe29, pe30, pe31, pe32;
                n1_0 = *(const LAS f32x4*)(np_ + 1 * 36); n2_0 = *(const LAS f32x4*)(np_ + 2 * 36); pe1 = 0.f;
                { n3_0 = *(const LAS f32x4*)(np_ + 3 * 36); float p = pe1; asm("v_fmac_f32 %0, %1, %2" : "+v"(p) : "v"(xq0), "v"(n1_0[0])); p += dpp_f(p, 0); pe2 = 0.f; p += dpp_f(p, 1); xq0 = kq1 ? (xq0 + p) : xq0; asm volatile("" : "+v"(xq0), "+v"(np_) : "v"(n1_0)); }
                { n4_0 = *(const LAS f32x4*)(np_ + 4 * 36); float p = pe2; asm("v_fmac_f32 %0, %1, %2" : "+v"(p) : "v"(xq0), "v"(n2_0[0])); p += dpp_f(p, 0); pe3 = 0.f; p += dpp_f(p, 1); xq0 = kq2 ? (xq0 + p) : xq0; asm volatile("" : "+v"(xq0), "+v"(np_) : "v"(n2_0)); }
                { n5_0 = *(const LAS f32x4*)(np_ + 5 * 36); float p = pe3; asm("v_fmac_f32 %0, %1, %2" : "+v"(p) : "v"(xq0), "v"(n3_0[0])); p += dpp_f(p, 0); pe4 = 0.f; p += dpp_f(p, 1); xq0 = kq3 ? (xq0 + p) : xq0; asm volatile("" : "+v"(xq0), "+v"(np_) : "v"(n3_0)); }
                { n6_0 = *(const LAS f32x4*)(np_ + 6 * 36); float p = pe4; asm("v_fmac_f32 %0, %1, %2" : "+v"(p) : "v"(xq0), "v"(n4_0[0])); p += dpp_f(p, 0); pe5 = 0.f; asm("v_fmac_f32 %0, %1, %2" : "+v"(pe5) : "v"(xq0), "v"(n5_0[0])); p += dpp_f(p, 1); xq1 = kq0 ? (xq1 + p) : xq1; asm volatile("" : "+v"(xq1), "+v"(np_) : "v"(n4_0)); }
                { n7_0 = *(const LAS f32x4*)(np_ + 7 * 36); float p = pe5; asm("v_fmac_f32 %0, %1, %2" : "+v"(p) : "v"(xq1), "v"(n5_0[1])); p += dpp_f(p, 0); pe6 = 0.f; asm("v_fmac_f32 %0, %1, %2" : "+v"(pe6) : "v"(xq0), "v"(n6_0[0])); p += dpp_f(p, 1); xq1 = kq1 ? (xq1 + p) : xq1; asm volatile("" : "+v"(xq1), "+v"(np_) : "v"(n5_0)); }
                { n8_0 = *(const LAS f32x4*)(np_ + 8 * 36); float p = pe6; asm("v_fmac_f32 %0, %1, %2" : "+v"(p) : "v"(xq1), "v"(n6_0[1])); p += dpp_f(p, 0); pe7 = 0.f; asm("v_fmac_f32 %0, %1, %2" : "+v"(pe7) : "v"(xq0), "v"(n7_0[0])); p += dpp_f(p, 1); xq1 = kq2 ? (xq1 + p) : xq1; asm volatile("" : "+v"(xq1), "+v"(np_) : "v"(n6_0)); }
                { n9_0 = *(const LAS f32x4*)(np_ + 9 * 36); float p = pe7; asm("v_fmac_f32 %0, %1, %2" : "+v"(p) : "v"(xq1), "v"(n7_0[1])); p += dpp_f(p, 0); pe8 = 0.f; asm("v_fmac_f32 %0, %1, %2" : "+v"(pe8) : "v"(xq0), "v"(n8_0[0])); p += dpp_f(p, 1); xq1 = kq3 ? (xq1 + p) : xq1; asm volatile("" : "+v"(xq1), "+v"(np_) : "v"(n7_0)); }
                { n10_0 = *(const LAS f32x4*)(np_ + 10 * 36); float p = pe8; asm("v_fmac_f32 %0, %1, %2" : "+v"(p) : "v"(xq1), "v"(n8_0[1])); p += dpp_f(p, 0); pe9 = 0.f; asm("v_fmac_f32 %0, %1, %2" : "+v"(pe9) : "v"(xq0), "v"(n9_0[0])); asm("v_fmac_f32 %0, %1, %2" : "+v"(pe9) : "v"(xq1), "v"(n9_0[1])); p += dpp_f(p, 1); xq2 = kq0 ? (xq2 + p) : xq2; asm volatile("" : "+v"(xq2), "+v"(np_) : "v"(n8_0)); }
                { n11_0 = *(const LAS f32x4*)(np_ + 11 * 36); float p = pe9; asm("v_fmac_f32 %0, %1, %2" : "+v"(p) : "v"(xq2), "v"(n9_0[2])); p += dpp_f(p, 0); pe10 = 0.f; asm("v_fmac_f32 %0, %1, %2" : "+v"(pe10) : "v"(xq0), "v"(n10_0[0])); asm("v_fmac_f32 %0, %1, %2" : "+v"(pe10) : "v"(xq1), "v"(n10_0[1])); p += dpp_f(p, 1); xq2 = kq1 ? (xq2 + p) : xq2; asm volatile("" : "+v"(xq2), "+v"(np_) : "v"(n9_0)); }
                { n12_0 = *(const LAS f32x4*)(np_ + 12 * 36); float p = pe10; asm("v_fmac_f32 %0, %1, %2" : "+v"(p) : "v"(xq2), "v"(n10_0[2])); p += dpp_f(p, 0); pe11 = 0.f; asm("v_fmac_f32 %0, %1, %2" : "+v"(pe11) : "v"(xq0), "v"(n11_0[0])); asm("v_fmac_f32 %0, %1, %2" : "+v"(pe11) : "v"(xq1), "v"(n11_0[1])); p += dpp_f(p, 1); xq2 = kq2 ? (xq2 + p) : xq2; asm volatile("" : "+v"(xq2), "+v"(np_) : "v"(n10_0)); }
                { n13_0 = *(const LAS f32x4*)(np_ + 13 * 36); float p = pe11; asm("v_fmac_f32 %0, %1, %2" : "+v"(p) : "v"(xq2), "v"(n11_0[2])); p += dpp_f(p, 0); pe12 = 0.f; asm("v_fmac_f32 %0, %1, %2" : "+v"(pe12) : "v"(xq0), "v"(n12_0[0])); asm("v_fmac_f32 %0, %1, %2" : "+v"(pe12) : "v"(xq1), "v"(n12_0[1])); p += dpp_f(p, 1); xq2 = kq3 ? (xq2 + p) : xq2; asm volatile("" : "+v"(xq2), "+v"(np_) : "v"(n11_0)); }
                { n14_0 = *(const LAS f32x4*)(np_ + 14 * 36); float p = pe12; asm("v_fmac_f32 %0, %1, %2" : "+v"(p) : "v"(xq2), "v"(n12_0[2])); p += dpp_f(p, 0); pe13 = 0.f; asm("v_fmac_f32 %0, %1, %2" : "+v"(pe13) : "v"(xq0), "v"(n13_0[0])); asm("v_fmac_f32 %0, %1, %2" : "+v"(pe13) : "v"(xq1), "v"(n13_0[1])); asm("v_fmac_f32 %0, %1, %2" : "+v"(pe13) : "v"(xq2), "v"(n13_0[2])); p += dpp_f(p, 1); xq3 = kq0 ? (xq3 + p) : xq3; asm volatile("" : "+v"(xq3), "+v"(np_) : "v"(n12_0)); }
                { n15_0 = *(const LAS f32x4*)(np_ + 15 * 36); float p = pe13; asm("v_fmac_f32 %0, %1, %2" : "+v"(p) : "v"(xq3), "v"(n13_0[3])); p += dpp_f(p, 0); pe14 = 0.f; asm("v_fmac_f32 %0, %1, %2" : "+v"(pe14) : "v"(xq0), "v"(n14_0[0])); asm("v_fmac_f32 %0, %1, %2" : "+v"(pe14) : "v"(xq1), "v"(n14_0[1])); asm("v_fmac_f32 %0, %1, %2" : "+v"(pe14) : "v"(xq2), "v"(n14_0[2])); p += dpp_f(p, 1); xq3 = kq1 ? (xq3 + p) : xq3; asm volatile("" : "+v"(xq3), "+v"(np_) : "v"(n13_0)); }
                { n16_0 = *(const LAS f32x4*)(np_ + 16 * 36); float p = pe14; asm("v_fmac_f32 %0, %1, %2" : "+v"(p) : "v"(xq3), "v"(n14_0[3])); p += dpp_f(p, 0); pe15 = 0.f; asm("v_fmac_f32 %0, %1, %2" : "+v"(pe15) : "v"(xq0), "v"(n15_0[0])); asm("v_fmac_f32 %0, %1, %2" : "+v"(pe15) : "v"(xq1), "v"(n15_0[1])); asm("v_fmac_f32 %0, %1, %2" : "+v"(pe15) : "v"(xq2), "v"(n15_0[2])); p += dpp_f(p, 1); xq3 = kq2 ? (xq3 + p) : xq3; asm volatile("" : "+v"(xq3), "+v"(np_) : "v"(n14_0)); }
                { n17_0 = *(const LAS f32x4*)(np_ + 17 * 36); n17_1 = *(const LAS f32x4*)(np_ + 17 * 36 + 4); float p = pe15; asm("v_fmac_f32 %0, %1, %2" : "+v"(p) : "v"(xq3), "v"(n15_0[3])); p += dpp_f(p, 0); pe16 = 0.f; asm("v_fmac_f32 %0, %1, %2" : "+v"(pe16) : "v"(xq0), "v"(n16_0[0])); asm("v_fmac_f32 %0, %1, %2" : "+v"(pe16) : "v"(xq1), "v"(n16_0[1])); asm("v_fmac_f32 %0, %1, %2" : "+v"(pe16) : "v"(xq2), "v"(n16_0[2])); p += dpp_f(p, 1); xq3 = kq3 ? (xq3 + p) : xq3; asm volatile("" : "+v"(xq3), "+v"(np_) : "v"(n15_0)); }
                { n18_0 = *(const LAS f32x4*)(np_ + 18 * 36); n18_1 = *(const LAS f32x4*)(np_ + 18 * 36 + 4); float p = pe16; asm("v_fmac_f32 %0, %1, %2" : "+v"(p) : "v"(xq3), "v"(n16_0[3])); p += dpp_f(p, 0); pe17 = 0.f; asm("v_fmac_f32 %0, %1, %2" : "+v"(pe17) : "v"(xq0), "v"(n17_0[0])); asm("v_fmac_f32 %0, %1, %2" : "+v"(pe17) : "v"(xq1), "v"(n17_0[1])); asm("v_fmac_f32 %0, %1, %2" : "+v"(pe17) : "v"(xq2), "v"(n17_0[2])); asm("v_fmac_f32 %0, %1, %2" : "+v"(pe17) : "v"(xq3), "v"(n17_0[3])); p += dpp_f(p, 1); xq4 = kq0 ? (xq4 + p) : xq4; asm volatile("" : "+v"(xq4), "+v"(np_) : "v"(n16_0)); }
                { n19_0 = *(const LAS f32x4*)(np_ + 19 * 36); n19_1 = *(const LAS f32x4*)(np_ + 19 * 36 + 4); float p = pe17; asm("v_fmac_f32 %0, %1, %2" : "+v"(p) : "v"(xq4), "v"(n17_1[0])); p += dpp_f(p, 0); pe18 = 0.f; asm("v_fmac_f32 %0, %1, %2" : "+v"(pe18) : "v"(xq0), "v"(n18_0[0])); asm("v_fmac_f32 %0, %1, %2" : "+v"(pe18) : "v"(xq1), "v"(n18_0[1])); asm("v_fmac_f32 %0, %1, %2" : "+v"(pe18) : "v"(xq2), "v"(n18_0[2])); asm("v_fmac_f32 %0, %1, %2" : "+v"(pe18) : "v"(xq3), "v"(n18_0[3])); p += dpp_f(p, 1); xq4 = kq1 ? (xq4 + p) : xq4; asm volatile("" : "+v"(xq4), "+v"(np_) : "v"(n17_0), "v"(n17_1)); }
                { n20_0 = *(const LAS f32x4*)(np_ + 20 * 36); n20_1 = *(const LAS f32x4*)(np_ + 20 * 36 + 4); float p = pe18; asm("v_fmac_f32 %0, %1, %2" : "+v"(p) : "v"(xq4), "v"(n18_1[0])); p += dpp_f(p, 0); pe19 = 0.f; asm("v_fmac_f32 %0, %1, %2" : "+v"(pe19) : "v"(xq0), "v"(n19_0[0])); asm("v_fmac_f32 %0, %1, %2" : "+v"(pe19) : "v"(xq1), "v"(n19_0[1])); asm("v_fmac_f32 %0, %1, %2" : "+v"(pe19) : "v"(xq2), "v"(n19_0[2])); asm("v_fmac_f32 %0, %1, %2" : "+v"(pe19) : "v"(xq3), "v"(n19_0[3])); p += dpp_f(p, 1); xq4 = kq2 ? (xq4 + p) : xq4; asm volatile("" : "+v"(xq4), "+v"(np_) : "v"(n18_0), "v"(n18_1)); }
                { n21_0 = *(const LAS f32x4*)(np_ + 21 * 36); n21_1 = *(const LAS f32x4*)(np_ + 21 * 36 + 4); float p = pe19; asm("v_fmac_f32 %0, %1, %2" : "+v"(p) : "v"(xq4), "v"(n19_1[0])); p += dpp_f(p, 0); pe20 = 0.f; asm("v_fmac_f32 %0, %1, %2" : "+v"(pe20) : "v"(xq0), "v"(n20_0[0])); asm("v_fmac_f32 %0, %1, %2" : "+v"(pe20) : "v"(xq1), "v"(n20_0[1])); asm("v_fmac_f32 %0, %1, %2" : "+v"(pe20) : "v"(xq2), "v"(n20_0[2])); asm("v_fmac_f32 %0, %1, %2" : "+v"(pe20) : "v"(xq3), "v"(n20_0[3])); p += dpp_f(p, 1); xq4 = kq3 ? (xq4 + p) : xq4; asm volatile("" : "+v"(xq4), "+v"(np_) : "v"(n19_0), "v"(n19_1)); }
                { n22_0 = *(const LAS f32x4*)(np_ + 22 * 36); n22_1 = *(const LAS f32x4*)(np_ + 22 * 36 + 4); float p = pe20; asm("v_fmac_f32 %0, %1, %2" : "+v"(p) : "v"(xq4), "v"(n20_1[0])); p += dpp_f(p, 0); pe21 = 0.f; asm("v_fmac_f32 %0, %1, %2" : "+v"(pe21) : "v"(xq0), "v"(n21_0[0])); asm("v_fmac_f32 %0, %1, %2" : "+v"(pe21) : "v"(xq1), "v"(n21_0[1])); asm("v_fmac_f32 %0, %1, %2" : "+v"(pe21) : "v"(xq2), "v"(n21_0[2])); asm("v_fmac_f32 %0, %1, %2" : "+v"(pe21) : "v"(xq3), "v"(n21_0[3])); asm("v_fmac_f32 %0, %1, %2" : "+v"(pe21) : "v"(xq4), "v"(n21_1[0])); p += dpp_f(p, 1); xq5 = kq0 ? (xq5 + p) : xq5; asm volatile("" : "+v"(xq5), "+v"(np_) : "v"(n20_0), "v"(n20_1)); }
                { n23_0 = *(const LAS f32x4*)(np_ + 23 * 36); n23_1 = *(const LAS f32x4*)(np_ + 23 * 36 + 4); float p = pe21; asm("v_fmac_f32 %0, %1, %2" : "+v"(p) : "v"(xq5), "v"(n21_1[1])); p += dpp_f(p, 0); pe22 = 0.f; asm("v_fmac_f32 %0, %1, %2" : "+v"(pe22) : "v"(xq0), "v"(n22_0[0])); asm("v_fmac_f32 %0, %1, %2" : "+v"(pe22) : "v"(xq1), "v"(n22_0[1])); asm("v_fmac_f32 %0, %1, %2" : "+v"(pe22) : "v"(xq2), "v"(n22_0[2])); asm("v_fmac_f32 %0, %1, %2" : "+v"(pe22) : "v"(xq3), "v"(n22_0[3])); asm("v_fmac_f32 %0, %1, %2" : "+v"(pe22) : "v"(xq4), "v"(n22_1[0])); p += dpp_f(p, 1); xq5 = kq1 ? (xq5 + p) : xq5; asm volatile("" : "+v"(xq5), "+v"(np_) : "v"(n21_0), "v"(n21_1)); }
                { n24_0 = *(const LAS f32x4*)(np_ + 24 * 36); n24_1 = *(const LAS f32x4*)(np_ + 24 * 36 + 4); float p = pe22; asm("v_fmac_f32 %0, %1, %2" : "+v"(p) : "v"(xq5), "v"(n22_1[1])); p += dpp_f(p, 0); pe23 = 0.f; asm("v_fmac_f32 %0, %1, %2" : "+v"(pe23) : "v"(xq0), "v"(n23_0[0])); asm("v_fmac_f32 %0, %1, %2" : "+v"(pe23) : "v"(xq1), "v"(n23_0[1])); asm("v_fmac_f32 %0, %1, %2" : "+v"(pe23) : "v"(xq2), "v"(n23_0[2])); asm("v_fmac_f32 %0, %1, %2" : "+v"(pe23) : "v"(xq3), "v"(n23_0[3])); asm("v_fmac_f32 %0, %1, %2" : "+v"(pe23) : "v"(xq4), "v"(n23_1[0])); p += dpp_f(p, 1); xq5 = kq2 ? (xq5 + p) : xq5; asm volatile("" : "+v"(xq5), "+v"(np_) : "v"(n22_0), "v"(n22_1)); }
                { n25_0 = *(const LAS f32x4*)(np_ + 25 * 36); n25_1 = *(const LAS f32x4*)(np_ + 25 * 36 + 4); float p = pe23; asm("v_fmac_f32 %0, %1, %2" : "+v"(p) : "v"(xq5), "v"(n23_1[1])); p += dpp_f(p, 0); pe24 = 0.f; asm("v_fmac_f32 %0, %1, %2" : "+v"(pe24) : "v"(xq0), "v"(n24_0[0])); asm("v_fmac_f32 %0, %1, %2" : "+v"(pe24) : "v"(xq1), "v"(n24_0[1])); asm("v_fmac_f32 %0, %1, %2" : "+v"(pe24) : "v"(xq2), "v"(n24_0[2])); asm("v_fmac_f32 %0, %1, %2" : "+v"(pe24) : "v"(xq3), "v"(n24_0[3])); asm("v_fmac_f32 %0, %1, %2" : "+v"(pe24) : "v"(xq4), "v"(n24_1[0])); p += dpp_f(p, 1); xq5 = kq3 ? (xq5 + p) : xq5; asm volatile("" : "+v"(xq5), "+v"(np_) : "v"(n23_0), "v"(n23_1)); }
                { n26_0 = *(const LAS f32x4*)(np_ + 26 * 36); n26_1 = *(const LAS f32x4*)(np_ + 26 * 36 + 4); float p = pe24; asm("v_fmac_f32 %0, %1, %2" : "+v"(p) : "v"(xq5), "v"(n24_1[1])); p += dpp_f(p, 0); pe25 = 0.f; asm("v_fmac_f32 %0, %1, %2" : "+v"(pe25) : "v"(xq0), "v"(n25_0[0])); asm("v_fmac_f32 %0, %1, %2" : "+v"(pe25) : "v"(xq1), "v"(n25_0[1])); asm("v_fmac_f32 %0, %1, %2" : "+v"(pe25) : "v"(xq2), "v"(n25_0[2])); asm("v_fmac_f32 %0, %1, %2" : "+v"(pe25) : "v"(xq3), "v"(n25_0[3])); asm("v_fmac_f32 %0, %1, %2" : "+v"(pe25) : "v"(xq4), "v"(n25_1[0])); asm("v_fmac_f32 %0, %1, %2" : "+v"(pe25) : "v"(xq5), "v"(n25_1[1])); p += dpp_f(p, 1); xq6 = kq0 ? (xq6 + p) : xq6; asm volatile("" : "+v"(xq6), "+v"(np_) : "v"(n24_0), "v"(n24_1)); }
                { n27_0 = *(const LAS f32x4*)(np_ + 27 * 36); n27_1 = *(const LAS f32x4*)(np_ + 27 * 36 + 4); float p = pe25; asm("v_fmac_f32 %0, %1, %2" : "+v"(p) : "v"(xq6), "v"(n25_1[2])); p += dpp_f(p, 0); pe26 = 0.f; asm("v_fmac_f32 %0, %1, %2" : "+v"(pe26) : "v"(xq0), "v"(n26_0[0])); asm("v_fmac_f32 %0, %1, %2" : "+v"(pe26) : "v"(xq1), "v"(n26_0[1])); asm("v_fmac_f32 %0, %1, %2" : "+v"(pe26) : "v"(xq2), "v"(n26_0[2])); asm("v_fmac_f32 %0, %1, %2" : "+v"(pe26) : "v"(xq3), "v"(n26_0[3])); asm("v_fmac_f32 %0, %1, %2" : "+v"(pe26) : "v"(xq4), "v"(n26_1[0])); asm("v_fmac_f32 %0, %1, %2" : "+v"(pe26) : "v"(xq5), "v"(n26_1[1])); p += dpp_f(p, 1); xq6 = kq1 ? (xq6 + p) : xq6; asm volatile("" : "+v"(xq6), "+v"(np_) : "v"(n25_0), "v"(n25_1)); }
                { n28_0 = *(const LAS f32x4*)(np_ + 28 * 36); n28_1 = *(const LAS f32x4*)(np_ + 28 * 36 + 4); float p = pe26; asm("v_fmac_f32 %0, %1, %2" : "+v"(p) : "v"(xq6), "v"(n26_1[2])); p += dpp_f(p, 0); pe27 = 0.f; asm("v_fmac_f32 %0, %1, %2" : "+v"(pe27) : "v"(xq0), "v"(n27_0[0])); asm("v_fmac_f32 %0, %1, %2" : "+v"(pe27) : "v"(xq1), "v"(n27_0[1])); asm("v_fmac_f32 %0, %1, %2" : "+v"(pe27) : "v"(xq2), "v"(n27_0[2])); asm("v_fmac_f32 %0, %1, %2" : "+v"(pe27) : "v"(xq3), "v"(n27_0[3])); asm("v_fmac_f32 %0, %1, %2" : "+v"(pe27) : "v"(xq4), "v"(n27_1[0])); asm("v_fmac_f32 %0, %1, %2" : "+v"(pe27) : "v"(xq5), "v"(n27_1[1])); p += dpp_f(p, 1); xq6 = kq2 ? (xq6 + p) : xq6; asm volatile("" : "+v"(xq6), "+v"(np_) : "v"(n26_0), "v"(n26_1)); }
                { n29_0 = *(const LAS f32x4*)(np_ + 29 * 36); n29_1 = *(const LAS f32x4*)(np_ + 29 * 36 + 4); float p = pe27; asm("v_fmac_f32 %0, %1, %2" : "+v"(p) : "v"(xq6), "v"(n27_1[2])); p += dpp_f(p, 0); pe28 = 0.f; asm("v_fmac_f32 %0, %1, %2" : "+v"(pe28) : "v"(xq0), "v"(n28_0[0])); asm("v_fmac_f32 %0, %1, %2" : "+v"(pe28) : "v"(xq1), "v"(n28_0[1])); asm("v_fmac_f32 %0, %1, %2" : "+v"(pe28) : "v"(xq2), "v"(n28_0[2])); asm("v_fmac_f32 %0, %1, %2" : "+v"(pe28) : "v"(xq3), "v"(n28_0[3])); asm("v_fmac_f32 %0, %1, %2" : "+v"(pe28) : "v"(xq4), "v"(n28_1[0])); asm("v_fmac_f32 %0, %1, %2" : "+v"(pe28) : "v"(xq5), "v"(n28_1[1])); p += dpp_f(p, 1); xq6 = kq3 ? (xq6 + p) : xq6; asm volatile("" : "+v"(xq6), "+v"(np_) : "v"(n27_0), "v"(n27_1)); }
                { n30_0 = *(const LAS f32x4*)(np_ + 30 * 36); n30_1 = *(const LAS f32x4*)(np_ + 30 * 36 + 4); float p = pe28; asm("v_fmac_f32 %0, %1, %2" : "+v"(p) : "v"(xq6), "v"(n28_1[2])); p += dpp_f(p, 0); pe29 = 0.f; asm("v_fmac_f32 %0, %1, %2" : "+v"(pe29) : "v"(xq0), "v"(n29_0[0])); asm("v_fmac_f32 %0, %1, %2" : "+v"(pe29) : "v"(xq1), "v"(n29_0[1])); asm("v_fmac_f32 %0, %1, %2" : "+v"(pe29) : "v"(xq2), "v"(n29_0[2])); asm("v_fmac_f32 %0, %1, %2" : "+v"(pe29) : "v"(xq3), "v"(n29_0[3])); asm("v_fmac_f32 %0, %1, %2" : "+v"(pe29) : "v"(xq4), "v"(n29_1[0])); asm("v_fmac_f32 %0, %1, %2" : "+v"(pe29) : "v"(xq5), "v"(n29_1[1])); asm("v_fmac_f32 %0, %1, %2" : "+v"(pe29) : "v"(xq6), "v"(n29_1[2])); p += dpp_f(p, 1); xq7 = kq0 ? (xq7 + p) : xq7; asm volatile("" : "+v"(xq7), "+v"(np_) : "v"(n28_0), "v"(n28_1)); }
                { n31_0 = *(const LAS f32x4*)(np_ + 31 * 36); n31_1 = *(const LAS f32x4*)(np_ + 31 * 36 + 4); float p = pe29; asm("v_fmac_f32 %0, %1, %2" : "+v"(p) : "v"(xq7), "v"(n29_1[3])); p += dpp_f(p, 0); pe30 = 0.f; asm("v_fmac_f32 %0, %1, %2" : "+v"(pe30) : "v"(xq0), "v"(n30_0[0])); asm("v_fmac_f32 %0, %1, %2" : "+v"(pe30) : "v"(xq1), "v"(n30_0[1])); asm("v_fmac_f32 %0, %1, %2" : "+v"(pe30) : "v"(xq2), "v"(n30_0[2])); asm("v_fmac_f32 %0, %1, %2" : "+v"(pe30) : "v"(xq3), "v"(n30_0[3])); asm("v_fmac_f32 %0, %1, %2" : "+v"(pe30) : "v"(xq4), "v"(n30_1[0])); asm("v_fmac_f32 %0, %1, %2" : "+v"(pe30) : "v"(xq5), "v"(n30_1[1])); asm("v_fmac_f32 %0, %1, %2" : "+v"(pe30) : "v"(xq6), "v"(n30_1[2])); p += dpp_f(p, 1); xq7 = kq1 ? (xq7 + p) : xq7; asm volatile("" : "+v"(xq7), "+v"(np_) : "v"(n29_0), "v"(n29_1)); }
                { float p = pe30; asm("v_fmac_f32 %0, %1, %2" : "+v"(p) : "v"(xq7), "v"(n30_1[3])); p += dpp_f(p, 0); pe31 = 0.f; asm("v_fmac_f32 %0, %1, %2" : "+v"(pe31) : "v"(xq0), "v"(n31_0[0])); asm("v_fmac_f32 %0, %1, %2" : "+v"(pe31) : "v"(xq1), "v"(n31_0[1])); asm("v_fmac_f32 %0, %1, %2" : "+v"(pe31) : "v"(xq2), "v"(n31_0[2])); asm("v_fmac_f32 %0, %1, %2" : "+v"(pe31) : "v"(xq3), "v"(n31_0[3])); asm("v_fmac_f32 %0, %1, %2" : "+v"(pe31) : "v"(xq4), "v"(n31_1[0])); asm("v_fmac_f32 %0, %1, %2" : "+v"(pe31) : "v"(xq5), "v"(n31_1[1])); asm("v_fmac_f32 %0, %1, %2" : "+v"(pe31) : "v"(xq6), "v"(n31_1[2])); p += dpp_f(p, 1); xq7 = kq2 ? (xq7 + p) : xq7; asm volatile("" : "+v"(xq7), "+v"(np_) : "v"(n30_0), "v"(n30_1)); }
                { float p = pe31; asm("v_fmac_f32 %0, %1, %2" : "+v"(p) : "v"(xq7), "v"(n31_1[3])); p += dpp_f(p, 0); p += dpp_f(p, 1); xq7 = kq3 ? (xq7 + p) : xq7; asm volatile("" : "+v"(xq7), "+v"(np_) : "v"(n31_0), "v"(n31_1)); }
                LAS bf16_t* dst = S_.Tb + rowi * 40 + q;
                dst[0] = bf1(xq0);
                dst[4] = bf1(xq1);
                dst[8] = bf1(xq2);
                dst[12] = bf1(xq3);
                dst[16] = bf1(xq4);
                dst[20] = bf1(xq5);
                dst[24] = bf1(xq6);
                dst[28] = bf1(xq7);
            }
            __syncthreads();
            if (wave < 6) { if (wave < 3) w5_s2b(SA, wave, lane); else w5_s2b(SB, wave - 3, lane); }
            __syncthreads();
            w5_s3(SA, wave, accw, lane);
            w5_s3(SB, (wave + 4) & 7, accw, lane);
            __syncthreads();
            { const size_t idx = (size_t)bh * 32 + (chunk & 31);
              w5_copyout(SA, STG_R + idx * STG_R_STRIDE, STG_P + idx * 8192, tid);
              w5_copyout(SB, STG_R + (idx + 1) * STG_R_STRIDE, STG_P + (idx + 1) * 8192, tid); }
            __syncthreads();
        }
    }
}
__device__ __forceinline__ void wkv5b(const Args& a, LAS unsigned char* lds, const int round) {
    const int tid = threadIdx.x, lane = tid & 63, wave = __builtin_amdgcn_readfirstlane(tid >> 6);
    unsigned char* ws = a.ws;
    const bf16_t* COLS = (const bf16_t*)(ws + WS_A); float* Y = (float*)(ws + WS_B);
    const unsigned char* STG_R = ws + WS_RWKV; const unsigned char* STG_P = (const unsigned char*)a.out + 96 * MiB;
    constexpr int SET = 24576;
    LAS bf16_t* SBF = (LAS bf16_t*)(lds + 118272);
    LAS float* YST = (LAS float*)(lds + 127488);
    LAS float* SSAVE = (LAS float*)(lds + 135936);
    for (int item = blockIdx.x; item < 256; item += gridDim.x) {
        const int bh = item >> 1, half = item & 1, b = bh >> 3, h = bh & 7;
        const int pj = tid >> 4, pq = tid & 15;
        f32x16 Sacc;
#pragma unroll
        for (int i = 0; i < 16; ++i) Sacc[i] = 0.f;
        __syncthreads();
        if (round == 0) { for (int i = tid; i < 2 * 32 * 72 / 2; i += 512) ((LAS unsigned*)SBF)[i] = 0u; }
        else if (wave < 2) {
#pragma unroll
            for (int i = 0; i < 16; ++i) Sacc[i] = SSAVE[(wave * 16 + i) * 64 + lane]; }
        const f32x2 muv = *(const f32x2*)(a.in[I_MU] + C_V + h * 64 + 32 * half + 2 * pq);
        u32x4 gP, gA, gB; unsigned vcur, vprv;
#define W5_LOAD(chunk) do { const size_t idx_ = (size_t)bh * 32 + ((chunk) & 31); const unsigned char* gr_ = STG_R + idx_ * STG_R_STRIDE; const unsigned char* gp_ = STG_P + idx_ * 8192; \
            gP = *(const u32x4*)(gp_ + (tid >> 3) * 128 + (tid & 7) * 16); \
            gA = (tid < 256) ? *(const u32x4*)(gr_ + (tid >> 3) * 128 + (tid & 7) * 16) : *(const u32x4*)(gr_ + 4096 + ((tid - 256) >> 2) * 64 + ((tid - 256) & 3) * 16); \
            gB = (tid < 144) ? *(const u32x4*)(gr_ + 8192 + tid * 16) : (u32x4){0u, 0u, 0u, 0u}; \
            { const int s_ = (chunk) * 32 + pj; const bf16_t* cb_ = COLS + ((size_t)b * SEQ + s_) * INC + C_V + h * 64 + 32 * half + 2 * pq; vcur = *(const unsigned*)cb_; vprv = (s_ > 0) ? *(const unsigned*)(cb_ - INC) : 0u; } } while (0)
#define W5_STORE(setb) do { LAS unsigned char* sb_ = lds + 10240 + (setb) * SET; \
            *(LAS u32x4*)(sb_ + 12288 + (tid >> 3) * 144 + (tid & 7) * 16) = gP; \
            if (tid < 256) *(LAS u32x4*)(sb_ + 7680 + (tid >> 3) * 144 + (tid & 7) * 16) = gA; \
            else *(LAS u32x4*)(sb_ + 2560 + ((tid - 256) >> 2) * 80 + ((tid - 256) & 3) * 16) = gA; \
            if (tid < 128) *(LAS u32x4*)(sb_ + (tid >> 2) * 80 + (tid & 3) * 16) = gB; \
            else if (tid < 144) *(LAS u32x4*)(sb_ + 21504 + (tid - 128) * 16) = gB; \
            { const float c0_ = bflo(vcur), c1_ = bfhi(vcur), p0_ = bflo(vprv), p1_ = bfhi(vprv); LAS bf16_t* vm_ = (LAS bf16_t*)(sb_ + 21760); \
                vm_[(2 * pq) * 40 + pj] = bf1(c0_ + (p0_ - c0_) * muv[0]); vm_[(2 * pq + 1) * 40 + pj] = bf1(c1_ + (p1_ - c1_) * muv[1]); } } while (0)
        const int chunk0 = 32 * round;
        W5_LOAD(chunk0); W5_STORE(chunk0 & 1);
        __syncthreads();
        for (int chunk = chunk0; chunk < chunk0 + 32; ++chunk) {
            const int bi = chunk & 1;
            if (chunk + 1 < chunk0 + 32) W5_LOAD(chunk + 1);
            { LAS unsigned char* sb = lds + 10240 + bi * SET;
              LAS bf16_t* WyT = (LAS bf16_t*)sb; LAS bf16_t* WzT = (LAS bf16_t*)(sb + 2560); LAS bf16_t* R2T = (LAS bf16_t*)(sb + 7680); LAS bf16_t* PpT = (LAS bf16_t*)(sb + 12288);
              LAS float* GC = (LAS float*)(sb + 21504); LAS bf16_t* VmT = (LAS bf16_t*)(sb + 21760); LAS float* YSTc = YST + bi * (32 * 33);
            if (wave < 3) {
                const int t = lane & 31; const LAS bf16_t* Sb = SBF + bi * (32 * 72); f32x16 acc;
#pragma unroll
                for (int i = 0; i < 16; ++i) acc[i] = 0.f;
                if (wave < 2) {
                    acc = mm32<2>(acc, VmT, 40, WzT + 32 * wave * 40, 40, lane);
                    acc = mm32<4>(acc, Sb, 72, PpT + 32 * wave * 72, 72, lane);
                    const float gc = GC[32 * wave + t]; LAS bf16_t* Sn = SBF + (bi ^ 1) * (32 * 72);
#pragma unroll
                    for (int i = 0; i < 16; ++i) { Sacc[i] = fmaf(Sacc[i], gc, acc[i]); Sn[TROW(i, lane) * 72 + 32 * wave + t] = bf1(Sacc[i]); }
                } else {
                    acc = mm32<2>(acc, VmT, 40, WyT, 40, lane);
                    acc = mm32<4>(acc, Sb, 72, R2T, 72, lane);
#pragma unroll
                    for (int i = 0; i < 16; ++i) YSTc[t * 33 + TROW(i, lane)] = acc[i];
                }
            }
            }
            if (chunk + 1 < chunk0 + 32) W5_STORE(bi ^ 1);
            __syncthreads();
            { const LAS float* ys = YST + bi * (32 * 33) + pj * 33 + 2 * pq;
                *(f32x2*)(Y + ((size_t)b * SEQ + chunk * 32 + pj) * 512 + h * 64 + 32 * half + 2 * pq) = (f32x2){ys[0], ys[1]}; }
        }
        if (wave < 2) {
#pragma unroll
            for (int i = 0; i < 16; ++i) SSAVE[(wave * 16 + i) * 64 + lane] = Sacc[i]; }
#undef W5_LOAD
#undef W5_STORE
    }
}
__device__ __forceinline__ void wkv5b2(const Args& a, LAS unsigned char* lds, const int round) {
    const int tid = threadIdx.x, lane = tid & 63, wave = __builtin_amdgcn_readfirstlane(tid >> 6);
    unsigned char* ws = a.ws;
    const bf16_t* COLS = (const bf16_t*)(ws + WS_A); float* Y = (float*)(ws + WS_B); float* SSV = (float*)(ws + WS_S5O);
    const unsigned char* STG_R = ws + WS_RWKV; const unsigned char* STG_P = (const unsigned char*)a.out + 96 * MiB;
    constexpr int SET = 26880;
    LAS bf16_t* SBF = (LAS bf16_t*)(lds + 53760);
    LAS float* YST = (LAS float*)(lds + 72192);
    for (int item = blockIdx.x; item < 128; item += gridDim.x) {
        const int bh = item, b = bh >> 3, h = bh & 7;
        const int pj = tid >> 4, pq = tid & 15;
        const int half = (wave >> 1) & 1, kh = wave & 1;
        f32x16 Sacc;
#pragma unroll
        for (int i = 0; i < 16; ++i) Sacc[i] = 0.f;
        __syncthreads();
        if (round == 0) { for (int i = tid; i < 64 * 72 / 2; i += 512) ((LAS unsigned*)SBF)[i] = 0u; }
        else if (wave < 4) { const int t = lane & 31;
#pragma unroll
            for (int i = 0; i < 16; ++i) { Sacc[i] = SSV[(((size_t)bh * 4 + wave) * 16 + i) * 64 + lane]; SBF[(32 * half + TROW(i, lane)) * 72 + 32 * kh + t] = bf1(Sacc[i]); } }
        const f32x4 muv = *(const f32x4*)(a.in[I_MU] + C_V + h * 64 + 4 * pq);
        u32x4 gPA, gAA, gBA, gPB, gAB, gBB; u32x2 vcA, vpA, vcB, vpB;
#define W5_LOAD(R, chunk) do { const size_t idx_ = (size_t)bh * 32 + ((chunk) & 31); const unsigned char* gr_ = STG_R + idx_ * STG_R_STRIDE; const unsigned char* gp_ = STG_P + idx_ * 8192; \
            gP##R = *(const u32x4*)(gp_ + (tid >> 3) * 128 + (tid & 7) * 16); \
            gA##R = (tid < 256) ? *(const u32x4*)(gr_ + (tid >> 3) * 128 + (tid & 7) * 16) : *(const u32x4*)(gr_ + 4096 + ((tid - 256) >> 2) * 64 + ((tid - 256) & 3) * 16); \
            gB##R = (tid < 144) ? *(const u32x4*)(gr_ + 8192 + tid * 16) : (u32x4){0u, 0u, 0u, 0u}; \
            { const int s_ = (chunk) * 32 + pj; const bf16_t* cb_ = COLS + ((size_t)b * SEQ + s_) * INC + C_V + h * 64 + 4 * pq; vc##R = *(const u32x2*)cb_; vp##R = (s_ > 0) ? *(const u32x2*)(cb_ - INC) : (u32x2){0u, 0u}; } } while (0)
#define W5_STORE(R, setb) do { LAS unsigned char* sb_ = lds + (setb) * SET; \
            *(LAS u32x4*)(sb_ + 12288 + (tid >> 3) * 144 + (tid & 7) * 16) = gP##R; \
            if (tid < 256) *(LAS u32x4*)(sb_ + 7680 + (tid >> 3) * 144 + (tid & 7) * 16) = gA##R; \
            else *(LAS u32x4*)(sb_ + 2560 + ((tid - 256) >> 2) * 80 + ((tid - 256) & 3) * 16) = gA##R; \
            if (tid < 128) *(LAS u32x4*)(sb_ + (tid >> 2) * 80 + (tid & 3) * 16) = gB##R; \
            else if (tid < 144) *(LAS u32x4*)(sb_ + 21504 + (tid - 128) * 16) = gB##R; \
            { float c_[4], p_[4]; unpack4(vc##R, c_); unpack4(vp##R, p_); LAS bf16_t* vm_ = (LAS bf16_t*)(sb_ + 21760); \
              _Pragma("unroll") for (int i_ = 0; i_ < 4; ++i_) vm_[(4 * pq + i_) * 40 + pj] = bf1(c_[i_] + (p_[i_] - c_[i_]) * muv[i_]); } } while (0)
#define W5_STEP(chunk, RL, RS) do { const int bi = (chunk) & 1; \
            if ((chunk) + 2 < cend) W5_LOAD(RL, (chunk) + 2); \
            { LAS unsigned char* sb = lds + bi * SET; \
              LAS bf16_t* WyT = (LAS bf16_t*)sb; LAS bf16_t* WzT = (LAS bf16_t*)(sb + 2560); LAS bf16_t* R2T = (LAS bf16_t*)(sb + 7680); LAS bf16_t* PpT = (LAS bf16_t*)(sb + 12288); \
              LAS float* GC = (LAS float*)(sb + 21504); LAS bf16_t* VmT = (LAS bf16_t*)(sb + 21760); \
              if (wave < 6) { const int t = lane & 31; f32x16 acc; \
                _Pragma("unroll") for (int i = 0; i < 16; ++i) acc[i] = 0.f; \
                if (wave < 4) { const LAS bf16_t* Sb = SBF + bi * (64 * 72) + 32 * half * 72; \
                    acc = mm32<2>(acc, VmT + 32 * half * 40, 40, WzT + 32 * kh * 40, 40, lane); \
                    acc = mm32<4>(acc, Sb, 72, PpT + 32 * kh * 72, 72, lane); \
                    const float gc = GC[32 * kh + t]; LAS bf16_t* Sn = SBF + (bi ^ 1) * (64 * 72) + 32 * half * 72; \
                    _Pragma("unroll") for (int i = 0; i < 16; ++i) { Sacc[i] = fmaf(Sacc[i], gc, acc[i]); Sn[TROW(i, lane) * 72 + 32 * kh + t] = bf1(Sacc[i]); } \
                } else { const int yh = wave - 4; const LAS bf16_t* Sb = SBF + bi * (64 * 72) + 32 * yh * 72; LAS float* YSTc = YST + (bi * 2 + yh) * (32 * 33); \
                    acc = mm32<2>(acc, VmT + 32 * yh * 40, 40, WyT, 40, lane); \
                    acc = mm32<4>(acc, Sb, 72, R2T, 72, lane); \
                    _Pragma("unroll") for (int i = 0; i < 16; ++i) YSTc[t * 33 + TROW(i, lane)] = acc[i]; \
                } } } \
            if ((chunk) + 1 < cend) W5_STORE(RS, bi ^ 1); \
            __syncthreads(); \
            { const LAS float* ys = YST + (bi * 2 + (pq >> 3)) * (32 * 33) + pj * 33 + 4 * (pq & 7); \
                *(f32x4*)(Y + ((size_t)b * SEQ + (chunk) * 32 + pj) * 512 + h * 64 + 4 * pq) = (f32x4){ys[0], ys[1], ys[2], ys[3]}; } } while (0)
        const int chunk0 = 32 * round, cend = chunk0 + 32;
        W5_LOAD(A, chunk0); W5_LOAD(B, chunk0 + 1); W5_STORE(A, 0);
        __syncthreads();
        for (int chunk = chunk0; chunk < cend; chunk += 2) { W5_STEP(chunk, A, B); W5_STEP(chunk + 1, B, A); }
        if (wave < 4) {
#pragma unroll
            for (int i = 0; i < 16; ++i) SSV[(((size_t)bh * 4 + wave) * 16 + i) * 64 + lane] = Sacc[i]; }
#undef W5_LOAD
#undef W5_STORE
#undef W5_STEP
    }
}
__device__ __forceinline__ void wkv5b3(const Args& a, LAS unsigned char* lds, const int round) {
    const int tid = threadIdx.x, lane = tid & 63, wave = __builtin_amdgcn_readfirstlane(tid >> 6);
    unsigned char* ws = a.ws;
    const bf16_t* COLS = (const bf16_t*)(ws + WS_A); float* Y = (float*)(ws + WS_B); float* SSV = (float*)(ws + WS_S5O);
    const unsigned char* STG_R = ws + WS_RWKV; const unsigned char* STG_P = (const unsigned char*)a.out + 96 * MiB;
    constexpr int SET = 26880;
    LAS bf16_t* SBF = (LAS bf16_t*)(lds + 53760);
    for (int item = blockIdx.x; item < 128; item += gridDim.x) {
        const int bh = item, b = bh >> 3, h = bh & 7;
        const int t = lane & 31, hh = lane >> 5;
        const int half = (wave >> 1) & 1, kh = wave & 1;
        const int chunk0 = 32 * round, cend = chunk0 + 32;
        __syncthreads();
        if (wave >= 6) {
            const int u = tid - 384, pj = u >> 2, cq = u & 3;
            f32x4 mv0, mv1, mv2, mv3;
            { const float* mp = a.in[I_MU] + C_V + h * 64 + 16 * cq; mv0 = *(const f32x4*)mp; mv1 = *(const f32x4*)(mp + 4); mv2 = *(const f32x4*)(mp + 8); mv3 = *(const f32x4*)(mp + 12); }
            u32x4 p0A, p1A, p2A, p3A, r0A, r1A, z0A, z1A, y0A, gcA, c0A, c1A, q0A, q1A;
            u32x4 p0B, p1B, p2B, p3B, r0B, r1B, z0B, z1B, y0B, gcB, c0B, c1B, q0B, q1B;
#define W5_LOAD(R, chunk) do { const size_t idx_ = (size_t)bh * 32 + ((chunk) & 31); const unsigned char* gr_ = STG_R + idx_ * STG_R_STRIDE; const unsigned char* gp_ = STG_P + idx_ * 8192; \
                p0##R = *(const u32x4*)(gp_ + u * 16); p1##R = *(const u32x4*)(gp_ + 2048 + u * 16); p2##R = *(const u32x4*)(gp_ + 4096 + u * 16); p3##R = *(const u32x4*)(gp_ + 6144 + u * 16); \
                r0##R = *(const u32x4*)(gr_ + u * 16); r1##R = *(const u32x4*)(gr_ + 2048 + u * 16); z0##R = *(const u32x4*)(gr_ + 4096 + u * 16); z1##R = *(const u32x4*)(gr_ + 6144 + u * 16); \
                y0##R = *(const u32x4*)(gr_ + 8192 + u * 16); gc##R = (u < 16) ? *(const u32x4*)(gr_ + 10240 + u * 16) : (u32x4){0u, 0u, 0u, 0u}; \
                { const int s_ = (chunk) * 32 + pj; const bf16_t* cb_ = COLS + ((size_t)b * SEQ + s_) * INC + C_V + h * 64 + 16 * cq; c0##R = *(const u32x4*)cb_; c1##R = *(const u32x4*)(cb_ + 8); \
                  if (s_ > 0) { q0##R = *(const u32x4*)(cb_ - INC); q1##R = *(const u32x4*)(cb_ - INC + 8); } else { q0##R = (u32x4){0u, 0u, 0u, 0u}; q1##R = (u32x4){0u, 0u, 0u, 0u}; } } } while (0)
#define W5_PIECE8(base, p_) ((base) + ((p_) >> 3) * 144 + ((p_) & 7) * 16)
#define W5_PIECE4(base, p_) ((base) + ((p_) >> 2) * 80 + ((p_) & 3) * 16)
#define W5_VM(cv, qv, mv, off) do { float c_[8], q_[8]; unpack8(cv, c_); unpack8(qv, q_); \
                _Pragma("unroll") for (int i_ = 0; i_ < 8; ++i_) vm_[(16 * cq + (off) + i_) * 40 + pj] = bf1(c_[i_] + (q_[i_] - c_[i_]) * ((i_ < 4) ? mv##0[i_ & 3] : mv##1[i_ & 3])); } while (0)
#define W5_STORE(R, setb) do { LAS unsigned char* sb_ = lds + (setb) * SET; \
                *(LAS u32x4*)W5_PIECE8(sb_ + 12288, u) = p0##R; *(LAS u32x4*)W5_PIECE8(sb_ + 12288, u + 128) = p1##R; *(LAS u32x4*)W5_PIECE8(sb_ + 12288, u + 256) = p2##R; *(LAS u32x4*)W5_PIECE8(sb_ + 12288, u + 384) = p3##R; \
                *(LAS u32x4*)W5_PIECE8(sb_ + 7680, u) = r0##R; *(LAS u32x4*)W5_PIECE8(sb_ + 7680, u + 128) = r1##R; \
                *(LAS u32x4*)W5_PIECE4(sb_ + 2560, u) = z0##R; *(LAS u32x4*)W5_PIECE4(sb_ + 2560, u + 128) = z1##R; \
                *(LAS u32x4*)W5_PIECE4(sb_, u) = y0##R; if (u < 16) *(LAS u32x4*)(sb_ + 21504 + u * 16) = gc##R; \
                { LAS bf16_t* vm_ = (LAS bf16_t*)(sb_ + 21760); \
                  { float c_[8], q_[8]; unpack8(c0##R, c_); unpack8(q0##R, q_); \
                    _Pragma("unroll") for (int i_ = 0; i_ < 8; ++i_) vm_[(16 * cq + i_) * 40 + pj] = bf1(c_[i_] + (q_[i_] - c_[i_]) * ((i_ < 4) ? mv0[i_ & 3] : mv1[i_ & 3])); } \
                  { float c_[8], q_[8]; unpack8(c1##R, c_); unpack8(q1##R, q_); \
                    _Pragma("unroll") for (int i_ = 0; i_ < 8; ++i_) vm_[(16 * cq + 8 + i_) * 40 + pj] = bf1(c_[i_] + (q_[i_] - c_[i_]) * ((i_ < 4) ? mv2[i_ & 3] : mv3[i_ & 3])); } } } while (0)
            W5_LOAD(A, chunk0); W5_LOAD(B, chunk0 + 1); W5_STORE(A, 0);
            __syncthreads();
            for (int chunk = chunk0; chunk < cend; chunk += 2) {
                if (chunk + 2 < cend) W5_LOAD(A, chunk + 2);
                W5_STORE(B, 1);
                __syncthreads();
                if (chunk + 3 < cend) W5_LOAD(B, chunk + 3);
                if (chunk + 2 < cend) W5_STORE(A, 0);
                __syncthreads();
            }
#undef W5_LOAD
#undef W5_STORE
#undef W5_VM
#undef W5_PIECE8
#undef W5_PIECE4
        } else {
            f32x16 Sacc;
#pragma unroll
            for (int i = 0; i < 16; ++i) Sacc[i] = 0.f;
            if (wave < 4) {
                if (round != 0) {
#pragma unroll
                    for (int i = 0; i < 16; ++i) Sacc[i] = SSV[(((size_t)bh * 4 + wave) * 16 + i) * 64 + lane]; }
                LAS bf16_t* Sn = SBF + (32 * half + t) * 72 + 32 * kh;
#pragma unroll
                for (int g4 = 0; g4 < 4; ++g4) *(LAS u32x2*)(Sn + 8 * g4 + 4 * hh) = (u32x2){cvt_pk_bf16(Sacc[4 * g4], Sacc[4 * g4 + 1]), cvt_pk_bf16(Sacc[4 * g4 + 2], Sacc[4 * g4 + 3])};
            }
            __syncthreads();
            for (int chunk = chunk0; chunk < cend; ++chunk) {
                const int bi = chunk & 1; LAS unsigned char* sb = lds + bi * SET;
                LAS bf16_t* WyT = (LAS bf16_t*)sb; LAS bf16_t* WzT = (LAS bf16_t*)(sb + 2560); LAS bf16_t* R2T = (LAS bf16_t*)(sb + 7680); LAS bf16_t* PpT = (LAS bf16_t*)(sb + 12288);
                LAS float* GC = (LAS float*)(sb + 21504); LAS bf16_t* VmT = (LAS bf16_t*)(sb + 21760);
                f32x16 acc;
#pragma unroll
                for (int i = 0; i < 16; ++i) acc[i] = 0.f;
                if (wave < 4) {
                    const LAS bf16_t* Sb = SBF + bi * (64 * 72) + 32 * half * 72;
                    acc = mm32<2>(acc, WzT + 32 * kh * 40, 40, VmT + 32 * half * 40, 40, lane);
                    acc = mm32<4>(acc, PpT + 32 * kh * 72, 72, Sb, 72, lane);
                    LAS bf16_t* Sn = SBF + (bi ^ 1) * (64 * 72) + (32 * half + t) * 72 + 32 * kh;
#pragma unroll
                    for (int g4 = 0; g4 < 4; ++g4) { const int k0 = 8 * g4 + 4 * hh; const f32x4 gc4 = *(const LAS f32x4*)(GC + 32 * kh + k0);
#pragma unroll
                        for (int i = 0; i < 4; ++i) Sacc[4 * g4 + i] = fmaf(Sacc[4 * g4 + i], gc4[i], acc[4 * g4 + i]);
                        *(LAS u32x2*)(Sn + k0) = (u32x2){cvt_pk_bf16(Sacc[4 * g4], Sacc[4 * g4 + 1]), cvt_pk_bf16(Sacc[4 * g4 + 2], Sacc[4 * g4 + 3])}; }
                } else {
                    const int yh = wave - 4; const LAS bf16_t* Sb = SBF + bi * (64 * 72) + 32 * yh * 72;
                    acc = mm32<2>(acc, WyT, 40, VmT + 32 * yh * 40, 40, lane);
                    acc = mm32<4>(acc, R2T, 72, Sb, 72, lane);
                    float* yp = Y + ((size_t)b * SEQ + chunk * 32) * 512 + h * 64 + 32 * yh + t;
#pragma unroll
                    for (int i = 0; i < 16; ++i) yp[(size_t)TROW(i, lane) * 512] = acc[i];
                }
                __syncthreads();
            }
            if (wave < 4) {
#pragma unroll
                for (int i = 0; i < 16; ++i) SSV[(((size_t)bh * 4 + wave) * 16 + i) * 64 + lane] = Sacc[i]; }
        }
    }
}
__device__ __forceinline__ unsigned w5_img_src(int o) {
    if (o < 2560) { const int r = o / 80, c = o - r * 80; return (c < 64) ? (unsigned)(8192 + r * 64 + c) : 0u; }
    if (o < 7680) { const int o2 = o - 2560, r = o2 / 80, c = o2 - r * 80; return (c < 64) ? (unsigned)(4096 + r * 64 + c) : 0u; }
    if (o < 12288) { const int o2 = o - 7680, r = o2 / 144, c = o2 - r * 144; return (c < 128) ? (unsigned)(r * 128 + c) : 0u; }
    if (o < 21504) { const int o2 = o - 12288, r = o2 / 144, c = o2 - r * 144; return (c < 128) ? (unsigned)(r * 128 + c) : 0u; }
    return (unsigned)(10240 + (o - 21504));
}
__device__ __forceinline__ void wkv5b4(const Args& a, LAS unsigned char* lds, const int round) {
    const int tid = threadIdx.x, lane = tid & 63, wave = __builtin_amdgcn_readfirstlane(tid >> 6);
    unsigned char* ws = a.ws;
    const bf16_t* COLS = (const bf16_t*)(ws + WS_A); float* Y = (float*)(ws + WS_B); float* SSV = (float*)(ws + WS_S5O);
    const unsigned char* STG_R = ws + WS_RWKV; const unsigned char* STG_P = (const unsigned char*)a.out + 96 * MiB;
    constexpr int SETB = 31104;
    LAS bf16_t* SBF = (LAS bf16_t*)(lds + 4 * SETB);
#define W5_BAR() do { asm volatile("s_waitcnt lgkmcnt(0)" ::: "memory"); __builtin_amdgcn_s_barrier(); asm volatile("" ::: "memory"); } while (0)
    for (int item = blockIdx.x; item < 128; item += gridDim.x) {
        const int bh = item, b = bh >> 3, h = bh & 7;
        const int t = lane & 31, hh = lane >> 5;
        const int half = (wave >> 1) & 1, kh = wave & 1;
        const int chunk0 = 32 * round;
        __syncthreads();
        if (wave >= 6) {
            const int u = tid - 384, pj = u >> 2, cq = u & 3;
            const int j0 = (wave == 6) ? 0 : 9, nb = (wave == 6) ? 9 : 13;
            unsigned goff[13];
#pragma unroll
            for (int j = 0; j < 13; ++j) goff[j] = w5_img_src((j0 + j) * 1024 + lane * 16);
            f32x4 mv0, mv1, mv2, mv3;
            { const float* mp = a.in[I_MU] + C_V + h * 64 + 16 * cq; mv0 = *(const f32x4*)mp; mv1 = *(const f32x4*)(mp + 4); mv2 = *(const f32x4*)(mp + 8); mv3 = *(const f32x4*)(mp + 12); }
#define W5_ISSUE(i_) do { const int c_ = chunk0 + (i_); const size_t idx_ = (size_t)bh * 32 + (c_ & 31); const unsigned char* gr_ = STG_R + idx_ * STG_R_STRIDE; const unsigned char* gp_ = STG_P + idx_ * 8192; \
                LAS unsigned char* sb_ = lds + ((i_) & 3) * SETB; \
                if (wave == 6) { const unsigned char* vb_ = (const unsigned char*)(COLS + ((size_t)b * SEQ + (size_t)c_ * 32) * INC + C_V + h * 64) - (size_t)INC * 2; \
                    _Pragma("unroll") for (int j = 0; j < 5; ++j) { const int p_ = j * 64 + lane; \
                        if (p_ < 264) __builtin_amdgcn_global_load_lds((const unsigned*)(vb_ + (size_t)(p_ >> 3) * (INC * 2) + (p_ & 7) * 16), (LAS unsigned*)(sb_ + 26880 + j * 1024), 16, 0, 0); } } \
                _Pragma("unroll") for (int j = 0; j < 13; ++j) { if (j < nb) { const int jj = j0 + j; const unsigned char* base_ = (jj >= 12 && jj < 21) ? gp_ : gr_; \
                    if (jj < 21 || lane < 16) __builtin_amdgcn_global_load_lds((const unsigned*)(base_ + goff[j]), (LAS unsigned*)(sb_ + jj * 1024), 16, 0, 0); } } } while (0)
#define W5_CONV(i_) do { const int c_ = chunk0 + (i_); LAS unsigned char* sb_ = lds + ((i_) & 3) * SETB; const LAS unsigned char* rw_ = sb_ + 26880 + pj * 128 + cq * 32; LAS bf16_t* vm_ = (LAS bf16_t*)(sb_ + 21760); \
                u32x4 q0_ = *(const LAS u32x4*)rw_, q1_ = *(const LAS u32x4*)(rw_ + 16); const u32x4 c0_ = *(const LAS u32x4*)(rw_ + 128), c1_ = *(const LAS u32x4*)(rw_ + 144); \
                if (c_ * 32 + pj == 0) { q0_ = (u32x4){0u, 0u, 0u, 0u}; q1_ = q0_; } \
                { float c8_[8], q8_[8]; unpack8(c0_, c8_); unpack8(q0_, q8_); \
                  _Pragma("unroll") for (int e_ = 0; e_ < 8; ++e_) vm_[(16 * cq + e_) * 40 + pj] = bf1(c8_[e_] + (q8_[e_] - c8_[e_]) * ((e_ < 4) ? mv0[e_ & 3] : mv1[e_ & 3])); } \
                { float c8_[8], q8_[8]; unpack8(c1_, c8_); unpack8(q1_, q8_); \
                  _Pragma("unroll") for (int e_ = 0; e_ < 8; ++e_) vm_[(16 * cq + 8 + e_) * 40 + pj] = bf1(c8_[e_] + (q8_[e_] - c8_[e_]) * ((e_ < 4) ? mv2[e_ & 3] : mv3[e_ & 3])); } } while (0)
            W5_ISSUE(0); W5_ISSUE(1); W5_ISSUE(2);
            if (wave == 6) asm volatile("s_waitcnt vmcnt(37)" ::: "memory");
            W5_BAR();
            W5_CONV(0);
            if (wave == 6) asm volatile("s_waitcnt vmcnt(23)" ::: "memory"); else asm volatile("s_waitcnt vmcnt(26)" ::: "memory");
            W5_BAR();
            for (int i = 0; i < 32; ++i) {
                if (i + 3 < 32) W5_ISSUE(i + 3);
                if (i + 1 < 32) W5_CONV(i + 1);
                if (i + 3 < 32) { if (wave == 6) asm volatile("s_waitcnt vmcnt(23)" ::: "memory"); else asm volatile("s_waitcnt vmcnt(26)" ::: "memory"); }
                else asm volatile("s_waitcnt vmcnt(0)" ::: "memory");
                W5_BAR();
            }
#undef W5_ISSUE
#undef W5_CONV
        } else {
            f32x16 Sacc;
#pragma unroll
            for (int i = 0; i < 16; ++i) Sacc[i] = 0.f;
            if (wave < 4) {
                if (round != 0) {
#pragma unroll
                    for (int i = 0; i < 16; ++i) Sacc[i] = SSV[(((size_t)bh * 4 + wave) * 16 + i) * 64 + lane]; }
                LAS bf16_t* Sn = SBF + (32 * half + t) * 72 + 32 * kh;
#pragma unroll
                for (int g4 = 0; g4 < 4; ++g4) *(LAS u32x2*)(Sn + 8 * g4 + 4 * hh) = (u32x2){cvt_pk_bf16(Sacc[4 * g4], Sacc[4 * g4 + 1]), cvt_pk_bf16(Sacc[4 * g4 + 2], Sacc[4 * g4 + 3])};
            }
            W5_BAR();
            W5_BAR();
            for (int i = 0; i < 32; ++i) {
                const int chunk = chunk0 + i, bi = i & 1; LAS unsigned char* sb = lds + (i & 3) * SETB;
                LAS bf16_t* WyT = (LAS bf16_t*)sb; LAS bf16_t* WzT = (LAS bf16_t*)(sb + 2560); LAS bf16_t* R2T = (LAS bf16_t*)(sb + 7680); LAS bf16_t* PpT = (LAS bf16_t*)(sb + 12288);
                LAS float* GC = (LAS float*)(sb + 21504); LAS bf16_t* VmT = (LAS bf16_t*)(sb + 21760);
                f32x16 acc;
#pragma unroll
                for (int k = 0; k < 16; ++k) acc[k] = 0.f;
                if (wave < 4) {
                    const LAS bf16_t* Sb = SBF + bi * (64 * 72) + 32 * half * 72;
                    acc = mm32<2>(acc, WzT + 32 * kh * 40, 40, VmT + 32 * half * 40, 40, lane);
                    acc = mm32<4>(acc, PpT + 32 * kh * 72, 72, Sb, 72, lane);
                    LAS bf16_t* Sn = SBF + (bi ^ 1) * (64 * 72) + (32 * half + t) * 72 + 32 * kh;
#pragma unroll
                    for (int g4 = 0; g4 < 4; ++g4) { const int k0 = 8 * g4 + 4 * hh; const f32x4 gc4 = *(const LAS f32x4*)(GC + 32 * kh + k0);
#pragma unroll
                        for (int k = 0; k < 4; ++k) Sacc[4 * g4 + k] = fmaf(Sacc[4 * g4 + k], gc4[k], acc[4 * g4 + k]);
                        *(LAS u32x2*)(Sn + k0) = (u32x2){cvt_pk_bf16(Sacc[4 * g4], Sacc[4 * g4 + 1]), cvt_pk_bf16(Sacc[4 * g4 + 2], Sacc[4 * g4 + 3])}; }
                } else {
                    const int yh = wave - 4; const LAS bf16_t* Sb = SBF + bi * (64 * 72) + 32 * yh * 72;
                    acc = mm32<2>(acc, WyT, 40, VmT + 32 * yh * 40, 40, lane);
                    acc = mm32<4>(acc, R2T, 72, Sb, 72, lane);
                    float* yp = Y + ((size_t)b * SEQ + chunk * 32) * 512 + h * 64 + 32 * yh + t;
#pragma unroll
                    for (int k = 0; k < 16; ++k) yp[(size_t)TROW(k, lane) * 512] = acc[k];
                }
                W5_BAR();
            }
            if (wave < 4) {
#pragma unroll
                for (int i = 0; i < 16; ++i) SSV[(((size_t)bh * 4 + wave) * 16 + i) * 64 + lane] = Sacc[i]; }
        }
    }
#undef W5_BAR
}
__device__ __forceinline__ unsigned w5_img_src2(int o) {
    if (o < 2560) { const int r = o / 80, c = o - r * 80; return (c < 64) ? (unsigned)(8192 + r * 64 + c) : 0u; }
    if (o < 7680) { const int o2 = o - 2560, r = o2 / 80, c = o2 - r * 80; return (c < 64) ? (unsigned)(4096 + r * 64 + c) : 0u; }
    if (o < 12288) { const int o2 = o - 7680, r = o2 / 144, c = o2 - r * 144; return (c < 128) ? (unsigned)(r * 128 + c) : 0u; }
    if (o < 21504) { const int o2 = o - 12288, r = o2 / 144, c = o2 - r * 144; return (c < 128) ? (unsigned)(r * 128 + c) : 0u; }
    return (unsigned)(10240 + (o - 21504));
}
__device__ __forceinline__ void wkv5b5(const Args& a, LAS unsigned char* lds, const int round) {
    const int tid = threadIdx.x, lane = tid & 63, wave = __builtin_amdgcn_readfirstlane(tid >> 6);
    unsigned char* ws = a.ws;
    const bf16_t* COLS = (const bf16_t*)(ws + WS_A); float* Y = (float*)(ws + WS_B); float* SSV = (float*)(ws + WS_S5O);
    const unsigned char* STG_R = ws + WS_RWKV; const unsigned char* STG_P = (const unsigned char*)a.out + 96 * MiB;
    constexpr int SETB = 31104;
    LAS bf16_t* SBF = (LAS bf16_t*)(lds + 4 * SETB);
#define W5_BAR() do { asm volatile("s_waitcnt lgkmcnt(0)" ::: "memory"); __builtin_amdgcn_s_barrier(); asm volatile("" ::: "memory"); } while (0)
    for (int item = blockIdx.x; item < 128; item += gridDim.x) {
        const int bh = item, b = bh >> 3, h = bh & 7;
        const int t = lane & 31, hh = lane >> 5;
        const int half = (wave >> 1) & 1, kh = wave & 1;
        const int chunk0 = 32 * round;
        __syncthreads();
        if (wave >= 6) {
            const int j0 = (wave == 6) ? 0 : 9, nb = (wave == 6) ? 9 : 13;
            unsigned goff[13];
#pragma unroll
            for (int j = 0; j < 13; ++j) goff[j] = w5_img_src2((j0 + j) * 1024 + lane * 16);
#define W5_ISSUE(i_) do { const int c_ = chunk0 + (i_); const size_t idx_ = (size_t)bh * 32 + (c_ & 31); const unsigned char* gr_ = STG_R + idx_ * STG_R_STRIDE; const unsigned char* gp_ = STG_P + idx_ * 8192; \
                LAS unsigned char* sb_ = lds + ((i_) & 3) * SETB; \
                if (wave == 6) { const unsigned char* vb_ = (const unsigned char*)(COLS + ((size_t)b * SEQ + (size_t)c_ * 32) * INC + C_V + h * 64) - (size_t)INC * 2; \
                    _Pragma("unroll") for (int j = 0; j < 5; ++j) { const int p_ = j * 64 + lane; \
                        if (p_ < 264) __builtin_amdgcn_global_load_lds((const unsigned*)(vb_ + (size_t)(p_ >> 3) * (INC * 2) + (p_ & 7) * 16), (LAS unsigned*)(sb_ + 26880 + j * 1024), 16, 0, 0); } } \
                _Pragma("unroll") for (int j = 0; j < 13; ++j) { if (j < nb) { const int jj = j0 + j; const unsigned char* base_ = (jj >= 12 && jj < 21) ? gp_ : gr_; \
                    if (jj < 21 || lane < 16) __builtin_amdgcn_global_load_lds((const unsigned*)(base_ + goff[j]), (LAS unsigned*)(sb_ + jj * 1024), 16, 0, 0); } } } while (0)
            W5_ISSUE(0); W5_ISSUE(1); W5_ISSUE(2);
            if (wave == 6) asm volatile("s_waitcnt vmcnt(37)" ::: "memory");
            W5_BAR();
            if (wave == 6) asm volatile("s_waitcnt vmcnt(23)" ::: "memory"); else asm volatile("s_waitcnt vmcnt(26)" ::: "memory");
            W5_BAR();
            for (int i = 0; i < 32; ++i) {
                if (i + 3 < 32) W5_ISSUE(i + 3);
                if (i + 3 < 32) { if (wave == 6) asm volatile("s_waitcnt vmcnt(23)" ::: "memory"); else asm volatile("s_waitcnt vmcnt(26)" ::: "memory"); }
                else asm volatile("s_waitcnt vmcnt(0)" ::: "memory");
                W5_BAR();
            }
#undef W5_ISSUE
        } else {
            f32x16 Sacc;
#pragma unroll
            for (int i = 0; i < 16; ++i) Sacc[i] = 0.f;
            if (wave < 4) {
                if (round != 0) {
#pragma unroll
                    for (int i = 0; i < 16; ++i) Sacc[i] = SSV[(((size_t)bh * 4 + wave) * 16 + i) * 64 + lane]; }
                LAS bf16_t* Sn = SBF + (32 * half + t) * 72 + 32 * kh;
#pragma unroll
                for (int g4 = 0; g4 < 4; ++g4) *(LAS u32x2*)(Sn + 8 * g4 + 4 * hh) = (u32x2){cvt_pk_bf16(Sacc[4 * g4], Sacc[4 * g4 + 1]), cvt_pk_bf16(Sacc[4 * g4 + 2], Sacc[4 * g4 + 3])};
            }
            const int u2 = tid - 256, pp = (u2 >> 3) & 15, cg = u2 & 7;
            f32x4 mva = (f32x4){0.f, 0.f, 0.f, 0.f}, mvb = mva;
            if (wave >= 4) { const float* mp = a.in[I_MU] + C_V + h * 64 + 8 * cg; mva = *(const f32x4*)mp; mvb = *(const f32x4*)(mp + 4); }
#define W5_CONV(i_) do { const int c_ = chunk0 + (i_); LAS unsigned char* sb_ = lds + ((i_) & 3) * SETB; const LAS unsigned char* rw_ = sb_ + 26880 + (2 * pp) * 128 + cg * 16; LAS bf16_t* vm_ = (LAS bf16_t*)(sb_ + 21760); \
                u32x4 q_ = *(const LAS u32x4*)rw_; const u32x4 c0_ = *(const LAS u32x4*)(rw_ + 128), c1_ = *(const LAS u32x4*)(rw_ + 256); \
                if (c_ * 32 + 2 * pp == 0) q_ = (u32x4){0u, 0u, 0u, 0u}; \
                float q8_[8], a8_[8], b8_[8]; unpack8(q_, q8_); unpack8(c0_, a8_); unpack8(c1_, b8_); \
                _Pragma("unroll") for (int e_ = 0; e_ < 8; ++e_) { const float m_ = (e_ < 4) ? mva[e_ & 3] : mvb[e_ & 3]; \
                    *(LAS unsigned*)(vm_ + (8 * cg + e_) * 40 + 2 * pp) = cvt_pk_bf16(a8_[e_] + (q8_[e_] - a8_[e_]) * m_, b8_[e_] + (a8_[e_] - b8_[e_]) * m_); } } while (0)
            W5_BAR();
            if (wave >= 4) W5_CONV(0);
            W5_BAR();
            for (int i = 0; i < 32; ++i) {
                const int chunk = chunk0 + i, bi = i & 1; LAS unsigned char* sb = lds + (i & 3) * SETB;
                LAS bf16_t* WyT = (LAS bf16_t*)sb; LAS bf16_t* WzT = (LAS bf16_t*)(sb + 2560); LAS bf16_t* R2T = (LAS bf16_t*)(sb + 7680); LAS bf16_t* PpT = (LAS bf16_t*)(sb + 12288);
                LAS float* GC = (LAS float*)(sb + 21504); LAS bf16_t* VmT = (LAS bf16_t*)(sb + 21760);
                f32x16 acc;
#pragma unroll
                for (int k = 0; k < 16; ++k) acc[k] = 0.f;
                if (wave < 4) {
                    const LAS bf16_t* Sb = SBF + bi * (64 * 72) + 32 * half * 72;
                    acc = mm32<2>(acc, WzT + 32 * kh * 40, 40, VmT + 32 * half * 40, 40, lane);
                    acc = mm32<4>(acc, PpT + 32 * kh * 72, 72, Sb, 72, lane);
                    LAS bf16_t* Sn = SBF + (bi ^ 1) * (64 * 72) + (32 * half + t) * 72 + 32 * kh;
#pragma unroll
                    for (int g4 = 0; g4 < 4; ++g4) { const int k0 = 8 * g4 + 4 * hh; const f32x4 gc4 = *(const LAS f32x4*)(GC + 32 * kh + k0);
#pragma unroll
                        for (int k = 0; k < 4; ++k) Sacc[4 * g4 + k] = fmaf(Sacc[4 * g4 + k], gc4[k], acc[4 * g4 + k]);
                        *(LAS u32x2*)(Sn + k0) = (u32x2){cvt_pk_bf16(Sacc[4 * g4], Sacc[4 * g4 + 1]), cvt_pk_bf16(Sacc[4 * g4 + 2], Sacc[4 * g4 + 3])}; }
                } else {
                    const int yh = wave - 4; const LAS bf16_t* Sb = SBF + bi * (64 * 72) + 32 * yh * 72;
                    acc = mm32<2>(acc, WyT, 40, VmT + 32 * yh * 40, 40, lane);
                    acc = mm32<4>(acc, R2T, 72, Sb, 72, lane);
                    float* yp = Y + ((size_t)b * SEQ + chunk * 32) * 512 + h * 64 + 32 * yh + t;
#pragma unroll
                    for (int k = 0; k < 16; ++k) yp[(size_t)TROW(k, lane) * 512] = acc[k];
                    if (i + 1 < 32) W5_CONV(i + 1);
                }
                W5_BAR();
            }
#undef W5_CONV
            if (wave < 4) {
#pragma unroll
                for (int i = 0; i < 16; ++i) SSV[(((size_t)bh * 4 + wave) * 16 + i) * 64 + lane] = Sacc[i]; }
        }
    }
#undef W5_BAR
}
__device__ __forceinline__ void phase4s(const Args& a, LAS unsigned char* lds, const XcdBarrier& bar) {
    const int tid = threadIdx.x;
    unsigned char* ws = a.ws;
    for (int item = blockIdx.x; item < 256; item += gridDim.x) {
        if (tid < 64) {
            const int b = item >> 4, g = item & 15, n = tid;
            const f32x2 lamL = ((const f32x2*)(ws + WS_LAML))[g * 64 + n];
            const float* E = (const float*)(ws + WS_E) + ((size_t)g * S5ROWS + b * S5NCH) * 128;
            bf16_t* UG = (bf16_t*)(ws + WS_UG) + ((size_t)g * S5ROWS + b * S5NCH) * S5K + 512;
            float xr = 0.f, xi = 0.f;
#pragma unroll 8
            for (int ch = 0; ch < S5NCH; ++ch) {
                UG[(size_t)ch * S5K + n] = (bf16_t)f2bf(xr); UG[(size_t)ch * S5K + 64 + n] = (bf16_t)f2bf(xi);
                const float er = E[ch * 128 + n], ei = E[ch * 128 + 64 + n];
                const float nr = lamL[0] * xr - lamL[1] * xi + er, ni = lamL[0] * xi + lamL[1] * xr + ei; xr = nr; xi = ni;
            }
        }
    }
    if (gridDim.x != 256) { late_items_idle(a, lds, 0, N_LATE, 0); __syncthreads(); }
    wkv5a2(a, lds, 0); xcd_barrier(bar);
    wkv5b5(a, lds, 0); xcd_barrier(bar);
    wkv5a2(a, lds, 1); xcd_barrier(bar);
    wkv5b5(a, lds, 1);
}

__device__ __forceinline__ void phase5_post(const Args& a) {
    const int gt = blockIdx.x * 512 + threadIdx.x, NT = gridDim.x * 512;
    unsigned char* ws = a.ws;
    const bf16_t* COLS = (const bf16_t*)(ws + WS_A); const bf16_t* LORA = (const bf16_t*)a.out; const float* Y = (const float*)(ws + WS_B); const float* BON = (const float*)(ws + WS_BON);
    bf16_t* RO = (bf16_t*)(ws + WS_RWKV);
    const int hq = gt & 127, h = hq >> 4, q = hq & 15, hc = h * 64 + 4 * q;
    float lg[4], lb[4], muv[4];
#pragma unroll
    for (int i = 0; i < 4; ++i) { lg[i] = a.in[I_LNG][hc + i]; lb[i] = a.in[I_LNB][hc + i]; muv[i] = a.in[I_MU][C_V + hc + i]; }
    for (int p = gt; p < T * 128; p += NT) {
        const int t = p >> 7;
        const f32x4 y4 = *(const f32x4*)(Y + (size_t)t * 512 + hc);
        float s = (y4[0] + y4[1]) + (y4[2] + y4[3]); s = row16_sum(s); const float mean = s * (1.0f / 64.0f);
        const float d0 = y4[0] - mean, d1 = y4[1] - mean, d2 = y4[2] - mean, d3 = y4[3] - mean;
        float qv = (d0 * d0 + d1 * d1) + (d2 * d2 + d3 * d3); qv = row16_sum(qv); const float rstd = 1.0f / sqrtf(qv * (1.0f / 64.0f) + 64e-5f);
        float vc[4], vp[4], g4[4]; unpack4(*(const u32x2*)(COLS + (size_t)t * INC + C_V + hc), vc);
        if ((t & (SEQ - 1)) != 0) unpack4(*(const u32x2*)(COLS + (size_t)(t - 1) * INC + C_V + hc), vp); else { vp[0] = vp[1] = vp[2] = vp[3] = 0.f; }
        unpack4(*(const u32x2*)(LORA + (size_t)t * 1536 + 1024 + hc), g4);
        const float bon = BON[(size_t)t * 8 + h];
        const float dd[4] = {d0, d1, d2, d3}; float o[4];
#pragma unroll
        for (int i = 0; i < 4; ++i) { const float v = vc[i] + (vp[i] - vc[i]) * muv[i]; o[i] = (dd[i] * rstd * lg[i] + lb[i] + bon * v) * g4[i]; }
        u32x2 w; w.x = cvt_pk_bf16(o[0], o[1]); w.y = cvt_pk_bf16(o[2], o[3]); *(u32x2*)(RO + (size_t)t * 512 + hc) = w;
    }
}

__device__ __forceinline__ void phase9(const Args& a, LAS unsigned char* lds) {
    const int tid = threadIdx.x, lane = tid & 63, wave = tid >> 6;
    unsigned char* ws = a.ws;
    const float* X1 = a.out; const bf16_t* WR = (const bf16_t*)(ws + WS_WR);
    int4* ROUTE = (int4*)(ws + WS_ROUTE); int* BC = (int*)(ws + WS_BC);
    LAS float* LG = (LAS float*)lds + wave * (16 * 49);
    LAS int* cnt = (LAS int*)(lds + 32768);
    for (int vb = blockIdx.x; vb < 256; vb += gridDim.x) {
        __syncthreads();
        if (tid < 32) cnt[tid] = 0;
        __syncthreads();
        const int t0 = vb * 128 + wave * 16;
        const int ar = lane & 15, aq = lane >> 4;
        f32x4 acc0 = (f32x4){0.f, 0.f, 0.f, 0.f}, acc1 = acc0, acc2 = acc0; float ssq = 0.f;
        const float* xrow = X1 + (size_t)(t0 + ar) * DM + 8 * aq;
        const bf16_t* wrow = WR + (size_t)ar * DM + 8 * aq;
#pragma unroll 4
        for (int kb = 0; kb < 32; ++kb) {
            const f32x4 x0 = *(const f32x4*)(xrow + kb * 32), x1 = *(const f32x4*)(xrow + kb * 32 + 4);
            ssq += (x0[0] * x0[0] + x0[1] * x0[1]) + (x0[2] * x0[2] + x0[3] * x0[3]) + (x1[0] * x1[0] + x1[1] * x1[1]) + (x1[2] * x1[2] + x1[3] * x1[3]);
            u32x4 af; af.x = cvt_pk_bf16(x0[0], x0[1]); af.y = cvt_pk_bf16(x0[2], x0[3]); af.z = cvt_pk_bf16(x1[0], x1[1]); af.w = cvt_pk_bf16(x1[2], x1[3]);
            const bf16x8 A = __builtin_bit_cast(bf16x8, af);
            const bf16x8 B0 = *(const bf16x8*)(wrow + kb * 32), B1 = *(const bf16x8*)(wrow + 16 * DM + kb * 32), B2 = *(const bf16x8*)(wrow + 32 * DM + kb * 32);
            acc0 = __builtin_amdgcn_mfma_f32_16x16x32_bf16(A, B0, acc0, 0, 0, 0);
            acc1 = __builtin_amdgcn_mfma_f32_16x16x32_bf16(A, B1, acc1, 0, 0, 0);
            acc2 = __builtin_amdgcn_mfma_f32_16x16x32_bf16(A, B2, acc2, 0, 0, 0);
        }
        ssq += __shfl_xor(ssq, 16); ssq += __shfl_xor(ssq, 32);
        const float rs = 1.0f / sqrtf(ssq * (1.0f / DM) + 1e-6f);
#pragma unroll
        for (int r = 0; r < 4; ++r) { const int row = aq * 4 + r; LG[row * 49 + ar] = acc0[r]; LG[row * 49 + 16 + ar] = acc1[r]; LG[row * 49 + 32 + ar] = acc2[r]; }
        LDS_WAIT();
        if (lane < 16) {
            const int t = t0 + lane; const LAS float* lg = LG + lane * 49;
            float gl[4]; float mx = -3.0e38f; int gi = 0;
#pragma unroll
            for (int j = 0; j < 4; ++j) { gl[j] = lg[j] * rs + a.in[I_RGB][j]; if (gl[j] > mx) { mx = gl[j]; gi = j; } }
            float den = 0.f;
#pragma unroll
            for (int j = 0; j < 4; ++j) den += __expf(gl[j] - mx);
            const float gp = 1.0f / den;
            float b1 = -3.0e38f, b2 = -3.0e38f; int i1 = 0, i2 = 0;
            for (int j = 0; j < 8; ++j) { const float v = lg[4 + gi * 8 + j] * rs + a.in[I_REB][gi * 8 + j];
                if (v > b1) { b2 = b1; i2 = i1; b1 = v; i1 = j; } else if (v > b2) { b2 = v; i2 = j; } }
            const float e2 = __expf(b2 - b1), w1 = gp / (1.0f + e2), w2 = gp * e2 / (1.0f + e2);
            const int e0 = gi * 8 + i1, e1 = gi * 8 + i2;
            const int s0 = atomicAdd((int*)&cnt[e0], 1), s1 = atomicAdd((int*)&cnt[e1], 1);
            int4 rt; rt.x = e0 | (e1 << 8); rt.y = s0 | (s1 << 16); rt.z = __builtin_bit_cast(int, w1); rt.w = __builtin_bit_cast(int, w2);
            ROUTE[t] = rt;
        }
        __syncthreads();
        if (tid < 32) BC[vb * 32 + tid] = cnt[tid];
    }
}

__device__ __forceinline__ void phase10(const Args& a, LAS unsigned char* lds) {
    const int tid = threadIdx.x, lane = tid & 63, wave = tid >> 6;
    unsigned char* ws = a.ws;
    const float* X1 = a.out; const int4* ROUTE = (const int4*)(ws + WS_ROUTE); const int* BC = (const int*)(ws + WS_BC);
    bf16_t* HS = (bf16_t*)(ws + WS_A); float* ROWW = (float*)(ws + WS_ROWW); int2* POS = (int2*)(ws + WS_POS); int* OFF = (int*)(ws + WS_OFF);
    LAS int* ptot = (LAS int*)lds;
    LAS int* pmine = ptot + 512;
    LAS int* base = pmine + 512;
    for (int vb = blockIdx.x; vb < 256; vb += gridDim.x) {
        __syncthreads();
        { const int e = tid & 31, part = tid >> 5; int st = 0, sm = 0;
            for (int k = 0; k < 16; ++k) { const int r = part * 16 + k; const int c = BC[r * 32 + e]; st += c; sm += (r < vb) ? c : 0; }
            ptot[part * 32 + e] = st; pmine[part * 32 + e] = sm; }
        __syncthreads();
        if (tid < 32) { int st = 0, sm = 0; for (int k = 0; k < 16; ++k) { st += ptot[k * 32 + tid]; sm += pmine[k * 32 + tid]; } ptot[tid] = (st + 255) & ~255; pmine[tid] = sm; }
        __syncthreads();
        if (tid < 32) { int off = 0; for (int k = 0; k < tid; ++k) off += ptot[k]; base[tid] = off + pmine[tid];
            if (vb == 0) { OFF[tid] = off; if (tid == 31) OFF[32] = off + ptot[31]; } }
        __syncthreads();
        for (int i0 = 0; i0 < 16; i0 += 2) {
            f32x4 v[2][4]; int4 rt[2];
#pragma unroll
            for (int u = 0; u < 2; ++u) { const int t = vb * 128 + wave * 16 + i0 + u; rt[u] = ROUTE[t]; const f32x4* xr = (const f32x4*)(X1 + (size_t)t * DM) + lane;
#pragma unroll
                for (int j = 0; j < 4; ++j) v[u][j] = xr[64 * j]; }
#pragma unroll
            for (int u = 0; u < 2; ++u) { const int t = vb * 128 + wave * 16 + i0 + u;
                const int e0 = rt[u].x & 255, e1 = (rt[u].x >> 8) & 255, p0 = base[e0] + (rt[u].y & 0xffff), p1 = base[e1] + ((rt[u].y >> 16) & 0xffff);
                float s = 0.f;
#pragma unroll
                for (int j = 0; j < 4; ++j) s += (v[u][j][0] * v[u][j][0] + v[u][j][1] * v[u][j][1]) + (v[u][j][2] * v[u][j][2] + v[u][j][3] * v[u][j][3]);
                const float rs = 1.0f / sqrtf(wave_sum(s) * (1.0f / DM) + 1e-6f);
                u32x2* o0 = (u32x2*)(HS + (size_t)p0 * DM) + lane; u32x2* o1 = (u32x2*)(HS + (size_t)p1 * DM) + lane;
#pragma unroll
                for (int j = 0; j < 4; ++j) { u32x2 w; w.x = pk2(v[u][j][0] * rs, v[u][j][1] * rs); w.y = pk2(v[u][j][2] * rs, v[u][j][3] * rs); o0[64 * j] = w; o1[64 * j] = w; }
                if (lane == 0) { ROWW[p0] = __builtin_bit_cast(float, rt[u].z); ROWW[p1] = __builtin_bit_cast(float, rt[u].w); POS[t] = make_int2(p0, p1); } }
        }
    }
}

__device__ __forceinline__ void phase13(const Args& a) {
    const int tid = threadIdx.x, lane = tid & 63, wave = tid >> 6;
    const int gw = blockIdx.x * 8 + wave, NGW = gridDim.x * 8;
    unsigned char* ws = a.ws;
    float* X = a.out; const bf16_t* YM = (const bf16_t*)(ws + WS_A); const int2* POS = (const int2*)(ws + WS_POS); bf16_t* HP = (bf16_t*)(ws + WS_HP); bf16_t* P16 = (bf16_t*)(ws + WS_P16);
    for (int t0 = gw; t0 < T; t0 += 2 * NGW) {
        f32x4 v[2][4]; u32x2 ya[2][4], yb[2][4]; f32x4 pv[2];
#pragma unroll
        for (int u = 0; u < 2; ++u) { const int t = t0 + u * NGW; const int2 ps = POS[t];
            const f32x4* xr = (const f32x4*)(X + (size_t)t * DM) + lane; const u32x2* y0 = (const u32x2*)(YM + (size_t)ps.x * DM) + lane; const u32x2* y1 = (const u32x2*)(YM + (size_t)ps.y * DM) + lane;
#pragma unroll
            for (int j = 0; j < 4; ++j) { v[u][j] = xr[64 * j]; ya[u][j] = y0[64 * j]; yb[u][j] = y1[64 * j]; }
            pv[u] = *((const f32x4*)(a.in[I_P] + (size_t)t * 256) + lane); }
#pragma unroll
        for (int u = 0; u < 2; ++u) { const int t = t0 + u * NGW; float s = 0.f; f32x4* xr = (f32x4*)(X + (size_t)t * DM) + lane;
#pragma unroll
            for (int j = 0; j < 4; ++j) { float a0[4], a1[4]; unpack4(ya[u][j], a0); unpack4(yb[u][j], a1);
                v[u][j][0] = (v[u][j][0] + a0[0]) + a1[0]; v[u][j][1] = (v[u][j][1] + a0[1]) + a1[1]; v[u][j][2] = (v[u][j][2] + a0[2]) + a1[2]; v[u][j][3] = (v[u][j][3] + a0[3]) + a1[3];
                s += (v[u][j][0] * v[u][j][0] + v[u][j][1] * v[u][j][1]) + (v[u][j][2] * v[u][j][2] + v[u][j][3] * v[u][j][3]); xr[64 * j] = v[u][j]; }
            const float rs = 1.0f / sqrtf(wave_sum(s) * (1.0f / DM) + 1e-6f);
            u32x2* o = (u32x2*)(HP + (size_t)t * DM) + lane;
#pragma unroll
            for (int j = 0; j < 4; ++j) { u32x2 w; w.x = pk2(v[u][j][0] * rs, v[u][j][1] * rs); w.y = pk2(v[u][j][2] * rs, v[u][j][3] * rs); o[64 * j] = w; }
            u32x2 w; w.x = pk2(pv[u][0], pv[u][1]); w.y = pk2(pv[u][2], pv[u][3]); *((u32x2*)(P16 + (size_t)t * 256) + lane) = w; }
    }
}
__device__ __forceinline__ void phase15(const Args& a, const float* XS) {
    const int tid = threadIdx.x, lane = tid & 63, wave = tid >> 6;
    const int gw = blockIdx.x * 8 + wave, NGW = gridDim.x * 8;
    float* X = a.out; const f32x4* gn = (const f32x4*)a.in[I_FINN] + lane;
    f32x4 g[4];
#pragma unroll
    for (int j = 0; j < 4; ++j) g[j] = gn[64 * j];
    for (int t0 = gw; t0 < T; t0 += 2 * NGW) {
        f32x4 v[2][4];
#pragma unroll
        for (int u = 0; u < 2; ++u) { const f32x4* xs = (const f32x4*)(XS + (size_t)(t0 + u * NGW) * DM) + lane;
#pragma unroll
            for (int j = 0; j < 4; ++j) v[u][j] = xs[64 * j]; }
#pragma unroll
        for (int u = 0; u < 2; ++u) { float s = 0.f;
#pragma unroll
            for (int j = 0; j < 4; ++j) s += (v[u][j][0] * v[u][j][0] + v[u][j][1] * v[u][j][1]) + (v[u][j][2] * v[u][j][2] + v[u][j][3] * v[u][j][3]);
            const float rs = 1.0f / sqrtf(wave_sum(s) * (1.0f / DM) + 1e-6f);
            f32x4* xr = (f32x4*)(X + (size_t)(t0 + u * NGW) * DM) + lane;
#pragma unroll
            for (int j = 0; j < 4; ++j) xr[64 * j] = (f32x4){v[u][j][0] * rs * g[j][0], v[u][j][1] * rs * g[j][1], v[u][j][2] * rs * g[j][2], v[u][j][3] * rs * g[j][3]}; }
    }
}

#ifdef PROBE
__device__ __forceinline__ void phase_probe(const Args& a) {
    const int gt = blockIdx.x * 512 + threadIdx.x, NT = gridDim.x * 512;
#if PROBE == 1
    const bf16_t* src = (const bf16_t*)(a.ws + WS_HP); const size_t n = (size_t)T * DM;
#elif PROBE == 2
    const bf16_t* src = (const bf16_t*)(a.ws + WS_WPG); const size_t n = (size_t)1024 * 1024;
#else
    const bf16_t* src = (const bf16_t*)(a.ws + WS_G); const size_t n = (size_t)T * DM;
#endif
    for (size_t i = gt; i < (size_t)T * DM; i += NT) a.out[i] = (i < n) ? __builtin_bit_cast(float, (unsigned)src[i] << 16) : 0.f;
}
#endif
__global__ void __launch_bounds__(512) mega_fwd(Args a) {
    extern __shared__ __attribute__((aligned(16))) unsigned char lds_raw[];
    LAS unsigned char* lds = (LAS unsigned char*)lds_raw;
    unsigned char* ws = a.ws;
    const int G = gridDim.x, c = blockIdx.x;
    const int lo = a.ph_lo, hi = a.ph_hi;
    if (threadIdx.x < 32) ((LAS unsigned*)(lds + MISC_OFF))[threadIdx.x] = 0u;
    __syncthreads();
    XcdBarrier bar; bar.bar = (unsigned*)(ws + WS_CTL) + 4096; bar.x = 0; bar.st = nullptr;
    if (hi - lo > 1) bar = xcd_barrier_post((unsigned*)(ws + WS_CTL) + 4096, (volatile LAS unsigned*)(lds + MISC_OFF));
#ifndef DUPMASK
#define DUPMASK 0
#endif
#ifndef PHMASK
#define PHMASK 0xFFFFF
#endif
#define IN(k) ((((PHMASK) >> (k)) & 1) && lo <= (k) && (k) < hi)
#define SEAM_MASK 0x5FBB7u
#define SEAM(k) do { if (IN(k) && IN((k) + 1)) { if ((SEAM_MASK >> (k)) & 1u) { xcd_barrier(bar); } else __syncthreads(); } } while (0)
    bf16_t* COLS = (bf16_t*)(ws + WS_A);
    TSTART(100);
    if (IN(0)) for (int rep_ = 0; rep_ < (((DUPMASK) >> 0) & 1 ? 2 : 1); ++rep_) { phase0(a, lds); }
    SEAM(0);
    TSTOP(100);
    TSTART(101);
    if (IN(1)) for (int rep_ = 0; rep_ < (((DUPMASK) >> 1) & 1 ? 2 : 1); ++rep_) {
        pg8::DenseSched S; S.init(a.out, 1024, ws + WS_WIN, 1024, T, INC, G, c);
        pg8::EpiRow8<F_Cols> E{{COLS, INC, (bf16_t*)(ws + WS_UG)}};
        pg8::gemm_phase<pg8::EpiRow8<F_Cols>, pg8::DenseSched, true>(lds, 1024, 1024, 1024, S, E);
    }
    SEAM(1);
    TSTOP(101);
    TSTART(102);
    if (IN(2)) for (int rep_ = 0; rep_ < (((DUPMASK) >> 2) & 1 ? 2 : 1); ++rep_) { phase2(a); }
    SEAM(2);
    TSTOP(102);
    TSTART(103);
    if (IN(3)) for (int rep_ = 0; rep_ < (((DUPMASK) >> 3) & 1 ? 2 : 1); ++rep_) {
        pg8::LoraSched S{(const char*)(ws + WS_Z), (const char*)(ws + WS_WLORA), {}}; S.so.init(T, 1536, G, c);
        pg8::EpiRow8<F_Lora> E{{(bf16_t*)a.out, a.in[I_W0], a.in[I_A0]}};
        pg8::gemm_phase<pg8::EpiRow8<F_Lora>, pg8::LoraSched, true>(lds, 128, 256, 256, S, E);
    }
    SEAM(3);
    TSTOP(103);
    TSTART(104);
    if (IN(4)) for (int rep_ = 0; rep_ < (((DUPMASK) >> 4) & 1 ? 2 : 1); ++rep_) {
        pg8::GroupSched S{(const char*)(ws + WS_UG), (const char*)(ws + WS_W1), S5K, 512, 4, 1, 16, G, c, (size_t)S5ROWS * S5K * 2, (size_t)256 * 512 * 2};
        pg8::EpiRow8<F_S5a> E{{(float*)(ws + WS_E)}};
        pg8::gemm_phase<pg8::EpiRow8<F_S5a>, pg8::GroupSched, true>(lds, 512, S5K, 512, S, E);
        if (G == 256) { late_items_idle(a, lds, 0, 896, 64); late_items_idle(a, lds, 1536, 1568, 64); }
    }
    SEAM(4);
    TSTOP(104);
    TSTART(105);
    if (IN(5)) for (int rep_ = 0; rep_ < (((DUPMASK) >> 5) & 1 ? 2 : 1); ++rep_) {
#if WKV_CHUNKED == 2
        phase4s(a, lds, bar);
#elif WKV_CHUNKED
        phase4c(a, lds);
#else
        phase4(a, lds);
#endif
    }
    SEAM(5);
    TSTOP(105);
    TSTART(106);
    if (IN(6)) for (int rep_ = 0; rep_ < (((DUPMASK) >> 6) & 1 ? 2 : 1); ++rep_) { phase5_post(a); }
    SEAM(6);
    TSTOP(106);
    TSTART(107);
    if (IN(7)) for (int rep_ = 0; rep_ < (((DUPMASK) >> 7) & 1 ? 2 : 1); ++rep_) {
        pg8::GroupSched S{(const char*)(ws + WS_UG), (const char*)(ws + WS_TZ), S5K, S5K, 4, 2, 16, G, c, (size_t)S5ROWS * S5K * 2, (size_t)S5N * S5K * 2};
        pg8::EpiRow8<F_S5c> E{{COLS, a.in[I_SD], (bf16_t*)(ws + WS_Z)}};
        pg8::gemm_phase<pg8::EpiRow8<F_S5c>, pg8::GroupSched, true>(lds, S5K, S5K, S5K, S, E);
        if (G == 256) late_items_idle(a, lds, 1568, N_LATE, 128);
    }
    SEAM(7);
    TSTOP(107);
    TSTART(108);
    if (IN(8)) for (int rep_ = 0; rep_ < (((DUPMASK) >> 8) & 1 ? 2 : 1); ++rep_) {
        pg8::DenseSched S; S.init(ws + WS_Z, 256, ws + WS_WGLU, 256, T, 256, G, c);
        pg8::EpiRow8<F_Glu> E{{(const bf16_t*)(ws + WS_Z), a.in[I_GLUB], (bf16_t*)a.out}};
        pg8::gemm_phase<pg8::EpiRow8<F_Glu>, pg8::DenseSched, true>(lds, 256, 256, 256, S, E);
        if (G == 256) late_items_idle(a, lds, 896, 1536, 128);
    }
    SEAM(8);
    TSTOP(108);
    TSTART(109);
    if (IN(9)) for (int rep_ = 0; rep_ < (((DUPMASK) >> 9) & 1 ? 2 : 1); ++rep_) {
        pg8::BrSched S{(const char*)(ws + WS_RWKV), (const char*)(ws + WS_WBA), (const char*)a.out, (const char*)(ws + WS_WBB), {}}; S.so.init(T, DM, G, c);
        pg8::EpiBr E{COLS, (bf16_t*)(ws + WS_B)};
        pg8::gemm_phase2<pg8::EpiBr, pg8::BrSched, true, 8, 4>(lds, 512, 512, S, E);
    }
    SEAM(9);
    TSTOP(109);
    TSTART(110);
    SEAM(10);
    TSTOP(110);
    TSTART(111);
    if (IN(11)) for (int rep_ = 0; rep_ < (((DUPMASK) >> 11) & 1 ? 2 : 1); ++rep_) {
        pg8::DenseSched S; S.init(ws + WS_B, 1024, ws + WS_WOUT, 1024, T, DM, G, c);
        pg8::EpiRow8<F_Res> E{{a.in[I_X], a.out}};
        pg8::gemm_phase<pg8::EpiRow8<F_Res>, pg8::DenseSched, true>(lds, 1024, 1024, 1024, S, E);
    }
    SEAM(11);
    TSTOP(111);
    TSTART(112);
    if (IN(12)) for (int rep_ = 0; rep_ < (((DUPMASK) >> 12) & 1 ? 2 : 1); ++rep_) { phase9(a, lds); }
    SEAM(12);
    TSTOP(112);
    TSTART(113);
    if (IN(13)) for (int rep_ = 0; rep_ < (((DUPMASK) >> 13) & 1 ? 2 : 1); ++rep_) { phase10(a, lds); }
    SEAM(13);
    TSTOP(113);
    TSTART(114);
    if (IN(14)) for (int rep_ = 0; rep_ < (((DUPMASK) >> 14) & 1 ? 2 : 1); ++rep_) {
        pg8::MoeSched S{(const int*)(ws + WS_OFF), (const char*)(ws + WS_A), (const char*)(ws + WS_WGU), 1024, 1024, 2, G, c, (size_t)512 * 1024 * 2};
        pg8::EpiMoeUp E{(bf16_t*)(ws + WS_HID)};
        pg8::gemm_phase<pg8::EpiMoeUp, pg8::MoeSched, true>(lds, 1024, 1024, 1024, S, E);
    }
    SEAM(14);
    TSTOP(114);
    TSTART(115);
    if (IN(15)) for (int rep_ = 0; rep_ < (((DUPMASK) >> 15) & 1 ? 2 : 1); ++rep_) {
        pg8::MoeSched S{(const int*)(ws + WS_OFF), (const char*)(ws + WS_HID), (const char*)(ws + WS_WD), 256, 256, 4, G, c, (size_t)1024 * 256 * 2};
        pg8::EpiRow8<F_MoeDown> E{{(const float*)(ws + WS_ROWW), (bf16_t*)(ws + WS_A)}};
        pg8::gemm_phase<pg8::EpiRow8<F_MoeDown>, pg8::MoeSched, true>(lds, 256, 256, 256, S, E);
    }
    SEAM(15);
    TSTOP(115);
    TSTART(116);
    if (IN(16)) for (int rep_ = 0; rep_ < (((DUPMASK) >> 16) & 1 ? 2 : 1); ++rep_) { phase13(a); }
    SEAM(16);
    TSTOP(116);
    TSTART(117);
    if (IN(17)) for (int rep_ = 0; rep_ < (((DUPMASK) >> 17) & 1 ? 2 : 1); ++rep_) {
        pg8::DenseSched S; S.init(ws + WS_HP, 1024, ws + WS_WPG, 1024, T, DM, G, c);
        pg8::EpiRow8<F_PleG> E{{(bf16_t*)(ws + WS_G)}};
        pg8::gemm_phase<pg8::EpiRow8<F_PleG>, pg8::DenseSched, true>(lds, 1024, 1024, 1024, S, E);
    }
    SEAM(17);
    TSTOP(117);
    TSTART(118);
    if (IN(18)) for (int rep_ = 0; rep_ < (((DUPMASK) >> 18) & 1 ? 2 : 1); ++rep_) {
        pg8::DenseSched S; S.init(ws + WS_P16, 256, ws + WS_WPP, 256, T, DM, G, c);
        pg8::EpiRow8<F_PleP> E{{(const bf16_t*)(ws + WS_G), a.out, (float*)(ws + WS_A)}};
        pg8::gemm_phase<pg8::EpiRow8<F_PleP>, pg8::DenseSched, true>(lds, 256, 256, 256, S, E);
    }
    SEAM(18);
    TSTOP(118);
#ifdef PROBE
    TSTART(119);
    if (IN(19)) for (int rep_ = 0; rep_ < (((DUPMASK) >> 19) & 1 ? 2 : 1); ++rep_) { phase_probe(a); }
#else
    TSTART(119);
    if (IN(19)) for (int rep_ = 0; rep_ < (((DUPMASK) >> 19) & 1 ? 2 : 1); ++rep_) { phase15(a, ((PHMASK >> 18) & 1) ? (const float*)(ws + WS_A) : (const float*)a.out); }
#endif
    TSTOP(119);
#if TIMER_SEL || TIMER_PHMASK
    if (blockIdx.x == 0 && threadIdx.x == 0) { const unsigned acc_ = ((volatile LAS unsigned*)(lds + MISC_OFF + 64))[0]; const unsigned long long t0_ = __builtin_amdgcn_s_memrealtime();
        while (__builtin_amdgcn_s_memrealtime() - t0_ < (unsigned long long)acc_ * TIMER_MULT) __builtin_amdgcn_s_sleep(8); }
#endif
#undef IN
#undef SEAM
}

extern "C" void kernel_launch(void* const* d_in, const int* in_sizes, int n_in, void* d_out, int out_size, void* d_ws, size_t ws_size, hipStream_t stream) {
    static int grid = 0;
    if (grid == 0) {
        if (n_in != 40 || out_size != T * DM || ws_size < WS_END) { fprintf(stderr, "kernel_launch: unexpected problem (n_in %d, out %d, ws %zu < %zu); nothing launched\n", n_in, out_size, ws_size, (size_t)WS_END); grid = -1; return; }
        int dev = 0, cus = 0, per_cu = 0;
        hipGetDevice(&dev); hipDeviceGetAttribute(&cus, hipDeviceAttributeMultiprocessorCount, dev);
        if (hipFuncSetAttribute((const void*)mega_fwd, hipFuncAttributeMaxDynamicSharedMemorySize, LDS_BYTES) != hipSuccess) { fprintf(stderr, "kernel_launch: hipFuncSetAttribute failed\n"); grid = -1; return; }
        if (hipOccupancyMaxActiveBlocksPerMultiprocessor(&per_cu, (const void*)mega_fwd, 512, LDS_BYTES) != hipSuccess || per_cu < 1) { fprintf(stderr, "kernel_launch: occupancy query says %d\n", per_cu); per_cu = 1; }
        (void)hipGetLastError();
        grid = cus * 1;
        if (grid > 256) grid = 256;
    }
    if (grid < 0) return;
    Args a{};
    for (int i = 0; i < 40; ++i) a.in[i] = (const float*)d_in[i];
    a.out = (float*)d_out; a.ws = (unsigned char*)d_ws;
#if MK_N_LAUNCHES == 1
    if (hipMemsetAsync((char*)d_ws + WS_CTL, 0, 65536, stream) != hipSuccess) { fprintf(stderr, "kernel_launch: memset failed\n"); return; }
    a.ph_lo = 0; a.ph_hi = NPHASE;
    void* kargs[] = {&a};
    hipError_t e = hipLaunchCooperativeKernel((const void*)mega_fwd, dim3(grid), dim3(512), kargs, LDS_BYTES, stream);
    if (e != hipSuccess) fprintf(stderr, "kernel_launch: cooperative launch failed: %s\n", hipGetErrorString(e));
#else
    for (int k = 0; k < NPHASE; ++k) {
        a.ph_lo = k; a.ph_hi = k + 1;
        hipLaunchKernelGGL(mega_fwd, dim3(grid), dim3(512), LDS_BYTES, stream, a);
    }
#endif
}
```

```cpp
#include <hip/hip_runtime.h>
#include <hip/hip_cooperative_groups.h>
#include <cstdio>
#include <cstdint>
namespace cg = cooperative_groups;

#ifndef WKV_CHUNKED
#define WKV_CHUNKED 2
#endif
#ifndef MK_N_LAUNCHES
#define MK_N_LAUNCHES 1
#endif

#define LAS __attribute__((address_space(3)))
typedef unsigned short bf16_t;
typedef short bf16x8 __attribute__((ext_vector_type(8)));
typedef float f32x4 __attribute__((ext_vector_type(4)));
typedef float f32x2 __attribute__((ext_vector_type(2)));
typedef unsigned u32x4 __attribute__((ext_vector_type(4)));
typedef unsigned u32x2 __attribute__((ext_vector_type(2)));

constexpr int T = 32768, DM = 1024, SEQ = 2048, NBATCH = 16, INC = 4096;
constexpr int C_R = 0, C_K = 512, C_V = 1024, C_WD = 1536, C_U = 1792, C_GA = 2048, C_GB = 3072;
constexpr int S5L = 32, S5NCH = 64, S5K = 640, S5N = 512, S5ROWS = 1024;
constexpr int NEXP = 32, DEXP = 256, MOE_ROWS_MAX = 2 * T + NEXP * 256;
constexpr int NPHASE = 20;

constexpr size_t MiB = (size_t)1 << 20, KiB = 1024;
constexpr size_t WS_CTL = 0;
constexpr size_t WS_WIN = 1 * MiB, WS_WBA = 9 * MiB, WS_WBB = 10 * MiB, WS_WOUT = 11 * MiB, WS_WPG = 13 * MiB, WS_WPP = 15 * MiB;
constexpr size_t WS_WLORA = 16 * MiB, WS_WGLU = 17 * MiB, WS_WR = 17 * MiB + 512 * KiB, WS_LAML = 17 * MiB + 768 * KiB;
constexpr size_t WS_KG = 18 * MiB, WS_W1 = 19 * MiB, WS_TZ = 23 * MiB, WS_WGU = 33 * MiB, WS_WD = 65 * MiB;
constexpr size_t WS_A = 82 * MiB;
constexpr size_t WS_HID = WS_A + 144 * MiB, WS_G = WS_A + 128 * MiB;
constexpr size_t WS_B = 338 * MiB;
constexpr size_t WS_UG = 402 * MiB, WS_E = 422 * MiB, WS_BON = 430 * MiB, WS_RWKV = 431 * MiB, WS_Z = 463 * MiB, WS_S5O = 479 * MiB;
constexpr size_t WS_ROUTE = 495 * MiB, WS_POS = 495 * MiB + 512 * KiB, WS_ROWW = 496 * MiB, WS_BC = 496 * MiB + 512 * KiB, WS_OFF = 496 * MiB + 768 * KiB;
constexpr size_t WS_HP = WS_RWKV;
constexpr size_t WS_P16 = WS_UG;
constexpr size_t WS_END = 497 * MiB;

constexpr int LDS_BYTES = 163840;
constexpr int MISC_OFF = 163584;

struct Args { const float* in[40]; float* out; unsigned char* ws; int ph_lo, ph_hi; };

#ifndef TIMER_SEL
#define TIMER_SEL 0
#endif
#ifndef TIMER_MULT
#define TIMER_MULT 2
#endif
#ifndef TIMER_PHMASK
#define TIMER_PHMASK 0
#endif
#if TIMER_SEL || TIMER_PHMASK
#define TSTART(id) do { if (((id) == TIMER_SEL || ((id) >= 100 && ((TIMER_PHMASK >> ((id) - 100)) & 1))) && blockIdx.x == 0 && threadIdx.x == 0) { volatile LAS unsigned* t_ = (volatile LAS unsigned*)(lds + MISC_OFF + 64); t_[0] = t_[0] - (unsigned)__builtin_amdgcn_s_memrealtime(); } } while (0)
#define TSTOP(id) do { if (((id) == TIMER_SEL || ((id) >= 100 && ((TIMER_PHMASK >> ((id) - 100)) & 1))) && blockIdx.x == 0 && threadIdx.x == 0) { volatile LAS unsigned* t_ = (volatile LAS unsigned*)(lds + MISC_OFF + 64); t_[0] = t_[0] + (unsigned)__builtin_amdgcn_s_memrealtime(); } } while (0)
#else
#define TSTART(id) do { } while (0)
#define TSTOP(id) do { } while (0)
#endif

#define LDS_WAIT() asm volatile("s_waitcnt lgkmcnt(0)" ::: "memory")
#define VM_WAIT() asm volatile("s_waitcnt vmcnt(0)" ::: "memory")
__device__ __forceinline__ unsigned f2bf(float f) { unsigned u = __builtin_bit_cast(unsigned, f); return (u + 0x7fffu + ((u >> 16) & 1u)) >> 16; }
__device__ __forceinline__ unsigned pk2(float lo, float hi) { return f2bf(lo) | (f2bf(hi) << 16); }
typedef __bf16 bf16x2_t __attribute__((ext_vector_type(2)));
__device__ __forceinline__ unsigned cvt_pk_bf16(float lo, float hi) { const f32x2 v = {lo, hi}; const bf16x2_t b = __builtin_convertvector(v, bf16x2_t); return __builtin_bit_cast(unsigned, b); }
__device__ __forceinline__ float bflo(unsigned w) { return __builtin_bit_cast(float, w << 16); }
__device__ __forceinline__ float bfhi(unsigned w) { return __builtin_bit_cast(float, w & 0xffff0000u); }
__device__ __forceinline__ void unpack8(u32x4 w, float (&v)[8]) { v[0] = bflo(w.x); v[1] = bfhi(w.x); v[2] = bflo(w.y); v[3] = bfhi(w.y); v[4] = bflo(w.z); v[5] = bfhi(w.z); v[6] = bflo(w.w); v[7] = bfhi(w.w); }
__device__ __forceinline__ void unpack4(u32x2 w, float (&v)[4]) { v[0] = bflo(w.x); v[1] = bfhi(w.x); v[2] = bflo(w.y); v[3] = bfhi(w.y); }
__device__ __forceinline__ u32x4 pack8(const float (&v)[8]) { u32x4 w; w.x = cvt_pk_bf16(v[0], v[1]); w.y = cvt_pk_bf16(v[2], v[3]); w.z = cvt_pk_bf16(v[4], v[5]); w.w = cvt_pk_bf16(v[6], v[7]); return w; }
__device__ __forceinline__ float sigmoidf_(float x) { return __builtin_amdgcn_rcpf(1.0f + __expf(-x)); }
__device__ __forceinline__ float tanhf_(float x) { return 1.0f - 2.0f * __builtin_amdgcn_rcpf(1.0f + __expf(2.0f * x)); }
__device__ __forceinline__ float gelu_tanh(float y) { return 0.5f * y * (1.0f + tanhf_(0.7978845608028654f * (y + 0.044715f * y * y * y))); }
__device__ __forceinline__ float wave_sum(float v) {
#pragma unroll
    for (int o = 1; o < 64; o <<= 1) v += __shfl_xor(v, o);
    return v;
}
__device__ __forceinline__ float dpp_f(float x, const int ctrl_sel) {
    int xi = __builtin_bit_cast(int, x), r;
    if (ctrl_sel == 0) r = __builtin_amdgcn_update_dpp(0, xi, 0xB1, 0xf, 0xf, true);
    else if (ctrl_sel == 1) r = __builtin_amdgcn_update_dpp(0, xi, 0x4E, 0xf, 0xf, true);
    else if (ctrl_sel == 2) r = __builtin_amdgcn_update_dpp(0, xi, 0x141, 0xf, 0xf, true);
    else r = __builtin_amdgcn_update_dpp(0, xi, 0x140, 0xf, 0xf, true);
    return __builtin_bit_cast(float, r);
}
__device__ __forceinline__ float row16_sum(float x) {
    x += dpp_f(x, 0); x += dpp_f(x, 1); x += dpp_f(x, 2); x += dpp_f(x, 3); return x;
}


#define XB_TMO      128
#define XB_XCNT(j)  (256  + 64 * (j))
#define XB_XSUB(j)  (1280 + 64 * (j))
#define XB_XGEN(j)  (2304 + 64 * (j))
#define XB_TOP      3328
#define XB_TOPGEN   3392
#define XCD_BAR_WORDS 3456
#define XB_SPIN_CAP (1u << 22)
__device__ __forceinline__ unsigned xb_ld(unsigned* p)              { return __hip_atomic_load(p, __ATOMIC_RELAXED, __HIP_MEMORY_SCOPE_AGENT); }
__device__ __forceinline__ unsigned xb_add(unsigned* p, unsigned v) { return __hip_atomic_fetch_add(p, v, __ATOMIC_RELAXED, __HIP_MEMORY_SCOPE_AGENT); }
__device__ __forceinline__ unsigned xb_xcc_id() { return (unsigned)__builtin_amdgcn_s_getreg((3 << 11) | 20) & 0xFu; }
#define XB_SPIN(cond, bar) do { unsigned _sp = 0; while (cond) { __builtin_amdgcn_s_sleep(1); \
    if ((++_sp & 255u) == 0u) { if (xb_ld(&(bar)[XB_TMO])) break; if (_sp > XB_SPIN_CAP) { atomicAdd(&(bar)[XB_TMO], 1u); break; } } } } while (0)
struct XcdBarrier { unsigned* bar; unsigned x; volatile LAS unsigned* st; };
__device__ __forceinline__ XcdBarrier xcd_barrier_post(unsigned* bar, volatile LAS unsigned* st) {
    XcdBarrier b; b.bar = bar; b.x = xb_xcc_id(); b.st = st;
    if (threadIdx.x == 0) (void)xb_add(&bar[XB_XCNT(b.x)], 1u);
    return b;
}
__device__ __forceinline__ void xcd_barrier_complete(unsigned* bar, unsigned x, unsigned& nloc, unsigned& nx) {
    const unsigned G = gridDim.x * gridDim.y * gridDim.z;
    unsigned sum, cnt, mine, sp = 0u;
    for (;;) {
        sum = 0u; cnt = 0u; mine = 0u;
#pragma unroll
        for (unsigned j = 0; j < 16; ++j) { const unsigned c = xb_ld(&bar[XB_XCNT(j)]); sum += c; cnt += (c > 0u) ? 1u : 0u; mine = (j == x) ? c : mine; }
        if (sum == G) break;
        __builtin_amdgcn_s_sleep(1);
        if ((++sp & 255u) == 0u) { if (xb_ld(&bar[XB_TMO])) break; if (sp > XB_SPIN_CAP) { atomicAdd(&bar[XB_TMO], 1u); break; } }
    }
    nloc = mine > 0u ? mine : 1u; nx = cnt > 0u ? cnt : 1u;
}
__device__ __forceinline__ void xcd_barrier(const XcdBarrier& b) {
    asm volatile("s_waitcnt vmcnt(0)" ::: "memory");
    __syncthreads();
    if (threadIdx.x == 0) {
        unsigned* bar = b.bar;
        __builtin_amdgcn_s_waitcnt(0);
        unsigned nloc = b.st[0], nx = b.st[1];
        if (nloc == 0u) { xcd_barrier_complete(bar, b.x, nloc, nx); b.st[0] = nloc; b.st[1] = nx; }
        const unsigned old = xb_add(&bar[XB_XSUB(b.x)], 1u);
        const unsigned gen = old / nloc;
        if (old + 1u == (gen + 1u) * nloc) {
            __builtin_amdgcn_fence(__ATOMIC_RELEASE, "agent");
            asm volatile("s_waitcnt vmcnt(0)" ::: "memory");
            const unsigned og = xb_add(&bar[XB_TOP], 1u);
            const unsigned tg = og / nx;
            if (og + 1u == (tg + 1u) * nx) xb_add(&bar[XB_TOPGEN], 1u);
            else XB_SPIN(xb_ld(&bar[XB_TOPGEN]) == tg, bar);
            __builtin_amdgcn_fence(__ATOMIC_ACQUIRE, "agent");
            xb_add(&bar[XB_XGEN(b.x)], 1u);
            asm volatile("s_waitcnt vmcnt(0)" ::: "memory");
        } else {
            XB_SPIN(xb_ld(&bar[XB_XGEN(b.x)]) == gen, bar);
            __builtin_amdgcn_fence(__ATOMIC_ACQUIRE, "agent");
            asm volatile("s_waitcnt vmcnt(0)" ::: "memory");
        }
    }
    __syncthreads();
}

namespace pg8 {
constexpr int BM = 256, BK = 64, HALF = 128, HTB = HALF * BK * 2, STAGE_BYTES = 8 * HTB, NXCD = 8, WGM = 8;
__host__ __device__ __forceinline__ int lds_byte(int r, int c) { const int st = (r >> 4) * 2 + (c >> 5), rr = r & 15, cc = c & 31, ob = rr * 64 + cc * 2; return st * 1024 + (ob ^ (((ob >> 9) & 1) << 5)); }
__host__ __device__ __forceinline__ void stage_rc(int b, int& R, int& C) { const int st = b / 1024, sb = b % 1024, swz = sb ^ (((sb >> 9) & 1) << 5); R = (st >> 1) * 16 + swz / 64; C = (st & 1) * 32 + (swz % 64) / 2; }
__host__ __device__ __forceinline__ int perm32(int rho) { const int n = rho >> 4, i = rho & 15; return 8 * (i >> 2) + 4 * n + (i & 3); }

struct Unit { int pm, pn, aux; const char* A; const char* B; };

struct StaticOrder {
    int nM, nN, nwg, G, c;
    __device__ __forceinline__ void init(int M, int N, int G_, int c_) { nM = M / BM; nN = N / BM; nwg = nM * nN; G = G_; c = c_; }
    __device__ __forceinline__ bool next(int i, int& pm, int& pn) const {
        const long L = (long)i * G + c; if (L >= nwg) return false;
        int wgid = (int)L; { const int q = nwg / NXCD, r = nwg % NXCD, xcd = wgid % NXCD, off = wgid / NXCD; wgid = (xcd < r ? xcd * (q + 1) : r * (q + 1) + (xcd - r) * q) + off; }
        const int nig = WGM * nN, gid = wgid / nig, fm = gid * WGM, gsz = (nM - fm) < WGM ? (nM - fm) : WGM;
        pm = fm + ((wgid % nig) % gsz); pn = (wgid % nig) / gsz; return true;
    }
};
struct DenseSched {
    const char* A; const char* B; int lda, ldb; StaticOrder so;
    __device__ __forceinline__ void init(const void* A_, int lda_, const void* B_, int ldb_, int M, int N, int G, int c) { A = (const char*)A_; B = (const char*)B_; lda = lda_; ldb = ldb_; so.init(M, N, G, c); }
    __device__ __forceinline__ bool next(int i, Unit& u) const {
        int pm, pn; if (!so.next(i, pm, pn)) return false;
        u.pm = pm; u.pn = pn; u.aux = 0; u.A = A + (size_t)pm * BM * lda * 2; u.B = B + (size_t)pn * BM * ldb * 2; return true;
    }
};
struct LoraSched {
    const char* A; const char* B; StaticOrder so;
    __device__ __forceinline__ bool next(int i, Unit& u) const {
        int pm, pn; if (!so.next(i, pm, pn)) return false;
        const int k0 = pn < 4 ? 0 : 128;
        u.pm = pm; u.pn = pn; u.aux = 0; u.A = A + ((size_t)pm * BM * 256 + k0) * 2; u.B = B + ((size_t)pn * BM * 256 + k0) * 2; return true;
    }
};
struct GroupSched {
    const char* A; const char* B; int lda, ldb, nM, nN, ngroups, G, c; size_t aStride, bStride;
    __device__ __forceinline__ bool next(int i, Unit& u) const {
        const int L = i * G + c; if (L >= ngroups * nM * nN) return false;
        const int g = L / (nM * nN), r = L % (nM * nN), pm = r % nM, pn = r / nM;
        u.pm = pm; u.pn = pn; u.aux = g; u.A = A + g * aStride + (size_t)pm * BM * lda * 2; u.B = B + g * bStride + (size_t)pn * BM * ldb * 2; return true;
    }
};
struct MoeSched {
    const int* off; const char* A; const char* B; int lda, ldb, NPN, G, c; size_t bStride;
    __device__ __forceinline__ bool next(int i, Unit& u) const {
        const int nTiles = off[NEXP] >> 8; const int L = i * G + c; if (L >= nTiles * NPN) return false;
        const int tile = L / NPN, pn = L % NPN, row = tile << 8; int e = 0;
        for (int k = 1; k < NEXP; ++k) e += (off[k] <= row) ? 1 : 0;
        u.pm = tile; u.pn = pn; u.aux = e; u.A = A + (size_t)tile * BM * lda * 2; u.B = B + e * bStride + (size_t)pn * BM * ldb * 2; return true;
    }
};

template <class F> struct EpiRow8 {
    F f;
    __device__ __forceinline__ void operator()(const f32x4 (&acc)[2][2][4][2], const Unit& u, int wr, int wc, int fr, int fq) const {
#pragma unroll
        for (int ai = 0; ai < 2; ++ai)
#pragma unroll
            for (int m = 0; m < 4; ++m) { const int r = ai * HALF + wr * 64 + m * 16 + fr;
#pragma unroll
                for (int bj = 0; bj < 2; ++bj) { const int c = bj * HALF + wc * 32 + 8 * fq;
                    float v[8] = {acc[ai][bj][m][0][0], acc[ai][bj][m][0][1], acc[ai][bj][m][0][2], acc[ai][bj][m][0][3], acc[ai][bj][m][1][0], acc[ai][bj][m][1][1], acc[ai][bj][m][1][2], acc[ai][bj][m][1][3]};
                    f(u, r, c, v); } }
    }
};
struct EpiMoeUp {
    bf16_t* HID;
    __device__ __forceinline__ void operator()(const f32x4 (&acc)[2][2][4][2], const Unit& u, int wr, int wc, int fr, int fq) const {
#pragma unroll
        for (int ai = 0; ai < 2; ++ai)
#pragma unroll
            for (int m = 0; m < 4; ++m) { const int r = u.pm * BM + ai * HALF + wr * 64 + m * 16 + fr; const int hc = u.pn * HALF + wc * 32 + 8 * fq;
                float o[8];
#pragma unroll
                for (int n = 0; n < 2; ++n)
#pragma unroll
                    for (int k = 0; k < 4; ++k) { const float g = acc[ai][0][m][n][k], up = acc[ai][1][m][n][k]; o[4 * n + k] = g * sigmoidf_(g) * up; }
                *(u32x4*)(HID + (size_t)r * DEXP + hc) = pack8(o); }
    }
};

template <class Epi, class Sched, bool ALIGN_EPI>
__device__ __forceinline__ void gemm_phase(LAS unsigned char* lds, const int K, const int lda, const int ldb, const Sched& S, const Epi& E) {
    const int tid = threadIdx.x, wid = __builtin_amdgcn_readfirstlane(tid >> 6), lane = tid & 63, wr = wid >> 2, wc = wid & 3, fr = lane & 15, fq = lane >> 4;
    const int nt = K / BK;
    unsigned voffA[2], voffB[2];
#pragma unroll
    for (int i = 0; i < 2; ++i) { int R, C; stage_rc(tid * 16 + i * 8192, R, C); const int Rb = (R & ~31) + perm32(R & 31);
        voffA[i] = (unsigned)(R * lda + C) * 2u; voffB[i] = (unsigned)(Rb * ldb + C) * 2u; }
    const size_t kstep = (size_t)(BK * 2);
    const size_t hstepA = (size_t)HALF * lda * 2, hstepB = (size_t)HALF * ldb * 2;
    const unsigned ldsw = (unsigned)wid * 1024u;
    const int aoff = lds_byte(wr * 64 + fr, fq * 8), boff = lds_byte(wc * 32 + fr, fq * 8);
#define PG8_SA(b, h) (((b) * 2 + (h)) * HTB)
#define PG8_SB(b, h) ((4 + (b) * 2 + (h)) * HTB)
#define PG8_STAGE(bufoff, gbase, voff) do { _Pragma("unroll") for (int _i = 0; _i < 2; ++_i) \
        __builtin_amdgcn_global_load_lds((const unsigned*)((const char*)(gbase) + (voff)[_i]), (LAS unsigned*)(lds + (bufoff) + ldsw + _i * 8192), 16, 0, 0); } while (0)
#define PG8_LDA(dst, b, h) do { _Pragma("unroll") for (int m = 0; m < 4; ++m) _Pragma("unroll") for (int k = 0; k < 2; ++k) dst[m][k] = *(const LAS bf16x8*)(lds + PG8_SA(b, h) + aoff + m * 2048 + k * 1024); } while (0)
#define PG8_LDB(dst, b, h) do { _Pragma("unroll") for (int n = 0; n < 2; ++n) _Pragma("unroll") for (int k = 0; k < 2; ++k) dst[n][k] = *(const LAS bf16x8*)(lds + PG8_SB(b, h) + boff + n * 2048 + k * 1024); } while (0)
#define PG8_MMA(ai, bj, At, Bt) do { __builtin_amdgcn_s_setprio(1); _Pragma("unroll") for (int m = 0; m < 4; ++m) _Pragma("unroll") for (int n = 0; n < 2; ++n) _Pragma("unroll") for (int k = 0; k < 2; ++k) \
        acc[ai][bj][m][n] = __builtin_amdgcn_mfma_f32_16x16x32_bf16(Bt[n][k], At[m][k], acc[ai][bj][m][n], 0, 0, 0); __builtin_amdgcn_s_setprio(0); } while (0)
#define PG8_WAIT_V(n) asm volatile("s_waitcnt vmcnt(" #n ")" ::: "memory")
#define PG8_WAIT_L(n) asm volatile("s_waitcnt lgkmcnt(" #n ")" ::: "memory")
#define PG8_BAR __builtin_amdgcn_s_barrier()
#define PG8_SCHED __builtin_amdgcn_sched_barrier(0)
    Unit cur, nxt; int ui = 0;
    if (!S.next(0, cur)) return;
    f32x4 acc[2][2][4][2];
#pragma unroll
    for (int a = 0; a < 2; ++a)
#pragma unroll
        for (int b = 0; b < 2; ++b)
#pragma unroll
            for (int m = 0; m < 4; ++m)
#pragma unroll
                for (int n = 0; n < 2; ++n) acc[a][b][m][n] = (f32x4){0.f, 0.f, 0.f, 0.f};
    bf16x8 At[4][2], B0[2][2], B1[2][2];
    const char* cA = cur.A; const char* cB = cur.B;
    PG8_STAGE(PG8_SB(0, 0), cB, voffB); PG8_STAGE(PG8_SB(0, 1), cB + hstepB, voffB); PG8_STAGE(PG8_SA(0, 0), cA, voffA); PG8_STAGE(PG8_SA(0, 1), cA + hstepA, voffA);
    if (wr == 1) PG8_BAR;
    PG8_WAIT_V(2); PG8_BAR;
    PG8_STAGE(PG8_SB(1, 0), cB + kstep, voffB); PG8_STAGE(PG8_SA(1, 0), cA + kstep, voffA); PG8_STAGE(PG8_SB(1, 1), cB + hstepB + kstep, voffB);
    PG8_WAIT_V(6); PG8_BAR;
    for (;;) {
        const bool has_next = S.next(ui + 1, nxt);
        const char* nA = has_next ? nxt.A : cA; const char* nB = has_next ? nxt.B : cB;
#pragma unroll 1
        for (int t = 0; t < nt; t += 2) {
            const bool last = (t == nt - 2);
            const char* a1 = cA + (size_t)(t + 1) * kstep;
            const char* a2 = last ? nA : cA + (size_t)(t + 2) * kstep; const char* b2 = last ? nB : cB + (size_t)(t + 2) * kstep;
            const char* a3 = a2 + kstep; const char* b3 = b2 + kstep;
            PG8_LDB(B0, 0, 0); PG8_LDB(B1, 0, 1); PG8_SCHED; PG8_LDA(At, 0, 0); PG8_STAGE(PG8_SA(1, 1), a1 + hstepA, voffA);
            PG8_WAIT_V(8); PG8_WAIT_L(0); PG8_BAR; PG8_MMA(0, 0, At, B0); PG8_MMA(0, 1, At, B1); PG8_BAR; PG8_SCHED;
            PG8_LDA(At, 0, 1); PG8_STAGE(PG8_SB(0, 0), b2, voffB); PG8_STAGE(PG8_SB(0, 1), b2 + hstepB, voffB); PG8_STAGE(PG8_SA(0, 0), a2, voffA);
            PG8_WAIT_V(8); PG8_WAIT_L(0); PG8_BAR; PG8_MMA(1, 0, At, B0); PG8_MMA(1, 1, At, B1); PG8_BAR; PG8_SCHED;
            PG8_LDB(B0, 1, 0); PG8_LDB(B1, 1, 1); PG8_SCHED; PG8_LDA(At, 1, 0); PG8_STAGE(PG8_SA(0, 1), a2 + hstepA, voffA);
            PG8_WAIT_V(8); PG8_WAIT_L(0); PG8_BAR; PG8_MMA(0, 0, At, B0); PG8_MMA(0, 1, At, B1); PG8_BAR; PG8_SCHED;
            PG8_LDA(At, 1, 1); PG8_STAGE(PG8_SB(1, 0), b3, voffB); PG8_STAGE(PG8_SB(1, 1), b3 + hstepB, voffB); PG8_STAGE(PG8_SA(1, 0), a3, voffA);
            PG8_WAIT_V(8); PG8_WAIT_L(0); PG8_BAR; PG8_MMA(1, 0, At, B0); PG8_MMA(1, 1, At, B1); PG8_BAR; PG8_SCHED;
        }
        if constexpr (ALIGN_EPI) { if (wr == 0) PG8_BAR; }
        E(acc, cur, wr, wc, fr, fq);
        if (!has_next) break;
#pragma unroll
        for (int a = 0; a < 2; ++a)
#pragma unroll
            for (int b = 0; b < 2; ++b)
#pragma unroll
                for (int m = 0; m < 4; ++m)
#pragma unroll
                    for (int n = 0; n < 2; ++n) acc[a][b][m][n] = (f32x4){0.f, 0.f, 0.f, 0.f};
        cur = nxt; cA = nA; cB = nB; ++ui;
        if constexpr (ALIGN_EPI) { if (wr == 1) PG8_BAR; }
    }
    PG8_WAIT_V(0);
    if constexpr (!ALIGN_EPI) { if (wr == 0) PG8_BAR; }
    PG8_BAR;
#undef PG8_SA
#undef PG8_SB
#undef PG8_STAGE
#undef PG8_LDA
#undef PG8_LDB
#undef PG8_MMA
#undef PG8_WAIT_V
#undef PG8_WAIT_L
#undef PG8_BAR
#undef PG8_SCHED
}

struct Unit2 { int pm, pn; const char* A0; const char* B0; const char* A1; const char* B1; };
template <class Epi, class Sched, bool ALIGN_EPI, int NT0, int NT1>
__device__ __forceinline__ void gemm_phase2(LAS unsigned char* lds, const int lda, const int ldb, const Sched& S, const Epi& E) {
    const int tid = threadIdx.x, wid = __builtin_amdgcn_readfirstlane(tid >> 6), lane = tid & 63, wr = wid >> 2, wc = wid & 3, fr = lane & 15, fq = lane >> 4;
    unsigned voffA[2], voffB[2];
#pragma unroll
    for (int i = 0; i < 2; ++i) { int R, C; stage_rc(tid * 16 + i * 8192, R, C); const int Rb = (R & ~31) + perm32(R & 31);
        voffA[i] = (unsigned)(R * lda + C) * 2u; voffB[i] = (unsigned)(Rb * ldb + C) * 2u; }
    const size_t kstep = (size_t)(BK * 2);
    const size_t hstepA = (size_t)HALF * lda * 2, hstepB = (size_t)HALF * ldb * 2;
    const unsigned ldsw = (unsigned)wid * 1024u;
    const int aoff = lds_byte(wr * 64 + fr, fq * 8), boff = lds_byte(wc * 32 + fr, fq * 8);
#define PG8_SA(b, h) (((b) * 2 + (h)) * HTB)
#define PG8_SB(b, h) ((4 + (b) * 2 + (h)) * HTB)
#define PG8_STAGE(bufoff, gbase, voff) do { _Pragma("unroll") for (int _i = 0; _i < 2; ++_i) \
        __builtin_amdgcn_global_load_lds((const unsigned*)((const char*)(gbase) + (voff)[_i]), (LAS unsigned*)(lds + (bufoff) + ldsw + _i * 8192), 16, 0, 0); } while (0)
#define PG8_LDA(dst, b, h) do { _Pragma("unroll") for (int m = 0; m < 4; ++m) _Pragma("unroll") for (int k = 0; k < 2; ++k) dst[m][k] = *(const LAS bf16x8*)(lds + PG8_SA(b, h) + aoff + m * 2048 + k * 1024); } while (0)
#define PG8_LDB(dst, b, h) do { _Pragma("unroll") for (int n = 0; n < 2; ++n) _Pragma("unroll") for (int k = 0; k < 2; ++k) dst[n][k] = *(const LAS bf16x8*)(lds + PG8_SB(b, h) + boff + n * 2048 + k * 1024); } while (0)
#define PG8_MMA(ai, bj, At, Bt) do { __builtin_amdgcn_s_setprio(1); _Pragma("unroll") for (int m = 0; m < 4; ++m) _Pragma("unroll") for (int n = 0; n < 2; ++n) _Pragma("unroll") for (int k = 0; k < 2; ++k) \
        acc[ai][bj][m][n] = __builtin_amdgcn_mfma_f32_16x16x32_bf16(Bt[n][k], At[m][k], acc[ai][bj][m][n], 0, 0, 0); __builtin_amdgcn_s_setprio(0); } while (0)
#define PG8_WAIT_V(n) asm volatile("s_waitcnt vmcnt(" #n ")" ::: "memory")
#define PG8_WAIT_L(n) asm volatile("s_waitcnt lgkmcnt(" #n ")" ::: "memory")
#define PG8_BAR __builtin_amdgcn_s_barrier()
#define PG8_SCHED __builtin_amdgcn_sched_barrier(0)
#define PG8_KLOOP(NT, cA_, cB_, nA_, nB_) _Pragma("unroll 1") for (int t = 0; t < (NT); t += 2) { \
            const bool last = (t == (NT) - 2); \
            const char* a1 = (cA_) + (size_t)(t + 1) * kstep; \
            const char* a2 = last ? (nA_) : (cA_) + (size_t)(t + 2) * kstep; const char* b2 = last ? (nB_) : (cB_) + (size_t)(t + 2) * kstep; \
            const char* a3 = a2 + kstep; const char* b3 = b2 + kstep; \
            PG8_LDB(B0, 0, 0); PG8_LDB(B1, 0, 1); PG8_SCHED; PG8_LDA(At, 0, 0); PG8_STAGE(PG8_SA(1, 1), a1 + hstepA, voffA); \
            PG8_WAIT_V(8); PG8_WAIT_L(0); PG8_BAR; PG8_MMA(0, 0, At, B0); PG8_MMA(0, 1, At, B1); PG8_BAR; PG8_SCHED; \
            PG8_LDA(At, 0, 1); PG8_STAGE(PG8_SB(0, 0), b2, voffB); PG8_STAGE(PG8_SB(0, 1), b2 + hstepB, voffB); PG8_STAGE(PG8_SA(0, 0), a2, voffA); \
            PG8_WAIT_V(8); PG8_WAIT_L(0); PG8_BAR; PG8_MMA(1, 0, At, B0); PG8_MMA(1, 1, At, B1); PG8_BAR; PG8_SCHED; \
            PG8_LDB(B0, 1, 0); PG8_LDB(B1, 1, 1); PG8_SCHED; PG8_LDA(At, 1, 0); PG8_STAGE(PG8_SA(0, 1), a2 + hstepA, voffA); \
            PG8_WAIT_V(8); PG8_WAIT_L(0); PG8_BAR; PG8_MMA(0, 0, At, B0); PG8_MMA(0, 1, At, B1); PG8_BAR; PG8_SCHED; \
            PG8_LDA(At, 1, 1); PG8_STAGE(PG8_SB(1, 0), b3, voffB); PG8_STAGE(PG8_SB(1, 1), b3 + hstepB, voffB); PG8_STAGE(PG8_SA(1, 0), a3, voffA); \
            PG8_WAIT_V(8); PG8_WAIT_L(0); PG8_BAR; PG8_MMA(1, 0, At, B0); PG8_MMA(1, 1, At, B1); PG8_BAR; PG8_SCHED; }
    Unit2 cur, nxt; int ui = 0;
    if (!S.next(0, cur)) return;
    f32x4 acc[2][2][4][2];
#pragma unroll
    for (int a = 0; a < 2; ++a)
#pragma unroll
        for (int b = 0; b < 2; ++b)
#pragma unroll
            for (int m = 0; m < 4; ++m)
#pragma unroll
                for (int n = 0; n < 2; ++n) acc[a][b][m][n] = (f32x4){0.f, 0.f, 0.f, 0.f};
    bf16x8 At[4][2], B0[2][2], B1[2][2];
    {
        const char* cA = cur.A0; const char* cB = cur.B0;
        PG8_STAGE(PG8_SB(0, 0), cB, voffB); PG8_STAGE(PG8_SB(0, 1), cB + hstepB, voffB); PG8_STAGE(PG8_SA(0, 0), cA, voffA); PG8_STAGE(PG8_SA(0, 1), cA + hstepA, voffA);
        if (wr == 1) PG8_BAR;
        PG8_WAIT_V(2); PG8_BAR;
        PG8_STAGE(PG8_SB(1, 0), cB + kstep, voffB); PG8_STAGE(PG8_SA(1, 0), cA + kstep, voffA); PG8_STAGE(PG8_SB(1, 1), cB + hstepB + kstep, voffB);
        PG8_WAIT_V(6); PG8_BAR;
    }
    for (;;) {
        const bool has_next = S.next(ui + 1, nxt);
        const char* nA = has_next ? nxt.A0 : cur.A0; const char* nB = has_next ? nxt.B0 : cur.B0;
        PG8_KLOOP(NT0, cur.A0, cur.B0, cur.A1, cur.B1)
        E.mid(acc, cur, wr, wc, fr, fq);
        PG8_KLOOP(NT1, cur.A1, cur.B1, nA, nB)
        if constexpr (ALIGN_EPI) { if (wr == 0) PG8_BAR; }
        E.fin(acc, cur, wr, wc, fr, fq);
        if (!has_next) break;
#pragma unroll
        for (int a = 0; a < 2; ++a)
#pragma unroll
            for (int b = 0; b < 2; ++b)
#pragma unroll
                for (int m = 0; m < 4; ++m)
#pragma unroll
                    for (int n = 0; n < 2; ++n) acc[a][b][m][n] = (f32x4){0.f, 0.f, 0.f, 0.f};
        cur = nxt; ++ui;
        if constexpr (ALIGN_EPI) { if (wr == 1) PG8_BAR; }
    }
    PG8_WAIT_V(0);
    if constexpr (!ALIGN_EPI) { if (wr == 0) PG8_BAR; }
    PG8_BAR;
#undef PG8_KLOOP
#undef PG8_SA
#undef PG8_SB
#undef PG8_STAGE
#undef PG8_LDA
#undef PG8_LDB
#undef PG8_MMA
#undef PG8_WAIT_V
#undef PG8_WAIT_L
#undef PG8_BAR
#undef PG8_SCHED
}
struct BrSched {
    const char* A0; const char* B0; const char* A1; const char* B1; StaticOrder so;
    __device__ __forceinline__ bool next(int i, Unit2& u) const {
        int pm, pn; if (!so.next(i, pm, pn)) return false;
        u.pm = pm; u.pn = pn; u.A0 = A0 + (size_t)pm * BM * 512 * 2; u.B0 = B0 + (size_t)pn * BM * 512 * 2; u.A1 = A1 + (size_t)pm * BM * 512 * 2; u.B1 = B1 + (size_t)pn * BM * 512 * 2; return true;
    }
};
struct EpiBr {
    const bf16_t* COLS; bf16_t* MG;
    __device__ __forceinline__ void mid(f32x4 (&acc)[2][2][4][2], const Unit2& u, int wr, int wc, int fr, int fq) const {
#pragma unroll
        for (int ai = 0; ai < 2; ++ai)
#pragma unroll
            for (int m = 0; m < 4; ++m) { const size_t t = (size_t)u.pm * BM + ai * HALF + wr * 64 + m * 16 + fr;
#pragma unroll
                for (int bj = 0; bj < 2; ++bj) { const int col = u.pn * BM + bj * HALF + wc * 32 + 8 * fq; float ga[8], gb[8];
                    unpack8(*(const u32x4*)(COLS + t * INC + C_GA + col), ga); unpack8(*(const u32x4*)(COLS + t * INC + C_GB + col), gb);
#pragma unroll
                    for (int n = 0; n < 2; ++n)
#pragma unroll
                        for (int k = 0; k < 4; ++k) { const float rt_ = sigmoidf_(ga[4 * n + k]) * (1.0f + __expf(-gb[4 * n + k]));
                            asm volatile("v_mul_f32 %0, %0, %1" : "+v"(acc[ai][bj][m][n][k]) : "v"(rt_)); } }
                asm volatile("" ::: "memory"); }
    }
    __device__ __forceinline__ void fin(const f32x4 (&acc)[2][2][4][2], const Unit2& u, int wr, int wc, int fr, int fq) const {
#pragma unroll
        for (int ai = 0; ai < 2; ++ai)
#pragma unroll
            for (int m = 0; m < 4; ++m) { const size_t t = (size_t)u.pm * BM + ai * HALF + wr * 64 + m * 16 + fr;
#pragma unroll
                for (int bj = 0; bj < 2; ++bj) { const int col = u.pn * BM + bj * HALF + wc * 32 + 8 * fq; float gb[8], o[8];
                    unpack8(*(const u32x4*)(COLS + t * INC + C_GB + col), gb);
#pragma unroll
                    for (int n = 0; n < 2; ++n)
#pragma unroll
                        for (int k = 0; k < 4; ++k) o[4 * n + k] = acc[ai][bj][m][n][k] * sigmoidf_(gb[4 * n + k]);
                    *(u32x4*)(MG + t * DM + col) = pack8(o); }
                asm volatile("" ::: "memory"); }
    }
};
}
using pg8::Unit;

struct F_Cols { bf16_t* C; int ldc; bf16_t* UG;
    __device__ __forceinline__ void operator()(const Unit& u, int r, int c, float (&v)[8]) const {
        const u32x4 w = pack8(v); const int t = u.pm * 256 + r;
        *(u32x4*)(C + (size_t)t * ldc + u.pn * 256 + c) = w;
        if (u.pn == 7) { const int g = c >> 4, c0 = c & 15, b = t >> 11, s = t & (SEQ - 1), ch = s >> 5, j = s & 31;
            *(u32x4*)(UG + ((size_t)g * S5ROWS + b * S5NCH + ch) * S5K + j * 16 + c0) = w; } } };
struct F_Lora { bf16_t* O; const float* w0; const float* a0;
    __device__ __forceinline__ void operator()(const Unit& u, int r, int c, float (&v)[8]) const {
        const int gc = u.pn * 256 + c; const int ty = u.pn >> 1;
        if (ty == 0) {
#pragma unroll
            for (int i = 0; i < 8; ++i) v[i] = 0.6065306597126334f * sigmoidf_(v[i] + w0[gc + i]);
        } else if (ty == 1) {
#pragma unroll
            for (int i = 0; i < 8; ++i) v[i] = sigmoidf_(v[i] + a0[gc - 512 + i]);
        }
        *(u32x4*)(O + (size_t)(u.pm * 256 + r) * 1536 + gc) = pack8(v); } };
struct F_S5a { float* E;
    __device__ __forceinline__ void operator()(const Unit& u, int r, int c, float (&v)[8]) const {
        if (c < 128) { float* p = E + ((size_t)u.aux * S5ROWS + u.pm * 256 + r) * 128 + c;
            *(f32x4*)p = (f32x4){v[0], v[1], v[2], v[3]}; *(f32x4*)(p + 4) = (f32x4){v[4], v[5], v[6], v[7]}; } } };
struct F_S5c { const bf16_t* COLS; const float* Dsk; bf16_t* Z;
    __device__ __forceinline__ void operator()(const Unit& u, int r, int c, float (&v)[8]) const {
        const int row = u.pm * 256 + r, col = u.pn * 256 + c; const int b = row >> 6, ch = row & 63, j = col >> 4, c0 = col & 15;
        const int t = b * SEQ + ch * S5L + j, chan = u.aux * 16 + c0;
        float uu[8]; unpack8(*(const u32x4*)(COLS + (size_t)t * INC + C_U + chan), uu);
#pragma unroll
        for (int i = 0; i < 8; ++i) v[i] = gelu_tanh(v[i] + Dsk[chan + i] * uu[i]);
        *(u32x4*)(Z + (size_t)t * 256 + chan) = pack8(v); } };
struct F_Glu { const bf16_t* Z; const float* gb; bf16_t* O;
    __device__ __forceinline__ void operator()(const Unit& u, int r, int c, float (&v)[8]) const {
        const size_t t = (size_t)u.pm * 256 + r; float z[8]; unpack8(*(const u32x4*)(Z + t * 256 + c), z);
#pragma unroll
        for (int i = 0; i < 8; ++i) v[i] = z[i] * sigmoidf_(v[i] + gb[c + i]);
        *(u32x4*)(O + t * 512 + c) = pack8(v); } };
struct F_BrA { const bf16_t* COLS; float* PART;
    __device__ __forceinline__ void operator()(const Unit& u, int r, int c, float (&v)[8]) const {
        const size_t t = (size_t)u.pm * 256 + r; const int col = u.pn * 256 + c; float g[8]; unpack8(*(const u32x4*)(COLS + t * INC + C_GA + col), g);
#pragma unroll
        for (int i = 0; i < 8; ++i) v[i] *= sigmoidf_(g[i]);
        float* p = PART + t * DM + col; *(f32x4*)p = (f32x4){v[0], v[1], v[2], v[3]}; *(f32x4*)(p + 4) = (f32x4){v[4], v[5], v[6], v[7]}; } };
struct F_BrB { const bf16_t* COLS; const float* PART; bf16_t* MG;
    __device__ __forceinline__ void operator()(const Unit& u, int r, int c, float (&v)[8]) const {
        const size_t t = (size_t)u.pm * 256 + r; const int col = u.pn * 256 + c; float g[8]; unpack8(*(const u32x4*)(COLS + t * INC + C_GB + col), g);
        const float* p = PART + t * DM + col; const f32x4 p0 = *(const f32x4*)p, p1 = *(const f32x4*)(p + 4);
        const float pp[8] = {p0[0], p0[1], p0[2], p0[3], p1[0], p1[1], p1[2], p1[3]};
#pragma unroll
        for (int i = 0; i < 8; ++i) v[i] = pp[i] + v[i] * sigmoidf_(g[i]);
        *(u32x4*)(MG + t * DM + col) = pack8(v); } };
struct F_Res { const float* X; float* O;
    __device__ __forceinline__ void operator()(const Unit& u, int r, int c, float (&v)[8]) const {
        const size_t o = ((size_t)u.pm * 256 + r) * DM + u.pn * 256 + c; const f32x4 x0 = *(const f32x4*)(X + o), x1 = *(const f32x4*)(X + o + 4);
        *(f32x4*)(O + o) = (f32x4){x0[0] + v[0], x0[1] + v[1], x0[2] + v[2], x0[3] + v[3]}; *(f32x4*)(O + o + 4) = (f32x4){x1[0] + v[4], x1[1] + v[5], x1[2] + v[6], x1[3] + v[7]}; } };
struct F_MoeDown { const float* ROWW; bf16_t* YM;
    __device__ __forceinline__ void operator()(const Unit& u, int r, int c, float (&v)[8]) const {
        const size_t row = (size_t)u.pm * 256 + r; const float w = ROWW[row];
#pragma unroll
        for (int i = 0; i < 8; ++i) v[i] *= w;
        *(u32x4*)(YM + row * DM + u.pn * 256 + c) = pack8(v); } };
struct F_PleG { bf16_t* G;
    __device__ __forceinline__ void operator()(const Unit& u, int r, int c, float (&v)[8]) const {
#pragma unroll
        for (int i = 0; i < 8; ++i) v[i] = sigmoidf_(v[i]);
        *(u32x4*)(G + ((size_t)u.pm * 256 + r) * DM + u.pn * 256 + c) = pack8(v); } };
struct F_PleP { const bf16_t* G; const float* X; float* XO;
    __device__ __forceinline__ void operator()(const Unit& u, int r, int c, float (&v)[8]) const {
        const size_t o = ((size_t)u.pm * 256 + r) * DM + u.pn * 256 + c; float g[8]; unpack8(*(const u32x4*)(G + o), g);
        const f32x4 x0 = *(const f32x4*)(X + o), x1 = *(const f32x4*)(X + o + 4);
#ifdef EXP_NOG
        for (int i = 0; i < 8; ++i) g[i] = 0.5f;
#endif
#ifdef EXP_NOACC
        for (int i = 0; i < 8; ++i) v[i] = 1.0f;
#endif
        *(f32x4*)(XO + o) = (f32x4){x0[0] + g[0] * v[0], x0[1] + g[1] * v[1], x0[2] + g[2] * v[2], x0[3] + g[3] * v[3]};
        *(f32x4*)(XO + o + 4) = (f32x4){x1[0] + g[4] * v[4], x1[1] + g[5] * v[5], x1[2] + g[6] * v[6], x1[3] + g[7] * v[7]}; } };

enum { I_X = 0, I_P, I_MIXN, I_WIN, I_MU, I_W0, I_WUP, I_A0, I_AUP, I_GUP, I_KK, I_KA, I_RK, I_LNG, I_LNB, I_LRE, I_LIM, I_LDT, I_BRE, I_BIM, I_CRE, I_CIM, I_SD, I_GLUW, I_GLUB,
       I_WBA, I_WBB, I_WOUT, I_FFNN, I_RGW, I_RGB, I_REW, I_REB, I_EG, I_EU, I_ED, I_PLEN, I_PLEG, I_PLEP, I_FINN };

__device__ __forceinline__ void transpose_item(const float* __restrict__ W, int ldw, const float* __restrict__ kscale, int k0, int n0, bf16_t* WT, int ldt, int dst_row0, int dst_k0, LAS float* scr, int lane) {
#pragma unroll 2
    for (int i = 0; i < 32; ++i) { const int kk = 2 * i + (lane >> 5); float v = W[(size_t)(k0 + kk) * ldw + n0 + (lane & 31)]; if (kscale) v *= kscale[k0 + kk]; scr[kk * 33 + (lane & 31)] = v; }
    LDS_WAIT();
    const int c = lane & 7;
#pragma unroll
    for (int j = 0; j < 4; ++j) { const int n = (lane >> 3) + 8 * j; const LAS float* s = scr + (8 * c) * 33 + n;
        u32x4 o; o.x = pk2(s[0 * 33], s[1 * 33]); o.y = pk2(s[2 * 33], s[3 * 33]); o.z = pk2(s[4 * 33], s[5 * 33]); o.w = pk2(s[6 * 33], s[7 * 33]);
        *(u32x4*)(WT + (size_t)(dst_row0 + n) * ldt + dst_k0 + 8 * c) = o; }
    LDS_WAIT();
}

constexpr int N_WBA = 8 * 32, N_WBB = 4 * 32, N_WOUT = 16 * 32, N_WPG = 16 * 32, N_WPP = 4 * 32, N_GLU = 4 * 8, N_EG = 32 * 128, N_EU = 32 * 128, N_ED = 32 * 128;
constexpr int N_LATE = N_WBA + N_WBB + N_WOUT + N_WPG + N_WPP + N_GLU + N_EG + N_EU + N_ED;
struct TrDesc { const float* W; const float* ks; bf16_t* WT; int ldw, k0, n0, ldt, row0; };
__device__ __forceinline__ TrDesc late_desc(const Args& a, int r) {
    unsigned char* ws = a.ws; TrDesc d; d.ks = nullptr;
    if (r < N_WBA) { d.W = a.in[I_WBA]; d.ldw = 1024; d.k0 = 64 * (r / 32); d.n0 = 32 * (r % 32); d.WT = (bf16_t*)(ws + WS_WBA); d.ldt = 512; d.row0 = d.n0; return d; } r -= N_WBA;
    if (r < N_WBB) { d.W = a.in[I_WBB]; d.ldw = 1024; d.k0 = 64 * (r / 32); d.n0 = 32 * (r % 32); d.WT = (bf16_t*)(ws + WS_WBB); d.ldt = 512; d.row0 = d.n0; return d; } r -= N_WBB;
    if (r < N_WOUT) { d.W = a.in[I_WOUT]; d.ldw = 1024; d.k0 = 64 * (r / 32); d.n0 = 32 * (r % 32); d.WT = (bf16_t*)(ws + WS_WOUT); d.ldt = 1024; d.row0 = d.n0; return d; } r -= N_WOUT;
    if (r < N_WPG) { d.W = a.in[I_PLEG]; d.ks = a.in[I_PLEN]; d.ldw = 1024; d.k0 = 64 * (r / 32); d.n0 = 32 * (r % 32); d.WT = (bf16_t*)(ws + WS_WPG); d.ldt = 1024; d.row0 = d.n0; return d; } r -= N_WPG;
    if (r < N_WPP) { d.W = a.in[I_PLEP]; d.ldw = 1024; d.k0 = 64 * (r / 32); d.n0 = 32 * (r % 32); d.WT = (bf16_t*)(ws + WS_WPP); d.ldt = 256; d.row0 = d.n0; return d; } r -= N_WPP;
    if (r < N_GLU) { d.W = a.in[I_GLUW]; d.ldw = 256; d.k0 = 64 * (r / 8); d.n0 = 32 * (r % 8); d.WT = (bf16_t*)(ws + WS_WGLU); d.ldt = 256; d.row0 = d.n0; return d; } r -= N_GLU;
    if (r < N_EG + N_EU) { const int up = r >= N_EG ? 1 : 0; if (up) r -= N_EG; const int e = r / 128, q = r % 128; d.k0 = 64 * (q / 8); d.n0 = 32 * (q % 8);
        d.W = a.in[up ? I_EU : I_EG] + (size_t)e * 1024 * 256; d.ks = a.in[I_FFNN]; d.ldw = 256; d.WT = (bf16_t*)(ws + WS_WGU); d.ldt = 1024; d.row0 = e * 512 + (d.n0 / 128) * 256 + up * 128 + (d.n0 % 128); return d; } r -= N_EG + N_EU;
    { const int e = r / 128, q = r % 128; d.k0 = 64 * (q / 32); d.n0 = 32 * (q % 32); d.W = a.in[I_ED] + (size_t)e * 256 * 1024; d.ldw = 1024; d.WT = (bf16_t*)(ws + WS_WD) + (size_t)e * 1024 * 256; d.ldt = 256; d.row0 = d.n0; return d; }
}
__device__ __forceinline__ void tr_load(const TrDesc& d, float (&tv)[32], int lane) {
#pragma unroll
    for (int i = 0; i < 32; ++i) tv[i] = d.W[(size_t)(d.k0 + 2 * i + (lane >> 5)) * d.ldw + d.n0 + (lane & 31)];
}
__device__ __forceinline__ void tr_store(const TrDesc& d, const float (&tv)[32], LAS float* scr, int lane) {
#pragma unroll
    for (int i = 0; i < 32; ++i) scr[(2 * i + (lane >> 5)) * 33 + (lane & 31)] = tv[i];
    LDS_WAIT();
    const int c = lane & 7; float sc[8];
#pragma unroll
    for (int i = 0; i < 8; ++i) sc[i] = d.ks ? d.ks[d.k0 + 8 * c + i] : 1.0f;
#pragma unroll
    for (int j = 0; j < 4; ++j) { const int n = (lane >> 3) + 8 * j; const LAS float* s = scr + (8 * c) * 33 + n;
        u32x4 o; o.x = pk2(s[0 * 33] * sc[0], s[1 * 33] * sc[1]); o.y = pk2(s[2 * 33] * sc[2], s[3 * 33] * sc[3]); o.z = pk2(s[4 * 33] * sc[4], s[5 * 33] * sc[5]); o.w = pk2(s[6 * 33] * sc[6], s[7 * 33] * sc[7]);
        *(u32x4*)(d.WT + (size_t)(d.row0 + n) * d.ldt + d.k0 + 8 * c) = o; }
    LDS_WAIT();
}
__device__ __forceinline__ void dsincos_reduced(double x, double& s, double& c) {
    const double x2 = x * x;
    double ps = -1.0 / 1.307674368e12  ; ps = ps * x2 + 1.0 / 6227020800.0; ps = ps * x2 - 1.0 / 39916800.0; ps = ps * x2 + 1.0 / 362880.0; ps = ps * x2 - 1.0 / 5040.0; ps = ps * x2 + 1.0 / 120.0; ps = ps * x2 - 1.0 / 6.0;
    double hs = -1.0 / 1.21645100408832e17  ; hs = hs * x2 + 1.0 / 3.55687428096e14  ; ps = ((hs * x2) * x2 * x2 * x2 * x2 * x2 * x2) + ps;
    s = x + x * x2 * ps;
    double pc = 1.0 / 2.0922789888e13  ; pc = pc * x2 - 1.0 / 87178291200.0; pc = pc * x2 + 1.0 / 479001600.0; pc = pc * x2 - 1.0 / 3628800.0; pc = pc * x2 + 1.0 / 40320.0; pc = pc * x2 - 1.0 / 720.0; pc = pc * x2 + 1.0 / 24.0; pc = pc * x2 - 0.5;
    double hc = 1.0 / 2.43290200817664e18  ; hc = hc * x2 - 1.0 / 6.402373705728e15  ; pc = ((hc * x2) * x2 * x2 * x2 * x2 * x2 * x2 * x2) + pc;
    c = 1.0 + x2 * pc;
}
__device__ __forceinline__ double dexp_(double x) {
    const double ln2 = 0.6931471805599453094; const double kf = __builtin_rint(x * 1.4426950408889634074); const double r = x - kf * ln2;
    double t = 1.0 / 6227020800.0; t = t * r + 1.0 / 479001600.0; t = t * r + 1.0 / 39916800.0; t = t * r + 1.0 / 3628800.0; t = t * r + 1.0 / 362880.0; t = t * r + 1.0 / 40320.0; t = t * r + 1.0 / 5040.0;
    t = t * r + 1.0 / 720.0; t = t * r + 1.0 / 120.0; t = t * r + 1.0 / 24.0; t = t * r + 1.0 / 6.0; t = t * r + 0.5; t = t * r + 1.0; t = t * r + 1.0;
    const int ki = (int)kf; const long long bits = (long long)(1023 + ki) << 52;
    return t * __builtin_bit_cast(double, bits);
}

__device__ __forceinline__ void phase0(const Args& a, LAS unsigned char* lds) {
    const int tid = threadIdx.x, lane = tid & 63, wave = tid >> 6, G = gridDim.x;
    const int gw = blockIdx.x * 8 + wave, NGW = G * 8;
    unsigned char* ws = a.ws;
    LAS float* scr = (LAS float*)(lds + wave * 16384);
    float tv[32]; TrDesc td; const bool has_tr = gw < 16 * 128;
    { const int it = has_tr ? gw : 0; td.W = a.in[I_WIN]; td.ks = a.in[I_MIXN]; td.WT = (bf16_t*)(ws + WS_WIN); td.ldw = INC; td.k0 = 64 * (it / 128); td.n0 = 32 * (it % 128); td.ldt = 1024; td.row0 = td.n0; }
    if (has_tr) tr_load(td, tv, lane);
    const int gt = blockIdx.x * 512 + tid;
    float sv[8]; f32x4 sg0 = (f32x4){1.f, 1.f, 1.f, 1.f}, sg1 = sg0;
#pragma unroll
    for (int i = 0; i < 8; ++i) sv[i] = 0.f;
    if (gt < 1536 * 32) { const int n = gt >> 5, k0 = (gt & 31) * 8; const float* bp = nullptr;
        if (n < 512) { if (k0 < 64) bp = a.in[I_WUP] + k0 * 512 + n; }
        else if (n < 1024) { if (k0 >= 64 && k0 < 128) bp = a.in[I_AUP] + (k0 - 64) * 512 + (n - 512); }
        else { if (k0 >= 128) bp = a.in[I_GUP] + (k0 - 128) * 512 + (n - 1024); }
        if (bp) {
#pragma unroll
            for (int i = 0; i < 8; ++i) sv[i] = bp[i * 512]; }
    } else if (gt < 1536 * 32 + 48 * 128) { const int cc = gt - 1536 * 32, j = cc >> 7, k0 = (cc & 127) * 8;
        if (j < 36) { const float* bp = (j < 4) ? (a.in[I_RGW] + k0 * 4 + j) : (a.in[I_REW] + k0 * 32 + (j - 4)); const int st = (j < 4) ? 4 : 32;
#pragma unroll
            for (int i = 0; i < 8; ++i) sv[i] = bp[i * st];
            sg0 = *(const f32x4*)(a.in[I_FFNN] + k0); sg1 = *(const f32x4*)(a.in[I_FFNN] + k0 + 4); }
    }
    {
        bf16_t* HN = (bf16_t*)a.out;
        for (int m0 = gw; m0 < T; m0 += 2 * NGW) {
            f32x4 v[2][4]; float s[2] = {0.f, 0.f};
#pragma unroll
            for (int u = 0; u < 2; ++u) { const f32x4* xr = (const f32x4*)(a.in[I_X] + (size_t)(m0 + u * NGW) * DM) + lane;
#pragma unroll
                for (int j = 0; j < 4; ++j) v[u][j] = xr[64 * j]; }
#pragma unroll
            for (int u = 0; u < 2; ++u) {
#pragma unroll
                for (int j = 0; j < 4; ++j) s[u] += (v[u][j][0] * v[u][j][0] + v[u][j][1] * v[u][j][1]) + (v[u][j][2] * v[u][j][2] + v[u][j][3] * v[u][j][3]);
                const float rs = 1.0f / sqrtf(wave_sum(s[u]) * (1.0f / DM) + 1e-6f);
                u32x2* o = (u32x2*)(HN + (size_t)(m0 + u * NGW) * DM) + lane;
#pragma unroll
                for (int j = 0; j < 4; ++j) { u32x2 w; w.x = pk2(v[u][j][0] * rs, v[u][j][1] * rs); w.y = pk2(v[u][j][2] * rs, v[u][j][3] * rs); o[64 * j] = w; }
            }
        }
    }
    if (has_tr) tr_store(td, tv, scr, lane);
    for (int it = gw + NGW; it < 16 * 128; it += NGW)
        transpose_item(a.in[I_WIN], INC, a.in[I_MIXN], 64 * (it / 128), 32 * (it % 128), (bf16_t*)(ws + WS_WIN), 1024, 32 * (it % 128), 64 * (it / 128), scr, lane);
    if (gt < 1536 * 32 + 48 * 128) {
        u32x4 o; o.x = pk2(sv[0] * sg0[0], sv[1] * sg0[1]); o.y = pk2(sv[2] * sg0[2], sv[3] * sg0[3]); o.z = pk2(sv[4] * sg1[0], sv[5] * sg1[1]); o.w = pk2(sv[6] * sg1[2], sv[7] * sg1[3]);
        if (gt < 1536 * 32) *(u32x4*)((bf16_t*)(ws + WS_WLORA) + (size_t)(gt >> 5) * 256 + (gt & 31) * 8) = o;
        else { const int cc = gt - 1536 * 32; *(u32x4*)((bf16_t*)(ws + WS_WR) + (size_t)(cc >> 7) * 1024 + (cc & 127) * 8) = o; }
    }
    for (int c = gt + G * 512; c < 1536 * 32 + 48 * 128; c += G * 512) {
        float v[8];
        if (c < 1536 * 32) { const int n = c >> 5, k0 = (c & 31) * 8;
#pragma unroll
            for (int i = 0; i < 8; ++i) { const int k = k0 + i; float x = 0.f;
                if (n < 512) { if (k < 64) x = a.in[I_WUP][k * 512 + n]; }
                else if (n < 1024) { if (k >= 64 && k < 128) x = a.in[I_AUP][(k - 64) * 512 + (n - 512)]; }
                else { if (k >= 128) x = a.in[I_GUP][(k - 128) * 512 + (n - 1024)]; }
                v[i] = x; }
            u32x4 o; o.x = pk2(v[0], v[1]); o.y = pk2(v[2], v[3]); o.z = pk2(v[4], v[5]); o.w = pk2(v[6], v[7]); *(u32x4*)((bf16_t*)(ws + WS_WLORA) + (size_t)n * 256 + k0) = o;
        } else { const int cc = c - 1536 * 32, j = cc >> 7, k0 = (cc & 127) * 8;
#pragma unroll
            for (int i = 0; i < 8; ++i) { const int k = k0 + i; float x = 0.f;
                if (j < 4) x = a.in[I_RGW][k * 4 + j] * a.in[I_FFNN][k]; else if (j < 36) x = a.in[I_REW][k * 32 + (j - 4)] * a.in[I_FFNN][k];
                v[i] = x; }
            u32x4 o; o.x = pk2(v[0], v[1]); o.y = pk2(v[2], v[3]); o.z = pk2(v[4], v[5]); o.w = pk2(v[6], v[7]); *(u32x4*)((bf16_t*)(ws + WS_WR) + (size_t)j * 1024 + k0) = o; }
    }
    for (int vb = blockIdx.x; vb < 256; vb += G) {
        __syncthreads();
        const int g = vb & 15, part = vb >> 4;
        LAS float* Pre = (LAS float*)lds;
        LAS float* Pim = Pre + 33 * 64;
        LAS float* Bre = Pim + 33 * 64;
        LAS float* Bim = Bre + 64 * 16;
        LAS float* Cre = Bim + 64 * 16;
        LAS float* Cim = Cre + 16 * 64;
        if (tid < 64) {
            const int n = tid; const double lr = (double)a.in[I_LRE][g * 64 + n], li = (double)a.in[I_LIM][g * 64 + n];
            const double dt = dexp_((double)a.in[I_LDT][g]);
            const double mag = dexp_(lr * dt); double ang = li * dt; const double twopi = 6.283185307179586477; ang -= __builtin_rint(ang * 0.15915494309189533577) * twopi;
            double sn, cs; dsincos_reduced(ang, sn, cs);
            const double lre = mag * cs, lim = mag * sn;
            const double nr = lre - 1.0, ni = lim, den = lr * lr + li * li; const double rden = 1.0 / den;
            const double cfr = (nr * lr + ni * li) * rden, cfi = (ni * lr - nr * li) * rden;
            for (int c = 0; c < 16; ++c) { const double br = (double)a.in[I_BRE][(g * 64 + n) * 16 + c], bi = (double)a.in[I_BIM][(g * 64 + n) * 16 + c];
                Bre[n * 16 + c] = (float)(cfr * br - cfi * bi); Bim[n * 16 + c] = (float)(cfr * bi + cfi * br); }
            double pr = 1.0, pi = 0.0;
            for (int tau = 0; tau <= 32; ++tau) { Pre[tau * 64 + n] = (float)pr; Pim[tau * 64 + n] = (float)pi; const double t2 = pr * lre - pi * lim; pi = pr * lim + pi * lre; pr = t2; }
            if (part == 0) ((f32x2*)(ws + WS_LAML))[g * 64 + n] = (f32x2){Pre[32 * 64 + n], Pim[32 * 64 + n]};
        }
        for (int i = tid; i < 1024; i += 512) { Cre[i] = a.in[I_CRE][g * 1024 + i]; Cim[i] = a.in[I_CIM][g * 1024 + i]; }
        __syncthreads();
        float* KG = (float*)(ws + WS_KG) + (size_t)g * 32 * 256;
        { const int e = part * 512 + tid; const int tau = e >> 8, co = (e >> 4) & 15, ci = e & 15; float s = 0.f;
            for (int n = 0; n < 64; ++n) { const float pr = Pre[tau * 64 + n], pi = Pim[tau * 64 + n], br = Bre[n * 16 + ci], bi = Bim[n * 16 + ci];
                const float qr = pr * br - pi * bi, qi = pr * bi + pi * br; s += Cre[co * 64 + n] * qr - Cim[co * 64 + n] * qi; }
            KG[e] = s; }
        bf16_t* TZ = (bf16_t*)(ws + WS_TZ) + (size_t)g * S5N * S5K;
        { const int e = part * 512 + tid; const int row = e >> 4, m0 = (e & 15) * 8, j = row >> 4, co = row & 15; float v[8];
#pragma unroll
            for (int i = 0; i < 8; ++i) { const int m = m0 + i, n = m & 63; const float pr = Pre[(j + 1) * 64 + n], pi = Pim[(j + 1) * 64 + n], cr = Cre[co * 64 + n], ci = Cim[co * 64 + n];
                v[i] = (m < 64) ? (cr * pr - ci * pi) : -(cr * pi + ci * pr); }
            u32x4 o; o.x = pk2(v[0], v[1]); o.y = pk2(v[2], v[3]); o.z = pk2(v[4], v[5]); o.w = pk2(v[6], v[7]); *(u32x4*)(TZ + (size_t)row * S5K + 512 + m0) = o; }
        bf16_t* W1 = (bf16_t*)(ws + WS_W1) + (size_t)g * 256 * 512;
        for (int e = part * 1024 + tid; e < part * 1024 + 1024; e += 512) { const int m = e >> 6, s = (e & 63) >> 1, ci0 = (e & 1) * 8; float v[8];
#pragma unroll
            for (int i = 0; i < 8; ++i) { float x = 0.f;
                if (m < 128) { const int n = m & 63; const float pr = Pre[(31 - s) * 64 + n], pi = Pim[(31 - s) * 64 + n], br = Bre[n * 16 + ci0 + i], bi = Bim[n * 16 + ci0 + i];
                    x = (m < 64) ? (pr * br - pi * bi) : (pr * bi + pi * br); }
                v[i] = x; }
            u32x4 o; o.x = pk2(v[0], v[1]); o.y = pk2(v[2], v[3]); o.z = pk2(v[4], v[5]); o.w = pk2(v[6], v[7]); *(u32x4*)(W1 + (size_t)m * 512 + s * 16 + ci0) = o; }
    }
    __syncthreads();
}

__device__ __forceinline__ void phase2(const Args& a) {
    const int gt = blockIdx.x * 512 + threadIdx.x, NT = gridDim.x * 512;
    unsigned char* ws = a.ws;
    const bf16_t* COLS = (const bf16_t*)(ws + WS_A); bf16_t* LIN = (bf16_t*)(ws + WS_Z);
    const float* mu = a.in[I_MU];
    for (int p = gt; p < T * 32; p += NT) {
        const int t = p >> 5, q = p & 31;
        {
            const int c8 = q * 8, src = C_WD + c8; float cur[8], prv[8], o[8];
            unpack8(*(const u32x4*)(COLS + (size_t)t * INC + src), cur);
            if ((t & (SEQ - 1)) != 0) unpack8(*(const u32x4*)(COLS + (size_t)(t - 1) * INC + src), prv);
            else {
#pragma unroll
                for (int i = 0; i < 8; ++i) prv[i] = 0.f; }
#pragma unroll
            for (int i = 0; i < 8; ++i) { const float xs = cur[i] + (prv[i] - cur[i]) * mu[src + i]; o[i] = (c8 < 64) ? tanhf_(xs) : ((c8 < 128) ? xs : sigmoidf_(xs)); }
            *(u32x4*)(LIN + (size_t)t * 256 + c8) = pack8(o);
        }
    }
    const float* KG = (const float*)(ws + WS_KG); bf16_t* TZ = (bf16_t*)(ws + WS_TZ);
    for (int p = gt; p < 16 * 512 * 64; p += NT) {
        const int g = p >> 15, row = (p >> 6) & 511, kc = p & 63, j = row >> 4, co = row & 15, s = kc >> 1, ci0 = (kc & 1) * 8;
        u32x4 o = (u32x4){0u, 0u, 0u, 0u};
        if (s <= j) { const float* k = KG + (((size_t)g * 32 + (j - s)) * 16 + co) * 16 + ci0; const f32x4 k0 = *(const f32x4*)k, k1 = *(const f32x4*)(k + 4);
            o.x = pk2(k0[0], k0[1]); o.y = pk2(k0[2], k0[3]); o.z = pk2(k1[0], k1[1]); o.w = pk2(k1[2], k1[3]); }
        *(u32x4*)(TZ + ((size_t)g * S5N + row) * S5K + kc * 8) = o;
    }
}

__device__ __forceinline__ void phase4(const Args& a, LAS unsigned char* lds) {
    const int tid = threadIdx.x, lane = tid & 63, wave = tid >> 6;
    unsigned char* ws = a.ws;
    TSTART(4); TSTART(1);
    for (int item = blockIdx.x; item < 256; item += gridDim.x) {
        if (tid < 64) {
            const int b = item >> 4, g = item & 15, n = tid;
            const f32x2 lamL = ((const f32x2*)(ws + WS_LAML))[g * 64 + n];
            const float* E = (const float*)(ws + WS_E) + ((size_t)g * S5ROWS + b * S5NCH) * 128;
            bf16_t* UG = (bf16_t*)(ws + WS_UG) + ((size_t)g * S5ROWS + b * S5NCH) * S5K + 512;
            float xr = 0.f, xi = 0.f;
#pragma unroll 2
            for (int ch = 0; ch < S5NCH; ++ch) {
                UG[(size_t)ch * S5K + n] = (bf16_t)f2bf(xr); UG[(size_t)ch * S5K + 64 + n] = (bf16_t)f2bf(xi);
                const float er = E[ch * 128 + n], ei = E[ch * 128 + 64 + n];
                const float nr = lamL[0] * xr - lamL[1] * xi + er, ni = lamL[0] * xi + lamL[1] * xr + ei; xr = nr; xi = ni;
            }
        }
    }
    TSTOP(1);
    const bf16_t* COLS = (const bf16_t*)(ws + WS_A); const bf16_t* LORA = (const bf16_t*)a.out;
    float* Y = (float*)(ws + WS_B); float* BON = (float*)(ws + WS_BON);
    LAS float* VECF = (LAS float*)lds;
    LAS float* VKP = (LAS float*)(lds + 81920);
    LAS float* BETA = (LAS float*)(lds + 98304);
    LAS float* YST = (LAS float*)(lds + 98816);
    for (int item = blockIdx.x; item < 256; item += gridDim.x) {
        const int bh = item >> 1, half = item & 1, b = bh >> 3, h = bh & 7;
        const int pj = tid >> 4, pq = tid & 15, hc = h * 64 + 4 * pq;
        float mur[4], muk[4], muv[4], kk4[4], ka4[4], rk4[4];
#pragma unroll
        for (int i = 0; i < 4; ++i) { mur[i] = a.in[I_MU][C_R + hc + i]; muk[i] = a.in[I_MU][C_K + hc + i]; muv[i] = a.in[I_MU][C_V + hc + i];
            kk4[i] = a.in[I_KK][hc + i]; ka4[i] = a.in[I_KA][hc + i]; rk4[i] = a.in[I_RK][hc + i]; }
        const int rr = lane >> 4, cl = lane & 15;
        const bool vmine = (pq >> 3) == half;
        const int qv = pq & 7;
        u32x2 rc, rp, kc, kp, kn, vc, vp, e4, a4;
        const u32x2 zero2 = (u32x2){0u, 0u};
        __syncthreads();
#define WKV_LOAD(chunk) do { const int s_ = (chunk) * 32 + pj; const size_t t_ = (size_t)b * SEQ + s_; const bf16_t* cb_ = COLS + t_ * INC + hc; \
            rc = *(const u32x2*)(cb_ + C_R); kc = *(const u32x2*)(cb_ + C_K); vc = *(const u32x2*)(cb_ + C_V); \
            if (s_ > 0) { rp = *(const u32x2*)(cb_ - INC + C_R); kp = *(const u32x2*)(cb_ - INC + C_K); vp = *(const u32x2*)(cb_ - INC + C_V); } else { rp = zero2; kp = zero2; vp = zero2; } \
            if (s_ < SEQ - 1) kn = *(const u32x2*)(cb_ + INC + C_K); else kn = zero2; \
            e4 = *(const u32x2*)(LORA + t_ * 1536 + hc); a4 = *(const u32x2*)(LORA + t_ * 1536 + 512 + hc); } while (0)
#define WKV_PREP(chunk, bi) do { float r_[4], rq_[4], k_[4], kq_[4], kx_[4], v_[4], vq_[4], e_[4], aa_[4]; unpack4(rc, r_); unpack4(rp, rq_); unpack4(kc, k_); unpack4(kp, kq_); unpack4(kn, kx_); unpack4(vc, v_); unpack4(vp, vq_); unpack4(e4, e_); unpack4(a4, aa_); \
            float kkv_[4], kkn_[4], k2_[4], ss_ = 0.f, ssn_ = 0.f; \
            _Pragma("unroll") for (int i = 0; i < 4; ++i) { r_[i] += (rq_[i] - r_[i]) * mur[i]; kx_[i] += (k_[i] - kx_[i]) * muk[i]; k_[i] += (kq_[i] - k_[i]) * muk[i]; v_[i] += (vq_[i] - v_[i]) * muv[i]; \
                kkv_[i] = k_[i] * kk4[i]; ss_ += kkv_[i] * kkv_[i]; kkn_[i] = kx_[i] * kk4[i]; ssn_ += kkn_[i] * kkn_[i]; k2_[i] = k_[i] * (1.0f + (aa_[i] - 1.0f) * ka4[i]); } \
            ss_ = row16_sum(ss_); ssn_ = row16_sum(ssn_); \
            const float inv_ = __builtin_amdgcn_rsqf(fmaxf(ss_, 1e-24f)), invn_ = __builtin_amdgcn_rsqf(fmaxf(ssn_, 1e-24f)); \
            float bv_[4], an_[4], w_[4], cv_[4], bon_ = 0.f, beta_ = 0.f, kap_ = 0.f; \
            _Pragma("unroll") for (int i = 0; i < 4; ++i) { bv_[i] = kkv_[i] * inv_ * aa_[i]; an_[i] = -kkn_[i] * invn_; w_[i] = __expf(-e_[i]); cv_[i] = w_[i] * an_[i]; \
                bon_ += r_[i] * k2_[i] * rk4[i]; beta_ += bv_[i] * an_[i]; kap_ += k2_[i] * an_[i]; } \
            bon_ = row16_sum(bon_); beta_ = row16_sum(beta_); kap_ = row16_sum(kap_); \
            if (pq == 0 && half == 0) BON[((size_t)b * SEQ + (chunk) * 32 + pj) * 8 + h] = bon_; \
            LAS float* vf_ = VECF + (bi) * 10240 + pj * 64 + 4 * pq; \
            *(LAS f32x4*)vf_ = (f32x4){w_[0], w_[1], w_[2], w_[3]}; *(LAS f32x4*)(vf_ + 2048) = (f32x4){cv_[0], cv_[1], cv_[2], cv_[3]}; *(LAS f32x4*)(vf_ + 4096) = (f32x4){bv_[0], bv_[1], bv_[2], bv_[3]}; \
            *(LAS f32x4*)(vf_ + 6144) = (f32x4){k2_[0], k2_[1], k2_[2], k2_[3]}; *(LAS f32x4*)(vf_ + 8192) = (f32x4){r_[0], r_[1], r_[2], r_[3]}; \
            if (pq == 0) *(LAS f32x2*)(BETA + ((bi) * 32 + pj) * 2) = (f32x2){beta_, beta_}; \
            if (vmine) { LAS float* kp_ = VKP + ((((bi) * 32 + pj) * 4 + (qv >> 1)) * 4) * 4 + (qv & 1); \
                _Pragma("unroll") for (int i = 0; i < 4; ++i) { kp_[i * 4] = v_[i]; kp_[i * 4 + 2] = v_[i] * kap_; } } } while (0)
        WKV_LOAD(0); WKV_PREP(0, 0);
        __syncthreads();
        float ltv[32];
#pragma unroll
        for (int i = 0; i < 32; ++i) ltv[i] = 0.f;
        f32x2 Q0 = {0.f, 0.f}, Q1 = Q0, Q2 = Q0, Q3 = Q0, SA = Q0, YP = Q0; float yselA = 0.f, yselB = 0.f; const int clp = (cl + 1) & 15;
        for (int chunk = 0; chunk < SEQ / 32; ++chunk) {
            const int bi = chunk & 1;
            TSTART(3);
            if (chunk > 1) { const LAS float* ys = YST + (((chunk - 2) & 3) * 32 + pj) * 33 + 2 * pq;
                *(f32x2*)(Y + ((size_t)b * SEQ + (chunk - 2) * 32 + pj) * 512 + h * 64 + 32 * half + 2 * pq) = (f32x2){ys[0], ys[1]}; }
            if (chunk + 1 < SEQ / 32) WKV_LOAD(chunk + 1);
            TSTOP(3); TSTART(2);
            if (__builtin_amdgcn_readfirstlane(wave) < 4) {
            const LAS float* vecp = VECF + bi * 10240 + 4 * cl; const LAS float* vkp = VKP + ((bi * 32 * 4 + wave) * 4 + rr) * 4; const LAS float* btp = BETA + bi * 64;
            LAS float* ysp = YST + ((chunk & 3) * 32 + cl) * 33 + 8 * wave + rr;
            LAS float* ysp_prev = YST + (((chunk + 3) & 3) * 32 + 16 + cl) * 33 + 8 * wave + rr;
            f32x4 w4 = *(const LAS f32x4*)vecp, c4 = *(const LAS f32x4*)(vecp + 2048), b4 = *(const LAS f32x4*)(vecp + 4096), k4 = *(const LAS f32x4*)(vecp + 6144), r4 = *(const LAS f32x4*)(vecp + 8192);
            f32x4 vk = *(const LAS f32x4*)vkp; f32x2 be = *(const LAS f32x2*)btp;
#pragma unroll 2
            for (int j = 0; j < 32; ++j) {
                const int jn = (j + 1) & 31;
                const f32x4 w4n = *(const LAS f32x4*)(vecp + jn * 64), c4n = *(const LAS f32x4*)(vecp + 2048 + jn * 64), b4n = *(const LAS f32x4*)(vecp + 4096 + jn * 64);
                const f32x4 k4n = *(const LAS f32x4*)(vecp + 6144 + jn * 64), r4n = *(const LAS f32x4*)(vecp + 8192 + jn * 64), vkn = *(const LAS f32x4*)(vkp + jn * 64);
                const f32x2 ben = *(const LAS f32x2*)(btp + jn * 2);
                const f32x2 w01 = __builtin_shufflevector(w4, w4, 0, 1), w23 = __builtin_shufflevector(w4, w4, 2, 3), c01 = __builtin_shufflevector(c4, c4, 0, 1), c23 = __builtin_shufflevector(c4, c4, 2, 3);
                const f32x2 b01 = __builtin_shufflevector(b4, b4, 0, 1), b23 = __builtin_shufflevector(b4, b4, 2, 3), k01 = __builtin_shufflevector(k4, k4, 0, 1), k23 = __builtin_shufflevector(k4, k4, 2, 3);
                const f32x2 r01 = __builtin_shufflevector(r4, r4, 0, 1), r23 = __builtin_shufflevector(r4, r4, 2, 3), VP = __builtin_shufflevector(vk, vk, 0, 1), VK2 = __builtin_shufflevector(vk, vk, 2, 3);
                f32x2 YN;
                asm volatile(
                    "v_pk_mul_f32 v[250:251], %[Q0], %[c01] op_sel_hi:[1,0]\n\t"
                    "v_pk_mul_f32 %[Q0], %[Q0], %[w01] op_sel_hi:[1,0]\n\t"
                    "v_add_f32_dpp %[yA], %[yA], %[yA] quad_perm:[1,0,3,2] row_mask:0xf bank_mask:0xf bound_ctrl:1\n\t"
                    "v_pk_fma_f32 v[250:251], %[Q1], %[c01], v[250:251] op_sel:[0,1,0] op_sel_hi:[1,1,1]\n\t"
                    "v_pk_mul_f32 %[Q1], %[Q1], %[w01] op_sel:[0,1] op_sel_hi:[1,1]\n\t"
                    "v_add_f32_dpp %[yB], %[yB], %[yB] quad_perm:[1,0,3,2] row_mask:0xf bank_mask:0xf bound_ctrl:1\n\t"
                    "v_pk_fma_f32 v[250:251], %[Q2], %[c23], v[250:251] op_sel_hi:[1,0,1]\n\t"
                    "v_pk_mul_f32 %[Q2], %[Q2], %[w23] op_sel_hi:[1,0]\n\t"
                    "v_add_f32_dpp %[yA], %[yA], %[yA] quad_perm:[2,3,0,1] row_mask:0xf bank_mask:0xf bound_ctrl:1\n\t"
                    "v_pk_fma_f32 v[250:251], %[Q3], %[c23], v[250:251] op_sel:[0,1,0] op_sel_hi:[1,1,1]\n\t"
                    "v_pk_mul_f32 %[Q3], %[Q3], %[w23] op_sel:[0,1] op_sel_hi:[1,1]\n\t"
                    "v_add_f32_dpp %[yB], %[yB], %[yB] quad_perm:[2,3,0,1] row_mask:0xf bank_mask:0xf bound_ctrl:1\n\t"
                    "v_pk_fma_f32 %[Q0], %[VP], %[k01], %[Q0] op_sel_hi:[1,0,1]\n\t"
                    "v_add_f32_dpp v250, v250, v250 quad_perm:[1,0,3,2] row_mask:0xf bank_mask:0xf bound_ctrl:1\n\t"
                    "v_pk_fma_f32 %[Q1], %[VP], %[k01], %[Q1] op_sel:[0,1,0] op_sel_hi:[1,1,1]\n\t"
                    "v_add_f32_dpp v251, v251, v251 quad_perm:[1,0,3,2] row_mask:0xf bank_mask:0xf bound_ctrl:1\n\t"
                    "v_pk_fma_f32 %[Q2], %[VP], %[k23], %[Q2] op_sel_hi:[1,0,1]\n\t"
                    "v_add_f32_dpp %[yA], %[yA], %[yA] row_half_mirror row_mask:0xf bank_mask:0xf bound_ctrl:1\n\t"
                    "v_pk_fma_f32 %[Q3], %[VP], %[k23], %[Q3] op_sel:[0,1,0] op_sel_hi:[1,1,1]\n\t"
                    "v_add_f32_dpp v250, v250, v250 quad_perm:[2,3,0,1] row_mask:0xf bank_mask:0xf bound_ctrl:1\n\t"
                    "v_pk_fma_f32 %[Q0], %[SA], %[b01], %[Q0] op_sel_hi:[1,0,1]\n\t"
                    "v_add_f32_dpp v251, v251, v251 quad_perm:[2,3,0,1] row_mask:0xf bank_mask:0xf bound_ctrl:1\n\t"
                    "v_pk_fma_f32 %[Q1], %[SA], %[b01], %[Q1] op_sel:[0,1,0] op_sel_hi:[1,1,1]\n\t"
                    "v_add_f32_dpp %[yB], %[yB], %[yB] row_half_mirror row_mask:0xf bank_mask:0xf bound_ctrl:1\n\t"
                    "v_pk_fma_f32 %[Q2], %[SA], %[b23], %[Q2] op_sel_hi:[1,0,1]\n\t"
                    "v_add_f32_dpp v250, v250, v250 row_half_mirror row_mask:0xf bank_mask:0xf bound_ctrl:1\n\t"
                    "v_pk_fma_f32 %[Q3], %[SA], %[b23], %[Q3] op_sel:[0,1,0] op_sel_hi:[1,1,1]\n\t"
                    "v_add_f32_dpp v251, v251, v251 row_half_mirror row_mask:0xf bank_mask:0xf bound_ctrl:1\n\t"
                    "v_pk_mul_f32 %[YN], %[Q0], %[r01] op_sel_hi:[1,0]\n\t"
                    "v_add_f32_dpp %[yA], %[yA], %[yA] row_mirror row_mask:0xf bank_mask:0xf bound_ctrl:1\n\t"
                    "v_pk_fma_f32 %[YN], %[Q1], %[r01], %[YN] op_sel:[0,1,0] op_sel_hi:[1,1,1]\n\t"
                    "v_add_f32_dpp v250, v250, v250 row_mirror row_mask:0xf bank_mask:0xf bound_ctrl:1\n\t"
                    "v_add_f32_dpp %[yB], %[yB], %[yB] row_mirror row_mask:0xf bank_mask:0xf bound_ctrl:1\n\t"
                    "v_add_f32_dpp v251, v251, v251 row_mirror row_mask:0xf bank_mask:0xf bound_ctrl:1\n\t"
                    "v_pk_fma_f32 %[YN], %[Q2], %[r23], %[YN] op_sel_hi:[1,0,1]\n\t"
                    "s_nop 0\n\t"
                    "v_pk_fma_f32 %[YN], %[Q3], %[r23], %[YN] op_sel:[0,1,0] op_sel_hi:[1,1,1]\n\t"
                    "v_pk_add_f32 v[250:251], v[250:251], %[VK2]\n\t"
                    "s_nop 0\n\t"
                    "v_pk_fma_f32 %[SA], %[SA], %[be], v[250:251]\n\t"
                    : [Q0] "+v"(Q0), [Q1] "+v"(Q1), [Q2] "+v"(Q2), [Q3] "+v"(Q3), [SA] "+v"(SA), [YN] "=&v"(YN), [yA] "+v"(YP[0]), [yB] "+v"(YP[1])
                    : [c01] "v"(c01), [c23] "v"(c23), [w01] "v"(w01), [w23] "v"(w23), [k01] "v"(k01), [k23] "v"(k23), [b01] "v"(b01), [b23] "v"(b23), [r01] "v"(r01), [r23] "v"(r23),
                      [VP] "v"(VP), [VK2] "v"(VK2), [be] "v"(be)
                    : "v250", "v251");
                const bool mine = (j & 15) == clp;
                yselA = mine ? YP[0] : yselA; yselB = mine ? YP[1] : yselB;
                if ((j & 15) == 0) { LAS float* yq = (j == 0) ? ysp_prev : ysp; yq[0] = yselA; yq[4] = yselB; }
                YP = YN;
                w4 = w4n; c4 = c4n; b4 = b4n; k4 = k4n; r4 = r4n; vk = vkn; be = ben;
            }
            }
            else if (item < (int)gridDim.x) {
                const int wv4 = __builtin_amdgcn_readfirstlane(wave) - 4; LAS float* lscr = (LAS float*)(lds + (wv4 < 3 ? 131584 + wv4 * 8448 : 115712));
                const int lit_prev = (chunk - 1) * (int)(gridDim.x * 4) + (int)blockIdx.x * 4 + wv4, lit = lit_prev + (int)(gridDim.x * 4);
                if (chunk > 0 && lit_prev < N_LATE) { const TrDesc d = late_desc(a, lit_prev); tr_store(d, ltv, lscr, lane); }
                if (lit < N_LATE) { const TrDesc d = late_desc(a, lit); tr_load(d, ltv, lane); }
            }
            TSTOP(2); TSTART(3);
            if (chunk + 1 < SEQ / 32) WKV_PREP(chunk + 1, bi ^ 1);
            __syncthreads();
            TSTOP(3);
        }
        if (__builtin_amdgcn_readfirstlane(wave) < 4) {
            const float ya = row16_sum(YP[0]), yb = row16_sum(YP[1]);
            if (cl == 15) { yselA = ya; yselB = yb; }
            LAS float* yq = YST + ((((SEQ / 32) - 1) & 3) * 32 + 16 + cl) * 33 + 8 * wave + rr; yq[0] = yselA; yq[4] = yselB;
        }
        __syncthreads();
#pragma unroll
        for (int cc = SEQ / 32 - 2; cc < SEQ / 32; ++cc) { const LAS float* ys = YST + ((cc & 3) * 32 + pj) * 33 + 2 * pq;
            *(f32x2*)(Y + ((size_t)b * SEQ + cc * 32 + pj) * 512 + h * 64 + 32 * half + 2 * pq) = (f32x2){ys[0], ys[1]}; }
#undef WKV_LOAD
#undef WKV_PREP
    }
    TSTOP(4);
}


__device__ __forceinline__ void late_items_idle(const Args& a, LAS unsigned char* lds, int lo, int hi, int first_idle) {
    if ((int)blockIdx.x < first_idle) return;
    const int lane = threadIdx.x & 63, wave = __builtin_amdgcn_readfirstlane(threadIdx.x >> 6);
    float ltv[32]; LAS float* lscr = (LAS float*)(lds + wave * 16384);
    for (int it = lo + ((int)blockIdx.x - first_idle) * 8 + wave; it < hi; it += ((int)gridDim.x - first_idle) * 8) { const TrDesc d = late_desc(a, it); tr_load(d, ltv, lane); tr_store(d, ltv, lscr, lane); }
}

typedef float f32x16 __attribute__((ext_vector_type(16)));
template <int KSTEPS>
__device__ __forceinline__ f32x16 mm32(f32x16 acc, const LAS bf16_t* A, int lda, const LAS bf16_t* Bt, int ldb, int lane) {
    const int r = lane & 31, h = lane >> 5;
    const LAS bf16_t* ap = A + r * lda + 8 * h; const LAS bf16_t* bp = Bt + r * ldb + 8 * h;
#pragma unroll
    for (int ks = 0; ks < KSTEPS; ++ks) acc = __builtin_amdgcn_mfma_f32_32x32x16_bf16(*(const LAS bf16x8*)(ap + 16 * ks), *(const LAS bf16x8*)(bp + 16 * ks), acc, 0, 0, 0);
    return acc;
}
#define TROW(i, lane) (((i) & 3) + 8 * ((i) >> 2) + 4 * ((lane) >> 5))
__device__ __forceinline__ unsigned short bf1(float f) { return (unsigned short)f2bf(f); }

__device__ __forceinline__ void phase4c(const Args& a, LAS unsigned char* lds) {
    const int tid = threadIdx.x, lane = tid & 63, wave = __builtin_amdgcn_readfirstlane(tid >> 6);
    unsigned char* ws = a.ws;
    TSTART(4); TSTART(1);
    for (int item = blockIdx.x; item < 256; item += gridDim.x) {
        if (tid < 64) {
            const int b = item >> 4, g = item & 15, n = tid;
            const f32x2 lamL = ((const f32x2*)(ws + WS_LAML))[g * 64 + n];
            const float* E = (const float*)(ws + WS_E) + ((size_t)g * S5ROWS + b * S5NCH) * 128;
            bf16_t* UG = (bf16_t*)(ws + WS_UG) + ((size_t)g * S5ROWS + b * S5NCH) * S5K + 512;
            float xr = 0.f, xi = 0.f;
#pragma unroll 8
            for (int ch = 0; ch < S5NCH; ++ch) {
                UG[(size_t)ch * S5K + n] = (bf16_t)f2bf(xr); UG[(size_t)ch * S5K + 64 + n] = (bf16_t)f2bf(xi);
                const float er = E[ch * 128 + n], ei = E[ch * 128 + 64 + n];
                const float nr = lamL[0] * xr - lamL[1] * xi + er, ni = lamL[0] * xi + lamL[1] * xr + ei; xr = nr; xi = ni;
            }
        }
    }
    TSTOP(1);
    if (gridDim.x != 256) { late_items_idle(a, lds, 0, N_LATE, 0); __syncthreads(); }
    const bf16_t* COLS = (const bf16_t*)(ws + WS_A); const bf16_t* LORA = (const bf16_t*)a.out;
    float* Y = (float*)(ws + WS_B); float* BON = (float*)(ws + WS_BON);
    LAS float* CUM = (LAS float*)lds;
    LAS float* PS = (LAS float*)(lds + 8192);
    LAS bf16_t* AT = (LAS bf16_t*)(lds + 10240);
    LAS bf16_t* BT = (LAS bf16_t*)(lds + 14848);
    LAS bf16_t* KT = (LAS bf16_t*)(lds + 19456);
    LAS bf16_t* RT = (LAS bf16_t*)(lds + 24064);
    LAS bf16_t* BTt = (LAS bf16_t*)(lds + 28672);
    LAS bf16_t* VmT = (LAS bf16_t*)(lds + 33792);
    LAS float* NabT = (LAS float*)(lds + 36352);
    LAS float* Nak = (LAS float*)(lds + 40960);
    LAS bf16_t* MbrT = (LAS bf16_t*)(lds + 45184);
    LAS bf16_t* A2 = (LAS bf16_t*)(lds + 47744);
    LAS bf16_t* NT = (LAS bf16_t*)(lds + 52864);
    LAS bf16_t* WyT = (LAS bf16_t*)(lds + 55424);
    LAS bf16_t* WzT = (LAS bf16_t*)(lds + 57984);
    LAS bf16_t* R2T = (LAS bf16_t*)(lds + 63104);
    LAS bf16_t* PpT = (LAS bf16_t*)(lds + 67712);
    LAS float* GC = (LAS float*)(lds + 76928);
    LAS bf16_t* SBF = (LAS bf16_t*)(lds + 77184);
    LAS float* YST = (LAS float*)(lds + 86400);
    for (int item = blockIdx.x; item < 256; item += gridDim.x) {
        const int bh = item >> 1, half = item & 1, b = bh >> 3, h = bh & 7;
        const int pj = tid >> 4, pq = tid & 15, hc = h * 64 + 4 * pq;
        const bool vmine = (pq >> 3) == half;
        u32x2 rc, rp, kc, kp, vc, vp, e4, a4;
        const u32x2 zero2 = (u32x2){0u, 0u};
        f32x16 Sacc;
#pragma unroll
        for (int i = 0; i < 16; ++i) Sacc[i] = 0.f;
        __syncthreads();
        for (int i = tid; i < 2 * 32 * 72 / 2; i += 512) ((LAS unsigned*)SBF)[i] = 0u;
#define WKV_LOAD(chunk) do { const int s_ = (chunk) * 32 + pj; const size_t t_ = (size_t)b * SEQ + s_; const bf16_t* cb_ = COLS + t_ * INC + hc; \
            rc = *(const u32x2*)(cb_ + C_R); kc = *(const u32x2*)(cb_ + C_K); vc = *(const u32x2*)(cb_ + C_V); \
            if (s_ > 0) { rp = *(const u32x2*)(cb_ - INC + C_R); kp = *(const u32x2*)(cb_ - INC + C_K); vp = *(const u32x2*)(cb_ - INC + C_V); } else { rp = zero2; kp = zero2; vp = zero2; } \
            e4 = *(const u32x2*)(LORA + t_ * 1536 + hc); a4 = *(const u32x2*)(LORA + t_ * 1536 + 512 + hc); } while (0)
        WKV_LOAD(0);
        for (int chunk = 0; chunk < SEQ / 32; ++chunk) {
            const int bi = chunk & 1;
            int tid_l = tid; asm volatile("" : "+v"(tid_l));
            const int lane = tid_l & 63, pj = tid_l >> 4, pq = tid_l & 15, tid = tid_l; (void)tid;
            float r_[4], k_[4], v_[4], e_[4], aa_[4], kkn_[4], k2_[4];
            { float rq_[4], kq_[4], vq_[4];
                const f32x4 mur = *(const f32x4*)(a.in[I_MU] + C_R + hc), muk = *(const f32x4*)(a.in[I_MU] + C_K + hc), muv = *(const f32x4*)(a.in[I_MU] + C_V + hc);
                const f32x4 kk4 = *(const f32x4*)(a.in[I_KK] + hc), ka4 = *(const f32x4*)(a.in[I_KA] + hc), rk4 = *(const f32x4*)(a.in[I_RK] + hc); unpack4(rc, r_); unpack4(rp, rq_); unpack4(kc, k_); unpack4(kp, kq_); unpack4(vc, v_); unpack4(vp, vq_); unpack4(e4, e_); unpack4(a4, aa_);
                float ss_ = 0.f, bon_ = 0.f;
#pragma unroll
                for (int i = 0; i < 4; ++i) { r_[i] += (rq_[i] - r_[i]) * mur[i]; k_[i] += (kq_[i] - k_[i]) * muk[i]; v_[i] += (vq_[i] - v_[i]) * muv[i];
                    kkn_[i] = k_[i] * kk4[i]; ss_ += kkn_[i] * kkn_[i]; k2_[i] = k_[i] * (1.0f + (aa_[i] - 1.0f) * ka4[i]); bon_ += r_[i] * k2_[i] * rk4[i]; }
                ss_ = row16_sum(ss_); bon_ = row16_sum(bon_); const float inv_ = __builtin_amdgcn_rsqf(fmaxf(ss_, 1e-24f));
#pragma unroll
                for (int i = 0; i < 4; ++i) kkn_[i] *= inv_;
                if (pq == 0 && half == 0) BON[((size_t)b * SEQ + chunk * 32 + pj) * 8 + h] = bon_;
                *(LAS f32x4*)(CUM + pj * 64 + 4 * pq) = (f32x4){e_[0], e_[1], e_[2], e_[3]}; }
            if (chunk + 1 < SEQ / 32) WKV_LOAD(chunk + 1);
            __syncthreads();
            {
                const int col = tid & 63, qd = tid >> 6; float e0 = CUM[(4 * qd) * 64 + col], e1 = CUM[(4 * qd + 1) * 64 + col], e2 = CUM[(4 * qd + 2) * 64 + col], e3 = CUM[(4 * qd + 3) * 64 + col];
                e1 += e0; e2 += e1; e3 += e2; PS[qd * 64 + col] = e3;
                __syncthreads();
                float base = 0.f;
#pragma unroll
                for (int q2 = 0; q2 < 7; ++q2) base += (q2 < qd) ? PS[q2 * 64 + col] : 0.f;
                CUM[(4 * qd) * 64 + col] = base + e0; CUM[(4 * qd + 1) * 64 + col] = base + e1; CUM[(4 * qd + 2) * 64 + col] = base + e2; CUM[(4 * qd + 3) * 64 + col] = base + e3; }
            __syncthreads();
            {
                const f32x4 cm = *(const LAS f32x4*)(CUM + pj * 64 + 4 * pq); float at_[4], bt_[4], kt_[4], rt_[4], g_[4];
#pragma unroll
                for (int i = 0; i < 4; ++i) { const float g = __expf(-cm[i]), ig = __expf(cm[i]), gp = __expf(e_[i] - cm[i]); g_[i] = g;
                    at_[i] = -kkn_[i] * gp; bt_[i] = kkn_[i] * aa_[i] * ig; kt_[i] = k2_[i] * ig; rt_[i] = r_[i] * g; }
                *(LAS u32x2*)(AT + pj * 72 + 4 * pq) = (u32x2){cvt_pk_bf16(at_[0], at_[1]), cvt_pk_bf16(at_[2], at_[3])};
                *(LAS u32x2*)(BT + pj * 72 + 4 * pq) = (u32x2){cvt_pk_bf16(bt_[0], bt_[1]), cvt_pk_bf16(bt_[2], bt_[3])};
                *(LAS u32x2*)(KT + pj * 72 + 4 * pq) = (u32x2){cvt_pk_bf16(kt_[0], kt_[1]), cvt_pk_bf16(kt_[2], kt_[3])};
                *(LAS u32x2*)(RT + pj * 72 + 4 * pq) = (u32x2){cvt_pk_bf16(rt_[0], rt_[1]), cvt_pk_bf16(rt_[2], rt_[3])};
#pragma unroll
                for (int i = 0; i < 4; ++i) BTt[(4 * pq + i) * 40 + pj] = bf1(bt_[i]);
                if (vmine) {
#pragma unroll
                    for (int i = 0; i < 4; ++i) VmT[(4 * pq - 32 * half + i) * 40 + pj] = bf1(v_[i]); }
                if (pj == 31) *(LAS f32x4*)(GC + 4 * pq) = (f32x4){g_[0], g_[1], g_[2], g_[3]}; }
            __syncthreads();
            f32x16 accw;
#pragma unroll
            for (int i = 0; i < 16; ++i) accw[i] = 0.f;
            if (wave < 4) {
                f32x16 acc;
#pragma unroll
                for (int i = 0; i < 16; ++i) acc[i] = 0.f;
                acc = mm32<4>(acc, (wave & 1) ? KT : BT, 72, (wave & 2) ? RT : AT, 72, lane);
                const int t = lane & 31;
                if (wave == 0) {
#pragma unroll
                    for (int g4 = 0; g4 < 4; ++g4) { const int s0 = 8 * g4 + 4 * (lane >> 5);
#pragma unroll
                        for (int i = 0; i < 4; ++i) NabT[t * 36 + i * 8 + 2 * g4 + (lane >> 5)] = (s0 + i < t) ? acc[4 * g4 + i] : 0.f; }
                } else if (wave == 1) {
#pragma unroll
                    for (int i = 0; i < 16; ++i) { const int s = TROW(i, lane); Nak[s * 33 + t] = (s < t) ? acc[i] : 0.f; }
                } else if (wave == 2) {
#pragma unroll
                    for (int g4 = 0; g4 < 4; ++g4) { const int s0 = 8 * g4 + 4 * (lane >> 5); float o[4];
#pragma unroll
                        for (int i = 0; i < 4; ++i) o[i] = (s0 + i <= t) ? acc[4 * g4 + i] : 0.f;
                        *(LAS u32x2*)(MbrT + t * 40 + s0) = (u32x2){cvt_pk_bf16(o[0], o[1]), cvt_pk_bf16(o[2], o[3])}; }
                } else {
#pragma unroll
                    for (int i = 0; i < 16; ++i) { const int s = TROW(i, lane); accw[i] = (s <= t) ? acc[i] : 0.f; }
                }
            }
            __syncthreads();
            if (wave < 6) {
                const int q = lane & 3, rowi = ((wave & 3) * 64 + lane) >> 2; const bool isA = wave < 4;
                float xq0, xq1, xq2, xq3, xq4, xq5, xq6, xq7;
                if (isA) {
                    xq0 = __builtin_bit_cast(float, (unsigned)AT[(0 + q) * 72 + rowi] << 16);
                    xq1 = __builtin_bit_cast(float, (unsigned)AT[(4 + q) * 72 + rowi] << 16);
                    xq2 = __builtin_bit_cast(float, (unsigned)AT[(8 + q) * 72 + rowi] << 16);
                    xq3 = __builtin_bit_cast(float, (unsigned)AT[(12 + q) * 72 + rowi] << 16);
                    xq4 = __builtin_bit_cast(float, (unsigned)AT[(16 + q) * 72 + rowi] << 16);
                    xq5 = __builtin_bit_cast(float, (unsigned)AT[(20 + q) * 72 + rowi] << 16);
                    xq6 = __builtin_bit_cast(float, (unsigned)AT[(24 + q) * 72 + rowi] << 16);
                    xq7 = __builtin_bit_cast(float, (unsigned)AT[(28 + q) * 72 + rowi] << 16);
                } else {
                    xq0 = Nak[rowi * 33 + 0 + q];
                    xq1 = Nak[rowi * 33 + 4 + q];
                    xq2 = Nak[rowi * 33 + 8 + q];
                    xq3 = Nak[rowi * 33 + 12 + q];
                    xq4 = Nak[rowi * 33 + 16 + q];
                    xq5 = Nak[rowi * 33 + 20 + q];
                    xq6 = Nak[rowi * 33 + 24 + q];
                    xq7 = Nak[rowi * 33 + 28 + q];
                }
                const bool kq0 = q == 0, kq1 = q == 1, kq2 = q == 2, kq3 = q == 3;
                const LAS float* np_ = NabT + q * 8;
                f32x4 n1_0, n2_0, n3_0, n4_0, n5_0, n6_0, n7_0, n8_0, n9_0, n10_0, n11_0, n12_0, n13_0, n14_0, n15_0, n16_0, n17_0, n17_1, n18_0, n18_1, n19_0, n19_1, n20_0, n20_1, n21_0, n21_1, n22_0, n22_1, n23_0, n23_1, n24_0, n24_1, n25_0, n25_1, n26_0, n26_1, n27_0, n27_1, n28_0, n28_1, n29_0, n29_1, n30_0, n30_1, n31_0, n31_1;
                float pe1, pe2, pe3, pe4, pe5, pe6, pe7, pe8, pe9, pe10, pe11, pe12, pe13, pe14, pe15, pe16, pe17, pe18, pe19, pe20, pe21, pe22, pe23, pe24, pe25, pe26, pe27, pe28, pe29, pe30, pe31, pe32;
                n1_0 = *(const LAS f32x4*)(np_ + 1 * 36); n2_0 = *(const LAS f32x4*)(np_ + 2 * 36); pe1 = 0.f;
                { n3_0 = *(const LAS f32x4*)(np_ + 3 * 36); float p = pe1; asm("v_fmac_f32 %0, %1, %2" : "+v"(p) : "v"(xq0), "v"(n1_0[0])); p += dpp_f(p, 0); pe2 = 0.f; p += dpp_f(p, 1); xq0 = kq1 ? (xq0 + p) : xq0; asm volatile("" : "+v"(xq0), "+v"(np_) : "v"(n1_0)); }
                { n4_0 = *(const LAS f32x4*)(np_ + 4 * 36); float p = pe2; asm("v_fmac_f32 %0, %1, %2" : "+v"(p) : "v"(xq0), "v"(n2_0[0])); p += dpp_f(p, 0); pe3 = 0.f; p += dpp_f(p, 1); xq0 = kq2 ? (xq0 + p) : xq0; asm volatile("" : "+v"(xq0), "+v"(np_) : "v"(n2_0)); }
                { n5_0 = *(const LAS f32x4*)(np_ + 5 * 36); float p = pe3; asm("v_fmac_f32 %0, %1, %2" : "+v"(p) : "v"(xq0), "v"(n3_0[0])); p += dpp_f(p, 0); pe4 = 0.f; p += dpp_f(p, 1); xq0 = kq3 ? (xq0 + p) : xq0; asm volatile("" : "+v"(xq0), "+v"(np_) : "v"(n3_0)); }
                { n6_0 = *(const LAS f32x4*)(np_ + 6 * 36); float p = pe4; asm("v_fmac_f32 %0, %1, %2" : "+v"(p) : "v"(xq0), "v"(n4_0[0])); p += dpp_f(p, 0); pe5 = 0.f; asm("v_fmac_f32 %0, %1, %2" : "+v"(pe5) : "v"(xq0), "v"(n5_0[0])); p += dpp_f(p, 1); xq1 = kq0 ? (xq1 + p) : xq1; asm volatile("" : "+v"(xq1), "+v"(np_) : "v"(n4_0)); }
                { n7_0 = *(const LAS f32x4*)(np_ + 7 * 36); float p = pe5; asm("v_fmac_f32 %0, %1, %2" : "+v"(p) : "v"(xq1), "v"(n5_0[1])); p += dpp_f(p, 0); pe6 = 0.f; asm("v_fmac_f32 %0, %1, %2" : "+v"(pe6) : "v"(xq0), "v"(n6_0[0])); p += dpp_f(p, 1); xq1 = kq1 ? (xq1 + p) : xq1; asm volatile("" : "+v"(xq1), "+v"(np_) : "v"(n5_0)); }
                { n8_0 = *(const LAS f32x4*)(np_ + 8 * 36); float p = pe6; asm("v_fmac_f32 %0, %1, %2" : "+v"(p) : "v"(xq1), "v"(n6_0[1])); p += dpp_f(p, 0); pe7 = 0.f; asm("v_fmac_f32 %0, %1, %2" : "+v"(pe7) : "v"(xq0), "v"(n7_0[0])); p += dpp_f(p, 1); xq1 = kq2 ? (xq1 + p) : xq1; asm volatile("" : "+v"(xq1), "+v"(np_) : "v"(n6_0)); }
                { n9_0 = *(const LAS f32x4*)(np_ + 9 * 36); float p = pe7; asm("v_fmac_f32 %0, %1, %2" : "+v"(p) : "v"(xq1), "v"(n7_0[1])); p += dpp_f(p, 0); pe8 = 0.f; asm("v_fmac_f32 %0, %1, %2" : "+v"(pe8) : "v"(xq0), "v"(n8_0[0])); p += dpp_f(p, 1); xq1 = kq3 ? (xq1 + p) : xq1; asm volatile("" : "+v"(xq1), "+v"(np_) : "v"(n7_0)); }
                { n10_0 = *(const LAS f32x4*)(np_ + 10 * 36); float p = pe8; asm("v_fmac_f32 %0, %1, %2" : "+v"(p) : "v"(xq1), "v"(n8_0[1])); p += dpp_f(p, 0); pe9 = 0.f; asm("v_fmac_f32 %0, %1, %2" : "+v"(pe9) : "v"(xq0), "v"(n9_0[0])); asm("v_fmac_f32 %0, %1, %2" : "+v"(pe9) : "v"(xq1), "v"(n9_0[1])); p += dpp_f(p, 1); xq2 = kq0 ? (xq2 + p) : xq2; asm volatile("" : "+v"(xq2), "+v"(np_) : "v"(n8_0)); }
                { n11_0 = *(const LAS f32x4*)(np_ + 11 * 36); float p = pe9; asm("v_fmac_f32 %0, %1, %2" : "+v"(p) : "v"(xq2), "v"(n9_0[2])); p += dpp_f(p, 0); pe10 = 0.f; asm("v_fmac_f32 %0, %1, %2" : "+v"(pe10) : "v"(xq0), "v"(n10_0[0])); asm("v_fmac_f32 %0, %1, %2" : "+v"(pe10) : "v"(xq1), "v"(n10_0[1])); p += dpp_f(p, 1); xq2 = kq1 ? (xq2 + p) : xq2; asm volatile("" : "+v"(xq2), "+v"(np_) : "v"(n9_0)); }
                { n12_0 = *(const LAS f32x4*)(np_ + 12 * 36); float p = pe10; asm("v_fmac_f32 %0, %1, %2" : "+v"(p) : "v"(xq2), "v"(n10_0[2])); p += dpp_f(p, 0); pe11 = 0.f; asm("v_fmac_f32 %0, %1, %2" : "+v"(pe11) : "v"(xq0), "v"(n11_0[0])); asm("v_fmac_f32 %0, %1, %2" : "+v"(pe11) : "v"(xq1), "v"(n11_0[1])); p += dpp_f(p, 1); xq2 = kq2 ? (xq2 + p) : xq2; asm volatile("" : "+v"(xq2), "+v"(np_) : "v"(n10_0)); }
                { n13_0 = *(const LAS f32x4*)(np_ + 13 * 36); float p = pe11; asm("v_fmac_f32 %0, %1, %2" : "+v"(p) : "v"(xq2), "v"(n11_0[2])); p += dpp_f(p, 0); pe12 = 0.f; asm("v_fmac_f32 %0, %1, %2" : "+v"(pe12) : "v"(xq0), "v"(n12_0[0])); asm("v_fmac_f32 %0, %1, %2" : "+v"(pe12) : "v"(xq1), "v"(n12_0[1])); p += dpp_f(p, 1); xq2 = kq3 ? (xq2 + p) : xq2; asm volatile("" : "+v"(xq2), "+v"(np_) : "v"(n11_0)); }
                { n14_0 = *(const LAS f32x4*)(np_ + 14 * 36); float p = pe12; asm("v_fmac_f32 %0, %1, %2" : "+v"(p) : "v"(xq2), "v"(n12_0[2])); p += dpp_f(p, 0); pe13 = 0.f; asm("v_fmac_f32 %0, %1, %2" : "+v"(pe13) : "v"(xq0), "v"(n13_0[0])); asm("v_fmac_f32 %0, %1, %2" : "+v"(pe13) : "v"(xq1), "v"(n13_0[1])); asm("v_fmac_f32 %0, %1, %2" : "+v"(pe13) : "v"(xq2), "v"(n13_0[2])); p += dpp_f(p, 1); xq3 = kq0 ? (xq3 + p) : xq3; asm volatile("" : "+v"(xq3), "+v"(np_) : "v"(n12_0)); }
                { n15_0 = *(const LAS f32x4*)(np_ + 15 * 36); float p = pe13; asm("v_fmac_f32 %0, %1, %2" : "+v"(p) : "v"(xq3), "v"(n13_0[3])); p += dpp_f(p, 0); pe14 = 0.f; asm("v_fmac_f32 %0, %1, %2" : "+v"(pe14) : "v"(xq0), "v"(n14_0[0])); asm("v_fmac_f32 %0, %1, %2" : "+v"(pe14) : "v"(xq1), "v"(n14_0[1])); asm("v_fmac_f32 %0, %1, %2" : "+v"(pe14) : "v"(xq2), "v"(n14_0[2])); p += dpp_f(p, 1); xq3 = kq1 ? (xq3 + p) : xq3; asm volatile("" : "+v"(xq3), "+v"(np_) : "v"(n13_0)); }
                { n16_0 = *(const LAS f32x4*)(np_ + 16 * 36); float p = pe14; asm("v_fmac_f32 %0, %1, %2" : "+v"(p) : "v"(xq3), "v"(n14_0[3])); p += dpp_f(p, 0); pe15 = 0.f; asm("v_fmac_f32 %0, %1, %2" : "+v"(pe15) : "v"(xq0), "v"(n15_0[0])); asm("v_fmac_f32 %0, %1, %2" : "+v"(pe15) : "v"(xq1), "v"(n15_0[1])); asm("v_fmac_f32 %0, %1, %2" : "+v"(pe15) : "v"(xq2), "v"(n15_0[2])); p += dpp_f(p, 1); xq3 = kq2 ? (xq3 + p) : xq3; asm volatile("" : "+v"(xq3), "+v"(np_) : "v"(n14_0)); }
                { n17_0 = *(const LAS f32x4*)(np_ + 17 * 36); n17_1 = *(const LAS f32x4*)(np_ + 17 * 36 + 4); float p = pe15; asm("v_fmac_f32 %0, %1, %2" : "+v"(p) : "v"(xq3), "v"(n15_0[3])); p += dpp_f(p, 0); pe16 = 0.f; asm("v_fmac_f32 %0, %1, %2" : "+v"(pe16) : "v"(xq0), "v"(n16_0[0])); asm("v_fmac_f32 %0, %1, %2" : "+v"(pe16) : "v"(xq1), "v"(n16_0[1])); asm("v_fmac_f32 %0, %1, %2" : "+v"(pe16) : "v"(xq2), "v"(n16_0[2])); p += dpp_f(p, 1); xq3 = kq3 ? (xq3 + p) : xq3; asm volatile("" : "+v"(xq3), "+v"(np_) : "v"(n15_0)); }
                { n18_0 = *(const LAS f32x4*)(np_ + 18 * 36); n18_1 = *(const LAS f32x4*)(np_ + 18 * 36 + 4); float p = pe16; asm("v_fmac_f32 %0, %1, %2" : "+v"(p) : "v"(xq3), "v"(n16_0[3])); p += dpp_f(p, 0); pe17 = 0.f; asm("v_fmac_f32 %0, %1, %2" : "+v"(pe17) : "v"(xq0), "v"(n17_0[0])); asm("v_fmac_f32 %0, %1, %2" : "+v"(pe17) : "v"(xq1), "v"(n17_0[1])); asm("v_fmac_f32 %0, %1, %2" : "+v"(pe17) : "v"(xq2), "v"(n17_0[2])); asm("v_fmac_f32 %0, %1, %2" : "+v"(pe17) : "v"(xq3), "v"(n17_0[3])); p += dpp_f(p, 1); xq4 = kq0 ? (xq4 + p) : xq4; asm volatile("" : "+v"(xq4), "+v"(np_) : "v"(n16_0)); }
                { n19_0 = *(const LAS f32x4*)(np_ + 19 * 36); n19_1 = *(const LAS f32x4*)(np_ + 19 * 36 + 4); float p = pe17; asm("v_fmac_f32 %0, %1, %2" : "+v"(p) : "v"(xq4), "v"(n17_1[0])); p += dpp_f(p, 0); pe18 = 0.f; asm("v_fmac_f32 %0, %1, %2" : "+v"(pe18) : "v"(xq0), "v"(n18_0[0])); asm("v_fmac_f32 %0, %1, %2" : "+v"(pe18) : "v"(xq1), "v"(n18_0[1])); asm("v_fmac_f32 %0, %1, %2" : "+v"(pe18) : "v"(xq2), "v"(n18_0[2])); asm("v_fmac_f32 %0, %1, %2" : "+v"(pe18) : "v"(xq3), "v"(n18_0[3])); p += dpp_f(p, 1); xq4 = kq1 ? (xq4 + p) : xq4; asm volatile("" : "+v"(xq4), "+v"(np_) : "v"(n17_0), "v"(n17_1)); }
                { n20_0 = *(const LAS f32x4*)(np_ + 20 * 36); n20_1 = *(const LAS f32x4*)(np_ + 20 * 36 + 4); float p = pe18; asm("v_fmac_f32 %0, %1, %2" : "+v"(p) : "v"(xq4), "v"(n18_1[0])); p += dpp_f(p, 0); pe19 = 0.f; asm("v_fmac_f32 %0, %1, %2" : "+v"(pe19) : "v"(xq0), "v"(n19_0[0])); asm("v_fmac_f32 %0, %1, %2" : "+v"(pe19) : "v"(xq1), "v"(n19_0[1])); asm("v_fmac_f32 %0, %1, %2" : "+v"(pe19) : "v"(xq2), "v"(n19_0[2])); asm("v_fmac_f32 %0, %1, %2" : "+v"(pe19) : "v"(xq3), "v"(n19_0[3])); p += dpp_f(p, 1); xq4 = kq2 ? (xq4 + p) : xq4; asm volatile("" : "+v"(xq4), "+v"(np_) : "v"(n18_0), "v"(n18_1)); }
                { n21_0 = *(const LAS f32x4*)(np_ + 21 * 36); n21_1 = *(const LAS f32x4*)(np_ + 21 * 36 + 4); float p = pe19; asm("v_fmac_f32 %0, %1, %2" : "+v"(p) : "v"(xq4), "v"(n19_1[0])); p += dpp_f(p, 0); pe20 = 0.f; asm("v_fmac_f32 %0, %1, %2" : "+v"(pe20) : "v"(xq0), "v"(n20_0[0])); asm("v_fmac_f32 %0, %1, %2" : "+v"(pe20) : "v"(xq1), "v"(n20_0[1])); asm("v_fmac_f32 %0, %1, %2" : "+v"(pe20) : "v"(xq2), "v"(n20_0[2])); asm("v_fmac_f32 %0, %1, %2" : "+v"(pe20) : "v"(xq3), "v"(n20_0[3])); p += dpp_f(p, 1); xq4 = kq3 ? (xq4 + p) : xq4; asm volatile("" : "+v"(xq4), "+v"(np_) : "v"(n19_0), "v"(n19_1)); }
                { n22_0 = *(const LAS f32x4*)(np_ + 22 * 36); n22_1 = *(const LAS f32x4*)(np_ + 22 * 36 + 4); float p = pe20; asm("v_fmac_f32 %0, %1, %2" : "+v"(p) : "v"(xq4), "v"(n20_1[0])); p += dpp_f(p, 0); pe21 = 0.f; asm("v_fmac_f32 %0, %1, %2" : "+v"(pe21) : "v"(xq0), "v"(n21_0[0])); asm("v_fmac_f32 %0, %1, %2" : "+v"(pe21) : "v"(xq1), "v"(n21_0[1])); asm("v_fmac_f32 %0, %1, %2" : "+v"(pe21) : "v"(xq2), "v"(n21_0[2])); asm("v_fmac_f32 %0, %1, %2" : "+v"(pe21) : "v"(xq3), "v"(n21_0[3])); asm("v_fmac_f32 %0, %1, %2" : "+v"(pe21) : "v"(xq4), "v"(n21_1[0])); p += dpp_f(p, 1); xq5 = kq0 ? (xq5 + p) : xq5; asm volatile("" : "+v"(xq5), "+v"(np_) : "v"(n20_0), "v"(n20_1)); }
                { n23_0 = *(const LAS f32x4*)(np_ + 23 * 36); n23_1 = *(const LAS f32x4*)(np_ + 23 * 36 + 4); float p = pe21; asm("v_fmac_f32 %0, %1, %2" : "+v"(p) : "v"(xq5), "v"(n21_1[1])); p += dpp_f(p, 0); pe22 = 0.f; asm("v_fmac_f32 %0, %1, %2" : "+v"(pe22) : "v"(xq0), "v"(n22_0[0])); asm("v_fmac_f32 %0, %1, %2" : "+v"(pe22) : "v"(xq1), "v"(n22_0[1])); asm("v_fmac_f32 %0, %1, %2" : "+v"(pe22) : "v"(xq2), "v"(n22_0[2])); asm("v_fmac_f32 %0, %1, %2" : "+v"(pe22) : "v"(xq3), "v"(n22_0[3])); asm("v_fmac_f32 %0, %1, %2" : "+v"(pe22) : "v"(xq4), "v"(n22_1[0])); p += dpp_f(p, 1); xq5 = kq1 ? (xq5 + p) : xq5; asm volatile("" : "+v"(xq5), "+v"(np_) : "v"(n21_0), "v"(n21_1)); }
                { n24_0 = *(const LAS f32x4*)(np_ + 24 * 36); n24_1 = *(const LAS f32x4*)(np_ + 24 * 36 + 4); float p = pe22; asm("v_fmac_f32 %0, %1, %2" : "+v"(p) : "v"(xq5), "v"(n22_1[1])); p += dpp_f(p, 0); pe23 = 0.f; asm("v_fmac_f32 %0, %1, %2" : "+v"(pe23) : "v"(xq0), "v"(n23_0[0])); asm("v_fmac_f32 %0, %1, %2" : "+v"(pe23) : "v"(xq1), "v"(n23_0[1])); asm("v_fmac_f32 %0, %1, %2" : "+v"(pe23) : "v"(xq2), "v"(n23_0[2])); asm("v_fmac_f32 %0, %1, %2" : "+v"(pe23) : "v"(xq3), "v"(n23_0[3])); asm("v_fmac_f32 %0, %1, %2" : "+v"(pe23) : "v"(xq4), "v"(n23_1[0])); p += dpp_f(p, 1); xq5 = kq2 ? (xq5 + p) : xq5; asm volatile("" : "+v"(xq5), "+v"(np_) : "v"(n22_0), "v"(n22_1)); }
                { n25_0 = *(const LAS f32x4*)(np_ + 25 * 36); n25_1 = *(const LAS f32x4*)(np_ + 25 * 36 + 4); float p = pe23; asm("v_fmac_f32 %0, %1, %2" : "+v"(p) : "v"(xq5), "v"(n23_1[1])); p += dpp_f(p, 0); pe24 = 0.f; asm("v_fmac_f32 %0, %1, %2" : "+v"(pe24) : "v"(xq0), "v"(n24_0[0])); asm("v_fmac_f32 %0, %1, %2" : "+v"(pe24) : "v"(xq1), "v"(n24_0[1])); asm("v_fmac_f32 %0, %1, %2" : "+v"(pe24) : "v"(xq2), "v"(n24_0[2])); asm("v_fmac_f32 %0, %1, %2" : "+v"(pe24) : "v"(xq3), "v"(n24_0[3])); asm("v_fmac_f32 %0, %1, %2" : "+v"(pe24) : "v"(xq4), "v"(n24_1[0])); p += dpp_f(p, 1); xq5 = kq3 ? (xq5 + p) : xq5; asm volatile("" : "+v"(xq5), "+v"(np_) : "v"(n23_0), "v"(n23_1)); }
                { n26_0 = *(const LAS f32x4*)(np_ + 26 * 36); n26_1 = *(const LAS f32x4*)(np_ + 26 * 36 + 4); float p = pe24; asm("v_fmac_f32 %0, %1, %2" : "+v"(p) : "v"(xq5), "v"(n24_1[1])); p += dpp_f(p, 0); pe25 = 0.f; asm("v_fmac_f32 %0, %1, %2" : "+v"(pe25) : "v"(xq0), "v"(n25_0[0])); asm("v_fmac_f32 %0, %1, %2" : "+v"(pe25) : "v"(xq1), "v"(n25_0[1])); asm("v_fmac_f32 %0, %1, %2" : "+v"(pe25) : "v"(xq2), "v"(n25_0[2])); asm("v_fmac_f32 %0, %1, %2" : "+v"(pe25) : "v"(xq3), "v"(n25_0[3])); asm("v_fmac_f32 %0, %1, %2" : "+v"(pe25) : "v"(xq4), "v"(n25_1[0])); asm("v_fmac_f32 %0, %1, %2" : "+v"(pe25) : "v"(xq5), "v"(n25_1[1])); p += dpp_f(p, 1); xq6 = kq0 ? (xq6 + p) : xq6; asm volatile("" : "+v"(xq6), "+v"(np_) : "v"(n24_0), "v"(n24_1)); }
                { n27_0 = *(const LAS f32x4*)(np_ + 27 * 36); n27_1 = *(const LAS f32x4*)(np_ + 27 * 36 + 4); float p = pe25; asm("v_fmac_f32 %0, %1, %2" : "+v"(p) : "v"(xq6), "v"(n25_1[2])); p += dpp_f(p, 0); pe26 = 0.f; asm("v_fmac_f32 %0, %1, %2" : "+v"(pe26) : "v"(xq0), "v"(n26_0[0])); asm("v_fmac_f32 %0, %1, %2" : "+v"(pe26) : "v"(xq1), "v"(n26_0[1])); asm("v_fmac_f32 %0, %1, %2" : "+v"(pe26) : "v"(xq2), "v"(n26_0[2])); asm("v_fmac_f32 %0, %1, %2" : "+v"(pe26) : "v"(xq3), "v"(n26_0[3])); asm("v_fmac_f32 %0, %1, %2" : "+v"(pe26) : "v"(xq4), "v"(n26_1[0])); asm("v_fmac_f32 %0, %1, %2" : "+v"(pe26) : "v"(xq5), "v"(n26_1[1])); p += dpp_f(p, 1); xq6 = kq1 ? (xq6 + p) : xq6; asm volatile("" : "+v"(xq6), "+v"(np_) : "v"(n25_0), "v"(n25_1)); }
                { n28_0 = *(const LAS f32x4*)(np_ + 28 * 36); n28_1 = *(const LAS f32x4*)(np_ + 28 * 36 + 4); float p = pe26; asm("v_fmac_f32 %0, %1, %2" : "+v"(p) : "v"(xq6), "v"(n26_1[2])); p += dpp_f(p, 0); pe27 = 0.f; asm("v_fmac_f32 %0, %1, %2" : "+v"(pe27) : "v"(xq0), "v"(n27_0[0])); asm("v_fmac_f32 %0, %1, %2" : "+v"(pe27) : "v"(xq1), "v"(n27_0[1])); asm("v_fmac_f32 %0, %1, %2" : "+v"(pe27) : "v"(xq2), "v"(n27_0[2])); asm("v_fmac_f32 %0, %1, %2" : "+v"(pe27) : "v"(xq3), "v"(n27_0[3])); asm("v_fmac_f32 %0, %1, %2" : "+v"(pe27) : "v"(xq4), "v"(n27_1[0])); asm("v_fmac_f32 %0, %1, %2" : "+v"(pe27) : "v"(xq5), "v"(n27_1[1])); p += dpp_f(p, 1); xq6 = kq2 ? (xq6 + p) : xq6; asm volatile("" : "+v"(xq6), "+v"(np_) : "v"(n26_0), "v"(n26_1)); }
                { n29_0 = *(const LAS f32x4*)(np_ + 29 * 36); n29_1 = *(const LAS f32x4*)(np_ + 29 * 36 + 4); float p = pe27; asm("v_fmac_f32 %0, %1, %2" : "+v"(p) : "v"(xq6), "v"(n27_1[2])); p += dpp_f(p, 0); pe28 = 0.f; asm("v_fmac_f32 %0, %1, %2" : "+v"(pe28) : "v"(xq0), "v"(n28_0[0])); asm("v_fmac_f32 %0, %1, %2" : "+v"(pe28) : "v"(xq1), "v"(n28_0[1])); asm("v_fmac_f32 %0, %1, %2" : "+v"(pe28) : "v"(xq2), "v"(n28_0[2])); asm("v_fmac_f32 %0, %1, %2" : "+v"(pe28) : "v"(xq3), "v"(n28_0[3])); asm("v_fmac_f32 %0, %1, %2" : "+v"(pe28) : "v"(xq4), "v"(n28_1[0])); asm("v_fmac_f32 %0, %1, %2" : "+v"(pe28) : "v"(xq5), "v"(n28_1[1])); p += dpp_f(p, 1); xq6 = kq3 ? (xq6 + p) : xq6; asm volatile("" : "+v"(xq6), "+v"(np_) : "v"(n27_0), "v"(n27_1)); }
                { n30_0 = *(const LAS f32x4*)(np_ + 30 * 36); n30_1 = *(const LAS f32x4*)(np_ + 30 * 36 + 4); float p = pe28; asm("v_fmac_f32 %0, %1, %2" : "+v"(p) : "v"(xq6), "v"(n28_1[2])); p += dpp_f(p, 0); pe29 = 0.f; asm("v_fmac_f32 %0, %1, %2" : "+v"(pe29) : "v"(xq0), "v"(n29_0[0])); asm("v_fmac_f32 %0, %1, %2" : "+v"(pe29) : "v"(xq1), "v"(n29_0[1])); asm("v_fmac_f32 %0, %1, %2" : "+v"(pe29) : "v"(xq2), "v"(n29_0[2])); asm("v_fmac_f32 %0, %1, %2" : "+v"(pe29) : "v"(xq3), "v"(n29_0[3])); asm("v_fmac_f32 %0, %1, %2" : "+v"(pe29) : "v"(xq4), "v"(n29_1[0])); asm("v_fmac_f32 %0, %1, %2" : "+v"(pe29) : "v"(xq5), "v"(n29_1[1])); asm("v_fmac_f32 %0, %1, %2" : "+v"(pe29) : "v"(xq6), "v"(n29_1[2])); p += dpp_f(p, 1); xq7 = kq0 ? (xq7 + p) : xq7; asm volatile("" : "+v"(xq7), "+v"(np_) : "v"(n28_0), "v"(n28_1)); }
                { n31_0 = *(const LAS f32x4*)(np_ + 31 * 36); n31_1 = *(const LAS f32x4*)(np_ + 31 * 36 + 4); float p = pe29; asm("v_fmac_f32 %0, %1, %2" : "+v"(p) : "v"(xq7), "v"(n29_1[3])); p += dpp_f(p, 0); pe30 = 0.f; asm("v_fmac_f32 %0, %1, %2" : "+v"(pe30) : "v"(xq0), "v"(n30_0[0])); asm("v_fmac_f32 %0, %1, %2" : "+v"(pe30) : "v"(xq1), "v"(n30_0[1])); asm("v_fmac_f32 %0, %1, %2" : "+v"(pe30) : "v"(xq2), "v"(n30_0[2])); asm("v_fmac_f32 %0, %1, %2" : "+v"(pe30) : "v"(xq3), "v"(n30_0[3])); asm("v_fmac_f32 %0, %1, %2" : "+v"(pe30) : "v"(xq4), "v"(n30_1[0])); asm("v_fmac_f32 %0, %1, %2" : "+v"(pe30) : "v"(xq5), "v"(n30_1[1])); asm("v_fmac_f32 %0, %1, %2" : "+v"(pe30) : "v"(xq6), "v"(n30_1[2])); p += dpp_f(p, 1); xq7 = kq1 ? (xq7 + p) : xq7; asm volatile("" : "+v"(xq7), "+v"(np_) : "v"(n29_0), "v"(n29_1)); }
                { float p = pe30; asm("v_fmac_f32 %0, %1, %2" : "+v"(p) : "v"(xq7), "v"(n30_1[3])); p += dpp_f(p, 0); pe31 = 0.f; asm("v_fmac_f32 %0, %1, %2" : "+v"(pe31) : "v"(xq0), "v"(n31_0[0])); asm("v_fmac_f32 %0, %1, %2" : "+v"(pe31) : "v"(xq1), "v"(n31_0[1])); asm("v_fmac_f32 %0, %1, %2" : "+v"(pe31) : "v"(xq2), "v"(n31_0[2])); asm("v_fmac_f32 %0, %1, %2" : "+v"(pe31) : "v"(xq3), "v"(n31_0[3])); asm("v_fmac_f32 %0, %1, %2" : "+v"(pe31) : "v"(xq4), "v"(n31_1[0])); asm("v_fmac_f32 %0, %1, %2" : "+v"(pe31) : "v"(xq5), "v"(n31_1[1])); asm("v_fmac_f32 %0, %1, %2" : "+v"(pe31) : "v"(xq6), "v"(n31_1[2])); p += dpp_f(p, 1); xq7 = kq2 ? (xq7 + p) : xq7; asm volatile("" : "+v"(xq7), "+v"(np_) : "v"(n30_0), "v"(n30_1)); }
                { float p = pe31; asm("v_fmac_f32 %0, %1, %2" : "+v"(p) : "v"(xq7), "v"(n31_1[3])); p += dpp_f(p, 0); p += dpp_f(p, 1); xq7 = kq3 ? (xq7 + p) : xq7; asm volatile("" : "+v"(xq7), "+v"(np_) : "v"(n31_0), "v"(n31_1)); }
                LAS bf16_t* dst = isA ? (A2 + rowi * 40 + q) : (NT + rowi * 40 + q);
                dst[0] = bf1(xq0);
                dst[4] = bf1(xq1);
                dst[8] = bf1(xq2);
                dst[12] = bf1(xq3);
                dst[16] = bf1(xq4);
                dst[20] = bf1(xq5);
                dst[24] = bf1(xq6);
                dst[28] = bf1(xq7);
            }
            __syncthreads();
            {
                const int t = lane & 31; f32x16 acc;
#pragma unroll
                for (int i = 0; i < 16; ++i) acc[i] = 0.f;
                if (wave == 0 || wave == 1) {
                    acc = mm32<2>(acc, NT, 40, BTt + 32 * wave * 40, 40, lane); const int k = 32 * wave + t; const float gc = GC[k];
#pragma unroll
                    for (int g4 = 0; g4 < 4; ++g4) { const int s0 = 8 * g4 + 4 * (lane >> 5); float o[4];
#pragma unroll
                        for (int i = 0; i < 4; ++i) o[i] = (acc[4 * g4 + i] + __builtin_bit_cast(float, (unsigned)KT[(s0 + i) * 72 + k] << 16)) * gc;
                        *(LAS u32x2*)(WzT + k * 40 + s0) = (u32x2){cvt_pk_bf16(o[0], o[1]), cvt_pk_bf16(o[2], o[3])}; }
                } else if (wave == 2 || wave == 6) {
                    const int rh = (wave == 6) ? 1 : 0; acc = mm32<2>(acc, A2 + 32 * rh * 40, 40, MbrT, 40, lane);
#pragma unroll
                    for (int g4 = 0; g4 < 4; ++g4) { const int k0 = 32 * rh + 8 * g4 + 4 * (lane >> 5); float o[4]; const u32x2 rv = *(const LAS u32x2*)(RT + t * 72 + k0);
                        o[0] = acc[4 * g4] + bflo(rv.x); o[1] = acc[4 * g4 + 1] + bfhi(rv.x); o[2] = acc[4 * g4 + 2] + bflo(rv.y); o[3] = acc[4 * g4 + 3] + bfhi(rv.y);
                        *(LAS u32x2*)(R2T + t * 72 + k0) = (u32x2){cvt_pk_bf16(o[0], o[1]), cvt_pk_bf16(o[2], o[3])}; }
                } else {
                    if (wave == 3) { accw = mm32<2>(accw, NT, 40, MbrT, 40, lane);
#pragma unroll
                        for (int g4 = 0; g4 < 4; ++g4) { const int s0 = 8 * g4 + 4 * (lane >> 5);
                            *(LAS u32x2*)(WyT + t * 40 + s0) = (u32x2){cvt_pk_bf16(accw[4 * g4], accw[4 * g4 + 1]), cvt_pk_bf16(accw[4 * g4 + 2], accw[4 * g4 + 3])}; } }
                    const int pt = (wave == 3) ? 3 : (wave == 7 ? 2 : wave - 4);
                    const int rh = pt >> 1, ch = pt & 1; acc = mm32<2>(acc, A2 + 32 * rh * 40, 40, BTt + 32 * ch * 40, 40, lane); const int kp = 32 * ch + t; const float gc = GC[kp];
#pragma unroll
                    for (int g4 = 0; g4 < 4; ++g4) { const int k0 = 32 * rh + 8 * g4 + 4 * (lane >> 5);
                        *(LAS u32x2*)(PpT + kp * 72 + k0) = (u32x2){cvt_pk_bf16(acc[4 * g4] * gc, acc[4 * g4 + 1] * gc), cvt_pk_bf16(acc[4 * g4 + 2] * gc, acc[4 * g4 + 3] * gc)}; }
                }
            }
            __syncthreads();
            if (wave < 3) {
                const int t = lane & 31; const LAS bf16_t* Sb = SBF + bi * (32 * 72); f32x16 acc;
#pragma unroll
                for (int i = 0; i < 16; ++i) acc[i] = 0.f;
                if (wave < 2) {
                    acc = mm32<2>(acc, VmT, 40, WzT + 32 * wave * 40, 40, lane);
                    acc = mm32<4>(acc, Sb, 72, PpT + 32 * wave * 72, 72, lane);
                    const float gc = GC[32 * wave + t]; LAS bf16_t* Sn = SBF + (bi ^ 1) * (32 * 72);
#pragma unroll
                    for (int i = 0; i < 16; ++i) { Sacc[i] = fmaf(Sacc[i], gc, acc[i]); Sn[TROW(i, lane) * 72 + 32 * wave + t] = bf1(Sacc[i]); }
                } else {
                    acc = mm32<2>(acc, VmT, 40, WyT, 40, lane);
                    acc = mm32<4>(acc, Sb, 72, R2T, 72, lane);
#pragma unroll
                    for (int i = 0; i < 16; ++i) YST[t * 33 + TROW(i, lane)] = acc[i];
                }
            }
            __syncthreads();
            { const LAS float* ys = YST + pj * 33 + 2 * pq;
                *(f32x2*)(Y + ((size_t)b * SEQ + chunk * 32 + pj) * 512 + h * 64 + 32 * half + 2 * pq) = (f32x2){ys[0], ys[1]}; }
        }
#undef WKV_LOAD
    }
    TSTOP(4);
}


constexpr int STG_R_STRIDE = 10752;
struct WSet { LAS float* CUM; LAS float* PS; LAS bf16_t* AT; LAS bf16_t* BT; LAS bf16_t* KT; LAS bf16_t* RT; LAS bf16_t* BTt; LAS bf16_t* ATt; LAS float* NabT; LAS bf16_t* Nakb; LAS bf16_t* MbrT; LAS bf16_t* Tb; LAS bf16_t* Ut; LAS bf16_t* Wt;
              LAS bf16_t* WyT; LAS bf16_t* WzT; LAS bf16_t* R2T; LAS bf16_t* PpT; LAS float* GC; };
constexpr int WSET_BYTES = 59136;
__device__ __forceinline__ WSet wset(LAS unsigned char* p) {
    WSet s; s.CUM = (LAS float*)p; s.PS = (LAS float*)(p + 8192); s.WyT = (LAS bf16_t*)p; s.WzT = (LAS bf16_t*)(p + 2560);
    s.AT = (LAS bf16_t*)(p + 10240); s.BT = (LAS bf16_t*)(p + 14848); s.PpT = (LAS bf16_t*)(p + 10240); s.KT = (LAS bf16_t*)(p + 19456); s.RT = (LAS bf16_t*)(p + 24064);
    s.BTt = (LAS bf16_t*)(p + 28672); s.ATt = (LAS bf16_t*)(p + 33792); s.NabT = (LAS float*)(p + 38912); s.R2T = (LAS bf16_t*)(p + 38912); s.Nakb = (LAS bf16_t*)(p + 43520); s.MbrT = (LAS bf16_t*)(p + 46080);
    s.Tb = (LAS bf16_t*)(p + 48640); s.Ut = (LAS bf16_t*)(p + 51200); s.Wt = (LAS bf16_t*)(p + 53760); s.GC = (LAS float*)(p + 58880); return s;
}
struct WRaw { u32x2 rc, rp, kc, kp, e4, a4; };
__device__ __forceinline__ void w5_load(WRaw& w, const bf16_t* COLS, const bf16_t* LORA, int b, int chunk, int pj, int hc) {
    const int s_ = chunk * 32 + pj; const size_t t_ = (size_t)b * SEQ + s_; const bf16_t* cb_ = COLS + t_ * INC + hc; const u32x2 z = (u32x2){0u, 0u};
    w.rc = *(const u32x2*)(cb_ + C_R); w.kc = *(const u32x2*)(cb_ + C_K);
    if (s_ > 0) { w.rp = *(const u32x2*)(cb_ - INC + C_R); w.kp = *(const u32x2*)(cb_ - INC + C_K); } else { w.rp = z; w.kp = z; }
    w.e4 = *(const u32x2*)(LORA + t_ * 1536 + hc); w.a4 = *(const u32x2*)(LORA + t_ * 1536 + 512 + hc);
}
struct WConst { f32x4 mur, muk, kk4, ka4, rk4; };
__device__ __forceinline__ void w5_prep_scale(const WConst& cst, const WRaw& w, const WSet& S, float* BON, int b, int h, int chunk, int pj, int pq) {
    float r_[4], rq_[4], k_[4], kq_[4], e_[4], aa_[4], kkn_[4], k2_[4];
    const f32x4 mur = cst.mur, muk = cst.muk, kk4 = cst.kk4, ka4 = cst.ka4, rk4 = cst.rk4;
    unpack4(w.rc, r_); unpack4(w.rp, rq_); unpack4(w.kc, k_); unpack4(w.kp, kq_); unpack4(w.e4, e_); unpack4(w.a4, aa_);
    float ss_ = 0.f, bon_ = 0.f;
#pragma unroll
    for (int i = 0; i < 4; ++i) { r_[i] += (rq_[i] - r_[i]) * mur[i]; k_[i] += (kq_[i] - k_[i]) * muk[i];
        kkn_[i] = k_[i] * kk4[i]; ss_ += kkn_[i] * kkn_[i]; k2_[i] = k_[i] * (1.0f + (aa_[i] - 1.0f) * ka4[i]); bon_ += r_[i] * k2_[i] * rk4[i]; }
    ss_ = row16_sum(ss_); bon_ = row16_sum(bon_); const float inv_ = __builtin_amdgcn_rsqf(fmaxf(ss_, 1e-24f));
    if (pq == 0) BON[((size_t)b * SEQ + chunk * 32 + pj) * 8 + h] = bon_;
    const f32x4 cm = *(const LAS f32x4*)(S.CUM + pj * 64 + 4 * pq); float at_[4], bt_[4], kt_[4], rt_[4], g_[4];
#pragma unroll
    for (int i = 0; i < 4; ++i) { const float kn = kkn_[i] * inv_; const float g = __expf(-cm[i]), ig = __expf(cm[i]), gp = __expf(e_[i] - cm[i]); g_[i] = g;
        at_[i] = -kn * gp; bt_[i] = kn * aa_[i] * ig; kt_[i] = k2_[i] * ig; rt_[i] = r_[i] * g; }
    *(LAS u32x2*)(S.AT + pj * 72 + 4 * pq) = (u32x2){cvt_pk_bf16(at_[0], at_[1]), cvt_pk_bf16(at_[2], at_[3])};
    *(LAS u32x2*)(S.BT + pj * 72 + 4 * pq) = (u32x2){cvt_pk_bf16(bt_[0], bt_[1]), cvt_pk_bf16(bt_[2], bt_[3])};
    *(LAS u32x2*)(S.KT + pj * 72 + 4 * pq) = (u32x2){cvt_pk_bf16(kt_[0], kt_[1]), cvt_pk_bf16(kt_[2], kt_[3])};
    *(LAS u32x2*)(S.RT + pj * 72 + 4 * pq) = (u32x2){cvt_pk_bf16(rt_[0], rt_[1]), cvt_pk_bf16(rt_[2], rt_[3])};
#pragma unroll
    for (int i = 0; i < 4; ++i) { S.BTt[(4 * pq + i) * 40 + pj] = bf1(bt_[i]); S.ATt[(4 * pq + i) * 40 + pj] = bf1(at_[i]); }
    if (pj == 31) *(LAS f32x4*)(S.GC + 4 * pq) = (f32x4){g_[0], g_[1], g_[2], g_[3]};
}
__device__ __forceinline__ void w5_s1(const WSet& S, int tl, f32x16& accw, int lane) {
    f32x16 acc;
#pragma unroll
    for (int i = 0; i < 16; ++i) acc[i] = 0.f;
    const int t = lane & 31, hh = lane >> 5;
    if (tl == 1) {
        acc = mm32<4>(acc, S.AT, 72, S.KT, 72, lane);
#pragma unroll
        for (int g4 = 0; g4 < 4; ++g4) { const int t0 = 8 * g4 + 4 * hh; float o[4];
#pragma unroll
            for (int i = 0; i < 4; ++i) o[i] = (t < t0 + i) ? acc[4 * g4 + i] : 0.f;
            *(LAS u32x2*)(S.Nakb + t * 40 + t0) = (u32x2){cvt_pk_bf16(o[0], o[1]), cvt_pk_bf16(o[2], o[3])}; }
        return;
    }
    acc = mm32<4>(acc, (tl & 1) ? S.KT : S.BT, 72, (tl & 2) ? S.RT : S.AT, 72, lane);
    if (tl == 0) {
#pragma unroll
        for (int g4 = 0; g4 < 4; ++g4) { const int s0 = 8 * g4 + 4 * hh;
#pragma unroll
            for (int i = 0; i < 4; ++i) S.NabT[t * 36 + i * 8 + 2 * g4 + hh] = (s0 + i < t) ? acc[4 * g4 + i] : 0.f; }
    } else if (tl == 2) {
#pragma unroll
        for (int g4 = 0; g4 < 4; ++g4) { const int s0 = 8 * g4 + 4 * hh; float o[4];
#pragma unroll
            for (int i = 0; i < 4; ++i) o[i] = (s0 + i <= t) ? acc[4 * g4 + i] : 0.f;
            *(LAS u32x2*)(S.MbrT + t * 40 + s0) = (u32x2){cvt_pk_bf16(o[0], o[1]), cvt_pk_bf16(o[2], o[3])}; }
    } else {
#pragma unroll
        for (int i = 0; i < 16; ++i) { const int s = TROW(i, lane); accw[i] = (s <= t) ? acc[i] : 0.f; }
    }
}
__device__ __forceinline__ void w5_s2b(const WSet& S, int tl, int lane) {
    f32x16 acc;
#pragma unroll
    for (int i = 0; i < 16; ++i) acc[i] = 0.f;
    const int t = lane & 31, hh = lane >> 5;
    acc = mm32<2>(acc, S.Tb, 40, (tl == 0) ? S.MbrT : (S.BTt + 32 * (tl - 1) * 40), 40, lane);
    LAS bf16_t* o = (tl == 0) ? (S.Ut + t * 40) : (S.Wt + (32 * (tl - 1) + t) * 40);
#pragma unroll
    for (int g4 = 0; g4 < 4; ++g4) { const int s0 = 8 * g4 + 4 * hh;
        *(LAS u32x2*)(o + s0) = (u32x2){cvt_pk_bf16(acc[4 * g4], acc[4 * g4 + 1]), cvt_pk_bf16(acc[4 * g4 + 2], acc[4 * g4 + 3])}; }
}
__device__ __forceinline__ void w5_s3(const WSet& S, int role, f32x16& accw, int lane) {
    const int t = lane & 31, hh = lane >> 5; f32x16 acc;
#pragma unroll
    for (int i = 0; i < 16; ++i) acc[i] = 0.f;
    if (role == 0 || role == 1) {
        acc = mm32<2>(acc, S.Nakb, 40, S.Wt + 32 * role * 40, 40, lane); const int k = 32 * role + t; const float gc = S.GC[k];
#pragma unroll
        for (int g4 = 0; g4 < 4; ++g4) { const int s0 = 8 * g4 + 4 * hh; float o[4];
#pragma unroll
            for (int i = 0; i < 4; ++i) o[i] = (acc[4 * g4 + i] + __builtin_bit_cast(float, (unsigned)S.KT[(s0 + i) * 72 + k] << 16)) * gc;
            *(LAS u32x2*)(S.WzT + k * 40 + s0) = (u32x2){cvt_pk_bf16(o[0], o[1]), cvt_pk_bf16(o[2], o[3])}; }
    } else if (role == 2 || role == 6) {
        const int rh = (role == 6) ? 1 : 0; acc = mm32<2>(acc, S.ATt + 32 * rh * 40, 40, S.Ut, 40, lane);
#pragma unroll
        for (int g4 = 0; g4 < 4; ++g4) { const int k0 = 32 * rh + 8 * g4 + 4 * hh; float o[4]; const u32x2 rv = *(const LAS u32x2*)(S.RT + t * 72 + k0);
            o[0] = acc[4 * g4] + bflo(rv.x); o[1] = acc[4 * g4 + 1] + bfhi(rv.x); o[2] = acc[4 * g4 + 2] + bflo(rv.y); o[3] = acc[4 * g4 + 3] + bfhi(rv.y);
            *(LAS u32x2*)(S.R2T + t * 72 + k0) = (u32x2){cvt_pk_bf16(o[0], o[1]), cvt_pk_bf16(o[2], o[3])}; }
    } else {
        if (role == 3) { accw = mm32<2>(accw, S.Nakb, 40, S.Ut, 40, lane);
#pragma unroll
            for (int g4 = 0; g4 < 4; ++g4) { const int s0 = 8 * g4 + 4 * hh;
                *(LAS u32x2*)(S.WyT + t * 40 + s0) = (u32x2){cvt_pk_bf16(accw[4 * g4], accw[4 * g4 + 1]), cvt_pk_bf16(accw[4 * g4 + 2], accw[4 * g4 + 3])}; } }
        const int pt = (role == 3) ? 3 : (role == 7 ? 2 : role - 4);
        const int rh = pt >> 1, ch = pt & 1; acc = mm32<2>(acc, S.ATt + 32 * rh * 40, 40, S.Wt + 32 * ch * 40, 40, lane); const int kp = 32 * ch + t; const float gc = S.GC[kp];
#pragma unroll
        for (int g4 = 0; g4 < 4; ++g4) { const int k0 = 32 * rh + 8 * g4 + 4 * hh;
            *(LAS u32x2*)(S.PpT + kp * 72 + k0) = (u32x2){cvt_pk_bf16(acc[4 * g4] * gc, acc[4 * g4 + 1] * gc), cvt_pk_bf16(acc[4 * g4 + 2] * gc, acc[4 * g4 + 3] * gc)}; }
    }
}
__device__ __forceinline__ void w5_copyout(const WSet& S, unsigned char* gr, unsigned char* gp, int tid) {
    { const int row = tid >> 3, pc = tid & 7; *(u32x4*)(gp + row * 128 + pc * 16) = *(const LAS u32x4*)((const LAS unsigned char*)S.PpT + row * 144 + pc * 16); }
    if (tid < 256) { const int row = tid >> 3, pc = tid & 7; *(u32x4*)(gr + row * 128 + pc * 16) = *(const LAS u32x4*)((const LAS unsigned char*)S.R2T + row * 144 + pc * 16); }
    else { const int u = tid - 256, row = u >> 2, pc = u & 3; *(u32x4*)(gr + 4096 + row * 64 + pc * 16) = *(const LAS u32x4*)((const LAS unsigned char*)S.WzT + row * 80 + pc * 16); }
    if (tid < 128) { const int row = tid >> 2, pc = tid & 3; *(u32x4*)(gr + 8192 + row * 64 + pc * 16) = *(const LAS u32x4*)((const LAS unsigned char*)S.WyT + row * 80 + pc * 16); }
    else if (tid < 144) { const int pc = tid - 128; *(u32x4*)(gr + 10240 + pc * 16) = *(const LAS u32x4*)((const LAS unsigned char*)S.GC + pc * 16); }
}
__device__ __forceinline__ void wkv5a2(const Args& a, LAS unsigned char* lds, const int round) {
    const int tid = threadIdx.x, wave = __builtin_amdgcn_readfirstlane(tid >> 6);
    unsigned char* ws = a.ws;
    const bf16_t* COLS = (const bf16_t*)(ws + WS_A); const bf16_t* LORA = (const bf16_t*)a.out; float* BON = (float*)(ws + WS_BON);
    unsigned char* STG_R = ws + WS_RWKV; unsigned char* STG_P = (unsigned char*)a.out + 96 * MiB;
    const WSet SA = wset(lds), SB = wset(lds + WSET_BYTES);
    for (int item = blockIdx.x; item < 256; item += gridDim.x) {
        const int bh = item >> 1, sub = item & 1, b = bh >> 3, h = bh & 7;
        const int chunk0 = 32 * round + 16 * sub, chunk_end = chunk0 + 16;
        WRaw wa, wb; WConst cst;
        { const int hc0 = h * 64 + 4 * (tid & 15); cst.mur = *(const f32x4*)(a.in[I_MU] + C_R + hc0); cst.muk = *(const f32x4*)(a.in[I_MU] + C_K + hc0);
          cst.kk4 = *(const f32x4*)(a.in[I_KK] + hc0); cst.ka4 = *(const f32x4*)(a.in[I_KA] + hc0); cst.rk4 = *(const f32x4*)(a.in[I_RK] + hc0); }
        w5_load(wa, COLS, LORA, b, chunk0, tid >> 4, h * 64 + 4 * (tid & 15)); w5_load(wb, COLS, LORA, b, chunk0 + 1, tid >> 4, h * 64 + 4 * (tid & 15));
        __syncthreads();
        for (int chunk = chunk0; chunk < chunk_end; chunk += 2) {
            int tid_l = tid; asm volatile("" : "+v"(tid_l));
            const int lane = tid_l & 63, pj = tid_l >> 4, pq = tid_l & 15, tid = tid_l, hc = h * 64 + 4 * pq; (void)tid;
            { float e_[4]; unpack4(wa.e4, e_); *(LAS f32x4*)(SA.CUM + pj * 64 + 4 * pq) = (f32x4){e_[0], e_[1], e_[2], e_[3]};
              unpack4(wb.e4, e_); *(LAS f32x4*)(SB.CUM + pj * 64 + 4 * pq) = (f32x4){e_[0], e_[1], e_[2], e_[3]}; }
            __syncthreads();
            {
                const int col = tid & 63, qd = tid >> 6;
                float p0 = SA.CUM[(4 * qd) * 64 + col], p1 = SA.CUM[(4 * qd + 1) * 64 + col], p2 = SA.CUM[(4 * qd + 2) * 64 + col], p3 = SA.CUM[(4 * qd + 3) * 64 + col];
                float q0 = SB.CUM[(4 * qd) * 64 + col], q1 = SB.CUM[(4 * qd + 1) * 64 + col], q2 = SB.CUM[(4 * qd + 2) * 64 + col], q3 = SB.CUM[(4 * qd + 3) * 64 + col];
                p1 += p0; p2 += p1; p3 += p2; SA.PS[qd * 64 + col] = p3; q1 += q0; q2 += q1; q3 += q2; SB.PS[qd * 64 + col] = q3;
                __syncthreads();
                float ba = 0.f, bb = 0.f;
#pragma unroll
                for (int q2_ = 0; q2_ < 7; ++q2_) { ba += (q2_ < qd) ? SA.PS[q2_ * 64 + col] : 0.f; bb += (q2_ < qd) ? SB.PS[q2_ * 64 + col] : 0.f; }
                SA.CUM[(4 * qd) * 64 + col] = ba + p0; SA.CUM[(4 * qd + 1) * 64 + col] = ba + p1; SA.CUM[(4 * qd + 2) * 64 + col] = ba + p2; SA.CUM[(4 * qd + 3) * 64 + col] = ba + p3;
                SB.CUM[(4 * qd) * 64 + col] = bb + q0; SB.CUM[(4 * qd + 1) * 64 + col] = bb + q1; SB.CUM[(4 * qd + 2) * 64 + col] = bb + q2; SB.CUM[(4 * qd + 3) * 64 + col] = bb + q3; }
            __syncthreads();
            w5_prep_scale(cst, wa, SA, BON, b, h, chunk, pj, pq);
            w5_prep_scale(cst, wb, SB, BON, b, h, chunk + 1, pj, pq);
            if (chunk + 2 < chunk_end) { w5_load(wa, COLS, LORA, b, chunk + 2, pj, hc); w5_load(wb, COLS, LORA, b, chunk + 3, pj, hc); }
            __syncthreads();
            f32x16 accw;
#pragma unroll
            for (int i = 0; i < 16; ++i) accw[i] = 0.f;
            if (wave < 4) w5_s1(SA, wave, accw, lane); else w5_s1(SB, wave - 4, accw, lane);
            __syncthreads();
            if (wave < 4) {
                const WSet& S_ = (wave >= 2) ? SB : SA;
                const int q = lane & 3, rowi = ((wave & 1) * 64 + lane) >> 2;
                float xq0, xq1, xq2, xq3, xq4, xq5, xq6, xq7;
                xq0 = (0 + q == rowi) ? 1.0f : 0.0f;
                xq1 = (4 + q == rowi) ? 1.0f : 0.0f;
                xq2 = (8 + q == rowi) ? 1.0f : 0.0f;
                xq3 = (12 + q == rowi) ? 1.0f : 0.0f;
                xq4 = (16 + q == rowi) ? 1.0f : 0.0f;
                xq5 = (20 + q == rowi) ? 1.0f : 0.0f;
                xq6 = (24 + q == rowi) ? 1.0f : 0.0f;
                xq7 = (28 + q == rowi) ? 1.0f : 0.0f;
                const bool kq0 = q == 0, kq1 = q == 1, kq2 = q == 2, kq3 = q == 3;
                const LAS float* np_ = S_.NabT + q * 8;
                f32x4 n1_0, n2_0, n3_0, n4_0, n5_0, n6_0, n7_0, n8_0, n9_0, n10_0, n11_0, n12_0, n13_0, n14_0, n15_0, n16_0, n17_0, n17_1, n18_0, n18_1, n19_0, n19_1, n20_0, n20_1, n21_0, n21_1, n22_0, n22_1, n23_0, n23_1, n24_0, n24_1, n25_0, n25_1, n26_0, n26_1, n27_0, n27_1, n28_0, n28_1, n29_0, n29_1, n30_0, n30_1, n31_0, n31_1;
                float pe1, pe2, pe3, pe4, pe5, pe6, pe7, pe8, pe9, pe10, pe11, pe12, pe13, pe14, pe15, pe16, pe17, pe18, pe19, pe20, pe21, pe22, pe23, pe24, pe25, pe26, pe27, pe28, pe29, pe30, pe31, pe32;
                n1_0 = *(const LAS f32x4*)(np_ + 1 * 36); n2_0 = *(const LAS f32x4*)(np_ + 2 * 36); pe1 = 0.f;
                { n3_0 = *(const LAS f32x4*)(np_ + 3 * 36); float p = pe1; asm("v_fmac_f32 %0, %1, %2" : "+v"(p) : "v"(xq0), "v"(n1_0[0])); p += dpp_f(p, 0); pe2 = 0.f; p += dpp_f(p, 1); xq0 = kq1 ? (xq0 + p) : xq0; asm volatile("" : "+v"(xq0), "+v"(np_) : "v"(n1_0)); }
                { n4_0 = *(const LAS f32x4*)(np_ + 4 * 36); float p = pe2; asm("v_fmac_f32 %0, %1, %2" : "+v"(p) : "v"(xq0), "v"(n2_0[0])); p += dpp_f(p, 0); pe3 = 0.f; p += dpp_f(p, 1); xq0 = kq2 ? (xq0 + p) : xq0; asm volatile("" : "+v"(xq0), "+v"(np_) : "v"(n2_0)); }
                { n5_0 = *(const LAS f32x4*)(np_ + 5 * 36); float p = pe3; asm("v_fmac_f32 %0, %1, %2" : "+v"(p) : "v"(xq0), "v"(n3_0[0])); p += dpp_f(p, 0); pe4 = 0.f; p += dpp_f(p, 1); xq0 = kq3 ? (xq0 + p) : xq0; asm volatile("" : "+v"(xq0), "+v"(np_) : "v"(n3_0)); }
                { n6_0 = *(const LAS f32x4*)(np_ + 6 * 36); float p = pe4; asm("v_fmac_f32 %0, %1, %2" : "+v"(p) : "v"(xq0), "v"(n4_0[0])); p += dpp_f(p, 0); pe5 = 0.f; asm("v_fmac_f32 %0, %1, %2" : "+v"(pe5) : "v"(xq0), "v"(n5_0[0])); p += dpp_f(p, 1); xq1 = kq0 ? (xq1 + p) : xq1; asm volatile("" : "+v"(xq1), "+v"(np_) : "v"(n4_0)); }
                { n7_0 = *(const LAS f32x4*)(np_ + 7 * 36); float p = pe5; asm("v_fmac_f32 %0, %1, %2" : "+v"(p) : "v"(xq1), "v"(n5_0[1])); p += dpp_f(p, 0); pe6 = 0.f; asm("v_fmac_f32 %0, %1, %2" : "+v"(pe6) : "v"(xq0), "v"(n6_0[0])); p += dpp_f(p, 1); xq1 = kq1 ? (xq1 + p) : xq1; asm volatile("" : "+v"(xq1), "+v"(np_) : "v"(n5_0)); }
                { n8_0 = *(const LAS f32x4*)(np_ + 8 * 36); float p = pe6; asm("v_fmac_f32 %0, %1, %2" : "+v"(p) : "v"(xq1), "v"(n6_0[1])); p += dpp_f(p, 0); pe7 = 0.f; asm("v_fmac_f32 %0, %1, %2" : "+v"(pe7) : "v"(xq0), "v"(n7_0[0])); p += dpp_f(p, 1); xq1 = kq2 ? (xq1 + p) : xq1; asm volatile("" : "+v"(xq1), "+v"(np_) : "v"(n6_0)); }
                { n9_0 = *(const LAS f32x4*)(np_ + 9 * 36); float p = pe7; asm("v_fmac_f32 %0, %1, %2" : "+v"(p) : "v"(xq1), "v"(n7_0[1])); p += dpp_f(p, 0); pe8 = 0.f; asm("v_fmac_f32 %0, %1, %2" : "+v"(pe8) : "v"(xq0), "v"(n8_0[0])); p += dpp_f(p, 1); xq1 = kq3 ? (xq1 + p) : xq1; asm volatile("" : "+v"(xq1), "+v"(np_) : "v"(n7_0)); }
                { n10_0 = *(const LAS f32x4*)(np_ + 10 * 36); float p = pe8; asm("v_fmac_f32 %0, %1, %2" : "+v"(p) : "v"(xq1), "v"(n8_0[1])); p += dpp_f(p, 0); pe9 = 0.f; asm("v_fmac_f32 %0, %1, %2" : "+v"(pe9) : "v"(xq0), "v"(n9_0[0])); asm("v_fmac_f32 %0, %1, %2" : "+v"(pe9) : "v"(xq1), "v"(n9_0[1])); p += dpp_f(p, 1); xq2 = kq0 ? (xq2 + p) : xq2; asm volatile("" : "+v"(xq2), "+v"(np_) : "v"(n8_0)); }
                { n11_0 = *(const LAS f32x4*)(np_ + 11 * 36); float p = pe9; asm("v_fmac_f32 %0, %1, %2" : "+v"(p) : "v"(xq2), "v"(n9_0[2])); p += dpp_f(p, 0); pe10 = 0.f; asm("v_fmac_f32 %0, %1, %2" : "+v"(pe10) : "v"(xq0), "v"(n10_0[0])); asm("v_fmac_f32 %0, %1, %2" : "+v"(pe10) : "v"(xq1), "v"(n10_0[1])); p += dpp_f(p, 1); xq2 = kq1 ? (xq2 + p) : xq2; asm volatile("" : "+v"(xq2), "+v"(np_) : "v"(n9_0)); }
                { n12_0 = *(const LAS f32x4*)(np_ + 12 * 36); float p = pe10; asm("v_fmac_f32 %0, %1, %2" : "+v"(p) : "v"(xq2), "v"(n10_0[2])); p += dpp_f(p, 0); pe11 = 0.f; asm("v_fmac_f32 %0, %1, %2" : "+v"(pe11) : "v"(xq0), "v"(n11_0[0])); asm("v_fmac_f32 %0, %1, %2" : "+v"(pe11) : "v"(xq1), "v"(n11_0[1])); p += dpp_f(p, 1); xq2 = kq2 ? (xq2 + p) : xq2; asm volatile("" : "+v"(xq2), "+v"(np_) : "v"(n10_0)); }
                { n13_0 = *(const LAS f32x4*)(np_ + 13 * 36); float p = pe11; asm("v_fmac_f32 %0, %1, %2" : "+v"(p) : "v"(xq2), "v"(n11_0[2])); p += dpp_f(p, 0); pe12 = 0.f; asm("v_fmac_f32 %0, %1, %2" : "+v"(pe12) : "v"(xq0), "v"(n12_0[0])); asm("v_fmac_f32 %0, %1, %2" : "+v"(pe12) : "v"(xq1), "v"(n12_0[1])); p += dpp_f(p, 1); xq2 = kq3 ? (xq2 + p) : xq2; asm volatile("" : "+v"(xq2), "+v"(np_) : "v"(n11_0)); }
                { n14_0 = *(const LAS f32x4*)(np_ + 14 * 36); float p = pe12; asm("v_fmac_f32 %0, %1, %2" : "+v"(p) : "v"(xq2), "v"(n12_0[2])); p += dpp_f(p, 0); pe13 = 0.f; asm("v_fmac_f32 %0, %1, %2" : "+v"(pe13) : "v"(xq0), "v"(n13_0[0])); asm("v_fmac_f32 %0, %1, %2" : "+v"(pe13) : "v"(xq1), "v"(n13_0[1])); asm("v_fmac_f32 %0, %1, %2" : "+v"(pe13) : "v"(xq2), "v"(n13_0[2])); p += dpp_f(p, 1); xq3 = kq0 ? (xq3 + p) : xq3; asm volatile("" : "+v"(xq3), "+v"(np_) : "v"(n12_0)); }
                { n15_0 = *(const LAS f32x4*)(np_ + 15 * 36); float p = pe13; asm("v_fmac_f32 %0, %1, %2" : "+v"(p) : "v"(xq3), "v"(n13_0[3])); p += dpp_f(p, 0); pe14 = 0.f; asm("v_fmac_f32 %0, %1, %2" : "+v"(pe14) : "v"(xq0), "v"(n14_0[0])); asm("v_fmac_f32 %0, %1, %2" : "+v"(pe14) : "v"(xq1), "v"(n14_0[1])); asm("v_fmac_f32 %0, %1, %2" : "+v"(pe14) : "v"(xq2), "v"(n14_0[2])); p += dpp_f(p, 1); xq3 = kq1 ? (xq3 + p) : xq3; asm volatile("" : "+v"(xq3), "+v"(np_) : "v"(n13_0)); }
                { n16_0 = *(const LAS f32x4*)(np_ + 16 * 36); float p = pe14; asm("v_fmac_f32 %0, %1, %2" : "+v"(p) : "v"(xq3), "v"(n14_0[3])); p += dpp_f(p, 0); pe15 = 0.f; asm("v_fmac_f32 %0, %1, %2" : "+v"(pe15) : "v"(xq0), "v"(n15_0[0])); asm("v_fmac_f32 %0, %1, %2" : "+v"(pe15) : "v"(xq1), "v"(n15_0[1])); asm("v_fmac_f32 %0, %1, %2" : "+v"(pe15) : "v"(xq2), "v"(n15_0[2])); p += dpp_f(p, 1); xq3 = kq2 ? (xq3 + p) : xq3; asm volatile("" : "+v"(xq3), "+v"(np_) : "v"(n14_0)); }
                { n17_0 = *(const LAS f32x4*)(np_ + 17 * 36); n17_1 = *(const LAS f32x4*)(np_ + 17 * 36 + 4); float p = pe15; asm("v_fmac_f32 %0, %1, %2" : "+v"(p) : "v"(xq3), "v"(n15_0[3])); p += dpp_f(p, 0); pe16 = 0.f; asm("v_fmac_f32 %0, %1, %2" : "+v"(pe16) : "v"(xq0), "v"(n16_0[0])); asm("v_fmac_f32 %0, %1, %2" : "+v"(pe16) : "v"(xq1), "v"(n16_0[1])); asm("v_fmac_f32 %0, %1, %2" : "+v"(pe16) : "v"(xq2), "v"(n16_0[2])); p += dpp_f(p, 1); xq3 = kq3 ? (xq3 + p) : xq3; asm volatile("" : "+v"(xq3), "+v"(np_) : "v"(n15_0)); }
                { n18_0 = *(const LAS f32x4*)(np_ + 18 * 36); n18_1 = *(const LAS f32x4*)(np_ + 18 * 36 + 4); float p = pe16; asm("v_fmac_f32 %0, %1, %2" : "+v"(p) : "v"(xq3), "v"(n16_0[3])); p += dpp_f(p, 0); pe17 = 0.f; asm("v_fmac_f32 %0, %1, %2" : "+v"(pe17) : "v"(xq0), "v"(n17_0[0])); asm("v_fmac_f32 %0, %1, %2" : "+v"(pe17) : "v"(xq1), "v"(n17_0[1])); asm("v_fmac_f32 %0, %1, %2" : "+v"(pe17) : "v"(xq2), "v"(n17_0[2])); asm("v_fmac_f32 %0, %1, %2" : "+v"(pe17) : "v"(xq3), "v"(n17_0[3])); p += dpp_f(p, 1); xq4 = kq0 ? (xq4 + p) : xq4; asm volatile("" : "+v"(xq4), "+v"(np_) : "v"(n16_0)); }
                { n19_0 = *(const LAS f32x4*)(np_ + 19 * 36); n19_1 = *(const LAS f32x4*)(np_ + 19 * 36 + 4); float p = pe17; asm("v_fmac_f32 %0, %1, %2" : "+v"(p) : "v"(xq4), "v"(n17_1[0])); p += dpp_f(p, 0); pe18 = 0.f; asm("v_fmac_f32 %0, %1, %2" : "+v"(pe18) : "v"(xq0), "v"(n18_0[0])); asm("v_fmac_f32 %0, %1, %2" : "+v"(pe18) : "v"(xq1), "v"(n18_0[1])); asm("v_fmac_f32 %0, %1, %2" : "+v"(pe18) : "v"(xq2), "v"(n18_0[2])); asm("v_fmac_f32 %0, %1, %2" : "+v"(pe18) : "v"(xq3), "v"(n18_0[3])); p += dpp_f(p, 1); xq4 = kq1 ? (xq4 + p) : xq4; asm volatile("" : "+v"(xq4), "+v"(np_) : "v"(n17_0), "v"(n17_1)); }
                { n20_0 = *(const LAS f32x4*)(np_ + 20 * 36); n20_1 = *(const LAS f32x4*)(np_ + 20 * 36 + 4); float p = pe18; asm("v_fmac_f32 %0, %1, %2" : "+v"(p) : "v"(xq4), "v"(n18_1[0])); p += dpp_f(p, 0); pe19 = 0.f; asm("v_fmac_f32 %0, %1, %2" : "+v"(pe19) : "v"(xq0), "v"(n19_0[0])); asm("v_fmac_f32 %0, %1, %2" : "+v"(pe19) : "v"(xq1), "v"(n19_0[1])); asm("v_fmac_f32 %0, %1, %2" : "+v"(pe19) : "v"(xq2), "v"(n19_0[2])); asm("v_fmac_f32 %0, %1, %2" : "+v"(pe19) : "v"(xq3), "v"(n19_0[3])); p += dpp_f(p, 1); xq4 = kq2 ? (xq4 + p) : xq4; asm volatile("" : "+v"(xq4), "+v"(np_) : "v"(n18_0), "v"(n18_1)); }
                { n21_0 = *(const LAS f32x4*)(np_ + 21 * 36); n21_1 = *(const LAS f32x4*)(np_ + 21 * 36 + 4); float p = pe19; asm("v_fmac_f32 %0, %1, %2" : "+v"(p) : "v"(xq4), "v"(n19_1[0])); p += dpp_f(p, 0); pe20 = 0.f; asm("v_fmac_f32 %0, %1, %2" : "+v"(pe20) : "v"(xq0), "v"(n20_0[0])); asm("v_fmac_f32 %0, %1, %2" : "+v"(pe20) : "v"(xq1), "v"(n20_0[1])); asm("v_fmac_f32 %0, %1, %2" : "+v"(pe20) : "v"(xq2), "v"(n20_0[2])); asm("v_fmac_f32 %0, %1, %2" : "+v"(pe20) : "v"(xq3), "v"(n20_0[3])); p += dpp_f(p, 1); xq4 = kq3 ? (xq4 + p) : xq4; asm volatile("" : "+v"(xq4), "+v"(np_) : "v"(n19_0), "v"(n19_1)); }
                { n22_0 = *(const LAS f32x4*)(np_ + 22 * 36); n22_1 = *(const LAS f32x4*)(np_ + 22 * 36 + 4); float p = pe20; asm("v_fmac_f32 %0, %1, %2" : "+v"(p) : "v"(xq4), "v"(n20_1[0])); p += dpp_f(p, 0); pe21 = 0.f; asm("v_fmac_f32 %0, %1, %2" : "+v"(pe21) : "v"(xq0), "v"(n21_0[0])); asm("v_fmac_f32 %0, %1, %2" : "+v"(pe21) : "v"(xq1), "v"(n21_0[1])); asm("v_fmac_f32 %0, %1, %2" : "+v"(pe21) : "v"(xq2), "v"(n21_0[2])); asm("v_fmac_f32 %0, %1, %2" : "+v"(pe21) : "v"(xq3), "v"(n21_0[3])); asm("v_fmac_f32 %0, %1, %2" : "+v"(pe21) : "v"(xq4), "v"(n21_1[0])); p += dpp_f(p, 1); xq5 = kq0 ? (xq5 + p) : xq5; asm volatile("" : "+v"(xq5), "+v"(np_) : "v"(n20_0), "v"(n20_1)); }
                { n23_0 = *(const LAS f32x4*)(np_ + 23 * 36); n23_1 = *(const LAS f32x4*)(np_ + 23 * 36 + 4); float p = pe21; asm("v_fmac_f32 %0, %1, %2" : "+v"(p) : "v"(xq5), "v"(n21_1[1])); p += dpp_f(p, 0); pe22 = 0.f; asm("v_fmac_f32 %0, %1, %2" : "+v"(pe22) : "v"(xq0), "v"(n22_0[0])); asm("v_fmac_f32 %0, %1, %2" : "+v"(pe22) : "v"(xq1), "v"(n22_0[1])); asm("v_fmac_f32 %0, %1, %2" : "+v"(pe22) : "v"(xq2), "v"(n22_0[2])); asm("v_fmac_f32 %0, %1, %2" : "+v"(pe22) : "v"(xq3), "v"(n22_0[3])); asm("v_fmac_f32 %0, %1, %2" : "+v"(pe22) : "v"(xq4), "v"(n22_1[0])); p += dpp_f(p, 1); xq5 = kq1 ? (xq5 + p) : xq5; asm volatile("" : "+v"(xq5), "+v"(np_) : "v"(n21_0), "v"(n21_1)); }
                { n24_0 = *(const LAS f32x4*)(np_ + 24 * 36); n24_1 = *(const LAS f32x4*)(np_ + 24 * 36 + 4); float p = pe22; asm("v_fmac_f32 %0, %1, %2" : "+v"(p) : "v"(xq5), "v"(n22_1[1])); p += dpp_f(p, 0); pe23 = 0.f; asm("v_fmac_f32 %0, %1, %2" : "+v"(pe23) : "v"(xq0), "v"(n23_0[0])); asm("v_fmac_f32 %0, %1, %2" : "+v"(pe23) : "v"(xq1), "v"(n23_0[1])); asm("v_fmac_f32 %0, %1, %2" : "+v"(pe23) : "v"(xq2), "v"(n23_0[2])); asm("v_fmac_f32 %0, %1, %2" : "+v"(pe23) : "v"(xq3), "v"(n23_0[3])); asm("v_fmac_f32 %0, %1, %2" : "+v"(pe23) : "v"(xq4), "v"(n23_1[0])); p += dpp_f(p, 1); xq5 = kq2 ? (xq5 + p) : xq5; asm volatile("" : "+v"(xq5), "+v"(np_) : "v"(n22_0), "v"(n22_1)); }
                { n25_0 = *(const LAS f32x4*)(np_ + 25 * 36); n25_1 = *(const LAS f32x4*)(np_ + 25 * 36 + 4); float p = pe23; asm("v_fmac_f32 %0, %1, %2" : "+v"(p) : "v"(xq5), "v"(n23_1[1])); p += dpp_f(p, 0); pe24 = 0.f; asm("v_fmac_f32 %0, %1, %2" : "+v"(pe24) : "v"(xq0), "v"(n24_0[0])); asm("v_fmac_f32 %0, %1, %2" : "+v"(pe24) : "v"(xq1), "v"(n24_0[1])); asm("v_fmac_f32 %0, %1, %2" : "+v"(pe24) : "v"(xq2), "v"(n24_0[2])); asm("v_fmac_f32 %0, %1, %2" : "+v"(pe24) : "v"(xq3), "v"(n24_0[3])); asm("v_fmac_f32 %0, %1, %2" : "+v"(pe24) : "v"(xq4), "v"(n24_1[0])); p += dpp_f(p, 1); xq5 = kq3 ? (xq5 + p) : xq5; asm volatile("" : "+v"(xq5), "+v"(np_) : "v"(n23_0), "v"(n23_1)); }
                { n26_0 = *(const LAS f32x4*)(np_ + 26 * 36); n26_1 = *(const LAS f32x4*)(np_ + 26 * 36 + 4); float p = pe24; asm("v_fmac_f32 %0, %1, %2" : "+v"(p) : "v"(xq5), "v"(n24_1[1])); p += dpp_f(p, 0); pe25 = 0.f; asm("v_fmac_f32 %0, %1, %2" : "+v"(pe25) : "v"(xq0), "v"(n25_0[0])); asm("v_fmac_f32 %0, %1, %2" : "+v"(pe25) : "v"(xq1), "v"(n25_0[1])); asm("v_fmac_f32 %0, %1, %2" : "+v"(pe25) : "v"(xq2), "v"(n25_0[2])); asm("v_fmac_f32 %0, %1, %2" : "+v"(pe25) : "v"(xq3), "v"(n25_0[3])); asm("v_fmac_f32 %0, %1, %2" : "+v"(pe25) : "v"(xq4), "v"(n25_1[0])); asm("v_fmac_f32 %0, %1, %2" : "+v"(pe25) : "v"(xq5), "v"(n25_1[1])); p += dpp_f(p, 1); xq6 = kq0 ? (xq6 + p) : xq6; asm volatile("" : "+v"(xq6), "+v"(np_) : "v"(n24_0), "v"(n24_1)); }
                { n27_0 = *(const LAS f32x4*)(np_ + 27 * 36); n27_1 = *(const LAS f32x4*)(np_ + 27 * 36 + 4); float p = pe25; asm("v_fmac_f32 %0, %1, %2" : "+v"(p) : "v"(xq6), "v"(n25_1[2])); p += dpp_f(p, 0); pe26 = 0.f; asm("v_fmac_f32 %0, %1, %2" : "+v"(pe26) : "v"(xq0), "v"(n26_0[0])); asm("v_fmac_f32 %0, %1, %2" : "+v"(pe26) : "v"(xq1), "v"(n26_0[1])); asm("v_fmac_f32 %0, %1, %2" : "+v"(pe26) : "v"(xq2), "v"(n26_0[2])); asm("v_fmac_f32 %0, %1, %2" : "+v"(pe26) : "v"(xq3), "v"(n26_0[3])); asm("v_fmac_f32 %0, %1, %2" : "+v"(pe26) : "v"(xq4), "v"(n26_1[0])); asm("v_fmac_f32 %0, %1, %2" : "+v"(pe26) : "v"(xq5), "v"(n26_1[1])); p += dpp_f(p, 1); xq6 = kq1 ? (xq6 + p) : xq6; asm volatile("" : "+v"(xq6), "+v"(np_) : "v"(n25_0), "v"(n25_1)); }
                { n28_0 = *(const LAS f32x4*)(np_ + 28 * 36); n28_1 = *(const LAS f32x4*)(np_ + 28 * 36 + 4); float p = pe26; asm("v_fmac_f32 %0, %1, %2" : "+v"(p) : "v"(xq6), "v"(n26_1[2])); p += dpp_f(p, 0); pe27 = 0.f; asm("v_fmac_f32 %0, %1, %2" : "+v"(pe27) : "v"(xq0), "v"(n27_0[0])); asm("v_fmac_f32 %0, %1, %2" : "+v"(pe27) : "v"(xq1), "v"(n27_0[1])); asm("v_fmac_f32 %0, %1, %2" : "+v"(pe27) : "v"(xq2), "v"(n27_0[2])); asm("v_fmac_f32 %0, %1, %2" : "+v"(pe27) : "v"(xq3), "v"(n27_0[3])); asm("v_fmac_f32 %0, %1, %2" : "+v"(pe27) : "v"(xq4), "v"(n27_1[0])); asm("v_fmac_f32 %0, %1, %2" : "+v"(pe27) : "v"(xq5), "v"(n27_1[1])); p += dpp_f(p, 1); xq6 = kq2 ? (xq6 + p) : xq6; asm volatile("" : "+v"(xq6), "+v"(np_) : "v"(n26_0), "v"(n26_1)); }
                { n29_0 = *(const LAS f32x4*)(np_ + 29 * 36); n29_1 = *(const LAS f32x4*)(np_ + 29 * 36 + 4); float p = pe27; asm("v_fmac_f32 %0, %1, %2" : "+v"(p) : "v"(xq6), "v"(n27_1[2])); p += dpp_f(p, 0); pe28 = 0.f; asm("v_fmac_f32 %0, %1, %2" : "+v"(pe28) : "v"(xq0), "v"(n28_0[0])); asm("v_fmac_f32 %0, %1, %2" : "+v"(pe28) : "v"(xq1), "v"(n28_0[1])); asm("v_fmac_f32 %0, %1, %2" : "+v"(pe28) : "v"(xq2), "v"(n28_0[2])); asm("v_fmac_f32 %0, %1, %2" : "+v"(pe28) : "v"(xq3), "v"(n28_0[3])); asm("v_fmac_f32 %0, %1, %2" : "+v"(pe28) : "v"(xq4), "v"(n28_1[0])); asm("v_fmac_f32 %0, %1, %2" : "+v"(pe28) : "v"(xq5), "v"(n28_1[1])); p += dpp_f(p, 1); xq6 = kq3 ? (xq6 + p) : xq6; asm volatile("" : "+v"(xq6), "+v"(np_) : "v"(n27_0), "v"(n27_1)); }
                { n30_0 = *(const LAS f32x4*)(np_ + 30 * 36); n30_1 = *(const LAS f32x4*)(np_ + 30 * 36 + 4); float p = pe28; asm("v_fmac_f32 %0, %1, %2" : "+v"(p) : "v"(xq6), "v"(n28_1[2])); p += dpp_f(p, 0); pe29 = 0.f; asm("v_fmac_f32 %0, %1, %2" : "+v"(pe29) : "v"(xq0), "v"(n29_0[0])); asm("v_fmac_f32 %0, %1, %2" : "+v"(pe29) : "v"(xq1), "v"(n29_0[1])); asm("v_fmac_f32 %0, %1, %2" : "+v"(pe29) : "v"(xq2), "v"(n29_0[2])); asm("v_fmac_f32 %0, %1, %2" : "+v"(pe29) : "v"(xq3), "v"(n29_0[3])); asm("v_fmac_f32 %0, %1, %2" : "+v"(pe29) : "v"(xq4), "v"(n29_1[0])); asm("v_fmac_f32 %0, %1, %2" : "+v"(pe29) : "v"(xq5), "v"(n29_1[1])); asm("v_fmac_f32 %0, %1, %2" : "+v"(pe29) : "v"(xq6), "v"(n29_1[2])); p += dpp_f(p, 1); xq7 = kq0 ? (xq7 + p) : xq7; asm volatile("" : "+v"(xq7), "+v"(np_) : "v"(n28_0), "v"(n28_1)); }
                { n31_0 = *(const LAS f32x4*)(np_ + 31 * 36); n31_1 = *(const LAS f32x4*)(np_ + 31 * 36 + 4); float p = pe29; asm("v_fmac_f32 %0, %1, %2" : "+v"(p) : "v"(xq7), "v"(n29_1[3])); p += dpp_f(p, 0); pe30 = 0.f; asm("v_fmac_f32 %0, %1, %2" : "+v"(pe30) : "v"(xq0), "v"(n30_0[0])); asm("v_fmac_f32 %0, %1, %2" : "+v"(pe30) : "v"(xq1), "v"(n30_0[1])); asm("v_fmac_f32 %0, %1, %2" : "+v"(pe30) : "v"(xq2), "v"(n30_0[2])); asm("v_fmac_f32 %0, %1, %2" : "+v"(pe30) : "v"(xq3), "v"(n30_0[3])); asm("v_fmac_f32 %0, %1, %2" : "+v"(pe30) : "v"(xq4), "v"(n30_1[0])); asm("v_fmac_f32 %0, %1, %2" : "+v"(pe30) : "v"(xq5), "v"(n30_1[1])); asm("v_fmac_f32 %0, %1, %2" : "+v"(pe30) : "v"(xq6), "v"(n30_1[2])); p += dpp_f(p, 1); xq7 = kq1 ? (xq7 + p) : xq7; asm volatile("" : "+v"(xq7), "+v"(np_) : "v"(n29_0), "v"(n29_1)); }
                { float p = pe30; asm("v_fmac_f32 %0, %1, %2" : "+v"(p) : "v"(xq7), "v"(n30_1[3])); p += dpp_f(p, 0); pe31 = 0.f; asm("v_fmac_f32 %0, %1, %2" : "+v"(pe31) : "v"(xq0), "v"(n31_0[0])); asm("v_fmac_f32 %0, %1, %2" : "+v"(pe31) : "v"(xq1), "v"(n31_0[1])); asm("v_fmac_f32 %0, %1, %2" : "+v"(pe31) : "v"(xq2), "v"(n31_0[2])); asm("v_fmac_f32 %0, %1, %2" : "+v"(pe31) : "v"(xq3), "v"(n31_0[3])); asm("v_fmac_f32 %0, %1, %2" : "+v"(pe31) : "v"(xq4), "v"(n31_1[0])); asm("v_fmac_f32 %0, %1, %2" : "+v"(pe31) : "v"(xq5), "v"(n31_1[1])); asm("v_fmac_f32 %0, %1, %2" : "+v"(pe31) : "v"(xq6), "v"(n31_1[2])); p += dpp_f(p, 1); xq7 = kq2 ? (xq7 + p) : xq7; asm volatile("" : "+v"(xq7), "+v"(np_) : "v"(n30_0), "v"(n30_1)); }
                { float p = pe31; asm("v_fmac_f32 %0, %1, %2" : "+v"(p) : "v"(xq7), "v"(n31_1[3])); p += dpp_f(p, 0); p += dpp_f(p, 1); xq7 = kq3 ? (xq7 + p) : xq7; asm volatile("" : "+v"(xq7), "+v"(np_) : "v"(n31_0), "v"(n31_1)); }
                LAS bf16_t* dst = S_.Tb + rowi * 40 + q;
                dst[0] = bf1(xq0);
                dst[4] = bf1(xq1);
                dst[8] = bf1(xq2);
                dst[12] = bf1(xq3);
                dst[16] = bf1(xq4);
                dst[20] = bf1(xq5);
                dst[24] = bf1(xq6);
                dst[28] = bf1(xq7);
            }
            __syncthreads();
            if (wave < 6) { if (wave < 3) w5_s2b(SA, wave, lane); else w5_s2b(SB, wave - 3, lane); }
            __syncthreads();
            w5_s3(SA, wave, accw, lane);
            w5_s3(SB, (wave + 4) & 7, accw, lane);
            __syncthreads();
            { const size_t idx = (size_t)bh * 32 + (chunk & 31);
              w5_copyout(SA, STG_R + idx * STG_R_STRIDE, STG_P + idx * 8192, tid);
              w5_copyout(SB, STG_R + (idx + 1) * STG_R_STRIDE, STG_P + (idx + 1) * 8192, tid); }
            __syncthreads();
        }
    }
}
__device__ __forceinline__ void wkv5b(const Args& a, LAS unsigned char* lds, const int round) {
    const int tid = threadIdx.x, lane = tid & 63, wave = __builtin_amdgcn_readfirstlane(tid >> 6);
    unsigned char* ws = a.ws;
    const bf16_t* COLS = (const bf16_t*)(ws + WS_A); float* Y = (float*)(ws + WS_B);
    const unsigned char* STG_R = ws + WS_RWKV; const unsigned char* STG_P = (const unsigned char*)a.out + 96 * MiB;
    constexpr int SET = 24576;
    LAS bf16_t* SBF = (LAS bf16_t*)(lds + 118272);
    LAS float* YST = (LAS float*)(lds + 127488);
    LAS float* SSAVE = (LAS float*)(lds + 135936);
    for (int item = blockIdx.x; item < 256; item += gridDim.x) {
        const int bh = item >> 1, half = item & 1, b = bh >> 3, h = bh & 7;
        const int pj = tid >> 4, pq = tid & 15;
        f32x16 Sacc;
#pragma unroll
        for (int i = 0; i < 16; ++i) Sacc[i] = 0.f;
        __syncthreads();
        if (round == 0) { for (int i = tid; i < 2 * 32 * 72 / 2; i += 512) ((LAS unsigned*)SBF)[i] = 0u; }
        else if (wave < 2) {
#pragma unroll
            for (int i = 0; i < 16; ++i) Sacc[i] = SSAVE[(wave * 16 + i) * 64 + lane]; }
        const f32x2 muv = *(const f32x2*)(a.in[I_MU] + C_V + h * 64 + 32 * half + 2 * pq);
        u32x4 gP, gA, gB; unsigned vcur, vprv;
#define W5_LOAD(chunk) do { const size_t idx_ = (size_t)bh * 32 + ((chunk) & 31); const unsigned char* gr_ = STG_R + idx_ * STG_R_STRIDE; const unsigned char* gp_ = STG_P + idx_ * 8192; \
            gP = *(const u32x4*)(gp_ + (tid >> 3) * 128 + (tid & 7) * 16); \
            gA = (tid < 256) ? *(const u32x4*)(gr_ + (tid >> 3) * 128 + (tid & 7) * 16) : *(const u32x4*)(gr_ + 4096 + ((tid - 256) >> 2) * 64 + ((tid - 256) & 3) * 16); \
            gB = (tid < 144) ? *(const u32x4*)(gr_ + 8192 + tid * 16) : (u32x4){0u, 0u, 0u, 0u}; \
            { const int s_ = (chunk) * 32 + pj; const bf16_t* cb_ = COLS + ((size_t)b * SEQ + s_) * INC + C_V + h * 64 + 32 * half + 2 * pq; vcur = *(const unsigned*)cb_; vprv = (s_ > 0) ? *(const unsigned*)(cb_ - INC) : 0u; } } while (0)
#define W5_STORE(setb) do { LAS unsigned char* sb_ = lds + 10240 + (setb) * SET; \
            *(LAS u32x4*)(sb_ + 12288 + (tid >> 3) * 144 + (tid & 7) * 16) = gP; \
            if (tid < 256) *(LAS u32x4*)(sb_ + 7680 + (tid >> 3) * 144 + (tid & 7) * 16) = gA; \
            else *(LAS u32x4*)(sb_ + 2560 + ((tid - 256) >> 2) * 80 + ((tid - 256) & 3) * 16) = gA; \
            if (tid < 128) *(LAS u32x4*)(sb_ + (tid >> 2) * 80 + (tid & 3) * 16) = gB; \
            else if (tid < 144) *(LAS u32x4*)(sb_ + 21504 + (tid - 128) * 16) = gB; \
            { const float c0_ = bflo(vcur), c1_ = bfhi(vcur), p0_ = bflo(vprv), p1_ = bfhi(vprv); LAS bf16_t* vm_ = (LAS bf16_t*)(sb_ + 21760); \
                vm_[(2 * pq) * 40 + pj] = bf1(c0_ + (p0_ - c0_) * muv[0]); vm_[(2 * pq + 1) * 40 + pj] = bf1(c1_ + (p1_ - c1_) * muv[1]); } } while (0)
        const int chunk0 = 32 * round;
        W5_LOAD(chunk0); W5_STORE(chunk0 & 1);
        __syncthreads();
        for (int chunk = chunk0; chunk < chunk0 + 32; ++chunk) {
            const int bi = chunk & 1;
            if (chunk + 1 < chunk0 + 32) W5_LOAD(chunk + 1);
            { LAS unsigned char* sb = lds + 10240 + bi * SET;
              LAS bf16_t* WyT = (LAS bf16_t*)sb; LAS bf16_t* WzT = (LAS bf16_t*)(sb + 2560); LAS bf16_t* R2T = (LAS bf16_t*)(sb + 7680); LAS bf16_t* PpT = (LAS bf16_t*)(sb + 12288);
              LAS float* GC = (LAS float*)(sb + 21504); LAS bf16_t* VmT = (LAS bf16_t*)(sb + 21760); LAS float* YSTc = YST + bi * (32 * 33);
            if (wave < 3) {
                const int t = lane & 31; const LAS bf16_t* Sb = SBF + bi * (32 * 72); f32x16 acc;
#pragma unroll
                for (int i = 0; i < 16; ++i) acc[i] = 0.f;
                if (wave < 2) {
                    acc = mm32<2>(acc, VmT, 40, WzT + 32 * wave * 40, 40, lane);
                    acc = mm32<4>(acc, Sb, 72, PpT + 32 * wave * 72, 72, lane);
                    const float gc = GC[32 * wave + t]; LAS bf16_t* Sn = SBF + (bi ^ 1) * (32 * 72);
#pragma unroll
                    for (int i = 0; i < 16; ++i) { Sacc[i] = fmaf(Sacc[i], gc, acc[i]); Sn[TROW(i, lane) * 72 + 32 * wave + t] = bf1(Sacc[i]); }
                } else {
                    acc = mm32<2>(acc, VmT, 40, WyT, 40, lane);
                    acc = mm32<4>(acc, Sb, 72, R2T, 72, lane);
#pragma unroll
                    for (int i = 0; i < 16; ++i) YSTc[t * 33 + TROW(i, lane)] = acc[i];
                }
            }
            }
            if (chunk + 1 < chunk0 + 32) W5_STORE(bi ^ 1);
            __syncthreads();
            { const LAS float* ys = YST + bi * (32 * 33) + pj * 33 + 2 * pq;
                *(f32x2*)(Y + ((size_t)b * SEQ + chunk * 32 + pj) * 512 + h * 64 + 32 * half + 2 * pq) = (f32x2){ys[0], ys[1]}; }
        }
        if (wave < 2) {
#pragma unroll
            for (int i = 0; i < 16; ++i) SSAVE[(wave * 16 + i) * 64 + lane] = Sacc[i]; }
#undef W5_LOAD
#undef W5_STORE
    }
}
__device__ __forceinline__ void wkv5b2(const Args& a, LAS unsigned char* lds, const int round) {
    const int tid = threadIdx.x, lane = tid & 63, wave = __builtin_amdgcn_readfirstlane(tid >> 6);
    unsigned char* ws = a.ws;
    const bf16_t* COLS = (const bf16_t*)(ws + WS_A); float* Y = (float*)(ws + WS_B); float* SSV = (float*)(ws + WS_S5O);
    const unsigned char* STG_R = ws + WS_RWKV; const unsigned char* STG_P = (const unsigned char*)a.out + 96 * MiB;
    constexpr int SET = 26880;
    LAS bf16_t* SBF = (LAS bf16_t*)(lds + 53760);
    LAS float* YST = (LAS float*)(lds + 72192);
    for (int item = blockIdx.x; item < 128; item += gridDim.x) {
        const int bh = item, b = bh >> 3, h = bh & 7;
        const int pj = tid >> 4, pq = tid & 15;
        const int half = (wave >> 1) & 1, kh = wave & 1;
        f32x16 Sacc;
#pragma unroll
        for (int i = 0; i < 16; ++i) Sacc[i] = 0.f;
        __syncthreads();
        if (round == 0) { for (int i = tid; i < 64 * 72 / 2; i += 512) ((LAS unsigned*)SBF)[i] = 0u; }
        else if (wave < 4) { const int t = lane & 31;
#pragma unroll
            for (int i = 0; i < 16; ++i) { Sacc[i] = SSV[(((size_t)bh * 4 + wave) * 16 + i) * 64 + lane]; SBF[(32 * half + TROW(i, lane)) * 72 + 32 * kh + t] = bf1(Sacc[i]); } }
        const f32x4 muv = *(const f32x4*)(a.in[I_MU] + C_V + h * 64 + 4 * pq);
        u32x4 gPA, gAA, gBA, gPB, gAB, gBB; u32x2 vcA, vpA, vcB, vpB;
#define W5_LOAD(R, chunk) do { const size_t idx_ = (size_t)bh * 32 + ((chunk) & 31); const unsigned char* gr_ = STG_R + idx_ * STG_R_STRIDE; const unsigned char* gp_ = STG_P + idx_ * 8192; \
            gP##R = *(const u32x4*)(gp_ + (tid >> 3) * 128 + (tid & 7) * 16); \
            gA##R = (tid < 256) ? *(const u32x4*)(gr_ + (tid >> 3) * 128 + (tid & 7) * 16) : *(const u32x4*)(gr_ + 4096 + ((tid - 256) >> 2) * 64 + ((tid - 256) & 3) * 16); \
            gB##R = (tid < 144) ? *(const u32x4*)(gr_ + 8192 + tid * 16) : (u32x4){0u, 0u, 0u, 0u}; \
            { const int s_ = (chunk) * 32 + pj; const bf16_t* cb_ = COLS + ((size_t)b * SEQ + s_) * INC + C_V + h * 64 + 4 * pq; vc##R = *(const u32x2*)cb_; vp##R = (s_ > 0) ? *(const u32x2*)(cb_ - INC) : (u32x2){0u, 0u}; } } while (0)
#define W5_STORE(R, setb) do { LAS unsigned char* sb_ = lds + (setb) * SET; \
            *(LAS u32x4*)(sb_ + 12288 + (tid >> 3) * 144 + (tid & 7) * 16) = gP##R; \
            if (tid < 256) *(LAS u32x4*)(sb_ + 7680 + (tid >> 3) * 144 + (tid & 7) * 16) = gA##R; \
            else *(LAS u32x4*)(sb_ + 2560 + ((tid - 256) >> 2) * 80 + ((tid - 256) & 3) * 16) = gA##R; \
            if (tid < 128) *(LAS u32x4*)(sb_ + (tid >> 2) * 80 + (tid & 3) * 16) = gB##R; \
            else if (tid < 144) *(LAS u32x4*)(sb_ + 21504 + (tid - 128) * 16) = gB##R; \
            { float c_[4], p_[4]; unpack4(vc##R, c_); unpack4(vp##R, p_); LAS bf16_t* vm_ = (LAS bf16_t*)(sb_ + 21760); \
              _Pragma("unroll") for (int i_ = 0; i_ < 4; ++i_) vm_[(4 * pq + i_) * 40 + pj] = bf1(c_[i_] + (p_[i_] - c_[i_]) * muv[i_]); } } while (0)
#define W5_STEP(chunk, RL, RS) do { const int bi = (chunk) & 1; \
            if ((chunk) + 2 < cend) W5_LOAD(RL, (chunk) + 2); \
            { LAS unsigned char* sb = lds + bi * SET; \
              LAS bf16_t* WyT = (LAS bf16_t*)sb; LAS bf16_t* WzT = (LAS bf16_t*)(sb + 2560); LAS bf16_t* R2T = (LAS bf16_t*)(sb + 7680); LAS bf16_t* PpT = (LAS bf16_t*)(sb + 12288); \
              LAS float* GC = (LAS float*)(sb + 21504); LAS bf16_t* VmT = (LAS bf16_t*)(sb + 21760); \
              if (wave < 6) { const int t = lane & 31; f32x16 acc; \
                _Pragma("unroll") for (int i = 0; i < 16; ++i) acc[i] = 0.f; \
                if (wave < 4) { const LAS bf16_t* Sb = SBF + bi * (64 * 72) + 32 * half * 72; \
                    acc = mm32<2>(acc, VmT + 32 * half * 40, 40, WzT + 32 * kh * 40, 40, lane); \
                    acc = mm32<4>(acc, Sb, 72, PpT + 32 * kh * 72, 72, lane); \
                    const float gc = GC[32 * kh + t]; LAS bf16_t* Sn = SBF + (bi ^ 1) * (64 * 72) + 32 * half * 72; \
                    _Pragma("unroll") for (int i = 0; i < 16; ++i) { Sacc[i] = fmaf(Sacc[i], gc, acc[i]); Sn[TROW(i, lane) * 72 + 32 * kh + t] = bf1(Sacc[i]); } \
                } else { const int yh = wave - 4; const LAS bf16_t* Sb = SBF + bi * (64 * 72) + 32 * yh * 72; LAS float* YSTc = YST + (bi * 2 + yh) * (32 * 33); \
                    acc = mm32<2>(acc, VmT + 32 * yh * 40, 40, WyT, 40, lane); \
                    acc = mm32<4>(acc, Sb, 72, R2T, 72, lane); \
                    _Pragma("unroll") for (int i = 0; i < 16; ++i) YSTc[t * 33 + TROW(i, lane)] = acc[i]; \
                } } } \
            if ((chunk) + 1 < cend) W5_STORE(RS, bi ^ 1); \
            __syncthreads(); \
            { const LAS float* ys = YST + (bi * 2 + (pq >> 3)) * (32 * 33) + pj * 33 + 4 * (pq & 7); \
                *(f32x4*)(Y + ((size_t)b * SEQ + (chunk) * 32 + pj) * 512 + h * 64 + 4 * pq) = (f32x4){ys[0], ys[1], ys[2], ys[3]}; } } while (0)
        const int chunk0 = 32 * round, cend = chunk0 + 32;
        W5_LOAD(A, chunk0); W5_LOAD(B, chunk0 + 1); W5_STORE(A, 0);
        __syncthreads();
        for (int chunk = chunk0; chunk < cend; chunk += 2) { W5_STEP(chunk, A, B); W5_STEP(chunk + 1, B, A); }
        if (wave < 4) {
#pragma unroll
            for (int i = 0; i < 16; ++i) SSV[(((size_t)bh * 4 + wave) * 16 + i) * 64 + lane] = Sacc[i]; }
#undef W5_LOAD
#undef W5_STORE
#undef W5_STEP
    }
}
__device__ __forceinline__ void wkv5b3(const Args& a, LAS unsigned char* lds, const int round) {
    const int tid = threadIdx.x, lane = tid & 63, wave = __builtin_amdgcn_readfirstlane(tid >> 6);
    unsigned char* ws = a.ws;
    const bf16_t* COLS = (const bf16_t*)(ws + WS_A); float* Y = (float*)(ws + WS_B); float* SSV = (float*)(ws + WS_S5O);
    const unsigned char* STG_R = ws + WS_RWKV; const unsigned char* STG_P = (const unsigned char*)a.out + 96 * MiB;
    constexpr int SET = 26880;
    LAS bf16_t* SBF = (LAS bf16_t*)(lds + 53760);
    for (int item = blockIdx.x; item < 128; item += gridDim.x) {
        const int bh = item, b = bh >> 3, h = bh & 7;
        const int t = lane & 31, hh = lane >> 5;
        const int half = (wave >> 1) & 1, kh = wave & 1;
        const int chunk0 = 32 * round, cend = chunk0 + 32;
        __syncthreads();
        if (wave >= 6) {
            const int u = tid - 384, pj = u >> 2, cq = u & 3;
            f32x4 mv0, mv1, mv2, mv3;
            { const float* mp = a.in[I_MU] + C_V + h * 64 + 16 * cq; mv0 = *(const f32x4*)mp; mv1 = *(const f32x4*)(mp + 4); mv2 = *(const f32x4*)(mp + 8); mv3 = *(const f32x4*)(mp + 12); }
            u32x4 p0A, p1A, p2A, p3A, r0A, r1A, z0A, z1A, y0A, gcA, c0A, c1A, q0A, q1A;
            u32x4 p0B, p1B, p2B, p3B, r0B, r1B, z0B, z1B, y0B, gcB, c0B, c1B, q0B, q1B;
#define W5_LOAD(R, chunk) do { const size_t idx_ = (size_t)bh * 32 + ((chunk) & 31); const unsigned char* gr_ = STG_R + idx_ * STG_R_STRIDE; const unsigned char* gp_ = STG_P + idx_ * 8192; \
                p0##R = *(const u32x4*)(gp_ + u * 16); p1##R = *(const u32x4*)(gp_ + 2048 + u * 16); p2##R = *(const u32x4*)(gp_ + 4096 + u * 16); p3##R = *(const u32x4*)(gp_ + 6144 + u * 16); \
                r0##R = *(const u32x4*)(gr_ + u * 16); r1##R = *(const u32x4*)(gr_ + 2048 + u * 16); z0##R = *(const u32x4*)(gr_ + 4096 + u * 16); z1##R = *(const u32x4*)(gr_ + 6144 + u * 16); \
                y0##R = *(const u32x4*)(gr_ + 8192 + u * 16); gc##R = (u < 16) ? *(const u32x4*)(gr_ + 10240 + u * 16) : (u32x4){0u, 0u, 0u, 0u}; \
                { const int s_ = (chunk) * 32 + pj; const bf16_t* cb_ = COLS + ((size_t)b * SEQ + s_) * INC + C_V + h * 64 + 16 * cq; c0##R = *(const u32x4*)cb_; c1##R = *(const u32x4*)(cb_ + 8); \
                  if (s_ > 0) { q0##R = *(const u32x4*)(cb_ - INC); q1##R = *(const u32x4*)(cb_ - INC + 8); } else { q0##R = (u32x4){0u, 0u, 0u, 0u}; q1##R = (u32x4){0u, 0u, 0u, 0u}; } } } while (0)
#define W5_PIECE8(base, p_) ((base) + ((p_) >> 3) * 144 + ((p_) & 7) * 16)
#define W5_PIECE4(base, p_) ((base) + ((p_) >> 2) * 80 + ((p_) & 3) * 16)
#define W5_VM(cv, qv, mv, off) do { float c_[8], q_[8]; unpack8(cv, c_); unpack8(qv, q_); \
                _Pragma("unroll") for (int i_ = 0; i_ < 8; ++i_) vm_[(16 * cq + (off) + i_) * 40 + pj] = bf1(c_[i_] + (q_[i_] - c_[i_]) * ((i_ < 4) ? mv##0[i_ & 3] : mv##1[i_ & 3])); } while (0)
#define W5_STORE(R, setb) do { LAS unsigned char* sb_ = lds + (setb) * SET; \
                *(LAS u32x4*)W5_PIECE8(sb_ + 12288, u) = p0##R; *(LAS u32x4*)W5_PIECE8(sb_ + 12288, u + 128) = p1##R; *(LAS u32x4*)W5_PIECE8(sb_ + 12288, u + 256) = p2##R; *(LAS u32x4*)W5_PIECE8(sb_ + 12288, u + 384) = p3##R; \
                *(LAS u32x4*)W5_PIECE8(sb_ + 7680, u) = r0##R; *(LAS u32x4*)W5_PIECE8(sb_ + 7680, u + 128) = r1##R; \
                *(LAS u32x4*)W5_PIECE4(sb_ + 2560, u) = z0##R; *(LAS u32x4*)W5_PIECE4(sb_ + 2560, u + 128) = z1##R; \
                *(LAS u32x4*)W5_PIECE4(sb_, u) = y0##R; if (u < 16) *(LAS u32x4*)(sb_ + 21504 + u * 16) = gc##R; \
                { LAS bf16_t* vm_ = (LAS bf16_t*)(sb_ + 21760); \
                  { float c_[8], q_[8]; unpack8(c0##R, c_); unpack8(q0##R, q_); \
                    _Pragma("unroll") for (int i_ = 0; i_ < 8; ++i_) vm_[(16 * cq + i_) * 40 + pj] = bf1(c_[i_] + (q_[i_] - c_[i_]) * ((i_ < 4) ? mv0[i_ & 3] : mv1[i_ & 3])); } \
                  { float c_[8], q_[8]; unpack8(c1##R, c_); unpack8(q1##R, q_); \
                    _Pragma("unroll") for (int i_ = 0; i_ < 8; ++i_) vm_[(16 * cq + 8 + i_) * 40 + pj] = bf1(c_[i_] + (q_[i_] - c_[i_]) * ((i_ < 4) ? mv2[i_ & 3] : mv3[i_ & 3])); } } } while (0)
            W5_LOAD(A, chunk0); W5_LOAD(B, chunk0 + 1); W5_STORE(A, 0);
            __syncthreads();
            for (int chunk = chunk0; chunk < cend; chunk += 2) {
                if (chunk + 2 < cend) W5_LOAD(A, chunk + 2);
                W5_STORE(B, 1);
                __syncthreads();
                if (chunk + 3 < cend) W5_LOAD(B, chunk + 3);
                if (chunk + 2 < cend) W5_STORE(A, 0);
                __syncthreads();
            }
#undef W5_LOAD
#undef W5_STORE
#undef W5_VM
#undef W5_PIECE8
#undef W5_PIECE4
        } else {
            f32x16 Sacc;
#pragma unroll
            for (int i = 0; i < 16; ++i) Sacc[i] = 0.f;
            if (wave < 4) {
                if (round != 0) {
#pragma unroll
                    for (int i = 0; i < 16; ++i) Sacc[i] = SSV[(((size_t)bh * 4 + wave) * 16 + i) * 64 + lane]; }
                LAS bf16_t* Sn = SBF + (32 * half + t) * 72 + 32 * kh;
#pragma unroll
                for (int g4 = 0; g4 < 4; ++g4) *(LAS u32x2*)(Sn + 8 * g4 + 4 * hh) = (u32x2){cvt_pk_bf16(Sacc[4 * g4], Sacc[4 * g4 + 1]), cvt_pk_bf16(Sacc[4 * g4 + 2], Sacc[4 * g4 + 3])};
            }
            __syncthreads();
            for (int chunk = chunk0; chunk < cend; ++chunk) {
                const int bi = chunk & 1; LAS unsigned char* sb = lds + bi * SET;
                LAS bf16_t* WyT = (LAS bf16_t*)sb; LAS bf16_t* WzT = (LAS bf16_t*)(sb + 2560); LAS bf16_t* R2T = (LAS bf16_t*)(sb + 7680); LAS bf16_t* PpT = (LAS bf16_t*)(sb + 12288);
                LAS float* GC = (LAS float*)(sb + 21504); LAS bf16_t* VmT = (LAS bf16_t*)(sb + 21760);
                f32x16 acc;
#pragma unroll
                for (int i = 0; i < 16; ++i) acc[i] = 0.f;
                if (wave < 4) {
                    const LAS bf16_t* Sb = SBF + bi * (64 * 72) + 32 * half * 72;
                    acc = mm32<2>(acc, WzT + 32 * kh * 40, 40, VmT + 32 * half * 40, 40, lane);
                    acc = mm32<4>(acc, PpT + 32 * kh * 72, 72, Sb, 72, lane);
                    LAS bf16_t* Sn = SBF + (bi ^ 1) * (64 * 72) + (32 * half + t) * 72 + 32 * kh;
#pragma unroll
                    for (int g4 = 0; g4 < 4; ++g4) { const int k0 = 8 * g4 + 4 * hh; const f32x4 gc4 = *(const LAS f32x4*)(GC + 32 * kh + k0);
#pragma unroll
                        for (int i = 0; i < 4; ++i) Sacc[4 * g4 + i] = fmaf(Sacc[4 * g4 + i], gc4[i], acc[4 * g4 + i]);
                        *(LAS u32x2*)(Sn + k0) = (u32x2){cvt_pk_bf16(Sacc[4 * g4], Sacc[4 * g4 + 1]), cvt_pk_bf16(Sacc[4 * g4 + 2], Sacc[4 * g4 + 3])}; }
                } else {
                    const int yh = wave - 4; const LAS bf16_t* Sb = SBF + bi * (64 * 72) + 32 * yh * 72;
                    acc = mm32<2>(acc, WyT, 40, VmT + 32 * yh * 40, 40, lane);
                    acc = mm32<4>(acc, R2T, 72, Sb, 72, lane);
                    float* yp = Y + ((size_t)b * SEQ + chunk * 32) * 512 + h * 64 + 32 * yh + t;
#pragma unroll
                    for (int i = 0; i < 16; ++i) yp[(size_t)TROW(i, lane) * 512] = acc[i];
                }
                __syncthreads();
            }
            if (wave < 4) {
#pragma unroll
                for (int i = 0; i < 16; ++i) SSV[(((size_t)bh * 4 + wave) * 16 + i) * 64 + lane] = Sacc[i]; }
        }
    }
}
__device__ __forceinline__ unsigned w5_img_src(int o) {
    if (o < 2560) { const int r = o / 80, c = o - r * 80; return (c < 64) ? (unsigned)(8192 + r * 64 + c) : 0u; }
    if (o < 7680) { const int o2 = o - 2560, r = o2 / 80, c = o2 - r * 80; return (c < 64) ? (unsigned)(4096 + r * 64 + c) : 0u; }
    if (o < 12288) { const int o2 = o - 7680, r = o2 / 144, c = o2 - r * 144; return (c < 128) ? (unsigned)(r * 128 + c) : 0u; }
    if (o < 21504) { const int o2 = o - 12288, r = o2 / 144, c = o2 - r * 144; return (c < 128) ? (unsigned)(r * 128 + c) : 0u; }
    return (unsigned)(10240 + (o - 21504));
}
__device__ __forceinline__ void wkv5b4(const Args& a, LAS unsigned char* lds, const int round) {
    const int tid = threadIdx.x, lane = tid & 63, wave = __builtin_amdgcn_readfirstlane(tid >> 6);
    unsigned char* ws = a.ws;
    const bf16_t* COLS = (const bf16_t*)(ws + WS_A); float* Y = (float*)(ws + WS_B); float* SSV = (float*)(ws + WS_S5O);
    const unsigned char* STG_R = ws + WS_RWKV; const unsigned char* STG_P = (const unsigned char*)a.out + 96 * MiB;
    constexpr int SETB = 31104;
    LAS bf16_t* SBF = (LAS bf16_t*)(lds + 4 * SETB);
#define W5_BAR() do { asm volatile("s_waitcnt lgkmcnt(0)" ::: "memory"); __builtin_amdgcn_s_barrier(); asm volatile("" ::: "memory"); } while (0)
    for (int item = blockIdx.x; item < 128; item += gridDim.x) {
        const int bh = item, b = bh >> 3, h = bh & 7;
        const int t = lane & 31, hh = lane >> 5;
        const int half = (wave >> 1) & 1, kh = wave & 1;
        const int chunk0 = 32 * round;
        __syncthreads();
        if (wave >= 6) {
            const int u = tid - 384, pj = u >> 2, cq = u & 3;
            const int j0 = (wave == 6) ? 0 : 9, nb = (wave == 6) ? 9 : 13;
            unsigned goff[13];
#pragma unroll
            for (int j = 0; j < 13; ++j) goff[j] = w5_img_src((j0 + j) * 1024 + lane * 16);
            f32x4 mv0, mv1, mv2, mv3;
            { const float* mp = a.in[I_MU] + C_V + h * 64 + 16 * cq; mv0 = *(const f32x4*)mp; mv1 = *(const f32x4*)(mp + 4); mv2 = *(const f32x4*)(mp + 8); mv3 = *(const f32x4*)(mp + 12); }
#define W5_ISSUE(i_) do { const int c_ = chunk0 + (i_); const size_t idx_ = (size_t)bh * 32 + (c_ & 31); const unsigned char* gr_ = STG_R + idx_ * STG_R_STRIDE; const unsigned char* gp_ = STG_P + idx_ * 8192; \
                LAS unsigned char* sb_ = lds + ((i_) & 3) * SETB; \
                if (wave == 6) { const unsigned char* vb_ = (const unsigned char*)(COLS + ((size_t)b * SEQ + (size_t)c_ * 32) * INC + C_V + h * 64) - (size_t)INC * 2; \
                    _Pragma("unroll") for (int j = 0; j < 5; ++j) { const int p_ = j * 64 + lane; \
                        if (p_ < 264) __builtin_amdgcn_global_load_lds((const unsigned*)(vb_ + (size_t)(p_ >> 3) * (INC * 2) + (p_ & 7) * 16), (LAS unsigned*)(sb_ + 26880 + j * 1024), 16, 0, 0); } } \
                _Pragma("unroll") for (int j = 0; j < 13; ++j) { if (j < nb) { const int jj = j0 + j; const unsigned char* base_ = (jj >= 12 && jj < 21) ? gp_ : gr_; \
                    if (jj < 21 || lane < 16) __builtin_amdgcn_global_load_lds((const unsigned*)(base_ + goff[j]), (LAS unsigned*)(sb_ + jj * 1024), 16, 0, 0); } } } while (0)
#define W5_CONV(i_) do { const int c_ = chunk0 + (i_); LAS unsigned char* sb_ = lds + ((i_) & 3) * SETB; const LAS unsigned char* rw_ = sb_ + 26880 + pj * 128 + cq * 32; LAS bf16_t* vm_ = (LAS bf16_t*)(sb_ + 21760); \
                u32x4 q0_ = *(const LAS u32x4*)rw_, q1_ = *(const LAS u32x4*)(rw_ + 16); const u32x4 c0_ = *(const LAS u32x4*)(rw_ + 128), c1_ = *(const LAS u32x4*)(rw_ + 144); \
                if (c_ * 32 + pj == 0) { q0_ = (u32x4){0u, 0u, 0u, 0u}; q1_ = q0_; } \
                { float c8_[8], q8_[8]; unpack8(c0_, c8_); unpack8(q0_, q8_); \
                  _Pragma("unroll") for (int e_ = 0; e_ < 8; ++e_) vm_[(16 * cq + e_) * 40 + pj] = bf1(c8_[e_] + (q8_[e_] - c8_[e_]) * ((e_ < 4) ? mv0[e_ & 3] : mv1[e_ & 3])); } \
                { float c8_[8], q8_[8]; unpack8(c1_, c8_); unpack8(q1_, q8_); \
                  _Pragma("unroll") for (int e_ = 0; e_ < 8; ++e_) vm_[(16 * cq + 8 + e_) * 40 + pj] = bf1(c8_[e_] + (q8_[e_] - c8_[e_]) * ((e_ < 4) ? mv2[e_ & 3] : mv3[e_ & 3])); } } while (0)
            W5_ISSUE(0); W5_ISSUE(1); W5_ISSUE(2);
            if (wave == 6) asm volatile("s_waitcnt vmcnt(37)" ::: "memory");
            W5_BAR();
            W5_CONV(0);
            if (wave == 6) asm volatile("s_waitcnt vmcnt(23)" ::: "memory"); else asm volatile("s_waitcnt vmcnt(26)" ::: "memory");
            W5_BAR();
            for (int i = 0; i < 32; ++i) {
                if (i + 3 < 32) W5_ISSUE(i + 3);
                if (i + 1 < 32) W5_CONV(i + 1);
                if (i + 3 < 32) { if (wave == 6) asm volatile("s_waitcnt vmcnt(23)" ::: "memory"); else asm volatile("s_waitcnt vmcnt(26)" ::: "memory"); }
                else asm volatile("s_waitcnt vmcnt(0)" ::: "memory");
                W5_BAR();
            }
#undef W5_ISSUE
#undef W5_CONV
        } else {
            f32x16 Sacc;
#pragma unroll
            for (int i = 0; i < 16; ++i) Sacc[i] = 0.f;
            if (wave < 4) {
                if (round != 0) {
#pragma unroll
                    for (int i = 0; i < 16; ++i) Sacc[i] = SSV[(((size_t)bh * 4 + wave) * 16 + i) * 64 + lane]; }
                LAS bf16_t* Sn = SBF + (32 * half + t) * 72 + 32 * kh;
#pragma unroll
                for (int g4 = 0; g4 < 4; ++g4) *(LAS u32x2*)(Sn + 8 * g4 + 4 * hh) = (u32x2){cvt_pk_bf16(Sacc[4 * g4], Sacc[4 * g4 + 1]), cvt_pk_bf16(Sacc[4 * g4 + 2], Sacc[4 * g4 + 3])};
            }
            W5_BAR();
            W5_BAR();
            for (int i = 0; i < 32; ++i) {
                const int chunk = chunk0 + i, bi = i & 1; LAS unsigned char* sb = lds + (i & 3) * SETB;
                LAS bf16_t* WyT = (LAS bf16_t*)sb; LAS bf16_t* WzT = (LAS bf16_t*)(sb + 2560); LAS bf16_t* R2T = (LAS bf16_t*)(sb + 7680); LAS bf16_t* PpT = (LAS bf16_t*)(sb + 12288);
                LAS float* GC = (LAS float*)(sb + 21504); LAS bf16_t* VmT = (LAS bf16_t*)(sb + 21760);
                f32x16 acc;
#pragma unroll
                for (int k = 0; k < 16; ++k) acc[k] = 0.f;
                if (wave < 4) {
                    const LAS bf16_t* Sb = SBF + bi * (64 * 72) + 32 * half * 72;
                    acc = mm32<2>(acc, WzT + 32 * kh * 40, 40, VmT + 32 * half * 40, 40, lane);
                    acc = mm32<4>(acc, PpT + 32 * kh * 72, 72, Sb, 72, lane);
                    LAS bf16_t* Sn = SBF + (bi ^ 1) * (64 * 72) + (32 * half + t) * 72 + 32 * kh;
#pragma unroll
                    for (int g4 = 0; g4 < 4; ++g4) { const int k0 = 8 * g4 + 4 * hh; const f32x4 gc4 = *(const LAS f32x4*)(GC + 32 * kh + k0);
#pragma unroll
                        for (int k = 0; k < 4; ++k) Sacc[4 * g4 + k] = fmaf(Sacc[4 * g4 + k], gc4[k], acc[4 * g4 + k]);
                        *(LAS u32x2*)(Sn + k0) = (u32x2){cvt_pk_bf16(Sacc[4 * g4], Sacc[4 * g4 + 1]), cvt_pk_bf16(Sacc[4 * g4 + 2], Sacc[4 * g4 + 3])}; }
                } else {
                    const int yh = wave - 4; const LAS bf16_t* Sb = SBF + bi * (64 * 72) + 32 * yh * 72;
                    acc = mm32<2>(acc, WyT, 40, VmT + 32 * yh * 40, 40, lane);
                    acc = mm32<4>(acc, R2T, 72, Sb, 72, lane);
                    float* yp = Y + ((size_t)b * SEQ + chunk * 32) * 512 + h * 64 + 32 * yh + t;
#pragma unroll
                    for (int k = 0; k < 16; ++k) yp[(size_t)TROW(k, lane) * 512] = acc[k];
                }
                W5_BAR();
            }
            if (wave < 4) {
#pragma unroll
                for (int i = 0; i < 16; ++i) SSV[(((size_t)bh * 4 + wave) * 16 + i) * 64 + lane] = Sacc[i]; }
        }
    }
#undef W5_BAR
}
__device__ __forceinline__ void phase4s(const Args& a, LAS unsigned char* lds, const XcdBarrier& bar) {
    const int tid = threadIdx.x;
    unsigned char* ws = a.ws;
    for (int item = blockIdx.x; item < 256; item += gridDim.x) {
        if (tid < 64) {
            const int b = item >> 4, g = item & 15, n = tid;
            const f32x2 lamL = ((const f32x2*)(ws + WS_LAML))[g * 64 + n];
            const float* E = (const float*)(ws + WS_E) + ((size_t)g * S5ROWS + b * S5NCH) * 128;
            bf16_t* UG = (bf16_t*)(ws + WS_UG) + ((size_t)g * S5ROWS + b * S5NCH) * S5K + 512;
            float xr = 0.f, xi = 0.f;
#pragma unroll 8
            for (int ch = 0; ch < S5NCH; ++ch) {
                UG[(size_t)ch * S5K + n] = (bf16_t)f2bf(xr); UG[(size_t)ch * S5K + 64 + n] = (bf16_t)f2bf(xi);
                const float er = E[ch * 128 + n], ei = E[ch * 128 + 64 + n];
                const float nr = lamL[0] * xr - lamL[1] * xi + er, ni = lamL[0] * xi + lamL[1] * xr + ei; xr = nr; xi = ni;
            }
        }
    }
    if (gridDim.x != 256) { late_items_idle(a, lds, 0, N_LATE, 0); __syncthreads(); }
    wkv5a2(a, lds, 0); xcd_barrier(bar);
    wkv5b4(a, lds, 0); xcd_barrier(bar);
    wkv5a2(a, lds, 1); xcd_barrier(bar);
    wkv5b4(a, lds, 1);
}

__device__ __forceinline__ void phase5_post(const Args& a) {
    const int gt = blockIdx.x * 512 + threadIdx.x, NT = gridDim.x * 512;
    unsigned char* ws = a.ws;
    const bf16_t* COLS = (const bf16_t*)(ws + WS_A); const bf16_t* LORA = (const bf16_t*)a.out; const float* Y = (const float*)(ws + WS_B); const float* BON = (const float*)(ws + WS_BON);
    bf16_t* RO = (bf16_t*)(ws + WS_RWKV);
    const int hq = gt & 127, h = hq >> 4, q = hq & 15, hc = h * 64 + 4 * q;
    float lg[4], lb[4], muv[4];
#pragma unroll
    for (int i = 0; i < 4; ++i) { lg[i] = a.in[I_LNG][hc + i]; lb[i] = a.in[I_LNB][hc + i]; muv[i] = a.in[I_MU][C_V + hc + i]; }
    for (int p = gt; p < T * 128; p += NT) {
        const int t = p >> 7;
        const f32x4 y4 = *(const f32x4*)(Y + (size_t)t * 512 + hc);
        float s = (y4[0] + y4[1]) + (y4[2] + y4[3]); s = row16_sum(s); const float mean = s * (1.0f / 64.0f);
        const float d0 = y4[0] - mean, d1 = y4[1] - mean, d2 = y4[2] - mean, d3 = y4[3] - mean;
        float qv = (d0 * d0 + d1 * d1) + (d2 * d2 + d3 * d3); qv = row16_sum(qv); const float rstd = 1.0f / sqrtf(qv * (1.0f / 64.0f) + 64e-5f);
        float vc[4], vp[4], g4[4]; unpack4(*(const u32x2*)(COLS + (size_t)t * INC + C_V + hc), vc);
        if ((t & (SEQ - 1)) != 0) unpack4(*(const u32x2*)(COLS + (size_t)(t - 1) * INC + C_V + hc), vp); else { vp[0] = vp[1] = vp[2] = vp[3] = 0.f; }
        unpack4(*(const u32x2*)(LORA + (size_t)t * 1536 + 1024 + hc), g4);
        const float bon = BON[(size_t)t * 8 + h];
        const float dd[4] = {d0, d1, d2, d3}; float o[4];
#pragma unroll
        for (int i = 0; i < 4; ++i) { const float v = vc[i] + (vp[i] - vc[i]) * muv[i]; o[i] = (dd[i] * rstd * lg[i] + lb[i] + bon * v) * g4[i]; }
        u32x2 w; w.x = cvt_pk_bf16(o[0], o[1]); w.y = cvt_pk_bf16(o[2], o[3]); *(u32x2*)(RO + (size_t)t * 512 + hc) = w;
    }
}

__device__ __forceinline__ void phase9(const Args& a, LAS unsigned char* lds) {
    const int tid = threadIdx.x, lane = tid & 63, wave = tid >> 6;
    unsigned char* ws = a.ws;
    const float* X1 = a.out; const bf16_t* WR = (const bf16_t*)(ws + WS_WR);
    int4* ROUTE = (int4*)(ws + WS_ROUTE); int* BC = (int*)(ws + WS_BC);
    LAS float* LG = (LAS float*)lds + wave * (16 * 49);
    LAS int* cnt = (LAS int*)(lds + 32768);
    for (int vb = blockIdx.x; vb < 256; vb += gridDim.x) {
        __syncthreads();
        if (tid < 32) cnt[tid] = 0;
        __syncthreads();
        const int t0 = vb * 128 + wave * 16;
        const int ar = lane & 15, aq = lane >> 4;
        f32x4 acc0 = (f32x4){0.f, 0.f, 0.f, 0.f}, acc1 = acc0, acc2 = acc0; float ssq = 0.f;
        const float* xrow = X1 + (size_t)(t0 + ar) * DM + 8 * aq;
        const bf16_t* wrow = WR + (size_t)ar * DM + 8 * aq;
#pragma unroll 4
        for (int kb = 0; kb < 32; ++kb) {
            const f32x4 x0 = *(const f32x4*)(xrow + kb * 32), x1 = *(const f32x4*)(xrow + kb * 32 + 4);
            ssq += (x0[0] * x0[0] + x0[1] * x0[1]) + (x0[2] * x0[2] + x0[3] * x0[3]) + (x1[0] * x1[0] + x1[1] * x1[1]) + (x1[2] * x1[2] + x1[3] * x1[3]);
            u32x4 af; af.x = cvt_pk_bf16(x0[0], x0[1]); af.y = cvt_pk_bf16(x0[2], x0[3]); af.z = cvt_pk_bf16(x1[0], x1[1]); af.w = cvt_pk_bf16(x1[2], x1[3]);
            const bf16x8 A = __builtin_bit_cast(bf16x8, af);
            const bf16x8 B0 = *(const bf16x8*)(wrow + kb * 32), B1 = *(const bf16x8*)(wrow + 16 * DM + kb * 32), B2 = *(const bf16x8*)(wrow + 32 * DM + kb * 32);
            acc0 = __builtin_amdgcn_mfma_f32_16x16x32_bf16(A, B0, acc0, 0, 0, 0);
            acc1 = __builtin_amdgcn_mfma_f32_16x16x32_bf16(A, B1, acc1, 0, 0, 0);
            acc2 = __builtin_amdgcn_mfma_f32_16x16x32_bf16(A, B2, acc2, 0, 0, 0);
        }
        ssq += __shfl_xor(ssq, 16); ssq += __shfl_xor(ssq, 32);
        const float rs = 1.0f / sqrtf(ssq * (1.0f / DM) + 1e-6f);
#pragma unroll
        for (int r = 0; r < 4; ++r) { const int row = aq * 4 + r; LG[row * 49 + ar] = acc0[r]; LG[row * 49 + 16 + ar] = acc1[r]; LG[row * 49 + 32 + ar] = acc2[r]; }
        LDS_WAIT();
        if (lane < 16) {
            const int t = t0 + lane; const LAS float* lg = LG + lane * 49;
            float gl[4]; float mx = -3.0e38f; int gi = 0;
#pragma unroll
            for (int j = 0; j < 4; ++j) { gl[j] = lg[j] * rs + a.in[I_RGB][j]; if (gl[j] > mx) { mx = gl[j]; gi = j; } }
            float den = 0.f;
#pragma unroll
            for (int j = 0; j < 4; ++j) den += __expf(gl[j] - mx);
            const float gp = 1.0f / den;
            float b1 = -3.0e38f, b2 = -3.0e38f; int i1 = 0, i2 = 0;
            for (int j = 0; j < 8; ++j) { const float v = lg[4 + gi * 8 + j] * rs + a.in[I_REB][gi * 8 + j];
                if (v > b1) { b2 = b1; i2 = i1; b1 = v; i1 = j; } else if (v > b2) { b2 = v; i2 = j; } }
            const float e2 = __expf(b2 - b1), w1 = gp / (1.0f + e2), w2 = gp * e2 / (1.0f + e2);
            const int e0 = gi * 8 + i1, e1 = gi * 8 + i2;
            const int s0 = atomicAdd((int*)&cnt[e0], 1), s1 = atomicAdd((int*)&cnt[e1], 1);
            int4 rt; rt.x = e0 | (e1 << 8); rt.y = s0 | (s1 << 16); rt.z = __builtin_bit_cast(int, w1); rt.w = __builtin_bit_cast(int, w2);
            ROUTE[t] = rt;
        }
        __syncthreads();
        if (tid < 32) BC[vb * 32 + tid] = cnt[tid];
    }
}

__device__ __forceinline__ void phase10(const Args& a, LAS unsigned char* lds) {
    const int tid = threadIdx.x, lane = tid & 63, wave = tid >> 6;
    unsigned char* ws = a.ws;
    const float* X1 = a.out; const int4* ROUTE = (const int4*)(ws + WS_ROUTE); const int* BC = (const int*)(ws + WS_BC);
    bf16_t* HS = (bf16_t*)(ws + WS_A); float* ROWW = (float*)(ws + WS_ROWW); int2* POS = (int2*)(ws + WS_POS); int* OFF = (int*)(ws + WS_OFF);
    LAS int* ptot = (LAS int*)lds;
    LAS int* pmine = ptot + 512;
    LAS int* base = pmine + 512;
    for (int vb = blockIdx.x; vb < 256; vb += gridDim.x) {
        __syncthreads();
        { const int e = tid & 31, part = tid >> 5; int st = 0, sm = 0;
            for (int k = 0; k < 16; ++k) { const int r = part * 16 + k; const int c = BC[r * 32 + e]; st += c; sm += (r < vb) ? c : 0; }
            ptot[part * 32 + e] = st; pmine[part * 32 + e] = sm; }
        __syncthreads();
        if (tid < 32) { int st = 0, sm = 0; for (int k = 0; k < 16; ++k) { st += ptot[k * 32 + tid]; sm += pmine[k * 32 + tid]; } ptot[tid] = (st + 255) & ~255; pmine[tid] = sm; }
        __syncthreads();
        if (tid < 32) { int off = 0; for (int k = 0; k < tid; ++k) off += ptot[k]; base[tid] = off + pmine[tid];
            if (vb == 0) { OFF[tid] = off; if (tid == 31) OFF[32] = off + ptot[31]; } }
        __syncthreads();
        for (int i0 = 0; i0 < 16; i0 += 2) {
            f32x4 v[2][4]; int4 rt[2];
#pragma unroll
            for (int u = 0; u < 2; ++u) { const int t = vb * 128 + wave * 16 + i0 + u; rt[u] = ROUTE[t]; const f32x4* xr = (const f32x4*)(X1 + (size_t)t * DM) + lane;
#pragma unroll
                for (int j = 0; j < 4; ++j) v[u][j] = xr[64 * j]; }
#pragma unroll
            for (int u = 0; u < 2; ++u) { const int t = vb * 128 + wave * 16 + i0 + u;
                const int e0 = rt[u].x & 255, e1 = (rt[u].x >> 8) & 255, p0 = base[e0] + (rt[u].y & 0xffff), p1 = base[e1] + ((rt[u].y >> 16) & 0xffff);
                float s = 0.f;
#pragma unroll
                for (int j = 0; j < 4; ++j) s += (v[u][j][0] * v[u][j][0] + v[u][j][1] * v[u][j][1]) + (v[u][j][2] * v[u][j][2] + v[u][j][3] * v[u][j][3]);
                const float rs = 1.0f / sqrtf(wave_sum(s) * (1.0f / DM) + 1e-6f);
                u32x2* o0 = (u32x2*)(HS + (size_t)p0 * DM) + lane; u32x2* o1 = (u32x2*)(HS + (size_t)p1 * DM) + lane;
#pragma unroll
                for (int j = 0; j < 4; ++j) { u32x2 w; w.x = pk2(v[u][j][0] * rs, v[u][j][1] * rs); w.y = pk2(v[u][j][2] * rs, v[u][j][3] * rs); o0[64 * j] = w; o1[64 * j] = w; }
                if (lane == 0) { ROWW[p0] = __builtin_bit_cast(float, rt[u].z); ROWW[p1] = __builtin_bit_cast(float, rt[u].w); POS[t] = make_int2(p0, p1); } }
        }
    }
}

__device__ __forceinline__ void phase13(const Args& a) {
    const int tid = threadIdx.x, lane = tid & 63, wave = tid >> 6;
    const int gw = blockIdx.x * 8 + wave, NGW = gridDim.x * 8;
    unsigned char* ws = a.ws;
    float* X = a.out; const bf16_t* YM = (const bf16_t*)(ws + WS_A); const int2* POS = (const int2*)(ws + WS_POS); bf16_t* HP = (bf16_t*)(ws + WS_HP); bf16_t* P16 = (bf16_t*)(ws + WS_P16);
    for (int t0 = gw; t0 < T; t0 += 2 * NGW) {
        f32x4 v[2][4]; u32x2 ya[2][4], yb[2][4]; f32x4 pv[2];
#pragma unroll
        for (int u = 0; u < 2; ++u) { const int t = t0 + u * NGW; const int2 ps = POS[t];
            const f32x4* xr = (const f32x4*)(X + (size_t)t * DM) + lane; const u32x2* y0 = (const u32x2*)(YM + (size_t)ps.x * DM) + lane; const u32x2* y1 = (const u32x2*)(YM + (size_t)ps.y * DM) + lane;
#pragma unroll
            for (int j = 0; j < 4; ++j) { v[u][j] = xr[64 * j]; ya[u][j] = y0[64 * j]; yb[u][j] = y1[64 * j]; }
            pv[u] = *((const f32x4*)(a.in[I_P] + (size_t)t * 256) + lane); }
#pragma unroll
        for (int u = 0; u < 2; ++u) { const int t = t0 + u * NGW; float s = 0.f; f32x4* xr = (f32x4*)(X + (size_t)t * DM) + lane;
#pragma unroll
            for (int j = 0; j < 4; ++j) { float a0[4], a1[4]; unpack4(ya[u][j], a0); unpack4(yb[u][j], a1);
                v[u][j][0] = (v[u][j][0] + a0[0]) + a1[0]; v[u][j][1] = (v[u][j][1] + a0[1]) + a1[1]; v[u][j][2] = (v[u][j][2] + a0[2]) + a1[2]; v[u][j][3] = (v[u][j][3] + a0[3]) + a1[3];
                s += (v[u][j][0] * v[u][j][0] + v[u][j][1] * v[u][j][1]) + (v[u][j][2] * v[u][j][2] + v[u][j][3] * v[u][j][3]); xr[64 * j] = v[u][j]; }
            const float rs = 1.0f / sqrtf(wave_sum(s) * (1.0f / DM) + 1e-6f);
            u32x2* o = (u32x2*)(HP + (size_t)t * DM) + lane;
#pragma unroll
            for (int j = 0; j < 4; ++j) { u32x2 w; w.x = pk2(v[u][j][0] * rs, v[u][j][1] * rs); w.y = pk2(v[u][j][2] * rs, v[u][j][3] * rs); o[64 * j] = w; }
            u32x2 w; w.x = pk2(pv[u][0], pv[u][1]); w.y = pk2(pv[u][2], pv[u][3]); *((u32x2*)(P16 + (size_t)t * 256) + lane) = w; }
    }
}
__device__ __forceinline__ void phase15(const Args& a, const float* XS) {
    const int tid = threadIdx.x, lane = tid & 63, wave = tid >> 6;
    const int gw = blockIdx.x * 8 + wave, NGW = gridDim.x * 8;
    float* X = a.out; const f32x4* gn = (const f32x4*)a.in[I_FINN] + lane;
    f32x4 g[4];
#pragma unroll
    for (int j = 0; j < 4; ++j) g[j] = gn[64 * j];
    for (int t0 = gw; t0 < T; t0 += 2 * NGW) {
        f32x4 v[2][4];
#pragma unroll
        for (int u = 0; u < 2; ++u) { const f32x4* xs = (const f32x4*)(XS + (size_t)(t0 + u * NGW) * DM) + lane;
#pragma unroll
            for (int j = 0; j < 4; ++j) v[u][j] = xs[64 * j]; }
#pragma unroll
        for (int u = 0; u < 2; ++u) { float s = 0.f;
#pragma unroll
            for (int j = 0; j < 4; ++j) s += (v[u][j][0] * v[u][j][0] + v[u][j][1] * v[u][j][1]) + (v[u][j][2] * v[u][j][2] + v[u][j][3] * v[u][j][3]);
            const float rs = 1.0f / sqrtf(wave_sum(s) * (1.0f / DM) + 1e-6f);
            f32x4* xr = (f32x4*)(X + (size_t)(t0 + u * NGW) * DM) + lane;
#pragma unroll
            for (int j = 0; j < 4; ++j) xr[64 * j] = (f32x4){v[u][j][0] * rs * g[j][0], v[u][j][1] * rs * g[j][1], v[u][j][2] * rs * g[j][2], v[u][j][3] * rs * g[j][3]}; }
    }
}

#ifdef PROBE
__device__ __forceinline__ void phase_probe(const Args& a) {
    const int gt = blockIdx.x * 512 + threadIdx.x, NT = gridDim.x * 512;
#if PROBE == 1
    const bf16_t* src = (const bf16_t*)(a.ws + WS_HP); const size_t n = (size_t)T * DM;
#elif PROBE == 2
    const bf16_t* src = (const bf16_t*)(a.ws + WS_WPG); const size_t n = (size_t)1024 * 1024;
#else
    const bf16_t* src = (const bf16_t*)(a.ws + WS_G); const size_t n = (size_t)T * DM;
#endif
    for (size_t i = gt; i < (size_t)T * DM; i += NT) a.out[i] = (i < n) ? __builtin_bit_cast(float, (unsigned)src[i] << 16) : 0.f;
}
#endif
__global__ void __launch_bounds__(512) mega_fwd(Args a) {
    extern __shared__ __attribute__((aligned(16))) unsigned char lds_raw[];
    LAS unsigned char* lds = (LAS unsigned char*)lds_raw;
    unsigned char* ws = a.ws;
    const int G = gridDim.x, c = blockIdx.x;
    const int lo = a.ph_lo, hi = a.ph_hi;
    if (threadIdx.x < 32) ((LAS unsigned*)(lds + MISC_OFF))[threadIdx.x] = 0u;
    __syncthreads();
    XcdBarrier bar; bar.bar = (unsigned*)(ws + WS_CTL) + 4096; bar.x = 0; bar.st = nullptr;
    if (hi - lo > 1) bar = xcd_barrier_post((unsigned*)(ws + WS_CTL) + 4096, (volatile LAS unsigned*)(lds + MISC_OFF));
#ifndef DUPMASK
#define DUPMASK 0
#endif
#ifndef PHMASK
#define PHMASK 0xFFFFF
#endif
#define IN(k) ((((PHMASK) >> (k)) & 1) && lo <= (k) && (k) < hi)
#define SEAM_MASK 0x5FBB7u
#define SEAM(k) do { if (IN(k) && IN((k) + 1)) { if ((SEAM_MASK >> (k)) & 1u) { xcd_barrier(bar); } else __syncthreads(); } } while (0)
    bf16_t* COLS = (bf16_t*)(ws + WS_A);
    TSTART(100);
    if (IN(0)) for (int rep_ = 0; rep_ < (((DUPMASK) >> 0) & 1 ? 2 : 1); ++rep_) { phase0(a, lds); }
    SEAM(0);
    TSTOP(100);
    TSTART(101);
    if (IN(1)) for (int rep_ = 0; rep_ < (((DUPMASK) >> 1) & 1 ? 2 : 1); ++rep_) {
        pg8::DenseSched S; S.init(a.out, 1024, ws + WS_WIN, 1024, T, INC, G, c);
        pg8::EpiRow8<F_Cols> E{{COLS, INC, (bf16_t*)(ws + WS_UG)}};
        pg8::gemm_phase<pg8::EpiRow8<F_Cols>, pg8::DenseSched, true>(lds, 1024, 1024, 1024, S, E);
    }
    SEAM(1);
    TSTOP(101);
    TSTART(102);
    if (IN(2)) for (int rep_ = 0; rep_ < (((DUPMASK) >> 2) & 1 ? 2 : 1); ++rep_) { phase2(a); }
    SEAM(2);
    TSTOP(102);
    TSTART(103);
    if (IN(3)) for (int rep_ = 0; rep_ < (((DUPMASK) >> 3) & 1 ? 2 : 1); ++rep_) {
        pg8::LoraSched S{(const char*)(ws + WS_Z), (const char*)(ws + WS_WLORA), {}}; S.so.init(T, 1536, G, c);
        pg8::EpiRow8<F_Lora> E{{(bf16_t*)a.out, a.in[I_W0], a.in[I_A0]}};
        pg8::gemm_phase<pg8::EpiRow8<F_Lora>, pg8::LoraSched, true>(lds, 128, 256, 256, S, E);
    }
    SEAM(3);
    TSTOP(103);
    TSTART(104);
    if (IN(4)) for (int rep_ = 0; rep_ < (((DUPMASK) >> 4) & 1 ? 2 : 1); ++rep_) {
        pg8::GroupSched S{(const char*)(ws + WS_UG), (const char*)(ws + WS_W1), S5K, 512, 4, 1, 16, G, c, (size_t)S5ROWS * S5K * 2, (size_t)256 * 512 * 2};
        pg8::EpiRow8<F_S5a> E{{(float*)(ws + WS_E)}};
        pg8::gemm_phase<pg8::EpiRow8<F_S5a>, pg8::GroupSched, true>(lds, 512, S5K, 512, S, E);
        if (G == 256) { late_items_idle(a, lds, 0, 896, 64); late_items_idle(a, lds, 1536, 1568, 64); }
    }
    SEAM(4);
    TSTOP(104);
    TSTART(105);
    if (IN(5)) for (int rep_ = 0; rep_ < (((DUPMASK) >> 5) & 1 ? 2 : 1); ++rep_) {
#if WKV_CHUNKED == 2
        phase4s(a, lds, bar);
#elif WKV_CHUNKED
        phase4c(a, lds);
#else
        phase4(a, lds);
#endif
    }
    SEAM(5);
    TSTOP(105);
    TSTART(106);
    if (IN(6)) for (int rep_ = 0; rep_ < (((DUPMASK) >> 6) & 1 ? 2 : 1); ++rep_) { phase5_post(a); }
    SEAM(6);
    TSTOP(106);
    TSTART(107);
    if (IN(7)) for (int rep_ = 0; rep_ < (((DUPMASK) >> 7) & 1 ? 2 : 1); ++rep_) {
        pg8::GroupSched S{(const char*)(ws + WS_UG), (const char*)(ws + WS_TZ), S5K, S5K, 4, 2, 16, G, c, (size_t)S5ROWS * S5K * 2, (size_t)S5N * S5K * 2};
        pg8::EpiRow8<F_S5c> E{{COLS, a.in[I_SD], (bf16_t*)(ws + WS_Z)}};
        pg8::gemm_phase<pg8::EpiRow8<F_S5c>, pg8::GroupSched, true>(lds, S5K, S5K, S5K, S, E);
        if (G == 256) late_items_idle(a, lds, 1568, N_LATE, 128);
    }
    SEAM(7);
    TSTOP(107);
    TSTART(108);
    if (IN(8)) for (int rep_ = 0; rep_ < (((DUPMASK) >> 8) & 1 ? 2 : 1); ++rep_) {
        pg8::DenseSched S; S.init(ws + WS_Z, 256, ws + WS_WGLU, 256, T, 256, G, c);
        pg8::EpiRow8<F_Glu> E{{(const bf16_t*)(ws + WS_Z), a.in[I_GLUB], (bf16_t*)a.out}};
        pg8::gemm_phase<pg8::EpiRow8<F_Glu>, pg8::DenseSched, true>(lds, 256, 256, 256, S, E);
        if (G == 256) late_items_idle(a, lds, 896, 1536, 128);
    }
    SEAM(8);
    TSTOP(108);
    TSTART(109);
    if (IN(9)) for (int rep_ = 0; rep_ < (((DUPMASK) >> 9) & 1 ? 2 : 1); ++rep_) {
        pg8::BrSched S{(const char*)(ws + WS_RWKV), (const char*)(ws + WS_WBA), (const char*)a.out, (const char*)(ws + WS_WBB), {}}; S.so.init(T, DM, G, c);
        pg8::EpiBr E{COLS, (bf16_t*)(ws + WS_B)};
        pg8::gemm_phase2<pg8::EpiBr, pg8::BrSched, true, 8, 4>(lds, 512, 512, S, E);
    }
    SEAM(9);
    TSTOP(109);
    TSTART(110);
    SEAM(10);
    TSTOP(110);
    TSTART(111);
    if (IN(11)) for (int rep_ = 0; rep_ < (((DUPMASK) >> 11) & 1 ? 2 : 1); ++rep_) {
        pg8::DenseSched S; S.init(ws + WS_B, 1024, ws + WS_WOUT, 1024, T, DM, G, c);
        pg8::EpiRow8<F_Res> E{{a.in[I_X], a.out}};
        pg8::gemm_phase<pg8::EpiRow8<F_Res>, pg8::DenseSched, true>(lds, 1024, 1024, 1024, S, E);
    }
    SEAM(11);
    TSTOP(111);
    TSTART(112);
    if (IN(12)) for (int rep_ = 0; rep_ < (((DUPMASK) >> 12) & 1 ? 2 : 1); ++rep_) { phase9(a, lds); }
    SEAM(12);
    TSTOP(112);
    TSTART(113);
    if (IN(13)) for (int rep_ = 0; rep_ < (((DUPMASK) >> 13) & 1 ? 2 : 1); ++rep_) { phase10(a, lds); }
    SEAM(13);
    TSTOP(113);
    TSTART(114);
    if (IN(14)) for (int rep_ = 0; rep_ < (((DUPMASK) >> 14) & 1 ? 2 : 1); ++rep_) {
        pg8::MoeSched S{(const int*)(ws + WS_OFF), (const char*)(ws + WS_A), (const char*)(ws + WS_WGU), 1024, 1024, 2, G, c, (size_t)512 * 1024 * 2};
        pg8::EpiMoeUp E{(bf16_t*)(ws + WS_HID)};
        pg8::gemm_phase<pg8::EpiMoeUp, pg8::MoeSched, true>(lds, 1024, 1024, 1024, S, E);
    }
    SEAM(14);
    TSTOP(114);
    TSTART(115);
    if (IN(15)) for (int rep_ = 0; rep_ < (((DUPMASK) >> 15) & 1 ? 2 : 1); ++rep_) {
        pg8::MoeSched S{(const int*)(ws + WS_OFF), (const char*)(ws + WS_HID), (const char*)(ws + WS_WD), 256, 256, 4, G, c, (size_t)1024 * 256 * 2};
        pg8::EpiRow8<F_MoeDown> E{{(const float*)(ws + WS_ROWW), (bf16_t*)(ws + WS_A)}};
        pg8::gemm_phase<pg8::EpiRow8<F_MoeDown>, pg8::MoeSched, true>(lds, 256, 256, 256, S, E);
    }
    SEAM(15);
    TSTOP(115);
    TSTART(116);
    if (IN(16)) for (int rep_ = 0; rep_ < (((DUPMASK) >> 16) & 1 ? 2 : 1); ++rep_) { phase13(a); }
    SEAM(16);
    TSTOP(116);
    TSTART(117);
    if (IN(17)) for (int rep_ = 0; rep_ < (((DUPMASK) >> 17) & 1 ? 2 : 1); ++rep_) {
        pg8::DenseSched S; S.init(ws + WS_HP, 1024, ws + WS_WPG, 1024, T, DM, G, c);
        pg8::EpiRow8<F_PleG> E{{(bf16_t*)(ws + WS_G)}};
        pg8::gemm_phase<pg8::EpiRow8<F_PleG>, pg8::DenseSched, true>(lds, 1024, 1024, 1024, S, E);
    }
    SEAM(17);
    TSTOP(117);
    TSTART(118);
    if (IN(18)) for (int rep_ = 0; rep_ < (((DUPMASK) >> 18) & 1 ? 2 : 1); ++rep_) {
        pg8::DenseSched S; S.init(ws + WS_P16, 256, ws + WS_WPP, 256, T, DM, G, c);
        pg8::EpiRow8<F_PleP> E{{(const bf16_t*)(ws + WS_G), a.out, (float*)(ws + WS_A)}};
        pg8::gemm_phase<pg8::EpiRow8<F_PleP>, pg8::DenseSched, true>(lds, 256, 256, 256, S, E);
    }
    SEAM(18);
    TSTOP(118);
#ifdef PROBE
    TSTART(119);
    if (IN(19)) for (int rep_ = 0; rep_ < (((DUPMASK) >> 19) & 1 ? 2 : 1); ++rep_) { phase_probe(a); }
#else
    TSTART(119);
    if (IN(19)) for (int rep_ = 0; rep_ < (((DUPMASK) >> 19) & 1 ? 2 : 1); ++rep_) { phase15(a, ((PHMASK >> 18) & 1) ? (const float*)(ws + WS_A) : (const float*)a.out); }
#endif
    TSTOP(119);
#if TIMER_SEL || TIMER_PHMASK
    if (blockIdx.x == 0 && threadIdx.x == 0) { const unsigned acc_ = ((volatile LAS unsigned*)(lds + MISC_OFF + 64))[0]; const unsigned long long t0_ = __builtin_amdgcn_s_memrealtime();
        while (__builtin_amdgcn_s_memrealtime() - t0_ < (unsigned long long)acc_ * TIMER_MULT) __builtin_amdgcn_s_sleep(8); }
#endif
#undef IN
#undef SEAM
}

extern "C" void kernel_launch(void* const* d_in, const int* in_sizes, int n_in, void* d_out, int out_size, void* d_ws, size_t ws_size, hipStream_t stream) {
    static int grid = 0;
    if (grid == 0) {
        if (n_in != 40 || out_size != T * DM || ws_size < WS_END) { fprintf(stderr, "kernel_launch: unexpected problem (n_in %d, out %d, ws %zu < %zu); nothing launched\n", n_in, out_size, ws_size, (size_t)WS_END); grid = -1; return; }
        int dev = 0, cus = 0, per_cu = 0;
        hipGetDevice(&dev); hipDeviceGetAttribute(&cus, hipDeviceAttributeMultiprocessorCount, dev);
        if (hipFuncSetAttribute((const void*)mega_fwd, hipFuncAttributeMaxDynamicSharedMemorySize, LDS_BYTES) != hipSuccess) { fprintf(stderr, "kernel_launch: hipFuncSetAttribute failed\n"); grid = -1; return; }
        if (hipOccupancyMaxActiveBlocksPerMultiprocessor(&per_cu, (const void*)mega_fwd, 512, LDS_BYTES) != hipSuccess || per_cu < 1) { fprintf(stderr, "kernel_launch: occupancy query says %d\n", per_cu); per_cu = 1; }
        (void)hipGetLastError();
        grid = cus * 1;
        if (grid > 256) grid = 256;
    }
    if (grid < 0) return;
    Args a{};
    for (int i = 0; i < 40; ++i) a.in[i] = (const float*)d_in[i];
    a.out = (float*)d_out; a.ws = (unsigned char*)d_ws;
#if MK_N_LAUNCHES == 1
    if (hipMemsetAsync((char*)d_ws + WS_CTL, 0, 65536, stream) != hipSuccess) { fprintf(stderr, "kernel_launch: memset failed\n"); return; }
    a.ph_lo = 0; a.ph_hi = NPHASE;
    void* kargs[] = {&a};
    hipError_t e = hipLaunchCooperativeKernel((const void*)mega_fwd, dim3(grid), dim3(512), kargs, LDS_BYTES, stream);
    if (e != hipSuccess) fprintf(stderr, "kernel_launch: cooperative launch failed: %s\n", hipGetErrorString(e));
#else
    for (int k = 0; k < NPHASE; ++k) {
        a.ph_lo = k; a.ph_hi = k + 1;
        hipLaunchKernelGGL(mega_fwd, dim3(grid), dim3(512), LDS_BYTES, stream, a);
    }
#endif
}
```

```cpp
#include <hip/hip_runtime.h>
#include <hip/hip_cooperative_groups.h>
#include <cstdio>
#include <cstdint>
namespace cg = cooperative_groups;

#ifndef WKV_CHUNKED
#define WKV_CHUNKED 2
#endif
#ifndef MK_N_LAUNCHES
#define MK_N_LAUNCHES 1
#endif

#define LAS __attribute__((address_space(3)))
typedef unsigned short bf16_t;
typedef short bf16x8 __attribute__((ext_vector_type(8)));
typedef float f32x4 __attribute__((ext_vector_type(4)));
typedef float f32x2 __attribute__((ext_vector_type(2)));
typedef unsigned u32x4 __attribute__((ext_vector_type(4)));
typedef unsigned u32x2 __attribute__((ext_vector_type(2)));

constexpr int T = 32768, DM = 1024, SEQ = 2048, NBATCH = 16, INC = 4096;
constexpr int C_R = 0, C_K = 512, C_V = 1024, C_WD = 1536, C_U = 1792, C_GA = 2048, C_GB = 3072;
constexpr int S5L = 32, S5NCH = 64, S5K = 640, S5N = 512, S5ROWS = 1024;
constexpr int NEXP = 32, DEXP = 256, MOE_ROWS_MAX = 2 * T + NEXP * 256;
constexpr int NPHASE = 20;

constexpr size_t MiB = (size_t)1 << 20, KiB = 1024;
constexpr size_t WS_CTL = 0;
constexpr size_t WS_WIN = 1 * MiB, WS_WBA = 9 * MiB, WS_WBB = 10 * MiB, WS_WOUT = 11 * MiB, WS_WPG = 13 * MiB, WS_WPP = 15 * MiB;
constexpr size_t WS_WLORA = 16 * MiB, WS_WGLU = 17 * MiB, WS_WR = 17 * MiB + 512 * KiB, WS_LAML = 17 * MiB + 768 * KiB;
constexpr size_t WS_KG = 18 * MiB, WS_W1 = 19 * MiB, WS_TZ = 23 * MiB, WS_WGU = 33 * MiB, WS_WD = 65 * MiB;
constexpr size_t WS_A = 82 * MiB;
constexpr size_t WS_HID = WS_A + 144 * MiB, WS_G = WS_A + 128 * MiB;
constexpr size_t WS_B = 338 * MiB;
constexpr size_t WS_UG = 402 * MiB, WS_E = 422 * MiB, WS_BON = 430 * MiB, WS_RWKV = 431 * MiB, WS_Z = 463 * MiB, WS_S5O = 479 * MiB;
constexpr size_t WS_ROUTE = 495 * MiB, WS_POS = 495 * MiB + 512 * KiB, WS_ROWW = 496 * MiB, WS_BC = 496 * MiB + 512 * KiB, WS_OFF = 496 * MiB + 768 * KiB;
constexpr size_t WS_HP = WS_RWKV;
constexpr size_t WS_P16 = WS_UG;
constexpr size_t WS_END = 497 * MiB;

constexpr int LDS_BYTES = 163840;
constexpr int MISC_OFF = 163584;

struct Args { const float* in[40]; float* out; unsigned char* ws; int ph_lo, ph_hi; };

#ifndef TIMER_SEL
#define TIMER_SEL 0
#endif
#ifndef TIMER_MULT
#define TIMER_MULT 2
#endif
#ifndef TIMER_PHMASK
#define TIMER_PHMASK 0
#endif
#if TIMER_SEL || TIMER_PHMASK
#define TSTART(id) do { if (((id) == TIMER_SEL || ((id) >= 100 && ((TIMER_PHMASK >> ((id) - 100)) & 1))) && blockIdx.x == 0 && threadIdx.x == 0) { volatile LAS unsigned* t_ = (volatile LAS unsigned*)(lds + MISC_OFF + 64); t_[0] = t_[0] - (unsigned)__builtin_amdgcn_s_memrealtime(); } } while (0)
#define TSTOP(id) do { if (((id) == TIMER_SEL || ((id) >= 100 && ((TIMER_PHMASK >> ((id) - 100)) & 1))) && blockIdx.x == 0 && threadIdx.x == 0) { volatile LAS unsigned* t_ = (volatile LAS unsigned*)(lds + MISC_OFF + 64); t_[0] = t_[0] + (unsigned)__builtin_amdgcn_s_memrealtime(); } } while (0)
#else
#define TSTART(id) do { } while (0)
#define TSTOP(id) do { } while (0)
#endif

#define LDS_WAIT() asm volatile("s_waitcnt lgkmcnt(0)" ::: "memory")
#define VM_WAIT() asm volatile("s_waitcnt vmcnt(0)" ::: "memory")
__device__ __forceinline__ unsigned f2bf(float f) { unsigned u = __builtin_bit_cast(unsigned, f); return (u + 0x7fffu + ((u >> 16) & 1u)) >> 16; }
__device__ __forceinline__ unsigned pk2(float lo, float hi) { return f2bf(lo) | (f2bf(hi) << 16); }
typedef __bf16 bf16x2_t __attribute__((ext_vector_type(2)));
__device__ __forceinline__ unsigned cvt_pk_bf16(float lo, float hi) { const f32x2 v = {lo, hi}; const bf16x2_t b = __builtin_convertvector(v, bf16x2_t); return __builtin_bit_cast(unsigned, b); }
__device__ __forceinline__ float bflo(unsigned w) { return __builtin_bit_cast(float, w << 16); }
__device__ __forceinline__ float bfhi(unsigned w) { return __builtin_bit_cast(float, w & 0xffff0000u); }
__device__ __forceinline__ void unpack8(u32x4 w, float (&v)[8]) { v[0] = bflo(w.x); v[1] = bfhi(w.x); v[2] = bflo(w.y); v[3] = bfhi(w.y); v[4] = bflo(w.z); v[5] = bfhi(w.z); v[6] = bflo(w.w); v[7] = bfhi(w.w); }
__device__ __forceinline__ void unpack4(u32x2 w, float (&v)[4]) { v[0] = bflo(w.x); v[1] = bfhi(w.x); v[2] = bflo(w.y); v[3] = bfhi(w.y); }
__device__ __forceinline__ u32x4 pack8(const float (&v)[8]) { u32x4 w; w.x = cvt_pk_bf16(v[0], v[1]); w.y = cvt_pk_bf16(v[2], v[3]); w.z = cvt_pk_bf16(v[4], v[5]); w.w = cvt_pk_bf16(v[6], v[7]); return w; }
__device__ __forceinline__ float sigmoidf_(float x) { return __builtin_amdgcn_rcpf(1.0f + __expf(-x)); }
__device__ __forceinline__ float tanhf_(float x) { return 1.0f - 2.0f * __builtin_amdgcn_rcpf(1.0f + __expf(2.0f * x)); }
__device__ __forceinline__ float gelu_tanh(float y) { return 0.5f * y * (1.0f + tanhf_(0.7978845608028654f * (y + 0.044715f * y * y * y))); }
__device__ __forceinline__ float wave_sum(float v) {
#pragma unroll
    for (int o = 1; o < 64; o <<= 1) v += __shfl_xor(v, o);
    return v;
}
__device__ __forceinline__ float dpp_f(float x, const int ctrl_sel) {
    int xi = __builtin_bit_cast(int, x), r;
    if (ctrl_sel == 0) r = __builtin_amdgcn_update_dpp(0, xi, 0xB1, 0xf, 0xf, true);
    else if (ctrl_sel == 1) r = __builtin_amdgcn_update_dpp(0, xi, 0x4E, 0xf, 0xf, true);
    else if (ctrl_sel == 2) r = __builtin_amdgcn_update_dpp(0, xi, 0x141, 0xf, 0xf, true);
    else r = __builtin_amdgcn_update_dpp(0, xi, 0x140, 0xf, 0xf, true);
    return __builtin_bit_cast(float, r);
}
__device__ __forceinline__ float row16_sum(float x) {
    x += dpp_f(x, 0); x += dpp_f(x, 1); x += dpp_f(x, 2); x += dpp_f(x, 3); return x;
}


#define XB_TMO      128
#define XB_XCNT(j)  (256  + 64 * (j))
#define XB_XSUB(j)  (1280 + 64 * (j))
#define XB_XGEN(j)  (2304 + 64 * (j))
#define XB_TOP      3328
#define XB_TOPGEN   3392
#define XCD_BAR_WORDS 3456
#define XB_SPIN_CAP (1u << 22)
__device__ __forceinline__ unsigned xb_ld(unsigned* p)              { return __hip_atomic_load(p, __ATOMIC_RELAXED, __HIP_MEMORY_SCOPE_AGENT); }
__device__ __forceinline__ unsigned xb_add(unsigned* p, unsigned v) { return __hip_atomic_fetch_add(p, v, __ATOMIC_RELAXED, __HIP_MEMORY_SCOPE_AGENT); }
__device__ __forceinline__ unsigned xb_xcc_id() { return (unsigned)__builtin_amdgcn_s_getreg((3 << 11) | 20) & 0xFu; }
#define XB_SPIN(cond, bar) do { unsigned _sp = 0; while (cond) { __builtin_amdgcn_s_sleep(1); \
    if ((++_sp & 255u) == 0u) { if (xb_ld(&(bar)[XB_TMO])) break; if (_sp > XB_SPIN_CAP) { atomicAdd(&(bar)[XB_TMO], 1u); break; } } } } while (0)
struct XcdBarrier { unsigned* bar; unsigned x; volatile LAS unsigned* st; };
__device__ __forceinline__ XcdBarrier xcd_barrier_post(unsigned* bar, volatile LAS unsigned* st) {
    XcdBarrier b; b.bar = bar; b.x = xb_xcc_id(); b.st = st;
    if (threadIdx.x == 0) (void)xb_add(&bar[XB_XCNT(b.x)], 1u);
    return b;
}
__device__ __forceinline__ void xcd_barrier_complete(unsigned* bar, unsigned x, unsigned& nloc, unsigned& nx) {
    const unsigned G = gridDim.x * gridDim.y * gridDim.z;
    unsigned sum, cnt, mine, sp = 0u;
    for (;;) {
        sum = 0u; cnt = 0u; mine = 0u;
#pragma unroll
        for (unsigned j = 0; j < 16; ++j) { const unsigned c = xb_ld(&bar[XB_XCNT(j)]); sum += c; cnt += (c > 0u) ? 1u : 0u; mine = (j == x) ? c : mine; }
        if (sum == G) break;
        __builtin_amdgcn_s_sleep(1);
        if ((++sp & 255u) == 0u) { if (xb_ld(&bar[XB_TMO])) break; if (sp > XB_SPIN_CAP) { atomicAdd(&bar[XB_TMO], 1u); break; } }
    }
    nloc = mine > 0u ? mine : 1u; nx = cnt > 0u ? cnt : 1u;
}
__device__ __forceinline__ void xcd_barrier(const XcdBarrier& b) {
    asm volatile("s_waitcnt vmcnt(0)" ::: "memory");
    __syncthreads();
    if (threadIdx.x == 0) {
        unsigned* bar = b.bar;
        __builtin_amdgcn_s_waitcnt(0);
        unsigned nloc = b.st[0], nx = b.st[1];
        if (nloc == 0u) { xcd_barrier_complete(bar, b.x, nloc, nx); b.st[0] = nloc; b.st[1] = nx; }
        const unsigned old = xb_add(&bar[XB_XSUB(b.x)], 1u);
        const unsigned gen = old / nloc;
        if (old + 1u == (gen + 1u) * nloc) {
            __builtin_amdgcn_fence(__ATOMIC_RELEASE, "agent");
            asm volatile("s_waitcnt vmcnt(0)" ::: "memory");
            const unsigned og = xb_add(&bar[XB_TOP], 1u);
            const unsigned tg = og / nx;
            if (og + 1u == (tg + 1u) * nx) xb_add(&bar[XB_TOPGEN], 1u);
            else XB_SPIN(xb_ld(&bar[XB_TOPGEN]) == tg, bar);
            __builtin_amdgcn_fence(__ATOMIC_ACQUIRE, "agent");
            xb_add(&bar[XB_XGEN(b.x)], 1u);
            asm volatile("s_waitcnt vmcnt(0)" ::: "memory");
        } else {
            XB_SPIN(xb_ld(&bar[XB_XGEN(b.x)]) == gen, bar);
            __builtin_amdgcn_fence(__ATOMIC_ACQUIRE, "agent");
            asm volatile("s_waitcnt vmcnt(0)" ::: "memory");
        }
    }
    __syncthreads();
}

namespace pg8 {
constexpr int BM = 256, BK = 64, HALF = 128, HTB = HALF * BK * 2, STAGE_BYTES = 8 * HTB, NXCD = 8, WGM = 8;
__host__ __device__ __forceinline__ int lds_byte(int r, int c) { const int st = (r >> 4) * 2 + (c >> 5), rr = r & 15, cc = c & 31, ob = rr * 64 + cc * 2; return st * 1024 + (ob ^ (((ob >> 9) & 1) << 5)); }
__host__ __device__ __forceinline__ void stage_rc(int b, int& R, int& C) { const int st = b / 1024, sb = b % 1024, swz = sb ^ (((sb >> 9) & 1) << 5); R = (st >> 1) * 16 + swz / 64; C = (st & 1) * 32 + (swz % 64) / 2; }
__host__ __device__ __forceinline__ int perm32(int rho) { const int n = rho >> 4, i = rho & 15; return 8 * (i >> 2) + 4 * n + (i & 3); }

struct Unit { int pm, pn, aux; const char* A; const char* B; };

struct StaticOrder {
    int nM, nN, nwg, G, c;
    __device__ __forceinline__ void init(int M, int N, int G_, int c_) { nM = M / BM; nN = N / BM; nwg = nM * nN; G = G_; c = c_; }
    __device__ __forceinline__ bool next(int i, int& pm, int& pn) const {
        const long L = (long)i * G + c; if (L >= nwg) return false;
        int wgid = (int)L; { const int q = nwg / NXCD, r = nwg % NXCD, xcd = wgid % NXCD, off = wgid / NXCD; wgid = (xcd < r ? xcd * (q + 1) : r * (q + 1) + (xcd - r) * q) + off; }
        const int nig = WGM * nN, gid = wgid / nig, fm = gid * WGM, gsz = (nM - fm) < WGM ? (nM - fm) : WGM;
        pm = fm + ((wgid % nig) % gsz); pn = (wgid % nig) / gsz; return true;
    }
};
struct DenseSched {
    const char* A; const char* B; int lda, ldb; StaticOrder so;
    __device__ __forceinline__ void init(const void* A_, int lda_, const void* B_, int ldb_, int M, int N, int G, int c) { A = (const char*)A_; B = (const char*)B_; lda = lda_; ldb = ldb_; so.init(M, N, G, c); }
    __device__ __forceinline__ bool next(int i, Unit& u) const {
        int pm, pn; if (!so.next(i, pm, pn)) return false;
        u.pm = pm; u.pn = pn; u.aux = 0; u.A = A + (size_t)pm * BM * lda * 2; u.B = B + (size_t)pn * BM * ldb * 2; return true;
    }
};
struct LoraSched {
    const char* A; const char* B; StaticOrder so;
    __device__ __forceinline__ bool next(int i, Unit& u) const {
        int pm, pn; if (!so.next(i, pm, pn)) return false;
        const int k0 = pn < 4 ? 0 : 128;
        u.pm = pm; u.pn = pn; u.aux = 0; u.A = A + ((size_t)pm * BM * 256 + k0) * 2; u.B = B + ((size_t)pn * BM * 256 + k0) * 2; return true;
    }
};
struct GroupSched {
    const char* A; const char* B; int lda, ldb, nM, nN, ngroups, G, c; size_t aStride, bStride;
    __device__ __forceinline__ bool next(int i, Unit& u) const {
        const int L = i * G + c; if (L >= ngroups * nM * nN) return false;
        const int g = L / (nM * nN), r = L % (nM * nN), pm = r % nM, pn = r / nM;
        u.pm = pm; u.pn = pn; u.aux = g; u.A = A + g * aStride + (size_t)pm * BM * lda * 2; u.B = B + g * bStride + (size_t)pn * BM * ldb * 2; return true;
    }
};
struct MoeSched {
    const int* off; const char* A; const char* B; int lda, ldb, NPN, G, c; size_t bStride;
    __device__ __forceinline__ bool next(int i, Unit& u) const {
        const int nTiles = off[NEXP] >> 8; const int L = i * G + c; if (L >= nTiles * NPN) return false;
        const int tile = L / NPN, pn = L % NPN, row = tile << 8; int e = 0;
        for (int k = 1; k < NEXP; ++k) e += (off[k] <= row) ? 1 : 0;
        u.pm = tile; u.pn = pn; u.aux = e; u.A = A + (size_t)tile * BM * lda * 2; u.B = B + e * bStride + (size_t)pn * BM * ldb * 2; return true;
    }
};

template <class F> struct EpiRow8 {
    F f;
    __device__ __forceinline__ void operator()(const f32x4 (&acc)[2][2][4][2], const Unit& u, int wr, int wc, int fr, int fq) const {
#pragma unroll
        for (int ai = 0; ai < 2; ++ai)
#pragma unroll
            for (int m = 0; m < 4; ++m) { const int r = ai * HALF + wr * 64 + m * 16 + fr;
#pragma unroll
                for (int bj = 0; bj < 2; ++bj) { const int c = bj * HALF + wc * 32 + 8 * fq;
                    float v[8] = {acc[ai][bj][m][0][0], acc[ai][bj][m][0][1], acc[ai][bj][m][0][2], acc[ai][bj][m][0][3], acc[ai][bj][m][1][0], acc[ai][bj][m][1][1], acc[ai][bj][m][1][2], acc[ai][bj][m][1][3]};
                    f(u, r, c, v); } }
    }
};
struct EpiMoeUp {
    bf16_t* HID;
    __device__ __forceinline__ void operator()(const f32x4 (&acc)[2][2][4][2], const Unit& u, int wr, int wc, int fr, int fq) const {
#pragma unroll
        for (int ai = 0; ai < 2; ++ai)
#pragma unroll
            for (int m = 0; m < 4; ++m) { const int r = u.pm * BM + ai * HALF + wr * 64 + m * 16 + fr; const int hc = u.pn * HALF + wc * 32 + 8 * fq;
                float o[8];
#pragma unroll
                for (int n = 0; n < 2; ++n)
#pragma unroll
                    for (int k = 0; k < 4; ++k) { const float g = acc[ai][0][m][n][k], up = acc[ai][1][m][n][k]; o[4 * n + k] = g * sigmoidf_(g) * up; }
                *(u32x4*)(HID + (size_t)r * DEXP + hc) = pack8(o); }
    }
};

template <class Epi, class Sched, bool ALIGN_EPI>
__device__ __forceinline__ void gemm_phase(LAS unsigned char* lds, const int K, const int lda, const int ldb, const Sched& S, const Epi& E) {
    const int tid = threadIdx.x, wid = __builtin_amdgcn_readfirstlane(tid >> 6), lane = tid & 63, wr = wid >> 2, wc = wid & 3, fr = lane & 15, fq = lane >> 4;
    const int nt = K / BK;
    unsigned voffA[2], voffB[2];
#pragma unroll
    for (int i = 0; i < 2; ++i) { int R, C; stage_rc(tid * 16 + i * 8192, R, C); const int Rb = (R & ~31) + perm32(R & 31);
        voffA[i] = (unsigned)(R * lda + C) * 2u; voffB[i] = (unsigned)(Rb * ldb + C) * 2u; }
    const size_t kstep = (size_t)(BK * 2);
    const size_t hstepA = (size_t)HALF * lda * 2, hstepB = (size_t)HALF * ldb * 2;
    const unsigned ldsw = (unsigned)wid * 1024u;
    const int aoff = lds_byte(wr * 64 + fr, fq * 8), boff = lds_byte(wc * 32 + fr, fq * 8);
#define PG8_SA(b, h) (((b) * 2 + (h)) * HTB)
#define PG8_SB(b, h) ((4 + (b) * 2 + (h)) * HTB)
#define PG8_STAGE(bufoff, gbase, voff) do { _Pragma("unroll") for (int _i = 0; _i < 2; ++_i) \
        __builtin_amdgcn_global_load_lds((const unsigned*)((const char*)(gbase) + (voff)[_i]), (LAS unsigned*)(lds + (bufoff) + ldsw + _i * 8192), 16, 0, 0); } while (0)
#define PG8_LDA(dst, b, h) do { _Pragma("unroll") for (int m = 0; m < 4; ++m) _Pragma("unroll") for (int k = 0; k < 2; ++k) dst[m][k] = *(const LAS bf16x8*)(lds + PG8_SA(b, h) + aoff + m * 2048 + k * 1024); } while (0)
#define PG8_LDB(dst, b, h) do { _Pragma("unroll") for (int n = 0; n < 2; ++n) _Pragma("unroll") for (int k = 0; k < 2; ++k) dst[n][k] = *(const LAS bf16x8*)(lds + PG8_SB(b, h) + boff + n * 2048 + k * 1024); } while (0)
#define PG8_MMA(ai, bj, At, Bt) do { __builtin_amdgcn_s_setprio(1); _Pragma("unroll") for (int m = 0; m < 4; ++m) _Pragma("unroll") for (int n = 0; n < 2; ++n) _Pragma("unroll") for (int k = 0; k < 2; ++k) \
        acc[ai][bj][m][n] = __builtin_amdgcn_mfma_f32_16x16x32_bf16(Bt[n][k], At[m][k], acc[ai][bj][m][n], 0, 0, 0); __builtin_amdgcn_s_setprio(0); } while (0)
#define PG8_WAIT_V(n) asm volatile("s_waitcnt vmcnt(" #n ")" ::: "memory")
#define PG8_WAIT_L(n) asm volatile("s_waitcnt lgkmcnt(" #n ")" ::: "memory")
#define PG8_BAR __builtin_amdgcn_s_barrier()
#define PG8_SCHED __builtin_amdgcn_sched_barrier(0)
    Unit cur, nxt; int ui = 0;
    if (!S.next(0, cur)) return;
    f32x4 acc[2][2][4][2];
#pragma unroll
    for (int a = 0; a < 2; ++a)
#pragma unroll
        for (int b = 0; b < 2; ++b)
#pragma unroll
            for (int m = 0; m < 4; ++m)
#pragma unroll
                for (int n = 0; n < 2; ++n) acc[a][b][m][n] = (f32x4){0.f, 0.f, 0.f, 0.f};
    bf16x8 At[4][2], B0[2][2], B1[2][2];
    const char* cA = cur.A; const char* cB = cur.B;
    PG8_STAGE(PG8_SB(0, 0), cB, voffB); PG8_STAGE(PG8_SB(0, 1), cB + hstepB, voffB); PG8_STAGE(PG8_SA(0, 0), cA, voffA); PG8_STAGE(PG8_SA(0, 1), cA + hstepA, voffA);
    if (wr == 1) PG8_BAR;
    PG8_WAIT_V(2); PG8_BAR;
    PG8_STAGE(PG8_SB(1, 0), cB + kstep, voffB); PG8_STAGE(PG8_SA(1, 0), cA + kstep, voffA); PG8_STAGE(PG8_SB(1, 1), cB + hstepB + kstep, voffB);
    PG8_WAIT_V(6); PG8_BAR;
    for (;;) {
        const bool has_next = S.next(ui + 1, nxt);
        const char* nA = has_next ? nxt.A : cA; const char* nB = has_next ? nxt.B : cB;
#pragma unroll 1
        for (int t = 0; t < nt; t += 2) {
            const bool last = (t == nt - 2);
            const char* a1 = cA + (size_t)(t + 1) * kstep;
            const char* a2 = last ? nA : cA + (size_t)(t + 2) * kstep; const char* b2 = last ? nB : cB + (size_t)(t + 2) * kstep;
            const char* a3 = a2 + kstep; const char* b3 = b2 + kstep;
            PG8_LDB(B0, 0, 0); PG8_LDB(B1, 0, 1); PG8_SCHED; PG8_LDA(At, 0, 0); PG8_STAGE(PG8_SA(1, 1), a1 + hstepA, voffA);
            PG8_WAIT_V(8); PG8_WAIT_L(0); PG8_BAR; PG8_MMA(0, 0, At, B0); PG8_MMA(0, 1, At, B1); PG8_BAR; PG8_SCHED;
            PG8_LDA(At, 0, 1); PG8_STAGE(PG8_SB(0, 0), b2, voffB); PG8_STAGE(PG8_SB(0, 1), b2 + hstepB, voffB); PG8_STAGE(PG8_SA(0, 0), a2, voffA);
            PG8_WAIT_V(8); PG8_WAIT_L(0); PG8_BAR; PG8_MMA(1, 0, At, B0); PG8_MMA(1, 1, At, B1); PG8_BAR; PG8_SCHED;
            PG8_LDB(B0, 1, 0); PG8_LDB(B1, 1, 1); PG8_SCHED; PG8_LDA(At, 1, 0); PG8_STAGE(PG8_SA(0, 1), a2 + hstepA, voffA);
            PG8_WAIT_V(8); PG8_WAIT_L(0); PG8_BAR; PG8_MMA(0, 0, At, B0); PG8_MMA(0, 1, At, B1); PG8_BAR; PG8_SCHED;
            PG8_LDA(At, 1, 1); PG8_STAGE(PG8_SB(1, 0), b3, voffB); PG8_STAGE(PG8_SB(1, 1), b3 + hstepB, voffB); PG8_STAGE(PG8_SA(1, 0), a3, voffA);
            PG8_WAIT_V(8); PG8_WAIT_L(0); PG8_BAR; PG8_MMA(1, 0, At, B0); PG8_MMA(1, 1, At, B1); PG8_BAR; PG8_SCHED;
        }
        if constexpr (ALIGN_EPI) { if (wr == 0) PG8_BAR; }
        E(acc, cur, wr, wc, fr, fq);
        if (!has_next) break;
#pragma unroll
        for (int a = 0; a < 2; ++a)
#pragma unroll
            for (int b = 0; b < 2; ++b)
#pragma unroll
                for (int m = 0; m < 4; ++m)
#pragma unroll
                    for (int n = 0; n < 2; ++n) acc[a][b][m][n] = (f32x4){0.f, 0.f, 0.f, 0.f};
        cur = nxt; cA = nA; cB = nB; ++ui;
        if constexpr (ALIGN_EPI) { if (wr == 1) PG8_BAR; }
    }
    PG8_WAIT_V(0);
    if constexpr (!ALIGN_EPI) { if (wr == 0) PG8_BAR; }
    PG8_BAR;
#undef PG8_SA
#undef PG8_SB
#undef PG8_STAGE
#undef PG8_LDA
#undef PG8_LDB
#undef PG8_MMA
#undef PG8_WAIT_V
#undef PG8_WAIT_L
#undef PG8_BAR
#undef PG8_SCHED
}

struct Unit2 { int pm, pn; const char* A0; const char* B0; const char* A1; const char* B1; };
template <class Epi, class Sched, bool ALIGN_EPI, int NT0, int NT1>
__device__ __forceinline__ void gemm_phase2(LAS unsigned char* lds, const int lda, const int ldb, const Sched& S, const Epi& E) {
    const int tid = threadIdx.x, wid = __builtin_amdgcn_readfirstlane(tid >> 6), lane = tid & 63, wr = wid >> 2, wc = wid & 3, fr = lane & 15, fq = lane >> 4;
    unsigned voffA[2], voffB[2];
#pragma unroll
    for (int i = 0; i < 2; ++i) { int R, C; stage_rc(tid * 16 + i * 8192, R, C); const int Rb = (R & ~31) + perm32(R & 31);
        voffA[i] = (unsigned)(R * lda + C) * 2u; voffB[i] = (unsigned)(Rb * ldb + C) * 2u; }
    const size_t kstep = (size_t)(BK * 2);
    const size_t hstepA = (size_t)HALF * lda * 2, hstepB = (size_t)HALF * ldb * 2;
    const unsigned ldsw = (unsigned)wid * 1024u;
    const int aoff = lds_byte(wr * 64 + fr, fq * 8), boff = lds_byte(wc * 32 + fr, fq * 8);
#define PG8_SA(b, h) (((b) * 2 + (h)) * HTB)
#define PG8_SB(b, h) ((4 + (b) * 2 + (h)) * HTB)
#define PG8_STAGE(bufoff, gbase, voff) do { _Pragma("unroll") for (int _i = 0; _i < 2; ++_i) \
        __builtin_amdgcn_global_load_lds((const unsigned*)((const char*)(gbase) + (voff)[_i]), (LAS unsigned*)(lds + (bufoff) + ldsw + _i * 8192), 16, 0, 0); } while (0)
#define PG8_LDA(dst, b, h) do { _Pragma("unroll") for (int m = 0; m < 4; ++m) _Pragma("unroll") for (int k = 0; k < 2; ++k) dst[m][k] = *(const LAS bf16x8*)(lds + PG8_SA(b, h) + aoff + m * 2048 + k * 1024); } while (0)
#define PG8_LDB(dst, b, h) do { _Pragma("unroll") for (int n = 0; n < 2; ++n) _Pragma("unroll") for (int k = 0; k < 2; ++k) dst[n][k] = *(const LAS bf16x8*)(lds + PG8_SB(b, h) + boff + n * 2048 + k * 1024); } while (0)
#define PG8_MMA(ai, bj, At, Bt) do { __builtin_amdgcn_s_setprio(1); _Pragma("unroll") for (int m = 0; m < 4; ++m) _Pragma("unroll") for (int n = 0; n < 2; ++n) _Pragma("unroll") for (int k = 0; k < 2; ++k) \
        acc[ai][bj][m][n] = __builtin_amdgcn_mfma_f32_16x16x32_bf16(Bt[n][k], At[m][k], acc[ai][bj][m][n], 0, 0, 0); __builtin_amdgcn_s_setprio(0); } while (0)
#define PG8_WAIT_V(n) asm volatile("s_waitcnt vmcnt(" #n ")" ::: "memory")
#define PG8_WAIT_L(n) asm volatile("s_waitcnt lgkmcnt(" #n ")" ::: "memory")
#define PG8_BAR __builtin_amdgcn_s_barrier()
#define PG8_SCHED __builtin_amdgcn_sched_barrier(0)
#define PG8_KLOOP(NT, cA_, cB_, nA_, nB_) _Pragma("unroll 1") for (int t = 0; t < (NT); t += 2) { \
            const bool last = (t == (NT) - 2); \
            const char* a1 = (cA_) + (size_t)(t + 1) * kstep; \
            const char* a2 = last ? (nA_) : (cA_) + (size_t)(t + 2) * kstep; const char* b2 = last ? (nB_) : (cB_) + (size_t)(t + 2) * kstep; \
            const char* a3 = a2 + kstep; const char* b3 = b2 + kstep; \
            PG8_LDB(B0, 0, 0); PG8_LDB(B1, 0, 1); PG8_SCHED; PG8_LDA(At, 0, 0); PG8_STAGE(PG8_SA(1, 1), a1 + hstepA, voffA); \
            PG8_WAIT_V(8); PG8_WAIT_L(0); PG8_BAR; PG8_MMA(0, 0, At, B0); PG8_MMA(0, 1, At, B1); PG8_BAR; PG8_SCHED; \
            PG8_LDA(At, 0, 1); PG8_STAGE(PG8_SB(0, 0), b2, voffB); PG8_STAGE(PG8_SB(0, 1), b2 + hstepB, voffB); PG8_STAGE(PG8_SA(0, 0), a2, voffA); \
            PG8_WAIT_V(8); PG8_WAIT_L(0); PG8_BAR; PG8_MMA(1, 0, At, B0); PG8_MMA(1, 1, At, B1); PG8_BAR; PG8_SCHED; \
            PG8_LDB(B0, 1, 0); PG8_LDB(B1, 1, 1); PG8_SCHED; PG8_LDA(At, 1, 0); PG8_STAGE(PG8_SA(0, 1), a2 + hstepA, voffA); \
            PG8_WAIT_V(8); PG8_WAIT_L(0); PG8_BAR; PG8_MMA(0, 0, At, B0); PG8_MMA(0, 1, At, B1); PG8_BAR; PG8_SCHED; \
            PG8_LDA(At, 1, 1); PG8_STAGE(PG8_SB(1, 0), b3, voffB); PG8_STAGE(PG8_SB(1, 1), b3 + hstepB, voffB); PG8_STAGE(PG8_SA(1, 0), a3, voffA); \
            PG8_WAIT_V(8); PG8_WAIT_L(0); PG8_BAR; PG8_MMA(1, 0, At, B0); PG8_MMA(1, 1, At, B1); PG8_BAR; PG8_SCHED; }
    Unit2 cur, nxt; int ui = 0;
    if (!S.next(0, cur)) return;
    f32x4 acc[2][2][4][2];
#pragma unroll
    for (int a = 0; a < 2; ++a)
#pragma unroll
        for (int b = 0; b < 2; ++b)
#pragma unroll
            for (int m = 0; m < 4; ++m)
#pragma unroll
                for (int n = 0; n < 2; ++n) acc[a][b][m][n] = (f32x4){0.f, 0.f, 0.f, 0.f};
    bf16x8 At[4][2], B0[2][2], B1[2][2];
    {
        const char* cA = cur.A0; const char* cB = cur.B0;
        PG8_STAGE(PG8_SB(0, 0), cB, voffB); PG8_STAGE(PG8_SB(0, 1), cB + hstepB, voffB); PG8_STAGE(PG8_SA(0, 0), cA, voffA); PG8_STAGE(PG8_SA(0, 1), cA + hstepA, voffA);
        if (wr == 1) PG8_BAR;
        PG8_WAIT_V(2); PG8_BAR;
        PG8_STAGE(PG8_SB(1, 0), cB + kstep, voffB); PG8_STAGE(PG8_SA(1, 0), cA + kstep, voffA); PG8_STAGE(PG8_SB(1, 1), cB + hstepB + kstep, voffB);
        PG8_WAIT_V(6); PG8_BAR;
    }
    for (;;) {
        const bool has_next = S.next(ui + 1, nxt);
        const char* nA = has_next ? nxt.A0 : cur.A0; const char* nB = has_next ? nxt.B0 : cur.B0;
        PG8_KLOOP(NT0, cur.A0, cur.B0, cur.A1, cur.B1)
        E.mid(acc, cur, wr, wc, fr, fq);
        PG8_KLOOP(NT1, cur.A1, cur.B1, nA, nB)
        if constexpr (ALIGN_EPI) { if (wr == 0) PG8_BAR; }
        E.fin(acc, cur, wr, wc, fr, fq);
        if (!has_next) break;
#pragma unroll
        for (int a = 0; a < 2; ++a)
#pragma unroll
            for (int b = 0; b < 2; ++b)
#pragma unroll
                for (int m = 0; m < 4; ++m)
#pragma unroll
                    for (int n = 0; n < 2; ++n) acc[a][b][m][n] = (f32x4){0.f, 0.f, 0.f, 0.f};
        cur = nxt; ++ui;
        if constexpr (ALIGN_EPI) { if (wr == 1) PG8_BAR; }
    }
    PG8_WAIT_V(0);
    if constexpr (!ALIGN_EPI) { if (wr == 0) PG8_BAR; }
    PG8_BAR;
#undef PG8_KLOOP
#undef PG8_SA
#undef PG8_SB
#undef PG8_STAGE
#undef PG8_LDA
#undef PG8_LDB
#undef PG8_MMA
#undef PG8_WAIT_V
#undef PG8_WAIT_L
#undef PG8_BAR
#undef PG8_SCHED
}
struct BrSched {
    const char* A0; const char* B0; const char* A1; const char* B1; StaticOrder so;
    __device__ __forceinline__ bool next(int i, Unit2& u) const {
        int pm, pn; if (!so.next(i, pm, pn)) return false;
        u.pm = pm; u.pn = pn; u.A0 = A0 + (size_t)pm * BM * 512 * 2; u.B0 = B0 + (size_t)pn * BM * 512 * 2; u.A1 = A1 + (size_t)pm * BM * 512 * 2; u.B1 = B1 + (size_t)pn * BM * 512 * 2; return true;
    }
};
struct EpiBr {
    const bf16_t* COLS; bf16_t* MG;
    __device__ __forceinline__ void mid(f32x4 (&acc)[2][2][4][2], const Unit2& u, int wr, int wc, int fr, int fq) const {
#pragma unroll
        for (int ai = 0; ai < 2; ++ai)
#pragma unroll
            for (int m = 0; m < 4; ++m) { const size_t t = (size_t)u.pm * BM + ai * HALF + wr * 64 + m * 16 + fr;
#pragma unroll
                for (int bj = 0; bj < 2; ++bj) { const int col = u.pn * BM + bj * HALF + wc * 32 + 8 * fq; float ga[8], gb[8];
                    unpack8(*(const u32x4*)(COLS + t * INC + C_GA + col), ga); unpack8(*(const u32x4*)(COLS + t * INC + C_GB + col), gb);
#pragma unroll
                    for (int n = 0; n < 2; ++n)
#pragma unroll
                        for (int k = 0; k < 4; ++k) { const float rt_ = sigmoidf_(ga[4 * n + k]) * (1.0f + __expf(-gb[4 * n + k]));
                            asm volatile("v_mul_f32 %0, %0, %1" : "+v"(acc[ai][bj][m][n][k]) : "v"(rt_)); } }
                asm volatile("" ::: "memory"); }
    }
    __device__ __forceinline__ void fin(const f32x4 (&acc)[2][2][4][2], const Unit2& u, int wr, int wc, int fr, int fq) const {
#pragma unroll
        for (int ai = 0; ai < 2; ++ai)
#pragma unroll
            for (int m = 0; m < 4; ++m) { const size_t t = (size_t)u.pm * BM + ai * HALF + wr * 64 + m * 16 + fr;
#pragma unroll
                for (int bj = 0; bj < 2; ++bj) { const int col = u.pn * BM + bj * HALF + wc * 32 + 8 * fq; float gb[8], o[8];
                    unpack8(*(const u32x4*)(COLS + t * INC + C_GB + col), gb);
#pragma unroll
                    for (int n = 0; n < 2; ++n)
#pragma unroll
                        for (int k = 0; k < 4; ++k) o[4 * n + k] = acc[ai][bj][m][n][k] * sigmoidf_(gb[4 * n + k]);
                    *(u32x4*)(MG + t * DM + col) = pack8(o); }
                asm volatile("" ::: "memory"); }
    }
};
}
using pg8::Unit;

struct F_Cols { bf16_t* C; int ldc; bf16_t* UG;
    __device__ __forceinline__ void operator()(const Unit& u, int r, int c, float (&v)[8]) const {
        const u32x4 w = pack8(v); const int t = u.pm * 256 + r;
        *(u32x4*)(C + (size_t)t * ldc + u.pn * 256 + c) = w;
        if (u.pn == 7) { const int g = c >> 4, c0 = c & 15, b = t >> 11, s = t & (SEQ - 1), ch = s >> 5, j = s & 31;
            *(u32x4*)(UG + ((size_t)g * S5ROWS + b * S5NCH + ch) * S5K + j * 16 + c0) = w; } } };
struct F_Lora { bf16_t* O; const float* w0; const float* a0;
    __device__ __forceinline__ void operator()(const Unit& u, int r, int c, float (&v)[8]) const {
        const int gc = u.pn * 256 + c; const int ty = u.pn >> 1;
        if (ty == 0) {
#pragma unroll
            for (int i = 0; i < 8; ++i) v[i] = 0.6065306597126334f * sigmoidf_(v[i] + w0[gc + i]);
        } else if (ty == 1) {
#pragma unroll
            for (int i = 0; i < 8; ++i) v[i] = sigmoidf_(v[i] + a0[gc - 512 + i]);
        }
        *(u32x4*)(O + (size_t)(u.pm * 256 + r) * 1536 + gc) = pack8(v); } };
struct F_S5a { float* E;
    __device__ __forceinline__ void operator()(const Unit& u, int r, int c, float (&v)[8]) const {
        if (c < 128) { float* p = E + ((size_t)u.aux * S5ROWS + u.pm * 256 + r) * 128 + c;
            *(f32x4*)p = (f32x4){v[0], v[1], v[2], v[3]}; *(f32x4*)(p + 4) = (f32x4){v[4], v[5], v[6], v[7]}; } } };
struct F_S5c { const bf16_t* COLS; const float* Dsk; bf16_t* Z;
    __device__ __forceinline__ void operator()(const Unit& u, int r, int c, float (&v)[8]) const {
        const int row = u.pm * 256 + r, col = u.pn * 256 + c; const int b = row >> 6, ch = row & 63, j = col >> 4, c0 = col & 15;
        const int t = b * SEQ + ch * S5L + j, chan = u.aux * 16 + c0;
        float uu[8]; unpack8(*(const u32x4*)(COLS + (size_t)t * INC + C_U + chan), uu);
#pragma unroll
        for (int i = 0; i < 8; ++i) v[i] = gelu_tanh(v[i] + Dsk[chan + i] * uu[i]);
        *(u32x4*)(Z + (size_t)t * 256 + chan) = pack8(v); } };
struct F_Glu { const bf16_t* Z; const float* gb; bf16_t* O;
    __device__ __forceinline__ void operator()(const Unit& u, int r, int c, float (&v)[8]) const {
        const size_t t = (size_t)u.pm * 256 + r; float z[8]; unpack8(*(const u32x4*)(Z + t * 256 + c), z);
#pragma unroll
        for (int i = 0; i < 8; ++i) v[i] = z[i] * sigmoidf_(v[i] + gb[c + i]);
        *(u32x4*)(O + t * 512 + c) = pack8(v); } };
struct F_BrA { const bf16_t* COLS; float* PART;
    __device__ __forceinline__ void operator()(const Unit& u, int r, int c, float (&v)[8]) const {
        const size_t t = (size_t)u.pm * 256 + r; const int col = u.pn * 256 + c; float g[8]; unpack8(*(const u32x4*)(COLS + t * INC + C_GA + col), g);
#pragma unroll
        for (int i = 0; i < 8; ++i) v[i] *= sigmoidf_(g[i]);
        float* p = PART + t * DM + col; *(f32x4*)p = (f32x4){v[0], v[1], v[2], v[3]}; *(f32x4*)(p + 4) = (f32x4){v[4], v[5], v[6], v[7]}; } };
struct F_BrB { const bf16_t* COLS; const float* PART; bf16_t* MG;
    __device__ __forceinline__ void operator()(const Unit& u, int r, int c, float (&v)[8]) const {
        const size_t t = (size_t)u.pm * 256 + r; const int col = u.pn * 256 + c; float g[8]; unpack8(*(const u32x4*)(COLS + t * INC + C_GB + col), g);
        const float* p = PART + t * DM + col; const f32x4 p0 = *(const f32x4*)p, p1 = *(const f32x4*)(p + 4);
        const float pp[8] = {p0[0], p0[1], p0[2], p0[3], p1[0], p1[1], p1[2], p1[3]};
#pragma unroll
        for (int i = 0; i < 8; ++i) v[i] = pp[i] + v[i] * sigmoidf_(g[i]);
        *(u32x4*)(MG + t * DM + col) = pack8(v); } };
struct F_Res { const float* X; bf16_t* O;
    __device__ __forceinline__ void operator()(const Unit& u, int r, int c, float (&v)[8]) const {
        const size_t o = ((size_t)u.pm * 256 + r) * DM + u.pn * 256 + c; const f32x4 x0 = *(const f32x4*)(X + o), x1 = *(const f32x4*)(X + o + 4);
        const float w[8] = {x0[0] + v[0], x0[1] + v[1], x0[2] + v[2], x0[3] + v[3], x1[0] + v[4], x1[1] + v[5], x1[2] + v[6], x1[3] + v[7]};
        *(u32x4*)(O + o) = pack8(w); } };
struct F_MoeDown { const float* ROWW; bf16_t* YM;
    __device__ __forceinline__ void operator()(const Unit& u, int r, int c, float (&v)[8]) const {
        const size_t row = (size_t)u.pm * 256 + r; const float w = ROWW[row];
#pragma unroll
        for (int i = 0; i < 8; ++i) v[i] *= w;
        *(u32x4*)(YM + row * DM + u.pn * 256 + c) = pack8(v); } };
struct F_PleG { bf16_t* G;
    __device__ __forceinline__ void operator()(const Unit& u, int r, int c, float (&v)[8]) const {
#pragma unroll
        for (int i = 0; i < 8; ++i) v[i] = sigmoidf_(v[i]);
        *(u32x4*)(G + ((size_t)u.pm * 256 + r) * DM + u.pn * 256 + c) = pack8(v); } };
struct F_PleP { const bf16_t* G; const bf16_t* X; bf16_t* XO;
    __device__ __forceinline__ void operator()(const Unit& u, int r, int c, float (&v)[8]) const {
        const size_t o = ((size_t)u.pm * 256 + r) * DM + u.pn * 256 + c; float g[8], x[8], w[8]; unpack8(*(const u32x4*)(G + o), g); unpack8(*(const u32x4*)(X + o), x);
#pragma unroll
        for (int i = 0; i < 8; ++i) w[i] = x[i] + g[i] * v[i];
        *(u32x4*)(XO + o) = pack8(w); } };

enum { I_X = 0, I_P, I_MIXN, I_WIN, I_MU, I_W0, I_WUP, I_A0, I_AUP, I_GUP, I_KK, I_KA, I_RK, I_LNG, I_LNB, I_LRE, I_LIM, I_LDT, I_BRE, I_BIM, I_CRE, I_CIM, I_SD, I_GLUW, I_GLUB,
       I_WBA, I_WBB, I_WOUT, I_FFNN, I_RGW, I_RGB, I_REW, I_REB, I_EG, I_EU, I_ED, I_PLEN, I_PLEG, I_PLEP, I_FINN };

__device__ __forceinline__ void transpose_item(const float* __restrict__ W, int ldw, const float* __restrict__ kscale, int k0, int n0, bf16_t* WT, int ldt, int dst_row0, int dst_k0, LAS float* scr, int lane) {
#pragma unroll 2
    for (int i = 0; i < 32; ++i) { const int kk = 2 * i + (lane >> 5); float v = W[(size_t)(k0 + kk) * ldw + n0 + (lane & 31)]; if (kscale) v *= kscale[k0 + kk]; scr[kk * 33 + (lane & 31)] = v; }
    LDS_WAIT();
    const int c = lane & 7;
#pragma unroll
    for (int j = 0; j < 4; ++j) { const int n = (lane >> 3) + 8 * j; const LAS float* s = scr + (8 * c) * 33 + n;
        u32x4 o; o.x = pk2(s[0 * 33], s[1 * 33]); o.y = pk2(s[2 * 33], s[3 * 33]); o.z = pk2(s[4 * 33], s[5 * 33]); o.w = pk2(s[6 * 33], s[7 * 33]);
        *(u32x4*)(WT + (size_t)(dst_row0 + n) * ldt + dst_k0 + 8 * c) = o; }
    LDS_WAIT();
}

constexpr int N_WBA = 8 * 32, N_WBB = 4 * 32, N_WOUT = 16 * 32, N_WPG = 16 * 32, N_WPP = 4 * 32, N_GLU = 4 * 8, N_EG = 32 * 128, N_EU = 32 * 128, N_ED = 32 * 128;
constexpr int N_LATE = N_WBA + N_WBB + N_WOUT + N_WPG + N_WPP + N_GLU + N_EG + N_EU + N_ED;
struct TrDesc { const float* W; const float* ks; bf16_t* WT; int ldw, k0, n0, ldt, row0; };
__device__ __forceinline__ TrDesc late_desc(const Args& a, int r) {
    unsigned char* ws = a.ws; TrDesc d; d.ks = nullptr;
    if (r < N_WBA) { d.W = a.in[I_WBA]; d.ldw = 1024; d.k0 = 64 * (r / 32); d.n0 = 32 * (r % 32); d.WT = (bf16_t*)(ws + WS_WBA); d.ldt = 512; d.row0 = d.n0; return d; } r -= N_WBA;
    if (r < N_WBB) { d.W = a.in[I_WBB]; d.ldw = 1024; d.k0 = 64 * (r / 32); d.n0 = 32 * (r % 32); d.WT = (bf16_t*)(ws + WS_WBB); d.ldt = 512; d.row0 = d.n0; return d; } r -= N_WBB;
    if (r < N_WOUT) { d.W = a.in[I_WOUT]; d.ldw = 1024; d.k0 = 64 * (r / 32); d.n0 = 32 * (r % 32); d.WT = (bf16_t*)(ws + WS_WOUT); d.ldt = 1024; d.row0 = d.n0; return d; } r -= N_WOUT;
    if (r < N_WPG) { d.W = a.in[I_PLEG]; d.ks = a.in[I_PLEN]; d.ldw = 1024; d.k0 = 64 * (r / 32); d.n0 = 32 * (r % 32); d.WT = (bf16_t*)(ws + WS_WPG); d.ldt = 1024; d.row0 = d.n0; return d; } r -= N_WPG;
    if (r < N_WPP) { d.W = a.in[I_PLEP]; d.ldw = 1024; d.k0 = 64 * (r / 32); d.n0 = 32 * (r % 32); d.WT = (bf16_t*)(ws + WS_WPP); d.ldt = 256; d.row0 = d.n0; return d; } r -= N_WPP;
    if (r < N_GLU) { d.W = a.in[I_GLUW]; d.ldw = 256; d.k0 = 64 * (r / 8); d.n0 = 32 * (r % 8); d.WT = (bf16_t*)(ws + WS_WGLU); d.ldt = 256; d.row0 = d.n0; return d; } r -= N_GLU;
    if (r < N_EG + N_EU) { const int up = r >= N_EG ? 1 : 0; if (up) r -= N_EG; const int e = r / 128, q = r % 128; d.k0 = 64 * (q / 8); d.n0 = 32 * (q % 8);
        d.W = a.in[up ? I_EU : I_EG] + (size_t)e * 1024 * 256; d.ks = a.in[I_FFNN]; d.ldw = 256; d.WT = (bf16_t*)(ws + WS_WGU); d.ldt = 1024; d.row0 = e * 512 + (d.n0 / 128) * 256 + up * 128 + (d.n0 % 128); return d; } r -= N_EG + N_EU;
    { const int e = r / 128, q = r % 128; d.k0 = 64 * (q / 32); d.n0 = 32 * (q % 32); d.W = a.in[I_ED] + (size_t)e * 256 * 1024; d.ldw = 1024; d.WT = (bf16_t*)(ws + WS_WD) + (size_t)e * 1024 * 256; d.ldt = 256; d.row0 = d.n0; return d; }
}
__device__ __forceinline__ void tr_load(const TrDesc& d, float (&tv)[32], int lane) {
#pragma unroll
    for (int i = 0; i < 32; ++i) tv[i] = d.W[(size_t)(d.k0 + 2 * i + (lane >> 5)) * d.ldw + d.n0 + (lane & 31)];
}
__device__ __forceinline__ void tr_store(const TrDesc& d, const float (&tv)[32], LAS float* scr, int lane) {
#pragma unroll
    for (int i = 0; i < 32; ++i) scr[(2 * i + (lane >> 5)) * 33 + (lane & 31)] = tv[i];
    LDS_WAIT();
    const int c = lane & 7; float sc[8];
#pragma unroll
    for (int i = 0; i < 8; ++i) sc[i] = d.ks ? d.ks[d.k0 + 8 * c + i] : 1.0f;
#pragma unroll
    for (int j = 0; j < 4; ++j) { const int n = (lane >> 3) + 8 * j; const LAS float* s = scr + (8 * c) * 33 + n;
        u32x4 o; o.x = pk2(s[0 * 33] * sc[0], s[1 * 33] * sc[1]); o.y = pk2(s[2 * 33] * sc[2], s[3 * 33] * sc[3]); o.z = pk2(s[4 * 33] * sc[4], s[5 * 33] * sc[5]); o.w = pk2(s[6 * 33] * sc[6], s[7 * 33] * sc[7]);
        *(u32x4*)(d.WT + (size_t)(d.row0 + n) * d.ldt + d.k0 + 8 * c) = o; }
    LDS_WAIT();
}
__device__ __forceinline__ void dsincos_reduced(double x, double& s, double& c) {
    const double x2 = x * x;
    double ps = -1.0 / 1.307674368e12  ; ps = ps * x2 + 1.0 / 6227020800.0; ps = ps * x2 - 1.0 / 39916800.0; ps = ps * x2 + 1.0 / 362880.0; ps = ps * x2 - 1.0 / 5040.0; ps = ps * x2 + 1.0 / 120.0; ps = ps * x2 - 1.0 / 6.0;
    double hs = -1.0 / 1.21645100408832e17  ; hs = hs * x2 + 1.0 / 3.55687428096e14  ; ps = ((hs * x2) * x2 * x2 * x2 * x2 * x2 * x2) + ps;
    s = x + x * x2 * ps;
    double pc = 1.0 / 2.0922789888e13  ; pc = pc * x2 - 1.0 / 87178291200.0; pc = pc * x2 + 1.0 / 479001600.0; pc = pc * x2 - 1.0 / 3628800.0; pc = pc * x2 + 1.0 / 40320.0; pc = pc * x2 - 1.0 / 720.0; pc = pc * x2 + 1.0 / 24.0; pc = pc * x2 - 0.5;
    double hc = 1.0 / 2.43290200817664e18  ; hc = hc * x2 - 1.0 / 6.402373705728e15  ; pc = ((hc * x2) * x2 * x2 * x2 * x2 * x2 * x2 * x2) + pc;
    c = 1.0 + x2 * pc;
}
__device__ __forceinline__ double dexp_(double x) {
    const double ln2 = 0.6931471805599453094; const double kf = __builtin_rint(x * 1.4426950408889634074); const double r = x - kf * ln2;
    double t = 1.0 / 6227020800.0; t = t * r + 1.0 / 479001600.0; t = t * r + 1.0 / 39916800.0; t = t * r + 1.0 / 3628800.0; t = t * r + 1.0 / 362880.0; t = t * r + 1.0 / 40320.0; t = t * r + 1.0 / 5040.0;
    t = t * r + 1.0 / 720.0; t = t * r + 1.0 / 120.0; t = t * r + 1.0 / 24.0; t = t * r + 1.0 / 6.0; t = t * r + 0.5; t = t * r + 1.0; t = t * r + 1.0;
    const int ki = (int)kf; const long long bits = (long long)(1023 + ki) << 52;
    return t * __builtin_bit_cast(double, bits);
}

__device__ __forceinline__ void phase0(const Args& a, LAS unsigned char* lds) {
    const int tid = threadIdx.x, lane = tid & 63, wave = tid >> 6, G = gridDim.x;
    const int gw = blockIdx.x * 8 + wave, NGW = G * 8;
    unsigned char* ws = a.ws;
    LAS float* scr = (LAS float*)(lds + wave * 16384);
    float tv[32]; TrDesc td; const bool has_tr = gw < 16 * 128;
    { const int it = has_tr ? gw : 0; td.W = a.in[I_WIN]; td.ks = a.in[I_MIXN]; td.WT = (bf16_t*)(ws + WS_WIN); td.ldw = INC; td.k0 = 64 * (it / 128); td.n0 = 32 * (it % 128); td.ldt = 1024; td.row0 = td.n0; }
    if (has_tr) tr_load(td, tv, lane);
    const int gt = blockIdx.x * 512 + tid;
    float sv[8]; f32x4 sg0 = (f32x4){1.f, 1.f, 1.f, 1.f}, sg1 = sg0;
#pragma unroll
    for (int i = 0; i < 8; ++i) sv[i] = 0.f;
    if (gt < 1536 * 32) { const int n = gt >> 5, k0 = (gt & 31) * 8; const float* bp = nullptr;
        if (n < 512) { if (k0 < 64) bp = a.in[I_WUP] + k0 * 512 + n; }
        else if (n < 1024) { if (k0 >= 64 && k0 < 128) bp = a.in[I_AUP] + (k0 - 64) * 512 + (n - 512); }
        else { if (k0 >= 128) bp = a.in[I_GUP] + (k0 - 128) * 512 + (n - 1024); }
        if (bp) {
#pragma unroll
            for (int i = 0; i < 8; ++i) sv[i] = bp[i * 512]; }
    } else if (gt < 1536 * 32 + 48 * 128) { const int cc = gt - 1536 * 32, j = cc >> 7, k0 = (cc & 127) * 8;
        if (j < 36) { const float* bp = (j < 4) ? (a.in[I_RGW] + k0 * 4 + j) : (a.in[I_REW] + k0 * 32 + (j - 4)); const int st = (j < 4) ? 4 : 32;
#pragma unroll
            for (int i = 0; i < 8; ++i) sv[i] = bp[i * st];
            sg0 = *(const f32x4*)(a.in[I_FFNN] + k0); sg1 = *(const f32x4*)(a.in[I_FFNN] + k0 + 4); }
    }
    {
        bf16_t* HN = (bf16_t*)a.out;
        for (int m0 = gw; m0 < T; m0 += 2 * NGW) {
            f32x4 v[2][4]; float s[2] = {0.f, 0.f};
#pragma unroll
            for (int u = 0; u < 2; ++u) { const f32x4* xr = (const f32x4*)(a.in[I_X] + (size_t)(m0 + u * NGW) * DM) + lane;
#pragma unroll
                for (int j = 0; j < 4; ++j) v[u][j] = xr[64 * j]; }
#pragma unroll
            for (int u = 0; u < 2; ++u) {
#pragma unroll
                for (int j = 0; j < 4; ++j) s[u] += (v[u][j][0] * v[u][j][0] + v[u][j][1] * v[u][j][1]) + (v[u][j][2] * v[u][j][2] + v[u][j][3] * v[u][j][3]);
                const float rs = 1.0f / sqrtf(wave_sum(s[u]) * (1.0f / DM) + 1e-6f);
                u32x2* o = (u32x2*)(HN + (size_t)(m0 + u * NGW) * DM) + lane;
#pragma unroll
                for (int j = 0; j < 4; ++j) { u32x2 w; w.x = pk2(v[u][j][0] * rs, v[u][j][1] * rs); w.y = pk2(v[u][j][2] * rs, v[u][j][3] * rs); o[64 * j] = w; }
            }
        }
    }
    if (has_tr) tr_store(td, tv, scr, lane);
    for (int it = gw + NGW; it < 16 * 128; it += NGW)
        transpose_item(a.in[I_WIN], INC, a.in[I_MIXN], 64 * (it / 128), 32 * (it % 128), (bf16_t*)(ws + WS_WIN), 1024, 32 * (it % 128), 64 * (it / 128), scr, lane);
    if (gt < 1536 * 32 + 48 * 128) {
        u32x4 o; o.x = pk2(sv[0] * sg0[0], sv[1] * sg0[1]); o.y = pk2(sv[2] * sg0[2], sv[3] * sg0[3]); o.z = pk2(sv[4] * sg1[0], sv[5] * sg1[1]); o.w = pk2(sv[6] * sg1[2], sv[7] * sg1[3]);
        if (gt < 1536 * 32) *(u32x4*)((bf16_t*)(ws + WS_WLORA) + (size_t)(gt >> 5) * 256 + (gt & 31) * 8) = o;
        else { const int cc = gt - 1536 * 32; *(u32x4*)((bf16_t*)(ws + WS_WR) + (size_t)(cc >> 7) * 1024 + (cc & 127) * 8) = o; }
    }
    for (int c = gt + G * 512; c < 1536 * 32 + 48 * 128; c += G * 512) {
        float v[8];
        if (c < 1536 * 32) { const int n = c >> 5, k0 = (c & 31) * 8;
#pragma unroll
            for (int i = 0; i < 8; ++i) { const int k = k0 + i; float x = 0.f;
                if (n < 512) { if (k < 64) x = a.in[I_WUP][k * 512 + n]; }
                else if (n < 1024) { if (k >= 64 && k < 128) x = a.in[I_AUP][(k - 64) * 512 + (n - 512)]; }
                else { if (k >= 128) x = a.in[I_GUP][(k - 128) * 512 + (n - 1024)]; }
                v[i] = x; }
            u32x4 o; o.x = pk2(v[0], v[1]); o.y = pk2(v[2], v[3]); o.z = pk2(v[4], v[5]); o.w = pk2(v[6], v[7]); *(u32x4*)((bf16_t*)(ws + WS_WLORA) + (size_t)n * 256 + k0) = o;
        } else { const int cc = c - 1536 * 32, j = cc >> 7, k0 = (cc & 127) * 8;
#pragma unroll
            for (int i = 0; i < 8; ++i) { const int k = k0 + i; float x = 0.f;
                if (j < 4) x = a.in[I_RGW][k * 4 + j] * a.in[I_FFNN][k]; else if (j < 36) x = a.in[I_REW][k * 32 + (j - 4)] * a.in[I_FFNN][k];
                v[i] = x; }
            u32x4 o; o.x = pk2(v[0], v[1]); o.y = pk2(v[2], v[3]); o.z = pk2(v[4], v[5]); o.w = pk2(v[6], v[7]); *(u32x4*)((bf16_t*)(ws + WS_WR) + (size_t)j * 1024 + k0) = o; }
    }
    for (int vb = blockIdx.x; vb < 256; vb += G) {
        __syncthreads();
        const int g = vb & 15, part = vb >> 4;
        LAS float* Pre = (LAS float*)lds;
        LAS float* Pim = Pre + 33 * 64;
        LAS float* Bre = Pim + 33 * 64;
        LAS float* Bim = Bre + 64 * 16;
        LAS float* Cre = Bim + 64 * 16;
        LAS float* Cim = Cre + 16 * 64;
        if (tid < 64) {
            const int n = tid; const double lr = (double)a.in[I_LRE][g * 64 + n], li = (double)a.in[I_LIM][g * 64 + n];
            const double dt = dexp_((double)a.in[I_LDT][g]);
            const double mag = dexp_(lr * dt); double ang = li * dt; const double twopi = 6.283185307179586477; ang -= __builtin_rint(ang * 0.15915494309189533577) * twopi;
            double sn, cs; dsincos_reduced(ang, sn, cs);
            const double lre = mag * cs, lim = mag * sn;
            const double nr = lre - 1.0, ni = lim, den = lr * lr + li * li; const double rden = 1.0 / den;
            const double cfr = (nr * lr + ni * li) * rden, cfi = (ni * lr - nr * li) * rden;
            for (int c = 0; c < 16; ++c) { const double br = (double)a.in[I_BRE][(g * 64 + n) * 16 + c], bi = (double)a.in[I_BIM][(g * 64 + n) * 16 + c];
                Bre[n * 16 + c] = (float)(cfr * br - cfi * bi); Bim[n * 16 + c] = (float)(cfr * bi + cfi * br); }
            double pr = 1.0, pi = 0.0;
            for (int tau = 0; tau <= 32; ++tau) { Pre[tau * 64 + n] = (float)pr; Pim[tau * 64 + n] = (float)pi; const double t2 = pr * lre - pi * lim; pi = pr * lim + pi * lre; pr = t2; }
            if (part == 0) ((f32x2*)(ws + WS_LAML))[g * 64 + n] = (f32x2){Pre[32 * 64 + n], Pim[32 * 64 + n]};
        }
        for (int i = tid; i < 1024; i += 512) { Cre[i] = a.in[I_CRE][g * 1024 + i]; Cim[i] = a.in[I_CIM][g * 1024 + i]; }
        __syncthreads();
        float* KG = (float*)(ws + WS_KG) + (size_t)g * 32 * 256;
        { const int e = part * 512 + tid; const int tau = e >> 8, co = (e >> 4) & 15, ci = e & 15; float s = 0.f;
            for (int n = 0; n < 64; ++n) { const float pr = Pre[tau * 64 + n], pi = Pim[tau * 64 + n], br = Bre[n * 16 + ci], bi = Bim[n * 16 + ci];
                const float qr = pr * br - pi * bi, qi = pr * bi + pi * br; s += Cre[co * 64 + n] * qr - Cim[co * 64 + n] * qi; }
            KG[e] = s; }
        bf16_t* TZ = (bf16_t*)(ws + WS_TZ) + (size_t)g * S5N * S5K;
        { const int e = part * 512 + tid; const int row = e >> 4, m0 = (e & 15) * 8, j = row >> 4, co = row & 15; float v[8];
#pragma unroll
            for (int i = 0; i < 8; ++i) { const int m = m0 + i, n = m & 63; const float pr = Pre[(j + 1) * 64 + n], pi = Pim[(j + 1) * 64 + n], cr = Cre[co * 64 + n], ci = Cim[co * 64 + n];
                v[i] = (m < 64) ? (cr * pr - ci * pi) : -(cr * pi + ci * pr); }
            u32x4 o; o.x = pk2(v[0], v[1]); o.y = pk2(v[2], v[3]); o.z = pk2(v[4], v[5]); o.w = pk2(v[6], v[7]); *(u32x4*)(TZ + (size_t)row * S5K + 512 + m0) = o; }
        bf16_t* W1 = (bf16_t*)(ws + WS_W1) + (size_t)g * 256 * 512;
        for (int e = part * 1024 + tid; e < part * 1024 + 1024; e += 512) { const int m = e >> 6, s = (e & 63) >> 1, ci0 = (e & 1) * 8; float v[8];
#pragma unroll
            for (int i = 0; i < 8; ++i) { float x = 0.f;
                if (m < 128) { const int n = m & 63; const float pr = Pre[(31 - s) * 64 + n], pi = Pim[(31 - s) * 64 + n], br = Bre[n * 16 + ci0 + i], bi = Bim[n * 16 + ci0 + i];
                    x = (m < 64) ? (pr * br - pi * bi) : (pr * bi + pi * br); }
                v[i] = x; }
            u32x4 o; o.x = pk2(v[0], v[1]); o.y = pk2(v[2], v[3]); o.z = pk2(v[4], v[5]); o.w = pk2(v[6], v[7]); *(u32x4*)(W1 + (size_t)m * 512 + s * 16 + ci0) = o; }
    }
    __syncthreads();
}

__device__ __forceinline__ void phase2(const Args& a) {
    const int gt = blockIdx.x * 512 + threadIdx.x, NT = gridDim.x * 512;
    unsigned char* ws = a.ws;
    const bf16_t* COLS = (const bf16_t*)(ws + WS_A); bf16_t* LIN = (bf16_t*)(ws + WS_Z);
    const float* mu = a.in[I_MU];
    for (int p = gt; p < T * 32; p += NT) {
        const int t = p >> 5, q = p & 31;
        {
            const int c8 = q * 8, src = C_WD + c8; float cur[8], prv[8], o[8];
            unpack8(*(const u32x4*)(COLS + (size_t)t * INC + src), cur);
            if ((t & (SEQ - 1)) != 0) unpack8(*(const u32x4*)(COLS + (size_t)(t - 1) * INC + src), prv);
            else {
#pragma unroll
                for (int i = 0; i < 8; ++i) prv[i] = 0.f; }
#pragma unroll
            for (int i = 0; i < 8; ++i) { const float xs = cur[i] + (prv[i] - cur[i]) * mu[src + i]; o[i] = (c8 < 64) ? tanhf_(xs) : ((c8 < 128) ? xs : sigmoidf_(xs)); }
            *(u32x4*)(LIN + (size_t)t * 256 + c8) = pack8(o);
        }
    }
    const float* KG = (const float*)(ws + WS_KG); bf16_t* TZ = (bf16_t*)(ws + WS_TZ);
    for (int p = gt; p < 16 * 512 * 64; p += NT) {
        const int g = p >> 15, row = (p >> 6) & 511, kc = p & 63, j = row >> 4, co = row & 15, s = kc >> 1, ci0 = (kc & 1) * 8;
        u32x4 o = (u32x4){0u, 0u, 0u, 0u};
        if (s <= j) { const float* k = KG + (((size_t)g * 32 + (j - s)) * 16 + co) * 16 + ci0; const f32x4 k0 = *(const f32x4*)k, k1 = *(const f32x4*)(k + 4);
            o.x = pk2(k0[0], k0[1]); o.y = pk2(k0[2], k0[3]); o.z = pk2(k1[0], k1[1]); o.w = pk2(k1[2], k1[3]); }
        *(u32x4*)(TZ + ((size_t)g * S5N + row) * S5K + kc * 8) = o;
    }
}

__device__ __forceinline__ void phase4(const Args& a, LAS unsigned char* lds) {
    const int tid = threadIdx.x, lane = tid & 63, wave = tid >> 6;
    unsigned char* ws = a.ws;
    TSTART(4); TSTART(1);
    for (int item = blockIdx.x; item < 256; item += gridDim.x) {
        if (tid < 64) {
            const int b = item >> 4, g = item & 15, n = tid;
            const f32x2 lamL = ((const f32x2*)(ws + WS_LAML))[g * 64 + n];
            const float* E = (const float*)(ws + WS_E) + ((size_t)g * S5ROWS + b * S5NCH) * 128;
            bf16_t* UG = (bf16_t*)(ws + WS_UG) + ((size_t)g * S5ROWS + b * S5NCH) * S5K + 512;
            float xr = 0.f, xi = 0.f;
#pragma unroll 2
            for (int ch = 0; ch < S5NCH; ++ch) {
                UG[(size_t)ch * S5K + n] = (bf16_t)f2bf(xr); UG[(size_t)ch * S5K + 64 + n] = (bf16_t)f2bf(xi);
                const float er = E[ch * 128 + n], ei = E[ch * 128 + 64 + n];
                const float nr = lamL[0] * xr - lamL[1] * xi + er, ni = lamL[0] * xi + lamL[1] * xr + ei; xr = nr; xi = ni;
            }
        }
    }
    TSTOP(1);
    const bf16_t* COLS = (const bf16_t*)(ws + WS_A); const bf16_t* LORA = (const bf16_t*)a.out;
    float* Y = (float*)(ws + WS_B); float* BON = (float*)(ws + WS_BON);
    LAS float* VECF = (LAS float*)lds;
    LAS float* VKP = (LAS float*)(lds + 81920);
    LAS float* BETA = (LAS float*)(lds + 98304);
    LAS float* YST = (LAS float*)(lds + 98816);
    for (int item = blockIdx.x; item < 256; item += gridDim.x) {
        const int bh = item >> 1, half = item & 1, b = bh >> 3, h = bh & 7;
        const int pj = tid >> 4, pq = tid & 15, hc = h * 64 + 4 * pq;
        float mur[4], muk[4], muv[4], kk4[4], ka4[4], rk4[4];
#pragma unroll
        for (int i = 0; i < 4; ++i) { mur[i] = a.in[I_MU][C_R + hc + i]; muk[i] = a.in[I_MU][C_K + hc + i]; muv[i] = a.in[I_MU][C_V + hc + i];
            kk4[i] = a.in[I_KK][hc + i]; ka4[i] = a.in[I_KA][hc + i]; rk4[i] = a.in[I_RK][hc + i]; }
        const int rr = lane >> 4, cl = lane & 15;
        const bool vmine = (pq >> 3) == half;
        const int qv = pq & 7;
        u32x2 rc, rp, kc, kp, kn, vc, vp, e4, a4;
        const u32x2 zero2 = (u32x2){0u, 0u};
        __syncthreads();
#define WKV_LOAD(chunk) do { const int s_ = (chunk) * 32 + pj; const size_t t_ = (size_t)b * SEQ + s_; const bf16_t* cb_ = COLS + t_ * INC + hc; \
            rc = *(const u32x2*)(cb_ + C_R); kc = *(const u32x2*)(cb_ + C_K); vc = *(const u32x2*)(cb_ + C_V); \
            if (s_ > 0) { rp = *(const u32x2*)(cb_ - INC + C_R); kp = *(const u32x2*)(cb_ - INC + C_K); vp = *(const u32x2*)(cb_ - INC + C_V); } else { rp = zero2; kp = zero2; vp = zero2; } \
            if (s_ < SEQ - 1) kn = *(const u32x2*)(cb_ + INC + C_K); else kn = zero2; \
            e4 = *(const u32x2*)(LORA + t_ * 1536 + hc); a4 = *(const u32x2*)(LORA + t_ * 1536 + 512 + hc); } while (0)
#define WKV_PREP(chunk, bi) do { float r_[4], rq_[4], k_[4], kq_[4], kx_[4], v_[4], vq_[4], e_[4], aa_[4]; unpack4(rc, r_); unpack4(rp, rq_); unpack4(kc, k_); unpack4(kp, kq_); unpack4(kn, kx_); unpack4(vc, v_); unpack4(vp, vq_); unpack4(e4, e_); unpack4(a4, aa_); \
            float kkv_[4], kkn_[4], k2_[4], ss_ = 0.f, ssn_ = 0.f; \
            _Pragma("unroll") for (int i = 0; i < 4; ++i) { r_[i] += (rq_[i] - r_[i]) * mur[i]; kx_[i] += (k_[i] - kx_[i]) * muk[i]; k_[i] += (kq_[i] - k_[i]) * muk[i]; v_[i] += (vq_[i] - v_[i]) * muv[i]; \
                kkv_[i] = k_[i] * kk4[i]; ss_ += kkv_[i] * kkv_[i]; kkn_[i] = kx_[i] * kk4[i]; ssn_ += kkn_[i] * kkn_[i]; k2_[i] = k_[i] * (1.0f + (aa_[i] - 1.0f) * ka4[i]); } \
            ss_ = row16_sum(ss_); ssn_ = row16_sum(ssn_); \
            const float inv_ = __builtin_amdgcn_rsqf(fmaxf(ss_, 1e-24f)), invn_ = __builtin_amdgcn_rsqf(fmaxf(ssn_, 1e-24f)); \
            float bv_[4], an_[4], w_[4], cv_[4], bon_ = 0.f, beta_ = 0.f, kap_ = 0.f; \
            _Pragma("unroll") for (int i = 0; i < 4; ++i) { bv_[i] = kkv_[i] * inv_ * aa_[i]; an_[i] = -kkn_[i] * invn_; w_[i] = __expf(-e_[i]); cv_[i] = w_[i] * an_[i]; \
                bon_ += r_[i] * k2_[i] * rk4[i]; beta_ += bv_[i] * an_[i]; kap_ += k2_[i] * an_[i]; } \
            bon_ = row16_sum(bon_); beta_ = row16_sum(beta_); kap_ = row16_sum(kap_); \
            if (pq == 0 && half == 0) BON[((size_t)b * SEQ + (chunk) * 32 + pj) * 8 + h] = bon_; \
            LAS float* vf_ = VECF + (bi) * 10240 + pj * 64 + 4 * pq; \
            *(LAS f32x4*)vf_ = (f32x4){w_[0], w_[1], w_[2], w_[3]}; *(LAS f32x4*)(vf_ + 2048) = (f32x4){cv_[0], cv_[1], cv_[2], cv_[3]}; *(LAS f32x4*)(vf_ + 4096) = (f32x4){bv_[0], bv_[1], bv_[2], bv_[3]}; \
            *(LAS f32x4*)(vf_ + 6144) = (f32x4){k2_[0], k2_[1], k2_[2], k2_[3]}; *(LAS f32x4*)(vf_ + 8192) = (f32x4){r_[0], r_[1], r_[2], r_[3]}; \
            if (pq == 0) *(LAS f32x2*)(BETA + ((bi) * 32 + pj) * 2) = (f32x2){beta_, beta_}; \
            if (vmine) { LAS float* kp_ = VKP + ((((bi) * 32 + pj) * 4 + (qv >> 1)) * 4) * 4 + (qv & 1); \
                _Pragma("unroll") for (int i = 0; i < 4; ++i) { kp_[i * 4] = v_[i]; kp_[i * 4 + 2] = v_[i] * kap_; } } } while (0)
        WKV_LOAD(0); WKV_PREP(0, 0);
        __syncthreads();
        float ltv[32];
#pragma unroll
        for (int i = 0; i < 32; ++i) ltv[i] = 0.f;
        f32x2 Q0 = {0.f, 0.f}, Q1 = Q0, Q2 = Q0, Q3 = Q0, SA = Q0, YP = Q0; float yselA = 0.f, yselB = 0.f; const int clp = (cl + 1) & 15;
        for (int chunk = 0; chunk < SEQ / 32; ++chunk) {
            const int bi = chunk & 1;
            TSTART(3);
            if (chunk > 1) { const LAS float* ys = YST + (((chunk - 2) & 3) * 32 + pj) * 33 + 2 * pq;
                *(f32x2*)(Y + ((size_t)b * SEQ + (chunk - 2) * 32 + pj) * 512 + h * 64 + 32 * half + 2 * pq) = (f32x2){ys[0], ys[1]}; }
            if (chunk + 1 < SEQ / 32) WKV_LOAD(chunk + 1);
            TSTOP(3); TSTART(2);
            if (__builtin_amdgcn_readfirstlane(wave) < 4) {
            const LAS float* vecp = VECF + bi * 10240 + 4 * cl; const LAS float* vkp = VKP + ((bi * 32 * 4 + wave) * 4 + rr) * 4; const LAS float* btp = BETA + bi * 64;
            LAS float* ysp = YST + ((chunk & 3) * 32 + cl) * 33 + 8 * wave + rr;
            LAS float* ysp_prev = YST + (((chunk + 3) & 3) * 32 + 16 + cl) * 33 + 8 * wave + rr;
            f32x4 w4 = *(const LAS f32x4*)vecp, c4 = *(const LAS f32x4*)(vecp + 2048), b4 = *(const LAS f32x4*)(vecp + 4096), k4 = *(const LAS f32x4*)(vecp + 6144), r4 = *(const LAS f32x4*)(vecp + 8192);
            f32x4 vk = *(const LAS f32x4*)vkp; f32x2 be = *(const LAS f32x2*)btp;
#pragma unroll 2
            for (int j = 0; j < 32; ++j) {
                const int jn = (j + 1) & 31;
                const f32x4 w4n = *(const LAS f32x4*)(vecp + jn * 64), c4n = *(const LAS f32x4*)(vecp + 2048 + jn * 64), b4n = *(const LAS f32x4*)(vecp + 4096 + jn * 64);
                const f32x4 k4n = *(const LAS f32x4*)(vecp + 6144 + jn * 64), r4n = *(const LAS f32x4*)(vecp + 8192 + jn * 64), vkn = *(const LAS f32x4*)(vkp + jn * 64);
                const f32x2 ben = *(const LAS f32x2*)(btp + jn * 2);
                const f32x2 w01 = __builtin_shufflevector(w4, w4, 0, 1), w23 = __builtin_shufflevector(w4, w4, 2, 3), c01 = __builtin_shufflevector(c4, c4, 0, 1), c23 = __builtin_shufflevector(c4, c4, 2, 3);
                const f32x2 b01 = __builtin_shufflevector(b4, b4, 0, 1), b23 = __builtin_shufflevector(b4, b4, 2, 3), k01 = __builtin_shufflevector(k4, k4, 0, 1), k23 = __builtin_shufflevector(k4, k4, 2, 3);
                const f32x2 r01 = __builtin_shufflevector(r4, r4, 0, 1), r23 = __builtin_shufflevector(r4, r4, 2, 3), VP = __builtin_shufflevector(vk, vk, 0, 1), VK2 = __builtin_shufflevector(vk, vk, 2, 3);
                f32x2 YN;
                asm volatile(
                    "v_pk_mul_f32 v[250:251], %[Q0], %[c01] op_sel_hi:[1,0]\n\t"
                    "v_pk_mul_f32 %[Q0], %[Q0], %[w01] op_sel_hi:[1,0]\n\t"
                    "v_add_f32_dpp %[yA], %[yA], %[yA] quad_perm:[1,0,3,2] row_mask:0xf bank_mask:0xf bound_ctrl:1\n\t"
                    "v_pk_fma_f32 v[250:251], %[Q1], %[c01], v[250:251] op_sel:[0,1,0] op_sel_hi:[1,1,1]\n\t"
                    "v_pk_mul_f32 %[Q1], %[Q1], %[w01] op_sel:[0,1] op_sel_hi:[1,1]\n\t"
                    "v_add_f32_dpp %[yB], %[yB], %[yB] quad_perm:[1,0,3,2] row_mask:0xf bank_mask:0xf bound_ctrl:1\n\t"
                    "v_pk_fma_f32 v[250:251], %[Q2], %[c23], v[250:251] op_sel_hi:[1,0,1]\n\t"
                    "v_pk_mul_f32 %[Q2], %[Q2], %[w23] op_sel_hi:[1,0]\n\t"
                    "v_add_f32_dpp %[yA], %[yA], %[yA] quad_perm:[2,3,0,1] row_mask:0xf bank_mask:0xf bound_ctrl:1\n\t"
                    "v_pk_fma_f32 v[250:251], %[Q3], %[c23], v[250:251] op_sel:[0,1,0] op_sel_hi:[1,1,1]\n\t"
                    "v_pk_mul_f32 %[Q3], %[Q3], %[w23] op_sel:[0,1] op_sel_hi:[1,1]\n\t"
                    "v_add_f32_dpp %[yB], %[yB], %[yB] quad_perm:[2,3,0,1] row_mask:0xf bank_mask:0xf bound_ctrl:1\n\t"
                    "v_pk_fma_f32 %[Q0], %[VP], %[k01], %[Q0] op_sel_hi:[1,0,1]\n\t"
                    "v_add_f32_dpp v250, v250, v250 quad_perm:[1,0,3,2] row_mask:0xf bank_mask:0xf bound_ctrl:1\n\t"
                    "v_pk_fma_f32 %[Q1], %[VP], %[k01], %[Q1] op_sel:[0,1,0] op_sel_hi:[1,1,1]\n\t"
                    "v_add_f32_dpp v251, v251, v251 quad_perm:[1,0,3,2] row_mask:0xf bank_mask:0xf bound_ctrl:1\n\t"
                    "v_pk_fma_f32 %[Q2], %[VP], %[k23], %[Q2] op_sel_hi:[1,0,1]\n\t"
                    "v_add_f32_dpp %[yA], %[yA], %[yA] row_half_mirror row_mask:0xf bank_mask:0xf bound_ctrl:1\n\t"
                    "v_pk_fma_f32 %[Q3], %[VP], %[k23], %[Q3] op_sel:[0,1,0] op_sel_hi:[1,1,1]\n\t"
                    "v_add_f32_dpp v250, v250, v250 quad_perm:[2,3,0,1] row_mask:0xf bank_mask:0xf bound_ctrl:1\n\t"
                    "v_pk_fma_f32 %[Q0], %[SA], %[b01], %[Q0] op_sel_hi:[1,0,1]\n\t"
                    "v_add_f32_dpp v251, v251, v251 quad_perm:[2,3,0,1] row_mask:0xf bank_mask:0xf bound_ctrl:1\n\t"
                    "v_pk_fma_f32 %[Q1], %[SA], %[b01], %[Q1] op_sel:[0,1,0] op_sel_hi:[1,1,1]\n\t"
                    "v_add_f32_dpp %[yB], %[yB], %[yB] row_half_mirror row_mask:0xf bank_mask:0xf bound_ctrl:1\n\t"
                    "v_pk_fma_f32 %[Q2], %[SA], %[b23], %[Q2] op_sel_hi:[1,0,1]\n\t"
                    "v_add_f32_dpp v250, v250, v250 row_half_mirror row_mask:0xf bank_mask:0xf bound_ctrl:1\n\t"
                    "v_pk_fma_f32 %[Q3], %[SA], %[b23], %[Q3] op_sel:[0,1,0] op_sel_hi:[1,1,1]\n\t"
                    "v_add_f32_dpp v251, v251, v251 row_half_mirror row_mask:0xf bank_mask:0xf bound_ctrl:1\n\t"
                    "v_pk_mul_f32 %[YN], %[Q0], %[r01] op_sel_hi:[1,0]\n\t"
                    "v_add_f32_dpp %[yA], %[yA], %[yA] row_mirror row_mask:0xf bank_mask:0xf bound_ctrl:1\n\t"
                    "v_pk_fma_f32 %[YN], %[Q1], %[r01], %[YN] op_sel:[0,1,0] op_sel_hi:[1,1,1]\n\t"
                    "v_add_f32_dpp v250, v250, v250 row_mirror row_mask:0xf bank_mask:0xf bound_ctrl:1\n\t"
                    "v_add_f32_dpp %[yB], %[yB], %[yB] row_mirror row_mask:0xf bank_mask:0xf bound_ctrl:1\n\t"
                    "v_add_f32_dpp v251, v251, v251 row_mirror row_mask:0xf bank_mask:0xf bound_ctrl:1\n\t"
                    "v_pk_fma_f32 %[YN], %[Q2], %[r23], %[YN] op_sel_hi:[1,0,1]\n\t"
                    "s_nop 0\n\t"
                    "v_pk_fma_f32 %[YN], %[Q3], %[r23], %[YN] op_sel:[0,1,0] op_sel_hi:[1,1,1]\n\t"
                    "v_pk_add_f32 v[250:251], v[250:251], %[VK2]\n\t"
                    "s_nop 0\n\t"
                    "v_pk_fma_f32 %[SA], %[SA], %[be], v[250:251]\n\t"
                    : [Q0] "+v"(Q0), [Q1] "+v"(Q1), [Q2] "+v"(Q2), [Q3] "+v"(Q3), [SA] "+v"(SA), [YN] "=&v"(YN), [yA] "+v"(YP[0]), [yB] "+v"(YP[1])
                    : [c01] "v"(c01), [c23] "v"(c23), [w01] "v"(w01), [w23] "v"(w23), [k01] "v"(k01), [k23] "v"(k23), [b01] "v"(b01), [b23] "v"(b23), [r01] "v"(r01), [r23] "v"(r23),
                      [VP] "v"(VP), [VK2] "v"(VK2), [be] "v"(be)
                    : "v250", "v251");
                const bool mine = (j & 15) == clp;
                yselA = mine ? YP[0] : yselA; yselB = mine ? YP[1] : yselB;
                if ((j & 15) == 0) { LAS float* yq = (j == 0) ? ysp_prev : ysp; yq[0] = yselA; yq[4] = yselB; }
                YP = YN;
                w4 = w4n; c4 = c4n; b4 = b4n; k4 = k4n; r4 = r4n; vk = vkn; be = ben;
            }
            }
            else if (item < (int)gridDim.x) {
                const int wv4 = __builtin_amdgcn_readfirstlane(wave) - 4; LAS float* lscr = (LAS float*)(lds + (wv4 < 3 ? 131584 + wv4 * 8448 : 115712));
                const int lit_prev = (chunk - 1) * (int)(gridDim.x * 4) + (int)blockIdx.x * 4 + wv4, lit = lit_prev + (int)(gridDim.x * 4);
                if (chunk > 0 && lit_prev < N_LATE) { const TrDesc d = late_desc(a, lit_prev); tr_store(d, ltv, lscr, lane); }
                if (lit < N_LATE) { const TrDesc d = late_desc(a, lit); tr_load(d, ltv, lane); }
            }
            TSTOP(2); TSTART(3);
            if (chunk + 1 < SEQ / 32) WKV_PREP(chunk + 1, bi ^ 1);
            __syncthreads();
            TSTOP(3);
        }
        if (__builtin_amdgcn_readfirstlane(wave) < 4) {
            const float ya = row16_sum(YP[0]), yb = row16_sum(YP[1]);
            if (cl == 15) { yselA = ya; yselB = yb; }
            LAS float* yq = YST + ((((SEQ / 32) - 1) & 3) * 32 + 16 + cl) * 33 + 8 * wave + rr; yq[0] = yselA; yq[4] = yselB;
        }
        __syncthreads();
#pragma unroll
        for (int cc = SEQ / 32 - 2; cc < SEQ / 32; ++cc) { const LAS float* ys = YST + ((cc & 3) * 32 + pj) * 33 + 2 * pq;
            *(f32x2*)(Y + ((size_t)b * SEQ + cc * 32 + pj) * 512 + h * 64 + 32 * half + 2 * pq) = (f32x2){ys[0], ys[1]}; }
#undef WKV_LOAD
#undef WKV_PREP
    }
    TSTOP(4);
}


__device__ __forceinline__ void late_items_idle(const Args& a, LAS unsigned char* lds, int lo, int hi, int first_idle) {
    if ((int)blockIdx.x < first_idle) return;
    const int lane = threadIdx.x & 63, wave = __builtin_amdgcn_readfirstlane(threadIdx.x >> 6);
    float ltv[32]; LAS float* lscr = (LAS float*)(lds + wave * 16384);
    for (int it = lo + ((int)blockIdx.x - first_idle) * 8 + wave; it < hi; it += ((int)gridDim.x - first_idle) * 8) { const TrDesc d = late_desc(a, it); tr_load(d, ltv, lane); tr_store(d, ltv, lscr, lane); }
}

typedef float f32x16 __attribute__((ext_vector_type(16)));
template <int KSTEPS>
__device__ __forceinline__ f32x16 mm32(f32x16 acc, const LAS bf16_t* A, int lda, const LAS bf16_t* Bt, int ldb, int lane) {
    const int r = lane & 31, h = lane >> 5;
    const LAS bf16_t* ap = A + r * lda + 8 * h; const LAS bf16_t* bp = Bt + r * ldb + 8 * h;
#pragma unroll
    for (int ks = 0; ks < KSTEPS; ++ks) acc = __builtin_amdgcn_mfma_f32_32x32x16_bf16(*(const LAS bf16x8*)(ap + 16 * ks), *(const LAS bf16x8*)(bp + 16 * ks), acc, 0, 0, 0);
    return acc;
}
#define TROW(i, lane) (((i) & 3) + 8 * ((i) >> 2) + 4 * ((lane) >> 5))
__device__ __forceinline__ unsigned short bf1(float f) { return (unsigned short)f2bf(f); }

__device__ __forceinline__ void phase4c(const Args& a, LAS unsigned char* lds) {
    const int tid = threadIdx.x, lane = tid & 63, wave = __builtin_amdgcn_readfirstlane(tid >> 6);
    unsigned char* ws = a.ws;
    TSTART(4); TSTART(1);
    for (int item = blockIdx.x; item < 256; item += gridDim.x) {
        if (tid < 64) {
            const int b = item >> 4, g = item & 15, n = tid;
            const f32x2 lamL = ((const f32x2*)(ws + WS_LAML))[g * 64 + n];
            const float* E = (const float*)(ws + WS_E) + ((size_t)g * S5ROWS + b * S5NCH) * 128;
            bf16_t* UG = (bf16_t*)(ws + WS_UG) + ((size_t)g * S5ROWS + b * S5NCH) * S5K + 512;
            float xr = 0.f, xi = 0.f;
#pragma unroll 8
            for (int ch = 0; ch < S5NCH; ++ch) {
                UG[(size_t)ch * S5K + n] = (bf16_t)f2bf(xr); UG[(size_t)ch * S5K + 64 + n] = (bf16_t)f2bf(xi);
                const float er = E[ch * 128 + n], ei = E[ch * 128 + 64 + n];
                const float nr = lamL[0] * xr - lamL[1] * xi + er, ni = lamL[0] * xi + lamL[1] * xr + ei; xr = nr; xi = ni;
            }
        }
    }
    TSTOP(1);
    if (gridDim.x != 256) { late_items_idle(a, lds, 0, N_LATE, 0); __syncthreads(); }
    const bf16_t* COLS = (const bf16_t*)(ws + WS_A); const bf16_t* LORA = (const bf16_t*)a.out;
    float* Y = (float*)(ws + WS_B); float* BON = (float*)(ws + WS_BON);
    LAS float* CUM = (LAS float*)lds;
    LAS float* PS = (LAS float*)(lds + 8192);
    LAS bf16_t* AT = (LAS bf16_t*)(lds + 10240);
    LAS bf16_t* BT = (LAS bf16_t*)(lds + 14848);
    LAS bf16_t* KT = (LAS bf16_t*)(lds + 19456);
    LAS bf16_t* RT = (LAS bf16_t*)(lds + 24064);
    LAS bf16_t* BTt = (LAS bf16_t*)(lds + 28672);
    LAS bf16_t* VmT = (LAS bf16_t*)(lds + 33792);
    LAS float* NabT = (LAS float*)(lds + 36352);
    LAS float* Nak = (LAS float*)(lds + 40960);
    LAS bf16_t* MbrT = (LAS bf16_t*)(lds + 45184);
    LAS bf16_t* A2 = (LAS bf16_t*)(lds + 47744);
    LAS bf16_t* NT = (LAS bf16_t*)(lds + 52864);
    LAS bf16_t* WyT = (LAS bf16_t*)(lds + 55424);
    LAS bf16_t* WzT = (LAS bf16_t*)(lds + 57984);
    LAS bf16_t* R2T = (LAS bf16_t*)(lds + 63104);
    LAS bf16_t* PpT = (LAS bf16_t*)(lds + 67712);
    LAS float* GC = (LAS float*)(lds + 76928);
    LAS bf16_t* SBF = (LAS bf16_t*)(lds + 77184);
    LAS float* YST = (LAS float*)(lds + 86400);
    for (int item = blockIdx.x; item < 256; item += gridDim.x) {
        const int bh = item >> 1, half = item & 1, b = bh >> 3, h = bh & 7;
        const int pj = tid >> 4, pq = tid & 15, hc = h * 64 + 4 * pq;
        const bool vmine = (pq >> 3) == half;
        u32x2 rc, rp, kc, kp, vc, vp, e4, a4;
        const u32x2 zero2 = (u32x2){0u, 0u};
        f32x16 Sacc;
#pragma unroll
        for (int i = 0; i < 16; ++i) Sacc[i] = 0.f;
        __syncthreads();
        for (int i = tid; i < 2 * 32 * 72 / 2; i += 512) ((LAS unsigned*)SBF)[i] = 0u;
#define WKV_LOAD(chunk) do { const int s_ = (chunk) * 32 + pj; const size_t t_ = (size_t)b * SEQ + s_; const bf16_t* cb_ = COLS + t_ * INC + hc; \
            rc = *(const u32x2*)(cb_ + C_R); kc = *(const u32x2*)(cb_ + C_K); vc = *(const u32x2*)(cb_ + C_V); \
            if (s_ > 0) { rp = *(const u32x2*)(cb_ - INC + C_R); kp = *(const u32x2*)(cb_ - INC + C_K); vp = *(const u32x2*)(cb_ - INC + C_V); } else { rp = zero2; kp = zero2; vp = zero2; } \
            e4 = *(const u32x2*)(LORA + t_ * 1536 + hc); a4 = *(const u32x2*)(LORA + t_ * 1536 + 512 + hc); } while (0)
        WKV_LOAD(0);
        for (int chunk = 0; chunk < SEQ / 32; ++chunk) {
            const int bi = chunk & 1;
            int tid_l = tid; asm volatile("" : "+v"(tid_l));
            const int lane = tid_l & 63, pj = tid_l >> 4, pq = tid_l & 15, tid = tid_l; (void)tid;
            float r_[4], k_[4], v_[4], e_[4], aa_[4], kkn_[4], k2_[4];
            { float rq_[4], kq_[4], vq_[4];
                const f32x4 mur = *(const f32x4*)(a.in[I_MU] + C_R + hc), muk = *(const f32x4*)(a.in[I_MU] + C_K + hc), muv = *(const f32x4*)(a.in[I_MU] + C_V + hc);
                const f32x4 kk4 = *(const f32x4*)(a.in[I_KK] + hc), ka4 = *(const f32x4*)(a.in[I_KA] + hc), rk4 = *(const f32x4*)(a.in[I_RK] + hc); unpack4(rc, r_); unpack4(rp, rq_); unpack4(kc, k_); unpack4(kp, kq_); unpack4(vc, v_); unpack4(vp, vq_); unpack4(e4, e_); unpack4(a4, aa_);
                float ss_ = 0.f, bon_ = 0.f;
#pragma unroll
                for (int i = 0; i < 4; ++i) { r_[i] += (rq_[i] - r_[i]) * mur[i]; k_[i] += (kq_[i] - k_[i]) * muk[i]; v_[i] += (vq_[i] - v_[i]) * muv[i];
                    kkn_[i] = k_[i] * kk4[i]; ss_ += kkn_[i] * kkn_[i]; k2_[i] = k_[i] * (1.0f + (aa_[i] - 1.0f) * ka4[i]); bon_ += r_[i] * k2_[i] * rk4[i]; }
                ss_ = row16_sum(ss_); bon_ = row16_sum(bon_); const float inv_ = __builtin_amdgcn_rsqf(fmaxf(ss_, 1e-24f));
#pragma unroll
                for (int i = 0; i < 4; ++i) kkn_[i] *= inv_;
                if (pq == 0 && half == 0) BON[((size_t)b * SEQ + chunk * 32 + pj) * 8 + h] = bon_;
                *(LAS f32x4*)(CUM + pj * 64 + 4 * pq) = (f32x4){e_[0], e_[1], e_[2], e_[3]}; }
            if (chunk + 1 < SEQ / 32) WKV_LOAD(chunk + 1);
            __syncthreads();
            {
                const int col = tid & 63, qd = tid >> 6; float e0 = CUM[(4 * qd) * 64 + col], e1 = CUM[(4 * qd + 1) * 64 + col], e2 = CUM[(4 * qd + 2) * 64 + col], e3 = CUM[(4 * qd + 3) * 64 + col];
                e1 += e0; e2 += e1; e3 += e2; PS[qd * 64 + col] = e3;
                __syncthreads();
                float base = 0.f;
#pragma unroll
                for (int q2 = 0; q2 < 7; ++q2) base += (q2 < qd) ? PS[q2 * 64 + col] : 0.f;
                CUM[(4 * qd) * 64 + col] = base + e0; CUM[(4 * qd + 1) * 64 + col] = base + e1; CUM[(4 * qd + 2) * 64 + col] = base + e2; CUM[(4 * qd + 3) * 64 + col] = base + e3; }
            __syncthreads();
            {
                const f32x4 cm = *(const LAS f32x4*)(CUM + pj * 64 + 4 * pq); float at_[4], bt_[4], kt_[4], rt_[4], g_[4];
#pragma unroll
                for (int i = 0; i < 4; ++i) { const float g = __expf(-cm[i]), ig = __expf(cm[i]), gp = __expf(e_[i] - cm[i]); g_[i] = g;
                    at_[i] = -kkn_[i] * gp; bt_[i] = kkn_[i] * aa_[i] * ig; kt_[i] = k2_[i] * ig; rt_[i] = r_[i] * g; }
                *(LAS u32x2*)(AT + pj * 72 + 4 * pq) = (u32x2){cvt_pk_bf16(at_[0], at_[1]), cvt_pk_bf16(at_[2], at_[3])};
                *(LAS u32x2*)(BT + pj * 72 + 4 * pq) = (u32x2){cvt_pk_bf16(bt_[0], bt_[1]), cvt_pk_bf16(bt_[2], bt_[3])};
                *(LAS u32x2*)(KT + pj * 72 + 4 * pq) = (u32x2){cvt_pk_bf16(kt_[0], kt_[1]), cvt_pk_bf16(kt_[2], kt_[3])};
                *(LAS u32x2*)(RT + pj * 72 + 4 * pq) = (u32x2){cvt_pk_bf16(rt_[0], rt_[1]), cvt_pk_bf16(rt_[2], rt_[3])};
#pragma unroll
                for (int i = 0; i < 4; ++i) BTt[(4 * pq + i) * 40 + pj] = bf1(bt_[i]);
                if (vmine) {
#pragma unroll
                    for (int i = 0; i < 4; ++i) VmT[(4 * pq - 32 * half + i) * 40 + pj] = bf1(v_[i]); }
                if (pj == 31) *(LAS f32x4*)(GC + 4 * pq) = (f32x4){g_[0], g_[1], g_[2], g_[3]}; }
            __syncthreads();
            f32x16 accw;
#pragma unroll
            for (int i = 0; i < 16; ++i) accw[i] = 0.f;
            if (wave < 4) {
                f32x16 acc;
#pragma unroll
                for (int i = 0; i < 16; ++i) acc[i] = 0.f;
                acc = mm32<4>(acc, (wave & 1) ? KT : BT, 72, (wave & 2) ? RT : AT, 72, lane);
                const int t = lane & 31;
                if (wave == 0) {
#pragma unroll
                    for (int g4 = 0; g4 < 4; ++g4) { const int s0 = 8 * g4 + 4 * (lane >> 5);
#pragma unroll
                        for (int i = 0; i < 4; ++i) NabT[t * 36 + i * 8 + 2 * g4 + (lane >> 5)] = (s0 + i < t) ? acc[4 * g4 + i] : 0.f; }
                } else if (wave == 1) {
#pragma unroll
                    for (int i = 0; i < 16; ++i) { const int s = TROW(i, lane); Nak[s * 33 + t] = (s < t) ? acc[i] : 0.f; }
                } else if (wave == 2) {
#pragma unroll
                    for (int g4 = 0; g4 < 4; ++g4) { const int s0 = 8 * g4 + 4 * (lane >> 5); float o[4];
#pragma unroll
                        for (int i = 0; i < 4; ++i) o[i] = (s0 + i <= t) ? acc[4 * g4 + i] : 0.f;
                        *(LAS u32x2*)(MbrT + t * 40 + s0) = (u32x2){cvt_pk_bf16(o[0], o[1]), cvt_pk_bf16(o[2], o[3])}; }
                } else {
#pragma unroll
                    for (int i = 0; i < 16; ++i) { const int s = TROW(i, lane); accw[i] = (s <= t) ? acc[i] : 0.f; }
                }
            }
            __syncthreads();
            if (wave < 6) {
                const int q = lane & 3, rowi = ((wave & 3) * 64 + lane) >> 2; const bool isA = wave < 4;
                float xq0, xq1, xq2, xq3, xq4, xq5, xq6, xq7;
                if (isA) {
                    xq0 = __builtin_bit_cast(float, (unsigned)AT[(0 + q) * 72 + rowi] << 16);
                    xq1 = __builtin_bit_cast(float, (unsigned)AT[(4 + q) * 72 + rowi] << 16);
                    xq2 = __builtin_bit_cast(float, (unsigned)AT[(8 + q) * 72 + rowi] << 16);
                    xq3 = __builtin_bit_cast(float, (unsigned)AT[(12 + q) * 72 + rowi] << 16);
                    xq4 = __builtin_bit_cast(float, (unsigned)AT[(16 + q) * 72 + rowi] << 16);
                    xq5 = __builtin_bit_cast(float, (unsigned)AT[(20 + q) * 72 + rowi] << 16);
                    xq6 = __builtin_bit_cast(float, (unsigned)AT[(24 + q) * 72 + rowi] << 16);
                    xq7 = __builtin_bit_cast(float, (unsigned)AT[(28 + q) * 72 + rowi] << 16);
                } else {
                    xq0 = Nak[rowi * 33 + 0 + q];
                    xq1 = Nak[rowi * 33 + 4 + q];
                    xq2 = Nak[rowi * 33 + 8 + q];
                    xq3 = Nak[rowi * 33 + 12 + q];
                    xq4 = Nak[rowi * 33 + 16 + q];
                    xq5 = Nak[rowi * 33 + 20 + q];
                    xq6 = Nak[rowi * 33 + 24 + q];
                    xq7 = Nak[rowi * 33 + 28 + q];
                }
                const bool kq0 = q == 0, kq1 = q == 1, kq2 = q == 2, kq3 = q == 3;
                const LAS float* np_ = NabT + q * 8;
                f32x4 n1_0, n2_0, n3_0, n4_0, n5_0, n6_0, n7_0, n8_0, n9_0, n10_0, n11_0, n12_0, n13_0, n14_0, n15_0, n16_0, n17_0, n17_1, n18_0, n18_1, n19_0, n19_1, n20_0, n20_1, n21_0, n21_1, n22_0, n22_1, n23_0, n23_1, n24_0, n24_1, n25_0, n25_1, n26_0, n26_1, n27_0, n27_1, n28_0, n28_1, n29_0, n29_1, n30_0, n30_1, n31_0, n31_1;
                float pe1, pe2, pe3, pe4, pe5, pe6, pe7, pe8, pe9, pe10, pe11, pe12, pe13, pe14, pe15, pe16, pe17, pe18, pe19, pe20, pe21, pe22, pe23, pe24, pe25, pe26, pe27, pe28, pe29, pe30, pe31, pe32;
                n1_0 = *(const LAS f32x4*)(np_ + 1 * 36); n2_0 = *(const LAS f32x4*)(np_ + 2 * 36); pe1 = 0.f;
                { n3_0 = *(const LAS f32x4*)(np_ + 3 * 36); float p = pe1; asm("v_fmac_f32 %0, %1, %2" : "+v"(p) : "v"(xq0), "v"(n1_0[0])); p += dpp_f(p, 0); pe2 = 0.f; p += dpp_f(p, 1); xq0 = kq1 ? (xq0 + p) : xq0; asm volatile("" : "+v"(xq0), "+v"(np_) : "v"(n1_0)); }
                { n4_0 = *(const LAS f32x4*)(np_ + 4 * 36); float p = pe2; asm("v_fmac_f32 %0, %1, %2" : "+v"(p) : "v"(xq0), "v"(n2_0[0])); p += dpp_f(p, 0); pe3 = 0.f; p += dpp_f(p, 1); xq0 = kq2 ? (xq0 + p) : xq0; asm volatile("" : "+v"(xq0), "+v"(np_) : "v"(n2_0)); }
                { n5_0 = *(const LAS f32x4*)(np_ + 5 * 36); float p = pe3; asm("v_fmac_f32 %0, %1, %2" : "+v"(p) : "v"(xq0), "v"(n3_0[0])); p += dpp_f(p, 0); pe4 = 0.f; p += dpp_f(p, 1); xq0 = kq3 ? (xq0 + p) : xq0; asm volatile("" : "+v"(xq0), "+v"(np_) : "v"(n3_0)); }
                { n6_0 = *(const LAS f32x4*)(np_ + 6 * 36); float p = pe4; asm("v_fmac_f32 %0, %1, %2" : "+v"(p) : "v"(xq0), "v"(n4_0[0])); p += dpp_f(p, 0); pe5 = 0.f; asm("v_fmac_f32 %0, %1, %2" : "+v"(pe5) : "v"(xq0), "v"(n5_0[0])); p += dpp_f(p, 1); xq1 = kq0 ? (xq1 + p) : xq1; asm volatile("" : "+v"(xq1), "+v"(np_) : "v"(n4_0)); }
                { n7_0 = *(const LAS f32x4*)(np_ + 7 * 36); float p = pe5; asm("v_fmac_f32 %0, %1, %2" : "+v"(p) : "v"(xq1), "v"(n5_0[1])); p += dpp_f(p, 0); pe6 = 0.f; asm("v_fmac_f32 %0, %1, %2" : "+v"(pe6) : "v"(xq0), "v"(n6_0[0])); p += dpp_f(p, 1); xq1 = kq1 ? (xq1 + p) : xq1; asm volatile("" : "+v"(xq1), "+v"(np_) : "v"(n5_0)); }
                { n8_0 = *(const LAS f32x4*)(np_ + 8 * 36); float p = pe6; asm("v_fmac_f32 %0, %1, %2" : "+v"(p) : "v"(xq1), "v"(n6_0[1])); p += dpp_f(p, 0); pe7 = 0.f; asm("v_fmac_f32 %0, %1, %2" : "+v"(pe7) : "v"(xq0), "v"(n7_0[0])); p += dpp_f(p, 1); xq1 = kq2 ? (xq1 + p) : xq1; asm volatile("" : "+v"(xq1), "+v"(np_) : "v"(n6_0)); }
                { n9_0 = *(const LAS f32x4*)(np_ + 9 * 36); float p = pe7; asm("v_fmac_f32 %0, %1, %2" : "+v"(p) : "v"(xq1), "v"(n7_0[1])); p += dpp_f(p, 0); pe8 = 0.f; asm("v_fmac_f32 %0, %1, %2" : "+v"(pe8) : "v"(xq0), "v"(n8_0[0])); p += dpp_f(p, 1); xq1 = kq3 ? (xq1 + p) : xq1; asm volatile("" : "+v"(xq1), "+v"(np_) : "v"(n7_0)); }
                { n10_0 = *(const LAS f32x4*)(np_ + 10 * 36); float p = pe8; asm("v_fmac_f32 %0, %1, %2" : "+v"(p) : "v"(xq1), "v"(n8_0[1])); p += dpp_f(p, 0); pe9 = 0.f; asm("v_fmac_f32 %0, %1, %2" : "+v"(pe9) : "v"(xq0), "v"(n9_0[0])); asm("v_fmac_f32 %0, %1, %2" : "+v"(pe9) : "v"(xq1), "v"(n9_0[1])); p += dpp_f(p, 1); xq2 = kq0 ? (xq2 + p) : xq2; asm volatile("" : "+v"(xq2), "+v"(np_) : "v"(n8_0)); }
                { n11_0 = *(const LAS f32x4*)(np_ + 11 * 36); float p = pe9; asm("v_fmac_f32 %0, %1, %2" : "+v"(p) : "v"(xq2), "v"(n9_0[2])); p += dpp_f(p, 0); pe10 = 0.f; asm("v_fmac_f32 %0, %1, %2" : "+v"(pe10) : "v"(xq0), "v"(n10_0[0])); asm("v_fmac_f32 %0, %1, %2" : "+v"(pe10) : "v"(xq1), "v"(n10_0[1])); p += dpp_f(p, 1); xq2 = kq1 ? (xq2 + p) : xq2; asm volatile("" : "+v"(xq2), "+v"(np_) : "v"(n9_0)); }
                { n12_0 = *(const LAS f32x4*)(np_ + 12 * 36); float p = pe10; asm("v_fmac_f32 %0, %1, %2" : "+v"(p) : "v"(xq2), "v"(n10_0[2])); p += dpp_f(p, 0); pe11 = 0.f; asm("v_fmac_f32 %0, %1, %2" : "+v"(pe11) : "v"(xq0), "v"(n11_0[0])); asm("v_fmac_f32 %0, %1, %2" : "+v"(pe11) : "v"(xq1), "v"(n11_0[1])); p += dpp_f(p, 1); xq2 = kq2 ? (xq2 + p) : xq2; asm volatile("" : "+v"(xq2), "+v"(np_) : "v"(n10_0)); }
                { n13_0 = *(const LAS f32x4*)(np_ + 13 * 36); float p = pe11; asm("v_fmac_f32 %0, %1, %2" : "+v"(p) : "v"(xq2), "v"(n11_0[2])); p += dpp_f(p, 0); pe12 = 0.f; asm("v_fmac_f32 %0, %1, %2" : "+v"(pe12) : "v"(xq0), "v"(n12_0[0])); asm("v_fmac_f32 %0, %1, %2" : "+v"(pe12) : "v"(xq1), "v"(n12_0[1])); p += dpp_f(p, 1); xq2 = kq3 ? (xq2 + p) : xq2; asm volatile("" : "+v"(xq2), "+v"(np_) : "v"(n11_0)); }
                { n14_0 = *(const LAS f32x4*)(np_ + 14 * 36); float p = pe12; asm("v_fmac_f32 %0, %1, %2" : "+v"(p) : "v"(xq2), "v"(n12_0[2])); p += dpp_f(p, 0); pe13 = 0.f; asm("v_fmac_f32 %0, %1, %2" : "+v"(pe13) : "v"(xq0), "v"(n13_0[0])); asm("v_fmac_f32 %0, %1, %2" : "+v"(pe13) : "v"(xq1), "v"(n13_0[1])); asm("v_fmac_f32 %0, %1, %2" : "+v"(pe13) : "v"(xq2), "v"(n13_0[2])); p += dpp_f(p, 1); xq3 = kq0 ? (xq3 + p) : xq3; asm volatile("" : "+v"(xq3), "+v"(np_) : "v"(n12_0)); }
                { n15_0 = *(const LAS f32x4*)(np_ + 15 * 36); float p = pe13; asm("v_fmac_f32 %0, %1, %2" : "+v"(p) : "v"(xq3), "v"(n13_0[3])); p += dpp_f(p, 0); pe14 = 0.f; asm("v_fmac_f32 %0, %1, %2" : "+v"(pe14) : "v"(xq0), "v"(n14_0[0])); asm("v_fmac_f32 %0, %1, %2" : "+v"(pe14) : "v"(xq1), "v"(n14_0[1])); asm("v_fmac_f32 %0, %1, %2" : "+v"(pe14) : "v"(xq2), "v"(n14_0[2])); p += dpp_f(p, 1); xq3 = kq1 ? (xq3 + p) : xq3; asm volatile("" : "+v"(xq3), "+v"(np_) : "v"(n13_0)); }
                { n16_0 = *(const LAS f32x4*)(np_ + 16 * 36); float p = pe14; asm("v_fmac_f32 %0, %1, %2" : "+v"(p) : "v"(xq3), "v"(n14_0[3])); p += dpp_f(p, 0); pe15 = 0.f; asm("v_fmac_f32 %0, %1, %2" : "+v"(pe15) : "v"(xq0), "v"(n15_0[0])); asm("v_fmac_f32 %0, %1, %2" : "+v"(pe15) : "v"(xq1), "v"(n15_0[1])); asm("v_fmac_f32 %0, %1, %2" : "+v"(pe15) : "v"(xq2), "v"(n15_0[2])); p += dpp_f(p, 1); xq3 = kq2 ? (xq3 + p) : xq3; asm volatile("" : "+v"(xq3), "+v"(np_) : "v"(n14_0)); }
                { n17_0 = *(const LAS f32x4*)(np_ + 17 * 36); n17_1 = *(const LAS f32x4*)(np_ + 17 * 36 + 4); float p = pe15; asm("v_fmac_f32 %0, %1, %2" : "+v"(p) : "v"(xq3), "v"(n15_0[3])); p += dpp_f(p, 0); pe16 = 0.f; asm("v_fmac_f32 %0, %1, %2" : "+v"(pe16) : "v"(xq0), "v"(n16_0[0])); asm("v_fmac_f32 %0, %1, %2" : "+v"(pe16) : "v"(xq1), "v"(n16_0[1])); asm("v_fmac_f32 %0, %1, %2" : "+v"(pe16) : "v"(xq2), "v"(n16_0[2])); p += dpp_f(p, 1); xq3 = kq3 ? (xq3 + p) : xq3; asm volatile("" : "+v"(xq3), "+v"(np_) : "v"(n15_0)); }
                { n18_0 = *(const LAS f32x4*)(np_ + 18 * 36); n18_1 = *(const LAS f32x4*)(np_ + 18 * 36 + 4); float p = pe16; asm("v_fmac_f32 %0, %1, %2" : "+v"(p) : "v"(xq3), "v"(n16_0[3])); p += dpp_f(p, 0); pe17 = 0.f; asm("v_fmac_f32 %0, %1, %2" : "+v"(pe17) : "v"(xq0), "v"(n17_0[0])); asm("v_fmac_f32 %0, %1, %2" : "+v"(pe17) : "v"(xq1), "v"(n17_0[1])); asm("v_fmac_f32 %0, %1, %2" : "+v"(pe17) : "v"(xq2), "v"(n17_0[2])); asm("v_fmac_f32 %0, %1, %2" : "+v"(pe17) : "v"(xq3), "v"(n17_0[3])); p += dpp_f(p, 1); xq4 = kq0 ? (xq4 + p) : xq4; asm volatile("" : "+v"(xq4), "+v"(np_) : "v"(n16_0)); }
                { n19_0 = *(const LAS f32x4*)(np_ + 19 * 36); n19_1 = *(const LAS f32x4*)(np_ + 19 * 36 + 4); float p = pe17; asm("v_fmac_f32 %0, %1, %2" : "+v"(p) : "v"(xq4), "v"(n17_1[0])); p += dpp_f(p, 0); pe18 = 0.f; asm("v_fmac_f32 %0, %1, %2" : "+v"(pe18) : "v"(xq0), "v"(n18_0[0])); asm("v_fmac_f32 %0, %1, %2" : "+v"(pe18) : "v"(xq1), "v"(n18_0[1])); asm("v_fmac_f32 %0, %1, %2" : "+v"(pe18) : "v"(xq2), "v"(n18_0[2])); asm("v_fmac_f32 %0, %1, %2" : "+v"(pe18) : "v"(xq3), "v"(n18_0[3])); p += dpp_f(p, 1); xq4 = kq1 ? (xq4 + p) : xq4; asm volatile("" : "+v"(xq4), "+v"(np_) : "v"(n17_0), "v"(n17_1)); }
                { n20_0 = *(const LAS f32x4*)(np_ + 20 * 36); n20_1 = *(const LAS f32x4*)(np_ + 20 * 36 + 4); float p = pe18; asm("v_fmac_f32 %0, %1, %2" : "+v"(p) : "v"(xq4), "v"(n18_1[0])); p += dpp_f(p, 0); pe19 = 0.f; asm("v_fmac_f32 %0, %1, %2" : "+v"(pe19) : "v"(xq0), "v"(n19_0[0])); asm("v_fmac_f32 %0, %1, %2" : "+v"(pe19) : "v"(xq1), "v"(n19_0[1])); asm("v_fmac_f32 %0, %1, %2" : "+v"(pe19) : "v"(xq2), "v"(n19_0[2])); asm("v_fmac_f32 %0, %1, %2" : "+v"(pe19) : "v"(xq3), "v"(n19_0[3])); p += dpp_f(p, 1); xq4 = kq2 ? (xq4 + p) : xq4; asm volatile("" : "+v"(xq4), "+v"(np_) : "v"(n18_0), "v"(n18_1)); }
                { n21_0 = *(const LAS f32x4*)(np_ + 21 * 36); n21_1 = *(const LAS f32x4*)(np_ + 21 * 36 + 4); float p = pe19; asm("v_fmac_f32 %0, %1, %2" : "+v"(p) : "v"(xq4), "v"(n19_1[0])); p += dpp_f(p, 0); pe20 = 0.f; asm("v_fmac_f32 %0, %1, %2" : "+v"(pe20) : "v"(xq0), "v"(n20_0[0])); asm("v_fmac_f32 %0, %1, %2" : "+v"(pe20) : "v"(xq1), "v"(n20_0[1])); asm("v_fmac_f32 %0, %1, %2" : "+v"(pe20) : "v"(xq2), "v"(n20_0[2])); asm("v_fmac_f32 %0, %1, %2" : "+v"(pe20) : "v"(xq3), "v"(n20_0[3])); p += dpp_f(p, 1); xq4 = kq3 ? (xq4 + p) : xq4; asm volatile("" : "+v"(xq4), "+v"(np_) : "v"(n19_0), "v"(n19_1)); }
                { n22_0 = *(const LAS f32x4*)(np_ + 22 * 36); n22_1 = *(const LAS f32x4*)(np_ + 22 * 36 + 4); float p = pe20; asm("v_fmac_f32 %0, %1, %2" : "+v"(p) : "v"(xq4), "v"(n20_1[0])); p += dpp_f(p, 0); pe21 = 0.f; asm("v_fmac_f32 %0, %1, %2" : "+v"(pe21) : "v"(xq0), "v"(n21_0[0])); asm("v_fmac_f32 %0, %1, %2" : "+v"(pe21) : "v"(xq1), "v"(n21_0[1])); asm("v_fmac_f32 %0, %1, %2" : "+v"(pe21) : "v"(xq2), "v"(n21_0[2])); asm("v_fmac_f32 %0, %1, %2" : "+v"(pe21) : "v"(xq3), "v"(n21_0[3])); asm("v_fmac_f32 %0, %1, %2" : "+v"(pe21) : "v"(xq4), "v"(n21_1[0])); p += dpp_f(p, 1); xq5 = kq0 ? (xq5 + p) : xq5; asm volatile("" : "+v"(xq5), "+v"(np_) : "v"(n20_0), "v"(n20_1)); }
                { n23_0 = *(const LAS f32x4*)(np_ + 23 * 36); n23_1 = *(const LAS f32x4*)(np_ + 23 * 36 + 4); float p = pe21; asm("v_fmac_f32 %0, %1, %2" : "+v"(p) : "v"(xq5), "v"(n21_1[1])); p += dpp_f(p, 0); pe22 = 0.f; asm("v_fmac_f32 %0, %1, %2" : "+v"(pe22) : "v"(xq0), "v"(n22_0[0])); asm("v_fmac_f32 %0, %1, %2" : "+v"(pe22) : "v"(xq1), "v"(n22_0[1])); asm("v_fmac_f32 %0, %1, %2" : "+v"(pe22) : "v"(xq2), "v"(n22_0[2])); asm("v_fmac_f32 %0, %1, %2" : "+v"(pe22) : "v"(xq3), "v"(n22_0[3])); asm("v_fmac_f32 %0, %1, %2" : "+v"(pe22) : "v"(xq4), "v"(n22_1[0])); p += dpp_f(p, 1); xq5 = kq1 ? (xq5 + p) : xq5; asm volatile("" : "+v"(xq5), "+v"(np_) : "v"(n21_0), "v"(n21_1)); }
                { n24_0 = *(const LAS f32x4*)(np_ + 24 * 36); n24_1 = *(const LAS f32x4*)(np_ + 24 * 36 + 4); float p = pe22; asm("v_fmac_f32 %0, %1, %2" : "+v"(p) : "v"(xq5), "v"(n22_1[1])); p += dpp_f(p, 0); pe23 = 0.f; asm("v_fmac_f32 %0, %1, %2" : "+v"(pe23) : "v"(xq0), "v"(n23_0[0])); asm("v_fmac_f32 %0, %1, %2" : "+v"(pe23) : "v"(xq1), "v"(n23_0[1])); asm("v_fmac_f32 %0, %1, %2" : "+v"(pe23) : "v"(xq2), "v"(n23_0[2])); asm("v_fmac_f32 %0, %1, %2" : "+v"(pe23) : "v"(xq3), "v"(n23_0[3])); asm("v_fmac_f32 %0, %1, %2" : "+v"(pe23) : "v"(xq4), "v"(n23_1[0])); p += dpp_f(p, 1); xq5 = kq2 ? (xq5 + p) : xq5; asm volatile("" : "+v"(xq5), "+v"(np_) : "v"(n22_0), "v"(n22_1)); }
                { n25_0 = *(const LAS f32x4*)(np_ + 25 * 36); n25_1 = *(const LAS f32x4*)(np_ + 25 * 36 + 4); float p = pe23; asm("v_fmac_f32 %0, %1, %2" : "+v"(p) : "v"(xq5), "v"(n23_1[1])); p += dpp_f(p, 0); pe24 = 0.f; asm("v_fmac_f32 %0, %1, %2" : "+v"(pe24) : "v"(xq0), "v"(n24_0[0])); asm("v_fmac_f32 %0, %1, %2" : "+v"(pe24) : "v"(xq1), "v"(n24_0[1])); asm("v_fmac_f32 %0, %1, %2" : "+v"(pe24) : "v"(xq2), "v"(n24_0[2])); asm("v_fmac_f32 %0, %1, %2" : "+v"(pe24) : "v"(xq3), "v"(n24_0[3])); asm("v_fmac_f32 %0, %1, %2" : "+v"(pe24) : "v"(xq4), "v"(n24_1[0])); p += dpp_f(p, 1); xq5 = kq3 ? (xq5 + p) : xq5; asm volatile("" : "+v"(xq5), "+v"(np_) : "v"(n23_0), "v"(n23_1)); }
                { n26_0 = *(const LAS f32x4*)(np_ + 26 * 36); n26_1 = *(const LAS f32x4*)(np_ + 26 * 36 + 4); float p = pe24; asm("v_fmac_f32 %0, %1, %2" : "+v"(p) : "v"(xq5), "v"(n24_1[1])); p += dpp_f(p, 0); pe25 = 0.f; asm("v_fmac_f32 %0, %1, %2" : "+v"(pe25) : "v"(xq0), "v"(n25_0[0])); asm("v_fmac_f32 %0, %1, %2" : "+v"(pe25) : "v"(xq1), "v"(n25_0[1])); asm("v_fmac_f32 %0, %1, %2" : "+v"(pe25) : "v"(xq2), "v"(n25_0[2])); asm("v_fmac_f32 %0, %1, %2" : "+v"(pe25) : "v"(xq3), "v"(n25_0[3])); asm("v_fmac_f32 %0, %1, %2" : "+v"(pe25) : "v"(xq4), "v"(n25_1[0])); asm("v_fmac_f32 %0, %1, %2" : "+v"(pe25) : "v"(xq5), "v"(n25_1[1])); p += dpp_f(p, 1); xq6 = kq0 ? (xq6 + p) : xq6; asm volatile("" : "+v"(xq6), "+v"(np_) : "v"(n24_0), "v"(n24_1)); }
                { n27_0 = *(const LAS f32x4*)(np_ + 27 * 36); n27_1 = *(const LAS f32x4*)(np_ + 27 * 36 + 4); float p = pe25; asm("v_fmac_f32 %0, %1, %2" : "+v"(p) : "v"(xq6), "v"(n25_1[2])); p += dpp_f(p, 0); pe26 = 0.f; asm("v_fmac_f32 %0, %1, %2" : "+v"(pe26) : "v"(xq0), "v"(n26_0[0])); asm("v_fmac_f32 %0, %1, %2" : "+v"(pe26) : "v"(xq1), "v"(n26_0[1])); asm("v_fmac_f32 %0, %1, %2" : "+v"(pe26) : "v"(xq2), "v"(n26_0[2])); asm("v_fmac_f32 %0, %1, %2" : "+v"(pe26) : "v"(xq3), "v"(n26_0[3])); asm("v_fmac_f32 %0, %1, %2" : "+v"(pe26) : "v"(xq4), "v"(n26_1[0])); asm("v_fmac_f32 %0, %1, %2" : "+v"(pe26) : "v"(xq5), "v"(n26_1[1])); p += dpp_f(p, 1); xq6 = kq1 ? (xq6 + p) : xq6; asm volatile("" : "+v"(xq6), "+v"(np_) : "v"(n25_0), "v"(n25_1)); }
                { n28_0 = *(const LAS f32x4*)(np_ + 28 * 36); n28_1 = *(const LAS f32x4*)(np_ + 28 * 36 + 4); float p = pe26; asm("v_fmac_f32 %0, %1, %2" : "+v"(p) : "v"(xq6), "v"(n26_1[2])); p += dpp_f(p, 0); pe27 = 0.f; asm("v_fmac_f32 %0, %1, %2" : "+v"(pe27) : "v"(xq0), "v"(n27_0[0])); asm("v_fmac_f32 %0, %1, %2" : "+v"(pe27) : "v"(xq1), "v"(n27_0[1])); asm("v_fmac_f32 %0, %1, %2" : "+v"(pe27) : "v"(xq2), "v"(n27_0[2])); asm("v_fmac_f32 %0, %1, %2" : "+v"(pe27) : "v"(xq3), "v"(n27_0[3])); asm("v_fmac_f32 %0, %1, %2" : "+v"(pe27) : "v"(xq4), "v"(n27_1[0])); asm("v_fmac_f32 %0, %1, %2" : "+v"(pe27) : "v"(xq5), "v"(n27_1[1])); p += dpp_f(p, 1); xq6 = kq2 ? (xq6 + p) : xq6; asm volatile("" : "+v"(xq6), "+v"(np_) : "v"(n26_0), "v"(n26_1)); }
                { n29_0 = *(const LAS f32x4*)(np_ + 29 * 36); n29_1 = *(const LAS f32x4*)(np_ + 29 * 36 + 4); float p = pe27; asm("v_fmac_f32 %0, %1, %2" : "+v"(p) : "v"(xq6), "v"(n27_1[2])); p += dpp_f(p, 0); pe28 = 0.f; asm("v_fmac_f32 %0, %1, %2" : "+v"(pe28) : "v"(xq0), "v"(n28_0[0])); asm("v_fmac_f32 %0, %1, %2" : "+v"(pe28) : "v"(xq1), "v"(n28_0[1])); asm("v_fmac_f32 %0, %1, %2" : "+v"(pe28) : "v"(xq2), "v"(n28_0[2])); asm("v_fmac_f32 %0, %1, %2" : "+v"(pe28) : "v"(xq3), "v"(n28_0[3])); asm("v_fmac_f32 %0, %1, %2" : "+v"(pe28) : "v"(xq4), "v"(n28_1[0])); asm("v_fmac_f32 %0, %1, %2" : "+v"(pe28) : "v"(xq5), "v"(n28_1[1])); p += dpp_f(p, 1); xq6 = kq3 ? (xq6 + p) : xq6; asm volatile("" : "+v"(xq6), "+v"(np_) : "v"(n27_0), "v"(n27_1)); }
                { n30_0 = *(const LAS f32x4*)(np_ + 30 * 36); n30_1 = *(const LAS f32x4*)(np_ + 30 * 36 + 4); float p = pe28; asm("v_fmac_f32 %0, %1, %2" : "+v"(p) : "v"(xq6), "v"(n28_1[2])); p += dpp_f(p, 0); pe29 = 0.f; asm("v_fmac_f32 %0, %1, %2" : "+v"(pe29) : "v"(xq0), "v"(n29_0[0])); asm("v_fmac_f32 %0, %1, %2" : "+v"(pe29) : "v"(xq1), "v"(n29_0[1])); asm("v_fmac_f32 %0, %1, %2" : "+v"(pe29) : "v"(xq2), "v"(n29_0[2])); asm("v_fmac_f32 %0, %1, %2" : "+v"(pe29) : "v"(xq3), "v"(n29_0[3])); asm("v_fmac_f32 %0, %1, %2" : "+v"(pe29) : "v"(xq4), "v"(n29_1[0])); asm("v_fmac_f32 %0, %1, %2" : "+v"(pe29) : "v"(xq5), "v"(n29_1[1])); asm("v_fmac_f32 %0, %1, %2" : "+v"(pe29) : "v"(xq6), "v"(n29_1[2])); p += dpp_f(p, 1); xq7 = kq0 ? (xq7 + p) : xq7; asm volatile("" : "+v"(xq7), "+v"(np_) : "v"(n28_0), "v"(n28_1)); }
                { n31_0 = *(const LAS f32x4*)(np_ + 31 * 36); n31_1 = *(const LAS f32x4*)(np_ + 31 * 36 + 4); float p = pe29; asm("v_fmac_f32 %0, %1, %2" : "+v"(p) : "v"(xq7), "v"(n29_1[3])); p += dpp_f(p, 0); pe30 = 0.f; asm("v_fmac_f32 %0, %1, %2" : "+v"(pe30) : "v"(xq0), "v"(n30_0[0])); asm("v_fmac_f32 %0, %1, %2" : "+v"(pe30) : "v"(xq1), "v"(n30_0[1])); asm("v_fmac_f32 %0, %1, %2" : "+v"(pe30) : "v"(xq2), "v"(n30_0[2])); asm("v_fmac_f32 %0, %1, %2" : "+v"(pe30) : "v"(xq3), "v"(n30_0[3])); asm("v_fmac_f32 %0, %1, %2" : "+v"(pe30) : "v"(xq4), "v"(n30_1[0])); asm("v_fmac_f32 %0, %1, %2" : "+v"(pe30) : "v"(xq5), "v"(n30_1[1])); asm("v_fmac_f32 %0, %1, %2" : "+v"(pe30) : "v"(xq6), "v"(n30_1[2])); p += dpp_f(p, 1); xq7 = kq1 ? (xq7 + p) : xq7; asm volatile("" : "+v"(xq7), "+v"(np_) : "v"(n29_0), "v"(n29_1)); }
                { float p = pe30; asm("v_fmac_f32 %0, %1, %2" : "+v"(p) : "v"(xq7), "v"(n30_1[3])); p += dpp_f(p, 0); pe31 = 0.f; asm("v_fmac_f32 %0, %1, %2" : "+v"(pe31) : "v"(xq0), "v"(n31_0[0])); asm("v_fmac_f32 %0, %1, %2" : "+v"(pe31) : "v"(xq1), "v"(n31_0[1])); asm("v_fmac_f32 %0, %1, %2" : "+v"(pe31) : "v"(xq2), "v"(n31_0[2])); asm("v_fmac_f32 %0, %1, %2" : "+v"(pe31) : "v"(xq3), "v"(n31_0[3])); asm("v_fmac_f32 %0, %1, %2" : "+v"(pe31) : "v"(xq4), "v"(n31_1[0])); asm("v_fmac_f32 %0, %1, %2" : "+v"(pe31) : "v"(xq5), "v"(n31_1[1])); asm("v_fmac_f32 %0, %1, %2" : "+v"(pe31) : "v"(xq6), "v"(n31_1[2])); p += dpp_f(p, 1); xq7 = kq2 ? (xq7 + p) : xq7; asm volatile("" : "+v"(xq7), "+v"(np_) : "v"(n30_0), "v"(n30_1)); }
                { float p = pe31; asm("v_fmac_f32 %0, %1, %2" : "+v"(p) : "v"(xq7), "v"(n31_1[3])); p += dpp_f(p, 0); p += dpp_f(p, 1); xq7 = kq3 ? (xq7 + p) : xq7; asm volatile("" : "+v"(xq7), "+v"(np_) : "v"(n31_0), "v"(n31_1)); }
                LAS bf16_t* dst = isA ? (A2 + rowi * 40 + q) : (NT + rowi * 40 + q);
                dst[0] = bf1(xq0);
                dst[4] = bf1(xq1);
                dst[8] = bf1(xq2);
                dst[12] = bf1(xq3);
                dst[16] = bf1(xq4);
                dst[20] = bf1(xq5);
                dst[24] = bf1(xq6);
                dst[28] = bf1(xq7);
            }
            __syncthreads();
            {
                const int t = lane & 31; f32x16 acc;
#pragma unroll
                for (int i = 0; i < 16; ++i) acc[i] = 0.f;
                if (wave == 0 || wave == 1) {
                    acc = mm32<2>(acc, NT, 40, BTt + 32 * wave * 40, 40, lane); const int k = 32 * wave + t; const float gc = GC[k];
#pragma unroll
                    for (int g4 = 0; g4 < 4; ++g4) { const int s0 = 8 * g4 + 4 * (lane >> 5); float o[4];
#pragma unroll
                        for (int i = 0; i < 4; ++i) o[i] = (acc[4 * g4 + i] + __builtin_bit_cast(float, (unsigned)KT[(s0 + i) * 72 + k] << 16)) * gc;
                        *(LAS u32x2*)(WzT + k * 40 + s0) = (u32x2){cvt_pk_bf16(o[0], o[1]), cvt_pk_bf16(o[2], o[3])}; }
                } else if (wave == 2 || wave == 6) {
                    const int rh = (wave == 6) ? 1 : 0; acc = mm32<2>(acc, A2 + 32 * rh * 40, 40, MbrT, 40, lane);
#pragma unroll
                    for (int g4 = 0; g4 < 4; ++g4) { const int k0 = 32 * rh + 8 * g4 + 4 * (lane >> 5); float o[4]; const u32x2 rv = *(const LAS u32x2*)(RT + t * 72 + k0);
                        o[0] = acc[4 * g4] + bflo(rv.x); o[1] = acc[4 * g4 + 1] + bfhi(rv.x); o[2] = acc[4 * g4 + 2] + bflo(rv.y); o[3] = acc[4 * g4 + 3] + bfhi(rv.y);
                        *(LAS u32x2*)(R2T + t * 72 + k0) = (u32x2){cvt_pk_bf16(o[0], o[1]), cvt_pk_bf16(o[2], o[3])}; }
                } else {
                    if (wave == 3) { accw = mm32<2>(accw, NT, 40, MbrT, 40, lane);
#pragma unroll
                        for (int g4 = 0; g4 < 4; ++g4) { const int s0 = 8 * g4 + 4 * (lane >> 5);
                            *(LAS u32x2*)(WyT + t * 40 + s0) = (u32x2){cvt_pk_bf16(accw[4 * g4], accw[4 * g4 + 1]), cvt_pk_bf16(accw[4 * g4 + 2], accw[4 * g4 + 3])}; } }
                    const int pt = (wave == 3) ? 3 : (wave == 7 ? 2 : wave - 4);
                    const int rh = pt >> 1, ch = pt & 1; acc = mm32<2>(acc, A2 + 32 * rh * 40, 40, BTt + 32 * ch * 40, 40, lane); const int kp = 32 * ch + t; const float gc = GC[kp];
#pragma unroll
                    for (int g4 = 0; g4 < 4; ++g4) { const int k0 = 32 * rh + 8 * g4 + 4 * (lane >> 5);
                        *(LAS u32x2*)(PpT + kp * 72 + k0) = (u32x2){cvt_pk_bf16(acc[4 * g4] * gc, acc[4 * g4 + 1] * gc), cvt_pk_bf16(acc[4 * g4 + 2] * gc, acc[4 * g4 + 3] * gc)}; }
                }
            }
            __syncthreads();
            if (wave < 3) {
                const int t = lane & 31; const LAS bf16_t* Sb = SBF + bi * (32 * 72); f32x16 acc;
#pragma unroll
                for (int i = 0; i < 16; ++i) acc[i] = 0.f;
                if (wave < 2) {
                    acc = mm32<2>(acc, VmT, 40, WzT + 32 * wave * 40, 40, lane);
                    acc = mm32<4>(acc, Sb, 72, PpT + 32 * wave * 72, 72, lane);
                    const float gc = GC[32 * wave + t]; LAS bf16_t* Sn = SBF + (bi ^ 1) * (32 * 72);
#pragma unroll
                    for (int i = 0; i < 16; ++i) { Sacc[i] = fmaf(Sacc[i], gc, acc[i]); Sn[TROW(i, lane) * 72 + 32 * wave + t] = bf1(Sacc[i]); }
                } else {
                    acc = mm32<2>(acc, VmT, 40, WyT, 40, lane);
                    acc = mm32<4>(acc, Sb, 72, R2T, 72, lane);
#pragma unroll
                    for (int i = 0; i < 16; ++i) YST[t * 33 + TROW(i, lane)] = acc[i];
                }
            }
            __syncthreads();
            { const LAS float* ys = YST + pj * 33 + 2 * pq;
                *(f32x2*)(Y + ((size_t)b * SEQ + chunk * 32 + pj) * 512 + h * 64 + 32 * half + 2 * pq) = (f32x2){ys[0], ys[1]}; }
        }
#undef WKV_LOAD
    }
    TSTOP(4);
}


constexpr int STG_R_STRIDE = 10752;
struct WSet { LAS float* CUM; LAS float* PS; LAS bf16_t* AT; LAS bf16_t* BT; LAS bf16_t* KT; LAS bf16_t* RT; LAS bf16_t* BTt; LAS bf16_t* ATt; LAS float* NabT; LAS bf16_t* Nakb; LAS bf16_t* MbrT; LAS bf16_t* Tb; LAS bf16_t* Ut; LAS bf16_t* Wt;
              LAS bf16_t* WyT; LAS bf16_t* WzT; LAS bf16_t* R2T; LAS bf16_t* PpT; LAS float* GC; };
constexpr int WSET_BYTES = 59136;
__device__ __forceinline__ WSet wset(LAS unsigned char* p) {
    WSet s; s.CUM = (LAS float*)p; s.PS = (LAS float*)(p + 8192); s.WyT = (LAS bf16_t*)p; s.WzT = (LAS bf16_t*)(p + 2560);
    s.AT = (LAS bf16_t*)(p + 10240); s.BT = (LAS bf16_t*)(p + 14848); s.PpT = (LAS bf16_t*)(p + 10240); s.KT = (LAS bf16_t*)(p + 19456); s.RT = (LAS bf16_t*)(p + 24064);
    s.BTt = (LAS bf16_t*)(p + 28672); s.ATt = (LAS bf16_t*)(p + 33792); s.NabT = (LAS float*)(p + 38912); s.R2T = (LAS bf16_t*)(p + 38912); s.Nakb = (LAS bf16_t*)(p + 43520); s.MbrT = (LAS bf16_t*)(p + 46080);
    s.Tb = (LAS bf16_t*)(p + 48640); s.Ut = (LAS bf16_t*)(p + 51200); s.Wt = (LAS bf16_t*)(p + 53760); s.GC = (LAS float*)(p + 58880); return s;
}
struct WRaw { u32x2 rc, rp, kc, kp, e4, a4; };
__device__ __forceinline__ void w5_load(WRaw& w, const bf16_t* COLS, const bf16_t* LORA, int b, int chunk, int pj, int hc) {
    const int s_ = chunk * 32 + pj; const size_t t_ = (size_t)b * SEQ + s_; const bf16_t* cb_ = COLS + t_ * INC + hc; const u32x2 z = (u32x2){0u, 0u};
    w.rc = *(const u32x2*)(cb_ + C_R); w.kc = *(const u32x2*)(cb_ + C_K);
    if (s_ > 0) { w.rp = *(const u32x2*)(cb_ - INC + C_R); w.kp = *(const u32x2*)(cb_ - INC + C_K); } else { w.rp = z; w.kp = z; }
    w.e4 = *(const u32x2*)(LORA + t_ * 1536 + hc); w.a4 = *(const u32x2*)(LORA + t_ * 1536 + 512 + hc);
}
struct WConst { f32x4 mur, muk, kk4, ka4, rk4; };
__device__ __forceinline__ void w5_prep_scale(const WConst& cst, const WRaw& w, const WSet& S, float* BON, int b, int h, int chunk, int pj, int pq) {
    float r_[4], rq_[4], k_[4], kq_[4], e_[4], aa_[4], kkn_[4], k2_[4];
    const f32x4 mur = cst.mur, muk = cst.muk, kk4 = cst.kk4, ka4 = cst.ka4, rk4 = cst.rk4;
    unpack4(w.rc, r_); unpack4(w.rp, rq_); unpack4(w.kc, k_); unpack4(w.kp, kq_); unpack4(w.e4, e_); unpack4(w.a4, aa_);
    float ss_ = 0.f, bon_ = 0.f;
#pragma unroll
    for (int i = 0; i < 4; ++i) { r_[i] += (rq_[i] - r_[i]) * mur[i]; k_[i] += (kq_[i] - k_[i]) * muk[i];
        kkn_[i] = k_[i] * kk4[i]; ss_ += kkn_[i] * kkn_[i]; k2_[i] = k_[i] * (1.0f + (aa_[i] - 1.0f) * ka4[i]); bon_ += r_[i] * k2_[i] * rk4[i]; }
    ss_ = row16_sum(ss_); bon_ = row16_sum(bon_); const float inv_ = __builtin_amdgcn_rsqf(fmaxf(ss_, 1e-24f));
    if (pq == 0) BON[((size_t)b * SEQ + chunk * 32 + pj) * 8 + h] = bon_;
    const f32x4 cm = *(const LAS f32x4*)(S.CUM + pj * 64 + 4 * pq); float at_[4], bt_[4], kt_[4], rt_[4], g_[4];
#pragma unroll
    for (int i = 0; i < 4; ++i) { const float kn = kkn_[i] * inv_; const float g = __expf(-cm[i]), ig = __expf(cm[i]), gp = __expf(e_[i] - cm[i]); g_[i] = g;
        at_[i] = -kn * gp; bt_[i] = kn * aa_[i] * ig; kt_[i] = k2_[i] * ig; rt_[i] = r_[i] * g; }
    *(LAS u32x2*)(S.AT + pj * 72 + 4 * pq) = (u32x2){cvt_pk_bf16(at_[0], at_[1]), cvt_pk_bf16(at_[2], at_[3])};
    *(LAS u32x2*)(S.BT + pj * 72 + 4 * pq) = (u32x2){cvt_pk_bf16(bt_[0], bt_[1]), cvt_pk_bf16(bt_[2], bt_[3])};
    *(LAS u32x2*)(S.KT + pj * 72 + 4 * pq) = (u32x2){cvt_pk_bf16(kt_[0], kt_[1]), cvt_pk_bf16(kt_[2], kt_[3])};
    *(LAS u32x2*)(S.RT + pj * 72 + 4 * pq) = (u32x2){cvt_pk_bf16(rt_[0], rt_[1]), cvt_pk_bf16(rt_[2], rt_[3])};
#pragma unroll
    for (int i = 0; i < 4; ++i) { S.BTt[(4 * pq + i) * 40 + pj] = bf1(bt_[i]); S.ATt[(4 * pq + i) * 40 + pj] = bf1(at_[i]); }
    if (pj == 31) *(LAS f32x4*)(S.GC + 4 * pq) = (f32x4){g_[0], g_[1], g_[2], g_[3]};
}
__device__ __forceinline__ void w5_s1(const WSet& S, int tl, f32x16& accw, int lane) {
    f32x16 acc;
#pragma unroll
    for (int i = 0; i < 16; ++i) acc[i] = 0.f;
    const int t = lane & 31, hh = lane >> 5;
    if (tl == 1) {
        acc = mm32<4>(acc, S.AT, 72, S.KT, 72, lane);
#pragma unroll
        for (int g4 = 0; g4 < 4; ++g4) { const int t0 = 8 * g4 + 4 * hh; float o[4];
#pragma unroll
            for (int i = 0; i < 4; ++i) o[i] = (t < t0 + i) ? acc[4 * g4 + i] : 0.f;
            *(LAS u32x2*)(S.Nakb + t * 40 + t0) = (u32x2){cvt_pk_bf16(o[0], o[1]), cvt_pk_bf16(o[2], o[3])}; }
        return;
    }
    acc = mm32<4>(acc, (tl & 1) ? S.KT : S.BT, 72, (tl & 2) ? S.RT : S.AT, 72, lane);
    if (tl == 0) {
#pragma unroll
        for (int g4 = 0; g4 < 4; ++g4) { const int s0 = 8 * g4 + 4 * hh;
#pragma unroll
            for (int i = 0; i < 4; ++i) S.NabT[t * 36 + i * 8 + 2 * g4 + hh] = (s0 + i < t) ? acc[4 * g4 + i] : 0.f; }
    } else if (tl == 2) {
#pragma unroll
        for (int g4 = 0; g4 < 4; ++g4) { const int s0 = 8 * g4 + 4 * hh; float o[4];
#pragma unroll
            for (int i = 0; i < 4; ++i) o[i] = (s0 + i <= t) ? acc[4 * g4 + i] : 0.f;
            *(LAS u32x2*)(S.MbrT + t * 40 + s0) = (u32x2){cvt_pk_bf16(o[0], o[1]), cvt_pk_bf16(o[2], o[3])}; }
    } else {
#pragma unroll
        for (int i = 0; i < 16; ++i) { const int s = TROW(i, lane); accw[i] = (s <= t) ? acc[i] : 0.f; }
    }
}
__device__ __forceinline__ void w5_s2b(const WSet& S, int tl, int lane) {
    f32x16 acc;
#pragma unroll
    for (int i = 0; i < 16; ++i) acc[i] = 0.f;
    const int t = lane & 31, hh = lane >> 5;
    acc = mm32<2>(acc, S.Tb, 40, (tl == 0) ? S.MbrT : (S.BTt + 32 * (tl - 1) * 40), 40, lane);
    LAS bf16_t* o = (tl == 0) ? (S.Ut + t * 40) : (S.Wt + (32 * (tl - 1) + t) * 40);
#pragma unroll
    for (int g4 = 0; g4 < 4; ++g4) { const int s0 = 8 * g4 + 4 * hh;
        *(LAS u32x2*)(o + s0) = (u32x2){cvt_pk_bf16(acc[4 * g4], acc[4 * g4 + 1]), cvt_pk_bf16(acc[4 * g4 + 2], acc[4 * g4 + 3])}; }
}
__device__ __forceinline__ void w5_s3(const WSet& S, int role, f32x16& accw, int lane) {
    const int t = lane & 31, hh = lane >> 5; f32x16 acc;
#pragma unroll
    for (int i = 0; i < 16; ++i) acc[i] = 0.f;
    if (role == 0 || role == 1) {
        acc = mm32<2>(acc, S.Nakb, 40, S.Wt + 32 * role * 40, 40, lane); const int k = 32 * role + t; const float gc = S.GC[k];
#pragma unroll
        for (int g4 = 0; g4 < 4; ++g4) { const int s0 = 8 * g4 + 4 * hh; float o[4];
#pragma unroll
            for (int i = 0; i < 4; ++i) o[i] = (acc[4 * g4 + i] + __builtin_bit_cast(float, (unsigned)S.KT[(s0 + i) * 72 + k] << 16)) * gc;
            *(LAS u32x2*)(S.WzT + k * 40 + s0) = (u32x2){cvt_pk_bf16(o[0], o[1]), cvt_pk_bf16(o[2], o[3])}; }
    } else if (role == 2 || role == 6) {
        const int rh = (role == 6) ? 1 : 0; acc = mm32<2>(acc, S.ATt + 32 * rh * 40, 40, S.Ut, 40, lane);
#pragma unroll
        for (int g4 = 0; g4 < 4; ++g4) { const int k0 = 32 * rh + 8 * g4 + 4 * hh; float o[4]; const u32x2 rv = *(const LAS u32x2*)(S.RT + t * 72 + k0);
            o[0] = acc[4 * g4] + bflo(rv.x); o[1] = acc[4 * g4 + 1] + bfhi(rv.x); o[2] = acc[4 * g4 + 2] + bflo(rv.y); o[3] = acc[4 * g4 + 3] + bfhi(rv.y);
            *(LAS u32x2*)(S.R2T + t * 72 + k0) = (u32x2){cvt_pk_bf16(o[0], o[1]), cvt_pk_bf16(o[2], o[3])}; }
    } else {
        if (role == 3) { accw = mm32<2>(accw, S.Nakb, 40, S.Ut, 40, lane);
#pragma unroll
            for (int g4 = 0; g4 < 4; ++g4) { const int s0 = 8 * g4 + 4 * hh;
                *(LAS u32x2*)(S.WyT + t * 40 + s0) = (u32x2){cvt_pk_bf16(accw[4 * g4], accw[4 * g4 + 1]), cvt_pk_bf16(accw[4 * g4 + 2], accw[4 * g4 + 3])}; } }
        const int pt = (role == 3) ? 3 : (role == 7 ? 2 : role - 4);
        const int rh = pt >> 1, ch = pt & 1; acc = mm32<2>(acc, S.ATt + 32 * rh * 40, 40, S.Wt + 32 * ch * 40, 40, lane); const int kp = 32 * ch + t; const float gc = S.GC[kp];
#pragma unroll
        for (int g4 = 0; g4 < 4; ++g4) { const int k0 = 32 * rh + 8 * g4 + 4 * hh;
            *(LAS u32x2*)(S.PpT + kp * 72 + k0) = (u32x2){cvt_pk_bf16(acc[4 * g4] * gc, acc[4 * g4 + 1] * gc), cvt_pk_bf16(acc[4 * g4 + 2] * gc, acc[4 * g4 + 3] * gc)}; }
    }
}
__device__ __forceinline__ void w5_copyout(const WSet& S, unsigned char* gr, unsigned char* gp, int tid) {
    { const int row = tid >> 3, pc = tid & 7; *(u32x4*)(gp + row * 128 + pc * 16) = *(const LAS u32x4*)((const LAS unsigned char*)S.PpT + row * 144 + pc * 16); }
    if (tid < 256) { const int row = tid >> 3, pc = tid & 7; *(u32x4*)(gr + row * 128 + pc * 16) = *(const LAS u32x4*)((const LAS unsigned char*)S.R2T + row * 144 + pc * 16); }
    else { const int u = tid - 256, row = u >> 2, pc = u & 3; *(u32x4*)(gr + 4096 + row * 64 + pc * 16) = *(const LAS u32x4*)((const LAS unsigned char*)S.WzT + row * 80 + pc * 16); }
    if (tid < 128) { const int row = tid >> 2, pc = tid & 3; *(u32x4*)(gr + 8192 + row * 64 + pc * 16) = *(const LAS u32x4*)((const LAS unsigned char*)S.WyT + row * 80 + pc * 16); }
    else if (tid < 144) { const int pc = tid - 128; *(u32x4*)(gr + 10240 + pc * 16) = *(const LAS u32x4*)((const LAS unsigned char*)S.GC + pc * 16); }
}
__device__ __forceinline__ void wkv5a2(const Args& a, LAS unsigned char* lds, const int round) {
    const int tid = threadIdx.x, wave = __builtin_amdgcn_readfirstlane(tid >> 6);
    unsigned char* ws = a.ws;
    const bf16_t* COLS = (const bf16_t*)(ws + WS_A); const bf16_t* LORA = (const bf16_t*)a.out; float* BON = (float*)(ws + WS_BON);
    unsigned char* STG_R = ws + WS_RWKV; unsigned char* STG_P = (unsigned char*)a.out + 96 * MiB;
    const WSet SA = wset(lds), SB = wset(lds + WSET_BYTES);
    for (int item = blockIdx.x; item < 256; item += gridDim.x) {
        const int bh = item >> 1, sub = item & 1, b = bh >> 3, h = bh & 7;
        const int chunk0 = 32 * round + 16 * sub, chunk_end = chunk0 + 16;
        WRaw wa, wb; WConst cst;
        { const int hc0 = h * 64 + 4 * (tid & 15); cst.mur = *(const f32x4*)(a.in[I_MU] + C_R + hc0); cst.muk = *(const f32x4*)(a.in[I_MU] + C_K + hc0);
          cst.kk4 = *(const f32x4*)(a.in[I_KK] + hc0); cst.ka4 = *(const f32x4*)(a.in[I_KA] + hc0); cst.rk4 = *(const f32x4*)(a.in[I_RK] + hc0); }
        w5_load(wa, COLS, LORA, b, chunk0, tid >> 4, h * 64 + 4 * (tid & 15)); w5_load(wb, COLS, LORA, b, chunk0 + 1, tid >> 4, h * 64 + 4 * (tid & 15));
        __syncthreads();
        for (int chunk = chunk0; chunk < chunk_end; chunk += 2) {
            int tid_l = tid; asm volatile("" : "+v"(tid_l));
            const int lane = tid_l & 63, pj = tid_l >> 4, pq = tid_l & 15, tid = tid_l, hc = h * 64 + 4 * pq; (void)tid;
            { float e_[4]; unpack4(wa.e4, e_); *(LAS f32x4*)(SA.CUM + pj * 64 + 4 * pq) = (f32x4){e_[0], e_[1], e_[2], e_[3]};
              unpack4(wb.e4, e_); *(LAS f32x4*)(SB.CUM + pj * 64 + 4 * pq) = (f32x4){e_[0], e_[1], e_[2], e_[3]}; }
            __syncthreads();
            {
                const int col = tid & 63, qd = tid >> 6;
                float p0 = SA.CUM[(4 * qd) * 64 + col], p1 = SA.CUM[(4 * qd + 1) * 64 + col], p2 = SA.CUM[(4 * qd + 2) * 64 + col], p3 = SA.CUM[(4 * qd + 3) * 64 + col];
                float q0 = SB.CUM[(4 * qd) * 64 + col], q1 = SB.CUM[(4 * qd + 1) * 64 + col], q2 = SB.CUM[(4 * qd + 2) * 64 + col], q3 = SB.CUM[(4 * qd + 3) * 64 + col];
                p1 += p0; p2 += p1; p3 += p2; SA.PS[qd * 64 + col] = p3; q1 += q0; q2 += q1; q3 += q2; SB.PS[qd * 64 + col] = q3;
                __syncthreads();
                float ba = 0.f, bb = 0.f;
#pragma unroll
                for (int q2_ = 0; q2_ < 7; ++q2_) { ba += (q2_ < qd) ? SA.PS[q2_ * 64 + col] : 0.f; bb += (q2_ < qd) ? SB.PS[q2_ * 64 + col] : 0.f; }
                SA.CUM[(4 * qd) * 64 + col] = ba + p0; SA.CUM[(4 * qd + 1) * 64 + col] = ba + p1; SA.CUM[(4 * qd + 2) * 64 + col] = ba + p2; SA.CUM[(4 * qd + 3) * 64 + col] = ba + p3;
                SB.CUM[(4 * qd) * 64 + col] = bb + q0; SB.CUM[(4 * qd + 1) * 64 + col] = bb + q1; SB.CUM[(4 * qd + 2) * 64 + col] = bb + q2; SB.CUM[(4 * qd + 3) * 64 + col] = bb + q3; }
            __syncthreads();
            w5_prep_scale(cst, wa, SA, BON, b, h, chunk, pj, pq);
            w5_prep_scale(cst, wb, SB, BON, b, h, chunk + 1, pj, pq);
            if (chunk + 2 < chunk_end) { w5_load(wa, COLS, LORA, b, chunk + 2, pj, hc); w5_load(wb, COLS, LORA, b, chunk + 3, pj, hc); }
            __syncthreads();
            f32x16 accw;
#pragma unroll
            for (int i = 0; i < 16; ++i) accw[i] = 0.f;
            if (wave < 4) w5_s1(SA, wave, accw, lane); else w5_s1(SB, wave - 4, accw, lane);
            __syncthreads();
            if (wave < 4) {
                const WSet& S_ = (wave >= 2) ? SB : SA;
                const int q = lane & 3, rowi = ((wave & 1) * 64 + lane) >> 2;
                float xq0, xq1, xq2, xq3, xq4, xq5, xq6, xq7;
                xq0 = (0 + q == rowi) ? 1.0f : 0.0f;
                xq1 = (4 + q == rowi) ? 1.0f : 0.0f;
                xq2 = (8 + q == rowi) ? 1.0f : 0.0f;
                xq3 = (12 + q == rowi) ? 1.0f : 0.0f;
                xq4 = (16 + q == rowi) ? 1.0f : 0.0f;
                xq5 = (20 + q == rowi) ? 1.0f : 0.0f;
                xq6 = (24 + q == rowi) ? 1.0f : 0.0f;
                xq7 = (28 + q == rowi) ? 1.0f : 0.0f;
                const bool kq0 = q == 0, kq1 = q == 1, kq2 = q == 2, kq3 = q == 3;
                const LAS float* np_ = S_.NabT + q * 8;
                f32x4 n1_0, n2_0, n3_0, n4_0, n5_0, n6_0, n7_0, n8_0, n9_0, n10_0, n11_0, n12_0, n13_0, n14_0, n15_0, n16_0, n17_0, n17_1, n18_0, n18_1, n19_0, n19_1, n20_0, n20_1, n21_0, n21_1, n22_0, n22_1, n23_0, n23_1, n24_0, n24_1, n25_0, n25_1, n26_0, n26_1, n27_0, n27_1, n28_0, n28_1, n29_0, n29_1, n30_0, n30_1, n31_0, n31_1;
                float pe1, pe2, pe3, pe4, pe5, pe6, pe7, pe8, pe9, pe10, pe11, pe12, pe13, pe14, pe15, pe16, pe17, pe18, pe19, pe20, pe21, pe22, pe23, pe24, pe25, pe26, pe27, pe28, pe29, pe30, pe31, pe32;
                n1_0 = *(const LAS f32x4*)(np_ + 1 * 36); n2_0 = *(const LAS f32x4*)(np_ + 2 * 36); pe1 = 0.f;
                { n3_0 = *(const LAS f32x4*)(np_ + 3 * 36); float p = pe1; asm("v_fmac_f32 %0, %1, %2" : "+v"(p) : "v"(xq0), "v"(n1_0[0])); p += dpp_f(p, 0); pe2 = 0.f; p += dpp_f(p, 1); xq0 = kq1 ? (xq0 + p) : xq0; asm volatile("" : "+v"(xq0), "+v"(np_) : "v"(n1_0)); }
                { n4_0 = *(const LAS f32x4*)(np_ + 4 * 36); float p = pe2; asm("v_fmac_f32 %0, %1, %2" : "+v"(p) : "v"(xq0), "v"(n2_0[0])); p += dpp_f(p, 0); pe3 = 0.f; p += dpp_f(p, 1); xq0 = kq2 ? (xq0 + p) : xq0; asm volatile("" : "+v"(xq0), "+v"(np_) : "v"(n2_0)); }
                { n5_0 = *(const LAS f32x4*)(np_ + 5 * 36); float p = pe3; asm("v_fmac_f32 %0, %1, %2" : "+v"(p) : "v"(xq0), "v"(n3_0[0])); p += dpp_f(p, 0); pe4 = 0.f; p += dpp_f(p, 1); xq0 = kq3 ? (xq0 + p) : xq0; asm volatile("" : "+v"(xq0), "+v"(np_) : "v"(n3_0)); }
                { n6_0 = *(const LAS f32x4*)(np_ + 6 * 36); float p = pe4; asm("v_fmac_f32 %0, %1, %2" : "+v"(p) : "v"(xq0), "v"(n4_0[0])); p += dpp_f(p, 0); pe5 = 0.f; asm("v_fmac_f32 %0, %1, %2" : "+v"(pe5) : "v"(xq0), "v"(n5_0[0])); p += dpp_f(p, 1); xq1 = kq0 ? (xq1 + p) : xq1; asm volatile("" : "+v"(xq1), "+v"(np_) : "v"(n4_0)); }
                { n7_0 = *(const LAS f32x4*)(np_ + 7 * 36); float p = pe5; asm("v_fmac_f32 %0, %1, %2" : "+v"(p) : "v"(xq1), "v"(n5_0[1])); p += dpp_f(p, 0); pe6 = 0.f; asm("v_fmac_f32 %0, %1, %2" : "+v"(pe6) : "v"(xq0), "v"(n6_0[0])); p += dpp_f(p, 1); xq1 = kq1 ? (xq1 + p) : xq1; asm volatile("" : "+v"(xq1), "+v"(np_) : "v"(n5_0)); }
                { n8_0 = *(const LAS f32x4*)(np_ + 8 * 36); float p = pe6; asm("v_fmac_f32 %0, %1, %2" : "+v"(p) : "v"(xq1), "v"(n6_0[1])); p += dpp_f(p, 0); pe7 = 0.f; asm("v_fmac_f32 %0, %1, %2" : "+v"(pe7) : "v"(xq0), "v"(n7_0[0])); p += dpp_f(p, 1); xq1 = kq2 ? (xq1 + p) : xq1; asm volatile("" : "+v"(xq1), "+v"(np_) : "v"(n6_0)); }
                { n9_0 = *(const LAS f32x4*)(np_ + 9 * 36); float p = pe7; asm("v_fmac_f32 %0, %1, %2" : "+v"(p) : "v"(xq1), "v"(n7_0[1])); p += dpp_f(p, 0); pe8 = 0.f; asm("v_fmac_f32 %0, %1, %2" : "+v"(pe8) : "v"(xq0), "v"(n8_0[0])); p += dpp_f(p, 1); xq1 = kq3 ? (xq1 + p) : xq1; asm volatile("" : "+v"(xq1), "+v"(np_) : "v"(n7_0)); }
                { n10_0 = *(const LAS f32x4*)(np_ + 10 * 36); float p = pe8; asm("v_fmac_f32 %0, %1, %2" : "+v"(p) : "v"(xq1), "v"(n8_0[1])); p += dpp_f(p, 0); pe9 = 0.f; asm("v_fmac_f32 %0, %1, %2" : "+v"(pe9) : "v"(xq0), "v"(n9_0[0])); asm("v_fmac_f32 %0, %1, %2" : "+v"(pe9) : "v"(xq1), "v"(n9_0[1])); p += dpp_f(p, 1); xq2 = kq0 ? (xq2 + p) : xq2; asm volatile("" : "+v"(xq2), "+v"(np_) : "v"(n8_0)); }
                { n11_0 = *(const LAS f32x4*)(np_ + 11 * 36); float p = pe9; asm("v_fmac_f32 %0, %1, %2" : "+v"(p) : "v"(xq2), "v"(n9_0[2])); p += dpp_f(p, 0); pe10 = 0.f; asm("v_fmac_f32 %0, %1, %2" : "+v"(pe10) : "v"(xq0), "v"(n10_0[0])); asm("v_fmac_f32 %0, %1, %2" : "+v"(pe10) : "v"(xq1), "v"(n10_0[1])); p += dpp_f(p, 1); xq2 = kq1 ? (xq2 + p) : xq2; asm volatile("" : "+v"(xq2), "+v"(np_) : "v"(n9_0)); }
                { n12_0 = *(const LAS f32x4*)(np_ + 12 * 36); float p = pe10; asm("v_fmac_f32 %0, %1, %2" : "+v"(p) : "v"(xq2), "v"(n10_0[2])); p += dpp_f(p, 0); pe11 = 0.f; asm("v_fmac_f32 %0, %1, %2" : "+v"(pe11) : "v"(xq0), "v"(n11_0[0])); asm("v_fmac_f32 %0, %1, %2" : "+v"(pe11) : "v"(xq1), "v"(n11_0[1])); p += dpp_f(p, 1); xq2 = kq2 ? (xq2 + p) : xq2; asm volatile("" : "+v"(xq2), "+v"(np_) : "v"(n10_0)); }
                { n13_0 = *(const LAS f32x4*)(np_ + 13 * 36); float p = pe11; asm("v_fmac_f32 %0, %1, %2" : "+v"(p) : "v"(xq2), "v"(n11_0[2])); p += dpp_f(p, 0); pe12 = 0.f; asm("v_fmac_f32 %0, %1, %2" : "+v"(pe12) : "v"(xq0), "v"(n12_0[0])); asm("v_fmac_f32 %0, %1, %2" : "+v"(pe12) : "v"(xq1), "v"(n12_0[1])); p += dpp_f(p, 1); xq2 = kq3 ? (xq2 + p) : xq2; asm volatile("" : "+v"(xq2), "+v"(np_) : "v"(n11_0)); }
                { n14_0 = *(const LAS f32x4*)(np_ + 14 * 36); float p = pe12; asm("v_fmac_f32 %0, %1, %2" : "+v"(p) : "v"(xq2), "v"(n12_0[2])); p += dpp_f(p, 0); pe13 = 0.f; asm("v_fmac_f32 %0, %1, %2" : "+v"(pe13) : "v"(xq0), "v"(n13_0[0])); asm("v_fmac_f32 %0, %1, %2" : "+v"(pe13) : "v"(xq1), "v"(n13_0[1])); asm("v_fmac_f32 %0, %1, %2" : "+v"(pe13) : "v"(xq2), "v"(n13_0[2])); p += dpp_f(p, 1); xq3 = kq0 ? (xq3 + p) : xq3; asm volatile("" : "+v"(xq3), "+v"(np_) : "v"(n12_0)); }
                { n15_0 = *(const LAS f32x4*)(np_ + 15 * 36); float p = pe13; asm("v_fmac_f32 %0, %1, %2" : "+v"(p) : "v"(xq3), "v"(n13_0[3])); p += dpp_f(p, 0); pe14 = 0.f; asm("v_fmac_f32 %0, %1, %2" : "+v"(pe14) : "v"(xq0), "v"(n14_0[0])); asm("v_fmac_f32 %0, %1, %2" : "+v"(pe14) : "v"(xq1), "v"(n14_0[1])); asm("v_fmac_f32 %0, %1, %2" : "+v"(pe14) : "v"(xq2), "v"(n14_0[2])); p += dpp_f(p, 1); xq3 = kq1 ? (xq3 + p) : xq3; asm volatile("" : "+v"(xq3), "+v"(np_) : "v"(n13_0)); }
                { n16_0 = *(const LAS f32x4*)(np_ + 16 * 36); float p = pe14; asm("v_fmac_f32 %0, %1, %2" : "+v"(p) : "v"(xq3), "v"(n14_0[3])); p += dpp_f(p, 0); pe15 = 0.f; asm("v_fmac_f32 %0, %1, %2" : "+v"(pe15) : "v"(xq0), "v"(n15_0[0])); asm("v_fmac_f32 %0, %1, %2" : "+v"(pe15) : "v"(xq1), "v"(n15_0[1])); asm("v_fmac_f32 %0, %1, %2" : "+v"(pe15) : "v"(xq2), "v"(n15_0[2])); p += dpp_f(p, 1); xq3 = kq2 ? (xq3 + p) : xq3; asm volatile("" : "+v"(xq3), "+v"(np_) : "v"(n14_0)); }
                { n17_0 = *(const LAS f32x4*)(np_ + 17 * 36); n17_1 = *(const LAS f32x4*)(np_ + 17 * 36 + 4); float p = pe15; asm("v_fmac_f32 %0, %1, %2" : "+v"(p) : "v"(xq3), "v"(n15_0[3])); p += dpp_f(p, 0); pe16 = 0.f; asm("v_fmac_f32 %0, %1, %2" : "+v"(pe16) : "v"(xq0), "v"(n16_0[0])); asm("v_fmac_f32 %0, %1, %2" : "+v"(pe16) : "v"(xq1), "v"(n16_0[1])); asm("v_fmac_f32 %0, %1, %2" : "+v"(pe16) : "v"(xq2), "v"(n16_0[2])); p += dpp_f(p, 1); xq3 = kq3 ? (xq3 + p) : xq3; asm volatile("" : "+v"(xq3), "+v"(np_) : "v"(n15_0)); }
                { n18_0 = *(const LAS f32x4*)(np_ + 18 * 36); n18_1 = *(const LAS f32x4*)(np_ + 18 * 36 + 4); float p = pe16; asm("v_fmac_f32 %0, %1, %2" : "+v"(p) : "v"(xq3), "v"(n16_0[3])); p += dpp_f(p, 0); pe17 = 0.f; asm("v_fmac_f32 %0, %1, %2" : "+v"(pe17) : "v"(xq0), "v"(n17_0[0])); asm("v_fmac_f32 %0, %1, %2" : "+v"(pe17) : "v"(xq1), "v"(n17_0[1])); asm("v_fmac_f32 %0, %1, %2" : "+v"(pe17) : "v"(xq2), "v"(n17_0[2])); asm("v_fmac_f32 %0, %1, %2" : "+v"(pe17) : "v"(xq3), "v"(n17_0[3])); p += dpp_f(p, 1); xq4 = kq0 ? (xq4 + p) : xq4; asm volatile("" : "+v"(xq4), "+v"(np_) : "v"(n16_0)); }
                { n19_0 = *(const LAS f32x4*)(np_ + 19 * 36); n19_1 = *(const LAS f32x4*)(np_ + 19 * 36 + 4); float p = pe17; asm("v_fmac_f32 %0, %1, %2" : "+v"(p) : "v"(xq4), "v"(n17_1[0])); p += dpp_f(p, 0); pe18 = 0.f; asm("v_fmac_f32 %0, %1, %2" : "+v"(pe18) : "v"(xq0), "v"(n18_0[0])); asm("v_fmac_f32 %0, %1, %2" : "+v"(pe18) : "v"(xq1), "v"(n18_0[1])); asm("v_fmac_f32 %0, %1, %2" : "+v"(pe18) : "v"(xq2), "v"(n18_0[2])); asm("v_fmac_f32 %0, %1, %2" : "+v"(pe18) : "v"(xq3), "v"(n18_0[3])); p += dpp_f(p, 1); xq4 = kq1 ? (xq4 + p) : xq4; asm volatile("" : "+v"(xq4), "+v"(np_) : "v"(n17_0), "v"(n17_1)); }
                { n20_0 = *(const LAS f32x4*)(np_ + 20 * 36); n20_1 = *(const LAS f32x4*)(np_ + 20 * 36 + 4); float p = pe18; asm("v_fmac_f32 %0, %1, %2" : "+v"(p) : "v"(xq4), "v"(n18_1[0])); p += dpp_f(p, 0); pe19 = 0.f; asm("v_fmac_f32 %0, %1, %2" : "+v"(pe19) : "v"(xq0), "v"(n19_0[0])); asm("v_fmac_f32 %0, %1, %2" : "+v"(pe19) : "v"(xq1), "v"(n19_0[1])); asm("v_fmac_f32 %0, %1, %2" : "+v"(pe19) : "v"(xq2), "v"(n19_0[2])); asm("v_fmac_f32 %0, %1, %2" : "+v"(pe19) : "v"(xq3), "v"(n19_0[3])); p += dpp_f(p, 1); xq4 = kq2 ? (xq4 + p) : xq4; asm volatile("" : "+v"(xq4), "+v"(np_) : "v"(n18_0), "v"(n18_1)); }
                { n21_0 = *(const LAS f32x4*)(np_ + 21 * 36); n21_1 = *(const LAS f32x4*)(np_ + 21 * 36 + 4); float p = pe19; asm("v_fmac_f32 %0, %1, %2" : "+v"(p) : "v"(xq4), "v"(n19_1[0])); p += dpp_f(p, 0); pe20 = 0.f; asm("v_fmac_f32 %0, %1, %2" : "+v"(pe20) : "v"(xq0), "v"(n20_0[0])); asm("v_fmac_f32 %0, %1, %2" : "+v"(pe20) : "v"(xq1), "v"(n20_0[1])); asm("v_fmac_f32 %0, %1, %2" : "+v"(pe20) : "v"(xq2), "v"(n20_0[2])); asm("v_fmac_f32 %0, %1, %2" : "+v"(pe20) : "v"(xq3), "v"(n20_0[3])); p += dpp_f(p, 1); xq4 = kq3 ? (xq4 + p) : xq4; asm volatile("" : "+v"(xq4), "+v"(np_) : "v"(n19_0), "v"(n19_1)); }
                { n22_0 = *(const LAS f32x4*)(np_ + 22 * 36); n22_1 = *(const LAS f32x4*)(np_ + 22 * 36 + 4); float p = pe20; asm("v_fmac_f32 %0, %1, %2" : "+v"(p) : "v"(xq4), "v"(n20_1[0])); p += dpp_f(p, 0); pe21 = 0.f; asm("v_fmac_f32 %0, %1, %2" : "+v"(pe21) : "v"(xq0), "v"(n21_0[0])); asm("v_fmac_f32 %0, %1, %2" : "+v"(pe21) : "v"(xq1), "v"(n21_0[1])); asm("v_fmac_f32 %0, %1, %2" : "+v"(pe21) : "v"(xq2), "v"(n21_0[2])); asm("v_fmac_f32 %0, %1, %2" : "+v"(pe21) : "v"(xq3), "v"(n21_0[3])); asm("v_fmac_f32 %0, %1, %2" : "+v"(pe21) : "v"(xq4), "v"(n21_1[0])); p += dpp_f(p, 1); xq5 = kq0 ? (xq5 + p) : xq5; asm volatile("" : "+v"(xq5), "+v"(np_) : "v"(n20_0), "v"(n20_1)); }
                { n23_0 = *(const LAS f32x4*)(np_ + 23 * 36); n23_1 = *(const LAS f32x4*)(np_ + 23 * 36 + 4); float p = pe21; asm("v_fmac_f32 %0, %1, %2" : "+v"(p) : "v"(xq5), "v"(n21_1[1])); p += dpp_f(p, 0); pe22 = 0.f; asm("v_fmac_f32 %0, %1, %2" : "+v"(pe22) : "v"(xq0), "v"(n22_0[0])); asm("v_fmac_f32 %0, %1, %2" : "+v"(pe22) : "v"(xq1), "v"(n22_0[1])); asm("v_fmac_f32 %0, %1, %2" : "+v"(pe22) : "v"(xq2), "v"(n22_0[2])); asm("v_fmac_f32 %0, %1, %2" : "+v"(pe22) : "v"(xq3), "v"(n22_0[3])); asm("v_fmac_f32 %0, %1, %2" : "+v"(pe22) : "v"(xq4), "v"(n22_1[0])); p += dpp_f(p, 1); xq5 = kq1 ? (xq5 + p) : xq5; asm volatile("" : "+v"(xq5), "+v"(np_) : "v"(n21_0), "v"(n21_1)); }
                { n24_0 = *(const LAS f32x4*)(np_ + 24 * 36); n24_1 = *(const LAS f32x4*)(np_ + 24 * 36 + 4); float p = pe22; asm("v_fmac_f32 %0, %1, %2" : "+v"(p) : "v"(xq5), "v"(n22_1[1])); p += dpp_f(p, 0); pe23 = 0.f; asm("v_fmac_f32 %0, %1, %2" : "+v"(pe23) : "v"(xq0), "v"(n23_0[0])); asm("v_fmac_f32 %0, %1, %2" : "+v"(pe23) : "v"(xq1), "v"(n23_0[1])); asm("v_fmac_f32 %0, %1, %2" : "+v"(pe23) : "v"(xq2), "v"(n23_0[2])); asm("v_fmac_f32 %0, %1, %2" : "+v"(pe23) : "v"(xq3), "v"(n23_0[3])); asm("v_fmac_f32 %0, %1, %2" : "+v"(pe23) : "v"(xq4), "v"(n23_1[0])); p += dpp_f(p, 1); xq5 = kq2 ? (xq5 + p) : xq5; asm volatile("" : "+v"(xq5), "+v"(np_) : "v"(n22_0), "v"(n22_1)); }
                { n25_0 = *(const LAS f32x4*)(np_ + 25 * 36); n25_1 = *(const LAS f32x4*)(np_ + 25 * 36 + 4); float p = pe23; asm("v_fmac_f32 %0, %1, %2" : "+v"(p) : "v"(xq5), "v"(n23_1[1])); p += dpp_f(p, 0); pe24 = 0.f; asm("v_fmac_f32 %0, %1, %2" : "+v"(pe24) : "v"(xq0), "v"(n24_0[0])); asm("v_fmac_f32 %0, %1, %2" : "+v"(pe24) : "v"(xq1), "v"(n24_0[1])); asm("v_fmac_f32 %0, %1, %2" : "+v"(pe24) : "v"(xq2), "v"(n24_0[2])); asm("v_fmac_f32 %0, %1, %2" : "+v"(pe24) : "v"(xq3), "v"(n24_0[3])); asm("v_fmac_f32 %0, %1, %2" : "+v"(pe24) : "v"(xq4), "v"(n24_1[0])); p += dpp_f(p, 1); xq5 = kq3 ? (xq5 + p) : xq5; asm volatile("" : "+v"(xq5), "+v"(np_) : "v"(n23_0), "v"(n23_1)); }
                { n26_0 = *(const LAS f32x4*)(np_ + 26 * 36); n26_1 = *(const LAS f32x4*)(np_ + 26 * 36 + 4); float p = pe24; asm("v_fmac_f32 %0, %1, %2" : "+v"(p) : "v"(xq5), "v"(n24_1[1])); p += dpp_f(p, 0); pe25 = 0.f; asm("v_fmac_f32 %0, %1, %2" : "+v"(pe25) : "v"(xq0), "v"(n25_0[0])); asm("v_fmac_f32 %0, %1, %2" : "+v"(pe25) : "v"(xq1), "v"(n25_0[1])); asm("v_fmac_f32 %0, %1, %2" : "+v"(pe25) : "v"(xq2), "v"(n25_0[2])); asm("v_fmac_f32 %0, %1, %2" : "+v"(pe25) : "v"(xq3), "v"(n25_0[3])); asm("v_fmac_f32 %0, %1, %2" : "+v"(pe25) : "v"(xq4), "v"(n25_1[0])); asm("v_fmac_f32 %0, %1, %2" : "+v"(pe25) : "v"(xq5), "v"(n25_1[1])); p += dpp_f(p, 1); xq6 = kq0 ? (xq6 + p) : xq6; asm volatile("" : "+v"(xq6), "+v"(np_) : "v"(n24_0), "v"(n24_1)); }
                { n27_0 = *(const LAS f32x4*)(np_ + 27 * 36); n27_1 = *(const LAS f32x4*)(np_ + 27 * 36 + 4); float p = pe25; asm("v_fmac_f32 %0, %1, %2" : "+v"(p) : "v"(xq6), "v"(n25_1[2])); p += dpp_f(p, 0); pe26 = 0.f; asm("v_fmac_f32 %0, %1, %2" : "+v"(pe26) : "v"(xq0), "v"(n26_0[0])); asm("v_fmac_f32 %0, %1, %2" : "+v"(pe26) : "v"(xq1), "v"(n26_0[1])); asm("v_fmac_f32 %0, %1, %2" : "+v"(pe26) : "v"(xq2), "v"(n26_0[2])); asm("v_fmac_f32 %0, %1, %2" : "+v"(pe26) : "v"(xq3), "v"(n26_0[3])); asm("v_fmac_f32 %0, %1, %2" : "+v"(pe26) : "v"(xq4), "v"(n26_1[0])); asm("v_fmac_f32 %0, %1, %2" : "+v"(pe26) : "v"(xq5), "v"(n26_1[1])); p += dpp_f(p, 1); xq6 = kq1 ? (xq6 + p) : xq6; asm volatile("" : "+v"(xq6), "+v"(np_) : "v"(n25_0), "v"(n25_1)); }
                { n28_0 = *(const LAS f32x4*)(np_ + 28 * 36); n28_1 = *(const LAS f32x4*)(np_ + 28 * 36 + 4); float p = pe26; asm("v_fmac_f32 %0, %1, %2" : "+v"(p) : "v"(xq6), "v"(n26_1[2])); p += dpp_f(p, 0); pe27 = 0.f; asm("v_fmac_f32 %0, %1, %2" : "+v"(pe27) : "v"(xq0), "v"(n27_0[0])); asm("v_fmac_f32 %0, %1, %2" : "+v"(pe27) : "v"(xq1), "v"(n27_0[1])); asm("v_fmac_f32 %0, %1, %2" : "+v"(pe27) : "v"(xq2), "v"(n27_0[2])); asm("v_fmac_f32 %0, %1, %2" : "+v"(pe27) : "v"(xq3), "v"(n27_0[3])); asm("v_fmac_f32 %0, %1, %2" : "+v"(pe27) : "v"(xq4), "v"(n27_1[0])); asm("v_fmac_f32 %0, %1, %2" : "+v"(pe27) : "v"(xq5), "v"(n27_1[1])); p += dpp_f(p, 1); xq6 = kq2 ? (xq6 + p) : xq6; asm volatile("" : "+v"(xq6), "+v"(np_) : "v"(n26_0), "v"(n26_1)); }
                { n29_0 = *(const LAS f32x4*)(np_ + 29 * 36); n29_1 = *(const LAS f32x4*)(np_ + 29 * 36 + 4); float p = pe27; asm("v_fmac_f32 %0, %1, %2" : "+v"(p) : "v"(xq6), "v"(n27_1[2])); p += dpp_f(p, 0); pe28 = 0.f; asm("v_fmac_f32 %0, %1, %2" : "+v"(pe28) : "v"(xq0), "v"(n28_0[0])); asm("v_fmac_f32 %0, %1, %2" : "+v"(pe28) : "v"(xq1), "v"(n28_0[1])); asm("v_fmac_f32 %0, %1, %2" : "+v"(pe28) : "v"(xq2), "v"(n28_0[2])); asm("v_fmac_f32 %0, %1, %2" : "+v"(pe28) : "v"(xq3), "v"(n28_0[3])); asm("v_fmac_f32 %0, %1, %2" : "+v"(pe28) : "v"(xq4), "v"(n28_1[0])); asm("v_fmac_f32 %0, %1, %2" : "+v"(pe28) : "v"(xq5), "v"(n28_1[1])); p += dpp_f(p, 1); xq6 = kq3 ? (xq6 + p) : xq6; asm volatile("" : "+v"(xq6), "+v"(np_) : "v"(n27_0), "v"(n27_1)); }
                { n30_0 = *(const LAS f32x4*)(np_ + 30 * 36); n30_1 = *(const LAS f32x4*)(np_ + 30 * 36 + 4); float p = pe28; asm("v_fmac_f32 %0, %1, %2" : "+v"(p) : "v"(xq6), "v"(n28_1[2])); p += dpp_f(p, 0); pe29 = 0.f; asm("v_fmac_f32 %0, %1, %2" : "+v"(pe29) : "v"(xq0), "v"(n29_0[0])); asm("v_fmac_f32 %0, %1, %2" : "+v"(pe29) : "v"(xq1), "v"(n29_0[1])); asm("v_fmac_f32 %0, %1, %2" : "+v"(pe29) : "v"(xq2), "v"(n29_0[2])); asm("v_fmac_f32 %0, %1, %2" : "+v"(pe29) : "v"(xq3), "v"(n29_0[3])); asm("v_fmac_f32 %0, %1, %2" : "+v"(pe29) : "v"(xq4), "v"(n29_1[0])); asm("v_fmac_f32 %0, %1, %2" : "+v"(pe29) : "v"(xq5), "v"(n29_1[1])); asm("v_fmac_f32 %0, %1, %2" : "+v"(pe29) : "v"(xq6), "v"(n29_1[2])); p += dpp_f(p, 1); xq7 = kq0 ? (xq7 + p) : xq7; asm volatile("" : "+v"(xq7), "+v"(np_) : "v"(n28_0), "v"(n28_1)); }
                { n31_0 = *(const LAS f32x4*)(np_ + 31 * 36); n31_1 = *(const LAS f32x4*)(np_ + 31 * 36 + 4); float p = pe29; asm("v_fmac_f32 %0, %1, %2" : "+v"(p) : "v"(xq7), "v"(n29_1[3])); p += dpp_f(p, 0); pe30 = 0.f; asm("v_fmac_f32 %0, %1, %2" : "+v"(pe30) : "v"(xq0), "v"(n30_0[0])); asm("v_fmac_f32 %0, %1, %2" : "+v"(pe30) : "v"(xq1), "v"(n30_0[1])); asm("v_fmac_f32 %0, %1, %2" : "+v"(pe30) : "v"(xq2), "v"(n30_0[2])); asm("v_fmac_f32 %0, %1, %2" : "+v"(pe30) : "v"(xq3), "v"(n30_0[3])); asm("v_fmac_f32 %0, %1, %2" : "+v"(pe30) : "v"(xq4), "v"(n30_1[0])); asm("v_fmac_f32 %0, %1, %2" : "+v"(pe30) : "v"(xq5), "v"(n30_1[1])); asm("v_fmac_f32 %0, %1, %2" : "+v"(pe30) : "v"(xq6), "v"(n30_1[2])); p += dpp_f(p, 1); xq7 = kq1 ? (xq7 + p) : xq7; asm volatile("" : "+v"(xq7), "+v"(np_) : "v"(n29_0), "v"(n29_1)); }
                { float p = pe30; asm("v_fmac_f32 %0, %1, %2" : "+v"(p) : "v"(xq7), "v"(n30_1[3])); p += dpp_f(p, 0); pe31 = 0.f; asm("v_fmac_f32 %0, %1, %2" : "+v"(pe31) : "v"(xq0), "v"(n31_0[0])); asm("v_fmac_f32 %0, %1, %2" : "+v"(pe31) : "v"(xq1), "v"(n31_0[1])); asm("v_fmac_f32 %0, %1, %2" : "+v"(pe31) : "v"(xq2), "v"(n31_0[2])); asm("v_fmac_f32 %0, %1, %2" : "+v"(pe31) : "v"(xq3), "v"(n31_0[3])); asm("v_fmac_f32 %0, %1, %2" : "+v"(pe31) : "v"(xq4), "v"(n31_1[0])); asm("v_fmac_f32 %0, %1, %2" : "+v"(pe31) : "v"(xq5), "v"(n31_1[1])); asm("v_fmac_f32 %0, %1, %2" : "+v"(pe31) : "v"(xq6), "v"(n31_1[2])); p += dpp_f(p, 1); xq7 = kq2 ? (xq7 + p) : xq7; asm volatile("" : "+v"(xq7), "+v"(np_) : "v"(n30_0), "v"(n30_1)); }
                { float p = pe31; asm("v_fmac_f32 %0, %1, %2" : "+v"(p) : "v"(xq7), "v"(n31_1[3])); p += dpp_f(p, 0); p += dpp_f(p, 1); xq7 = kq3 ? (xq7 + p) : xq7; asm volatile("" : "+v"(xq7), "+v"(np_) : "v"(n31_0), "v"(n31_1)); }
                LAS bf16_t* dst = S_.Tb + rowi * 40 + q;
                dst[0] = bf1(xq0);
                dst[4] = bf1(xq1);
                dst[8] = bf1(xq2);
                dst[12] = bf1(xq3);
                dst[16] = bf1(xq4);
                dst[20] = bf1(xq5);
                dst[24] = bf1(xq6);
                dst[28] = bf1(xq7);
            }
            __syncthreads();
            if (wave < 6) { if (wave < 3) w5_s2b(SA, wave, lane); else w5_s2b(SB, wave - 3, lane); }
            __syncthreads();
            w5_s3(SA, wave, accw, lane);
            w5_s3(SB, (wave + 4) & 7, accw, lane);
            __syncthreads();
            { const size_t idx = (size_t)bh * 32 + (chunk & 31);
              w5_copyout(SA, STG_R + idx * STG_R_STRIDE, STG_P + idx * 8192, tid);
              w5_copyout(SB, STG_R + (idx + 1) * STG_R_STRIDE, STG_P + (idx + 1) * 8192, tid); }
            __syncthreads();
        }
    }
}
__device__ __forceinline__ void wkv5b(const Args& a, LAS unsigned char* lds, const int round) {
    const int tid = threadIdx.x, lane = tid & 63, wave = __builtin_amdgcn_readfirstlane(tid >> 6);
    unsigned char* ws = a.ws;
    const bf16_t* COLS = (const bf16_t*)(ws + WS_A); float* Y = (float*)(ws + WS_B);
    const unsigned char* STG_R = ws + WS_RWKV; const unsigned char* STG_P = (const unsigned char*)a.out + 96 * MiB;
    constexpr int SET = 24576;
    LAS bf16_t* SBF = (LAS bf16_t*)(lds + 118272);
    LAS float* YST = (LAS float*)(lds + 127488);
    LAS float* SSAVE = (LAS float*)(lds + 135936);
    for (int item = blockIdx.x; item < 256; item += gridDim.x) {
        const int bh = item >> 1, half = item & 1, b = bh >> 3, h = bh & 7;
        const int pj = tid >> 4, pq = tid & 15;
        f32x16 Sacc;
#pragma unroll
        for (int i = 0; i < 16; ++i) Sacc[i] = 0.f;
        __syncthreads();
        if (round == 0) { for (int i = tid; i < 2 * 32 * 72 / 2; i += 512) ((LAS unsigned*)SBF)[i] = 0u; }
        else if (wave < 2) {
#pragma unroll
            for (int i = 0; i < 16; ++i) Sacc[i] = SSAVE[(wave * 16 + i) * 64 + lane]; }
        const f32x2 muv = *(const f32x2*)(a.in[I_MU] + C_V + h * 64 + 32 * half + 2 * pq);
        u32x4 gP, gA, gB; unsigned vcur, vprv;
#define W5_LOAD(chunk) do { const size_t idx_ = (size_t)bh * 32 + ((chunk) & 31); const unsigned char* gr_ = STG_R + idx_ * STG_R_STRIDE; const unsigned char* gp_ = STG_P + idx_ * 8192; \
            gP = *(const u32x4*)(gp_ + (tid >> 3) * 128 + (tid & 7) * 16); \
            gA = (tid < 256) ? *(const u32x4*)(gr_ + (tid >> 3) * 128 + (tid & 7) * 16) : *(const u32x4*)(gr_ + 4096 + ((tid - 256) >> 2) * 64 + ((tid - 256) & 3) * 16); \
            gB = (tid < 144) ? *(const u32x4*)(gr_ + 8192 + tid * 16) : (u32x4){0u, 0u, 0u, 0u}; \
            { const int s_ = (chunk) * 32 + pj; const bf16_t* cb_ = COLS + ((size_t)b * SEQ + s_) * INC + C_V + h * 64 + 32 * half + 2 * pq; vcur = *(const unsigned*)cb_; vprv = (s_ > 0) ? *(const unsigned*)(cb_ - INC) : 0u; } } while (0)
#define W5_STORE(setb) do { LAS unsigned char* sb_ = lds + 10240 + (setb) * SET; \
            *(LAS u32x4*)(sb_ + 12288 + (tid >> 3) * 144 + (tid & 7) * 16) = gP; \
            if (tid < 256) *(LAS u32x4*)(sb_ + 7680 + (tid >> 3) * 144 + (tid & 7) * 16) = gA; \
            else *(LAS u32x4*)(sb_ + 2560 + ((tid - 256) >> 2) * 80 + ((tid - 256) & 3) * 16) = gA; \
            if (tid < 128) *(LAS u32x4*)(sb_ + (tid >> 2) * 80 + (tid & 3) * 16) = gB; \
            else if (tid < 144) *(LAS u32x4*)(sb_ + 21504 + (tid - 128) * 16) = gB; \
            { const float c0_ = bflo(vcur), c1_ = bfhi(vcur), p0_ = bflo(vprv), p1_ = bfhi(vprv); LAS bf16_t* vm_ = (LAS bf16_t*)(sb_ + 21760); \
                vm_[(2 * pq) * 40 + pj] = bf1(c0_ + (p0_ - c0_) * muv[0]); vm_[(2 * pq + 1) * 40 + pj] = bf1(c1_ + (p1_ - c1_) * muv[1]); } } while (0)
        const int chunk0 = 32 * round;
        W5_LOAD(chunk0); W5_STORE(chunk0 & 1);
        __syncthreads();
        for (int chunk = chunk0; chunk < chunk0 + 32; ++chunk) {
            const int bi = chunk & 1;
            if (chunk + 1 < chunk0 + 32) W5_LOAD(chunk + 1);
            { LAS unsigned char* sb = lds + 10240 + bi * SET;
              LAS bf16_t* WyT = (LAS bf16_t*)sb; LAS bf16_t* WzT = (LAS bf16_t*)(sb + 2560); LAS bf16_t* R2T = (LAS bf16_t*)(sb + 7680); LAS bf16_t* PpT = (LAS bf16_t*)(sb + 12288);
              LAS float* GC = (LAS float*)(sb + 21504); LAS bf16_t* VmT = (LAS bf16_t*)(sb + 21760); LAS float* YSTc = YST + bi * (32 * 33);
            if (wave < 3) {
                const int t = lane & 31; const LAS bf16_t* Sb = SBF + bi * (32 * 72); f32x16 acc;
#pragma unroll
                for (int i = 0; i < 16; ++i) acc[i] = 0.f;
                if (wave < 2) {
                    acc = mm32<2>(acc, VmT, 40, WzT + 32 * wave * 40, 40, lane);
                    acc = mm32<4>(acc, Sb, 72, PpT + 32 * wave * 72, 72, lane);
                    const float gc = GC[32 * wave + t]; LAS bf16_t* Sn = SBF + (bi ^ 1) * (32 * 72);
#pragma unroll
                    for (int i = 0; i < 16; ++i) { Sacc[i] = fmaf(Sacc[i], gc, acc[i]); Sn[TROW(i, lane) * 72 + 32 * wave + t] = bf1(Sacc[i]); }
                } else {
                    acc = mm32<2>(acc, VmT, 40, WyT, 40, lane);
                    acc = mm32<4>(acc, Sb, 72, R2T, 72, lane);
#pragma unroll
                    for (int i = 0; i < 16; ++i) YSTc[t * 33 + TROW(i, lane)] = acc[i];
                }
            }
            }
            if (chunk + 1 < chunk0 + 32) W5_STORE(bi ^ 1);
            __syncthreads();
            { const LAS float* ys = YST + bi * (32 * 33) + pj * 33 + 2 * pq;
                *(f32x2*)(Y + ((size_t)b * SEQ + chunk * 32 + pj) * 512 + h * 64 + 32 * half + 2 * pq) = (f32x2){ys[0], ys[1]}; }
        }
        if (wave < 2) {
#pragma unroll
            for (int i = 0; i < 16; ++i) SSAVE[(wave * 16 + i) * 64 + lane] = Sacc[i]; }
#undef W5_LOAD
#undef W5_STORE
    }
}
__device__ __forceinline__ void wkv5b2(const Args& a, LAS unsigned char* lds, const int round) {
    const int tid = threadIdx.x, lane = tid & 63, wave = __builtin_amdgcn_readfirstlane(tid >> 6);
    unsigned char* ws = a.ws;
    const bf16_t* COLS = (const bf16_t*)(ws + WS_A); float* Y = (float*)(ws + WS_B); float* SSV = (float*)(ws + WS_S5O);
    const unsigned char* STG_R = ws + WS_RWKV; const unsigned char* STG_P = (const unsigned char*)a.out + 96 * MiB;
    constexpr int SET = 26880;
    LAS bf16_t* SBF = (LAS bf16_t*)(lds + 53760);
    LAS float* YST = (LAS float*)(lds + 72192);
    for (int item = blockIdx.x; item < 128; item += gridDim.x) {
        const int bh = item, b = bh >> 3, h = bh & 7;
        const int pj = tid >> 4, pq = tid & 15;
        const int half = (wave >> 1) & 1, kh = wave & 1;
        f32x16 Sacc;
#pragma unroll
        for (int i = 0; i < 16; ++i) Sacc[i] = 0.f;
        __syncthreads();
        if (round == 0) { for (int i = tid; i < 64 * 72 / 2; i += 512) ((LAS unsigned*)SBF)[i] = 0u; }
        else if (wave < 4) { const int t = lane & 31;
#pragma unroll
            for (int i = 0; i < 16; ++i) { Sacc[i] = SSV[(((size_t)bh * 4 + wave) * 16 + i) * 64 + lane]; SBF[(32 * half + TROW(i, lane)) * 72 + 32 * kh + t] = bf1(Sacc[i]); } }
        const f32x4 muv = *(const f32x4*)(a.in[I_MU] + C_V + h * 64 + 4 * pq);
        u32x4 gPA, gAA, gBA, gPB, gAB, gBB; u32x2 vcA, vpA, vcB, vpB;
#define W5_LOAD(R, chunk) do { const size_t idx_ = (size_t)bh * 32 + ((chunk) & 31); const unsigned char* gr_ = STG_R + idx_ * STG_R_STRIDE; const unsigned char* gp_ = STG_P + idx_ * 8192; \
            gP##R = *(const u32x4*)(gp_ + (tid >> 3) * 128 + (tid & 7) * 16); \
            gA##R = (tid < 256) ? *(const u32x4*)(gr_ + (tid >> 3) * 128 + (tid & 7) * 16) : *(const u32x4*)(gr_ + 4096 + ((tid - 256) >> 2) * 64 + ((tid - 256) & 3) * 16); \
            gB##R = (tid < 144) ? *(const u32x4*)(gr_ + 8192 + tid * 16) : (u32x4){0u, 0u, 0u, 0u}; \
            { const int s_ = (chunk) * 32 + pj; const bf16_t* cb_ = COLS + ((size_t)b * SEQ + s_) * INC + C_V + h * 64 + 4 * pq; vc##R = *(const u32x2*)cb_; vp##R = (s_ > 0) ? *(const u32x2*)(cb_ - INC) : (u32x2){0u, 0u}; } } while (0)
#define W5_STORE(R, setb) do { LAS unsigned char* sb_ = lds + (setb) * SET; \
            *(LAS u32x4*)(sb_ + 12288 + (tid >> 3) * 144 + (tid & 7) * 16) = gP##R; \
            if (tid < 256) *(LAS u32x4*)(sb_ + 7680 + (tid >> 3) * 144 + (tid & 7) * 16) = gA##R; \
            else *(LAS u32x4*)(sb_ + 2560 + ((tid - 256) >> 2) * 80 + ((tid - 256) & 3) * 16) = gA##R; \
            if (tid < 128) *(LAS u32x4*)(sb_ + (tid >> 2) * 80 + (tid & 3) * 16) = gB##R; \
            else if (tid < 144) *(LAS u32x4*)(sb_ + 21504 + (tid - 128) * 16) = gB##R; \
            { float c_[4], p_[4]; unpack4(vc##R, c_); unpack4(vp##R, p_); LAS bf16_t* vm_ = (LAS bf16_t*)(sb_ + 21760); \
              _Pragma("unroll") for (int i_ = 0; i_ < 4; ++i_) vm_[(4 * pq + i_) * 40 + pj] = bf1(c_[i_] + (p_[i_] - c_[i_]) * muv[i_]); } } while (0)
#define W5_STEP(chunk, RL, RS) do { const int bi = (chunk) & 1; \
            if ((chunk) + 2 < cend) W5_LOAD(RL, (chunk) + 2); \
            { LAS unsigned char* sb = lds + bi * SET; \
              LAS bf16_t* WyT = (LAS bf16_t*)sb; LAS bf16_t* WzT = (LAS bf16_t*)(sb + 2560); LAS bf16_t* R2T = (LAS bf16_t*)(sb + 7680); LAS bf16_t* PpT = (LAS bf16_t*)(sb + 12288); \
              LAS float* GC = (LAS float*)(sb + 21504); LAS bf16_t* VmT = (LAS bf16_t*)(sb + 21760); \
              if (wave < 6) { const int t = lane & 31; f32x16 acc; \
                _Pragma("unroll") for (int i = 0; i < 16; ++i) acc[i] = 0.f; \
                if (wave < 4) { const LAS bf16_t* Sb = SBF + bi * (64 * 72) + 32 * half * 72; \
                    acc = mm32<2>(acc, VmT + 32 * half * 40, 40, WzT + 32 * kh * 40, 40, lane); \
                    acc = mm32<4>(acc, Sb, 72, PpT + 32 * kh * 72, 72, lane); \
                    const float gc = GC[32 * kh + t]; LAS bf16_t* Sn = SBF + (bi ^ 1) * (64 * 72) + 32 * half * 72; \
                    _Pragma("unroll") for (int i = 0; i < 16; ++i) { Sacc[i] = fmaf(Sacc[i], gc, acc[i]); Sn[TROW(i, lane) * 72 + 32 * kh + t] = bf1(Sacc[i]); } \
                } else { const int yh = wave - 4; const LAS bf16_t* Sb = SBF + bi * (64 * 72) + 32 * yh * 72; LAS float* YSTc = YST + (bi * 2 + yh) * (32 * 33); \
                    acc = mm32<2>(acc, VmT + 32 * yh * 40, 40, WyT, 40, lane); \
                    acc = mm32<4>(acc, Sb, 72, R2T, 72, lane); \
                    _Pragma("unroll") for (int i = 0; i < 16; ++i) YSTc[t * 33 + TROW(i, lane)] = acc[i]; \
                } } } \
            if ((chunk) + 1 < cend) W5_STORE(RS, bi ^ 1); \
            __syncthreads(); \
            { const LAS float* ys = YST + (bi * 2 + (pq >> 3)) * (32 * 33) + pj * 33 + 4 * (pq & 7); \
                *(f32x4*)(Y + ((size_t)b * SEQ + (chunk) * 32 + pj) * 512 + h * 64 + 4 * pq) = (f32x4){ys[0], ys[1], ys[2], ys[3]}; } } while (0)
        const int chunk0 = 32 * round, cend = chunk0 + 32;
        W5_LOAD(A, chunk0); W5_LOAD(B, chunk0 + 1); W5_STORE(A, 0);
        __syncthreads();
        for (int chunk = chunk0; chunk < cend; chunk += 2) { W5_STEP(chunk, A, B); W5_STEP(chunk + 1, B, A); }
        if (wave < 4) {
#pragma unroll
            for (int i = 0; i < 16; ++i) SSV[(((size_t)bh * 4 + wave) * 16 + i) * 64 + lane] = Sacc[i]; }
#undef W5_LOAD
#undef W5_STORE
#undef W5_STEP
    }
}
__device__ __forceinline__ void wkv5b3(const Args& a, LAS unsigned char* lds, const int round) {
    const int tid = threadIdx.x, lane = tid & 63, wave = __builtin_amdgcn_readfirstlane(tid >> 6);
    unsigned char* ws = a.ws;
    const bf16_t* COLS = (const bf16_t*)(ws + WS_A); float* Y = (float*)(ws + WS_B); float* SSV = (float*)(ws + WS_S5O);
    const unsigned char* STG_R = ws + WS_RWKV; const unsigned char* STG_P = (const unsigned char*)a.out + 96 * MiB;
    constexpr int SET = 26880;
    LAS bf16_t* SBF = (LAS bf16_t*)(lds + 53760);
    for (int item = blockIdx.x; item < 128; item += gridDim.x) {
        const int bh = item, b = bh >> 3, h = bh & 7;
        const int t = lane & 31, hh = lane >> 5;
        const int half = (wave >> 1) & 1, kh = wave & 1;
        const int chunk0 = 32 * round, cend = chunk0 + 32;
        __syncthreads();
        if (wave >= 6) {
            const int u = tid - 384, pj = u >> 2, cq = u & 3;
            f32x4 mv0, mv1, mv2, mv3;
            { const float* mp = a.in[I_MU] + C_V + h * 64 + 16 * cq; mv0 = *(const f32x4*)mp; mv1 = *(const f32x4*)(mp + 4); mv2 = *(const f32x4*)(mp + 8); mv3 = *(const f32x4*)(mp + 12); }
            u32x4 p0A, p1A, p2A, p3A, r0A, r1A, z0A, z1A, y0A, gcA, c0A, c1A, q0A, q1A;
            u32x4 p0B, p1B, p2B, p3B, r0B, r1B, z0B, z1B, y0B, gcB, c0B, c1B, q0B, q1B;
#define W5_LOAD(R, chunk) do { const size_t idx_ = (size_t)bh * 32 + ((chunk) & 31); const unsigned char* gr_ = STG_R + idx_ * STG_R_STRIDE; const unsigned char* gp_ = STG_P + idx_ * 8192; \
                p0##R = *(const u32x4*)(gp_ + u * 16); p1##R = *(const u32x4*)(gp_ + 2048 + u * 16); p2##R = *(const u32x4*)(gp_ + 4096 + u * 16); p3##R = *(const u32x4*)(gp_ + 6144 + u * 16); \
                r0##R = *(const u32x4*)(gr_ + u * 16); r1##R = *(const u32x4*)(gr_ + 2048 + u * 16); z0##R = *(const u32x4*)(gr_ + 4096 + u * 16); z1##R = *(const u32x4*)(gr_ + 6144 + u * 16); \
                y0##R = *(const u32x4*)(gr_ + 8192 + u * 16); gc##R = (u < 16) ? *(const u32x4*)(gr_ + 10240 + u * 16) : (u32x4){0u, 0u, 0u, 0u}; \
                { const int s_ = (chunk) * 32 + pj; const bf16_t* cb_ = COLS + ((size_t)b * SEQ + s_) * INC + C_V + h * 64 + 16 * cq; c0##R = *(const u32x4*)cb_; c1##R = *(const u32x4*)(cb_ + 8); \
                  if (s_ > 0) { q0##R = *(const u32x4*)(cb_ - INC); q1##R = *(const u32x4*)(cb_ - INC + 8); } else { q0##R = (u32x4){0u, 0u, 0u, 0u}; q1##R = (u32x4){0u, 0u, 0u, 0u}; } } } while (0)
#define W5_PIECE8(base, p_) ((base) + ((p_) >> 3) * 144 + ((p_) & 7) * 16)
#define W5_PIECE4(base, p_) ((base) + ((p_) >> 2) * 80 + ((p_) & 3) * 16)
#define W5_VM(cv, qv, mv, off) do { float c_[8], q_[8]; unpack8(cv, c_); unpack8(qv, q_); \
                _Pragma("unroll") for (int i_ = 0; i_ < 8; ++i_) vm_[(16 * cq + (off) + i_) * 40 + pj] = bf1(c_[i_] + (q_[i_] - c_[i_]) * ((i_ < 4) ? mv##0[i_ & 3] : mv##1[i_ & 3])); } while (0)
#define W5_STORE(R, setb) do { LAS unsigned char* sb_ = lds + (setb) * SET; \
                *(LAS u32x4*)W5_PIECE8(sb_ + 12288, u) = p0##R; *(LAS u32x4*)W5_PIECE8(sb_ + 12288, u + 128) = p1##R; *(LAS u32x4*)W5_PIECE8(sb_ + 12288, u + 256) = p2##R; *(LAS u32x4*)W5_PIECE8(sb_ + 12288, u + 384) = p3##R; \
                *(LAS u32x4*)W5_PIECE8(sb_ + 7680, u) = r0##R; *(LAS u32x4*)W5_PIECE8(sb_ + 7680, u + 128) = r1##R; \
                *(LAS u32x4*)W5_PIECE4(sb_ + 2560, u) = z0##R; *(LAS u32x4*)W5_PIECE4(sb_ + 2560, u + 128) = z1##R; \
                *(LAS u32x4*)W5_PIECE4(sb_, u) = y0##R; if (u < 16) *(LAS u32x4*)(sb_ + 21504 + u * 16) = gc##R; \
                { LAS bf16_t* vm_ = (LAS bf16_t*)(sb_ + 21760); \
                  { float c_[8], q_[8]; unpack8(c0##R, c_); unpack8(q0##R, q_); \
                    _Pragma("unroll") for (int i_ = 0; i_ < 8; ++i_) vm_[(16 * cq + i_) * 40 + pj] = bf1(c_[i_] + (q_[i_] - c_[i_]) * ((i_ < 4) ? mv0[i_ & 3] : mv1[i_ & 3])); } \
                  { float c_[8], q_[8]; unpack8(c1##R, c_); unpack8(q1##R, q_); \
                    _Pragma("unroll") for (int i_ = 0; i_ < 8; ++i_) vm_[(16 * cq + 8 + i_) * 40 + pj] = bf1(c_[i_] + (q_[i_] - c_[i_]) * ((i_ < 4) ? mv2[i_ & 3] : mv3[i_ & 3])); } } } while (0)
            W5_LOAD(A, chunk0); W5_LOAD(B, chunk0 + 1); W5_STORE(A, 0);
            __syncthreads();
            for (int chunk = chunk0; chunk < cend; chunk += 2) {
                if (chunk + 2 < cend) W5_LOAD(A, chunk + 2);
                W5_STORE(B, 1);
                __syncthreads();
                if (chunk + 3 < cend) W5_LOAD(B, chunk + 3);
                if (chunk + 2 < cend) W5_STORE(A, 0);
                __syncthreads();
            }
#undef W5_LOAD
#undef W5_STORE
#undef W5_VM
#undef W5_PIECE8
#undef W5_PIECE4
        } else {
            f32x16 Sacc;
#pragma unroll
            for (int i = 0; i < 16; ++i) Sacc[i] = 0.f;
            if (wave < 4) {
                if (round != 0) {
#pragma unroll
                    for (int i = 0; i < 16; ++i) Sacc[i] = SSV[(((size_t)bh * 4 + wave) * 16 + i) * 64 + lane]; }
                LAS bf16_t* Sn = SBF + (32 * half + t) * 72 + 32 * kh;
#pragma unroll
                for (int g4 = 0; g4 < 4; ++g4) *(LAS u32x2*)(Sn + 8 * g4 + 4 * hh) = (u32x2){cvt_pk_bf16(Sacc[4 * g4], Sacc[4 * g4 + 1]), cvt_pk_bf16(Sacc[4 * g4 + 2], Sacc[4 * g4 + 3])};
            }
            __syncthreads();
            for (int chunk = chunk0; chunk < cend; ++chunk) {
                const int bi = chunk & 1; LAS unsigned char* sb = lds + bi * SET;
                LAS bf16_t* WyT = (LAS bf16_t*)sb; LAS bf16_t* WzT = (LAS bf16_t*)(sb + 2560); LAS bf16_t* R2T = (LAS bf16_t*)(sb + 7680); LAS bf16_t* PpT = (LAS bf16_t*)(sb + 12288);
                LAS float* GC = (LAS float*)(sb + 21504); LAS bf16_t* VmT = (LAS bf16_t*)(sb + 21760);
                f32x16 acc;
#pragma unroll
                for (int i = 0; i < 16; ++i) acc[i] = 0.f;
                if (wave < 4) {
                    const LAS bf16_t* Sb = SBF + bi * (64 * 72) + 32 * half * 72;
                    acc = mm32<2>(acc, WzT + 32 * kh * 40, 40, VmT + 32 * half * 40, 40, lane);
                    acc = mm32<4>(acc, PpT + 32 * kh * 72, 72, Sb, 72, lane);
                    LAS bf16_t* Sn = SBF + (bi ^ 1) * (64 * 72) + (32 * half + t) * 72 + 32 * kh;
#pragma unroll
                    for (int g4 = 0; g4 < 4; ++g4) { const int k0 = 8 * g4 + 4 * hh; const f32x4 gc4 = *(const LAS f32x4*)(GC + 32 * kh + k0);
#pragma unroll
                        for (int i = 0; i < 4; ++i) Sacc[4 * g4 + i] = fmaf(Sacc[4 * g4 + i], gc4[i], acc[4 * g4 + i]);
                        *(LAS u32x2*)(Sn + k0) = (u32x2){cvt_pk_bf16(Sacc[4 * g4], Sacc[4 * g4 + 1]), cvt_pk_bf16(Sacc[4 * g4 + 2], Sacc[4 * g4 + 3])}; }
                } else {
                    const int yh = wave - 4; const LAS bf16_t* Sb = SBF + bi * (64 * 72) + 32 * yh * 72;
                    acc = mm32<2>(acc, WyT, 40, VmT + 32 * yh * 40, 40, lane);
                    acc = mm32<4>(acc, R2T, 72, Sb, 72, lane);
                    float* yp = Y + ((size_t)b * SEQ + chunk * 32) * 512 + h * 64 + 32 * yh + t;
#pragma unroll
                    for (int i = 0; i < 16; ++i) yp[(size_t)TROW(i, lane) * 512] = acc[i];
                }
                __syncthreads();
            }
            if (wave < 4) {
#pragma unroll
                for (int i = 0; i < 16; ++i) SSV[(((size_t)bh * 4 + wave) * 16 + i) * 64 + lane] = Sacc[i]; }
        }
    }
}
__device__ __forceinline__ unsigned w5_img_src(int o) {
    if (o < 2560) { const int r = o / 80, c = o - r * 80; return (c < 64) ? (unsigned)(8192 + r * 64 + c) : 0u; }
    if (o < 7680) { const int o2 = o - 2560, r = o2 / 80, c = o2 - r * 80; return (c < 64) ? (unsigned)(4096 + r * 64 + c) : 0u; }
    if (o < 12288) { const int o2 = o - 7680, r = o2 / 144, c = o2 - r * 144; return (c < 128) ? (unsigned)(r * 128 + c) : 0u; }
    if (o < 21504) { const int o2 = o - 12288, r = o2 / 144, c = o2 - r * 144; return (c < 128) ? (unsigned)(r * 128 + c) : 0u; }
    return (unsigned)(10240 + (o - 21504));
}
__device__ __forceinline__ void wkv5b4(const Args& a, LAS unsigned char* lds, const int round) {
    const int tid = threadIdx.x, lane = tid & 63, wave = __builtin_amdgcn_readfirstlane(tid >> 6);
    unsigned char* ws = a.ws;
    const bf16_t* COLS = (const bf16_t*)(ws + WS_A); float* Y = (float*)(ws + WS_B); float* SSV = (float*)(ws + WS_S5O);
    const unsigned char* STG_R = ws + WS_RWKV; const unsigned char* STG_P = (const unsigned char*)a.out + 96 * MiB;
    constexpr int SETB = 31104;
    LAS bf16_t* SBF = (LAS bf16_t*)(lds + 4 * SETB);
#define W5_BAR() do { asm volatile("s_waitcnt lgkmcnt(0)" ::: "memory"); __builtin_amdgcn_s_barrier(); asm volatile("" ::: "memory"); } while (0)
    for (int item = blockIdx.x; item < 128; item += gridDim.x) {
        const int bh = item, b = bh >> 3, h = bh & 7;
        const int t = lane & 31, hh = lane >> 5;
        const int half = (wave >> 1) & 1, kh = wave & 1;
        const int chunk0 = 32 * round;
        __syncthreads();
        if (wave >= 6) {
            const int u = tid - 384, pj = u >> 2, cq = u & 3;
            const int j0 = (wave == 6) ? 0 : 9, nb = (wave == 6) ? 9 : 13;
            unsigned goff[13];
#pragma unroll
            for (int j = 0; j < 13; ++j) goff[j] = w5_img_src((j0 + j) * 1024 + lane * 16);
            f32x4 mv0, mv1, mv2, mv3;
            { const float* mp = a.in[I_MU] + C_V + h * 64 + 16 * cq; mv0 = *(const f32x4*)mp; mv1 = *(const f32x4*)(mp + 4); mv2 = *(const f32x4*)(mp + 8); mv3 = *(const f32x4*)(mp + 12); }
#define W5_ISSUE(i_) do { const int c_ = chunk0 + (i_); const size_t idx_ = (size_t)bh * 32 + (c_ & 31); const unsigned char* gr_ = STG_R + idx_ * STG_R_STRIDE; const unsigned char* gp_ = STG_P + idx_ * 8192; \
                LAS unsigned char* sb_ = lds + ((i_) & 3) * SETB; \
                if (wave == 6) { const unsigned char* vb_ = (const unsigned char*)(COLS + ((size_t)b * SEQ + (size_t)c_ * 32) * INC + C_V + h * 64) - (size_t)INC * 2; \
                    _Pragma("unroll") for (int j = 0; j < 5; ++j) { const int p_ = j * 64 + lane; \
                        if (p_ < 264) __builtin_amdgcn_global_load_lds((const unsigned*)(vb_ + (size_t)(p_ >> 3) * (INC * 2) + (p_ & 7) * 16), (LAS unsigned*)(sb_ + 26880 + j * 1024), 16, 0, 0); } } \
                _Pragma("unroll") for (int j = 0; j < 13; ++j) { if (j < nb) { const int jj = j0 + j; const unsigned char* base_ = (jj >= 12 && jj < 21) ? gp_ : gr_; \
                    if (jj < 21 || lane < 16) __builtin_amdgcn_global_load_lds((const unsigned*)(base_ + goff[j]), (LAS unsigned*)(sb_ + jj * 1024), 16, 0, 0); } } } while (0)
#define W5_CONV(i_) do { const int c_ = chunk0 + (i_); LAS unsigned char* sb_ = lds + ((i_) & 3) * SETB; const LAS unsigned char* rw_ = sb_ + 26880 + pj * 128 + cq * 32; LAS bf16_t* vm_ = (LAS bf16_t*)(sb_ + 21760); \
                u32x4 q0_ = *(const LAS u32x4*)rw_, q1_ = *(const LAS u32x4*)(rw_ + 16); const u32x4 c0_ = *(const LAS u32x4*)(rw_ + 128), c1_ = *(const LAS u32x4*)(rw_ + 144); \
                if (c_ * 32 + pj == 0) { q0_ = (u32x4){0u, 0u, 0u, 0u}; q1_ = q0_; } \
                { float c8_[8], q8_[8]; unpack8(c0_, c8_); unpack8(q0_, q8_); \
                  _Pragma("unroll") for (int e_ = 0; e_ < 8; ++e_) vm_[(16 * cq + e_) * 40 + pj] = bf1(c8_[e_] + (q8_[e_] - c8_[e_]) * ((e_ < 4) ? mv0[e_ & 3] : mv1[e_ & 3])); } \
                { float c8_[8], q8_[8]; unpack8(c1_, c8_); unpack8(q1_, q8_); \
                  _Pragma("unroll") for (int e_ = 0; e_ < 8; ++e_) vm_[(16 * cq + 8 + e_) * 40 + pj] = bf1(c8_[e_] + (q8_[e_] - c8_[e_]) * ((e_ < 4) ? mv2[e_ & 3] : mv3[e_ & 3])); } } while (0)
            W5_ISSUE(0); W5_ISSUE(1); W5_ISSUE(2);
            if (wave == 6) asm volatile("s_waitcnt vmcnt(37)" ::: "memory");
            W5_BAR();
            W5_CONV(0);
            if (wave == 6) asm volatile("s_waitcnt vmcnt(23)" ::: "memory"); else asm volatile("s_waitcnt vmcnt(26)" ::: "memory");
            W5_BAR();
            for (int i = 0; i < 32; ++i) {
                if (i + 3 < 32) W5_ISSUE(i + 3);
                if (i + 1 < 32) W5_CONV(i + 1);
                if (i + 3 < 32) { if (wave == 6) asm volatile("s_waitcnt vmcnt(23)" ::: "memory"); else asm volatile("s_waitcnt vmcnt(26)" ::: "memory"); }
                else asm volatile("s_waitcnt vmcnt(0)" ::: "memory");
                W5_BAR();
            }
#undef W5_ISSUE
#undef W5_CONV
        } else {
            f32x16 Sacc;
#pragma unroll
            for (int i = 0; i < 16; ++i) Sacc[i] = 0.f;
            if (wave < 4) {
                if (round != 0) {
#pragma unroll
                    for (int i = 0; i < 16; ++i) Sacc[i] = SSV[(((size_t)bh * 4 + wave) * 16 + i) * 64 + lane]; }
                LAS bf16_t* Sn = SBF + (32 * half + t) * 72 + 32 * kh;
#pragma unroll
                for (int g4 = 0; g4 < 4; ++g4) *(LAS u32x2*)(Sn + 8 * g4 + 4 * hh) = (u32x2){cvt_pk_bf16(Sacc[4 * g4], Sacc[4 * g4 + 1]), cvt_pk_bf16(Sacc[4 * g4 + 2], Sacc[4 * g4 + 3])};
            }
            W5_BAR();
            W5_BAR();
            for (int i = 0; i < 32; ++i) {
                const int chunk = chunk0 + i, bi = i & 1; LAS unsigned char* sb = lds + (i & 3) * SETB;
                LAS bf16_t* WyT = (LAS bf16_t*)sb; LAS bf16_t* WzT = (LAS bf16_t*)(sb + 2560); LAS bf16_t* R2T = (LAS bf16_t*)(sb + 7680); LAS bf16_t* PpT = (LAS bf16_t*)(sb + 12288);
                LAS float* GC = (LAS float*)(sb + 21504); LAS bf16_t* VmT = (LAS bf16_t*)(sb + 21760);
                f32x16 acc;
#pragma unroll
                for (int k = 0; k < 16; ++k) acc[k] = 0.f;
                if (wave < 4) {
                    const LAS bf16_t* Sb = SBF + bi * (64 * 72) + 32 * half * 72;
                    acc = mm32<2>(acc, WzT + 32 * kh * 40, 40, VmT + 32 * half * 40, 40, lane);
                    acc = mm32<4>(acc, PpT + 32 * kh * 72, 72, Sb, 72, lane);
                    LAS bf16_t* Sn = SBF + (bi ^ 1) * (64 * 72) + (32 * half + t) * 72 + 32 * kh;
#pragma unroll
                    for (int g4 = 0; g4 < 4; ++g4) { const int k0 = 8 * g4 + 4 * hh; const f32x4 gc4 = *(const LAS f32x4*)(GC + 32 * kh + k0);
#pragma unroll
                        for (int k = 0; k < 4; ++k) Sacc[4 * g4 + k] = fmaf(Sacc[4 * g4 + k], gc4[k], acc[4 * g4 + k]);
                        *(LAS u32x2*)(Sn + k0) = (u32x2){cvt_pk_bf16(Sacc[4 * g4], Sacc[4 * g4 + 1]), cvt_pk_bf16(Sacc[4 * g4 + 2], Sacc[4 * g4 + 3])}; }
                } else {
                    const int yh = wave - 4; const LAS bf16_t* Sb = SBF + bi * (64 * 72) + 32 * yh * 72;
                    acc = mm32<2>(acc, WyT, 40, VmT + 32 * yh * 40, 40, lane);
                    acc = mm32<4>(acc, R2T, 72, Sb, 72, lane);
                    float* yp = Y + ((size_t)b * SEQ + chunk * 32) * 512 + h * 64 + 32 * yh + t;
#pragma unroll
                    for (int k = 0; k < 16; ++k) yp[(size_t)TROW(k, lane) * 512] = acc[k];
                }
                W5_BAR();
            }
            if (wave < 4) {
#pragma unroll
                for (int i = 0; i < 16; ++i) SSV[(((size_t)bh * 4 + wave) * 16 + i) * 64 + lane] = Sacc[i]; }
        }
    }
#undef W5_BAR
}
__device__ __forceinline__ void phase4s(const Args& a, LAS unsigned char* lds, const XcdBarrier& bar) {
    const int tid = threadIdx.x;
    unsigned char* ws = a.ws;
    for (int item = blockIdx.x; item < 256; item += gridDim.x) {
        if (tid < 64) {
            const int b = item >> 4, g = item & 15, n = tid;
            const f32x2 lamL = ((const f32x2*)(ws + WS_LAML))[g * 64 + n];
            const float* E = (const float*)(ws + WS_E) + ((size_t)g * S5ROWS + b * S5NCH) * 128;
            bf16_t* UG = (bf16_t*)(ws + WS_UG) + ((size_t)g * S5ROWS + b * S5NCH) * S5K + 512;
            float xr = 0.f, xi = 0.f;
#pragma unroll 8
            for (int ch = 0; ch < S5NCH; ++ch) {
                UG[(size_t)ch * S5K + n] = (bf16_t)f2bf(xr); UG[(size_t)ch * S5K + 64 + n] = (bf16_t)f2bf(xi);
                const float er = E[ch * 128 + n], ei = E[ch * 128 + 64 + n];
                const float nr = lamL[0] * xr - lamL[1] * xi + er, ni = lamL[0] * xi + lamL[1] * xr + ei; xr = nr; xi = ni;
            }
        }
    }
    if (gridDim.x != 256) { late_items_idle(a, lds, 0, N_LATE, 0); __syncthreads(); }
    wkv5a2(a, lds, 0); xcd_barrier(bar);
    wkv5b4(a, lds, 0); xcd_barrier(bar);
    wkv5a2(a, lds, 1); xcd_barrier(bar);
    wkv5b4(a, lds, 1);
}

__device__ __forceinline__ void phase5_post(const Args& a) {
    const int gt = blockIdx.x * 512 + threadIdx.x, NT = gridDim.x * 512;
    unsigned char* ws = a.ws;
    const bf16_t* COLS = (const bf16_t*)(ws + WS_A); const bf16_t* LORA = (const bf16_t*)a.out; const float* Y = (const float*)(ws + WS_B); const float* BON = (const float*)(ws + WS_BON);
    bf16_t* RO = (bf16_t*)(ws + WS_RWKV);
    const int hq = gt & 127, h = hq >> 4, q = hq & 15, hc = h * 64 + 4 * q;
    float lg[4], lb[4], muv[4];
#pragma unroll
    for (int i = 0; i < 4; ++i) { lg[i] = a.in[I_LNG][hc + i]; lb[i] = a.in[I_LNB][hc + i]; muv[i] = a.in[I_MU][C_V + hc + i]; }
    for (int p = gt; p < T * 128; p += NT) {
        const int t = p >> 7;
        const f32x4 y4 = *(const f32x4*)(Y + (size_t)t * 512 + hc);
        float s = (y4[0] + y4[1]) + (y4[2] + y4[3]); s = row16_sum(s); const float mean = s * (1.0f / 64.0f);
        const float d0 = y4[0] - mean, d1 = y4[1] - mean, d2 = y4[2] - mean, d3 = y4[3] - mean;
        float qv = (d0 * d0 + d1 * d1) + (d2 * d2 + d3 * d3); qv = row16_sum(qv); const float rstd = 1.0f / sqrtf(qv * (1.0f / 64.0f) + 64e-5f);
        float vc[4], vp[4], g4[4]; unpack4(*(const u32x2*)(COLS + (size_t)t * INC + C_V + hc), vc);
        if ((t & (SEQ - 1)) != 0) unpack4(*(const u32x2*)(COLS + (size_t)(t - 1) * INC + C_V + hc), vp); else { vp[0] = vp[1] = vp[2] = vp[3] = 0.f; }
        unpack4(*(const u32x2*)(LORA + (size_t)t * 1536 + 1024 + hc), g4);
        const float bon = BON[(size_t)t * 8 + h];
        const float dd[4] = {d0, d1, d2, d3}; float o[4];
#pragma unroll
        for (int i = 0; i < 4; ++i) { const float v = vc[i] + (vp[i] - vc[i]) * muv[i]; o[i] = (dd[i] * rstd * lg[i] + lb[i] + bon * v) * g4[i]; }
        u32x2 w; w.x = cvt_pk_bf16(o[0], o[1]); w.y = cvt_pk_bf16(o[2], o[3]); *(u32x2*)(RO + (size_t)t * 512 + hc) = w;
    }
}

__device__ __forceinline__ void phase9(const Args& a, LAS unsigned char* lds) {
    const int tid = threadIdx.x, lane = tid & 63, wave = tid >> 6;
    unsigned char* ws = a.ws;
    const bf16_t* X1 = (const bf16_t*)a.out; const bf16_t* WR = (const bf16_t*)(ws + WS_WR);
    int4* ROUTE = (int4*)(ws + WS_ROUTE); int* BC = (int*)(ws + WS_BC);
    LAS float* LG = (LAS float*)lds + wave * (16 * 49);
    LAS int* cnt = (LAS int*)(lds + 32768);
    for (int vb = blockIdx.x; vb < 256; vb += gridDim.x) {
        __syncthreads();
        if (tid < 32) cnt[tid] = 0;
        __syncthreads();
        const int t0 = vb * 128 + wave * 16;
        const int ar = lane & 15, aq = lane >> 4;
        f32x4 acc0 = (f32x4){0.f, 0.f, 0.f, 0.f}, acc1 = acc0, acc2 = acc0; float ssq = 0.f;
        const bf16_t* xrow = X1 + (size_t)(t0 + ar) * DM + 8 * aq;
        const bf16_t* wrow = WR + (size_t)ar * DM + 8 * aq;
#pragma unroll 4
        for (int kb = 0; kb < 32; ++kb) {
            const u32x4 af = *(const u32x4*)(xrow + kb * 32); float xf[8]; unpack8(af, xf);
            ssq += (xf[0] * xf[0] + xf[1] * xf[1]) + (xf[2] * xf[2] + xf[3] * xf[3]) + (xf[4] * xf[4] + xf[5] * xf[5]) + (xf[6] * xf[6] + xf[7] * xf[7]);
            const bf16x8 A = __builtin_bit_cast(bf16x8, af);
            const bf16x8 B0 = *(const bf16x8*)(wrow + kb * 32), B1 = *(const bf16x8*)(wrow + 16 * DM + kb * 32), B2 = *(const bf16x8*)(wrow + 32 * DM + kb * 32);
            acc0 = __builtin_amdgcn_mfma_f32_16x16x32_bf16(A, B0, acc0, 0, 0, 0);
            acc1 = __builtin_amdgcn_mfma_f32_16x16x32_bf16(A, B1, acc1, 0, 0, 0);
            acc2 = __builtin_amdgcn_mfma_f32_16x16x32_bf16(A, B2, acc2, 0, 0, 0);
        }
        ssq += __shfl_xor(ssq, 16); ssq += __shfl_xor(ssq, 32);
        const float rs = 1.0f / sqrtf(ssq * (1.0f / DM) + 1e-6f);
#pragma unroll
        for (int r = 0; r < 4; ++r) { const int row = aq * 4 + r; LG[row * 49 + ar] = acc0[r]; LG[row * 49 + 16 + ar] = acc1[r]; LG[row * 49 + 32 + ar] = acc2[r]; }
        LDS_WAIT();
        if (lane < 16) {
            const int t = t0 + lane; const LAS float* lg = LG + lane * 49;
            float gl[4]; float mx = -3.0e38f; int gi = 0;
#pragma unroll
            for (int j = 0; j < 4; ++j) { gl[j] = lg[j] * rs + a.in[I_RGB][j]; if (gl[j] > mx) { mx = gl[j]; gi = j; } }
            float den = 0.f;
#pragma unroll
            for (int j = 0; j < 4; ++j) den += __expf(gl[j] - mx);
            const float gp = 1.0f / den;
            float b1 = -3.0e38f, b2 = -3.0e38f; int i1 = 0, i2 = 0;
            for (int j = 0; j < 8; ++j) { const float v = lg[4 + gi * 8 + j] * rs + a.in[I_REB][gi * 8 + j];
                if (v > b1) { b2 = b1; i2 = i1; b1 = v; i1 = j; } else if (v > b2) { b2 = v; i2 = j; } }
            const float e2 = __expf(b2 - b1), w1 = gp / (1.0f + e2), w2 = gp * e2 / (1.0f + e2);
            const int e0 = gi * 8 + i1, e1 = gi * 8 + i2;
            const int s0 = atomicAdd((int*)&cnt[e0], 1), s1 = atomicAdd((int*)&cnt[e1], 1);
            int4 rt; rt.x = e0 | (e1 << 8); rt.y = s0 | (s1 << 16); rt.z = __builtin_bit_cast(int, w1); rt.w = __builtin_bit_cast(int, w2);
            ROUTE[t] = rt;
        }
        __syncthreads();
        if (tid < 32) BC[vb * 32 + tid] = cnt[tid];
    }
}

__device__ __forceinline__ void phase10(const Args& a, LAS unsigned char* lds) {
    const int tid = threadIdx.x, lane = tid & 63, wave = tid >> 6;
    unsigned char* ws = a.ws;
    const bf16_t* X1 = (const bf16_t*)a.out; const int4* ROUTE = (const int4*)(ws + WS_ROUTE); const int* BC = (const int*)(ws + WS_BC);
    bf16_t* HS = (bf16_t*)(ws + WS_A); float* ROWW = (float*)(ws + WS_ROWW); int2* POS = (int2*)(ws + WS_POS); int* OFF = (int*)(ws + WS_OFF);
    LAS int* ptot = (LAS int*)lds;
    LAS int* pmine = ptot + 512;
    LAS int* base = pmine + 512;
    for (int vb = blockIdx.x; vb < 256; vb += gridDim.x) {
        __syncthreads();
        { const int e = tid & 31, part = tid >> 5; int st = 0, sm = 0;
            for (int k = 0; k < 16; ++k) { const int r = part * 16 + k; const int c = BC[r * 32 + e]; st += c; sm += (r < vb) ? c : 0; }
            ptot[part * 32 + e] = st; pmine[part * 32 + e] = sm; }
        __syncthreads();
        if (tid < 32) { int st = 0, sm = 0; for (int k = 0; k < 16; ++k) { st += ptot[k * 32 + tid]; sm += pmine[k * 32 + tid]; } ptot[tid] = (st + 255) & ~255; pmine[tid] = sm; }
        __syncthreads();
        if (tid < 32) { int off = 0; for (int k = 0; k < tid; ++k) off += ptot[k]; base[tid] = off + pmine[tid];
            if (vb == 0) { OFF[tid] = off; if (tid == 31) OFF[32] = off + ptot[31]; } }
        __syncthreads();
        for (int i0 = 0; i0 < 16; i0 += 2) {
            f32x4 v[2][4]; int4 rt[2];
#pragma unroll
            for (int u = 0; u < 2; ++u) { const int t = vb * 128 + wave * 16 + i0 + u; rt[u] = ROUTE[t]; const u32x2* xr = (const u32x2*)(X1 + (size_t)t * DM) + lane;
#pragma unroll
                for (int j = 0; j < 4; ++j) { const u32x2 w = xr[64 * j]; v[u][j] = (f32x4){bflo(w.x), bfhi(w.x), bflo(w.y), bfhi(w.y)}; } }
#pragma unroll
            for (int u = 0; u < 2; ++u) { const int t = vb * 128 + wave * 16 + i0 + u;
                const int e0 = rt[u].x & 255, e1 = (rt[u].x >> 8) & 255, p0 = base[e0] + (rt[u].y & 0xffff), p1 = base[e1] + ((rt[u].y >> 16) & 0xffff);
                float s = 0.f;
#pragma unroll
                for (int j = 0; j < 4; ++j) s += (v[u][j][0] * v[u][j][0] + v[u][j][1] * v[u][j][1]) + (v[u][j][2] * v[u][j][2] + v[u][j][3] * v[u][j][3]);
                const float rs = 1.0f / sqrtf(wave_sum(s) * (1.0f / DM) + 1e-6f);
                u32x2* o0 = (u32x2*)(HS + (size_t)p0 * DM) + lane; u32x2* o1 = (u32x2*)(HS + (size_t)p1 * DM) + lane;
#pragma unroll
                for (int j = 0; j < 4; ++j) { u32x2 w; w.x = pk2(v[u][j][0] * rs, v[u][j][1] * rs); w.y = pk2(v[u][j][2] * rs, v[u][j][3] * rs); o0[64 * j] = w; o1[64 * j] = w; }
                if (lane == 0) { ROWW[p0] = __builtin_bit_cast(float, rt[u].z); ROWW[p1] = __builtin_bit_cast(float, rt[u].w); POS[t] = make_int2(p0, p1); } }
        }
    }
}

__device__ __forceinline__ void phase13(const Args& a) {
    const int tid = threadIdx.x, lane = tid & 63, wave = tid >> 6;
    const int gw = blockIdx.x * 8 + wave, NGW = gridDim.x * 8;
    unsigned char* ws = a.ws;
    bf16_t* X = (bf16_t*)a.out; const bf16_t* YM = (const bf16_t*)(ws + WS_A); const int2* POS = (const int2*)(ws + WS_POS); bf16_t* HP = (bf16_t*)(ws + WS_HP); bf16_t* P16 = (bf16_t*)(ws + WS_P16);
    for (int t0 = gw; t0 < T; t0 += 2 * NGW) {
        f32x4 v[2][4]; u32x2 ya[2][4], yb[2][4]; f32x4 pv[2];
#pragma unroll
        for (int u = 0; u < 2; ++u) { const int t = t0 + u * NGW; const int2 ps = POS[t];
            const u32x2* xr = (const u32x2*)(X + (size_t)t * DM) + lane; const u32x2* y0 = (const u32x2*)(YM + (size_t)ps.x * DM) + lane; const u32x2* y1 = (const u32x2*)(YM + (size_t)ps.y * DM) + lane;
#pragma unroll
            for (int j = 0; j < 4; ++j) { const u32x2 w = xr[64 * j]; v[u][j] = (f32x4){bflo(w.x), bfhi(w.x), bflo(w.y), bfhi(w.y)}; ya[u][j] = y0[64 * j]; yb[u][j] = y1[64 * j]; }
            pv[u] = *((const f32x4*)(a.in[I_P] + (size_t)t * 256) + lane); }
#pragma unroll
        for (int u = 0; u < 2; ++u) { const int t = t0 + u * NGW; float s = 0.f; u32x2* xr = (u32x2*)(X + (size_t)t * DM) + lane;
#pragma unroll
            for (int j = 0; j < 4; ++j) { float a0[4], a1[4]; unpack4(ya[u][j], a0); unpack4(yb[u][j], a1);
                v[u][j][0] = (v[u][j][0] + a0[0]) + a1[0]; v[u][j][1] = (v[u][j][1] + a0[1]) + a1[1]; v[u][j][2] = (v[u][j][2] + a0[2]) + a1[2]; v[u][j][3] = (v[u][j][3] + a0[3]) + a1[3];
                s += (v[u][j][0] * v[u][j][0] + v[u][j][1] * v[u][j][1]) + (v[u][j][2] * v[u][j][2] + v[u][j][3] * v[u][j][3]); xr[64 * j] = (u32x2){cvt_pk_bf16(v[u][j][0], v[u][j][1]), cvt_pk_bf16(v[u][j][2], v[u][j][3])}; }
            const float rs = 1.0f / sqrtf(wave_sum(s) * (1.0f / DM) + 1e-6f);
            u32x2* o = (u32x2*)(HP + (size_t)t * DM) + lane;
#pragma unroll
            for (int j = 0; j < 4; ++j) { u32x2 w; w.x = pk2(v[u][j][0] * rs, v[u][j][1] * rs); w.y = pk2(v[u][j][2] * rs, v[u][j][3] * rs); o[64 * j] = w; }
            u32x2 w; w.x = pk2(pv[u][0], pv[u][1]); w.y = pk2(pv[u][2], pv[u][3]); *((u32x2*)(P16 + (size_t)t * 256) + lane) = w; }
    }
}
__device__ __forceinline__ void phase15(const Args& a, const bf16_t* XS) {
    const int tid = threadIdx.x, lane = tid & 63, wave = tid >> 6;
    const int gw = blockIdx.x * 8 + wave, NGW = gridDim.x * 8;
    float* X = a.out; const f32x4* gn = (const f32x4*)a.in[I_FINN] + lane;
    f32x4 g[4];
#pragma unroll
    for (int j = 0; j < 4; ++j) g[j] = gn[64 * j];
    for (int t0 = gw; t0 < T; t0 += 2 * NGW) {
        f32x4 v[2][4];
#pragma unroll
        for (int u = 0; u < 2; ++u) { const u32x2* xs = (const u32x2*)(XS + (size_t)(t0 + u * NGW) * DM) + lane;
#pragma unroll
            for (int j = 0; j < 4; ++j) { const u32x2 w = xs[64 * j]; v[u][j] = (f32x4){bflo(w.x), bfhi(w.x), bflo(w.y), bfhi(w.y)}; } }
#pragma unroll
        for (int u = 0; u < 2; ++u) { float s = 0.f;
#pragma unroll
            for (int j = 0; j < 4; ++j) s += (v[u][j][0] * v[u][j][0] + v[u][j][1] * v[u][j][1]) + (v[u][j][2] * v[u][j][2] + v[u][j][3] * v[u][j][3]);
            const float rs = 1.0f / sqrtf(wave_sum(s) * (1.0f / DM) + 1e-6f);
            f32x4* xr = (f32x4*)(X + (size_t)(t0 + u * NGW) * DM) + lane;
#pragma unroll
            for (int j = 0; j < 4; ++j) xr[64 * j] = (f32x4){v[u][j][0] * rs * g[j][0], v[u][j][1] * rs * g[j][1], v[u][j][2] * rs * g[j][2], v[u][j][3] * rs * g[j][3]}; }
    }
}

#ifdef PROBE
__device__ __forceinline__ void phase_probe(const Args& a) {
    const int gt = blockIdx.x * 512 + threadIdx.x, NT = gridDim.x * 512;
#if PROBE == 1
    const bf16_t* src = (const bf16_t*)(a.ws + WS_HP); const size_t n = (size_t)T * DM;
#elif PROBE == 2
    const bf16_t* src = (const bf16_t*)(a.ws + WS_WPG); const size_t n = (size_t)1024 * 1024;
#else
    const bf16_t* src = (const bf16_t*)(a.ws + WS_G); const size_t n = (size_t)T * DM;
#endif
    for (size_t i = gt; i < (size_t)T * DM; i += NT) a.out[i] = (i < n) ? __builtin_bit_cast(float, (unsigned)src[i] << 16) : 0.f;
}
#endif
__global__ void __launch_bounds__(512) mega_fwd(Args a) {
    extern __shared__ __attribute__((aligned(16))) unsigned char lds_raw[];
    LAS unsigned char* lds = (LAS unsigned char*)lds_raw;
    unsigned char* ws = a.ws;
    const int G = gridDim.x, c = blockIdx.x;
    const int lo = a.ph_lo, hi = a.ph_hi;
    if (threadIdx.x < 32) ((LAS unsigned*)(lds + MISC_OFF))[threadIdx.x] = 0u;
    __syncthreads();
    XcdBarrier bar; bar.bar = (unsigned*)(ws + WS_CTL) + 4096; bar.x = 0; bar.st = nullptr;
    if (hi - lo > 1) bar = xcd_barrier_post((unsigned*)(ws + WS_CTL) + 4096, (volatile LAS unsigned*)(lds + MISC_OFF));
#ifndef DUPMASK
#define DUPMASK 0
#endif
#ifndef PHMASK
#define PHMASK 0xFFFFF
#endif
#define IN(k) ((((PHMASK) >> (k)) & 1) && lo <= (k) && (k) < hi)
#define SEAM_MASK 0x5FBB7u
#define SEAM(k) do { if (IN(k) && IN((k) + 1)) { if ((SEAM_MASK >> (k)) & 1u) { xcd_barrier(bar); } else __syncthreads(); } } while (0)
    bf16_t* COLS = (bf16_t*)(ws + WS_A);
    TSTART(100);
    if (IN(0)) for (int rep_ = 0; rep_ < (((DUPMASK) >> 0) & 1 ? 2 : 1); ++rep_) { phase0(a, lds); }
    SEAM(0);
    TSTOP(100);
    TSTART(101);
    if (IN(1)) for (int rep_ = 0; rep_ < (((DUPMASK) >> 1) & 1 ? 2 : 1); ++rep_) {
        pg8::DenseSched S; S.init(a.out, 1024, ws + WS_WIN, 1024, T, INC, G, c);
        pg8::EpiRow8<F_Cols> E{{COLS, INC, (bf16_t*)(ws + WS_UG)}};
        pg8::gemm_phase<pg8::EpiRow8<F_Cols>, pg8::DenseSched, true>(lds, 1024, 1024, 1024, S, E);
    }
    SEAM(1);
    TSTOP(101);
    TSTART(102);
    if (IN(2)) for (int rep_ = 0; rep_ < (((DUPMASK) >> 2) & 1 ? 2 : 1); ++rep_) { phase2(a); }
    SEAM(2);
    TSTOP(102);
    TSTART(103);
    if (IN(3)) for (int rep_ = 0; rep_ < (((DUPMASK) >> 3) & 1 ? 2 : 1); ++rep_) {
        pg8::LoraSched S{(const char*)(ws + WS_Z), (const char*)(ws + WS_WLORA), {}}; S.so.init(T, 1536, G, c);
        pg8::EpiRow8<F_Lora> E{{(bf16_t*)a.out, a.in[I_W0], a.in[I_A0]}};
        pg8::gemm_phase<pg8::EpiRow8<F_Lora>, pg8::LoraSched, true>(lds, 128, 256, 256, S, E);
    }
    SEAM(3);
    TSTOP(103);
    TSTART(104);
    if (IN(4)) for (int rep_ = 0; rep_ < (((DUPMASK) >> 4) & 1 ? 2 : 1); ++rep_) {
        pg8::GroupSched S{(const char*)(ws + WS_UG), (const char*)(ws + WS_W1), S5K, 512, 4, 1, 16, G, c, (size_t)S5ROWS * S5K * 2, (size_t)256 * 512 * 2};
        pg8::EpiRow8<F_S5a> E{{(float*)(ws + WS_E)}};
        pg8::gemm_phase<pg8::EpiRow8<F_S5a>, pg8::GroupSched, true>(lds, 512, S5K, 512, S, E);
        if (G == 256) { late_items_idle(a, lds, 0, 896, 64); late_items_idle(a, lds, 1536, 1568, 64); }
    }
    SEAM(4);
    TSTOP(104);
    TSTART(105);
    if (IN(5)) for (int rep_ = 0; rep_ < (((DUPMASK) >> 5) & 1 ? 2 : 1); ++rep_) {
#if WKV_CHUNKED == 2
        phase4s(a, lds, bar);
#elif WKV_CHUNKED
        phase4c(a, lds);
#else
        phase4(a, lds);
#endif
    }
    SEAM(5);
    TSTOP(105);
    TSTART(106);
    if (IN(6)) for (int rep_ = 0; rep_ < (((DUPMASK) >> 6) & 1 ? 2 : 1); ++rep_) { phase5_post(a); }
    SEAM(6);
    TSTOP(106);
    TSTART(107);
    if (IN(7)) for (int rep_ = 0; rep_ < (((DUPMASK) >> 7) & 1 ? 2 : 1); ++rep_) {
        pg8::GroupSched S{(const char*)(ws + WS_UG), (const char*)(ws + WS_TZ), S5K, S5K, 4, 2, 16, G, c, (size_t)S5ROWS * S5K * 2, (size_t)S5N * S5K * 2};
        pg8::EpiRow8<F_S5c> E{{COLS, a.in[I_SD], (bf16_t*)(ws + WS_Z)}};
        pg8::gemm_phase<pg8::EpiRow8<F_S5c>, pg8::GroupSched, true>(lds, S5K, S5K, S5K, S, E);
        if (G == 256) late_items_idle(a, lds, 1568, N_LATE, 128);
    }
    SEAM(7);
    TSTOP(107);
    TSTART(108);
    if (IN(8)) for (int rep_ = 0; rep_ < (((DUPMASK) >> 8) & 1 ? 2 : 1); ++rep_) {
        pg8::DenseSched S; S.init(ws + WS_Z, 256, ws + WS_WGLU, 256, T, 256, G, c);
        pg8::EpiRow8<F_Glu> E{{(const bf16_t*)(ws + WS_Z), a.in[I_GLUB], (bf16_t*)a.out}};
        pg8::gemm_phase<pg8::EpiRow8<F_Glu>, pg8::DenseSched, true>(lds, 256, 256, 256, S, E);
        if (G == 256) late_items_idle(a, lds, 896, 1536, 128);
    }
    SEAM(8);
    TSTOP(108);
    TSTART(109);
    if (IN(9)) for (int rep_ = 0; rep_ < (((DUPMASK) >> 9) & 1 ? 2 : 1); ++rep_) {
        pg8::BrSched S{(const char*)(ws + WS_RWKV), (const char*)(ws + WS_WBA), (const char*)a.out, (const char*)(ws + WS_WBB), {}}; S.so.init(T, DM, G, c);
        pg8::EpiBr E{COLS, (bf16_t*)(ws + WS_B)};
        pg8::gemm_phase2<pg8::EpiBr, pg8::BrSched, true, 8, 4>(lds, 512, 512, S, E);
    }
    SEAM(9);
    TSTOP(109);
    TSTART(110);
    SEAM(10);
    TSTOP(110);
    TSTART(111);
    if (IN(11)) for (int rep_ = 0; rep_ < (((DUPMASK) >> 11) & 1 ? 2 : 1); ++rep_) {
        pg8::DenseSched S; S.init(ws + WS_B, 1024, ws + WS_WOUT, 1024, T, DM, G, c);
        pg8::EpiRow8<F_Res> E{{a.in[I_X], (bf16_t*)a.out}};
        pg8::gemm_phase<pg8::EpiRow8<F_Res>, pg8::DenseSched, true>(lds, 1024, 1024, 1024, S, E);
    }
    SEAM(11);
    TSTOP(111);
    TSTART(112);
    if (IN(12)) for (int rep_ = 0; rep_ < (((DUPMASK) >> 12) & 1 ? 2 : 1); ++rep_) { phase9(a, lds); }
    SEAM(12);
    TSTOP(112);
    TSTART(113);
    if (IN(13)) for (int rep_ = 0; rep_ < (((DUPMASK) >> 13) & 1 ? 2 : 1); ++rep_) { phase10(a, lds); }
    SEAM(13);
    TSTOP(113);
    TSTART(114);
    if (IN(14)) for (int rep_ = 0; rep_ < (((DUPMASK) >> 14) & 1 ? 2 : 1); ++rep_) {
        pg8::MoeSched S{(const int*)(ws + WS_OFF), (const char*)(ws + WS_A), (const char*)(ws + WS_WGU), 1024, 1024, 2, G, c, (size_t)512 * 1024 * 2};
        pg8::EpiMoeUp E{(bf16_t*)(ws + WS_HID)};
        pg8::gemm_phase<pg8::EpiMoeUp, pg8::MoeSched, true>(lds, 1024, 1024, 1024, S, E);
    }
    SEAM(14);
    TSTOP(114);
    TSTART(115);
    if (IN(15)) for (int rep_ = 0; rep_ < (((DUPMASK) >> 15) & 1 ? 2 : 1); ++rep_) {
        pg8::MoeSched S{(const int*)(ws + WS_OFF), (const char*)(ws + WS_HID), (const char*)(ws + WS_WD), 256, 256, 4, G, c, (size_t)1024 * 256 * 2};
        pg8::EpiRow8<F_MoeDown> E{{(const float*)(ws + WS_ROWW), (bf16_t*)(ws + WS_A)}};
        pg8::gemm_phase<pg8::EpiRow8<F_MoeDown>, pg8::MoeSched, true>(lds, 256, 256, 256, S, E);
    }
    SEAM(15);
    TSTOP(115);
    TSTART(116);
    if (IN(16)) for (int rep_ = 0; rep_ < (((DUPMASK) >> 16) & 1 ? 2 : 1); ++rep_) { phase13(a); }
    SEAM(16);
    TSTOP(116);
    TSTART(117);
    if (IN(17)) for (int rep_ = 0; rep_ < (((DUPMASK) >> 17) & 1 ? 2 : 1); ++rep_) {
        pg8::DenseSched S; S.init(ws + WS_HP, 1024, ws + WS_WPG, 1024, T, DM, G, c);
        pg8::EpiRow8<F_PleG> E{{(bf16_t*)(ws + WS_G)}};
        pg8::gemm_phase<pg8::EpiRow8<F_PleG>, pg8::DenseSched, true>(lds, 1024, 1024, 1024, S, E);
    }
    SEAM(17);
    TSTOP(117);
    TSTART(118);
    if (IN(18)) for (int rep_ = 0; rep_ < (((DUPMASK) >> 18) & 1 ? 2 : 1); ++rep_) {
        pg8::DenseSched S; S.init(ws + WS_P16, 256, ws + WS_WPP, 256, T, DM, G, c);
        pg8::EpiRow8<F_PleP> E{{(const bf16_t*)(ws + WS_G), (const bf16_t*)a.out, (bf16_t*)(ws + WS_A)}};
        pg8::gemm_phase<pg8::EpiRow8<F_PleP>, pg8::DenseSched, true>(lds, 256, 256, 256, S, E);
    }
    SEAM(18);
    TSTOP(118);
#ifdef PROBE
    TSTART(119);
    if (IN(19)) for (int rep_ = 0; rep_ < (((DUPMASK) >> 19) & 1 ? 2 : 1); ++rep_) { phase_probe(a); }
#else
    TSTART(119);
    if (IN(19)) for (int rep_ = 0; rep_ < (((DUPMASK) >> 19) & 1 ? 2 : 1); ++rep_) { phase15(a, ((PHMASK >> 18) & 1) ? (const bf16_t*)(ws + WS_A) : (const bf16_t*)a.out); }
#endif
    TSTOP(119);
#if TIMER_SEL || TIMER_PHMASK
    if (blockIdx.x == 0 && threadIdx.x == 0) { const unsigned acc_ = ((volatile LAS unsigned*)(lds + MISC_OFF + 64))[0]; const unsigned long long t0_ = __builtin_amdgcn_s_memrealtime();
        while (__builtin_amdgcn_s_memrealtime() - t0_ < (unsigned long long)acc_ * TIMER_MULT) __builtin_amdgcn_s_sleep(8); }
#endif
#undef IN
#undef SEAM
}

extern "C" void kernel_launch(void* const* d_in, const int* in_sizes, int n_in, void* d_out, int out_size, void* d_ws, size_t ws_size, hipStream_t stream) {
    static int grid = 0;
    if (grid == 0) {
        if (n_in != 40 || out_size != T * DM || ws_size < WS_END) { fprintf(stderr, "kernel_launch: unexpected problem (n_in %d, out %d, ws %zu < %zu); nothing launched\n", n_in, out_size, ws_size, (size_t)WS_END); grid = -1; return; }
        int dev = 0, cus = 0, per_cu = 0;
        hipGetDevice(&dev); hipDeviceGetAttribute(&cus, hipDeviceAttributeMultiprocessorCount, dev);
        if (hipFuncSetAttribute((const void*)mega_fwd, hipFuncAttributeMaxDynamicSharedMemorySize, LDS_BYTES) != hipSuccess) { fprintf(stderr, "kernel_launch: hipFuncSetAttribute failed\n"); grid = -1; return; }
        if (hipOccupancyMaxActiveBlocksPerMultiprocessor(&per_cu, (const void*)mega_fwd, 512, LDS_BYTES) != hipSuccess || per_cu < 1) { fprintf(stderr, "kernel_launch: occupancy query says %d\n", per_cu); per_cu = 1; }
        (void)hipGetLastError();
        grid = cus * 1;
        if (grid > 256) grid = 256;
    }
    if (grid < 0) return;
    Args a{};
    for (int i = 0; i < 40; ++i) a.in[i] = (const float*)d_in[i];
    a.out = (float*)d_out; a.ws = (unsigned char*)d_ws;
#if MK_N_LAUNCHES == 1
    if (hipMemsetAsync((char*)d_ws + WS_CTL, 0, 65536, stream) != hipSuccess) { fprintf(stderr, "kernel_launch: memset failed\n"); return; }
    a.ph_lo = 0; a.ph_hi = NPHASE;
    void* kargs[] = {&a};
    hipError_t e = hipLaunchCooperativeKernel((const void*)mega_fwd, dim3(grid), dim3(512), kargs, LDS_BYTES, stream);
    if (e != hipSuccess) fprintf(stderr, "kernel_launch: cooperative launch failed: %s\n", hipGetErrorString(e));
#else
    for (int k = 0; k < NPHASE; ++k) {
        a.ph_lo = k; a.ph_hi = k + 1;
        hipLaunchKernelGGL(mega_fwd, dim3(grid), dim3(512), LDS_BYTES, stream, a);
    }
#endif
}
```

```cpp
#include <hip/hip_runtime.h>
#include <hip/hip_cooperative_groups.h>
#include <cstdio>
#include <cstdint>
namespace cg = cooperative_groups;

#ifndef WKV_CHUNKED
#define WKV_CHUNKED 2
#endif
#ifndef MK_N_LAUNCHES
#define MK_N_LAUNCHES 1
#endif

#define LAS __attribute__((address_space(3)))
typedef unsigned short bf16_t;
typedef short bf16x8 __attribute__((ext_vector_type(8)));
typedef float f32x4 __attribute__((ext_vector_type(4)));
typedef float f32x2 __attribute__((ext_vector_type(2)));
typedef unsigned u32x4 __attribute__((ext_vector_type(4)));
typedef unsigned u32x2 __attribute__((ext_vector_type(2)));

constexpr int T = 32768, DM = 1024, SEQ = 2048, NBATCH = 16, INC = 4096;
constexpr int C_R = 0, C_K = 512, C_V = 1024, C_WD = 1536, C_U = 1792, C_GA = 2048, C_GB = 3072;
constexpr int S5L = 32, S5NCH = 64, S5K = 640, S5N = 512, S5ROWS = 1024;
constexpr int NEXP = 32, DEXP = 256, MOE_ROWS_MAX = 2 * T + NEXP * 256;
constexpr int NPHASE = 20;

constexpr size_t MiB = (size_t)1 << 20, KiB = 1024;
constexpr size_t WS_CTL = 0;
constexpr size_t WS_WIN = 1 * MiB, WS_WBA = 9 * MiB, WS_WBB = 10 * MiB, WS_WOUT = 11 * MiB, WS_WPG = 13 * MiB, WS_WPP = 15 * MiB;
constexpr size_t WS_WLORA = 16 * MiB, WS_WGLU = 17 * MiB, WS_WR = 17 * MiB + 512 * KiB, WS_LAML = 17 * MiB + 768 * KiB;
constexpr size_t WS_KG = 18 * MiB, WS_W1 = 19 * MiB, WS_TZ = 23 * MiB, WS_WGU = 33 * MiB, WS_WD = 65 * MiB;
constexpr size_t WS_A = 82 * MiB;
constexpr size_t WS_HID = WS_A + 144 * MiB, WS_G = WS_A + 128 * MiB;
constexpr size_t WS_B = 338 * MiB;
constexpr size_t WS_UG = 402 * MiB, WS_E = 422 * MiB, WS_BON = 430 * MiB, WS_RWKV = 431 * MiB, WS_Z = 463 * MiB, WS_S5O = 479 * MiB;
constexpr size_t WS_ROUTE = 495 * MiB, WS_POS = 495 * MiB + 512 * KiB, WS_ROWW = 496 * MiB, WS_BC = 496 * MiB + 512 * KiB, WS_OFF = 496 * MiB + 768 * KiB;
constexpr size_t WS_HP = WS_RWKV;
constexpr size_t WS_P16 = WS_UG;
constexpr size_t WS_END = 497 * MiB;

constexpr int LDS_BYTES = 163840;
constexpr int MISC_OFF = 163584;

struct Args { const float* in[40]; float* out; unsigned char* ws; int ph_lo, ph_hi; };

#ifndef TIMER_SEL
#define TIMER_SEL 0
#endif
#ifndef TIMER_MULT
#define TIMER_MULT 2
#endif
#ifndef TIMER_PHMASK
#define TIMER_PHMASK 0
#endif
#if TIMER_SEL || TIMER_PHMASK
#define TSTART(id) do { if (((id) == TIMER_SEL || ((id) >= 100 && ((TIMER_PHMASK >> ((id) - 100)) & 1))) && blockIdx.x == 0 && threadIdx.x == 0) { volatile LAS unsigned* t_ = (volatile LAS unsigned*)(lds + MISC_OFF + 64); t_[0] = t_[0] - (unsigned)__builtin_amdgcn_s_memrealtime(); } } while (0)
#define TSTOP(id) do { if (((id) == TIMER_SEL || ((id) >= 100 && ((TIMER_PHMASK >> ((id) - 100)) & 1))) && blockIdx.x == 0 && threadIdx.x == 0) { volatile LAS unsigned* t_ = (volatile LAS unsigned*)(lds + MISC_OFF + 64); t_[0] = t_[0] + (unsigned)__builtin_amdgcn_s_memrealtime(); } } while (0)
#else
#define TSTART(id) do { } while (0)
#define TSTOP(id) do { } while (0)
#endif

#define LDS_WAIT() asm volatile("s_waitcnt lgkmcnt(0)" ::: "memory")
#define VM_WAIT() asm volatile("s_waitcnt vmcnt(0)" ::: "memory")
__device__ __forceinline__ unsigned f2bf(float f) { unsigned u = __builtin_bit_cast(unsigned, f); return (u + 0x7fffu + ((u >> 16) & 1u)) >> 16; }
__device__ __forceinline__ unsigned pk2(float lo, float hi) { return f2bf(lo) | (f2bf(hi) << 16); }
typedef __bf16 bf16x2_t __attribute__((ext_vector_type(2)));
__device__ __forceinline__ unsigned cvt_pk_bf16(float lo, float hi) { const f32x2 v = {lo, hi}; const bf16x2_t b = __builtin_convertvector(v, bf16x2_t); return __builtin_bit_cast(unsigned, b); }
__device__ __forceinline__ float bflo(unsigned w) { return __builtin_bit_cast(float, w << 16); }
__device__ __forceinline__ float bfhi(unsigned w) { return __builtin_bit_cast(float, w & 0xffff0000u); }
__device__ __forceinline__ void unpack8(u32x4 w, float (&v)[8]) { v[0] = bflo(w.x); v[1] = bfhi(w.x); v[2] = bflo(w.y); v[3] = bfhi(w.y); v[4] = bflo(w.z); v[5] = bfhi(w.z); v[6] = bflo(w.w); v[7] = bfhi(w.w); }
__device__ __forceinline__ void unpack4(u32x2 w, float (&v)[4]) { v[0] = bflo(w.x); v[1] = bfhi(w.x); v[2] = bflo(w.y); v[3] = bfhi(w.y); }
__device__ __forceinline__ u32x4 pack8(const float (&v)[8]) { u32x4 w; w.x = cvt_pk_bf16(v[0], v[1]); w.y = cvt_pk_bf16(v[2], v[3]); w.z = cvt_pk_bf16(v[4], v[5]); w.w = cvt_pk_bf16(v[6], v[7]); return w; }
__device__ __forceinline__ float sigmoidf_(float x) { return __builtin_amdgcn_rcpf(1.0f + __expf(-x)); }
__device__ __forceinline__ float tanhf_(float x) { return 1.0f - 2.0f * __builtin_amdgcn_rcpf(1.0f + __expf(2.0f * x)); }
__device__ __forceinline__ float gelu_tanh(float y) { return 0.5f * y * (1.0f + tanhf_(0.7978845608028654f * (y + 0.044715f * y * y * y))); }
__device__ __forceinline__ float wave_sum(float v) {
#pragma unroll
    for (int o = 1; o < 64; o <<= 1) v += __shfl_xor(v, o);
    return v;
}
__device__ __forceinline__ float dpp_f(float x, const int ctrl_sel) {
    int xi = __builtin_bit_cast(int, x), r;
    if (ctrl_sel == 0) r = __builtin_amdgcn_update_dpp(0, xi, 0xB1, 0xf, 0xf, true);
    else if (ctrl_sel == 1) r = __builtin_amdgcn_update_dpp(0, xi, 0x4E, 0xf, 0xf, true);
    else if (ctrl_sel == 2) r = __builtin_amdgcn_update_dpp(0, xi, 0x141, 0xf, 0xf, true);
    else r = __builtin_amdgcn_update_dpp(0, xi, 0x140, 0xf, 0xf, true);
    return __builtin_bit_cast(float, r);
}
__device__ __forceinline__ float row16_sum(float x) {
    x += dpp_f(x, 0); x += dpp_f(x, 1); x += dpp_f(x, 2); x += dpp_f(x, 3); return x;
}


#define XB_TMO      128
#define XB_XCNT(j)  (256  + 64 * (j))
#define XB_XSUB(j)  (1280 + 64 * (j))
#define XB_XGEN(j)  (2304 + 64 * (j))
#define XB_TOP      3328
#define XB_TOPGEN   3392
#define XCD_BAR_WORDS 3456
#define XB_SPIN_CAP (1u << 22)
__device__ __forceinline__ unsigned xb_ld(unsigned* p)              { return __hip_atomic_load(p, __ATOMIC_RELAXED, __HIP_MEMORY_SCOPE_AGENT); }
__device__ __forceinline__ unsigned xb_add(unsigned* p, unsigned v) { return __hip_atomic_fetch_add(p, v, __ATOMIC_RELAXED, __HIP_MEMORY_SCOPE_AGENT); }
__device__ __forceinline__ unsigned xb_xcc_id() { return (unsigned)__builtin_amdgcn_s_getreg((3 << 11) | 20) & 0xFu; }
#define XB_SPIN(cond, bar) do { unsigned _sp = 0; while (cond) { __builtin_amdgcn_s_sleep(1); \
    if ((++_sp & 255u) == 0u) { if (xb_ld(&(bar)[XB_TMO])) break; if (_sp > XB_SPIN_CAP) { atomicAdd(&(bar)[XB_TMO], 1u); break; } } } } while (0)
struct XcdBarrier { unsigned* bar; unsigned x; volatile LAS unsigned* st; };
__device__ __forceinline__ XcdBarrier xcd_barrier_post(unsigned* bar, volatile LAS unsigned* st) {
    XcdBarrier b; b.bar = bar; b.x = xb_xcc_id(); b.st = st;
    if (threadIdx.x == 0) (void)xb_add(&bar[XB_XCNT(b.x)], 1u);
    return b;
}
__device__ __forceinline__ void xcd_barrier_complete(unsigned* bar, unsigned x, unsigned& nloc, unsigned& nx) {
    const unsigned G = gridDim.x * gridDim.y * gridDim.z;
    unsigned sum, cnt, mine, sp = 0u;
    for (;;) {
        sum = 0u; cnt = 0u; mine = 0u;
#pragma unroll
        for (unsigned j = 0; j < 16; ++j) { const unsigned c = xb_ld(&bar[XB_XCNT(j)]); sum += c; cnt += (c > 0u) ? 1u : 0u; mine = (j == x) ? c : mine; }
        if (sum == G) break;
        __builtin_amdgcn_s_sleep(1);
        if ((++sp & 255u) == 0u) { if (xb_ld(&bar[XB_TMO])) break; if (sp > XB_SPIN_CAP) { atomicAdd(&bar[XB_TMO], 1u); break; } }
    }
    nloc = mine > 0u ? mine : 1u; nx = cnt > 0u ? cnt : 1u;
}
__device__ __forceinline__ void xcd_barrier(const XcdBarrier& b) {
    asm volatile("s_waitcnt vmcnt(0)" ::: "memory");
    __syncthreads();
    if (threadIdx.x == 0) {
        unsigned* bar = b.bar;
        __builtin_amdgcn_s_waitcnt(0);
        unsigned nloc = b.st[0], nx = b.st[1];
        if (nloc == 0u) { xcd_barrier_complete(bar, b.x, nloc, nx); b.st[0] = nloc; b.st[1] = nx; }
        const unsigned old = xb_add(&bar[XB_XSUB(b.x)], 1u);
        const unsigned gen = old / nloc;
        if (old + 1u == (gen + 1u) * nloc) {
            __builtin_amdgcn_fence(__ATOMIC_RELEASE, "agent");
            asm volatile("s_waitcnt vmcnt(0)" ::: "memory");
            const unsigned og = xb_add(&bar[XB_TOP], 1u);
            const unsigned tg = og / nx;
            if (og + 1u == (tg + 1u) * nx) xb_add(&bar[XB_TOPGEN], 1u);
            else XB_SPIN(xb_ld(&bar[XB_TOPGEN]) == tg, bar);
            __builtin_amdgcn_fence(__ATOMIC_ACQUIRE, "agent");
            xb_add(&bar[XB_XGEN(b.x)], 1u);
            asm volatile("s_waitcnt vmcnt(0)" ::: "memory");
        } else {
            XB_SPIN(xb_ld(&bar[XB_XGEN(b.x)]) == gen, bar);
            __builtin_amdgcn_fence(__ATOMIC_ACQUIRE, "agent");
            asm volatile("s_waitcnt vmcnt(0)" ::: "memory");
        }
    }
    __syncthreads();
}

namespace pg8 {
constexpr int BM = 256, BK = 64, HALF = 128, HTB = HALF * BK * 2, STAGE_BYTES = 8 * HTB, NXCD = 8, WGM = 8;
__host__ __device__ __forceinline__ int lds_byte(int r, int c) { const int st = (r >> 4) * 2 + (c >> 5), rr = r & 15, cc = c & 31, ob = rr * 64 + cc * 2; return st * 1024 + (ob ^ (((ob >> 9) & 1) << 5)); }
__host__ __device__ __forceinline__ void stage_rc(int b, int& R, int& C) { const int st = b / 1024, sb = b % 1024, swz = sb ^ (((sb >> 9) & 1) << 5); R = (st >> 1) * 16 + swz / 64; C = (st & 1) * 32 + (swz % 64) / 2; }
__host__ __device__ __forceinline__ int perm32(int rho) { const int n = rho >> 4, i = rho & 15; return 8 * (i >> 2) + 4 * n + (i & 3); }

struct Unit { int pm, pn, aux; const char* A; const char* B; };

struct StaticOrder {
    int nM, nN, nwg, G, c;
    __device__ __forceinline__ void init(int M, int N, int G_, int c_) { nM = M / BM; nN = N / BM; nwg = nM * nN; G = G_; c = c_; }
    __device__ __forceinline__ bool next(int i, int& pm, int& pn) const {
        const long L = (long)i * G + c; if (L >= nwg) return false;
        int wgid = (int)L; { const int q = nwg / NXCD, r = nwg % NXCD, xcd = wgid % NXCD, off = wgid / NXCD; wgid = (xcd < r ? xcd * (q + 1) : r * (q + 1) + (xcd - r) * q) + off; }
        const int nig = WGM * nN, gid = wgid / nig, fm = gid * WGM, gsz = (nM - fm) < WGM ? (nM - fm) : WGM;
        pm = fm + ((wgid % nig) % gsz); pn = (wgid % nig) / gsz; return true;
    }
};
struct DenseSched {
    const char* A; const char* B; int lda, ldb; StaticOrder so;
    __device__ __forceinline__ void init(const void* A_, int lda_, const void* B_, int ldb_, int M, int N, int G, int c) { A = (const char*)A_; B = (const char*)B_; lda = lda_; ldb = ldb_; so.init(M, N, G, c); }
    __device__ __forceinline__ bool next(int i, Unit& u) const {
        int pm, pn; if (!so.next(i, pm, pn)) return false;
        u.pm = pm; u.pn = pn; u.aux = 0; u.A = A + (size_t)pm * BM * lda * 2; u.B = B + (size_t)pn * BM * ldb * 2; return true;
    }
};
struct LoraSched {
    const char* A; const char* B; StaticOrder so;
    __device__ __forceinline__ bool next(int i, Unit& u) const {
        int pm, pn; if (!so.next(i, pm, pn)) return false;
        const int k0 = pn < 4 ? 0 : 128;
        u.pm = pm; u.pn = pn; u.aux = 0; u.A = A + ((size_t)pm * BM * 256 + k0) * 2; u.B = B + ((size_t)pn * BM * 256 + k0) * 2; return true;
    }
};
struct GroupSched {
    const char* A; const char* B; int lda, ldb, nM, nN, ngroups, G, c; size_t aStride, bStride;
    __device__ __forceinline__ bool next(int i, Unit& u) const {
        const int L = i * G + c; if (L >= ngroups * nM * nN) return false;
        const int g = L / (nM * nN), r = L % (nM * nN), pm = r % nM, pn = r / nM;
        u.pm = pm; u.pn = pn; u.aux = g; u.A = A + g * aStride + (size_t)pm * BM * lda * 2; u.B = B + g * bStride + (size_t)pn * BM * ldb * 2; return true;
    }
};
struct MoeSched {
    const int* off; const char* A; const char* B; int lda, ldb, NPN, G, c; size_t bStride;
    __device__ __forceinline__ bool next(int i, Unit& u) const {
        const int nTiles = off[NEXP] >> 8; const int L = i * G + c; if (L >= nTiles * NPN) return false;
        const int tile = L / NPN, pn = L % NPN, row = tile << 8; int e = 0;
        for (int k = 1; k < NEXP; ++k) e += (off[k] <= row) ? 1 : 0;
        u.pm = tile; u.pn = pn; u.aux = e; u.A = A + (size_t)tile * BM * lda * 2; u.B = B + e * bStride + (size_t)pn * BM * ldb * 2; return true;
    }
};

template <class F> struct EpiRow8 {
    F f;
    __device__ __forceinline__ void operator()(const f32x4 (&acc)[2][2][4][2], const Unit& u, int wr, int wc, int fr, int fq) const {
#pragma unroll
        for (int ai = 0; ai < 2; ++ai)
#pragma unroll
            for (int m = 0; m < 4; ++m) { const int r = ai * HALF + wr * 64 + m * 16 + fr;
#pragma unroll
                for (int bj = 0; bj < 2; ++bj) { const int c = bj * HALF + wc * 32 + 8 * fq;
                    float v[8] = {acc[ai][bj][m][0][0], acc[ai][bj][m][0][1], acc[ai][bj][m][0][2], acc[ai][bj][m][0][3], acc[ai][bj][m][1][0], acc[ai][bj][m][1][1], acc[ai][bj][m][1][2], acc[ai][bj][m][1][3]};
                    f(u, r, c, v); } }
    }
};
struct EpiMoeUp {
    bf16_t* HID;
    __device__ __forceinline__ void operator()(const f32x4 (&acc)[2][2][4][2], const Unit& u, int wr, int wc, int fr, int fq) const {
#pragma unroll
        for (int ai = 0; ai < 2; ++ai)
#pragma unroll
            for (int m = 0; m < 4; ++m) { const int r = u.pm * BM + ai * HALF + wr * 64 + m * 16 + fr; const int hc = u.pn * HALF + wc * 32 + 8 * fq;
                float o[8];
#pragma unroll
                for (int n = 0; n < 2; ++n)
#pragma unroll
                    for (int k = 0; k < 4; ++k) { const float g = acc[ai][0][m][n][k], up = acc[ai][1][m][n][k]; o[4 * n + k] = g * sigmoidf_(g) * up; }
                *(u32x4*)(HID + (size_t)r * DEXP + hc) = pack8(o); }
    }
};

template <class Epi, class Sched, bool ALIGN_EPI>
__device__ __forceinline__ void gemm_phase(LAS unsigned char* lds, const int K, const int lda, const int ldb, const Sched& S, const Epi& E) {
    const int tid = threadIdx.x, wid = __builtin_amdgcn_readfirstlane(tid >> 6), lane = tid & 63, wr = wid >> 2, wc = wid & 3, fr = lane & 15, fq = lane >> 4;
    const int nt = K / BK;
    unsigned voffA[2], voffB[2];
#pragma unroll
    for (int i = 0; i < 2; ++i) { int R, C; stage_rc(tid * 16 + i * 8192, R, C); const int Rb = (R & ~31) + perm32(R & 31);
        voffA[i] = (unsigned)(R * lda + C) * 2u; voffB[i] = (unsigned)(Rb * ldb + C) * 2u; }
    const size_t kstep = (size_t)(BK * 2);
    const size_t hstepA = (size_t)HALF * lda * 2, hstepB = (size_t)HALF * ldb * 2;
    const unsigned ldsw = (unsigned)wid * 1024u;
    const int aoff = lds_byte(wr * 64 + fr, fq * 8), boff = lds_byte(wc * 32 + fr, fq * 8);
#define PG8_SA(b, h) (((b) * 2 + (h)) * HTB)
#define PG8_SB(b, h) ((4 + (b) * 2 + (h)) * HTB)
#define PG8_STAGE(bufoff, gbase, voff) do { _Pragma("unroll") for (int _i = 0; _i < 2; ++_i) \
        __builtin_amdgcn_global_load_lds((const unsigned*)((const char*)(gbase) + (voff)[_i]), (LAS unsigned*)(lds + (bufoff) + ldsw + _i * 8192), 16, 0, 0); } while (0)
#define PG8_LDA(dst, b, h) do { _Pragma("unroll") for (int m = 0; m < 4; ++m) _Pragma("unroll") for (int k = 0; k < 2; ++k) dst[m][k] = *(const LAS bf16x8*)(lds + PG8_SA(b, h) + aoff + m * 2048 + k * 1024); } while (0)
#define PG8_LDB(dst, b, h) do { _Pragma("unroll") for (int n = 0; n < 2; ++n) _Pragma("unroll") for (int k = 0; k < 2; ++k) dst[n][k] = *(const LAS bf16x8*)(lds + PG8_SB(b, h) + boff + n * 2048 + k * 1024); } while (0)
#define PG8_MMA(ai, bj, At, Bt) do { __builtin_amdgcn_s_setprio(1); _Pragma("unroll") for (int m = 0; m < 4; ++m) _Pragma("unroll") for (int n = 0; n < 2; ++n) _Pragma("unroll") for (int k = 0; k < 2; ++k) \
        acc[ai][bj][m][n] = __builtin_amdgcn_mfma_f32_16x16x32_bf16(Bt[n][k], At[m][k], acc[ai][bj][m][n], 0, 0, 0); __builtin_amdgcn_s_setprio(0); } while (0)
#define PG8_WAIT_V(n) asm volatile("s_waitcnt vmcnt(" #n ")" ::: "memory")
#define PG8_WAIT_L(n) asm volatile("s_waitcnt lgkmcnt(" #n ")" ::: "memory")
#define PG8_BAR __builtin_amdgcn_s_barrier()
#define PG8_SCHED __builtin_amdgcn_sched_barrier(0)
    Unit cur, nxt; int ui = 0;
    if (!S.next(0, cur)) return;
    f32x4 acc[2][2][4][2];
#pragma unroll
    for (int a = 0; a < 2; ++a)
#pragma unroll
        for (int b = 0; b < 2; ++b)
#pragma unroll
            for (int m = 0; m < 4; ++m)
#pragma unroll
                for (int n = 0; n < 2; ++n) acc[a][b][m][n] = (f32x4){0.f, 0.f, 0.f, 0.f};
    bf16x8 At[4][2], B0[2][2], B1[2][2];
    const char* cA = cur.A; const char* cB = cur.B;
    PG8_STAGE(PG8_SB(0, 0), cB, voffB); PG8_STAGE(PG8_SB(0, 1), cB + hstepB, voffB); PG8_STAGE(PG8_SA(0, 0), cA, voffA); PG8_STAGE(PG8_SA(0, 1), cA + hstepA, voffA);
    if (wr == 1) PG8_BAR;
    PG8_WAIT_V(2); PG8_BAR;
    PG8_STAGE(PG8_SB(1, 0), cB + kstep, voffB); PG8_STAGE(PG8_SA(1, 0), cA + kstep, voffA); PG8_STAGE(PG8_SB(1, 1), cB + hstepB + kstep, voffB);
    PG8_WAIT_V(6); PG8_BAR;
    for (;;) {
        const bool has_next = S.next(ui + 1, nxt);
        const char* nA = has_next ? nxt.A : cA; const char* nB = has_next ? nxt.B : cB;
#pragma unroll 1
        for (int t = 0; t < nt; t += 2) {
            const bool last = (t == nt - 2);
            const char* a1 = cA + (size_t)(t + 1) * kstep;
            const char* a2 = last ? nA : cA + (size_t)(t + 2) * kstep; const char* b2 = last ? nB : cB + (size_t)(t + 2) * kstep;
            const char* a3 = a2 + kstep; const char* b3 = b2 + kstep;
            PG8_LDB(B0, 0, 0); PG8_LDB(B1, 0, 1); PG8_SCHED; PG8_LDA(At, 0, 0); PG8_STAGE(PG8_SA(1, 1), a1 + hstepA, voffA);
            PG8_WAIT_V(8); PG8_WAIT_L(0); PG8_BAR; PG8_MMA(0, 0, At, B0); PG8_MMA(0, 1, At, B1); PG8_BAR; PG8_SCHED;
            PG8_LDA(At, 0, 1); PG8_STAGE(PG8_SB(0, 0), b2, voffB); PG8_STAGE(PG8_SB(0, 1), b2 + hstepB, voffB); PG8_STAGE(PG8_SA(0, 0), a2, voffA);
            PG8_WAIT_V(8); PG8_WAIT_L(0); PG8_BAR; PG8_MMA(1, 0, At, B0); PG8_MMA(1, 1, At, B1); PG8_BAR; PG8_SCHED;
            PG8_LDB(B0, 1, 0); PG8_LDB(B1, 1, 1); PG8_SCHED; PG8_LDA(At, 1, 0); PG8_STAGE(PG8_SA(0, 1), a2 + hstepA, voffA);
            PG8_WAIT_V(8); PG8_WAIT_L(0); PG8_BAR; PG8_MMA(0, 0, At, B0); PG8_MMA(0, 1, At, B1); PG8_BAR; PG8_SCHED;
            PG8_LDA(At, 1, 1); PG8_STAGE(PG8_SB(1, 0), b3, voffB); PG8_STAGE(PG8_SB(1, 1), b3 + hstepB, voffB); PG8_STAGE(PG8_SA(1, 0), a3, voffA);
            PG8_WAIT_V(8); PG8_WAIT_L(0); PG8_BAR; PG8_MMA(1, 0, At, B0); PG8_MMA(1, 1, At, B1); PG8_BAR; PG8_SCHED;
        }
        if constexpr (ALIGN_EPI) { if (wr == 0) PG8_BAR; }
        E(acc, cur, wr, wc, fr, fq);
        if (!has_next) break;
#pragma unroll
        for (int a = 0; a < 2; ++a)
#pragma unroll
            for (int b = 0; b < 2; ++b)
#pragma unroll
                for (int m = 0; m < 4; ++m)
#pragma unroll
                    for (int n = 0; n < 2; ++n) acc[a][b][m][n] = (f32x4){0.f, 0.f, 0.f, 0.f};
        cur = nxt; cA = nA; cB = nB; ++ui;
        if constexpr (ALIGN_EPI) { if (wr == 1) PG8_BAR; }
    }
    PG8_WAIT_V(0);
    if constexpr (!ALIGN_EPI) { if (wr == 0) PG8_BAR; }
    PG8_BAR;
#undef PG8_SA
#undef PG8_SB
#undef PG8_STAGE
#undef PG8_LDA
#undef PG8_LDB
#undef PG8_MMA
#undef PG8_WAIT_V
#undef PG8_WAIT_L
#undef PG8_BAR
#undef PG8_SCHED
}

struct Unit2 { int pm, pn; const char* A0; const char* B0; const char* A1; const char* B1; };
template <class Epi, class Sched, bool ALIGN_EPI, int NT0, int NT1>
__device__ __forceinline__ void gemm_phase2(LAS unsigned char* lds, const int lda, const int ldb, const Sched& S, const Epi& E) {
    const int tid = threadIdx.x, wid = __builtin_amdgcn_readfirstlane(tid >> 6), lane = tid & 63, wr = wid >> 2, wc = wid & 3, fr = lane & 15, fq = lane >> 4;
    unsigned voffA[2], voffB[2];
#pragma unroll
    for (int i = 0; i < 2; ++i) { int R, C; stage_rc(tid * 16 + i * 8192, R, C); const int Rb = (R & ~31) + perm32(R & 31);
        voffA[i] = (unsigned)(R * lda + C) * 2u; voffB[i] = (unsigned)(Rb * ldb + C) * 2u; }
    const size_t kstep = (size_t)(BK * 2);
    const size_t hstepA = (size_t)HALF * lda * 2, hstepB = (size_t)HALF * ldb * 2;
    const unsigned ldsw = (unsigned)wid * 1024u;
    const int aoff = lds_byte(wr * 64 + fr, fq * 8), boff = lds_byte(wc * 32 + fr, fq * 8);
#define PG8_SA(b, h) (((b) * 2 + (h)) * HTB)
#define PG8_SB(b, h) ((4 + (b) * 2 + (h)) * HTB)
#define PG8_STAGE(bufoff, gbase, voff) do { _Pragma("unroll") for (int _i = 0; _i < 2; ++_i) \
        __builtin_amdgcn_global_load_lds((const unsigned*)((const char*)(gbase) + (voff)[_i]), (LAS unsigned*)(lds + (bufoff) + ldsw + _i * 8192), 16, 0, 0); } while (0)
#define PG8_LDA(dst, b, h) do { _Pragma("unroll") for (int m = 0; m < 4; ++m) _Pragma("unroll") for (int k = 0; k < 2; ++k) dst[m][k] = *(const LAS bf16x8*)(lds + PG8_SA(b, h) + aoff + m * 2048 + k * 1024); } while (0)
#define PG8_LDB(dst, b, h) do { _Pragma("unroll") for (int n = 0; n < 2; ++n) _Pragma("unroll") for (int k = 0; k < 2; ++k) dst[n][k] = *(const LAS bf16x8*)(lds + PG8_SB(b, h) + boff + n * 2048 + k * 1024); } while (0)
#define PG8_MMA(ai, bj, At, Bt) do { __builtin_amdgcn_s_setprio(1); _Pragma("unroll") for (int m = 0; m < 4; ++m) _Pragma("unroll") for (int n = 0; n < 2; ++n) _Pragma("unroll") for (int k = 0; k < 2; ++k) \
        acc[ai][bj][m][n] = __builtin_amdgcn_mfma_f32_16x16x32_bf16(Bt[n][k], At[m][k], acc[ai][bj][m][n], 0, 0, 0); __builtin_amdgcn_s_setprio(0); } while (0)
#define PG8_WAIT_V(n) asm volatile("s_waitcnt vmcnt(" #n ")" ::: "memory")
#define PG8_WAIT_L(n) asm volatile("s_waitcnt lgkmcnt(" #n ")" ::: "memory")
#define PG8_BAR __builtin_amdgcn_s_barrier()
#define PG8_SCHED __builtin_amdgcn_sched_barrier(0)
#define PG8_KLOOP(NT, cA_, cB_, nA_, nB_) _Pragma("unroll 1") for (int t = 0; t < (NT); t += 2) { \
            const bool last = (t == (NT) - 2); \
            const char* a1 = (cA_) + (size_t)(t + 1) * kstep; \
            const char* a2 = last ? (nA_) : (cA_) + (size_t)(t + 2) * kstep; const char* b2 = last ? (nB_) : (cB_) + (size_t)(t + 2) * kstep; \
            const char* a3 = a2 + kstep; const char* b3 = b2 + kstep; \
            PG8_LDB(B0, 0, 0); PG8_LDB(B1, 0, 1); PG8_SCHED; PG8_LDA(At, 0, 0); PG8_STAGE(PG8_SA(1, 1), a1 + hstepA, voffA); \
            PG8_WAIT_V(8); PG8_WAIT_L(0); PG8_BAR; PG8_MMA(0, 0, At, B0); PG8_MMA(0, 1, At, B1); PG8_BAR; PG8_SCHED; \
            PG8_LDA(At, 0, 1); PG8_STAGE(PG8_SB(0, 0), b2, voffB); PG8_STAGE(PG8_SB(0, 1), b2 + hstepB, voffB); PG8_STAGE(PG8_SA(0, 0), a2, voffA); \
            PG8_WAIT_V(8); PG8_WAIT_L(0); PG8_BAR; PG8_MMA(1, 0, At, B0); PG8_MMA(1, 1, At, B1); PG8_BAR; PG8_SCHED; \
            PG8_LDB(B0, 1, 0); PG8_LDB(B1, 1, 1); PG8_SCHED; PG8_LDA(At, 1, 0); PG8_STAGE(PG8_SA(0, 1), a2 + hstepA, voffA); \
            PG8_WAIT_V(8); PG8_WAIT_L(0); PG8_BAR; PG8_MMA(0, 0, At, B0); PG8_MMA(0, 1, At, B1); PG8_BAR; PG8_SCHED; \
            PG8_LDA(At, 1, 1); PG8_STAGE(PG8_SB(1, 0), b3, voffB); PG8_STAGE(PG8_SB(1, 1), b3 + hstepB, voffB); PG8_STAGE(PG8_SA(1, 0), a3, voffA); \
            PG8_WAIT_V(8); PG8_WAIT_L(0); PG8_BAR; PG8_MMA(1, 0, At, B0); PG8_MMA(1, 1, At, B1); PG8_BAR; PG8_SCHED; }
    Unit2 cur, nxt; int ui = 0;
    if (!S.next(0, cur)) return;
    f32x4 acc[2][2][4][2];
#pragma unroll
    for (int a = 0; a < 2; ++a)
#pragma unroll
        for (int b = 0; b < 2; ++b)
#pragma unroll
            for (int m = 0; m < 4; ++m)
#pragma unroll
                for (int n = 0; n < 2; ++n) acc[a][b][m][n] = (f32x4){0.f, 0.f, 0.f, 0.f};
    bf16x8 At[4][2], B0[2][2], B1[2][2];
    {
        const char* cA = cur.A0; const char* cB = cur.B0;
        PG8_STAGE(PG8_SB(0, 0), cB, voffB); PG8_STAGE(PG8_SB(0, 1), cB + hstepB, voffB); PG8_STAGE(PG8_SA(0, 0), cA, voffA); PG8_STAGE(PG8_SA(0, 1), cA + hstepA, voffA);
        if (wr == 1) PG8_BAR;
        PG8_WAIT_V(2); PG8_BAR;
        PG8_STAGE(PG8_SB(1, 0), cB + kstep, voffB); PG8_STAGE(PG8_SA(1, 0), cA + kstep, voffA); PG8_STAGE(PG8_SB(1, 1), cB + hstepB + kstep, voffB);
        PG8_WAIT_V(6); PG8_BAR;
    }
    for (;;) {
        const bool has_next = S.next(ui + 1, nxt);
        const char* nA = has_next ? nxt.A0 : cur.A0; const char* nB = has_next ? nxt.B0 : cur.B0;
        PG8_KLOOP(NT0, cur.A0, cur.B0, cur.A1, cur.B1)
        E.mid(acc, cur, wr, wc, fr, fq);
        PG8_KLOOP(NT1, cur.A1, cur.B1, nA, nB)
        if constexpr (ALIGN_EPI) { if (wr == 0) PG8_BAR; }
        E.fin(acc, cur, wr, wc, fr, fq);
        if (!has_next) break;
#pragma unroll
        for (int a = 0; a < 2; ++a)
#pragma unroll
            for (int b = 0; b < 2; ++b)
#pragma unroll
                for (int m = 0; m < 4; ++m)
#pragma unroll
                    for (int n = 0; n < 2; ++n) acc[a][b][m][n] = (f32x4){0.f, 0.f, 0.f, 0.f};
        cur = nxt; ++ui;
        if constexpr (ALIGN_EPI) { if (wr == 1) PG8_BAR; }
    }
    PG8_WAIT_V(0);
    if constexpr (!ALIGN_EPI) { if (wr == 0) PG8_BAR; }
    PG8_BAR;
#undef PG8_KLOOP
#undef PG8_SA
#undef PG8_SB
#undef PG8_STAGE
#undef PG8_LDA
#undef PG8_LDB
#undef PG8_MMA
#undef PG8_WAIT_V
#undef PG8_WAIT_L
#undef PG8_BAR
#undef PG8_SCHED
}
struct BrSched {
    const char* A0; const char* B0; const char* A1; const char* B1; StaticOrder so;
    __device__ __forceinline__ bool next(int i, Unit2& u) const {
        int pm, pn; if (!so.next(i, pm, pn)) return false;
        u.pm = pm; u.pn = pn; u.A0 = A0 + (size_t)pm * BM * 512 * 2; u.B0 = B0 + (size_t)pn * BM * 512 * 2; u.A1 = A1 + (size_t)pm * BM * 512 * 2; u.B1 = B1 + (size_t)pn * BM * 512 * 2; return true;
    }
};
struct EpiBr {
    const bf16_t* COLS; bf16_t* MG;
    __device__ __forceinline__ void mid(f32x4 (&acc)[2][2][4][2], const Unit2& u, int wr, int wc, int fr, int fq) const {
#pragma unroll
        for (int ai = 0; ai < 2; ++ai)
#pragma unroll
            for (int m = 0; m < 4; ++m) { const size_t t = (size_t)u.pm * BM + ai * HALF + wr * 64 + m * 16 + fr;
#pragma unroll
                for (int bj = 0; bj < 2; ++bj) { const int col = u.pn * BM + bj * HALF + wc * 32 + 8 * fq; float ga[8], gb[8];
                    unpack8(*(const u32x4*)(COLS + t * INC + C_GA + col), ga); unpack8(*(const u32x4*)(COLS + t * INC + C_GB + col), gb);
#pragma unroll
                    for (int n = 0; n < 2; ++n)
#pragma unroll
                        for (int k = 0; k < 4; ++k) { const float rt_ = sigmoidf_(ga[4 * n + k]) * (1.0f + __expf(-gb[4 * n + k]));
                            asm volatile("v_mul_f32 %0, %0, %1" : "+v"(acc[ai][bj][m][n][k]) : "v"(rt_)); } }
                asm volatile("" ::: "memory"); }
    }
    __device__ __forceinline__ void fin(const f32x4 (&acc)[2][2][4][2], const Unit2& u, int wr, int wc, int fr, int fq) const {
#pragma unroll
        for (int ai = 0; ai < 2; ++ai)
#pragma unroll
            for (int m = 0; m < 4; ++m) { const size_t t = (size_t)u.pm * BM + ai * HALF + wr * 64 + m * 16 + fr;
#pragma unroll
                for (int bj = 0; bj < 2; ++bj) { const int col = u.pn * BM + bj * HALF + wc * 32 + 8 * fq; float gb[8], o[8];
                    unpack8(*(const u32x4*)(COLS + t * INC + C_GB + col), gb);
#pragma unroll
                    for (int n = 0; n < 2; ++n)
#pragma unroll
                        for (int k = 0; k < 4; ++k) o[4 * n + k] = acc[ai][bj][m][n][k] * sigmoidf_(gb[4 * n + k]);
                    *(u32x4*)(MG + t * DM + col) = pack8(o); }
                asm volatile("" ::: "memory"); }
    }
};
}
using pg8::Unit;

struct F_Cols { bf16_t* C; int ldc; bf16_t* UG;
    __device__ __forceinline__ void operator()(const Unit& u, int r, int c, float (&v)[8]) const {
        const u32x4 w = pack8(v); const int t = u.pm * 256 + r;
        *(u32x4*)(C + (size_t)t * ldc + u.pn * 256 + c) = w;
        if (u.pn == 7) { const int g = c >> 4, c0 = c & 15, b = t >> 11, s = t & (SEQ - 1), ch = s >> 5, j = s & 31;
            *(u32x4*)(UG + ((size_t)g * S5ROWS + b * S5NCH + ch) * S5K + j * 16 + c0) = w; } } };
struct F_Lora { bf16_t* O; const float* w0; const float* a0;
    __device__ __forceinline__ void operator()(const Unit& u, int r, int c, float (&v)[8]) const {
        const int gc = u.pn * 256 + c; const int ty = u.pn >> 1;
        if (ty == 0) {
#pragma unroll
            for (int i = 0; i < 8; ++i) v[i] = 0.6065306597126334f * sigmoidf_(v[i] + w0[gc + i]);
        } else if (ty == 1) {
#pragma unroll
            for (int i = 0; i < 8; ++i) v[i] = sigmoidf_(v[i] + a0[gc - 512 + i]);
        }
        *(u32x4*)(O + (size_t)(u.pm * 256 + r) * 1536 + gc) = pack8(v); } };
struct F_S5a { float* E;
    __device__ __forceinline__ void operator()(const Unit& u, int r, int c, float (&v)[8]) const {
        if (c < 128) { float* p = E + ((size_t)u.aux * S5ROWS + u.pm * 256 + r) * 128 + c;
            *(f32x4*)p = (f32x4){v[0], v[1], v[2], v[3]}; *(f32x4*)(p + 4) = (f32x4){v[4], v[5], v[6], v[7]}; } } };
struct F_S5c { const bf16_t* COLS; const float* Dsk; bf16_t* Z;
    __device__ __forceinline__ void operator()(const Unit& u, int r, int c, float (&v)[8]) const {
        const int row = u.pm * 256 + r, col = u.pn * 256 + c; const int b = row >> 6, ch = row & 63, j = col >> 4, c0 = col & 15;
        const int t = b * SEQ + ch * S5L + j, chan = u.aux * 16 + c0;
        float uu[8]; unpack8(*(const u32x4*)(COLS + (size_t)t * INC + C_U + chan), uu);
#pragma unroll
        for (int i = 0; i < 8; ++i) v[i] = gelu_tanh(v[i] + Dsk[chan + i] * uu[i]);
        *(u32x4*)(Z + (size_t)t * 256 + chan) = pack8(v); } };
struct F_Glu { const bf16_t* Z; const float* gb; bf16_t* O;
    __device__ __forceinline__ void operator()(const Unit& u, int r, int c, float (&v)[8]) const {
        const size_t t = (size_t)u.pm * 256 + r; float z[8]; unpack8(*(const u32x4*)(Z + t * 256 + c), z);
#pragma unroll
        for (int i = 0; i < 8; ++i) v[i] = z[i] * sigmoidf_(v[i] + gb[c + i]);
        *(u32x4*)(O + t * 512 + c) = pack8(v); } };
struct F_BrA { const bf16_t* COLS; float* PART;
    __device__ __forceinline__ void operator()(const Unit& u, int r, int c, float (&v)[8]) const {
        const size_t t = (size_t)u.pm * 256 + r; const int col = u.pn * 256 + c; float g[8]; unpack8(*(const u32x4*)(COLS + t * INC + C_GA + col), g);
#pragma unroll
        for (int i = 0; i < 8; ++i) v[i] *= sigmoidf_(g[i]);
        float* p = PART + t * DM + col; *(f32x4*)p = (f32x4){v[0], v[1], v[2], v[3]}; *(f32x4*)(p + 4) = (f32x4){v[4], v[5], v[6], v[7]}; } };
struct F_BrB { const bf16_t* COLS; const float* PART; bf16_t* MG;
    __device__ __forceinline__ void operator()(const Unit& u, int r, int c, float (&v)[8]) const {
        const size_t t = (size_t)u.pm * 256 + r; const int col = u.pn * 256 + c; float g[8]; unpack8(*(const u32x4*)(COLS + t * INC + C_GB + col), g);
        const float* p = PART + t * DM + col; const f32x4 p0 = *(const f32x4*)p, p1 = *(const f32x4*)(p + 4);
        const float pp[8] = {p0[0], p0[1], p0[2], p0[3], p1[0], p1[1], p1[2], p1[3]};
#pragma unroll
        for (int i = 0; i < 8; ++i) v[i] = pp[i] + v[i] * sigmoidf_(g[i]);
        *(u32x4*)(MG + t * DM + col) = pack8(v); } };
struct F_Res { const float* X; bf16_t* O;
    __device__ __forceinline__ void operator()(const Unit& u, int r, int c, float (&v)[8]) const {
        const size_t o = ((size_t)u.pm * 256 + r) * DM + u.pn * 256 + c; const f32x4 x0 = *(const f32x4*)(X + o), x1 = *(const f32x4*)(X + o + 4);
        const float w[8] = {x0[0] + v[0], x0[1] + v[1], x0[2] + v[2], x0[3] + v[3], x1[0] + v[4], x1[1] + v[5], x1[2] + v[6], x1[3] + v[7]};
        *(u32x4*)(O + o) = pack8(w); } };
struct F_MoeDown { const float* ROWW; bf16_t* YM;
    __device__ __forceinline__ void operator()(const Unit& u, int r, int c, float (&v)[8]) const {
        const size_t row = (size_t)u.pm * 256 + r; const float w = ROWW[row];
#pragma unroll
        for (int i = 0; i < 8; ++i) v[i] *= w;
        *(u32x4*)(YM + row * DM + u.pn * 256 + c) = pack8(v); } };
struct F_PleG { bf16_t* G;
    __device__ __forceinline__ void operator()(const Unit& u, int r, int c, float (&v)[8]) const {
#pragma unroll
        for (int i = 0; i < 8; ++i) v[i] = sigmoidf_(v[i]);
        *(u32x4*)(G + ((size_t)u.pm * 256 + r) * DM + u.pn * 256 + c) = pack8(v); } };
struct F_PleP { const bf16_t* G; const bf16_t* X; bf16_t* XO;
    __device__ __forceinline__ void operator()(const Unit& u, int r, int c, float (&v)[8]) const {
        const size_t o = ((size_t)u.pm * 256 + r) * DM + u.pn * 256 + c; float g[8], x[8], w[8]; unpack8(*(const u32x4*)(G + o), g); unpack8(*(const u32x4*)(X + o), x);
#pragma unroll
        for (int i = 0; i < 8; ++i) w[i] = x[i] + g[i] * v[i];
        *(u32x4*)(XO + o) = pack8(w); } };

enum { I_X = 0, I_P, I_MIXN, I_WIN, I_MU, I_W0, I_WUP, I_A0, I_AUP, I_GUP, I_KK, I_KA, I_RK, I_LNG, I_LNB, I_LRE, I_LIM, I_LDT, I_BRE, I_BIM, I_CRE, I_CIM, I_SD, I_GLUW, I_GLUB,
       I_WBA, I_WBB, I_WOUT, I_FFNN, I_RGW, I_RGB, I_REW, I_REB, I_EG, I_EU, I_ED, I_PLEN, I_PLEG, I_PLEP, I_FINN };

__device__ __forceinline__ void transpose_item(const float* __restrict__ W, int ldw, const float* __restrict__ kscale, int k0, int n0, bf16_t* WT, int ldt, int dst_row0, int dst_k0, LAS float* scr, int lane) {
#pragma unroll 2
    for (int i = 0; i < 32; ++i) { const int kk = 2 * i + (lane >> 5); float v = W[(size_t)(k0 + kk) * ldw + n0 + (lane & 31)]; if (kscale) v *= kscale[k0 + kk]; scr[kk * 33 + (lane & 31)] = v; }
    LDS_WAIT();
    const int c = lane & 7;
#pragma unroll
    for (int j = 0; j < 4; ++j) { const int n = (lane >> 3) + 8 * j; const LAS float* s = scr + (8 * c) * 33 + n;
        u32x4 o; o.x = pk2(s[0 * 33], s[1 * 33]); o.y = pk2(s[2 * 33], s[3 * 33]); o.z = pk2(s[4 * 33], s[5 * 33]); o.w = pk2(s[6 * 33], s[7 * 33]);
        *(u32x4*)(WT + (size_t)(dst_row0 + n) * ldt + dst_k0 + 8 * c) = o; }
    LDS_WAIT();
}

constexpr int N_WBA = 8 * 32, N_WBB = 4 * 32, N_WOUT = 16 * 32, N_WPG = 16 * 32, N_WPP = 4 * 32, N_GLU = 4 * 8, N_EG = 32 * 128, N_EU = 32 * 128, N_ED = 32 * 128;
constexpr int N_LATE = N_WBA + N_WBB + N_WOUT + N_WPG + N_WPP + N_GLU + N_EG + N_EU + N_ED;
struct TrDesc { const float* W; const float* ks; bf16_t* WT; int ldw, k0, n0, ldt, row0; };
__device__ __forceinline__ TrDesc late_desc(const Args& a, int r) {
    unsigned char* ws = a.ws; TrDesc d; d.ks = nullptr;
    if (r < N_WBA) { d.W = a.in[I_WBA]; d.ldw = 1024; d.k0 = 64 * (r / 32); d.n0 = 32 * (r % 32); d.WT = (bf16_t*)(ws + WS_WBA); d.ldt = 512; d.row0 = d.n0; return d; } r -= N_WBA;
    if (r < N_WBB) { d.W = a.in[I_WBB]; d.ldw = 1024; d.k0 = 64 * (r / 32); d.n0 = 32 * (r % 32); d.WT = (bf16_t*)(ws + WS_WBB); d.ldt = 512; d.row0 = d.n0; return d; } r -= N_WBB;
    if (r < N_WOUT) { d.W = a.in[I_WOUT]; d.ldw = 1024; d.k0 = 64 * (r / 32); d.n0 = 32 * (r % 32); d.WT = (bf16_t*)(ws + WS_WOUT); d.ldt = 1024; d.row0 = d.n0; return d; } r -= N_WOUT;
    if (r < N_WPG) { d.W = a.in[I_PLEG]; d.ks = a.in[I_PLEN]; d.ldw = 1024; d.k0 = 64 * (r / 32); d.n0 = 32 * (r % 32); d.WT = (bf16_t*)(ws + WS_WPG); d.ldt = 1024; d.row0 = d.n0; return d; } r -= N_WPG;
    if (r < N_WPP) { d.W = a.in[I_PLEP]; d.ldw = 1024; d.k0 = 64 * (r / 32); d.n0 = 32 * (r % 32); d.WT = (bf16_t*)(ws + WS_WPP); d.ldt = 256; d.row0 = d.n0; return d; } r -= N_WPP;
    if (r < N_GLU) { d.W = a.in[I_GLUW]; d.ldw = 256; d.k0 = 64 * (r / 8); d.n0 = 32 * (r % 8); d.WT = (bf16_t*)(ws + WS_WGLU); d.ldt = 256; d.row0 = d.n0; return d; } r -= N_GLU;
    if (r < N_EG + N_EU) { const int up = r >= N_EG ? 1 : 0; if (up) r -= N_EG; const int e = r / 128, q = r % 128; d.k0 = 64 * (q / 8); d.n0 = 32 * (q % 8);
        d.W = a.in[up ? I_EU : I_EG] + (size_t)e * 1024 * 256; d.ks = a.in[I_FFNN]; d.ldw = 256; d.WT = (bf16_t*)(ws + WS_WGU); d.ldt = 1024; d.row0 = e * 512 + (d.n0 / 128) * 256 + up * 128 + (d.n0 % 128); return d; } r -= N_EG + N_EU;
    { const int e = r / 128, q = r % 128; d.k0 = 64 * (q / 32); d.n0 = 32 * (q % 32); d.W = a.in[I_ED] + (size_t)e * 256 * 1024; d.ldw = 1024; d.WT = (bf16_t*)(ws + WS_WD) + (size_t)e * 1024 * 256; d.ldt = 256; d.row0 = d.n0; return d; }
}
__device__ __forceinline__ void tr_load(const TrDesc& d, float (&tv)[32], int lane) {
#pragma unroll
    for (int i = 0; i < 32; ++i) tv[i] = d.W[(size_t)(d.k0 + 2 * i + (lane >> 5)) * d.ldw + d.n0 + (lane & 31)];
}
__device__ __forceinline__ void tr_store(const TrDesc& d, const float (&tv)[32], LAS float* scr, int lane) {
#pragma unroll
    for (int i = 0; i < 32; ++i) scr[(2 * i + (lane >> 5)) * 33 + (lane & 31)] = tv[i];
    LDS_WAIT();
    const int c = lane & 7; float sc[8];
#pragma unroll
    for (int i = 0; i < 8; ++i) sc[i] = d.ks ? d.ks[d.k0 + 8 * c + i] : 1.0f;
#pragma unroll
    for (int j = 0; j < 4; ++j) { const int n = (lane >> 3) + 8 * j; const LAS float* s = scr + (8 * c) * 33 + n;
        u32x4 o; o.x = pk2(s[0 * 33] * sc[0], s[1 * 33] * sc[1]); o.y = pk2(s[2 * 33] * sc[2], s[3 * 33] * sc[3]); o.z = pk2(s[4 * 33] * sc[4], s[5 * 33] * sc[5]); o.w = pk2(s[6 * 33] * sc[6], s[7 * 33] * sc[7]);
        *(u32x4*)(d.WT + (size_t)(d.row0 + n) * d.ldt + d.k0 + 8 * c) = o; }
    LDS_WAIT();
}
__device__ __forceinline__ void dsincos_reduced(double x, double& s, double& c) {
    const double x2 = x * x;
    double ps = -1.0 / 1.307674368e12  ; ps = ps * x2 + 1.0 / 6227020800.0; ps = ps * x2 - 1.0 / 39916800.0; ps = ps * x2 + 1.0 / 362880.0; ps = ps * x2 - 1.0 / 5040.0; ps = ps * x2 + 1.0 / 120.0; ps = ps * x2 - 1.0 / 6.0;
    double hs = -1.0 / 1.21645100408832e17  ; hs = hs * x2 + 1.0 / 3.55687428096e14  ; ps = ((hs * x2) * x2 * x2 * x2 * x2 * x2 * x2) + ps;
    s = x + x * x2 * ps;
    double pc = 1.0 / 2.0922789888e13  ; pc = pc * x2 - 1.0 / 87178291200.0; pc = pc * x2 + 1.0 / 479001600.0; pc = pc * x2 - 1.0 / 3628800.0; pc = pc * x2 + 1.0 / 40320.0; pc = pc * x2 - 1.0 / 720.0; pc = pc * x2 + 1.0 / 24.0; pc = pc * x2 - 0.5;
    double hc = 1.0 / 2.43290200817664e18  ; hc = hc * x2 - 1.0 / 6.402373705728e15  ; pc = ((hc * x2) * x2 * x2 * x2 * x2 * x2 * x2 * x2) + pc;
    c = 1.0 + x2 * pc;
}
__device__ __forceinline__ double dexp_(double x) {
    const double ln2 = 0.6931471805599453094; const double kf = __builtin_rint(x * 1.4426950408889634074); const double r = x - kf * ln2;
    double t = 1.0 / 6227020800.0; t = t * r + 1.0 / 479001600.0; t = t * r + 1.0 / 39916800.0; t = t * r + 1.0 / 3628800.0; t = t * r + 1.0 / 362880.0; t = t * r + 1.0 / 40320.0; t = t * r + 1.0 / 5040.0;
    t = t * r + 1.0 / 720.0; t = t * r + 1.0 / 120.0; t = t * r + 1.0 / 24.0; t = t * r + 1.0 / 6.0; t = t * r + 0.5; t = t * r + 1.0; t = t * r + 1.0;
    const int ki = (int)kf; const long long bits = (long long)(1023 + ki) << 52;
    return t * __builtin_bit_cast(double, bits);
}

__device__ __forceinline__ void phase0(const Args& a, LAS unsigned char* lds) {
    const int tid = threadIdx.x, lane = tid & 63, wave = tid >> 6, G = gridDim.x;
    const int gw = blockIdx.x * 8 + wave, NGW = G * 8;
    unsigned char* ws = a.ws;
    LAS float* scr = (LAS float*)(lds + wave * 16384);
    float tv[32]; TrDesc td; const bool has_tr = gw < 16 * 128;
    { const int it = has_tr ? gw : 0; td.W = a.in[I_WIN]; td.ks = a.in[I_MIXN]; td.WT = (bf16_t*)(ws + WS_WIN); td.ldw = INC; td.k0 = 64 * (it / 128); td.n0 = 32 * (it % 128); td.ldt = 1024; td.row0 = td.n0; }
    if (has_tr) tr_load(td, tv, lane);
    const int gt = blockIdx.x * 512 + tid;
    float sv[8]; f32x4 sg0 = (f32x4){1.f, 1.f, 1.f, 1.f}, sg1 = sg0;
#pragma unroll
    for (int i = 0; i < 8; ++i) sv[i] = 0.f;
    if (gt < 1536 * 32) { const int n = gt >> 5, k0 = (gt & 31) * 8; const float* bp = nullptr;
        if (n < 512) { if (k0 < 64) bp = a.in[I_WUP] + k0 * 512 + n; }
        else if (n < 1024) { if (k0 >= 64 && k0 < 128) bp = a.in[I_AUP] + (k0 - 64) * 512 + (n - 512); }
        else { if (k0 >= 128) bp = a.in[I_GUP] + (k0 - 128) * 512 + (n - 1024); }
        if (bp) {
#pragma unroll
            for (int i = 0; i < 8; ++i) sv[i] = bp[i * 512]; }
    } else if (gt < 1536 * 32 + 48 * 128) { const int cc = gt - 1536 * 32, j = cc >> 7, k0 = (cc & 127) * 8;
        if (j < 36) { const float* bp = (j < 4) ? (a.in[I_RGW] + k0 * 4 + j) : (a.in[I_REW] + k0 * 32 + (j - 4)); const int st = (j < 4) ? 4 : 32;
#pragma unroll
            for (int i = 0; i < 8; ++i) sv[i] = bp[i * st];
            sg0 = *(const f32x4*)(a.in[I_FFNN] + k0); sg1 = *(const f32x4*)(a.in[I_FFNN] + k0 + 4); }
    }
    {
        bf16_t* HN = (bf16_t*)a.out;
        for (int m0 = gw; m0 < T; m0 += 2 * NGW) {
            f32x4 v[2][4]; float s[2] = {0.f, 0.f};
#pragma unroll
            for (int u = 0; u < 2; ++u) { const f32x4* xr = (const f32x4*)(a.in[I_X] + (size_t)(m0 + u * NGW) * DM) + lane;
#pragma unroll
                for (int j = 0; j < 4; ++j) v[u][j] = xr[64 * j]; }
#pragma unroll
            for (int u = 0; u < 2; ++u) {
#pragma unroll
                for (int j = 0; j < 4; ++j) s[u] += (v[u][j][0] * v[u][j][0] + v[u][j][1] * v[u][j][1]) + (v[u][j][2] * v[u][j][2] + v[u][j][3] * v[u][j][3]);
                const float rs = 1.0f / sqrtf(wave_sum(s[u]) * (1.0f / DM) + 1e-6f);
                u32x2* o = (u32x2*)(HN + (size_t)(m0 + u * NGW) * DM) + lane;
#pragma unroll
                for (int j = 0; j < 4; ++j) { u32x2 w; w.x = pk2(v[u][j][0] * rs, v[u][j][1] * rs); w.y = pk2(v[u][j][2] * rs, v[u][j][3] * rs); o[64 * j] = w; }
            }
        }
    }
    if (has_tr) tr_store(td, tv, scr, lane);
    for (int it = gw + NGW; it < 16 * 128; it += NGW)
        transpose_item(a.in[I_WIN], INC, a.in[I_MIXN], 64 * (it / 128), 32 * (it % 128), (bf16_t*)(ws + WS_WIN), 1024, 32 * (it % 128), 64 * (it / 128), scr, lane);
    if (gt < 1536 * 32 + 48 * 128) {
        u32x4 o; o.x = pk2(sv[0] * sg0[0], sv[1] * sg0[1]); o.y = pk2(sv[2] * sg0[2], sv[3] * sg0[3]); o.z = pk2(sv[4] * sg1[0], sv[5] * sg1[1]); o.w = pk2(sv[6] * sg1[2], sv[7] * sg1[3]);
        if (gt < 1536 * 32) *(u32x4*)((bf16_t*)(ws + WS_WLORA) + (size_t)(gt >> 5) * 256 + (gt & 31) * 8) = o;
        else { const int cc = gt - 1536 * 32; *(u32x4*)((bf16_t*)(ws + WS_WR) + (size_t)(cc >> 7) * 1024 + (cc & 127) * 8) = o; }
    }
    for (int c = gt + G * 512; c < 1536 * 32 + 48 * 128; c += G * 512) {
        float v[8];
        if (c < 1536 * 32) { const int n = c >> 5, k0 = (c & 31) * 8;
#pragma unroll
            for (int i = 0; i < 8; ++i) { const int k = k0 + i; float x = 0.f;
                if (n < 512) { if (k < 64) x = a.in[I_WUP][k * 512 + n]; }
                else if (n < 1024) { if (k >= 64 && k < 128) x = a.in[I_AUP][(k - 64) * 512 + (n - 512)]; }
                else { if (k >= 128) x = a.in[I_GUP][(k - 128) * 512 + (n - 1024)]; }
                v[i] = x; }
            u32x4 o; o.x = pk2(v[0], v[1]); o.y = pk2(v[2], v[3]); o.z = pk2(v[4], v[5]); o.w = pk2(v[6], v[7]); *(u32x4*)((bf16_t*)(ws + WS_WLORA) + (size_t)n * 256 + k0) = o;
        } else { const int cc = c - 1536 * 32, j = cc >> 7, k0 = (cc & 127) * 8;
#pragma unroll
            for (int i = 0; i < 8; ++i) { const int k = k0 + i; float x = 0.f;
                if (j < 4) x = a.in[I_RGW][k * 4 + j] * a.in[I_FFNN][k]; else if (j < 36) x = a.in[I_REW][k * 32 + (j - 4)] * a.in[I_FFNN][k];
                v[i] = x; }
            u32x4 o; o.x = pk2(v[0], v[1]); o.y = pk2(v[2], v[3]); o.z = pk2(v[4], v[5]); o.w = pk2(v[6], v[7]); *(u32x4*)((bf16_t*)(ws + WS_WR) + (size_t)j * 1024 + k0) = o; }
    }
    for (int vb = blockIdx.x; vb < 256; vb += G) {
        __syncthreads();
        const int g = vb & 15, part = vb >> 4;
        LAS float* Pre = (LAS float*)lds;
        LAS float* Pim = Pre + 33 * 64;
        LAS float* Bre = Pim + 33 * 64;
        LAS float* Bim = Bre + 64 * 16;
        LAS float* Cre = Bim + 64 * 16;
        LAS float* Cim = Cre + 16 * 64;
        if (tid < 64) {
            const int n = tid; const double lr = (double)a.in[I_LRE][g * 64 + n], li = (double)a.in[I_LIM][g * 64 + n];
            const double dt = dexp_((double)a.in[I_LDT][g]);
            const double mag = dexp_(lr * dt); double ang = li * dt; const double twopi = 6.283185307179586477; ang -= __builtin_rint(ang * 0.15915494309189533577) * twopi;
            double sn, cs; dsincos_reduced(ang, sn, cs);
            const double lre = mag * cs, lim = mag * sn;
            const double nr = lre - 1.0, ni = lim, den = lr * lr + li * li; const double rden = 1.0 / den;
            const double cfr = (nr * lr + ni * li) * rden, cfi = (ni * lr - nr * li) * rden;
            for (int c = 0; c < 16; ++c) { const double br = (double)a.in[I_BRE][(g * 64 + n) * 16 + c], bi = (double)a.in[I_BIM][(g * 64 + n) * 16 + c];
                Bre[n * 16 + c] = (float)(cfr * br - cfi * bi); Bim[n * 16 + c] = (float)(cfr * bi + cfi * br); }
            double pr = 1.0, pi = 0.0;
            for (int tau = 0; tau <= 32; ++tau) { Pre[tau * 64 + n] = (float)pr; Pim[tau * 64 + n] = (float)pi; const double t2 = pr * lre - pi * lim; pi = pr * lim + pi * lre; pr = t2; }
            if (part == 0) ((f32x2*)(ws + WS_LAML))[g * 64 + n] = (f32x2){Pre[32 * 64 + n], Pim[32 * 64 + n]};
        }
        for (int i = tid; i < 1024; i += 512) { Cre[i] = a.in[I_CRE][g * 1024 + i]; Cim[i] = a.in[I_CIM][g * 1024 + i]; }
        __syncthreads();
        float* KG = (float*)(ws + WS_KG) + (size_t)g * 32 * 256;
        { const int e = part * 512 + tid; const int tau = e >> 8, co = (e >> 4) & 15, ci = e & 15; float s = 0.f;
            for (int n = 0; n < 64; ++n) { const float pr = Pre[tau * 64 + n], pi = Pim[tau * 64 + n], br = Bre[n * 16 + ci], bi = Bim[n * 16 + ci];
                const float qr = pr * br - pi * bi, qi = pr * bi + pi * br; s += Cre[co * 64 + n] * qr - Cim[co * 64 + n] * qi; }
            KG[e] = s; }
        bf16_t* TZ = (bf16_t*)(ws + WS_TZ) + (size_t)g * S5N * S5K;
        { const int e = part * 512 + tid; const int row = e >> 4, m0 = (e & 15) * 8, j = row >> 4, co = row & 15; float v[8];
#pragma unroll
            for (int i = 0; i < 8; ++i) { const int m = m0 + i, n = m & 63; const float pr = Pre[(j + 1) * 64 + n], pi = Pim[(j + 1) * 64 + n], cr = Cre[co * 64 + n], ci = Cim[co * 64 + n];
                v[i] = (m < 64) ? (cr * pr - ci * pi) : -(cr * pi + ci * pr); }
            u32x4 o; o.x = pk2(v[0], v[1]); o.y = pk2(v[2], v[3]); o.z = pk2(v[4], v[5]); o.w = pk2(v[6], v[7]); *(u32x4*)(TZ + (size_t)row * S5K + 512 + m0) = o; }
        bf16_t* W1 = (bf16_t*)(ws + WS_W1) + (size_t)g * 256 * 512;
        for (int e = part * 1024 + tid; e < part * 1024 + 1024; e += 512) { const int m = e >> 6, s = (e & 63) >> 1, ci0 = (e & 1) * 8; float v[8];
#pragma unroll
            for (int i = 0; i < 8; ++i) { float x = 0.f;
                if (m < 128) { const int n = m & 63; const float pr = Pre[(31 - s) * 64 + n], pi = Pim[(31 - s) * 64 + n], br = Bre[n * 16 + ci0 + i], bi = Bim[n * 16 + ci0 + i];
                    x = (m < 64) ? (pr * br - pi * bi) : (pr * bi + pi * br); }
                v[i] = x; }
            u32x4 o; o.x = pk2(v[0], v[1]); o.y = pk2(v[2], v[3]); o.z = pk2(v[4], v[5]); o.w = pk2(v[6], v[7]); *(u32x4*)(W1 + (size_t)m * 512 + s * 16 + ci0) = o; }
    }
    __syncthreads();
}

__device__ __forceinline__ void phase2(const Args& a) {
    const int gt = blockIdx.x * 512 + threadIdx.x, NT = gridDim.x * 512;
    unsigned char* ws = a.ws;
    const bf16_t* COLS = (const bf16_t*)(ws + WS_A); bf16_t* LIN = (bf16_t*)(ws + WS_Z);
    const float* mu = a.in[I_MU];
    for (int p = gt; p < T * 32; p += NT) {
        const int t = p >> 5, q = p & 31;
        {
            const int c8 = q * 8, src = C_WD + c8; float cur[8], prv[8], o[8];
            unpack8(*(const u32x4*)(COLS + (size_t)t * INC + src), cur);
            if ((t & (SEQ - 1)) != 0) unpack8(*(const u32x4*)(COLS + (size_t)(t - 1) * INC + src), prv);
            else {
#pragma unroll
                for (int i = 0; i < 8; ++i) prv[i] = 0.f; }
#pragma unroll
            for (int i = 0; i < 8; ++i) { const float xs = cur[i] + (prv[i] - cur[i]) * mu[src + i]; o[i] = (c8 < 64) ? tanhf_(xs) : ((c8 < 128) ? xs : sigmoidf_(xs)); }
            *(u32x4*)(LIN + (size_t)t * 256 + c8) = pack8(o);
        }
    }
    const float* KG = (const float*)(ws + WS_KG); bf16_t* TZ = (bf16_t*)(ws + WS_TZ);
    for (int p = gt; p < 16 * 512 * 64; p += NT) {
        const int g = p >> 15, row = (p >> 6) & 511, kc = p & 63, j = row >> 4, co = row & 15, s = kc >> 1, ci0 = (kc & 1) * 8;
        u32x4 o = (u32x4){0u, 0u, 0u, 0u};
        if (s <= j) { const float* k = KG + (((size_t)g * 32 + (j - s)) * 16 + co) * 16 + ci0; const f32x4 k0 = *(const f32x4*)k, k1 = *(const f32x4*)(k + 4);
            o.x = pk2(k0[0], k0[1]); o.y = pk2(k0[2], k0[3]); o.z = pk2(k1[0], k1[1]); o.w = pk2(k1[2], k1[3]); }
        *(u32x4*)(TZ + ((size_t)g * S5N + row) * S5K + kc * 8) = o;
    }
}

__device__ __forceinline__ void phase4(const Args& a, LAS unsigned char* lds) {
    const int tid = threadIdx.x, lane = tid & 63, wave = tid >> 6;
    unsigned char* ws = a.ws;
    TSTART(4); TSTART(1);
    for (int item = blockIdx.x; item < 256; item += gridDim.x) {
        if (tid < 64) {
            const int b = item >> 4, g = item & 15, n = tid;
            const f32x2 lamL = ((const f32x2*)(ws + WS_LAML))[g * 64 + n];
            const float* E = (const float*)(ws + WS_E) + ((size_t)g * S5ROWS + b * S5NCH) * 128;
            bf16_t* UG = (bf16_t*)(ws + WS_UG) + ((size_t)g * S5ROWS + b * S5NCH) * S5K + 512;
            float xr = 0.f, xi = 0.f;
#pragma unroll 2
            for (int ch = 0; ch < S5NCH; ++ch) {
                UG[(size_t)ch * S5K + n] = (bf16_t)f2bf(xr); UG[(size_t)ch * S5K + 64 + n] = (bf16_t)f2bf(xi);
                const float er = E[ch * 128 + n], ei = E[ch * 128 + 64 + n];
                const float nr = lamL[0] * xr - lamL[1] * xi + er, ni = lamL[0] * xi + lamL[1] * xr + ei; xr = nr; xi = ni;
            }
        }
    }
    TSTOP(1);
    const bf16_t* COLS = (const bf16_t*)(ws + WS_A); const bf16_t* LORA = (const bf16_t*)a.out;
    float* Y = (float*)(ws + WS_B); float* BON = (float*)(ws + WS_BON);
    LAS float* VECF = (LAS float*)lds;
    LAS float* VKP = (LAS float*)(lds + 81920);
    LAS float* BETA = (LAS float*)(lds + 98304);
    LAS float* YST = (LAS float*)(lds + 98816);
    for (int item = blockIdx.x; item < 256; item += gridDim.x) {
        const int bh = item >> 1, half = item & 1, b = bh >> 3, h = bh & 7;
        const int pj = tid >> 4, pq = tid & 15, hc = h * 64 + 4 * pq;
        float mur[4], muk[4], muv[4], kk4[4], ka4[4], rk4[4];
#pragma unroll
        for (int i = 0; i < 4; ++i) { mur[i] = a.in[I_MU][C_R + hc + i]; muk[i] = a.in[I_MU][C_K + hc + i]; muv[i] = a.in[I_MU][C_V + hc + i];
            kk4[i] = a.in[I_KK][hc + i]; ka4[i] = a.in[I_KA][hc + i]; rk4[i] = a.in[I_RK][hc + i]; }
        const int rr = lane >> 4, cl = lane & 15;
        const bool vmine = (pq >> 3) == half;
        const int qv = pq & 7;
        u32x2 rc, rp, kc, kp, kn, vc, vp, e4, a4;
        const u32x2 zero2 = (u32x2){0u, 0u};
        __syncthreads();
#define WKV_LOAD(chunk) do { const int s_ = (chunk) * 32 + pj; const size_t t_ = (size_t)b * SEQ + s_; const bf16_t* cb_ = COLS + t_ * INC + hc; \
            rc = *(const u32x2*)(cb_ + C_R); kc = *(const u32x2*)(cb_ + C_K); vc = *(const u32x2*)(cb_ + C_V); \
            if (s_ > 0) { rp = *(const u32x2*)(cb_ - INC + C_R); kp = *(const u32x2*)(cb_ - INC + C_K); vp = *(const u32x2*)(cb_ - INC + C_V); } else { rp = zero2; kp = zero2; vp = zero2; } \
            if (s_ < SEQ - 1) kn = *(const u32x2*)(cb_ + INC + C_K); else kn = zero2; \
            e4 = *(const u32x2*)(LORA + t_ * 1536 + hc); a4 = *(const u32x2*)(LORA + t_ * 1536 + 512 + hc); } while (0)
#define WKV_PREP(chunk, bi) do { float r_[4], rq_[4], k_[4], kq_[4], kx_[4], v_[4], vq_[4], e_[4], aa_[4]; unpack4(rc, r_); unpack4(rp, rq_); unpack4(kc, k_); unpack4(kp, kq_); unpack4(kn, kx_); unpack4(vc, v_); unpack4(vp, vq_); unpack4(e4, e_); unpack4(a4, aa_); \
            float kkv_[4], kkn_[4], k2_[4], ss_ = 0.f, ssn_ = 0.f; \
            _Pragma("unroll") for (int i = 0; i < 4; ++i) { r_[i] += (rq_[i] - r_[i]) * mur[i]; kx_[i] += (k_[i] - kx_[i]) * muk[i]; k_[i] += (kq_[i] - k_[i]) * muk[i]; v_[i] += (vq_[i] - v_[i]) * muv[i]; \
                kkv_[i] = k_[i] * kk4[i]; ss_ += kkv_[i] * kkv_[i]; kkn_[i] = kx_[i] * kk4[i]; ssn_ += kkn_[i] * kkn_[i]; k2_[i] = k_[i] * (1.0f + (aa_[i] - 1.0f) * ka4[i]); } \
            ss_ = row16_sum(ss_); ssn_ = row16_sum(ssn_); \
            const float inv_ = __builtin_amdgcn_rsqf(fmaxf(ss_, 1e-24f)), invn_ = __builtin_amdgcn_rsqf(fmaxf(ssn_, 1e-24f)); \
            float bv_[4], an_[4], w_[4], cv_[4], bon_ = 0.f, beta_ = 0.f, kap_ = 0.f; \
            _Pragma("unroll") for (int i = 0; i < 4; ++i) { bv_[i] = kkv_[i] * inv_ * aa_[i]; an_[i] = -kkn_[i] * invn_; w_[i] = __expf(-e_[i]); cv_[i] = w_[i] * an_[i]; \
                bon_ += r_[i] * k2_[i] * rk4[i]; beta_ += bv_[i] * an_[i]; kap_ += k2_[i] * an_[i]; } \
            bon_ = row16_sum(bon_); beta_ = row16_sum(beta_); kap_ = row16_sum(kap_); \
            if (pq == 0 && half == 0) BON[((size_t)b * SEQ + (chunk) * 32 + pj) * 8 + h] = bon_; \
            LAS float* vf_ = VECF + (bi) * 10240 + pj * 64 + 4 * pq; \
            *(LAS f32x4*)vf_ = (f32x4){w_[0], w_[1], w_[2], w_[3]}; *(LAS f32x4*)(vf_ + 2048) = (f32x4){cv_[0], cv_[1], cv_[2], cv_[3]}; *(LAS f32x4*)(vf_ + 4096) = (f32x4){bv_[0], bv_[1], bv_[2], bv_[3]}; \
            *(LAS f32x4*)(vf_ + 6144) = (f32x4){k2_[0], k2_[1], k2_[2], k2_[3]}; *(LAS f32x4*)(vf_ + 8192) = (f32x4){r_[0], r_[1], r_[2], r_[3]}; \
            if (pq == 0) *(LAS f32x2*)(BETA + ((bi) * 32 + pj) * 2) = (f32x2){beta_, beta_}; \
            if (vmine) { LAS float* kp_ = VKP + ((((bi) * 32 + pj) * 4 + (qv >> 1)) * 4) * 4 + (qv & 1); \
                _Pragma("unroll") for (int i = 0; i < 4; ++i) { kp_[i * 4] = v_[i]; kp_[i * 4 + 2] = v_[i] * kap_; } } } while (0)
        WKV_LOAD(0); WKV_PREP(0, 0);
        __syncthreads();
        float ltv[32];
#pragma unroll
        for (int i = 0; i < 32; ++i) ltv[i] = 0.f;
        f32x2 Q0 = {0.f, 0.f}, Q1 = Q0, Q2 = Q0, Q3 = Q0, SA = Q0, YP = Q0; float yselA = 0.f, yselB = 0.f; const int clp = (cl + 1) & 15;
        for (int chunk = 0; chunk < SEQ / 32; ++chunk) {
            const int bi = chunk & 1;
            TSTART(3);
            if (chunk > 1) { const LAS float* ys = YST + (((chunk - 2) & 3) * 32 + pj) * 33 + 2 * pq;
                *(f32x2*)(Y + ((size_t)b * SEQ + (chunk - 2) * 32 + pj) * 512 + h * 64 + 32 * half + 2 * pq) = (f32x2){ys[0], ys[1]}; }
            if (chunk + 1 < SEQ / 32) WKV_LOAD(chunk + 1);
            TSTOP(3); TSTART(2);
            if (__builtin_amdgcn_readfirstlane(wave) < 4) {
            const LAS float* vecp = VECF + bi * 10240 + 4 * cl; const LAS float* vkp = VKP + ((bi * 32 * 4 + wave) * 4 + rr) * 4; const LAS float* btp = BETA + bi * 64;
            LAS float* ysp = YST + ((chunk & 3) * 32 + cl) * 33 + 8 * wave + rr;
            LAS float* ysp_prev = YST + (((chunk + 3) & 3) * 32 + 16 + cl) * 33 + 8 * wave + rr;
            f32x4 w4 = *(const LAS f32x4*)vecp, c4 = *(const LAS f32x4*)(vecp + 2048), b4 = *(const LAS f32x4*)(vecp + 4096), k4 = *(const LAS f32x4*)(vecp + 6144), r4 = *(const LAS f32x4*)(vecp + 8192);
            f32x4 vk = *(const LAS f32x4*)vkp; f32x2 be = *(const LAS f32x2*)btp;
#pragma unroll 2
            for (int j = 0; j < 32; ++j) {
                const int jn = (j + 1) & 31;
                const f32x4 w4n = *(const LAS f32x4*)(vecp + jn * 64), c4n = *(const LAS f32x4*)(vecp + 2048 + jn * 64), b4n = *(const LAS f32x4*)(vecp + 4096 + jn * 64);
                const f32x4 k4n = *(const LAS f32x4*)(vecp + 6144 + jn * 64), r4n = *(const LAS f32x4*)(vecp + 8192 + jn * 64), vkn = *(const LAS f32x4*)(vkp + jn * 64);
                const f32x2 ben = *(const LAS f32x2*)(btp + jn * 2);
                const f32x2 w01 = __builtin_shufflevector(w4, w4, 0, 1), w23 = __builtin_shufflevector(w4, w4, 2, 3), c01 = __builtin_shufflevector(c4, c4, 0, 1), c23 = __builtin_shufflevector(c4, c4, 2, 3);
                const f32x2 b01 = __builtin_shufflevector(b4, b4, 0, 1), b23 = __builtin_shufflevector(b4, b4, 2, 3), k01 = __builtin_shufflevector(k4, k4, 0, 1), k23 = __builtin_shufflevector(k4, k4, 2, 3);
                const f32x2 r01 = __builtin_shufflevector(r4, r4, 0, 1), r23 = __builtin_shufflevector(r4, r4, 2, 3), VP = __builtin_shufflevector(vk, vk, 0, 1), VK2 = __builtin_shufflevector(vk, vk, 2, 3);
                f32x2 YN;
                asm volatile(
                    "v_pk_mul_f32 v[250:251], %[Q0], %[c01] op_sel_hi:[1,0]\n\t"
                    "v_pk_mul_f32 %[Q0], %[Q0], %[w01] op_sel_hi:[1,0]\n\t"
                    "v_add_f32_dpp %[yA], %[yA], %[yA] quad_perm:[1,0,3,2] row_mask:0xf bank_mask:0xf bound_ctrl:1\n\t"
                    "v_pk_fma_f32 v[250:251], %[Q1], %[c01], v[250:251] op_sel:[0,1,0] op_sel_hi:[1,1,1]\n\t"
                    "v_pk_mul_f32 %[Q1], %[Q1], %[w01] op_sel:[0,1] op_sel_hi:[1,1]\n\t"
                    "v_add_f32_dpp %[yB], %[yB], %[yB] quad_perm:[1,0,3,2] row_mask:0xf bank_mask:0xf bound_ctrl:1\n\t"
                    "v_pk_fma_f32 v[250:251], %[Q2], %[c23], v[250:251] op_sel_hi:[1,0,1]\n\t"
                    "v_pk_mul_f32 %[Q2], %[Q2], %[w23] op_sel_hi:[1,0]\n\t"
                    "v_add_f32_dpp %[yA], %[yA], %[yA] quad_perm:[2,3,0,1] row_mask:0xf bank_mask:0xf bound_ctrl:1\n\t"
                    "v_pk_fma_f32 v[250:251], %[Q3], %[c23], v[250:251] op_sel:[0,1,0] op_sel_hi:[1,1,1]\n\t"
                    "v_pk_mul_f32 %[Q3], %[Q3], %[w23] op_sel:[0,1] op_sel_hi:[1,1]\n\t"
                    "v_add_f32_dpp %[yB], %[yB], %[yB] quad_perm:[2,3,0,1] row_mask:0xf bank_mask:0xf bound_ctrl:1\n\t"
                    "v_pk_fma_f32 %[Q0], %[VP], %[k01], %[Q0] op_sel_hi:[1,0,1]\n\t"
                    "v_add_f32_dpp v250, v250, v250 quad_perm:[1,0,3,2] row_mask:0xf bank_mask:0xf bound_ctrl:1\n\t"
                    "v_pk_fma_f32 %[Q1], %[VP], %[k01], %[Q1] op_sel:[0,1,0] op_sel_hi:[1,1,1]\n\t"
                    "v_add_f32_dpp v251, v251, v251 quad_perm:[1,0,3,2] row_mask:0xf bank_mask:0xf bound_ctrl:1\n\t"
                    "v_pk_fma_f32 %[Q2], %[VP], %[k23], %[Q2] op_sel_hi:[1,0,1]\n\t"
                    "v_add_f32_dpp %[yA], %[yA], %[yA] row_half_mirror row_mask:0xf bank_mask:0xf bound_ctrl:1\n\t"
                    "v_pk_fma_f32 %[Q3], %[VP], %[k23], %[Q3] op_sel:[0,1,0] op_sel_hi:[1,1,1]\n\t"
                    "v_add_f32_dpp v250, v250, v250 quad_perm:[2,3,0,1] row_mask:0xf bank_mask:0xf bound_ctrl:1\n\t"
                    "v_pk_fma_f32 %[Q0], %[SA], %[b01], %[Q0] op_sel_hi:[1,0,1]\n\t"
                    "v_add_f32_dpp v251, v251, v251 quad_perm:[2,3,0,1] row_mask:0xf bank_mask:0xf bound_ctrl:1\n\t"
                    "v_pk_fma_f32 %[Q1], %[SA], %[b01], %[Q1] op_sel:[0,1,0] op_sel_hi:[1,1,1]\n\t"
                    "v_add_f32_dpp %[yB], %[yB], %[yB] row_half_mirror row_mask:0xf bank_mask:0xf bound_ctrl:1\n\t"
                    "v_pk_fma_f32 %[Q2], %[SA], %[b23], %[Q2] op_sel_hi:[1,0,1]\n\t"
                    "v_add_f32_dpp v250, v250, v250 row_half_mirror row_mask:0xf bank_mask:0xf bound_ctrl:1\n\t"
                    "v_pk_fma_f32 %[Q3], %[SA], %[b23], %[Q3] op_sel:[0,1,0] op_sel_hi:[1,1,1]\n\t"
                    "v_add_f32_dpp v251, v251, v251 row_half_mirror row_mask:0xf bank_mask:0xf bound_ctrl:1\n\t"
                    "v_pk_mul_f32 %[YN], %[Q0], %[r01] op_sel_hi:[1,0]\n\t"
                    "v_add_f32_dpp %[yA], %[yA], %[yA] row_mirror row_mask:0xf bank_mask:0xf bound_ctrl:1\n\t"
                    "v_pk_fma_f32 %[YN], %[Q1], %[r01], %[YN] op_sel:[0,1,0] op_sel_hi:[1,1,1]\n\t"
                    "v_add_f32_dpp v250, v250, v250 row_mirror row_mask:0xf bank_mask:0xf bound_ctrl:1\n\t"
                    "v_add_f32_dpp %[yB], %[yB], %[yB] row_mirror row_mask:0xf bank_mask:0xf bound_ctrl:1\n\t"
                    "v_add_f32_dpp v251, v251, v251 row_mirror row_mask:0xf bank_mask:0xf bound_ctrl:1\n\t"
                    "v_pk_fma_f32 %[YN], %[Q2], %[r23], %[YN] op_sel_hi:[1,0,1]\n\t"
                    "s_nop 0\n\t"
                    "v_pk_fma_f32 %[YN], %[Q3], %[r23], %[YN] op_sel:[0,1,0] op_sel_hi:[1,1,1]\n\t"
                    "v_pk_add_f32 v[250:251], v[250:251], %[VK2]\n\t"
                    "s_nop 0\n\t"
                    "v_pk_fma_f32 %[SA], %[SA], %[be], v[250:251]\n\t"
                    : [Q0] "+v"(Q0), [Q1] "+v"(Q1), [Q2] "+v"(Q2), [Q3] "+v"(Q3), [SA] "+v"(SA), [YN] "=&v"(YN), [yA] "+v"(YP[0]), [yB] "+v"(YP[1])
                    : [c01] "v"(c01), [c23] "v"(c23), [w01] "v"(w01), [w23] "v"(w23), [k01] "v"(k01), [k23] "v"(k23), [b01] "v"(b01), [b23] "v"(b23), [r01] "v"(r01), [r23] "v"(r23),
                      [VP] "v"(VP), [VK2] "v"(VK2), [be] "v"(be)
                    : "v250", "v251");
                const bool mine = (j & 15) == clp;
                yselA = mine ? YP[0] : yselA; yselB = mine ? YP[1] : yselB;
                if ((j & 15) == 0) { LAS float* yq = (j == 0) ? ysp_prev : ysp; yq[0] = yselA; yq[4] = yselB; }
                YP = YN;
                w4 = w4n; c4 = c4n; b4 = b4n; k4 = k4n; r4 = r4n; vk = vkn; be = ben;
            }
            }
            else if (item < (int)gridDim.x) {
                const int wv4 = __builtin_amdgcn_readfirstlane(wave) - 4; LAS float* lscr = (LAS float*)(lds + (wv4 < 3 ? 131584 + wv4 * 8448 : 115712));
                const int lit_prev = (chunk - 1) * (int)(gridDim.x * 4) + (int)blockIdx.x * 4 + wv4, lit = lit_prev + (int)(gridDim.x * 4);
                if (chunk > 0 && lit_prev < N_LATE) { const TrDesc d = late_desc(a, lit_prev); tr_store(d, ltv, lscr, lane); }
                if (lit < N_LATE) { const TrDesc d = late_desc(a, lit); tr_load(d, ltv, lane); }
            }
            TSTOP(2); TSTART(3);
            if (chunk + 1 < SEQ / 32) WKV_PREP(chunk + 1, bi ^ 1);
            __syncthreads();
            TSTOP(3);
        }
        if (__builtin_amdgcn_readfirstlane(wave) < 4) {
            const float ya = row16_sum(YP[0]), yb = row16_sum(YP[1]);
            if (cl == 15) { yselA = ya; yselB = yb; }
            LAS float* yq = YST + ((((SEQ / 32) - 1) & 3) * 32 + 16 + cl) * 33 + 8 * wave + rr; yq[0] = yselA; yq[4] = yselB;
        }
        __syncthreads();
#pragma unroll
        for (int cc = SEQ / 32 - 2; cc < SEQ / 32; ++cc) { const LAS float* ys = YST + ((cc & 3) * 32 + pj) * 33 + 2 * pq;
            *(f32x2*)(Y + ((size_t)b * SEQ + cc * 32 + pj) * 512 + h * 64 + 32 * half + 2 * pq) = (f32x2){ys[0], ys[1]}; }
#undef WKV_LOAD
#undef WKV_PREP
    }
    TSTOP(4);
}


__device__ __forceinline__ void late_items_idle(const Args& a, LAS unsigned char* lds, int lo, int hi, int first_idle) {
    if ((int)blockIdx.x < first_idle) return;
    const int lane = threadIdx.x & 63, wave = __builtin_amdgcn_readfirstlane(threadIdx.x >> 6);
    float ltv[32]; LAS float* lscr = (LAS float*)(lds + wave * 16384);
    for (int it = lo + ((int)blockIdx.x - first_idle) * 8 + wave; it < hi; it += ((int)gridDim.x - first_idle) * 8) { const TrDesc d = late_desc(a, it); tr_load(d, ltv, lane); tr_store(d, ltv, lscr, lane); }
}

typedef float f32x16 __attribute__((ext_vector_type(16)));
template <int KSTEPS>
__device__ __forceinline__ f32x16 mm32(f32x16 acc, const LAS bf16_t* A, int lda, const LAS bf16_t* Bt, int ldb, int lane) {
    const int r = lane & 31, h = lane >> 5;
    const LAS bf16_t* ap = A + r * lda + 8 * h; const LAS bf16_t* bp = Bt + r * ldb + 8 * h;
#pragma unroll
    for (int ks = 0; ks < KSTEPS; ++ks) acc = __builtin_amdgcn_mfma_f32_32x32x16_bf16(*(const LAS bf16x8*)(ap + 16 * ks), *(const LAS bf16x8*)(bp + 16 * ks), acc, 0, 0, 0);
    return acc;
}
#define TROW(i, lane) (((i) & 3) + 8 * ((i) >> 2) + 4 * ((lane) >> 5))
__device__ __forceinline__ unsigned short bf1(float f) { return (unsigned short)f2bf(f); }

__device__ __forceinline__ void phase4c(const Args& a, LAS unsigned char* lds) {
    const int tid = threadIdx.x, lane = tid & 63, wave = __builtin_amdgcn_readfirstlane(tid >> 6);
    unsigned char* ws = a.ws;
    TSTART(4); TSTART(1);
    for (int item = blockIdx.x; item < 256; item += gridDim.x) {
        if (tid < 64) {
            const int b = item >> 4, g = item & 15, n = tid;
            const f32x2 lamL = ((const f32x2*)(ws + WS_LAML))[g * 64 + n];
            const float* E = (const float*)(ws + WS_E) + ((size_t)g * S5ROWS + b * S5NCH) * 128;
            bf16_t* UG = (bf16_t*)(ws + WS_UG) + ((size_t)g * S5ROWS + b * S5NCH) * S5K + 512;
            float xr = 0.f, xi = 0.f;
#pragma unroll 8
            for (int ch = 0; ch < S5NCH; ++ch) {
                UG[(size_t)ch * S5K + n] = (bf16_t)f2bf(xr); UG[(size_t)ch * S5K + 64 + n] = (bf16_t)f2bf(xi);
                const float er = E[ch * 128 + n], ei = E[ch * 128 + 64 + n];
                const float nr = lamL[0] * xr - lamL[1] * xi + er, ni = lamL[0] * xi + lamL[1] * xr + ei; xr = nr; xi = ni;
            }
        }
    }
    TSTOP(1);
    if (gridDim.x != 256) { late_items_idle(a, lds, 0, N_LATE, 0); __syncthreads(); }
    const bf16_t* COLS = (const bf16_t*)(ws + WS_A); const bf16_t* LORA = (const bf16_t*)a.out;
    float* Y = (float*)(ws + WS_B); float* BON = (float*)(ws + WS_BON);
    LAS float* CUM = (LAS float*)lds;
    LAS float* PS = (LAS float*)(lds + 8192);
    LAS bf16_t* AT = (LAS bf16_t*)(lds + 10240);
    LAS bf16_t* BT = (LAS bf16_t*)(lds + 14848);
    LAS bf16_t* KT = (LAS bf16_t*)(lds + 19456);
    LAS bf16_t* RT = (LAS bf16_t*)(lds + 24064);
    LAS bf16_t* BTt = (LAS bf16_t*)(lds + 28672);
    LAS bf16_t* VmT = (LAS bf16_t*)(lds + 33792);
    LAS float* NabT = (LAS float*)(lds + 36352);
    LAS float* Nak = (LAS float*)(lds + 40960);
    LAS bf16_t* MbrT = (LAS bf16_t*)(lds + 45184);
    LAS bf16_t* A2 = (LAS bf16_t*)(lds + 47744);
    LAS bf16_t* NT = (LAS bf16_t*)(lds + 52864);
    LAS bf16_t* WyT = (LAS bf16_t*)(lds + 55424);
    LAS bf16_t* WzT = (LAS bf16_t*)(lds + 57984);
    LAS bf16_t* R2T = (LAS bf16_t*)(lds + 63104);
    LAS bf16_t* PpT = (LAS bf16_t*)(lds + 67712);
    LAS float* GC = (LAS float*)(lds + 76928);
    LAS bf16_t* SBF = (LAS bf16_t*)(lds + 77184);
    LAS float* YST = (LAS float*)(lds + 86400);
    for (int item = blockIdx.x; item < 256; item += gridDim.x) {
        const int bh = item >> 1, half = item & 1, b = bh >> 3, h = bh & 7;
        const int pj = tid >> 4, pq = tid & 15, hc = h * 64 + 4 * pq;
        const bool vmine = (pq >> 3) == half;
        u32x2 rc, rp, kc, kp, vc, vp, e4, a4;
        const u32x2 zero2 = (u32x2){0u, 0u};
        f32x16 Sacc;
#pragma unroll
        for (int i = 0; i < 16; ++i) Sacc[i] = 0.f;
        __syncthreads();
        for (int i = tid; i < 2 * 32 * 72 / 2; i += 512) ((LAS unsigned*)SBF)[i] = 0u;
#define WKV_LOAD(chunk) do { const int s_ = (chunk) * 32 + pj; const size_t t_ = (size_t)b * SEQ + s_; const bf16_t* cb_ = COLS + t_ * INC + hc; \
            rc = *(const u32x2*)(cb_ + C_R); kc = *(const u32x2*)(cb_ + C_K); vc = *(const u32x2*)(cb_ + C_V); \
            if (s_ > 0) { rp = *(const u32x2*)(cb_ - INC + C_R); kp = *(const u32x2*)(cb_ - INC + C_K); vp = *(const u32x2*)(cb_ - INC + C_V); } else { rp = zero2; kp = zero2; vp = zero2; } \
            e4 = *(const u32x2*)(LORA + t_ * 1536 + hc); a4 = *(const u32x2*)(LORA + t_ * 1536 + 512 + hc); } while (0)
        WKV_LOAD(0);
        for (int chunk = 0; chunk < SEQ / 32; ++chunk) {
            const int bi = chunk & 1;
            int tid_l = tid; asm volatile("" : "+v"(tid_l));
            const int lane = tid_l & 63, pj = tid_l >> 4, pq = tid_l & 15, tid = tid_l; (void)tid;
            float r_[4], k_[4], v_[4], e_[4], aa_[4], kkn_[4], k2_[4];
            { float rq_[4], kq_[4], vq_[4];
                const f32x4 mur = *(const f32x4*)(a.in[I_MU] + C_R + hc), muk = *(const f32x4*)(a.in[I_MU] + C_K + hc), muv = *(const f32x4*)(a.in[I_MU] + C_V + hc);
                const f32x4 kk4 = *(const f32x4*)(a.in[I_KK] + hc), ka4 = *(const f32x4*)(a.in[I_KA] + hc), rk4 = *(const f32x4*)(a.in[I_RK] + hc); unpack4(rc, r_); unpack4(rp, rq_); unpack4(kc, k_); unpack4(kp, kq_); unpack4(vc, v_); unpack4(vp, vq_); unpack4(e4, e_); unpack4(a4, aa_);
                float ss_ = 0.f, bon_ = 0.f;
#pragma unroll
                for (int i = 0; i < 4; ++i) { r_[i] += (rq_[i] - r_[i]) * mur[i]; k_[i] += (kq_[i] - k_[i]) * muk[i]; v_[i] += (vq_[i] - v_[i]) * muv[i];
                    kkn_[i] = k_[i] * kk4[i]; ss_ += kkn_[i] * kkn_[i]; k2_[i] = k_[i] * (1.0f + (aa_[i] - 1.0f) * ka4[i]); bon_ += r_[i] * k2_[i] * rk4[i]; }
                ss_ = row16_sum(ss_); bon_ = row16_sum(bon_); const float inv_ = __builtin_amdgcn_rsqf(fmaxf(ss_, 1e-24f));
#pragma unroll
                for (int i = 0; i < 4; ++i) kkn_[i] *= inv_;
                if (pq == 0 && half == 0) BON[((size_t)b * SEQ + chunk * 32 + pj) * 8 + h] = bon_;
                *(LAS f32x4*)(CUM + pj * 64 + 4 * pq) = (f32x4){e_[0], e_[1], e_[2], e_[3]}; }
            if (chunk + 1 < SEQ / 32) WKV_LOAD(chunk + 1);
            __syncthreads();
            {
                const int col = tid & 63, qd = tid >> 6; float e0 = CUM[(4 * qd) * 64 + col], e1 = CUM[(4 * qd + 1) * 64 + col], e2 = CUM[(4 * qd + 2) * 64 + col], e3 = CUM[(4 * qd + 3) * 64 + col];
                e1 += e0; e2 += e1; e3 += e2; PS[qd * 64 + col] = e3;
                __syncthreads();
                float base = 0.f;
#pragma unroll
                for (int q2 = 0; q2 < 7; ++q2) base += (q2 < qd) ? PS[q2 * 64 + col] : 0.f;
                CUM[(4 * qd) * 64 + col] = base + e0; CUM[(4 * qd + 1) * 64 + col] = base + e1; CUM[(4 * qd + 2) * 64 + col] = base + e2; CUM[(4 * qd + 3) * 64 + col] = base + e3; }
            __syncthreads();
            {
                const f32x4 cm = *(const LAS f32x4*)(CUM + pj * 64 + 4 * pq); float at_[4], bt_[4], kt_[4], rt_[4], g_[4];
#pragma unroll
                for (int i = 0; i < 4; ++i) { const float g = __expf(-cm[i]), ig = __expf(cm[i]), gp = __expf(e_[i] - cm[i]); g_[i] = g;
                    at_[i] = -kkn_[i] * gp; bt_[i] = kkn_[i] * aa_[i] * ig; kt_[i] = k2_[i] * ig; rt_[i] = r_[i] * g; }
                *(LAS u32x2*)(AT + pj * 72 + 4 * pq) = (u32x2){cvt_pk_bf16(at_[0], at_[1]), cvt_pk_bf16(at_[2], at_[3])};
                *(LAS u32x2*)(BT + pj * 72 + 4 * pq) = (u32x2){cvt_pk_bf16(bt_[0], bt_[1]), cvt_pk_bf16(bt_[2], bt_[3])};
                *(LAS u32x2*)(KT + pj * 72 + 4 * pq) = (u32x2){cvt_pk_bf16(kt_[0], kt_[1]), cvt_pk_bf16(kt_[2], kt_[3])};
                *(LAS u32x2*)(RT + pj * 72 + 4 * pq) = (u32x2){cvt_pk_bf16(rt_[0], rt_[1]), cvt_pk_bf16(rt_[2], rt_[3])};
#pragma unroll
                for (int i = 0; i < 4; ++i) BTt[(4 * pq + i) * 40 + pj] = bf1(bt_[i]);
                if (vmine) {
#pragma unroll
                    for (int i = 0; i < 4; ++i) VmT[(4 * pq - 32 * half + i) * 40 + pj] = bf1(v_[i]); }
                if (pj == 31) *(LAS f32x4*)(GC + 4 * pq) = (f32x4){g_[0], g_[1], g_[2], g_[3]}; }
            __syncthreads();
            f32x16 accw;
#pragma unroll
            for (int i = 0; i < 16; ++i) accw[i] = 0.f;
            if (wave < 4) {
                f32x16 acc;
#pragma unroll
                for (int i = 0; i < 16; ++i) acc[i] = 0.f;
                acc = mm32<4>(acc, (wave & 1) ? KT : BT, 72, (wave & 2) ? RT : AT, 72, lane);
                const int t = lane & 31;
                if (wave == 0) {
#pragma unroll
                    for (int g4 = 0; g4 < 4; ++g4) { const int s0 = 8 * g4 + 4 * (lane >> 5);
#pragma unroll
                        for (int i = 0; i < 4; ++i) NabT[t * 36 + i * 8 + 2 * g4 + (lane >> 5)] = (s0 + i < t) ? acc[4 * g4 + i] : 0.f; }
                } else if (wave == 1) {
#pragma unroll
                    for (int i = 0; i < 16; ++i) { const int s = TROW(i, lane); Nak[s * 33 + t] = (s < t) ? acc[i] : 0.f; }
                } else if (wave == 2) {
#pragma unroll
                    for (int g4 = 0; g4 < 4; ++g4) { const int s0 = 8 * g4 + 4 * (lane >> 5); float o[4];
#pragma unroll
                        for (int i = 0; i < 4; ++i) o[i] = (s0 + i <= t) ? acc[4 * g4 + i] : 0.f;
                        *(LAS u32x2*)(MbrT + t * 40 + s0) = (u32x2){cvt_pk_bf16(o[0], o[1]), cvt_pk_bf16(o[2], o[3])}; }
                } else {
#pragma unroll
                    for (int i = 0; i < 16; ++i) { const int s = TROW(i, lane); accw[i] = (s <= t) ? acc[i] : 0.f; }
                }
            }
            __syncthreads();
            if (wave < 6) {
                const int q = lane & 3, rowi = ((wave & 3) * 64 + lane) >> 2; const bool isA = wave < 4;
                float xq0, xq1, xq2, xq3, xq4, xq5, xq6, xq7;
                if (isA) {
                    xq0 = __builtin_bit_cast(float, (unsigned)AT[(0 + q) * 72 + rowi] << 16);
                    xq1 = __builtin_bit_cast(float, (unsigned)AT[(4 + q) * 72 + rowi] << 16);
                    xq2 = __builtin_bit_cast(float, (unsigned)AT[(8 + q) * 72 + rowi] << 16);
                    xq3 = __builtin_bit_cast(float, (unsigned)AT[(12 + q) * 72 + rowi] << 16);
                    xq4 = __builtin_bit_cast(float, (unsigned)AT[(16 + q) * 72 + rowi] << 16);
                    xq5 = __builtin_bit_cast(float, (unsigned)AT[(20 + q) * 72 + rowi] << 16);
                    xq6 = __builtin_bit_cast(float, (unsigned)AT[(24 + q) * 72 + rowi] << 16);
                    xq7 = __builtin_bit_cast(float, (unsigned)AT[(28 + q) * 72 + rowi] << 16);
                } else {
                    xq0 = Nak[rowi * 33 + 0 + q];
                    xq1 = Nak[rowi * 33 + 4 + q];
                    xq2 = Nak[rowi * 33 + 8 + q];
                    xq3 = Nak[rowi * 33 + 12 + q];
                    xq4 = Nak[rowi * 33 + 16 + q];
                    xq5 = Nak[rowi * 33 + 20 + q];
                    xq6 = Nak[rowi * 33 + 24 + q];
                    xq7 = Nak[rowi * 33 + 28 + q];
                }
                const bool kq0 = q == 0, kq1 = q == 1, kq2 = q == 2, kq3 = q == 3;
                const LAS float* np_ = NabT + q * 8;
                f32x4 n1_0, n2_0, n3_0, n4_0, n5_0, n6_0, n7_0, n8_0, n9_0, n10_0, n11_0, n12_0, n13_0, n14_0, n15_0, n16_0, n17_0, n17_1, n18_0, n18_1, n19_0, n19_1, n20_0, n20_1, n21_0, n21_1, n22_0, n22_1, n23_0, n23_1, n24_0, n24_1, n25_0, n25_1, n26_0, n26_1, n27_0, n27_1, n28_0, n28_1, n29_0, n29_1, n30_0, n30_1, n31_0, n31_1;
                float pe1, pe2, pe3, pe4, pe5, pe6, pe7, pe8, pe9, pe10, pe11, pe12, pe13, pe14, pe15, pe16, pe17, pe18, pe19, pe20, pe21, pe22, pe23, pe24, pe25, pe26, pe27, pe28, pe29, pe30, pe31, pe32;
                n1_0 = *(const LAS f32x4*)(np_ + 1 * 36); n2_0 = *(const LAS f32x4*)(np_ + 2 * 36); pe1 = 0.f;
                { n3_0 = *(const LAS f32x4*)(np_ + 3 * 36); float p = pe1; asm("v_fmac_f32 %0, %1, %2" : "+v"(p) : "v"(xq0), "v"(n1_0[0])); p += dpp_f(p, 0); pe2 = 0.f; p += dpp_f(p, 1); xq0 = kq1 ? (xq0 + p) : xq0; asm volatile("" : "+v"(xq0), "+v"(np_) : "v"(n1_0)); }
                { n4_0 = *(const LAS f32x4*)(np_ + 4 * 36); float p = pe2; asm("v_fmac_f32 %0, %1, %2" : "+v"(p) : "v"(xq0), "v"(n2_0[0])); p += dpp_f(p, 0); pe3 = 0.f; p += dpp_f(p, 1); xq0 = kq2 ? (xq0 + p) : xq0; asm volatile("" : "+v"(xq0), "+v"(np_) : "v"(n2_0)); }
                { n5_0 = *(const LAS f32x4*)(np_ + 5 * 36); float p = pe3; asm("v_fmac_f32 %0, %1, %2" : "+v"(p) : "v"(xq0), "v"(n3_0[0])); p += dpp_f(p, 0); pe4 = 0.f; p += dpp_f(p, 1); xq0 = kq3 ? (xq0 + p) : xq0; asm volatile("" : "+v"(xq0), "+v"(np_) : "v"(n3_0)); }
                { n6_0 = *(const LAS f32x4*)(np_ + 6 * 36); float p = pe4; asm("v_fmac_f32 %0, %1, %2" : "+v"(p) : "v"(xq0), "v"(n4_0[0])); p += dpp_f(p, 0); pe5 = 0.f; asm("v_fmac_f32 %0, %1, %2" : "+v"(pe5) : "v"(xq0), "v"(n5_0[0])); p += dpp_f(p, 1); xq1 = kq0 ? (xq1 + p) : xq1; asm volatile("" : "+v"(xq1), "+v"(np_) : "v"(n4_0)); }
                { n7_0 = *(const LAS f32x4*)(np_ + 7 * 36); float p = pe5; asm("v_fmac_f32 %0, %1, %2" : "+v"(p) : "v"(xq1), "v"(n5_0[1])); p += dpp_f(p, 0); pe6 = 0.f; asm("v_fmac_f32 %0, %1, %2" : "+v"(pe6) : "v"(xq0), "v"(n6_0[0])); p += dpp_f(p, 1); xq1 = kq1 ? (xq1 + p) : xq1; asm volatile("" : "+v"(xq1), "+v"(np_) : "v"(n5_0)); }
                { n8_0 = *(const LAS f32x4*)(np_ + 8 * 36); float p = pe6; asm("v_fmac_f32 %0, %1, %2" : "+v"(p) : "v"(xq1), "v"(n6_0[1])); p += dpp_f(p, 0); pe7 = 0.f; asm("v_fmac_f32 %0, %1, %2" : "+v"(pe7) : "v"(xq0), "v"(n7_0[0])); p += dpp_f(p, 1); xq1 = kq2 ? (xq1 + p) : xq1; asm volatile("" : "+v"(xq1), "+v"(np_) : "v"(n6_0)); }
                { n9_0 = *(const LAS f32x4*)(np_ + 9 * 36); float p = pe7; asm("v_fmac_f32 %0, %1, %2" : "+v"(p) : "v"(xq1), "v"(n7_0[1])); p += dpp_f(p, 0); pe8 = 0.f; asm("v_fmac_f32 %0, %1, %2" : "+v"(pe8) : "v"(xq0), "v"(n8_0[0])); p += dpp_f(p, 1); xq1 = kq3 ? (xq1 + p) : xq1; asm volatile("" : "+v"(xq1), "+v"(np_) : "v"(n7_0)); }
                { n10_0 = *(const LAS f32x4*)(np_ + 10 * 36); float p = pe8; asm("v_fmac_f32 %0, %1, %2" : "+v"(p) : "v"(xq1), "v"(n8_0[1])); p += dpp_f(p, 0); pe9 = 0.f; asm("v_fmac_f32 %0, %1, %2" : "+v"(pe9) : "v"(xq0), "v"(n9_0[0])); asm("v_fmac_f32 %0, %1, %2" : "+v"(pe9) : "v"(xq1), "v"(n9_0[1])); p += dpp_f(p, 1); xq2 = kq0 ? (xq2 + p) : xq2; asm volatile("" : "+v"(xq2), "+v"(np_) : "v"(n8_0)); }
                { n11_0 = *(const LAS f32x4*)(np_ + 11 * 36); float p = pe9; asm("v_fmac_f32 %0, %1, %2" : "+v"(p) : "v"(xq2), "v"(n9_0[2])); p += dpp_f(p, 0); pe10 = 0.f; asm("v_fmac_f32 %0, %1, %2" : "+v"(pe10) : "v"(xq0), "v"(n10_0[0])); asm("v_fmac_f32 %0, %1, %2" : "+v"(pe10) : "v"(xq1), "v"(n10_0[1])); p += dpp_f(p, 1); xq2 = kq1 ? (xq2 + p) : xq2; asm volatile("" : "+v"(xq2), "+v"(np_) : "v"(n9_0)); }
                { n12_0 = *(const LAS f32x4*)(np_ + 12 * 36); float p = pe10; asm("v_fmac_f32 %0, %1, %2" : "+v"(p) : "v"(xq2), "v"(n10_0[2])); p += dpp_f(p, 0); pe11 = 0.f; asm("v_fmac_f32 %0, %1, %2" : "+v"(pe11) : "v"(xq0), "v"(n11_0[0])); asm("v_fmac_f32 %0, %1, %2" : "+v"(pe11) : "v"(xq1), "v"(n11_0[1])); p += dpp_f(p, 1); xq2 = kq2 ? (xq2 + p) : xq2; asm volatile("" : "+v"(xq2), "+v"(np_) : "v"(n10_0)); }
                { n13_0 = *(const LAS f32x4*)(np_ + 13 * 36); float p = pe11; asm("v_fmac_f32 %0, %1, %2" : "+v"(p) : "v"(xq2), "v"(n11_0[2])); p += dpp_f(p, 0); pe12 = 0.f; asm("v_fmac_f32 %0, %1, %2" : "+v"(pe12) : "v"(xq0), "v"(n12_0[0])); asm("v_fmac_f32 %0, %1, %2" : "+v"(pe12) : "v"(xq1), "v"(n12_0[1])); p += dpp_f(p, 1); xq2 = kq3 ? (xq2 + p) : xq2; asm volatile("" : "+v"(xq2), "+v"(np_) : "v"(n11_0)); }
                { n14_0 = *(const LAS f32x4*)(np_ + 14 * 36); float p = pe12; asm("v_fmac_f32 %0, %1, %2" : "+v"(p) : "v"(xq2), "v"(n12_0[2])); p += dpp_f(p, 0); pe13 = 0.f; asm("v_fmac_f32 %0, %1, %2" : "+v"(pe13) : "v"(xq0), "v"(n13_0[0])); asm("v_fmac_f32 %0, %1, %2" : "+v"(pe13) : "v"(xq1), "v"(n13_0[1])); asm("v_fmac_f32 %0, %1, %2" : "+v"(pe13) : "v"(xq2), "v"(n13_0[2])); p += dpp_f(p, 1); xq3 = kq0 ? (xq3 + p) : xq3; asm volatile("" : "+v"(xq3), "+v"(np_) : "v"(n12_0)); }
                { n15_0 = *(const LAS f32x4*)(np_ + 15 * 36); float p = pe13; asm("v_fmac_f32 %0, %1, %2" : "+v"(p) : "v"(xq3), "v"(n13_0[3])); p += dpp_f(p, 0); pe14 = 0.f; asm("v_fmac_f32 %0, %1, %2" : "+v"(pe14) : "v"(xq0), "v"(n14_0[0])); asm("v_fmac_f32 %0, %1, %2" : "+v"(pe14) : "v"(xq1), "v"(n14_0[1])); asm("v_fmac_f32 %0, %1, %2" : "+v"(pe14) : "v"(xq2), "v"(n14_0[2])); p += dpp_f(p, 1); xq3 = kq1 ? (xq3 + p) : xq3; asm volatile("" : "+v"(xq3), "+v"(np_) : "v"(n13_0)); }
                { n16_0 = *(const LAS f32x4*)(np_ + 16 * 36); float p = pe14; asm("v_fmac_f32 %0, %1, %2" : "+v"(p) : "v"(xq3), "v"(n14_0[3])); p += dpp_f(p, 0); pe15 = 0.f; asm("v_fmac_f32 %0, %1, %2" : "+v"(pe15) : "v"(xq0), "v"(n15_0[0])); asm("v_fmac_f32 %0, %1, %2" : "+v"(pe15) : "v"(xq1), "v"(n15_0[1])); asm("v_fmac_f32 %0, %1, %2" : "+v"(pe15) : "v"(xq2), "v"(n15_0[2])); p += dpp_f(p, 1); xq3 = kq2 ? (xq3 + p) : xq3; asm volatile("" : "+v"(xq3), "+v"(np_) : "v"(n14_0)); }
                { n17_0 = *(const LAS f32x4*)(np_ + 17 * 36); n17_1 = *(const LAS f32x4*)(np_ + 17 * 36 + 4); float p = pe15; asm("v_fmac_f32 %0, %1, %2" : "+v"(p) : "v"(xq3), "v"(n15_0[3])); p += dpp_f(p, 0); pe16 = 0.f; asm("v_fmac_f32 %0, %1, %2" : "+v"(pe16) : "v"(xq0), "v"(n16_0[0])); asm("v_fmac_f32 %0, %1, %2" : "+v"(pe16) : "v"(xq1), "v"(n16_0[1])); asm("v_fmac_f32 %0, %1, %2" : "+v"(pe16) : "v"(xq2), "v"(n16_0[2])); p += dpp_f(p, 1); xq3 = kq3 ? (xq3 + p) : xq3; asm volatile("" : "+v"(xq3), "+v"(np_) : "v"(n15_0)); }
                { n18_0 = *(const LAS f32x4*)(np_ + 18 * 36); n18_1 = *(const LAS f32x4*)(np_ + 18 * 36 + 4); float p = pe16; asm("v_fmac_f32 %0, %1, %2" : "+v"(p) : "v"(xq3), "v"(n16_0[3])); p += dpp_f(p, 0); pe17 = 0.f; asm("v_fmac_f32 %0, %1, %2" : "+v"(pe17) : "v"(xq0), "v"(n17_0[0])); asm("v_fmac_f32 %0, %1, %2" : "+v"(pe17) : "v"(xq1), "v"(n17_0[1])); asm("v_fmac_f32 %0, %1, %2" : "+v"(pe17) : "v"(xq2), "v"(n17_0[2])); asm("v_fmac_f32 %0, %1, %2" : "+v"(pe17) : "v"(xq3), "v"(n17_0[3])); p += dpp_f(p, 1); xq4 = kq0 ? (xq4 + p) : xq4; asm volatile("" : "+v"(xq4), "+v"(np_) : "v"(n16_0)); }
                { n19_0 = *(const LAS f32x4*)(np_ + 19 * 36); n19_1 = *(const LAS f32x4*)(np_ + 19 * 36 + 4); float p = pe17; asm("v_fmac_f32 %0, %1, %2" : "+v"(p) : "v"(xq4), "v"(n17_1[0])); p += dpp_f(p, 0); pe18 = 0.f; asm("v_fmac_f32 %0, %1, %2" : "+v"(pe18) : "v"(xq0), "v"(n18_0[0])); asm("v_fmac_f32 %0, %1, %2" : "+v"(pe18) : "v"(xq1), "v"(n18_0[1])); asm("v_fmac_f32 %0, %1, %2" : "+v"(pe18) : "v"(xq2), "v"(n18_0[2])); asm("v_fmac_f32 %0, %1, %2" : "+v"(pe18) : "v"(xq3), "v"(n18_0[3])); p += dpp_f(p, 1); xq4 = kq1 ? (xq4 + p) : xq4; asm volatile("" : "+v"(xq4), "+v"(np_) : "v"(n17_0), "v"(n17_1)); }
                { n20_0 = *(const LAS f32x4*)(np_ + 20 * 36); n20_1 = *(const LAS f32x4*)(np_ + 20 * 36 + 4); float p = pe18; asm("v_fmac_f32 %0, %1, %2" : "+v"(p) : "v"(xq4), "v"(n18_1[0])); p += dpp_f(p, 0); pe19 = 0.f; asm("v_fmac_f32 %0, %1, %2" : "+v"(pe19) : "v"(xq0), "v"(n19_0[0])); asm("v_fmac_f32 %0, %1, %2" : "+v"(pe19) : "v"(xq1), "v"(n19_0[1])); asm("v_fmac_f32 %0, %1, %2" : "+v"(pe19) : "v"(xq2), "v"(n19_0[2])); asm("v_fmac_f32 %0, %1, %2" : "+v"(pe19) : "v"(xq3), "v"(n19_0[3])); p += dpp_f(p, 1); xq4 = kq2 ? (xq4 + p) : xq4; asm volatile("" : "+v"(xq4), "+v"(np_) : "v"(n18_0), "v"(n18_1)); }
                { n21_0 = *(const LAS f32x4*)(np_ + 21 * 36); n21_1 = *(const LAS f32x4*)(np_ + 21 * 36 + 4); float p = pe19; asm("v_fmac_f32 %0, %1, %2" : "+v"(p) : "v"(xq4), "v"(n19_1[0])); p += dpp_f(p, 0); pe20 = 0.f; asm("v_fmac_f32 %0, %1, %2" : "+v"(pe20) : "v"(xq0), "v"(n20_0[0])); asm("v_fmac_f32 %0, %1, %2" : "+v"(pe20) : "v"(xq1), "v"(n20_0[1])); asm("v_fmac_f32 %0, %1, %2" : "+v"(pe20) : "v"(xq2), "v"(n20_0[2])); asm("v_fmac_f32 %0, %1, %2" : "+v"(pe20) : "v"(xq3), "v"(n20_0[3])); p += dpp_f(p, 1); xq4 = kq3 ? (xq4 + p) : xq4; asm volatile("" : "+v"(xq4), "+v"(np_) : "v"(n19_0), "v"(n19_1)); }
                { n22_0 = *(const LAS f32x4*)(np_ + 22 * 36); n22_1 = *(const LAS f32x4*)(np_ + 22 * 36 + 4); float p = pe20; asm("v_fmac_f32 %0, %1, %2" : "+v"(p) : "v"(xq4), "v"(n20_1[0])); p += dpp_f(p, 0); pe21 = 0.f; asm("v_fmac_f32 %0, %1, %2" : "+v"(pe21) : "v"(xq0), "v"(n21_0[0])); asm("v_fmac_f32 %0, %1, %2" : "+v"(pe21) : "v"(xq1), "v"(n21_0[1])); asm("v_fmac_f32 %0, %1, %2" : "+v"(pe21) : "v"(xq2), "v"(n21_0[2])); asm("v_fmac_f32 %0, %1, %2" : "+v"(pe21) : "v"(xq3), "v"(n21_0[3])); asm("v_fmac_f32 %0, %1, %2" : "+v"(pe21) : "v"(xq4), "v"(n21_1[0])); p += dpp_f(p, 1); xq5 = kq0 ? (xq5 + p) : xq5; asm volatile("" : "+v"(xq5), "+v"(np_) : "v"(n20_0), "v"(n20_1)); }
                { n23_0 = *(const LAS f32x4*)(np_ + 23 * 36); n23_1 = *(const LAS f32x4*)(np_ + 23 * 36 + 4); float p = pe21; asm("v_fmac_f32 %0, %1, %2" : "+v"(p) : "v"(xq5), "v"(n21_1[1])); p += dpp_f(p, 0); pe22 = 0.f; asm("v_fmac_f32 %0, %1, %2" : "+v"(pe22) : "v"(xq0), "v"(n22_0[0])); asm("v_fmac_f32 %0, %1, %2" : "+v"(pe22) : "v"(xq1), "v"(n22_0[1])); asm("v_fmac_f32 %0, %1, %2" : "+v"(pe22) : "v"(xq2), "v"(n22_0[2])); asm("v_fmac_f32 %0, %1, %2" : "+v"(pe22) : "v"(xq3), "v"(n22_0[3])); asm("v_fmac_f32 %0, %1, %2" : "+v"(pe22) : "v"(xq4), "v"(n22_1[0])); p += dpp_f(p, 1); xq5 = kq1 ? (xq5 + p) : xq5; asm volatile("" : "+v"(xq5), "+v"(np_) : "v"(n21_0), "v"(n21_1)); }
                { n24_0 = *(const LAS f32x4*)(np_ + 24 * 36); n24_1 = *(const LAS f32x4*)(np_ + 24 * 36 + 4); float p = pe22; asm("v_fmac_f32 %0, %1, %2" : "+v"(p) : "v"(xq5), "v"(n22_1[1])); p += dpp_f(p, 0); pe23 = 0.f; asm("v_fmac_f32 %0, %1, %2" : "+v"(pe23) : "v"(xq0), "v"(n23_0[0])); asm("v_fmac_f32 %0, %1, %2" : "+v"(pe23) : "v"(xq1), "v"(n23_0[1])); asm("v_fmac_f32 %0, %1, %2" : "+v"(pe23) : "v"(xq2), "v"(n23_0[2])); asm("v_fmac_f32 %0, %1, %2" : "+v"(pe23) : "v"(xq3), "v"(n23_0[3])); asm("v_fmac_f32 %0, %1, %2" : "+v"(pe23) : "v"(xq4), "v"(n23_1[0])); p += dpp_f(p, 1); xq5 = kq2 ? (xq5 + p) : xq5; asm volatile("" : "+v"(xq5), "+v"(np_) : "v"(n22_0), "v"(n22_1)); }
                { n25_0 = *(const LAS f32x4*)(np_ + 25 * 36); n25_1 = *(const LAS f32x4*)(np_ + 25 * 36 + 4); float p = pe23; asm("v_fmac_f32 %0, %1, %2" : "+v"(p) : "v"(xq5), "v"(n23_1[1])); p += dpp_f(p, 0); pe24 = 0.f; asm("v_fmac_f32 %0, %1, %2" : "+v"(pe24) : "v"(xq0), "v"(n24_0[0])); asm("v_fmac_f32 %0, %1, %2" : "+v"(pe24) : "v"(xq1), "v"(n24_0[1])); asm("v_fmac_f32 %0, %1, %2" : "+v"(pe24) : "v"(xq2), "v"(n24_0[2])); asm("v_fmac_f32 %0, %1, %2" : "+v"(pe24) : "v"(xq3), "v"(n24_0[3])); asm("v_fmac_f32 %0, %1, %2" : "+v"(pe24) : "v"(xq4), "v"(n24_1[0])); p += dpp_f(p, 1); xq5 = kq3 ? (xq5 + p) : xq5; asm volatile("" : "+v"(xq5), "+v"(np_) : "v"(n23_0), "v"(n23_1)); }
                { n26_0 = *(const LAS f32x4*)(np_ + 26 * 36); n26_1 = *(const LAS f32x4*)(np_ + 26 * 36 + 4); float p = pe24; asm("v_fmac_f32 %0, %1, %2" : "+v"(p) : "v"(xq5), "v"(n24_1[1])); p += dpp_f(p, 0); pe25 = 0.f; asm("v_fmac_f32 %0, %1, %2" : "+v"(pe25) : "v"(xq0), "v"(n25_0[0])); asm("v_fmac_f32 %0, %1, %2" : "+v"(pe25) : "v"(xq1), "v"(n25_0[1])); asm("v_fmac_f32 %0, %1, %2" : "+v"(pe25) : "v"(xq2), "v"(n25_0[2])); asm("v_fmac_f32 %0, %1, %2" : "+v"(pe25) : "v"(xq3), "v"(n25_0[3])); asm("v_fmac_f32 %0, %1, %2" : "+v"(pe25) : "v"(xq4), "v"(n25_1[0])); asm("v_fmac_f32 %0, %1, %2" : "+v"(pe25) : "v"(xq5), "v"(n25_1[1])); p += dpp_f(p, 1); xq6 = kq0 ? (xq6 + p) : xq6; asm volatile("" : "+v"(xq6), "+v"(np_) : "v"(n24_0), "v"(n24_1)); }
                { n27_0 = *(const LAS f32x4*)(np_ + 27 * 36); n27_1 = *(const LAS f32x4*)(np_ + 27 * 36 + 4); float p = pe25; asm("v_fmac_f32 %0, %1, %2" : "+v"(p) : "v"(xq6), "v"(n25_1[2])); p += dpp_f(p, 0); pe26 = 0.f; asm("v_fmac_f32 %0, %1, %2" : "+v"(pe26) : "v"(xq0), "v"(n26_0[0])); asm("v_fmac_f32 %0, %1, %2" : "+v"(pe26) : "v"(xq1), "v"(n26_0[1])); asm("v_fmac_f32 %0, %1, %2" : "+v"(pe26) : "v"(xq2), "v"(n26_0[2])); asm("v_fmac_f32 %0, %1, %2" : "+v"(pe26) : "v"(xq3), "v"(n26_0[3])); asm("v_fmac_f32 %0, %1, %2" : "+v"(pe26) : "v"(xq4), "v"(n26_1[0])); asm("v_fmac_f32 %0, %1, %2" : "+v"(pe26) : "v"(xq5), "v"(n26_1[1])); p += dpp_f(p, 1); xq6 = kq1 ? (xq6 + p) : xq6; asm volatile("" : "+v"(xq6), "+v"(np_) : "v"(n25_0), "v"(n25_1)); }
                { n28_0 = *(const LAS f32x4*)(np_ + 28 * 36); n28_1 = *(const LAS f32x4*)(np_ + 28 * 36 + 4); float p = pe26; asm("v_fmac_f32 %0, %1, %2" : "+v"(p) : "v"(xq6), "v"(n26_1[2])); p += dpp_f(p, 0); pe27 = 0.f; asm("v_fmac_f32 %0, %1, %2" : "+v"(pe27) : "v"(xq0), "v"(n27_0[0])); asm("v_fmac_f32 %0, %1, %2" : "+v"(pe27) : "v"(xq1), "v"(n27_0[1])); asm("v_fmac_f32 %0, %1, %2" : "+v"(pe27) : "v"(xq2), "v"(n27_0[2])); asm("v_fmac_f32 %0, %1, %2" : "+v"(pe27) : "v"(xq3), "v"(n27_0[3])); asm("v_fmac_f32 %0, %1, %2" : "+v"(pe27) : "v"(xq4), "v"(n27_1[0])); asm("v_fmac_f32 %0, %1, %2" : "+v"(pe27) : "v"(xq5), "v"(n27_1[1])); p += dpp_f(p, 1); xq6 = kq2 ? (xq6 + p) : xq6; asm volatile("" : "+v"(xq6), "+v"(np_) : "v"(n26_0), "v"(n26_1)); }
                { n29_0 = *(const LAS f32x4*)(np_ + 29 * 36); n29_1 = *(const LAS f32x4*)(np_ + 29 * 36 + 4); float p = pe27; asm("v_fmac_f32 %0, %1, %2" : "+v"(p) : "v"(xq6), "v"(n27_1[2])); p += dpp_f(p, 0); pe28 = 0.f; asm("v_fmac_f32 %0, %1, %2" : "+v"(pe28) : "v"(xq0), "v"(n28_0[0])); asm("v_fmac_f32 %0, %1, %2" : "+v"(pe28) : "v"(xq1), "v"(n28_0[1])); asm("v_fmac_f32 %0, %1, %2" : "+v"(pe28) : "v"(xq2), "v"(n28_0[2])); asm("v_fmac_f32 %0, %1, %2" : "+v"(pe28) : "v"(xq3), "v"(n28_0[3])); asm("v_fmac_f32 %0, %1, %2" : "+v"(pe28) : "v"(xq4), "v"(n28_1[0])); asm("v_fmac_f32 %0, %1, %2" : "+v"(pe28) : "v"(xq5), "v"(n28_1[1])); p += dpp_f(p, 1); xq6 = kq3 ? (xq6 + p) : xq6; asm volatile("" : "+v"(xq6), "+v"(np_) : "v"(n27_0), "v"(n27_1)); }
                { n30_0 = *(const LAS f32x4*)(np_ + 30 * 36); n30_1 = *(const LAS f32x4*)(np_ + 30 * 36 + 4); float p = pe28; asm("v_fmac_f32 %0, %1, %2" : "+v"(p) : "v"(xq6), "v"(n28_1[2])); p += dpp_f(p, 0); pe29 = 0.f; asm("v_fmac_f32 %0, %1, %2" : "+v"(pe29) : "v"(xq0), "v"(n29_0[0])); asm("v_fmac_f32 %0, %1, %2" : "+v"(pe29) : "v"(xq1), "v"(n29_0[1])); asm("v_fmac_f32 %0, %1, %2" : "+v"(pe29) : "v"(xq2), "v"(n29_0[2])); asm("v_fmac_f32 %0, %1, %2" : "+v"(pe29) : "v"(xq3), "v"(n29_0[3])); asm("v_fmac_f32 %0, %1, %2" : "+v"(pe29) : "v"(xq4), "v"(n29_1[0])); asm("v_fmac_f32 %0, %1, %2" : "+v"(pe29) : "v"(xq5), "v"(n29_1[1])); asm("v_fmac_f32 %0, %1, %2" : "+v"(pe29) : "v"(xq6), "v"(n29_1[2])); p += dpp_f(p, 1); xq7 = kq0 ? (xq7 + p) : xq7; asm volatile("" : "+v"(xq7), "+v"(np_) : "v"(n28_0), "v"(n28_1)); }
                { n31_0 = *(const LAS f32x4*)(np_ + 31 * 36); n31_1 = *(const LAS f32x4*)(np_ + 31 * 36 + 4); float p = pe29; asm("v_fmac_f32 %0, %1, %2" : "+v"(p) : "v"(xq7), "v"(n29_1[3])); p += dpp_f(p, 0); pe30 = 0.f; asm("v_fmac_f32 %0, %1, %2" : "+v"(pe30) : "v"(xq0), "v"(n30_0[0])); asm("v_fmac_f32 %0, %1, %2" : "+v"(pe30) : "v"(xq1), "v"(n30_0[1])); asm("v_fmac_f32 %0, %1, %2" : "+v"(pe30) : "v"(xq2), "v"(n30_0[2])); asm("v_fmac_f32 %0, %1, %2" : "+v"(pe30) : "v"(xq3), "v"(n30_0[3])); asm("v_fmac_f32 %0, %1, %2" : "+v"(pe30) : "v"(xq4), "v"(n30_1[0])); asm("v_fmac_f32 %0, %1, %2" : "+v"(pe30) : "v"(xq5), "v"(n30_1[1])); asm("v_fmac_f32 %0, %1, %2" : "+v"(pe30) : "v"(xq6), "v"(n30_1[2])); p += dpp_f(p, 1); xq7 = kq1 ? (xq7 + p) : xq7; asm volatile("" : "+v"(xq7), "+v"(np_) : "v"(n29_0), "v"(n29_1)); }
                { float p = pe30; asm("v_fmac_f32 %0, %1, %2" : "+v"(p) : "v"(xq7), "v"(n30_1[3])); p += dpp_f(p, 0); pe31 = 0.f; asm("v_fmac_f32 %0, %1, %2" : "+v"(pe31) : "v"(xq0), "v"(n31_0[0])); asm("v_fmac_f32 %0, %1, %2" : "+v"(pe31) : "v"(xq1), "v"(n31_0[1])); asm("v_fmac_f32 %0, %1, %2" : "+v"(pe31) : "v"(xq2), "v"(n31_0[2])); asm("v_fmac_f32 %0, %1, %2" : "+v"(pe31) : "v"(xq3), "v"(n31_0[3])); asm("v_fmac_f32 %0, %1, %2" : "+v"(pe31) : "v"(xq4), "v"(n31_1[0])); asm("v_fmac_f32 %0, %1, %2" : "+v"(pe31) : "v"(xq5), "v"(n31_1[1])); asm("v_fmac_f32 %0, %1, %2" : "+v"(pe31) : "v"(xq6), "v"(n31_1[2])); p += dpp_f(p, 1); xq7 = kq2 ? (xq7 + p) : xq7; asm volatile("" : "+v"(xq7), "+v"(np_) : "v"(n30_0), "v"(n30_1)); }
                { float p = pe31; asm("v_fmac_f32 %0, %1, %2" : "+v"(p) : "v"(xq7), "v"(n31_1[3])); p += dpp_f(p, 0); p += dpp_f(p, 1); xq7 = kq3 ? (xq7 + p) : xq7; asm volatile("" : "+v"(xq7), "+v"(np_) : "v"(n31_0), "v"(n31_1)); }
                LAS bf16_t* dst = isA ? (A2 + rowi * 40 + q) : (NT + rowi * 40 + q);
                dst[0] = bf1(xq0);
                dst[4] = bf1(xq1);
                dst[8] = bf1(xq2);
                dst[12] = bf1(xq3);
                dst[16] = bf1(xq4);
                dst[20] = bf1(xq5);
                dst[24] = bf1(xq6);
                dst[28] = bf1(xq7);
            }
            __syncthreads();
            {
                const int t = lane & 31; f32x16 acc;
#pragma unroll
                for (int i = 0; i < 16; ++i) acc[i] = 0.f;
                if (wave == 0 || wave == 1) {
                    acc = mm32<2>(acc, NT, 40, BTt + 32 * wave * 40, 40, lane); const int k = 32 * wave + t; const float gc = GC[k];
#pragma unroll
                    for (int g4 = 0; g4 < 4; ++g4) { const int s0 = 8 * g4 + 4 * (lane >> 5); float o[4];
#pragma unroll
                        for (int i = 0; i < 4; ++i) o[i] = (acc[4 * g4 + i] + __builtin_bit_cast(float, (unsigned)KT[(s0 + i) * 72 + k] << 16)) * gc;
                        *(LAS u32x2*)(WzT + k * 40 + s0) = (u32x2){cvt_pk_bf16(o[0], o[1]), cvt_pk_bf16(o[2], o[3])}; }
                } else if (wave == 2 || wave == 6) {
                    const int rh = (wave == 6) ? 1 : 0; acc = mm32<2>(acc, A2 + 32 * rh * 40, 40, MbrT, 40, lane);
#pragma unroll
                    for (int g4 = 0; g4 < 4; ++g4) { const int k0 = 32 * rh + 8 * g4 + 4 * (lane >> 5); float o[4]; const u32x2 rv = *(const LAS u32x2*)(RT + t * 72 + k0);
                        o[0] = acc[4 * g4] + bflo(rv.x); o[1] = acc[4 * g4 + 1] + bfhi(rv.x); o[2] = acc[4 * g4 + 2] + bflo(rv.y); o[3] = acc[4 * g4 + 3] + bfhi(rv.y);
                        *(LAS u32x2*)(R2T + t * 72 + k0) = (u32x2){cvt_pk_bf16(o[0], o[1]), cvt_pk_bf16(o[2], o[3])}; }
                } else {
                    if (wave == 3) { accw = mm32<2>(accw, NT, 40, MbrT, 40, lane);
#pragma unroll
                        for (int g4 = 0; g4 < 4; ++g4) { const int s0 = 8 * g4 + 4 * (lane >> 5);
                            *(LAS u32x2*)(WyT + t * 40 + s0) = (u32x2){cvt_pk_bf16(accw[4 * g4], accw[4 * g4 + 1]), cvt_pk_bf16(accw[4 * g4 + 2], accw[4 * g4 + 3])}; } }
                    const int pt = (wave == 3) ? 3 : (wave == 7 ? 2 : wave - 4);
                    const int rh = pt >> 1, ch = pt & 1; acc = mm32<2>(acc, A2 + 32 * rh * 40, 40, BTt + 32 * ch * 40, 40, lane); const int kp = 32 * ch + t; const float gc = GC[kp];
#pragma unroll
                    for (int g4 = 0; g4 < 4; ++g4) { const int k0 = 32 * rh + 8 * g4 + 4 * (lane >> 5);
                        *(LAS u32x2*)(PpT + kp * 72 + k0) = (u32x2){cvt_pk_bf16(acc[4 * g4] * gc, acc[4 * g4 + 1] * gc), cvt_pk_bf16(acc[4 * g4 + 2] * gc, acc[4 * g4 + 3] * gc)}; }
                }
            }
            __syncthreads();
            if (wave < 3) {
                const int t = lane & 31; const LAS bf16_t* Sb = SBF + bi * (32 * 72); f32x16 acc;
#pragma unroll
                for (int i = 0; i < 16; ++i) acc[i] = 0.f;
                if (wave < 2) {
                    acc = mm32<2>(acc, VmT, 40, WzT + 32 * wave * 40, 40, lane);
                    acc = mm32<4>(acc, Sb, 72, PpT + 32 * wave * 72, 72, lane);
                    const float gc = GC[32 * wave + t]; LAS bf16_t* Sn = SBF + (bi ^ 1) * (32 * 72);
#pragma unroll
                    for (int i = 0; i < 16; ++i) { Sacc[i] = fmaf(Sacc[i], gc, acc[i]); Sn[TROW(i, lane) * 72 + 32 * wave + t] = bf1(Sacc[i]); }
                } else {
                    acc = mm32<2>(acc, VmT, 40, WyT, 40, lane);
                    acc = mm32<4>(acc, Sb, 72, R2T, 72, lane);
#pragma unroll
                    for (int i = 0; i < 16; ++i) YST[t * 33 + TROW(i, lane)] = acc[i];
                }
            }
            __syncthreads();
            { const LAS float* ys = YST + pj * 33 + 2 * pq;
                *(f32x2*)(Y + ((size_t)b * SEQ + chunk * 32 + pj) * 512 + h * 64 + 32 * half + 2 * pq) = (f32x2){ys[0], ys[1]}; }
        }
#undef WKV_LOAD
    }
    TSTOP(4);
}


constexpr int STG_R_STRIDE = 10752;
struct WSet { LAS float* CUM; LAS float* PS; LAS bf16_t* AT; LAS bf16_t* BT; LAS bf16_t* KT; LAS bf16_t* RT; LAS bf16_t* BTt; LAS bf16_t* ATt; LAS float* NabT; LAS bf16_t* Nakb; LAS bf16_t* MbrT; LAS bf16_t* Tb; LAS bf16_t* Ut; LAS bf16_t* Wt;
              LAS bf16_t* WyT; LAS bf16_t* WzT; LAS bf16_t* R2T; LAS bf16_t* PpT; LAS float* GC; };
constexpr int WSET_BYTES = 59136;
__device__ __forceinline__ WSet wset(LAS unsigned char* p) {
    WSet s; s.CUM = (LAS float*)p; s.PS = (LAS float*)(p + 8192); s.WyT = (LAS bf16_t*)p; s.WzT = (LAS bf16_t*)(p + 2560);
    s.AT = (LAS bf16_t*)(p + 10240); s.BT = (LAS bf16_t*)(p + 14848); s.PpT = (LAS bf16_t*)(p + 10240); s.KT = (LAS bf16_t*)(p + 19456); s.RT = (LAS bf16_t*)(p + 24064);
    s.BTt = (LAS bf16_t*)(p + 28672); s.ATt = (LAS bf16_t*)(p + 33792); s.NabT = (LAS float*)(p + 38912); s.R2T = (LAS bf16_t*)(p + 38912); s.Nakb = (LAS bf16_t*)(p + 43520); s.MbrT = (LAS bf16_t*)(p + 46080);
    s.Tb = (LAS bf16_t*)(p + 48640); s.Ut = (LAS bf16_t*)(p + 51200); s.Wt = (LAS bf16_t*)(p + 53760); s.GC = (LAS float*)(p + 58880); return s;
}
struct WRaw { u32x2 rc, rp, kc, kp, e4, a4; };
__device__ __forceinline__ void w5_load(WRaw& w, const bf16_t* COLS, const bf16_t* LORA, int b, int chunk, int pj, int hc) {
    const int s_ = chunk * 32 + pj; const size_t t_ = (size_t)b * SEQ + s_; const bf16_t* cb_ = COLS + t_ * INC + hc; const u32x2 z = (u32x2){0u, 0u};
    w.rc = *(const u32x2*)(cb_ + C_R); w.kc = *(const u32x2*)(cb_ + C_K);
    if (s_ > 0) { w.rp = *(const u32x2*)(cb_ - INC + C_R); w.kp = *(const u32x2*)(cb_ - INC + C_K); } else { w.rp = z; w.kp = z; }
    w.e4 = *(const u32x2*)(LORA + t_ * 1536 + hc); w.a4 = *(const u32x2*)(LORA + t_ * 1536 + 512 + hc);
}
struct WConst { f32x4 mur, muk, kk4, ka4, rk4; };
__device__ __forceinline__ void w5_prep_scale(const WConst& cst, const WRaw& w, const WSet& S, float* BON, int b, int h, int chunk, int pj, int pq) {
    float r_[4], rq_[4], k_[4], kq_[4], e_[4], aa_[4], kkn_[4], k2_[4];
    const f32x4 mur = cst.mur, muk = cst.muk, kk4 = cst.kk4, ka4 = cst.ka4, rk4 = cst.rk4;
    unpack4(w.rc, r_); unpack4(w.rp, rq_); unpack4(w.kc, k_); unpack4(w.kp, kq_); unpack4(w.e4, e_); unpack4(w.a4, aa_);
    float ss_ = 0.f, bon_ = 0.f;
#pragma unroll
    for (int i = 0; i < 4; ++i) { r_[i] += (rq_[i] - r_[i]) * mur[i]; k_[i] += (kq_[i] - k_[i]) * muk[i];
        kkn_[i] = k_[i] * kk4[i]; ss_ += kkn_[i] * kkn_[i]; k2_[i] = k_[i] * (1.0f + (aa_[i] - 1.0f) * ka4[i]); bon_ += r_[i] * k2_[i] * rk4[i]; }
    ss_ = row16_sum(ss_); bon_ = row16_sum(bon_); const float inv_ = __builtin_amdgcn_rsqf(fmaxf(ss_, 1e-24f));
    if (pq == 0) BON[((size_t)b * SEQ + chunk * 32 + pj) * 8 + h] = bon_;
    const f32x4 cm = *(const LAS f32x4*)(S.CUM + pj * 64 + 4 * pq); float at_[4], bt_[4], kt_[4], rt_[4], g_[4];
#pragma unroll
    for (int i = 0; i < 4; ++i) { const float kn = kkn_[i] * inv_; const float g = __expf(-cm[i]), ig = __expf(cm[i]), gp = __expf(e_[i] - cm[i]); g_[i] = g;
        at_[i] = -kn * gp; bt_[i] = kn * aa_[i] * ig; kt_[i] = k2_[i] * ig; rt_[i] = r_[i] * g; }
    *(LAS u32x2*)(S.AT + pj * 72 + 4 * pq) = (u32x2){cvt_pk_bf16(at_[0], at_[1]), cvt_pk_bf16(at_[2], at_[3])};
    *(LAS u32x2*)(S.BT + pj * 72 + 4 * pq) = (u32x2){cvt_pk_bf16(bt_[0], bt_[1]), cvt_pk_bf16(bt_[2], bt_[3])};
    *(LAS u32x2*)(S.KT + pj * 72 + 4 * pq) = (u32x2){cvt_pk_bf16(kt_[0], kt_[1]), cvt_pk_bf16(kt_[2], kt_[3])};
    *(LAS u32x2*)(S.RT + pj * 72 + 4 * pq) = (u32x2){cvt_pk_bf16(rt_[0], rt_[1]), cvt_pk_bf16(rt_[2], rt_[3])};
#pragma unroll
    for (int i = 0; i < 4; ++i) { S.BTt[(4 * pq + i) * 40 + pj] = bf1(bt_[i]); S.ATt[(4 * pq + i) * 40 + pj] = bf1(at_[i]); }
    if (pj == 31) *(LAS f32x4*)(S.GC + 4 * pq) = (f32x4){g_[0], g_[1], g_[2], g_[3]};
}
__device__ __forceinline__ void w5_s1(const WSet& S, int tl, f32x16& accw, int lane) {
    f32x16 acc;
#pragma unroll
    for (int i = 0; i < 16; ++i) acc[i] = 0.f;
    const int t = lane & 31, hh = lane >> 5;
    if (tl == 1) {
        acc = mm32<4>(acc, S.AT, 72, S.KT, 72, lane);
#pragma unroll
        for (int g4 = 0; g4 < 4; ++g4) { const int t0 = 8 * g4 + 4 * hh; float o[4];
#pragma unroll
            for (int i = 0; i < 4; ++i) o[i] = (t < t0 + i) ? acc[4 * g4 + i] : 0.f;
            *(LAS u32x2*)(S.Nakb + t * 40 + t0) = (u32x2){cvt_pk_bf16(o[0], o[1]), cvt_pk_bf16(o[2], o[3])}; }
        return;
    }
    acc = mm32<4>(acc, (tl & 1) ? S.KT : S.BT, 72, (tl & 2) ? S.RT : S.AT, 72, lane);
    if (tl == 0) {
#pragma unroll
        for (int g4 = 0; g4 < 4; ++g4) { const int s0 = 8 * g4 + 4 * hh;
#pragma unroll
            for (int i = 0; i < 4; ++i) S.NabT[t * 36 + i * 8 + 2 * g4 + hh] = (s0 + i < t) ? acc[4 * g4 + i] : 0.f; }
    } else if (tl == 2) {
#pragma unroll
        for (int g4 = 0; g4 < 4; ++g4) { const int s0 = 8 * g4 + 4 * hh; float o[4];
#pragma unroll
            for (int i = 0; i < 4; ++i) o[i] = (s0 + i <= t) ? acc[4 * g4 + i] : 0.f;
            *(LAS u32x2*)(S.MbrT + t * 40 + s0) = (u32x2){cvt_pk_bf16(o[0], o[1]), cvt_pk_bf16(o[2], o[3])}; }
    } else {
#pragma unroll
        for (int i = 0; i < 16; ++i) { const int s = TROW(i, lane); accw[i] = (s <= t) ? acc[i] : 0.f; }
    }
}
__device__ __forceinline__ void w5_s2b(const WSet& S, int tl, int lane) {
    f32x16 acc;
#pragma unroll
    for (int i = 0; i < 16; ++i) acc[i] = 0.f;
    const int t = lane & 31, hh = lane >> 5;
    acc = mm32<2>(acc, S.Tb, 40, (tl == 0) ? S.MbrT : (S.BTt + 32 * (tl - 1) * 40), 40, lane);
    LAS bf16_t* o = (tl == 0) ? (S.Ut + t * 40) : (S.Wt + (32 * (tl - 1) + t) * 40);
#pragma unroll
    for (int g4 = 0; g4 < 4; ++g4) { const int s0 = 8 * g4 + 4 * hh;
        *(LAS u32x2*)(o + s0) = (u32x2){cvt_pk_bf16(acc[4 * g4], acc[4 * g4 + 1]), cvt_pk_bf16(acc[4 * g4 + 2], acc[4 * g4 + 3])}; }
}
__device__ __forceinline__ void w5_s3(const WSet& S, int role, f32x16& accw, int lane) {
    const int t = lane & 31, hh = lane >> 5; f32x16 acc;
#pragma unroll
    for (int i = 0; i < 16; ++i) acc[i] = 0.f;
    if (role == 0 || role == 1) {
        acc = mm32<2>(acc, S.Nakb, 40, S.Wt + 32 * role * 40, 40, lane); const int k = 32 * role + t; const float gc = S.GC[k];
#pragma unroll
        for (int g4 = 0; g4 < 4; ++g4) { const int s0 = 8 * g4 + 4 * hh; float o[4];
#pragma unroll
            for (int i = 0; i < 4; ++i) o[i] = (acc[4 * g4 + i] + __builtin_bit_cast(float, (unsigned)S.KT[(s0 + i) * 72 + k] << 16)) * gc;
            *(LAS u32x2*)(S.WzT + k * 40 + s0) = (u32x2){cvt_pk_bf16(o[0], o[1]), cvt_pk_bf16(o[2], o[3])}; }
    } else if (role == 2 || role == 6) {
        const int rh = (role == 6) ? 1 : 0; acc = mm32<2>(acc, S.ATt + 32 * rh * 40, 40, S.Ut, 40, lane);
#pragma unroll
        for (int g4 = 0; g4 < 4; ++g4) { const int k0 = 32 * rh + 8 * g4 + 4 * hh; float o[4]; const u32x2 rv = *(const LAS u32x2*)(S.RT + t * 72 + k0);
            o[0] = acc[4 * g4] + bflo(rv.x); o[1] = acc[4 * g4 + 1] + bfhi(rv.x); o[2] = acc[4 * g4 + 2] + bflo(rv.y); o[3] = acc[4 * g4 + 3] + bfhi(rv.y);
            *(LAS u32x2*)(S.R2T + t * 72 + k0) = (u32x2){cvt_pk_bf16(o[0], o[1]), cvt_pk_bf16(o[2], o[3])}; }
    } else {
        if (role == 3) { accw = mm32<2>(accw, S.Nakb, 40, S.Ut, 40, lane);
#pragma unroll
            for (int g4 = 0; g4 < 4; ++g4) { const int s0 = 8 * g4 + 4 * hh;
                *(LAS u32x2*)(S.WyT + t * 40 + s0) = (u32x2){cvt_pk_bf16(accw[4 * g4], accw[4 * g4 + 1]), cvt_pk_bf16(accw[4 * g4 + 2], accw[4 * g4 + 3])}; } }
        const int pt = (role == 3) ? 3 : (role == 7 ? 2 : role - 4);
        const int rh = pt >> 1, ch = pt & 1; acc = mm32<2>(acc, S.ATt + 32 * rh * 40, 40, S.Wt + 32 * ch * 40, 40, lane); const int kp = 32 * ch + t; const float gc = S.GC[kp];
#pragma unroll
        for (int g4 = 0; g4 < 4; ++g4) { const int k0 = 32 * rh + 8 * g4 + 4 * hh;
            *(LAS u32x2*)(S.PpT + kp * 72 + k0) = (u32x2){cvt_pk_bf16(acc[4 * g4] * gc, acc[4 * g4 + 1] * gc), cvt_pk_bf16(acc[4 * g4 + 2] * gc, acc[4 * g4 + 3] * gc)}; }
    }
}
__device__ __forceinline__ void w5_copyout(const WSet& S, unsigned char* gr, unsigned char* gp, int tid) {
    { const int row = tid >> 3, pc = tid & 7; *(u32x4*)(gp + row * 128 + pc * 16) = *(const LAS u32x4*)((const LAS unsigned char*)S.PpT + row * 144 + pc * 16); }
    if (tid < 256) { const int row = tid >> 3, pc = tid & 7; *(u32x4*)(gr + row * 128 + pc * 16) = *(const LAS u32x4*)((const LAS unsigned char*)S.R2T + row * 144 + pc * 16); }
    else { const int u = tid - 256, row = u >> 2, pc = u & 3; *(u32x4*)(gr + 4096 + row * 64 + pc * 16) = *(const LAS u32x4*)((const LAS unsigned char*)S.WzT + row * 80 + pc * 16); }
    if (tid < 128) { const int row = tid >> 2, pc = tid & 3; *(u32x4*)(gr + 8192 + row * 64 + pc * 16) = *(const LAS u32x4*)((const LAS unsigned char*)S.WyT + row * 80 + pc * 16); }
    else if (tid < 144) { const int pc = tid - 128; *(u32x4*)(gr + 10240 + pc * 16) = *(const LAS u32x4*)((const LAS unsigned char*)S.GC + pc * 16); }
}
__device__ __forceinline__ void wkv5a2(const Args& a, LAS unsigned char* lds, const int round) {
    const int tid = threadIdx.x, wave = __builtin_amdgcn_readfirstlane(tid >> 6);
    unsigned char* ws = a.ws;
    const bf16_t* COLS = (const bf16_t*)(ws + WS_A); const bf16_t* LORA = (const bf16_t*)a.out; float* BON = (float*)(ws + WS_BON);
    unsigned char* STG_R = ws + WS_RWKV; unsigned char* STG_P = (unsigned char*)a.out + 96 * MiB;
    const WSet SA = wset(lds), SB = wset(lds + WSET_BYTES);
    for (int item = blockIdx.x; item < 256; item += gridDim.x) {
        const int bh = item >> 1, sub = item & 1, b = bh >> 3, h = bh & 7;
        const int chunk0 = 32 * round + 16 * sub, chunk_end = chunk0 + 16;
        WRaw wa, wb; WConst cst;
        { const int hc0 = h * 64 + 4 * (tid & 15); cst.mur = *(const f32x4*)(a.in[I_MU] + C_R + hc0); cst.muk = *(const f32x4*)(a.in[I_MU] + C_K + hc0);
          cst.kk4 = *(const f32x4*)(a.in[I_KK] + hc0); cst.ka4 = *(const f32x4*)(a.in[I_KA] + hc0); cst.rk4 = *(const f32x4*)(a.in[I_RK] + hc0); }
        w5_load(wa, COLS, LORA, b, chunk0, tid >> 4, h * 64 + 4 * (tid & 15)); w5_load(wb, COLS, LORA, b, chunk0 + 1, tid >> 4, h * 64 + 4 * (tid & 15));
        __syncthreads();
        for (int chunk = chunk0; chunk < chunk_end; chunk += 2) {
            int tid_l = tid; asm volatile("" : "+v"(tid_l));
            const int lane = tid_l & 63, pj = tid_l >> 4, pq = tid_l & 15, tid = tid_l, hc = h * 64 + 4 * pq; (void)tid;
            { float e_[4]; unpack4(wa.e4, e_); *(LAS f32x4*)(SA.CUM + pj * 64 + 4 * pq) = (f32x4){e_[0], e_[1], e_[2], e_[3]};
              unpack4(wb.e4, e_); *(LAS f32x4*)(SB.CUM + pj * 64 + 4 * pq) = (f32x4){e_[0], e_[1], e_[2], e_[3]}; }
            __syncthreads();
            {
                const int col = tid & 63, qd = tid >> 6;
                float p0 = SA.CUM[(4 * qd) * 64 + col], p1 = SA.CUM[(4 * qd + 1) * 64 + col], p2 = SA.CUM[(4 * qd + 2) * 64 + col], p3 = SA.CUM[(4 * qd + 3) * 64 + col];
                float q0 = SB.CUM[(4 * qd) * 64 + col], q1 = SB.CUM[(4 * qd + 1) * 64 + col], q2 = SB.CUM[(4 * qd + 2) * 64 + col], q3 = SB.CUM[(4 * qd + 3) * 64 + col];
                p1 += p0; p2 += p1; p3 += p2; SA.PS[qd * 64 + col] = p3; q1 += q0; q2 += q1; q3 += q2; SB.PS[qd * 64 + col] = q3;
                __syncthreads();
                float ba = 0.f, bb = 0.f;
#pragma unroll
                for (int q2_ = 0; q2_ < 7; ++q2_) { ba += (q2_ < qd) ? SA.PS[q2_ * 64 + col] : 0.f; bb += (q2_ < qd) ? SB.PS[q2_ * 64 + col] : 0.f; }
                SA.CUM[(4 * qd) * 64 + col] = ba + p0; SA.CUM[(4 * qd + 1) * 64 + col] = ba + p1; SA.CUM[(4 * qd + 2) * 64 + col] = ba + p2; SA.CUM[(4 * qd + 3) * 64 + col] = ba + p3;
                SB.CUM[(4 * qd) * 64 + col] = bb + q0; SB.CUM[(4 * qd + 1) * 64 + col] = bb + q1; SB.CUM[(4 * qd + 2) * 64 + col] = bb + q2; SB.CUM[(4 * qd + 3) * 64 + col] = bb + q3; }
            __syncthreads();
            w5_prep_scale(cst, wa, SA, BON, b, h, chunk, pj, pq);
            w5_prep_scale(cst, wb, SB, BON, b, h, chunk + 1, pj, pq);
            if (chunk + 2 < chunk_end) { w5_load(wa, COLS, LORA, b, chunk + 2, pj, hc); w5_load(wb, COLS, LORA, b, chunk + 3, pj, hc); }
            __syncthreads();
            f32x16 accw;
#pragma unroll
            for (int i = 0; i < 16; ++i) accw[i] = 0.f;
            if (wave < 4) w5_s1(SA, wave, accw, lane); else w5_s1(SB, wave - 4, accw, lane);
            __syncthreads();
            if (wave < 4) {
                const WSet& S_ = (wave >= 2) ? SB : SA;
                const int q = lane & 3, rowi = ((wave & 1) * 64 + lane) >> 2;
                float xq0, xq1, xq2, xq3, xq4, xq5, xq6, xq7;
                xq0 = (0 + q == rowi) ? 1.0f : 0.0f;
                xq1 = (4 + q == rowi) ? 1.0f : 0.0f;
                xq2 = (8 + q == rowi) ? 1.0f : 0.0f;
                xq3 = (12 + q == rowi) ? 1.0f : 0.0f;
                xq4 = (16 + q == rowi) ? 1.0f : 0.0f;
                xq5 = (20 + q == rowi) ? 1.0f : 0.0f;
                xq6 = (24 + q == rowi) ? 1.0f : 0.0f;
                xq7 = (28 + q == rowi) ? 1.0f : 0.0f;
                const bool kq0 = q == 0, kq1 = q == 1, kq2 = q == 2, kq3 = q == 3;
                const LAS float* np_ = S_.NabT + q * 8;
                f32x4 n1_0, n2_0, n3_0, n4_0, n5_0, n6_0, n7_0, n8_0, n9_0, n10_0, n11_0, n12_0, n13_0, n14_0, n15_0, n16_0, n17_0, n17_1, n18_0, n18_1, n19_0, n19_1, n20_0, n20_1, n21_0, n21_1, n22_0, n22_1, n23_0, n23_1, n24_0, n24_1, n25_0, n25_1, n26_0, n26_1, n27_0, n27_1, n28_0, n28_1, n29_0, n29_1, n30_0, n30_1, n31_0, n31_1;
                float pe1, pe2, pe3, pe4, pe5, pe6, pe7, pe8, pe9, pe10, pe11, pe12, pe13, pe14, pe15, pe16, pe17, pe18, pe19, pe20, pe21, pe22, pe23, pe24, pe25, pe26, pe27, pe28, pe29, pe30, pe31, pe32;
                n1_0 = *(const LAS f32x4*)(np_ + 1 * 36); n2_0 = *(const LAS f32x4*)(np_ + 2 * 36); pe1 = 0.f;
                { n3_0 = *(const LAS f32x4*)(np_ + 3 * 36); float p = pe1; asm("v_fmac_f32 %0, %1, %2" : "+v"(p) : "v"(xq0), "v"(n1_0[0])); p += dpp_f(p, 0); pe2 = 0.f; p += dpp_f(p, 1); xq0 = kq1 ? (xq0 + p) : xq0; asm volatile("" : "+v"(xq0), "+v"(np_) : "v"(n1_0)); }
                { n4_0 = *(const LAS f32x4*)(np_ + 4 * 36); float p = pe2; asm("v_fmac_f32 %0, %1, %2" : "+v"(p) : "v"(xq0), "v"(n2_0[0])); p += dpp_f(p, 0); pe3 = 0.f; p += dpp_f(p, 1); xq0 = kq2 ? (xq0 + p) : xq0; asm volatile("" : "+v"(xq0), "+v"(np_) : "v"(n2_0)); }
                { n5_0 = *(const LAS f32x4*)(np_ + 5 * 36); float p = pe3; asm("v_fmac_f32 %0, %1, %2" : "+v"(p) : "v"(xq0), "v"(n3_0[0])); p += dpp_f(p, 0); pe4 = 0.f; p += dpp_f(p, 1); xq0 = kq3 ? (xq0 + p) : xq0; asm volatile("" : "+v"(xq0), "+v"(np_) : "v"(n3_0)); }
                { n6_0 = *(const LAS f32x4*)(np_ + 6 * 36); float p = pe4; asm("v_fmac_f32 %0, %1, %2" : "+v"(p) : "v"(xq0), "v"(n4_0[0])); p += dpp_f(p, 0); pe5 = 0.f; asm("v_fmac_f32 %0, %1, %2" : "+v"(pe5) : "v"(xq0), "v"(n5_0[0])); p += dpp_f(p, 1); xq1 = kq0 ? (xq1 + p) : xq1; asm volatile("" : "+v"(xq1), "+v"(np_) : "v"(n4_0)); }
                { n7_0 = *(const LAS f32x4*)(np_ + 7 * 36); float p = pe5; asm("v_fmac_f32 %0, %1, %2" : "+v"(p) : "v"(xq1), "v"(n5_0[1])); p += dpp_f(p, 0); pe6 = 0.f; asm("v_fmac_f32 %0, %1, %2" : "+v"(pe6) : "v"(xq0), "v"(n6_0[0])); p += dpp_f(p, 1); xq1 = kq1 ? (xq1 + p) : xq1; asm volatile("" : "+v"(xq1), "+v"(np_) : "v"(n5_0)); }
                { n8_0 = *(const LAS f32x4*)(np_ + 8 * 36); float p = pe6; asm("v_fmac_f32 %0, %1, %2" : "+v"(p) : "v"(xq1), "v"(n6_0[1])); p += dpp_f(p, 0); pe7 = 0.f; asm("v_fmac_f32 %0, %1, %2" : "+v"(pe7) : "v"(xq0), "v"(n7_0[0])); p += dpp_f(p, 1); xq1 = kq2 ? (xq1 + p) : xq1; asm volatile("" : "+v"(xq1), "+v"(np_) : "v"(n6_0)); }
                { n9_0 = *(const LAS f32x4*)(np_ + 9 * 36); float p = pe7; asm("v_fmac_f32 %0, %1, %2" : "+v"(p) : "v"(xq1), "v"(n7_0[1])); p += dpp_f(p, 0); pe8 = 0.f; asm("v_fmac_f32 %0, %1, %2" : "+v"(pe8) : "v"(xq0), "v"(n8_0[0])); p += dpp_f(p, 1); xq1 = kq3 ? (xq1 + p) : xq1; asm volatile("" : "+v"(xq1), "+v"(np_) : "v"(n7_0)); }
                { n10_0 = *(const LAS f32x4*)(np_ + 10 * 36); float p = pe8; asm("v_fmac_f32 %0, %1, %2" : "+v"(p) : "v"(xq1), "v"(n8_0[1])); p += dpp_f(p, 0); pe9 = 0.f; asm("v_fmac_f32 %0, %1, %2" : "+v"(pe9) : "v"(xq0), "v"(n9_0[0])); asm("v_fmac_f32 %0, %1, %2" : "+v"(pe9) : "v"(xq1), "v"(n9_0[1])); p += dpp_f(p, 1); xq2 = kq0 ? (xq2 + p) : xq2; asm volatile("" : "+v"(xq2), "+v"(np_) : "v"(n8_0)); }
                { n11_0 = *(const LAS f32x4*)(np_ + 11 * 36); float p = pe9; asm("v_fmac_f32 %0, %1, %2" : "+v"(p) : "v"(xq2), "v"(n9_0[2])); p += dpp_f(p, 0); pe10 = 0.f; asm("v_fmac_f32 %0, %1, %2" : "+v"(pe10) : "v"(xq0), "v"(n10_0[0])); asm("v_fmac_f32 %0, %1, %2" : "+v"(pe10) : "v"(xq1), "v"(n10_0[1])); p += dpp_f(p, 1); xq2 = kq1 ? (xq2 + p) : xq2; asm volatile("" : "+v"(xq2), "+v"(np_) : "v"(n9_0)); }
                { n12_0 = *(const LAS f32x4*)(np_ + 12 * 36); float p = pe10; asm("v_fmac_f32 %0, %1, %2" : "+v"(p) : "v"(xq2), "v"(n10_0[2])); p += dpp_f(p, 0); pe11 = 0.f; asm("v_fmac_f32 %0, %1, %2" : "+v"(pe11) : "v"(xq0), "v"(n11_0[0])); asm("v_fmac_f32 %0, %1, %2" : "+v"(pe11) : "v"(xq1), "v"(n11_0[1])); p += dpp_f(p, 1); xq2 = kq2 ? (xq2 + p) : xq2; asm volatile("" : "+v"(xq2), "+v"(np_) : "v"(n10_0)); }
                { n13_0 = *(const LAS f32x4*)(np_ + 13 * 36); float p = pe11; asm("v_fmac_f32 %0, %1, %2" : "+v"(p) : "v"(xq2), "v"(n11_0[2])); p += dpp_f(p, 0); pe12 = 0.f; asm("v_fmac_f32 %0, %1, %2" : "+v"(pe12) : "v"(xq0), "v"(n12_0[0])); asm("v_fmac_f32 %0, %1, %2" : "+v"(pe12) : "v"(xq1), "v"(n12_0[1])); p += dpp_f(p, 1); xq2 = kq3 ? (xq2 + p) : xq2; asm volatile("" : "+v"(xq2), "+v"(np_) : "v"(n11_0)); }
                { n14_0 = *(const LAS f32x4*)(np_ + 14 * 36); float p = pe12; asm("v_fmac_f32 %0, %1, %2" : "+v"(p) : "v"(xq2), "v"(n12_0[2])); p += dpp_f(p, 0); pe13 = 0.f; asm("v_fmac_f32 %0, %1, %2" : "+v"(pe13) : "v"(xq0), "v"(n13_0[0])); asm("v_fmac_f32 %0, %1, %2" : "+v"(pe13) : "v"(xq1), "v"(n13_0[1])); asm("v_fmac_f32 %0, %1, %2" : "+v"(pe13) : "v"(xq2), "v"(n13_0[2])); p += dpp_f(p, 1); xq3 = kq0 ? (xq3 + p) : xq3; asm volatile("" : "+v"(xq3), "+v"(np_) : "v"(n12_0)); }
                { n15_0 = *(const LAS f32x4*)(np_ + 15 * 36); float p = pe13; asm("v_fmac_f32 %0, %1, %2" : "+v"(p) : "v"(xq3), "v"(n13_0[3])); p += dpp_f(p, 0); pe14 = 0.f; asm("v_fmac_f32 %0, %1, %2" : "+v"(pe14) : "v"(xq0), "v"(n14_0[0])); asm("v_fmac_f32 %0, %1, %2" : "+v"(pe14) : "v"(xq1), "v"(n14_0[1])); asm("v_fmac_f32 %0, %1, %2" : "+v"(pe14) : "v"(xq2), "v"(n14_0[2])); p += dpp_f(p, 1); xq3 = kq1 ? (xq3 + p) : xq3; asm volatile("" : "+v"(xq3), "+v"(np_) : "v"(n13_0)); }
                { n16_0 = *(const LAS f32x4*)(np_ + 16 * 36); float p = pe14; asm("v_fmac_f32 %0, %1, %2" : "+v"(p) : "v"(xq3), "v"(n14_0[3])); p += dpp_f(p, 0); pe15 = 0.f; asm("v_fmac_f32 %0, %1, %2" : "+v"(pe15) : "v"(xq0), "v"(n15_0[0])); asm("v_fmac_f32 %0, %1, %2" : "+v"(pe15) : "v"(xq1), "v"(n15_0[1])); asm("v_fmac_f32 %0, %1, %2" : "+v"(pe15) : "v"(xq2), "v"(n15_0[2])); p += dpp_f(p, 1); xq3 = kq2 ? (xq3 + p) : xq3; asm volatile("" : "+v"(xq3), "+v"(np_) : "v"(n14_0)); }
                { n17_0 = *(const LAS f32x4*)(np_ + 17 * 36); n17_1 = *(const LAS f32x4*)(np_ + 17 * 36 + 4); float p = pe15; asm("v_fmac_f32 %0, %1, %2" : "+v"(p) : "v"(xq3), "v"(n15_0[3])); p += dpp_f(p, 0); pe16 = 0.f; asm("v_fmac_f32 %0, %1, %2" : "+v"(pe16) : "v"(xq0), "v"(n16_0[0])); asm("v_fmac_f32 %0, %1, %2" : "+v"(pe16) : "v"(xq1), "v"(n16_0[1])); asm("v_fmac_f32 %0, %1, %2" : "+v"(pe16) : "v"(xq2), "v"(n16_0[2])); p += dpp_f(p, 1); xq3 = kq3 ? (xq3 + p) : xq3; asm volatile("" : "+v"(xq3), "+v"(np_) : "v"(n15_0)); }
                { n18_0 = *(const LAS f32x4*)(np_ + 18 * 36); n18_1 = *(const LAS f32x4*)(np_ + 18 * 36 + 4); float p = pe16; asm("v_fmac_f32 %0, %1, %2" : "+v"(p) : "v"(xq3), "v"(n16_0[3])); p += dpp_f(p, 0); pe17 = 0.f; asm("v_fmac_f32 %0, %1, %2" : "+v"(pe17) : "v"(xq0), "v"(n17_0[0])); asm("v_fmac_f32 %0, %1, %2" : "+v"(pe17) : "v"(xq1), "v"(n17_0[1])); asm("v_fmac_f32 %0, %1, %2" : "+v"(pe17) : "v"(xq2), "v"(n17_0[2])); asm("v_fmac_f32 %0, %1, %2" : "+v"(pe17) : "v"(xq3), "v"(n17_0[3])); p += dpp_f(p, 1); xq4 = kq0 ? (xq4 + p) : xq4; asm volatile("" : "+v"(xq4), "+v"(np_) : "v"(n16_0)); }
                { n19_0 = *(const LAS f32x4*)(np_ + 19 * 36); n19_1 = *(const LAS f32x4*)(np_ + 19 * 36 + 4); float p = pe17; asm("v_fmac_f32 %0, %1, %2" : "+v"(p) : "v"(xq4), "v"(n17_1[0])); p += dpp_f(p, 0); pe18 = 0.f; asm("v_fmac_f32 %0, %1, %2" : "+v"(pe18) : "v"(xq0), "v"(n18_0[0])); asm("v_fmac_f32 %0, %1, %2" : "+v"(pe18) : "v"(xq1), "v"(n18_0[1])); asm("v_fmac_f32 %0, %1, %2" : "+v"(pe18) : "v"(xq2), "v"(n18_0[2])); asm("v_fmac_f32 %0, %1, %2" : "+v"(pe18) : "v"(xq3), "v"(n18_0[3])); p += dpp_f(p, 1); xq4 = kq1 ? (xq4 + p) : xq4; asm volatile("" : "+v"(xq4), "+v"(np_) : "v"(n17_0), "v"(n17_1)); }
                { n20_0 = *(const LAS f32x4*)(np_ + 20 * 36); n20_1 = *(const LAS f32x4*)(np_ + 20 * 36 + 4); float p = pe18; asm("v_fmac_f32 %0, %1, %2" : "+v"(p) : "v"(xq4), "v"(n18_1[0])); p += dpp_f(p, 0); pe19 = 0.f; asm("v_fmac_f32 %0, %1, %2" : "+v"(pe19) : "v"(xq0), "v"(n19_0[0])); asm("v_fmac_f32 %0, %1, %2" : "+v"(pe19) : "v"(xq1), "v"(n19_0[1])); asm("v_fmac_f32 %0, %1, %2" : "+v"(pe19) : "v"(xq2), "v"(n19_0[2])); asm("v_fmac_f32 %0, %1, %2" : "+v"(pe19) : "v"(xq3), "v"(n19_0[3])); p += dpp_f(p, 1); xq4 = kq2 ? (xq4 + p) : xq4; asm volatile("" : "+v"(xq4), "+v"(np_) : "v"(n18_0), "v"(n18_1)); }
                { n21_0 = *(const LAS f32x4*)(np_ + 21 * 36); n21_1 = *(const LAS f32x4*)(np_ + 21 * 36 + 4); float p = pe19; asm("v_fmac_f32 %0, %1, %2" : "+v"(p) : "v"(xq4), "v"(n19_1[0])); p += dpp_f(p, 0); pe20 = 0.f; asm("v_fmac_f32 %0, %1, %2" : "+v"(pe20) : "v"(xq0), "v"(n20_0[0])); asm("v_fmac_f32 %0, %1, %2" : "+v"(pe20) : "v"(xq1), "v"(n20_0[1])); asm("v_fmac_f32 %0, %1, %2" : "+v"(pe20) : "v"(xq2), "v"(n20_0[2])); asm("v_fmac_f32 %0, %1, %2" : "+v"(pe20) : "v"(xq3), "v"(n20_0[3])); p += dpp_f(p, 1); xq4 = kq3 ? (xq4 + p) : xq4; asm volatile("" : "+v"(xq4), "+v"(np_) : "v"(n19_0), "v"(n19_1)); }
                { n22_0 = *(const LAS f32x4*)(np_ + 22 * 36); n22_1 = *(const LAS f32x4*)(np_ + 22 * 36 + 4); float p = pe20; asm("v_fmac_f32 %0, %1, %2" : "+v"(p) : "v"(xq4), "v"(n20_1[0])); p += dpp_f(p, 0); pe21 = 0.f; asm("v_fmac_f32 %0, %1, %2" : "+v"(pe21) : "v"(xq0), "v"(n21_0[0])); asm("v_fmac_f32 %0, %1, %2" : "+v"(pe21) : "v"(xq1), "v"(n21_0[1])); asm("v_fmac_f32 %0, %1, %2" : "+v"(pe21) : "v"(xq2), "v"(n21_0[2])); asm("v_fmac_f32 %0, %1, %2" : "+v"(pe21) : "v"(xq3), "v"(n21_0[3])); asm("v_fmac_f32 %0, %1, %2" : "+v"(pe21) : "v"(xq4), "v"(n21_1[0])); p += dpp_f(p, 1); xq5 = kq0 ? (xq5 + p) : xq5; asm volatile("" : "+v"(xq5), "+v"(np_) : "v"(n20_0), "v"(n20_1)); }
                { n23_0 = *(const LAS f32x4*)(np_ + 23 * 36); n23_1 = *(const LAS f32x4*)(np_ + 23 * 36 + 4); float p = pe21; asm("v_fmac_f32 %0, %1, %2" : "+v"(p) : "v"(xq5), "v"(n21_1[1])); p += dpp_f(p, 0); pe22 = 0.f; asm("v_fmac_f32 %0, %1, %2" : "+v"(pe22) : "v"(xq0), "v"(n22_0[0])); asm("v_fmac_f32 %0, %1, %2" : "+v"(pe22) : "v"(xq1), "v"(n22_0[1])); asm("v_fmac_f32 %0, %1, %2" : "+v"(pe22) : "v"(xq2), "v"(n22_0[2])); asm("v_fmac_f32 %0, %1, %2" : "+v"(pe22) : "v"(xq3), "v"(n22_0[3])); asm("v_fmac_f32 %0, %1, %2" : "+v"(pe22) : "v"(xq4), "v"(n22_1[0])); p += dpp_f(p, 1); xq5 = kq1 ? (xq5 + p) : xq5; asm volatile("" : "+v"(xq5), "+v"(np_) : "v"(n21_0), "v"(n21_1)); }
                { n24_0 = *(const LAS f32x4*)(np_ + 24 * 36); n24_1 = *(const LAS f32x4*)(np_ + 24 * 36 + 4); float p = pe22; asm("v_fmac_f32 %0, %1, %2" : "+v"(p) : "v"(xq5), "v"(n22_1[1])); p += dpp_f(p, 0); pe23 = 0.f; asm("v_fmac_f32 %0, %1, %2" : "+v"(pe23) : "v"(xq0), "v"(n23_0[0])); asm("v_fmac_f32 %0, %1, %2" : "+v"(pe23) : "v"(xq1), "v"(n23_0[1])); asm("v_fmac_f32 %0, %1, %2" : "+v"(pe23) : "v"(xq2), "v"(n23_0[2])); asm("v_fmac_f32 %0, %1, %2" : "+v"(pe23) : "v"(xq3), "v"(n23_0[3])); asm("v_fmac_f32 %0, %1, %2" : "+v"(pe23) : "v"(xq4), "v"(n23_1[0])); p += dpp_f(p, 1); xq5 = kq2 ? (xq5 + p) : xq5; asm volatile("" : "+v"(xq5), "+v"(np_) : "v"(n22_0), "v"(n22_1)); }
                { n25_0 = *(const LAS f32x4*)(np_ + 25 * 36); n25_1 = *(const LAS f32x4*)(np_ + 25 * 36 + 4); float p = pe23; asm("v_fmac_f32 %0, %1, %2" : "+v"(p) : "v"(xq5), "v"(n23_1[1])); p += dpp_f(p, 0); pe24 = 0.f; asm("v_fmac_f32 %0, %1, %2" : "+v"(pe24) : "v"(xq0), "v"(n24_0[0])); asm("v_fmac_f32 %0, %1, %2" : "+v"(pe24) : "v"(xq1), "v"(n24_0[1])); asm("v_fmac_f32 %0, %1, %2" : "+v"(pe24) : "v"(xq2), "v"(n24_0[2])); asm("v_fmac_f32 %0, %1, %2" : "+v"(pe24) : "v"(xq3), "v"(n24_0[3])); asm("v_fmac_f32 %0, %1, %2" : "+v"(pe24) : "v"(xq4), "v"(n24_1[0])); p += dpp_f(p, 1); xq5 = kq3 ? (xq5 + p) : xq5; asm volatile("" : "+v"(xq5), "+v"(np_) : "v"(n23_0), "v"(n23_1)); }
                { n26_0 = *(const LAS f32x4*)(np_ + 26 * 36); n26_1 = *(const LAS f32x4*)(np_ + 26 * 36 + 4); float p = pe24; asm("v_fmac_f32 %0, %1, %2" : "+v"(p) : "v"(xq5), "v"(n24_1[1])); p += dpp_f(p, 0); pe25 = 0.f; asm("v_fmac_f32 %0, %1, %2" : "+v"(pe25) : "v"(xq0), "v"(n25_0[0])); asm("v_fmac_f32 %0, %1, %2" : "+v"(pe25) : "v"(xq1), "v"(n25_0[1])); asm("v_fmac_f32 %0, %1, %2" : "+v"(pe25) : "v"(xq2), "v"(n25_0[2])); asm("v_fmac_f32 %0, %1, %2" : "+v"(pe25) : "v"(xq3), "v"(n25_0[3])); asm("v_fmac_f32 %0, %1, %2" : "+v"(pe25) : "v"(xq4), "v"(n25_1[0])); asm("v_fmac_f32 %0, %1, %2" : "+v"(pe25) : "v"(xq5), "v"(n25_1[1])); p += dpp_f(p, 1); xq6 = kq0 ? (xq6 + p) : xq6; asm volatile("" : "+v"(xq6), "+v"(np_) : "v"(n24_0), "v"(n24_1)); }
                { n27_0 = *(const LAS f32x4*)(np_ + 27 * 36); n27_1 = *(const LAS f32x4*)(np_ + 27 * 36 + 4); float p = pe25; asm("v_fmac_f32 %0, %1, %2" : "+v"(p) : "v"(xq6), "v"(n25_1[2])); p += dpp_f(p, 0); pe26 = 0.f; asm("v_fmac_f32 %0, %1, %2" : "+v"(pe26) : "v"(xq0), "v"(n26_0[0])); asm("v_fmac_f32 %0, %1, %2" : "+v"(pe26) : "v"(xq1), "v"(n26_0[1])); asm("v_fmac_f32 %0, %1, %2" : "+v"(pe26) : "v"(xq2), "v"(n26_0[2])); asm("v_fmac_f32 %0, %1, %2" : "+v"(pe26) : "v"(xq3), "v"(n26_0[3])); asm("v_fmac_f32 %0, %1, %2" : "+v"(pe26) : "v"(xq4), "v"(n26_1[0])); asm("v_fmac_f32 %0, %1, %2" : "+v"(pe26) : "v"(xq5), "v"(n26_1[1])); p += dpp_f(p, 1); xq6 = kq1 ? (xq6 + p) : xq6; asm volatile("" : "+v"(xq6), "+v"(np_) : "v"(n25_0), "v"(n25_1)); }
                { n28_0 = *(const LAS f32x4*)(np_ + 28 * 36); n28_1 = *(const LAS f32x4*)(np_ + 28 * 36 + 4); float p = pe26; asm("v_fmac_f32 %0, %1, %2" : "+v"(p) : "v"(xq6), "v"(n26_1[2])); p += dpp_f(p, 0); pe27 = 0.f; asm("v_fmac_f32 %0, %1, %2" : "+v"(pe27) : "v"(xq0), "v"(n27_0[0])); asm("v_fmac_f32 %0, %1, %2" : "+v"(pe27) : "v"(xq1), "v"(n27_0[1])); asm("v_fmac_f32 %0, %1, %2" : "+v"(pe27) : "v"(xq2), "v"(n27_0[2])); asm("v_fmac_f32 %0, %1, %2" : "+v"(pe27) : "v"(xq3), "v"(n27_0[3])); asm("v_fmac_f32 %0, %1, %2" : "+v"(pe27) : "v"(xq4), "v"(n27_1[0])); asm("v_fmac_f32 %0, %1, %2" : "+v"(pe27) : "v"(xq5), "v"(n27_1[1])); p += dpp_f(p, 1); xq6 = kq2 ? (xq6 + p) : xq6; asm volatile("" : "+v"(xq6), "+v"(np_) : "v"(n26_0), "v"(n26_1)); }
                { n29_0 = *(const LAS f32x4*)(np_ + 29 * 36); n29_1 = *(const LAS f32x4*)(np_ + 29 * 36 + 4); float p = pe27; asm("v_fmac_f32 %0, %1, %2" : "+v"(p) : "v"(xq6), "v"(n27_1[2])); p += dpp_f(p, 0); pe28 = 0.f; asm("v_fmac_f32 %0, %1, %2" : "+v"(pe28) : "v"(xq0), "v"(n28_0[0])); asm("v_fmac_f32 %0, %1, %2" : "+v"(pe28) : "v"(xq1), "v"(n28_0[1])); asm("v_fmac_f32 %0, %1, %2" : "+v"(pe28) : "v"(xq2), "v"(n28_0[2])); asm("v_fmac_f32 %0, %1, %2" : "+v"(pe28) : "v"(xq3), "v"(n28_0[3])); asm("v_fmac_f32 %0, %1, %2" : "+v"(pe28) : "v"(xq4), "v"(n28_1[0])); asm("v_fmac_f32 %0, %1, %2" : "+v"(pe28) : "v"(xq5), "v"(n28_1[1])); p += dpp_f(p, 1); xq6 = kq3 ? (xq6 + p) : xq6; asm volatile("" : "+v"(xq6), "+v"(np_) : "v"(n27_0), "v"(n27_1)); }
                { n30_0 = *(const LAS f32x4*)(np_ + 30 * 36); n30_1 = *(const LAS f32x4*)(np_ + 30 * 36 + 4); float p = pe28; asm("v_fmac_f32 %0, %1, %2" : "+v"(p) : "v"(xq6), "v"(n28_1[2])); p += dpp_f(p, 0); pe29 = 0.f; asm("v_fmac_f32 %0, %1, %2" : "+v"(pe29) : "v"(xq0), "v"(n29_0[0])); asm("v_fmac_f32 %0, %1, %2" : "+v"(pe29) : "v"(xq1), "v"(n29_0[1])); asm("v_fmac_f32 %0, %1, %2" : "+v"(pe29) : "v"(xq2), "v"(n29_0[2])); asm("v_fmac_f32 %0, %1, %2" : "+v"(pe29) : "v"(xq3), "v"(n29_0[3])); asm("v_fmac_f32 %0, %1, %2" : "+v"(pe29) : "v"(xq4), "v"(n29_1[0])); asm("v_fmac_f32 %0, %1, %2" : "+v"(pe29) : "v"(xq5), "v"(n29_1[1])); asm("v_fmac_f32 %0, %1, %2" : "+v"(pe29) : "v"(xq6), "v"(n29_1[2])); p += dpp_f(p, 1); xq7 = kq0 ? (xq7 + p) : xq7; asm volatile("" : "+v"(xq7), "+v"(np_) : "v"(n28_0), "v"(n28_1)); }
                { n31_0 = *(const LAS f32x4*)(np_ + 31 * 36); n31_1 = *(const LAS f32x4*)(np_ + 31 * 36 + 4); float p = pe29; asm("v_fmac_f32 %0, %1, %2" : "+v"(p) : "v"(xq7), "v"(n29_1[3])); p += dpp_f(p, 0); pe30 = 0.f; asm("v_fmac_f32 %0, %1, %2" : "+v"(pe30) : "v"(xq0), "v"(n30_0[0])); asm("v_fmac_f32 %0, %1, %2" : "+v"(pe30) : "v"(xq1), "v"(n30_0[1])); asm("v_fmac_f32 %0, %1, %2" : "+v"(pe30) : "v"(xq2), "v"(n30_0[2])); asm("v_fmac_f32 %0, %1, %2" : "+v"(pe30) : "v"(xq3), "v"(n30_0[3])); asm("v_fmac_f32 %0, %1, %2" : "+v"(pe30) : "v"(xq4), "v"(n30_1[0])); asm("v_fmac_f32 %0, %1, %2" : "+v"(pe30) : "v"(xq5), "v"(n30_1[1])); asm("v_fmac_f32 %0, %1, %2" : "+v"(pe30) : "v"(xq6), "v"(n30_1[2])); p += dpp_f(p, 1); xq7 = kq1 ? (xq7 + p) : xq7; asm volatile("" : "+v"(xq7), "+v"(np_) : "v"(n29_0), "v"(n29_1)); }
                { float p = pe30; asm("v_fmac_f32 %0, %1, %2" : "+v"(p) : "v"(xq7), "v"(n30_1[3])); p += dpp_f(p, 0); pe31 = 0.f; asm("v_fmac_f32 %0, %1, %2" : "+v"(pe31) : "v"(xq0), "v"(n31_0[0])); asm("v_fmac_f32 %0, %1, %2" : "+v"(pe31) : "v"(xq1), "v"(n31_0[1])); asm("v_fmac_f32 %0, %1, %2" : "+v"(pe31) : "v"(xq2), "v"(n31_0[2])); asm("v_fmac_f32 %0, %1, %2" : "+v"(pe31) : "v"(xq3), "v"(n31_0[3])); asm("v_fmac_f32 %0, %1, %2" : "+v"(pe31) : "v"(xq4), "v"(n31_1[0])); asm("v_fmac_f32 %0, %1, %2" : "+v"(pe31) : "v"(xq5), "v"(n31_1[1])); asm("v_fmac_f32 %0, %1, %2" : "+v"(pe31) : "v"(xq6), "v"(n31_1[2])); p += dpp_f(p, 1); xq7 = kq2 ? (xq7 + p) : xq7; asm volatile("" : "+v"(xq7), "+v"(np_) : "v"(n30_0), "v"(n30_1)); }
                { float p = pe31; asm("v_fmac_f32 %0, %1, %2" : "+v"(p) : "v"(xq7), "v"(n31_1[3])); p += dpp_f(p, 0); p += dpp_f(p, 1); xq7 = kq3 ? (xq7 + p) : xq7; asm volatile("" : "+v"(xq7), "+v"(np_) : "v"(n31_0), "v"(n31_1)); }
                LAS bf16_t* dst = S_.Tb + rowi * 40 + q;
                dst[0] = bf1(xq0);
                dst[4] = bf1(xq1);
                dst[8] = bf1(xq2);
                dst[12] = bf1(xq3);
                dst[16] = bf1(xq4);
                dst[20] = bf1(xq5);
                dst[24] = bf1(xq6);
                dst[28] = bf1(xq7);
            }
            __syncthreads();
            if (wave < 6) { if (wave < 3) w5_s2b(SA, wave, lane); else w5_s2b(SB, wave - 3, lane); }
            __syncthreads();
            w5_s3(SA, wave, accw, lane);
            w5_s3(SB, (wave + 4) & 7, accw, lane);
            __syncthreads();
            { const size_t idx = (size_t)bh * 32 + (chunk & 31);
              w5_copyout(SA, STG_R + idx * STG_R_STRIDE, STG_P + idx * 8192, tid);
              w5_copyout(SB, STG_R + (idx + 1) * STG_R_STRIDE, STG_P + (idx + 1) * 8192, tid); }
            __syncthreads();
        }
    }
}
__device__ __forceinline__ void wkv5b(const Args& a, LAS unsigned char* lds, const int round) {
    const int tid = threadIdx.x, lane = tid & 63, wave = __builtin_amdgcn_readfirstlane(tid >> 6);
    unsigned char* ws = a.ws;
    const bf16_t* COLS = (const bf16_t*)(ws + WS_A); float* Y = (float*)(ws + WS_B);
    const unsigned char* STG_R = ws + WS_RWKV; const unsigned char* STG_P = (const unsigned char*)a.out + 96 * MiB;
    constexpr int SET = 24576;
    LAS bf16_t* SBF = (LAS bf16_t*)(lds + 118272);
    LAS float* YST = (LAS float*)(lds + 127488);
    LAS float* SSAVE = (LAS float*)(lds + 135936);
    for (int item = blockIdx.x; item < 256; item += gridDim.x) {
        const int bh = item >> 1, half = item & 1, b = bh >> 3, h = bh & 7;
        const int pj = tid >> 4, pq = tid & 15;
        f32x16 Sacc;
#pragma unroll
        for (int i = 0; i < 16; ++i) Sacc[i] = 0.f;
        __syncthreads();
        if (round == 0) { for (int i = tid; i < 2 * 32 * 72 / 2; i += 512) ((LAS unsigned*)SBF)[i] = 0u; }
        else if (wave < 2) {
#pragma unroll
            for (int i = 0; i < 16; ++i) Sacc[i] = SSAVE[(wave * 16 + i) * 64 + lane]; }
        const f32x2 muv = *(const f32x2*)(a.in[I_MU] + C_V + h * 64 + 32 * half + 2 * pq);
        u32x4 gP, gA, gB; unsigned vcur, vprv;
#define W5_LOAD(chunk) do { const size_t idx_ = (size_t)bh * 32 + ((chunk) & 31); const unsigned char* gr_ = STG_R + idx_ * STG_R_STRIDE; const unsigned char* gp_ = STG_P + idx_ * 8192; \
            gP = *(const u32x4*)(gp_ + (tid >> 3) * 128 + (tid & 7) * 16); \
            gA = (tid < 256) ? *(const u32x4*)(gr_ + (tid >> 3) * 128 + (tid & 7) * 16) : *(const u32x4*)(gr_ + 4096 + ((tid - 256) >> 2) * 64 + ((tid - 256) & 3) * 16); \
            gB = (tid < 144) ? *(const u32x4*)(gr_ + 8192 + tid * 16) : (u32x4){0u, 0u, 0u, 0u}; \
            { const int s_ = (chunk) * 32 + pj; const bf16_t* cb_ = COLS + ((size_t)b * SEQ + s_) * INC + C_V + h * 64 + 32 * half + 2 * pq; vcur = *(const unsigned*)cb_; vprv = (s_ > 0) ? *(const unsigned*)(cb_ - INC) : 0u; } } while (0)
#define W5_STORE(setb) do { LAS unsigned char* sb_ = lds + 10240 + (setb) * SET; \
            *(LAS u32x4*)(sb_ + 12288 + (tid >> 3) * 144 + (tid & 7) * 16) = gP; \
            if (tid < 256) *(LAS u32x4*)(sb_ + 7680 + (tid >> 3) * 144 + (tid & 7) * 16) = gA; \
            else *(LAS u32x4*)(sb_ + 2560 + ((tid - 256) >> 2) * 80 + ((tid - 256) & 3) * 16) = gA; \
            if (tid < 128) *(LAS u32x4*)(sb_ + (tid >> 2) * 80 + (tid & 3) * 16) = gB; \
            else if (tid < 144) *(LAS u32x4*)(sb_ + 21504 + (tid - 128) * 16) = gB; \
            { const float c0_ = bflo(vcur), c1_ = bfhi(vcur), p0_ = bflo(vprv), p1_ = bfhi(vprv); LAS bf16_t* vm_ = (LAS bf16_t*)(sb_ + 21760); \
                vm_[(2 * pq) * 40 + pj] = bf1(c0_ + (p0_ - c0_) * muv[0]); vm_[(2 * pq + 1) * 40 + pj] = bf1(c1_ + (p1_ - c1_) * muv[1]); } } while (0)
        const int chunk0 = 32 * round;
        W5_LOAD(chunk0); W5_STORE(chunk0 & 1);
        __syncthreads();
        for (int chunk = chunk0; chunk < chunk0 + 32; ++chunk) {
            const int bi = chunk & 1;
            if (chunk + 1 < chunk0 + 32) W5_LOAD(chunk + 1);
            { LAS unsigned char* sb = lds + 10240 + bi * SET;
              LAS bf16_t* WyT = (LAS bf16_t*)sb; LAS bf16_t* WzT = (LAS bf16_t*)(sb + 2560); LAS bf16_t* R2T = (LAS bf16_t*)(sb + 7680); LAS bf16_t* PpT = (LAS bf16_t*)(sb + 12288);
              LAS float* GC = (LAS float*)(sb + 21504); LAS bf16_t* VmT = (LAS bf16_t*)(sb + 21760); LAS float* YSTc = YST + bi * (32 * 33);
            if (wave < 3) {
                const int t = lane & 31; const LAS bf16_t* Sb = SBF + bi * (32 * 72); f32x16 acc;
#pragma unroll
                for (int i = 0; i < 16; ++i) acc[i] = 0.f;
                if (wave < 2) {
                    acc = mm32<2>(acc, VmT, 40, WzT + 32 * wave * 40, 40, lane);
                    acc = mm32<4>(acc, Sb, 72, PpT + 32 * wave * 72, 72, lane);
                    const float gc = GC[32 * wave + t]; LAS bf16_t* Sn = SBF + (bi ^ 1) * (32 * 72);
#pragma unroll
                    for (int i = 0; i < 16; ++i) { Sacc[i] = fmaf(Sacc[i], gc, acc[i]); Sn[TROW(i, lane) * 72 + 32 * wave + t] = bf1(Sacc[i]); }
                } else {
                    acc = mm32<2>(acc, VmT, 40, WyT, 40, lane);
                    acc = mm32<4>(acc, Sb, 72, R2T, 72, lane);
#pragma unroll
                    for (int i = 0; i < 16; ++i) YSTc[t * 33 + TROW(i, lane)] = acc[i];
                }
            }
            }
            if (chunk + 1 < chunk0 + 32) W5_STORE(bi ^ 1);
            __syncthreads();
            { const LAS float* ys = YST + bi * (32 * 33) + pj * 33 + 2 * pq;
                *(f32x2*)(Y + ((size_t)b * SEQ + chunk * 32 + pj) * 512 + h * 64 + 32 * half + 2 * pq) = (f32x2){ys[0], ys[1]}; }
        }
        if (wave < 2) {
#pragma unroll
            for (int i = 0; i < 16; ++i) SSAVE[(wave * 16 + i) * 64 + lane] = Sacc[i]; }
#undef W5_LOAD
#undef W5_STORE
    }
}
__device__ __forceinline__ void wkv5b2(const Args& a, LAS unsigned char* lds, const int round) {
    const int tid = threadIdx.x, lane = tid & 63, wave = __builtin_amdgcn_readfirstlane(tid >> 6);
    unsigned char* ws = a.ws;
    const bf16_t* COLS = (const bf16_t*)(ws + WS_A); float* Y = (float*)(ws + WS_B); float* SSV = (float*)(ws + WS_S5O);
    const unsigned char* STG_R = ws + WS_RWKV; const unsigned char* STG_P = (const unsigned char*)a.out + 96 * MiB;
    constexpr int SET = 26880;
    LAS bf16_t* SBF = (LAS bf16_t*)(lds + 53760);
    LAS float* YST = (LAS float*)(lds + 72192);
    for (int item = blockIdx.x; item < 128; item += gridDim.x) {
        const int bh = item, b = bh >> 3, h = bh & 7;
        const int pj = tid >> 4, pq = tid & 15;
        const int half = (wave >> 1) & 1, kh = wave & 1;
        f32x16 Sacc;
#pragma unroll
        for (int i = 0; i < 16; ++i) Sacc[i] = 0.f;
        __syncthreads();
        if (round == 0) { for (int i = tid; i < 64 * 72 / 2; i += 512) ((LAS unsigned*)SBF)[i] = 0u; }
        else if (wave < 4) { const int t = lane & 31;
#pragma unroll
            for (int i = 0; i < 16; ++i) { Sacc[i] = SSV[(((size_t)bh * 4 + wave) * 16 + i) * 64 + lane]; SBF[(32 * half + TROW(i, lane)) * 72 + 32 * kh + t] = bf1(Sacc[i]); } }
        const f32x4 muv = *(const f32x4*)(a.in[I_MU] + C_V + h * 64 + 4 * pq);
        u32x4 gPA, gAA, gBA, gPB, gAB, gBB; u32x2 vcA, vpA, vcB, vpB;
#define W5_LOAD(R, chunk) do { const size_t idx_ = (size_t)bh * 32 + ((chunk) & 31); const unsigned char* gr_ = STG_R + idx_ * STG_R_STRIDE; const unsigned char* gp_ = STG_P + idx_ * 8192; \
            gP##R = *(const u32x4*)(gp_ + (tid >> 3) * 128 + (tid & 7) * 16); \
            gA##R = (tid < 256) ? *(const u32x4*)(gr_ + (tid >> 3) * 128 + (tid & 7) * 16) : *(const u32x4*)(gr_ + 4096 + ((tid - 256) >> 2) * 64 + ((tid - 256) & 3) * 16); \
            gB##R = (tid < 144) ? *(const u32x4*)(gr_ + 8192 + tid * 16) : (u32x4){0u, 0u, 0u, 0u}; \
            { const int s_ = (chunk) * 32 + pj; const bf16_t* cb_ = COLS + ((size_t)b * SEQ + s_) * INC + C_V + h * 64 + 4 * pq; vc##R = *(const u32x2*)cb_; vp##R = (s_ > 0) ? *(const u32x2*)(cb_ - INC) : (u32x2){0u, 0u}; } } while (0)
#define W5_STORE(R, setb) do { LAS unsigned char* sb_ = lds + (setb) * SET; \
            *(LAS u32x4*)(sb_ + 12288 + (tid >> 3) * 144 + (tid & 7) * 16) = gP##R; \
            if (tid < 256) *(LAS u32x4*)(sb_ + 7680 + (tid >> 3) * 144 + (tid & 7) * 16) = gA##R; \
            else *(LAS u32x4*)(sb_ + 2560 + ((tid - 256) >> 2) * 80 + ((tid - 256) & 3) * 16) = gA##R; \
            if (tid < 128) *(LAS u32x4*)(sb_ + (tid >> 2) * 80 + (tid & 3) * 16) = gB##R; \
            else if (tid < 144) *(LAS u32x4*)(sb_ + 21504 + (tid - 128) * 16) = gB##R; \
            { float c_[4], p_[4]; unpack4(vc##R, c_); unpack4(vp##R, p_); LAS bf16_t* vm_ = (LAS bf16_t*)(sb_ + 21760); \
              _Pragma("unroll") for (int i_ = 0; i_ < 4; ++i_) vm_[(4 * pq + i_) * 40 + pj] = bf1(c_[i_] + (p_[i_] - c_[i_]) * muv[i_]); } } while (0)
#define W5_STEP(chunk, RL, RS) do { const int bi = (chunk) & 1; \
            if ((chunk) + 2 < cend) W5_LOAD(RL, (chunk) + 2); \
            { LAS unsigned char* sb = lds + bi * SET; \
              LAS bf16_t* WyT = (LAS bf16_t*)sb; LAS bf16_t* WzT = (LAS bf16_t*)(sb + 2560); LAS bf16_t* R2T = (LAS bf16_t*)(sb + 7680); LAS bf16_t* PpT = (LAS bf16_t*)(sb + 12288); \
              LAS float* GC = (LAS float*)(sb + 21504); LAS bf16_t* VmT = (LAS bf16_t*)(sb + 21760); \
              if (wave < 6) { const int t = lane & 31; f32x16 acc; \
                _Pragma("unroll") for (int i = 0; i < 16; ++i) acc[i] = 0.f; \
                if (wave < 4) { const LAS bf16_t* Sb = SBF + bi * (64 * 72) + 32 * half * 72; \
                    acc = mm32<2>(acc, VmT + 32 * half * 40, 40, WzT + 32 * kh * 40, 40, lane); \
                    acc = mm32<4>(acc, Sb, 72, PpT + 32 * kh * 72, 72, lane); \
                    const float gc = GC[32 * kh + t]; LAS bf16_t* Sn = SBF + (bi ^ 1) * (64 * 72) + 32 * half * 72; \
                    _Pragma("unroll") for (int i = 0; i < 16; ++i) { Sacc[i] = fmaf(Sacc[i], gc, acc[i]); Sn[TROW(i, lane) * 72 + 32 * kh + t] = bf1(Sacc[i]); } \
                } else { const int yh = wave - 4; const LAS bf16_t* Sb = SBF + bi * (64 * 72) + 32 * yh * 72; LAS float* YSTc = YST + (bi * 2 + yh) * (32 * 33); \
                    acc = mm32<2>(acc, VmT + 32 * yh * 40, 40, WyT, 40, lane); \
                    acc = mm32<4>(acc, Sb, 72, R2T, 72, lane); \
                    _Pragma("unroll") for (int i = 0; i < 16; ++i) YSTc[t * 33 + TROW(i, lane)] = acc[i]; \
                } } } \
            if ((chunk) + 1 < cend) W5_STORE(RS, bi ^ 1); \
            __syncthreads(); \
            { const LAS float* ys = YST + (bi * 2 + (pq >> 3)) * (32 * 33) + pj * 33 + 4 * (pq & 7); \
                *(f32x4*)(Y + ((size_t)b * SEQ + (chunk) * 32 + pj) * 512 + h * 64 + 4 * pq) = (f32x4){ys[0], ys[1], ys[2], ys[3]}; } } while (0)
        const int chunk0 = 32 * round, cend = chunk0 + 32;
        W5_LOAD(A, chunk0); W5_LOAD(B, chunk0 + 1); W5_STORE(A, 0);
        __syncthreads();
        for (int chunk = chunk0; chunk < cend; chunk += 2) { W5_STEP(chunk, A, B); W5_STEP(chunk + 1, B, A); }
        if (wave < 4) {
#pragma unroll
            for (int i = 0; i < 16; ++i) SSV[(((size_t)bh * 4 + wave) * 16 + i) * 64 + lane] = Sacc[i]; }
#undef W5_LOAD
#undef W5_STORE
#undef W5_STEP
    }
}
__device__ __forceinline__ void wkv5b3(const Args& a, LAS unsigned char* lds, const int round) {
    const int tid = threadIdx.x, lane = tid & 63, wave = __builtin_amdgcn_readfirstlane(tid >> 6);
    unsigned char* ws = a.ws;
    const bf16_t* COLS = (const bf16_t*)(ws + WS_A); float* Y = (float*)(ws + WS_B); float* SSV = (float*)(ws + WS_S5O);
    const unsigned char* STG_R = ws + WS_RWKV; const unsigned char* STG_P = (const unsigned char*)a.out + 96 * MiB;
    constexpr int SET = 26880;
    LAS bf16_t* SBF = (LAS bf16_t*)(lds + 53760);
    for (int item = blockIdx.x; item < 128; item += gridDim.x) {
        const int bh = item, b = bh >> 3, h = bh & 7;
        const int t = lane & 31, hh = lane >> 5;
        const int half = (wave >> 1) & 1, kh = wave & 1;
        const int chunk0 = 32 * round, cend = chunk0 + 32;
        __syncthreads();
        if (wave >= 6) {
            const int u = tid - 384, pj = u >> 2, cq = u & 3;
            f32x4 mv0, mv1, mv2, mv3;
            { const float* mp = a.in[I_MU] + C_V + h * 64 + 16 * cq; mv0 = *(const f32x4*)mp; mv1 = *(const f32x4*)(mp + 4); mv2 = *(const f32x4*)(mp + 8); mv3 = *(const f32x4*)(mp + 12); }
            u32x4 p0A, p1A, p2A, p3A, r0A, r1A, z0A, z1A, y0A, gcA, c0A, c1A, q0A, q1A;
            u32x4 p0B, p1B, p2B, p3B, r0B, r1B, z0B, z1B, y0B, gcB, c0B, c1B, q0B, q1B;
#define W5_LOAD(R, chunk) do { const size_t idx_ = (size_t)bh * 32 + ((chunk) & 31); const unsigned char* gr_ = STG_R + idx_ * STG_R_STRIDE; const unsigned char* gp_ = STG_P + idx_ * 8192; \
                p0##R = *(const u32x4*)(gp_ + u * 16); p1##R = *(const u32x4*)(gp_ + 2048 + u * 16); p2##R = *(const u32x4*)(gp_ + 4096 + u * 16); p3##R = *(const u32x4*)(gp_ + 6144 + u * 16); \
                r0##R = *(const u32x4*)(gr_ + u * 16); r1##R = *(const u32x4*)(gr_ + 2048 + u * 16); z0##R = *(const u32x4*)(gr_ + 4096 + u * 16); z1##R = *(const u32x4*)(gr_ + 6144 + u * 16); \
                y0##R = *(const u32x4*)(gr_ + 8192 + u * 16); gc##R = (u < 16) ? *(const u32x4*)(gr_ + 10240 + u * 16) : (u32x4){0u, 0u, 0u, 0u}; \
                { const int s_ = (chunk) * 32 + pj; const bf16_t* cb_ = COLS + ((size_t)b * SEQ + s_) * INC + C_V + h * 64 + 16 * cq; c0##R = *(const u32x4*)cb_; c1##R = *(const u32x4*)(cb_ + 8); \
                  if (s_ > 0) { q0##R = *(const u32x4*)(cb_ - INC); q1##R = *(const u32x4*)(cb_ - INC + 8); } else { q0##R = (u32x4){0u, 0u, 0u, 0u}; q1##R = (u32x4){0u, 0u, 0u, 0u}; } } } while (0)
#define W5_PIECE8(base, p_) ((base) + ((p_) >> 3) * 144 + ((p_) & 7) * 16)
#define W5_PIECE4(base, p_) ((base) + ((p_) >> 2) * 80 + ((p_) & 3) * 16)
#define W5_VM(cv, qv, mv, off) do { float c_[8], q_[8]; unpack8(cv, c_); unpack8(qv, q_); \
                _Pragma("unroll") for (int i_ = 0; i_ < 8; ++i_) vm_[(16 * cq + (off) + i_) * 40 + pj] = bf1(c_[i_] + (q_[i_] - c_[i_]) * ((i_ < 4) ? mv##0[i_ & 3] : mv##1[i_ & 3])); } while (0)
#define W5_STORE(R, setb) do { LAS unsigned char* sb_ = lds + (setb) * SET; \
                *(LAS u32x4*)W5_PIECE8(sb_ + 12288, u) = p0##R; *(LAS u32x4*)W5_PIECE8(sb_ + 12288, u + 128) = p1##R; *(LAS u32x4*)W5_PIECE8(sb_ + 12288, u + 256) = p2##R; *(LAS u32x4*)W5_PIECE8(sb_ + 12288, u + 384) = p3##R; \
                *(LAS u32x4*)W5_PIECE8(sb_ + 7680, u) = r0##R; *(LAS u32x4*)W5_PIECE8(sb_ + 7680, u + 128) = r1##R; \
                *(LAS u32x4*)W5_PIECE4(sb_ + 2560, u) = z0##R; *(LAS u32x4*)W5_PIECE4(sb_ + 2560, u + 128) = z1##R; \
                *(LAS u32x4*)W5_PIECE4(sb_, u) = y0##R; if (u < 16) *(LAS u32x4*)(sb_ + 21504 + u * 16) = gc##R; \
                { LAS bf16_t* vm_ = (LAS bf16_t*)(sb_ + 21760); \
                  { float c_[8], q_[8]; unpack8(c0##R, c_); unpack8(q0##R, q_); \
                    _Pragma("unroll") for (int i_ = 0; i_ < 8; ++i_) vm_[(16 * cq + i_) * 40 + pj] = bf1(c_[i_] + (q_[i_] - c_[i_]) * ((i_ < 4) ? mv0[i_ & 3] : mv1[i_ & 3])); } \
                  { float c_[8], q_[8]; unpack8(c1##R, c_); unpack8(q1##R, q_); \
                    _Pragma("unroll") for (int i_ = 0; i_ < 8; ++i_) vm_[(16 * cq + 8 + i_) * 40 + pj] = bf1(c_[i_] + (q_[i_] - c_[i_]) * ((i_ < 4) ? mv2[i_ & 3] : mv3[i_ & 3])); } } } while (0)
            W5_LOAD(A, chunk0); W5_LOAD(B, chunk0 + 1); W5_STORE(A, 0);
            __syncthreads();
            for (int chunk = chunk0; chunk < cend; chunk += 2) {
                if (chunk + 2 < cend) W5_LOAD(A, chunk + 2);
                W5_STORE(B, 1);
                __syncthreads();
                if (chunk + 3 < cend) W5_LOAD(B, chunk + 3);
                if (chunk + 2 < cend) W5_STORE(A, 0);
                __syncthreads();
            }
#undef W5_LOAD
#undef W5_STORE
#undef W5_VM
#undef W5_PIECE8
#undef W5_PIECE4
        } else {
            f32x16 Sacc;
#pragma unroll
            for (int i = 0; i < 16; ++i) Sacc[i] = 0.f;
            if (wave < 4) {
                if (round != 0) {
#pragma unroll
                    for (int i = 0; i < 16; ++i) Sacc[i] = SSV[(((size_t)bh * 4 + wave) * 16 + i) * 64 + lane]; }
                LAS bf16_t* Sn = SBF + (32 * half + t) * 72 + 32 * kh;
#pragma unroll
                for (int g4 = 0; g4 < 4; ++g4) *(LAS u32x2*)(Sn + 8 * g4 + 4 * hh) = (u32x2){cvt_pk_bf16(Sacc[4 * g4], Sacc[4 * g4 + 1]), cvt_pk_bf16(Sacc[4 * g4 + 2], Sacc[4 * g4 + 3])};
            }
            __syncthreads();
            for (int chunk = chunk0; chunk < cend; ++chunk) {
                const int bi = chunk & 1; LAS unsigned char* sb = lds + bi * SET;
                LAS bf16_t* WyT = (LAS bf16_t*)sb; LAS bf16_t* WzT = (LAS bf16_t*)(sb + 2560); LAS bf16_t* R2T = (LAS bf16_t*)(sb + 7680); LAS bf16_t* PpT = (LAS bf16_t*)(sb + 12288);
                LAS float* GC = (LAS float*)(sb + 21504); LAS bf16_t* VmT = (LAS bf16_t*)(sb + 21760);
                f32x16 acc;
#pragma unroll
                for (int i = 0; i < 16; ++i) acc[i] = 0.f;
                if (wave < 4) {
                    const LAS bf16_t* Sb = SBF + bi * (64 * 72) + 32 * half * 72;
                    acc = mm32<2>(acc, WzT + 32 * kh * 40, 40, VmT + 32 * half * 40, 40, lane);
                    acc = mm32<4>(acc, PpT + 32 * kh * 72, 72, Sb, 72, lane);
                    LAS bf16_t* Sn = SBF + (bi ^ 1) * (64 * 72) + (32 * half + t) * 72 + 32 * kh;
#pragma unroll
                    for (int g4 = 0; g4 < 4; ++g4) { const int k0 = 8 * g4 + 4 * hh; const f32x4 gc4 = *(const LAS f32x4*)(GC + 32 * kh + k0);
#pragma unroll
                        for (int i = 0; i < 4; ++i) Sacc[4 * g4 + i] = fmaf(Sacc[4 * g4 + i], gc4[i], acc[4 * g4 + i]);
                        *(LAS u32x2*)(Sn + k0) = (u32x2){cvt_pk_bf16(Sacc[4 * g4], Sacc[4 * g4 + 1]), cvt_pk_bf16(Sacc[4 * g4 + 2], Sacc[4 * g4 + 3])}; }
                } else {
                    const int yh = wave - 4; const LAS bf16_t* Sb = SBF + bi * (64 * 72) + 32 * yh * 72;
                    acc = mm32<2>(acc, WyT, 40, VmT + 32 * yh * 40, 40, lane);
                    acc = mm32<4>(acc, R2T, 72, Sb, 72, lane);
                    float* yp = Y + ((size_t)b * SEQ + chunk * 32) * 512 + h * 64 + 32 * yh + t;
#pragma unroll
                    for (int i = 0; i < 16; ++i) yp[(size_t)TROW(i, lane) * 512] = acc[i];
                }
                __syncthreads();
            }
            if (wave < 4) {
#pragma unroll
                for (int i = 0; i < 16; ++i) SSV[(((size_t)bh * 4 + wave) * 16 + i) * 64 + lane] = Sacc[i]; }
        }
    }
}
__device__ __forceinline__ unsigned w5_img_src(int o) {
    if (o < 2560) { const int r = o / 80, c = o - r * 80; return (c < 64) ? (unsigned)(8192 + r * 64 + c) : 0u; }
    if (o < 7680) { const int o2 = o - 2560, r = o2 / 80, c = o2 - r * 80; return (c < 64) ? (unsigned)(4096 + r * 64 + c) : 0u; }
    if (o < 12288) { const int o2 = o - 7680, r = o2 / 144, c = o2 - r * 144; return (c < 128) ? (unsigned)(r * 128 + c) : 0u; }
    if (o < 21504) { const int o2 = o - 12288, r = o2 / 144, c = o2 - r * 144; return (c < 128) ? (unsigned)(r * 128 + c) : 0u; }
    return (unsigned)(10240 + (o - 21504));
}
__device__ __forceinline__ void wkv5b4(const Args& a, LAS unsigned char* lds, const int round) {
    const int tid = threadIdx.x, lane = tid & 63, wave = __builtin_amdgcn_readfirstlane(tid >> 6);
    unsigned char* ws = a.ws;
    const bf16_t* COLS = (const bf16_t*)(ws + WS_A); bf16_t* Y = (bf16_t*)(ws + WS_B); float* SSV = (float*)(ws + WS_S5O);
    const unsigned char* STG_R = ws + WS_RWKV; const unsigned char* STG_P = (const unsigned char*)a.out + 96 * MiB;
    constexpr int SETB = 31104;
    LAS bf16_t* SBF = (LAS bf16_t*)(lds + 4 * SETB);
#define W5_BAR() do { asm volatile("s_waitcnt lgkmcnt(0)" ::: "memory"); __builtin_amdgcn_s_barrier(); asm volatile("" ::: "memory"); } while (0)
    for (int item = blockIdx.x; item < 128; item += gridDim.x) {
        const int bh = item, b = bh >> 3, h = bh & 7;
        const int t = lane & 31, hh = lane >> 5;
        const int half = (wave >> 1) & 1, kh = wave & 1;
        const int chunk0 = 32 * round;
        __syncthreads();
        if (wave >= 6) {
            const int u = tid - 384, pj = u >> 2, cq = u & 3;
            const int j0 = (wave == 6) ? 0 : 9, nb = (wave == 6) ? 9 : 13;
            unsigned goff[13];
#pragma unroll
            for (int j = 0; j < 13; ++j) goff[j] = w5_img_src((j0 + j) * 1024 + lane * 16);
            f32x4 mv0, mv1, mv2, mv3;
            { const float* mp = a.in[I_MU] + C_V + h * 64 + 16 * cq; mv0 = *(const f32x4*)mp; mv1 = *(const f32x4*)(mp + 4); mv2 = *(const f32x4*)(mp + 8); mv3 = *(const f32x4*)(mp + 12); }
#define W5_ISSUE(i_) do { const int c_ = chunk0 + (i_); const size_t idx_ = (size_t)bh * 32 + (c_ & 31); const unsigned char* gr_ = STG_R + idx_ * STG_R_STRIDE; const unsigned char* gp_ = STG_P + idx_ * 8192; \
                LAS unsigned char* sb_ = lds + ((i_) & 3) * SETB; \
                if (wave == 6) { const unsigned char* vb_ = (const unsigned char*)(COLS + ((size_t)b * SEQ + (size_t)c_ * 32) * INC + C_V + h * 64) - (size_t)INC * 2; \
                    _Pragma("unroll") for (int j = 0; j < 5; ++j) { const int p_ = j * 64 + lane; \
                        if (p_ < 264) __builtin_amdgcn_global_load_lds((const unsigned*)(vb_ + (size_t)(p_ >> 3) * (INC * 2) + (p_ & 7) * 16), (LAS unsigned*)(sb_ + 26880 + j * 1024), 16, 0, 0); } } \
                _Pragma("unroll") for (int j = 0; j < 13; ++j) { if (j < nb) { const int jj = j0 + j; const unsigned char* base_ = (jj >= 12 && jj < 21) ? gp_ : gr_; \
                    if (jj < 21 || lane < 16) __builtin_amdgcn_global_load_lds((const unsigned*)(base_ + goff[j]), (LAS unsigned*)(sb_ + jj * 1024), 16, 0, 0); } } } while (0)
#define W5_CONV(i_) do { const int c_ = chunk0 + (i_); LAS unsigned char* sb_ = lds + ((i_) & 3) * SETB; const LAS unsigned char* rw_ = sb_ + 26880 + pj * 128 + cq * 32; LAS bf16_t* vm_ = (LAS bf16_t*)(sb_ + 21760); \
                u32x4 q0_ = *(const LAS u32x4*)rw_, q1_ = *(const LAS u32x4*)(rw_ + 16); const u32x4 c0_ = *(const LAS u32x4*)(rw_ + 128), c1_ = *(const LAS u32x4*)(rw_ + 144); \
                if (c_ * 32 + pj == 0) { q0_ = (u32x4){0u, 0u, 0u, 0u}; q1_ = q0_; } \
                { float c8_[8], q8_[8]; unpack8(c0_, c8_); unpack8(q0_, q8_); \
                  _Pragma("unroll") for (int e_ = 0; e_ < 8; ++e_) vm_[(16 * cq + e_) * 40 + pj] = bf1(c8_[e_] + (q8_[e_] - c8_[e_]) * ((e_ < 4) ? mv0[e_ & 3] : mv1[e_ & 3])); } \
                { float c8_[8], q8_[8]; unpack8(c1_, c8_); unpack8(q1_, q8_); \
                  _Pragma("unroll") for (int e_ = 0; e_ < 8; ++e_) vm_[(16 * cq + 8 + e_) * 40 + pj] = bf1(c8_[e_] + (q8_[e_] - c8_[e_]) * ((e_ < 4) ? mv2[e_ & 3] : mv3[e_ & 3])); } } while (0)
            W5_ISSUE(0); W5_ISSUE(1); W5_ISSUE(2);
            if (wave == 6) asm volatile("s_waitcnt vmcnt(37)" ::: "memory");
            W5_BAR();
            W5_CONV(0);
            if (wave == 6) asm volatile("s_waitcnt vmcnt(23)" ::: "memory"); else asm volatile("s_waitcnt vmcnt(26)" ::: "memory");
            W5_BAR();
            for (int i = 0; i < 32; ++i) {
                if (i + 3 < 32) W5_ISSUE(i + 3);
                if (i + 1 < 32) W5_CONV(i + 1);
                if (i + 3 < 32) { if (wave == 6) asm volatile("s_waitcnt vmcnt(23)" ::: "memory"); else asm volatile("s_waitcnt vmcnt(26)" ::: "memory"); }
                else asm volatile("s_waitcnt vmcnt(0)" ::: "memory");
                W5_BAR();
            }
#undef W5_ISSUE
#undef W5_CONV
        } else {
            f32x16 Sacc;
#pragma unroll
            for (int i = 0; i < 16; ++i) Sacc[i] = 0.f;
            if (wave < 4) {
                if (round != 0) {
#pragma unroll
                    for (int i = 0; i < 16; ++i) Sacc[i] = SSV[(((size_t)bh * 4 + wave) * 16 + i) * 64 + lane]; }
                LAS bf16_t* Sn = SBF + (32 * half + t) * 72 + 32 * kh;
#pragma unroll
                for (int g4 = 0; g4 < 4; ++g4) *(LAS u32x2*)(Sn + 8 * g4 + 4 * hh) = (u32x2){cvt_pk_bf16(Sacc[4 * g4], Sacc[4 * g4 + 1]), cvt_pk_bf16(Sacc[4 * g4 + 2], Sacc[4 * g4 + 3])};
            }
            W5_BAR();
            W5_BAR();
            for (int i = 0; i < 32; ++i) {
                const int chunk = chunk0 + i, bi = i & 1; LAS unsigned char* sb = lds + (i & 3) * SETB;
                LAS bf16_t* WyT = (LAS bf16_t*)sb; LAS bf16_t* WzT = (LAS bf16_t*)(sb + 2560); LAS bf16_t* R2T = (LAS bf16_t*)(sb + 7680); LAS bf16_t* PpT = (LAS bf16_t*)(sb + 12288);
                LAS float* GC = (LAS float*)(sb + 21504); LAS bf16_t* VmT = (LAS bf16_t*)(sb + 21760);
                f32x16 acc;
#pragma unroll
                for (int k = 0; k < 16; ++k) acc[k] = 0.f;
                if (wave < 4) {
                    const LAS bf16_t* Sb = SBF + bi * (64 * 72) + 32 * half * 72;
                    acc = mm32<2>(acc, WzT + 32 * kh * 40, 40, VmT + 32 * half * 40, 40, lane);
                    acc = mm32<4>(acc, PpT + 32 * kh * 72, 72, Sb, 72, lane);
                    LAS bf16_t* Sn = SBF + (bi ^ 1) * (64 * 72) + (32 * half + t) * 72 + 32 * kh;
#pragma unroll
                    for (int g4 = 0; g4 < 4; ++g4) { const int k0 = 8 * g4 + 4 * hh; const f32x4 gc4 = *(const LAS f32x4*)(GC + 32 * kh + k0);
#pragma unroll
                        for (int k = 0; k < 4; ++k) Sacc[4 * g4 + k] = fmaf(Sacc[4 * g4 + k], gc4[k], acc[4 * g4 + k]);
                        *(LAS u32x2*)(Sn + k0) = (u32x2){cvt_pk_bf16(Sacc[4 * g4], Sacc[4 * g4 + 1]), cvt_pk_bf16(Sacc[4 * g4 + 2], Sacc[4 * g4 + 3])}; }
                } else {
                    const int yh = wave - 4; const LAS bf16_t* Sb = SBF + bi * (64 * 72) + 32 * yh * 72;
                    acc = mm32<2>(acc, WyT, 40, VmT + 32 * yh * 40, 40, lane);
                    acc = mm32<4>(acc, R2T, 72, Sb, 72, lane);
                    bf16_t* yp = Y + ((size_t)b * SEQ + chunk * 32) * 512 + h * 64 + 32 * yh + t;
#pragma unroll
                    for (int k = 0; k < 16; ++k) yp[(size_t)TROW(k, lane) * 512] = (bf16_t)(cvt_pk_bf16(acc[k], acc[k]) & 0xffffu);
                }
                W5_BAR();
            }
            if (wave < 4) {
#pragma unroll
                for (int i = 0; i < 16; ++i) SSV[(((size_t)bh * 4 + wave) * 16 + i) * 64 + lane] = Sacc[i]; }
        }
    }
#undef W5_BAR
}
__device__ __forceinline__ void phase4s(const Args& a, LAS unsigned char* lds, const XcdBarrier& bar) {
    const int tid = threadIdx.x;
    unsigned char* ws = a.ws;
    for (int item = blockIdx.x; item < 256; item += gridDim.x) {
        if (tid < 64) {
            const int b = item >> 4, g = item & 15, n = tid;
            const f32x2 lamL = ((const f32x2*)(ws + WS_LAML))[g * 64 + n];
            const float* E = (const float*)(ws + WS_E) + ((size_t)g * S5ROWS + b * S5NCH) * 128;
            bf16_t* UG = (bf16_t*)(ws + WS_UG) + ((size_t)g * S5ROWS + b * S5NCH) * S5K + 512;
            float xr = 0.f, xi = 0.f;
#pragma unroll 8
            for (int ch = 0; ch < S5NCH; ++ch) {
                UG[(size_t)ch * S5K + n] = (bf16_t)f2bf(xr); UG[(size_t)ch * S5K + 64 + n] = (bf16_t)f2bf(xi);
                const float er = E[ch * 128 + n], ei = E[ch * 128 + 64 + n];
                const float nr = lamL[0] * xr - lamL[1] * xi + er, ni = lamL[0] * xi + lamL[1] * xr + ei; xr = nr; xi = ni;
            }
        }
    }
    if (gridDim.x != 256) { late_items_idle(a, lds, 0, N_LATE, 0); __syncthreads(); }
    wkv5a2(a, lds, 0); xcd_barrier(bar);
    wkv5b4(a, lds, 0); xcd_barrier(bar);
    wkv5a2(a, lds, 1); xcd_barrier(bar);
    wkv5b4(a, lds, 1);
}

__device__ __forceinline__ void phase5_post(const Args& a) {
    const int gt = blockIdx.x * 512 + threadIdx.x, NT = gridDim.x * 512;
    unsigned char* ws = a.ws;
    const bf16_t* COLS = (const bf16_t*)(ws + WS_A); const bf16_t* LORA = (const bf16_t*)a.out; const bf16_t* Y = (const bf16_t*)(ws + WS_B); const float* BON = (const float*)(ws + WS_BON);
    bf16_t* RO = (bf16_t*)(ws + WS_RWKV);
    const int hq = gt & 127, h = hq >> 4, q = hq & 15, hc = h * 64 + 4 * q;
    float lg[4], lb[4], muv[4];
#pragma unroll
    for (int i = 0; i < 4; ++i) { lg[i] = a.in[I_LNG][hc + i]; lb[i] = a.in[I_LNB][hc + i]; muv[i] = a.in[I_MU][C_V + hc + i]; }
    for (int p = gt; p < T * 128; p += NT) {
        const int t = p >> 7;
        float y4[4]; unpack4(*(const u32x2*)(Y + (size_t)t * 512 + hc), y4);
        float s = (y4[0] + y4[1]) + (y4[2] + y4[3]); s = row16_sum(s); const float mean = s * (1.0f / 64.0f);
        const float d0 = y4[0] - mean, d1 = y4[1] - mean, d2 = y4[2] - mean, d3 = y4[3] - mean;
        float qv = (d0 * d0 + d1 * d1) + (d2 * d2 + d3 * d3); qv = row16_sum(qv); const float rstd = 1.0f / sqrtf(qv * (1.0f / 64.0f) + 64e-5f);
        float vc[4], vp[4], g4[4]; unpack4(*(const u32x2*)(COLS + (size_t)t * INC + C_V + hc), vc);
        if ((t & (SEQ - 1)) != 0) unpack4(*(const u32x2*)(COLS + (size_t)(t - 1) * INC + C_V + hc), vp); else { vp[0] = vp[1] = vp[2] = vp[3] = 0.f; }
        unpack4(*(const u32x2*)(LORA + (size_t)t * 1536 + 1024 + hc), g4);
        const float bon = BON[(size_t)t * 8 + h];
        const float dd[4] = {d0, d1, d2, d3}; float o[4];
#pragma unroll
        for (int i = 0; i < 4; ++i) { const float v = vc[i] + (vp[i] - vc[i]) * muv[i]; o[i] = (dd[i] * rstd * lg[i] + lb[i] + bon * v) * g4[i]; }
        u32x2 w; w.x = cvt_pk_bf16(o[0], o[1]); w.y = cvt_pk_bf16(o[2], o[3]); *(u32x2*)(RO + (size_t)t * 512 + hc) = w;
    }
}

__device__ __forceinline__ void phase9(const Args& a, LAS unsigned char* lds) {
    const int tid = threadIdx.x, lane = tid & 63, wave = tid >> 6;
    unsigned char* ws = a.ws;
    const bf16_t* X1 = (const bf16_t*)a.out; const bf16_t* WR = (const bf16_t*)(ws + WS_WR);
    int4* ROUTE = (int4*)(ws + WS_ROUTE); int* BC = (int*)(ws + WS_BC);
    LAS float* LG = (LAS float*)lds + wave * (16 * 49);
    LAS int* cnt = (LAS int*)(lds + 32768);
    for (int vb = blockIdx.x; vb < 256; vb += gridDim.x) {
        __syncthreads();
        if (tid < 32) cnt[tid] = 0;
        __syncthreads();
        const int t0 = vb * 128 + wave * 16;
        const int ar = lane & 15, aq = lane >> 4;
        f32x4 acc0 = (f32x4){0.f, 0.f, 0.f, 0.f}, acc1 = acc0, acc2 = acc0; float ssq = 0.f;
        const bf16_t* xrow = X1 + (size_t)(t0 + ar) * DM + 8 * aq;
        const bf16_t* wrow = WR + (size_t)ar * DM + 8 * aq;
#pragma unroll 4
        for (int kb = 0; kb < 32; ++kb) {
            const u32x4 af = *(const u32x4*)(xrow + kb * 32); float xf[8]; unpack8(af, xf);
            ssq += (xf[0] * xf[0] + xf[1] * xf[1]) + (xf[2] * xf[2] + xf[3] * xf[3]) + (xf[4] * xf[4] + xf[5] * xf[5]) + (xf[6] * xf[6] + xf[7] * xf[7]);
            const bf16x8 A = __builtin_bit_cast(bf16x8, af);
            const bf16x8 B0 = *(const bf16x8*)(wrow + kb * 32), B1 = *(const bf16x8*)(wrow + 16 * DM + kb * 32), B2 = *(const bf16x8*)(wrow + 32 * DM + kb * 32);
            acc0 = __builtin_amdgcn_mfma_f32_16x16x32_bf16(A, B0, acc0, 0, 0, 0);
            acc1 = __builtin_amdgcn_mfma_f32_16x16x32_bf16(A, B1, acc1, 0, 0, 0);
            acc2 = __builtin_amdgcn_mfma_f32_16x16x32_bf16(A, B2, acc2, 0, 0, 0);
        }
        ssq += __shfl_xor(ssq, 16); ssq += __shfl_xor(ssq, 32);
        const float rs = 1.0f / sqrtf(ssq * (1.0f / DM) + 1e-6f);
#pragma unroll
        for (int r = 0; r < 4; ++r) { const int row = aq * 4 + r; LG[row * 49 + ar] = acc0[r]; LG[row * 49 + 16 + ar] = acc1[r]; LG[row * 49 + 32 + ar] = acc2[r]; }
        LDS_WAIT();
        if (lane < 16) {
            const int t = t0 + lane; const LAS float* lg = LG + lane * 49;
            float gl[4]; float mx = -3.0e38f; int gi = 0;
#pragma unroll
            for (int j = 0; j < 4; ++j) { gl[j] = lg[j] * rs + a.in[I_RGB][j]; if (gl[j] > mx) { mx = gl[j]; gi = j; } }
            float den = 0.f;
#pragma unroll
            for (int j = 0; j < 4; ++j) den += __expf(gl[j] - mx);
            const float gp = 1.0f / den;
            float b1 = -3.0e38f, b2 = -3.0e38f; int i1 = 0, i2 = 0;
            for (int j = 0; j < 8; ++j) { const float v = lg[4 + gi * 8 + j] * rs + a.in[I_REB][gi * 8 + j];
                if (v > b1) { b2 = b1; i2 = i1; b1 = v; i1 = j; } else if (v > b2) { b2 = v; i2 = j; } }
            const float e2 = __expf(b2 - b1), w1 = gp / (1.0f + e2), w2 = gp * e2 / (1.0f + e2);
            const int e0 = gi * 8 + i1, e1 = gi * 8 + i2;
            const int s0 = atomicAdd((int*)&cnt[e0], 1), s1 = atomicAdd((int*)&cnt[e1], 1);
            int4 rt; rt.x = e0 | (e1 << 8); rt.y = s0 | (s1 << 16); rt.z = __builtin_bit_cast(int, w1); rt.w = __builtin_bit_cast(int, w2);
            ROUTE[t] = rt;
        }
        __syncthreads();
        if (tid < 32) BC[vb * 32 + tid] = cnt[tid];
    }
}

__device__ __forceinline__ void phase10(const Args& a, LAS unsigned char* lds) {
    const int tid = threadIdx.x, lane = tid & 63, wave = tid >> 6;
    unsigned char* ws = a.ws;
    const bf16_t* X1 = (const bf16_t*)a.out; const int4* ROUTE = (const int4*)(ws + WS_ROUTE); const int* BC = (const int*)(ws + WS_BC);
    bf16_t* HS = (bf16_t*)(ws + WS_A); float* ROWW = (float*)(ws + WS_ROWW); int2* POS = (int2*)(ws + WS_POS); int* OFF = (int*)(ws + WS_OFF);
    LAS int* ptot = (LAS int*)lds;
    LAS int* pmine = ptot + 512;
    LAS int* base = pmine + 512;
    for (int vb = blockIdx.x; vb < 256; vb += gridDim.x) {
        __syncthreads();
        { const int e = tid & 31, part = tid >> 5; int st = 0, sm = 0;
            for (int k = 0; k < 16; ++k) { const int r = part * 16 + k; const int c = BC[r * 32 + e]; st += c; sm += (r < vb) ? c : 0; }
            ptot[part * 32 + e] = st; pmine[part * 32 + e] = sm; }
        __syncthreads();
        if (tid < 32) { int st = 0, sm = 0; for (int k = 0; k < 16; ++k) { st += ptot[k * 32 + tid]; sm += pmine[k * 32 + tid]; } ptot[tid] = (st + 255) & ~255; pmine[tid] = sm; }
        __syncthreads();
        if (tid < 32) { int off = 0; for (int k = 0; k < tid; ++k) off += ptot[k]; base[tid] = off + pmine[tid];
            if (vb == 0) { OFF[tid] = off; if (tid == 31) OFF[32] = off + ptot[31]; } }
        __syncthreads();
        for (int i0 = 0; i0 < 16; i0 += 2) {
            f32x4 v[2][4]; int4 rt[2];
#pragma unroll
            for (int u = 0; u < 2; ++u) { const int t = vb * 128 + wave * 16 + i0 + u; rt[u] = ROUTE[t]; const u32x2* xr = (const u32x2*)(X1 + (size_t)t * DM) + lane;
#pragma unroll
                for (int j = 0; j < 4; ++j) { const u32x2 w = xr[64 * j]; v[u][j] = (f32x4){bflo(w.x), bfhi(w.x), bflo(w.y), bfhi(w.y)}; } }
#pragma unroll
            for (int u = 0; u < 2; ++u) { const int t = vb * 128 + wave * 16 + i0 + u;
                const int e0 = rt[u].x & 255, e1 = (rt[u].x >> 8) & 255, p0 = base[e0] + (rt[u].y & 0xffff), p1 = base[e1] + ((rt[u].y >> 16) & 0xffff);
                float s = 0.f;
#pragma unroll
                for (int j = 0; j < 4; ++j) s += (v[u][j][0] * v[u][j][0] + v[u][j][1] * v[u][j][1]) + (v[u][j][2] * v[u][j][2] + v[u][j][3] * v[u][j][3]);
                const float rs = 1.0f / sqrtf(wave_sum(s) * (1.0f / DM) + 1e-6f);
                u32x2* o0 = (u32x2*)(HS + (size_t)p0 * DM) + lane; u32x2* o1 = (u32x2*)(HS + (size_t)p1 * DM) + lane;
#pragma unroll
                for (int j = 0; j < 4; ++j) { u32x2 w; w.x = pk2(v[u][j][0] * rs, v[u][j][1] * rs); w.y = pk2(v[u][j][2] * rs, v[u][j][3] * rs); o0[64 * j] = w; o1[64 * j] = w; }
                if (lane == 0) { ROWW[p0] = __builtin_bit_cast(float, rt[u].z); ROWW[p1] = __builtin_bit_cast(float, rt[u].w); POS[t] = make_int2(p0, p1); } }
        }
    }
}

__device__ __forceinline__ void phase13(const Args& a) {
    const int tid = threadIdx.x, lane = tid & 63, wave = tid >> 6;
    const int gw = blockIdx.x * 8 + wave, NGW = gridDim.x * 8;
    unsigned char* ws = a.ws;
    bf16_t* X = (bf16_t*)a.out; const bf16_t* YM = (const bf16_t*)(ws + WS_A); const int2* POS = (const int2*)(ws + WS_POS); bf16_t* HP = (bf16_t*)(ws + WS_HP); bf16_t* P16 = (bf16_t*)(ws + WS_P16);
    for (int t0 = gw; t0 < T; t0 += 2 * NGW) {
        f32x4 v[2][4]; u32x2 ya[2][4], yb[2][4]; f32x4 pv[2];
#pragma unroll
        for (int u = 0; u < 2; ++u) { const int t = t0 + u * NGW; const int2 ps = POS[t];
            const u32x2* xr = (const u32x2*)(X + (size_t)t * DM) + lane; const u32x2* y0 = (const u32x2*)(YM + (size_t)ps.x * DM) + lane; const u32x2* y1 = (const u32x2*)(YM + (size_t)ps.y * DM) + lane;
#pragma unroll
            for (int j = 0; j < 4; ++j) { const u32x2 w = xr[64 * j]; v[u][j] = (f32x4){bflo(w.x), bfhi(w.x), bflo(w.y), bfhi(w.y)}; ya[u][j] = y0[64 * j]; yb[u][j] = y1[64 * j]; }
            pv[u] = *((const f32x4*)(a.in[I_P] + (size_t)t * 256) + lane); }
#pragma unroll
        for (int u = 0; u < 2; ++u) { const int t = t0 + u * NGW; float s = 0.f; u32x2* xr = (u32x2*)(X + (size_t)t * DM) + lane;
#pragma unroll
            for (int j = 0; j < 4; ++j) { float a0[4], a1[4]; unpack4(ya[u][j], a0); unpack4(yb[u][j], a1);
                v[u][j][0] = (v[u][j][0] + a0[0]) + a1[0]; v[u][j][1] = (v[u][j][1] + a0[1]) + a1[1]; v[u][j][2] = (v[u][j][2] + a0[2]) + a1[2]; v[u][j][3] = (v[u][j][3] + a0[3]) + a1[3];
                s += (v[u][j][0] * v[u][j][0] + v[u][j][1] * v[u][j][1]) + (v[u][j][2] * v[u][j][2] + v[u][j][3] * v[u][j][3]); xr[64 * j] = (u32x2){cvt_pk_bf16(v[u][j][0], v[u][j][1]), cvt_pk_bf16(v[u][j][2], v[u][j][3])}; }
            const float rs = 1.0f / sqrtf(wave_sum(s) * (1.0f / DM) + 1e-6f);
            u32x2* o = (u32x2*)(HP + (size_t)t * DM) + lane;
#pragma unroll
            for (int j = 0; j < 4; ++j) { u32x2 w; w.x = pk2(v[u][j][0] * rs, v[u][j][1] * rs); w.y = pk2(v[u][j][2] * rs, v[u][j][3] * rs); o[64 * j] = w; }
            u32x2 w; w.x = pk2(pv[u][0], pv[u][1]); w.y = pk2(pv[u][2], pv[u][3]); *((u32x2*)(P16 + (size_t)t * 256) + lane) = w; }
    }
}
__device__ __forceinline__ void phase15(const Args& a, const bf16_t* XS) {
    const int tid = threadIdx.x, lane = tid & 63, wave = tid >> 6;
    const int gw = blockIdx.x * 8 + wave, NGW = gridDim.x * 8;
    float* X = a.out; const f32x4* gn = (const f32x4*)a.in[I_FINN] + lane;
    f32x4 g[4];
#pragma unroll
    for (int j = 0; j < 4; ++j) g[j] = gn[64 * j];
    for (int t0 = gw; t0 < T; t0 += 2 * NGW) {
        f32x4 v[2][4];
#pragma unroll
        for (int u = 0; u < 2; ++u) { const u32x2* xs = (const u32x2*)(XS + (size_t)(t0 + u * NGW) * DM) + lane;
#pragma unroll
            for (int j = 0; j < 4; ++j) { const u32x2 w = xs[64 * j]; v[u][j] = (f32x4){bflo(w.x), bfhi(w.x), bflo(w.y), bfhi(w.y)}; } }
#pragma unroll
        for (int u = 0; u < 2; ++u) { float s = 0.f;
#pragma unroll
            for (int j = 0; j < 4; ++j) s += (v[u][j][0] * v[u][j][0] + v[u][j][1] * v[u][j][1]) + (v[u][j][2] * v[u][j][2] + v[u][j][3] * v[u][j][3]);
            const float rs = 1.0f / sqrtf(wave_sum(s) * (1.0f / DM) + 1e-6f);
            f32x4* xr = (f32x4*)(X + (size_t)(t0 + u * NGW) * DM) + lane;
#pragma unroll
            for (int j = 0; j < 4; ++j) xr[64 * j] = (f32x4){v[u][j][0] * rs * g[j][0], v[u][j][1] * rs * g[j][1], v[u][j][2] * rs * g[j][2], v[u][j][3] * rs * g[j][3]}; }
    }
}

#ifdef PROBE
__device__ __forceinline__ void phase_probe(const Args& a) {
    const int gt = blockIdx.x * 512 + threadIdx.x, NT = gridDim.x * 512;
#if PROBE == 1
    const bf16_t* src = (const bf16_t*)(a.ws + WS_HP); const size_t n = (size_t)T * DM;
#elif PROBE == 2
    const bf16_t* src = (const bf16_t*)(a.ws + WS_WPG); const size_t n = (size_t)1024 * 1024;
#else
    const bf16_t* src = (const bf16_t*)(a.ws + WS_G); const size_t n = (size_t)T * DM;
#endif
    for (size_t i = gt; i < (size_t)T * DM; i += NT) a.out[i] = (i < n) ? __builtin_bit_cast(float, (unsigned)src[i] << 16) : 0.f;
}
#endif
__global__ void __launch_bounds__(512) mega_fwd(Args a) {
    extern __shared__ __attribute__((aligned(16))) unsigned char lds_raw[];
    LAS unsigned char* lds = (LAS unsigned char*)lds_raw;
    unsigned char* ws = a.ws;
    const int G = gridDim.x, c = blockIdx.x;
    const int lo = a.ph_lo, hi = a.ph_hi;
    if (threadIdx.x < 32) ((LAS unsigned*)(lds + MISC_OFF))[threadIdx.x] = 0u;
    __syncthreads();
    XcdBarrier bar; bar.bar = (unsigned*)(ws + WS_CTL) + 4096; bar.x = 0; bar.st = nullptr;
    if (hi - lo > 1) bar = xcd_barrier_post((unsigned*)(ws + WS_CTL) + 4096, (volatile LAS unsigned*)(lds + MISC_OFF));
#ifndef DUPMASK
#define DUPMASK 0
#endif
#ifndef PHMASK
#define PHMASK 0xFFFFF
#endif
#define IN(k) ((((PHMASK) >> (k)) & 1) && lo <= (k) && (k) < hi)
#define SEAM_MASK 0x5FBB7u
#define SEAM(k) do { if (IN(k) && IN((k) + 1)) { if ((SEAM_MASK >> (k)) & 1u) { xcd_barrier(bar); } else __syncthreads(); } } while (0)
    bf16_t* COLS = (bf16_t*)(ws + WS_A);
    TSTART(100);
    if (IN(0)) for (int rep_ = 0; rep_ < (((DUPMASK) >> 0) & 1 ? 2 : 1); ++rep_) { phase0(a, lds); }
    SEAM(0);
    TSTOP(100);
    TSTART(101);
    if (IN(1)) for (int rep_ = 0; rep_ < (((DUPMASK) >> 1) & 1 ? 2 : 1); ++rep_) {
        pg8::DenseSched S; S.init(a.out, 1024, ws + WS_WIN, 1024, T, INC, G, c);
        pg8::EpiRow8<F_Cols> E{{COLS, INC, (bf16_t*)(ws + WS_UG)}};
        pg8::gemm_phase<pg8::EpiRow8<F_Cols>, pg8::DenseSched, true>(lds, 1024, 1024, 1024, S, E);
    }
    SEAM(1);
    TSTOP(101);
    TSTART(102);
    if (IN(2)) for (int rep_ = 0; rep_ < (((DUPMASK) >> 2) & 1 ? 2 : 1); ++rep_) { phase2(a); }
    SEAM(2);
    TSTOP(102);
    TSTART(103);
    if (IN(3)) for (int rep_ = 0; rep_ < (((DUPMASK) >> 3) & 1 ? 2 : 1); ++rep_) {
        pg8::LoraSched S{(const char*)(ws + WS_Z), (const char*)(ws + WS_WLORA), {}}; S.so.init(T, 1536, G, c);
        pg8::EpiRow8<F_Lora> E{{(bf16_t*)a.out, a.in[I_W0], a.in[I_A0]}};
        pg8::gemm_phase<pg8::EpiRow8<F_Lora>, pg8::LoraSched, true>(lds, 128, 256, 256, S, E);
    }
    SEAM(3);
    TSTOP(103);
    TSTART(104);
    if (IN(4)) for (int rep_ = 0; rep_ < (((DUPMASK) >> 4) & 1 ? 2 : 1); ++rep_) {
        pg8::GroupSched S{(const char*)(ws + WS_UG), (const char*)(ws + WS_W1), S5K, 512, 4, 1, 16, G, c, (size_t)S5ROWS * S5K * 2, (size_t)256 * 512 * 2};
        pg8::EpiRow8<F_S5a> E{{(float*)(ws + WS_E)}};
        pg8::gemm_phase<pg8::EpiRow8<F_S5a>, pg8::GroupSched, true>(lds, 512, S5K, 512, S, E);
        if (G == 256) { late_items_idle(a, lds, 0, 896, 64); late_items_idle(a, lds, 1536, 1568, 64); }
    }
    SEAM(4);
    TSTOP(104);
    TSTART(105);
    if (IN(5)) for (int rep_ = 0; rep_ < (((DUPMASK) >> 5) & 1 ? 2 : 1); ++rep_) {
#if WKV_CHUNKED == 2
        phase4s(a, lds, bar);
#elif WKV_CHUNKED
        phase4c(a, lds);
#else
        phase4(a, lds);
#endif
    }
    SEAM(5);
    TSTOP(105);
    TSTART(106);
    if (IN(6)) for (int rep_ = 0; rep_ < (((DUPMASK) >> 6) & 1 ? 2 : 1); ++rep_) { phase5_post(a); }
    SEAM(6);
    TSTOP(106);
    TSTART(107);
    if (IN(7)) for (int rep_ = 0; rep_ < (((DUPMASK) >> 7) & 1 ? 2 : 1); ++rep_) {
        pg8::GroupSched S{(const char*)(ws + WS_UG), (const char*)(ws + WS_TZ), S5K, S5K, 4, 2, 16, G, c, (size_t)S5ROWS * S5K * 2, (size_t)S5N * S5K * 2};
        pg8::EpiRow8<F_S5c> E{{COLS, a.in[I_SD], (bf16_t*)(ws + WS_Z)}};
        pg8::gemm_phase<pg8::EpiRow8<F_S5c>, pg8::GroupSched, true>(lds, S5K, S5K, S5K, S, E);
        if (G == 256) late_items_idle(a, lds, 1568, N_LATE, 128);
    }
    SEAM(7);
    TSTOP(107);
    TSTART(108);
    if (IN(8)) for (int rep_ = 0; rep_ < (((DUPMASK) >> 8) & 1 ? 2 : 1); ++rep_) {
        pg8::DenseSched S; S.init(ws + WS_Z, 256, ws + WS_WGLU, 256, T, 256, G, c);
        pg8::EpiRow8<F_Glu> E{{(const bf16_t*)(ws + WS_Z), a.in[I_GLUB], (bf16_t*)a.out}};
        pg8::gemm_phase<pg8::EpiRow8<F_Glu>, pg8::DenseSched, true>(lds, 256, 256, 256, S, E);
        if (G == 256) late_items_idle(a, lds, 896, 1536, 128);
    }
    SEAM(8);
    TSTOP(108);
    TSTART(109);
    if (IN(9)) for (int rep_ = 0; rep_ < (((DUPMASK) >> 9) & 1 ? 2 : 1); ++rep_) {
        pg8::BrSched S{(const char*)(ws + WS_RWKV), (const char*)(ws + WS_WBA), (const char*)a.out, (const char*)(ws + WS_WBB), {}}; S.so.init(T, DM, G, c);
        pg8::EpiBr E{COLS, (bf16_t*)(ws + WS_B)};
        pg8::gemm_phase2<pg8::EpiBr, pg8::BrSched, true, 8, 4>(lds, 512, 512, S, E);
    }
    SEAM(9);
    TSTOP(109);
    TSTART(110);
    SEAM(10);
    TSTOP(110);
    TSTART(111);
    if (IN(11)) for (int rep_ = 0; rep_ < (((DUPMASK) >> 11) & 1 ? 2 : 1); ++rep_) {
        pg8::DenseSched S; S.init(ws + WS_B, 1024, ws + WS_WOUT, 1024, T, DM, G, c);
        pg8::EpiRow8<F_Res> E{{a.in[I_X], (bf16_t*)a.out}};
        pg8::gemm_phase<pg8::EpiRow8<F_Res>, pg8::DenseSched, true>(lds, 1024, 1024, 1024, S, E);
    }
    SEAM(11);
    TSTOP(111);
    TSTART(112);
    if (IN(12)) for (int rep_ = 0; rep_ < (((DUPMASK) >> 12) & 1 ? 2 : 1); ++rep_) { phase9(a, lds); }
    SEAM(12);
    TSTOP(112);
    TSTART(113);
    if (IN(13)) for (int rep_ = 0; rep_ < (((DUPMASK) >> 13) & 1 ? 2 : 1); ++rep_) { phase10(a, lds); }
    SEAM(13);
    TSTOP(113);
    TSTART(114);
    if (IN(14)) for (int rep_ = 0; rep_ < (((DUPMASK) >> 14) & 1 ? 2 : 1); ++rep_) {
        pg8::MoeSched S{(const int*)(ws + WS_OFF), (const char*)(ws + WS_A), (const char*)(ws + WS_WGU), 1024, 1024, 2, G, c, (size_t)512 * 1024 * 2};
        pg8::EpiMoeUp E{(bf16_t*)(ws + WS_HID)};
        pg8::gemm_phase<pg8::EpiMoeUp, pg8::MoeSched, true>(lds, 1024, 1024, 1024, S, E);
    }
    SEAM(14);
    TSTOP(114);
    TSTART(115);
    if (IN(15)) for (int rep_ = 0; rep_ < (((DUPMASK) >> 15) & 1 ? 2 : 1); ++rep_) {
        pg8::MoeSched S{(const int*)(ws + WS_OFF), (const char*)(ws + WS_HID), (const char*)(ws + WS_WD), 256, 256, 4, G, c, (size_t)1024 * 256 * 2};
        pg8::EpiRow8<F_MoeDown> E{{(const float*)(ws + WS_ROWW), (bf16_t*)(ws + WS_A)}};
        pg8::gemm_phase<pg8::EpiRow8<F_MoeDown>, pg8::MoeSched, true>(lds, 256, 256, 256, S, E);
    }
    SEAM(15);
    TSTOP(115);
    TSTART(116);
    if (IN(16)) for (int rep_ = 0; rep_ < (((DUPMASK) >> 16) & 1 ? 2 : 1); ++rep_) { phase13(a); }
    SEAM(16);
    TSTOP(116);
    TSTART(117);
    if (IN(17)) for (int rep_ = 0; rep_ < (((DUPMASK) >> 17) & 1 ? 2 : 1); ++rep_) {
        pg8::DenseSched S; S.init(ws + WS_HP, 1024, ws + WS_WPG, 1024, T, DM, G, c);
        pg8::EpiRow8<F_PleG> E{{(bf16_t*)(ws + WS_G)}};
        pg8::gemm_phase<pg8::EpiRow8<F_PleG>, pg8::DenseSched, true>(lds, 1024, 1024, 1024, S, E);
    }
    SEAM(17);
    TSTOP(117);
    TSTART(118);
    if (IN(18)) for (int rep_ = 0; rep_ < (((DUPMASK) >> 18) & 1 ? 2 : 1); ++rep_) {
        pg8::DenseSched S; S.init(ws + WS_P16, 256, ws + WS_WPP, 256, T, DM, G, c);
        pg8::EpiRow8<F_PleP> E{{(const bf16_t*)(ws + WS_G), (const bf16_t*)a.out, (bf16_t*)(ws + WS_A)}};
        pg8::gemm_phase<pg8::EpiRow8<F_PleP>, pg8::DenseSched, true>(lds, 256, 256, 256, S, E);
    }
    SEAM(18);
    TSTOP(118);
#ifdef PROBE
    TSTART(119);
    if (IN(19)) for (int rep_ = 0; rep_ < (((DUPMASK) >> 19) & 1 ? 2 : 1); ++rep_) { phase_probe(a); }
#else
    TSTART(119);
    if (IN(19)) for (int rep_ = 0; rep_ < (((DUPMASK) >> 19) & 1 ? 2 : 1); ++rep_) { phase15(a, ((PHMASK >> 18) & 1) ? (const bf16_t*)(ws + WS_A) : (const bf16_t*)a.out); }
#endif
    TSTOP(119);
#if TIMER_SEL || TIMER_PHMASK
    if (blockIdx.x == 0 && threadIdx.x == 0) { const unsigned acc_ = ((volatile LAS unsigned*)(lds + MISC_OFF + 64))[0]; const unsigned long long t0_ = __builtin_amdgcn_s_memrealtime();
        while (__builtin_amdgcn_s_memrealtime() - t0_ < (unsigned long long)acc_ * TIMER_MULT) __builtin_amdgcn_s_sleep(8); }
#endif
#undef IN
#undef SEAM
}

extern "C" void kernel_launch(void* const* d_in, const int* in_sizes, int n_in, void* d_out, int out_size, void* d_ws, size_t ws_size, hipStream_t stream) {
    static int grid = 0;
    if (grid == 0) {
        if (n_in != 40 || out_size != T * DM || ws_size < WS_END) { fprintf(stderr, "kernel_launch: unexpected problem (n_in %d, out %d, ws %zu < %zu); nothing launched\n", n_in, out_size, ws_size, (size_t)WS_END); grid = -1; return; }
        int dev = 0, cus = 0, per_cu = 0;
        hipGetDevice(&dev); hipDeviceGetAttribute(&cus, hipDeviceAttributeMultiprocessorCount, dev);
        if (hipFuncSetAttribute((const void*)mega_fwd, hipFuncAttributeMaxDynamicSharedMemorySize, LDS_BYTES) != hipSuccess) { fprintf(stderr, "kernel_launch: hipFuncSetAttribute failed\n"); grid = -1; return; }
        if (hipOccupancyMaxActiveBlocksPerMultiprocessor(&per_cu, (const void*)mega_fwd, 512, LDS_BYTES) != hipSuccess || per_cu < 1) { fprintf(stderr, "kernel_launch: occupancy query says %d\n", per_cu); per_cu = 1; }
        (void)hipGetLastError();
        grid = cus * 1;
        if (grid > 256) grid = 256;
    }
    if (grid < 0) return;
    Args a{};
    for (int i = 0; i < 40; ++i) a.in[i] = (const float*)d_in[i];
    a.out = (float*)d_out; a.ws = (unsigned char*)d_ws;
#if MK_N_LAUNCHES == 1
    if (hipMemsetAsync((char*)d_ws + WS_CTL, 0, 65536, stream) != hipSuccess) { fprintf(stderr, "kernel_launch: memset failed\n"); return; }
    a.ph_lo = 0; a.ph_hi = NPHASE;
    void* kargs[] = {&a};
    hipError_t e = hipLaunchCooperativeKernel((const void*)mega_fwd, dim3(grid), dim3(512), kargs, LDS_BYTES, stream);
    if (e != hipSuccess) fprintf(stderr, "kernel_launch: cooperative launch failed: %s\n", hipGetErrorString(e));
#else
    for (int k = 0; k < NPHASE; ++k) {
        a.ph_lo = k; a.ph_hi = k + 1;
        hipLaunchKernelGGL(mega_fwd, dim3(grid), dim3(512), LDS_BYTES, stream, a);
    }
#endif
}
```

```cpp
#include <hip/hip_runtime.h>
#include <hip/hip_cooperative_groups.h>
#include <cstdio>
#include <cstdint>
namespace cg = cooperative_groups;

#ifndef WKV_CHUNKED
#define WKV_CHUNKED 2
#endif
#ifndef MK_N_LAUNCHES
#define MK_N_LAUNCHES 1
#endif

#define LAS __attribute__((address_space(3)))
typedef unsigned short bf16_t;
typedef short bf16x8 __attribute__((ext_vector_type(8)));
typedef float f32x4 __attribute__((ext_vector_type(4)));
typedef float f32x2 __attribute__((ext_vector_type(2)));
typedef unsigned u32x4 __attribute__((ext_vector_type(4)));
typedef unsigned u32x2 __attribute__((ext_vector_type(2)));

constexpr int T = 32768, DM = 1024, SEQ = 2048, NBATCH = 16, INC = 4096;
constexpr int C_R = 0, C_K = 512, C_V = 1024, C_WD = 1536, C_U = 1792, C_GA = 2048, C_GB = 3072;
constexpr int S5L = 32, S5NCH = 64, S5K = 640, S5N = 512, S5ROWS = 1024;
constexpr int NEXP = 32, DEXP = 256, MOE_ROWS_MAX = 2 * T + NEXP * 256;
constexpr int NPHASE = 20;

constexpr size_t MiB = (size_t)1 << 20, KiB = 1024;
constexpr size_t WS_CTL = 0;
constexpr size_t WS_WIN = 1 * MiB, WS_WBA = 9 * MiB, WS_WBB = 10 * MiB, WS_WOUT = 11 * MiB, WS_WPG = 13 * MiB, WS_WPP = 15 * MiB;
constexpr size_t WS_WLORA = 16 * MiB, WS_WGLU = 17 * MiB, WS_WR = 17 * MiB + 512 * KiB, WS_LAML = 17 * MiB + 768 * KiB;
constexpr size_t WS_KG = 18 * MiB, WS_W1 = 19 * MiB, WS_TZ = 23 * MiB, WS_WGU = 33 * MiB, WS_WD = 65 * MiB;
constexpr size_t WS_A = 82 * MiB;
constexpr size_t WS_HID = WS_A + 144 * MiB, WS_G = WS_A + 128 * MiB;
constexpr size_t WS_B = 338 * MiB;
constexpr size_t WS_UG = 402 * MiB, WS_E = 422 * MiB, WS_BON = 430 * MiB, WS_RWKV = 431 * MiB, WS_Z = 463 * MiB, WS_S5O = 479 * MiB;
constexpr size_t WS_ROUTE = 495 * MiB, WS_POS = 495 * MiB + 512 * KiB, WS_ROWW = 496 * MiB, WS_BC = 496 * MiB + 512 * KiB, WS_OFF = 496 * MiB + 768 * KiB;
constexpr size_t WS_HP = WS_RWKV;
constexpr size_t WS_P16 = WS_UG;
constexpr size_t WS_TOK = 497 * MiB;
constexpr size_t WS_RST = 497 * MiB + 512 * KiB, WS_RSROW = 497 * MiB + 640 * KiB;
constexpr size_t WS_END = 498 * MiB;

constexpr int LDS_BYTES = 163840;
constexpr int MISC_OFF = 163584;

struct Args { const float* in[40]; float* out; unsigned char* ws; int ph_lo, ph_hi; };

#ifndef TIMER_SEL
#define TIMER_SEL 0
#endif
#ifndef TIMER_MULT
#define TIMER_MULT 2
#endif
#ifndef TIMER_PHMASK
#define TIMER_PHMASK 0
#endif
#if TIMER_SEL || TIMER_PHMASK
#define TSTART(id) do { if (((id) == TIMER_SEL || ((id) >= 100 && ((TIMER_PHMASK >> ((id) - 100)) & 1))) && blockIdx.x == 0 && threadIdx.x == 0) { volatile LAS unsigned* t_ = (volatile LAS unsigned*)(lds + MISC_OFF + 64); t_[0] = t_[0] - (unsigned)__builtin_amdgcn_s_memrealtime(); } } while (0)
#define TSTOP(id) do { if (((id) == TIMER_SEL || ((id) >= 100 && ((TIMER_PHMASK >> ((id) - 100)) & 1))) && blockIdx.x == 0 && threadIdx.x == 0) { volatile LAS unsigned* t_ = (volatile LAS unsigned*)(lds + MISC_OFF + 64); t_[0] = t_[0] + (unsigned)__builtin_amdgcn_s_memrealtime(); } } while (0)
#else
#define TSTART(id) do { } while (0)
#define TSTOP(id) do { } while (0)
#endif

#define LDS_WAIT() asm volatile("s_waitcnt lgkmcnt(0)" ::: "memory")
#define VM_WAIT() asm volatile("s_waitcnt vmcnt(0)" ::: "memory")
__device__ __forceinline__ unsigned f2bf(float f) { unsigned u = __builtin_bit_cast(unsigned, f); return (u + 0x7fffu + ((u >> 16) & 1u)) >> 16; }
__device__ __forceinline__ unsigned pk2(float lo, float hi) { return f2bf(lo) | (f2bf(hi) << 16); }
typedef __bf16 bf16x2_t __attribute__((ext_vector_type(2)));
__device__ __forceinline__ unsigned cvt_pk_bf16(float lo, float hi) { const f32x2 v = {lo, hi}; const bf16x2_t b = __builtin_convertvector(v, bf16x2_t); return __builtin_bit_cast(unsigned, b); }
__device__ __forceinline__ float bflo(unsigned w) { return __builtin_bit_cast(float, w << 16); }
__device__ __forceinline__ float bfhi(unsigned w) { return __builtin_bit_cast(float, w & 0xffff0000u); }
__device__ __forceinline__ void unpack8(u32x4 w, float (&v)[8]) { v[0] = bflo(w.x); v[1] = bfhi(w.x); v[2] = bflo(w.y); v[3] = bfhi(w.y); v[4] = bflo(w.z); v[5] = bfhi(w.z); v[6] = bflo(w.w); v[7] = bfhi(w.w); }
__device__ __forceinline__ void unpack4(u32x2 w, float (&v)[4]) { v[0] = bflo(w.x); v[1] = bfhi(w.x); v[2] = bflo(w.y); v[3] = bfhi(w.y); }
__device__ __forceinline__ u32x4 pack8(const float (&v)[8]) { u32x4 w; w.x = cvt_pk_bf16(v[0], v[1]); w.y = cvt_pk_bf16(v[2], v[3]); w.z = cvt_pk_bf16(v[4], v[5]); w.w = cvt_pk_bf16(v[6], v[7]); return w; }
__device__ __forceinline__ float sigmoidf_(float x) { return __builtin_amdgcn_rcpf(1.0f + __expf(-x)); }
__device__ __forceinline__ float tanhf_(float x) { return 1.0f - 2.0f * __builtin_amdgcn_rcpf(1.0f + __expf(2.0f * x)); }
__device__ __forceinline__ float gelu_tanh(float y) { return y * __builtin_amdgcn_rcpf(1.0f + __expf(-1.5957691216057308f * (y + 0.044715f * y * y * y))); }
__device__ __forceinline__ float wave_sum(float v) {
#pragma unroll
    for (int o = 1; o < 64; o <<= 1) v += __shfl_xor(v, o);
    return v;
}
__device__ __forceinline__ float dpp_f(float x, const int ctrl_sel) {
    int xi = __builtin_bit_cast(int, x), r;
    if (ctrl_sel == 0) r = __builtin_amdgcn_update_dpp(0, xi, 0xB1, 0xf, 0xf, true);
    else if (ctrl_sel == 1) r = __builtin_amdgcn_update_dpp(0, xi, 0x4E, 0xf, 0xf, true);
    else if (ctrl_sel == 2) r = __builtin_amdgcn_update_dpp(0, xi, 0x141, 0xf, 0xf, true);
    else r = __builtin_amdgcn_update_dpp(0, xi, 0x140, 0xf, 0xf, true);
    return __builtin_bit_cast(float, r);
}
__device__ __forceinline__ float row16_sum(float x) {
    x += dpp_f(x, 0); x += dpp_f(x, 1); x += dpp_f(x, 2); x += dpp_f(x, 3); return x;
}


#define XB_TMO      128
#define XB_XCNT(j)  (256  + 64 * (j))
#define XB_XSUB(j)  (1280 + 64 * (j))
#define XB_XGEN(j)  (2304 + 64 * (j))
#define XB_TOP      3328
#define XB_TOPGEN   3392
#define XCD_BAR_WORDS 3456
#define XB_SPIN_CAP (1u << 22)
__device__ __forceinline__ unsigned xb_ld(unsigned* p)              { return __hip_atomic_load(p, __ATOMIC_RELAXED, __HIP_MEMORY_SCOPE_AGENT); }
__device__ __forceinline__ unsigned xb_add(unsigned* p, unsigned v) { return __hip_atomic_fetch_add(p, v, __ATOMIC_RELAXED, __HIP_MEMORY_SCOPE_AGENT); }
__device__ __forceinline__ unsigned xb_xcc_id() { return (unsigned)__builtin_amdgcn_s_getreg((3 << 11) | 20) & 0xFu; }
#define XB_SPIN(cond, bar) do { unsigned _sp = 0; while (cond) { __builtin_amdgcn_s_sleep(1); \
    if ((++_sp & 255u) == 0u) { if (xb_ld(&(bar)[XB_TMO])) break; if (_sp > XB_SPIN_CAP) { atomicAdd(&(bar)[XB_TMO], 1u); break; } } } } while (0)
struct XcdBarrier { unsigned* bar; unsigned x; volatile LAS unsigned* st; };
__device__ __forceinline__ XcdBarrier xcd_barrier_post(unsigned* bar, volatile LAS unsigned* st) {
    XcdBarrier b; b.bar = bar; b.x = xb_xcc_id(); b.st = st;
    if (threadIdx.x == 0) (void)xb_add(&bar[XB_XCNT(b.x)], 1u);
    return b;
}
__device__ __forceinline__ void xcd_barrier_complete(unsigned* bar, unsigned x, unsigned& nloc, unsigned& nx) {
    const unsigned G = gridDim.x * gridDim.y * gridDim.z;
    unsigned sum, cnt, mine, sp = 0u;
    for (;;) {
        sum = 0u; cnt = 0u; mine = 0u;
#pragma unroll
        for (unsigned j = 0; j < 16; ++j) { const unsigned c = xb_ld(&bar[XB_XCNT(j)]); sum += c; cnt += (c > 0u) ? 1u : 0u; mine = (j == x) ? c : mine; }
        if (sum == G) break;
        __builtin_amdgcn_s_sleep(1);
        if ((++sp & 255u) == 0u) { if (xb_ld(&bar[XB_TMO])) break; if (sp > XB_SPIN_CAP) { atomicAdd(&bar[XB_TMO], 1u); break; } }
    }
    nloc = mine > 0u ? mine : 1u; nx = cnt > 0u ? cnt : 1u;
}
__device__ __forceinline__ void xcd_barrier(const XcdBarrier& b) {
    asm volatile("s_waitcnt vmcnt(0)" ::: "memory");
    __syncthreads();
    if (threadIdx.x == 0) {
        unsigned* bar = b.bar;
        __builtin_amdgcn_s_waitcnt(0);
        unsigned nloc = b.st[0], nx = b.st[1];
        if (nloc == 0u) { xcd_barrier_complete(bar, b.x, nloc, nx); b.st[0] = nloc; b.st[1] = nx; }
        const unsigned old = xb_add(&bar[XB_XSUB(b.x)], 1u);
        const unsigned gen = old / nloc;
        if (old + 1u == (gen + 1u) * nloc) {
            __builtin_amdgcn_fence(__ATOMIC_RELEASE, "agent");
            asm volatile("s_waitcnt vmcnt(0)" ::: "memory");
            const unsigned og = xb_add(&bar[XB_TOP], 1u);
            const unsigned tg = og / nx;
            if (og + 1u == (tg + 1u) * nx) xb_add(&bar[XB_TOPGEN], 1u);
            else XB_SPIN(xb_ld(&bar[XB_TOPGEN]) == tg, bar);
            __builtin_amdgcn_fence(__ATOMIC_ACQUIRE, "agent");
            xb_add(&bar[XB_XGEN(b.x)], 1u);
            asm volatile("s_waitcnt vmcnt(0)" ::: "memory");
        } else {
            XB_SPIN(xb_ld(&bar[XB_XGEN(b.x)]) == gen, bar);
            __builtin_amdgcn_fence(__ATOMIC_ACQUIRE, "agent");
            asm volatile("s_waitcnt vmcnt(0)" ::: "memory");
        }
    }
    __syncthreads();
}

namespace pg8 {
constexpr int BM = 256, BK = 64, HALF = 128, HTB = HALF * BK * 2, STAGE_BYTES = 8 * HTB, NXCD = 8, WGM = 8;
__host__ __device__ __forceinline__ int lds_byte(int r, int c) { const int st = (r >> 4) * 2 + (c >> 5), rr = r & 15, cc = c & 31, ob = rr * 64 + cc * 2; return st * 1024 + (ob ^ (((ob >> 9) & 1) << 5)); }
__host__ __device__ __forceinline__ void stage_rc(int b, int& R, int& C) { const int st = b / 1024, sb = b % 1024, swz = sb ^ (((sb >> 9) & 1) << 5); R = (st >> 1) * 16 + swz / 64; C = (st & 1) * 32 + (swz % 64) / 2; }
__host__ __device__ __forceinline__ int perm32(int rho) { const int n = rho >> 4, i = rho & 15; return 8 * (i >> 2) + 4 * n + (i & 3); }

struct Unit { int pm, pn, aux; const char* A; const char* B; };

struct StaticOrder {
    int nM, nN, nwg, G, c;
    __device__ __forceinline__ void init(int M, int N, int G_, int c_) { nM = M / BM; nN = N / BM; nwg = nM * nN; G = G_; c = c_; }
    __device__ __forceinline__ bool next(int i, int& pm, int& pn) const {
        const long L = (long)i * G + c; if (L >= nwg) return false;
        int wgid = (int)L; { const int q = nwg / NXCD, r = nwg % NXCD, xcd = wgid % NXCD, off = wgid / NXCD; wgid = (xcd < r ? xcd * (q + 1) : r * (q + 1) + (xcd - r) * q) + off; }
        const int nig = WGM * nN, gid = wgid / nig, fm = gid * WGM, gsz = (nM - fm) < WGM ? (nM - fm) : WGM;
        pm = fm + ((wgid % nig) % gsz); pn = (wgid % nig) / gsz; return true;
    }
};
struct DenseSched {
    const char* A; const char* B; int lda, ldb; StaticOrder so;
    __device__ __forceinline__ void init(const void* A_, int lda_, const void* B_, int ldb_, int M, int N, int G, int c) { A = (const char*)A_; B = (const char*)B_; lda = lda_; ldb = ldb_; so.init(M, N, G, c); }
    __device__ __forceinline__ bool next(int i, Unit& u) const {
        int pm, pn; if (!so.next(i, pm, pn)) return false;
        u.pm = pm; u.pn = pn; u.aux = 0; u.A = A + (size_t)pm * BM * lda * 2; u.B = B + (size_t)pn * BM * ldb * 2; return true;
    }
};
struct LoraSched {
    const char* A; const char* B; StaticOrder so;
    __device__ __forceinline__ bool next(int i, Unit& u) const {
        int pm, pn; if (!so.next(i, pm, pn)) return false;
        const int k0 = pn < 4 ? 0 : 128;
        u.pm = pm; u.pn = pn; u.aux = 0; u.A = A + ((size_t)pm * BM * 256 + k0) * 2; u.B = B + ((size_t)pn * BM * 256 + k0) * 2; return true;
    }
};
struct GroupSched {
    const char* A; const char* B; int lda, ldb, nM, nN, ngroups, G, c; size_t aStride, bStride;
    __device__ __forceinline__ bool next(int i, Unit& u) const {
        const int L = i * G + c; if (L >= ngroups * nM * nN) return false;
        const int g = L / (nM * nN), r = L % (nM * nN), pm = r % nM, pn = r / nM;
        u.pm = pm; u.pn = pn; u.aux = g; u.A = A + g * aStride + (size_t)pm * BM * lda * 2; u.B = B + g * bStride + (size_t)pn * BM * ldb * 2; return true;
    }
};
struct MoeSched {
    const int* off; const char* A; const char* B; int lda, ldb, NPN, G, c; size_t bStride; int bal;
    __device__ __forceinline__ bool next(int i, Unit& u) const {
        const int nTiles = off[NEXP] >> 8; int L = i * G + c;
        if (bal) { const int n3 = 2 * nTiles - 2 * G;
            if (n3 > 0 && n3 < G) { if (c < n3) { if (i >= 3) return false; L = i * n3 + c; } else L = 3 * n3 + i * (G - n3) + (c - n3); } }
        if (L >= nTiles * NPN) return false;
        { const int nu = nTiles * NPN, q = nu / NXCD, r = nu % NXCD, xcd = L % NXCD, o2 = L / NXCD; L = (xcd < r ? xcd * (q + 1) : r * (q + 1) + (xcd - r) * q) + o2; }
        const int tile = L / NPN, pn = L % NPN; const int e = off[40 + tile];
        u.pm = tile; u.pn = pn; u.aux = e; u.A = A + (size_t)tile * BM * lda * 2; u.B = B + e * bStride + (size_t)pn * BM * ldb * 2; return true;
    }
};

template <class F> struct EpiRow8 {
    F f;
    __device__ __forceinline__ void operator()(const f32x4 (&acc)[2][2][4][2], const Unit& u, int wr, int wc, int fr, int fq) const {
#pragma unroll
        for (int ai = 0; ai < 2; ++ai)
#pragma unroll
            for (int m = 0; m < 4; ++m) { const int r = ai * HALF + wr * 64 + m * 16 + fr;
#pragma unroll
                for (int bj = 0; bj < 2; ++bj) { const int c = bj * HALF + wc * 32 + 8 * fq;
                    float v[8] = {acc[ai][bj][m][0][0], acc[ai][bj][m][0][1], acc[ai][bj][m][0][2], acc[ai][bj][m][0][3], acc[ai][bj][m][1][0], acc[ai][bj][m][1][1], acc[ai][bj][m][1][2], acc[ai][bj][m][1][3]};
                    f(u, r, c, v); } }
    }
};
template <class F> struct EpiRow8P {
    F f;
    __device__ __forceinline__ void operator()(const f32x4 (&acc)[2][2][4][2], const Unit& u, int wr, int wc, int fr, int fq) const {
        constexpr int NB = F::NB;
#pragma unroll
        for (int g = 0; g < 16 / NB; ++g) {
            typename F::Pre pre[NB];
#pragma unroll
            for (int j = 0; j < NB; ++j) { const int i = g * NB + j, ai = i >> 3, m = (i >> 1) & 3, bj = i & 1; f.pre(u, ai * HALF + wr * 64 + m * 16 + fr, bj * HALF + wc * 32 + 8 * fq, pre[j]); }
#pragma unroll
            for (int j = 0; j < NB; ++j) { const int i = g * NB + j, ai = i >> 3, m = (i >> 1) & 3, bj = i & 1;
                float v[8] = {acc[ai][bj][m][0][0], acc[ai][bj][m][0][1], acc[ai][bj][m][0][2], acc[ai][bj][m][0][3], acc[ai][bj][m][1][0], acc[ai][bj][m][1][1], acc[ai][bj][m][1][2], acc[ai][bj][m][1][3]};
                f.post(u, ai * HALF + wr * 64 + m * 16 + fr, bj * HALF + wc * 32 + 8 * fq, v, pre[j]); }
        }
    }
};
struct EpiMoeUp {
    bf16_t* HID; const float* RS;
    __device__ __forceinline__ void operator()(const f32x4 (&acc)[2][2][4][2], const Unit& u, int wr, int wc, int fr, int fq) const {
        const __amdgpu_buffer_rsrc_t hid_rsrc = __builtin_amdgcn_make_buffer_rsrc(HID, 0, MOE_ROWS_MAX * DEXP * 2, 0x00020000);
        float rsv[2][4];
#pragma unroll
        for (int ai = 0; ai < 2; ++ai)
#pragma unroll
            for (int m = 0; m < 4; ++m) rsv[ai][m] = RS[u.pm * BM + ai * HALF + wr * 64 + m * 16 + fr];
#pragma unroll
        for (int ai = 0; ai < 2; ++ai)
#pragma unroll
            for (int m = 0; m < 4; ++m) { const int r = u.pm * BM + ai * HALF + wr * 64 + m * 16 + fr; const int hc = u.pn * HALF + wc * 32 + 8 * fq;
                float o[8];
#pragma unroll
                for (int n = 0; n < 2; ++n)
#pragma unroll
                    for (int k = 0; k < 4; ++k) { const float g = acc[ai][0][m][n][k] * rsv[ai][m], up = acc[ai][1][m][n][k] * rsv[ai][m]; o[4 * n + k] = g * sigmoidf_(g) * up; }
                __builtin_amdgcn_raw_buffer_store_b128(pack8(o), hid_rsrc, (unsigned)(((size_t)r * DEXP + hc) * 2), 0,   16); }
    }
};

template <class Epi, class Sched, bool ALIGN_EPI>
__device__ __forceinline__ void gemm_phase(LAS unsigned char* lds, const int K, const int lda, const int ldb, const Sched& S, const Epi& E) {
    const int tid = threadIdx.x, wid = __builtin_amdgcn_readfirstlane(tid >> 6), lane = tid & 63, wr = wid >> 2, wc = wid & 3, fr = lane & 15, fq = lane >> 4;
    const int nt = K / BK;
    unsigned voffA[2], voffB[2];
#pragma unroll
    for (int i = 0; i < 2; ++i) { int R, C; stage_rc(tid * 16 + i * 8192, R, C); const int Rb = (R & ~31) + perm32(R & 31);
        voffA[i] = (unsigned)(R * lda + C) * 2u; voffB[i] = (unsigned)(Rb * ldb + C) * 2u; }
    const size_t kstep = (size_t)(BK * 2);
    const size_t hstepA = (size_t)HALF * lda * 2, hstepB = (size_t)HALF * ldb * 2;
    const unsigned ldsw = (unsigned)wid * 1024u;
    const int aoff = lds_byte(wr * 64 + fr, fq * 8), boff = lds_byte(wc * 32 + fr, fq * 8);
#define PG8_SA(b, h) (((b) * 2 + (h)) * HTB)
#define PG8_SB(b, h) ((4 + (b) * 2 + (h)) * HTB)
#define PG8_STAGE(bufoff, gbase, voff) do { _Pragma("unroll") for (int _i = 0; _i < 2; ++_i) \
        __builtin_amdgcn_global_load_lds((const unsigned*)((const char*)(gbase) + (voff)[_i]), (LAS unsigned*)(lds + (bufoff) + ldsw + _i * 8192), 16, 0, 0); } while (0)
#define PG8_LDA(dst, b, h) do { _Pragma("unroll") for (int m = 0; m < 4; ++m) _Pragma("unroll") for (int k = 0; k < 2; ++k) dst[m][k] = *(const LAS bf16x8*)(lds + PG8_SA(b, h) + aoff + m * 2048 + k * 1024); } while (0)
#define PG8_LDB(dst, b, h) do { _Pragma("unroll") for (int n = 0; n < 2; ++n) _Pragma("unroll") for (int k = 0; k < 2; ++k) dst[n][k] = *(const LAS bf16x8*)(lds + PG8_SB(b, h) + boff + n * 2048 + k * 1024); } while (0)
#define PG8_MMA(ai, bj, At, Bt) do { __builtin_amdgcn_s_setprio(1); _Pragma("unroll") for (int m = 0; m < 4; ++m) _Pragma("unroll") for (int n = 0; n < 2; ++n) _Pragma("unroll") for (int k = 0; k < 2; ++k) \
        acc[ai][bj][m][n] = __builtin_amdgcn_mfma_f32_16x16x32_bf16(Bt[n][k], At[m][k], acc[ai][bj][m][n], 0, 0, 0); __builtin_amdgcn_s_setprio(0); } while (0)
#define PG8_WAIT_V(n) asm volatile("s_waitcnt vmcnt(" #n ")" ::: "memory")
#define PG8_WAIT_L(n) asm volatile("s_waitcnt lgkmcnt(" #n ")" ::: "memory")
#define PG8_BAR __builtin_amdgcn_s_barrier()
#define PG8_SCHED __builtin_amdgcn_sched_barrier(0)
    Unit cur, nxt; int ui = 0;
    if (!S.next(0, cur)) return;
    f32x4 acc[2][2][4][2];
#pragma unroll
    for (int a = 0; a < 2; ++a)
#pragma unroll
        for (int b = 0; b < 2; ++b)
#pragma unroll
            for (int m = 0; m < 4; ++m)
#pragma unroll
                for (int n = 0; n < 2; ++n) acc[a][b][m][n] = (f32x4){0.f, 0.f, 0.f, 0.f};
    bf16x8 At[4][2], B0[2][2], B1[2][2];
    const char* cA = cur.A; const char* cB = cur.B;
    PG8_STAGE(PG8_SB(0, 0), cB, voffB); PG8_STAGE(PG8_SB(0, 1), cB + hstepB, voffB); PG8_STAGE(PG8_SA(0, 0), cA, voffA); PG8_STAGE(PG8_SA(0, 1), cA + hstepA, voffA);
    if (wr == 1) PG8_BAR;
    PG8_WAIT_V(2); PG8_BAR;
    PG8_STAGE(PG8_SB(1, 0), cB + kstep, voffB); PG8_STAGE(PG8_SA(1, 0), cA + kstep, voffA); PG8_STAGE(PG8_SB(1, 1), cB + hstepB + kstep, voffB);
    PG8_WAIT_V(6); PG8_BAR;
    for (;;) {
        const bool has_next = S.next(ui + 1, nxt);
        const char* nA = has_next ? nxt.A : cA; const char* nB = has_next ? nxt.B : cB;
#pragma unroll 1
        for (int t = 0; t < nt; t += 2) {
            const bool last = (t == nt - 2);
            const char* a1 = cA + (size_t)(t + 1) * kstep;
            const char* a2 = last ? nA : cA + (size_t)(t + 2) * kstep; const char* b2 = last ? nB : cB + (size_t)(t + 2) * kstep;
            const char* a3 = a2 + kstep; const char* b3 = b2 + kstep;
            PG8_LDB(B0, 0, 0); PG8_LDB(B1, 0, 1); PG8_SCHED; PG8_LDA(At, 0, 0); PG8_STAGE(PG8_SA(1, 1), a1 + hstepA, voffA);
            PG8_WAIT_V(8); PG8_WAIT_L(0); PG8_BAR; PG8_MMA(0, 0, At, B0); PG8_MMA(0, 1, At, B1); PG8_BAR; PG8_SCHED;
            PG8_LDA(At, 0, 1); PG8_STAGE(PG8_SB(0, 0), b2, voffB); PG8_STAGE(PG8_SB(0, 1), b2 + hstepB, voffB); PG8_STAGE(PG8_SA(0, 0), a2, voffA);
            PG8_WAIT_V(8); PG8_WAIT_L(0); PG8_BAR; PG8_MMA(1, 0, At, B0); PG8_MMA(1, 1, At, B1); PG8_BAR; PG8_SCHED;
            PG8_LDB(B0, 1, 0); PG8_LDB(B1, 1, 1); PG8_SCHED; PG8_LDA(At, 1, 0); PG8_STAGE(PG8_SA(0, 1), a2 + hstepA, voffA);
            PG8_WAIT_V(8); PG8_WAIT_L(0); PG8_BAR; PG8_MMA(0, 0, At, B0); PG8_MMA(0, 1, At, B1); PG8_BAR; PG8_SCHED;
            PG8_LDA(At, 1, 1); PG8_STAGE(PG8_SB(1, 0), b3, voffB); PG8_STAGE(PG8_SB(1, 1), b3 + hstepB, voffB); PG8_STAGE(PG8_SA(1, 0), a3, voffA);
            PG8_WAIT_V(8); PG8_WAIT_L(0); PG8_BAR; PG8_MMA(1, 0, At, B0); PG8_MMA(1, 1, At, B1); PG8_BAR; PG8_SCHED;
        }
        if constexpr (ALIGN_EPI) { if (wr == 0) PG8_BAR; }
        E(acc, cur, wr, wc, fr, fq);
        if (!has_next) break;
#pragma unroll
        for (int a = 0; a < 2; ++a)
#pragma unroll
            for (int b = 0; b < 2; ++b)
#pragma unroll
                for (int m = 0; m < 4; ++m)
#pragma unroll
                    for (int n = 0; n < 2; ++n) acc[a][b][m][n] = (f32x4){0.f, 0.f, 0.f, 0.f};
        cur = nxt; cA = nA; cB = nB; ++ui;
        if constexpr (ALIGN_EPI) { if (wr == 1) PG8_BAR; }
    }
    PG8_WAIT_V(0);
    if constexpr (!ALIGN_EPI) { if (wr == 0) PG8_BAR; }
    PG8_BAR;
#undef PG8_SA
#undef PG8_SB
#undef PG8_STAGE
#undef PG8_LDA
#undef PG8_LDB
#undef PG8_MMA
#undef PG8_WAIT_V
#undef PG8_WAIT_L
#undef PG8_BAR
#undef PG8_SCHED
}

template <class Epi, class Sched, bool ALIGN_EPI>
__device__ __forceinline__ void gemm_phase_dn(LAS unsigned char* lds, const int K, const int lda, const int ldb, const Sched& S, const Epi& E, const unsigned* tile_ready, const unsigned need) {
    const int tid = threadIdx.x, wid = __builtin_amdgcn_readfirstlane(tid >> 6), lane = tid & 63, wr = wid >> 2, wc = wid & 3, fr = lane & 15, fq = lane >> 4;
    const int nt = K / BK;
    unsigned voffA[2], voffB[2];
#pragma unroll
    for (int i = 0; i < 2; ++i) { int R, C; stage_rc(tid * 16 + i * 8192, R, C); const int Rb = (R & ~31) + perm32(R & 31);
        voffA[i] = (unsigned)(R * lda + C) * 2u; voffB[i] = (unsigned)(Rb * ldb + C) * 2u; }
    const size_t kstep = (size_t)(BK * 2);
    const size_t hstepA = (size_t)HALF * lda * 2, hstepB = (size_t)HALF * ldb * 2;
    const unsigned ldsw = (unsigned)wid * 1024u;
    const int aoff = lds_byte(wr * 64 + fr, fq * 8), boff = lds_byte(wc * 32 + fr, fq * 8);
#define PG8_SA(b, h) (((b) * 2 + (h)) * HTB)
#define PG8_SB(b, h) ((4 + (b) * 2 + (h)) * HTB)
#define PG8_STAGE(bufoff, gbase, voff) do { _Pragma("unroll") for (int _i = 0; _i < 2; ++_i) \
        __builtin_amdgcn_global_load_lds((const unsigned*)((const char*)(gbase) + (voff)[_i]), (LAS unsigned*)(lds + (bufoff) + ldsw + _i * 8192), 16, 0, 0); } while (0)
#define PG8_LDA(dst, b, h) do { _Pragma("unroll") for (int m = 0; m < 4; ++m) _Pragma("unroll") for (int k = 0; k < 2; ++k) dst[m][k] = *(const LAS bf16x8*)(lds + PG8_SA(b, h) + aoff + m * 2048 + k * 1024); } while (0)
#define PG8_LDB(dst, b, h) do { _Pragma("unroll") for (int n = 0; n < 2; ++n) _Pragma("unroll") for (int k = 0; k < 2; ++k) dst[n][k] = *(const LAS bf16x8*)(lds + PG8_SB(b, h) + boff + n * 2048 + k * 1024); } while (0)
#define PG8_MMA(ai, bj, At, Bt) do { __builtin_amdgcn_s_setprio(1); _Pragma("unroll") for (int m = 0; m < 4; ++m) _Pragma("unroll") for (int n = 0; n < 2; ++n) _Pragma("unroll") for (int k = 0; k < 2; ++k) \
        acc[ai][bj][m][n] = __builtin_amdgcn_mfma_f32_16x16x32_bf16(Bt[n][k], At[m][k], acc[ai][bj][m][n], 0, 0, 0); __builtin_amdgcn_s_setprio(0); } while (0)
#define PG8_WAIT_V(n) asm volatile("s_waitcnt vmcnt(" #n ")" ::: "memory")
#define PG8_WAIT_L(n) asm volatile("s_waitcnt lgkmcnt(" #n ")" ::: "memory")
#define PG8_BAR __builtin_amdgcn_s_barrier()
#define PG8_SCHED __builtin_amdgcn_sched_barrier(0)
#define PG8_AREADY(unit) do { if (threadIdx.x < 64) { unsigned sp_ = 0; \
            while ((unsigned)__builtin_amdgcn_readfirstlane(__hip_atomic_load(tile_ready + (unit).pm * 4, __ATOMIC_RELAXED, __HIP_MEMORY_SCOPE_AGENT)) < need) { __builtin_amdgcn_s_sleep(2); if (++sp_ > (1u << 22)) break; } \
            __builtin_amdgcn_fence(__ATOMIC_ACQUIRE, "agent"); asm volatile("s_waitcnt vmcnt(0)" ::: "memory"); } \
        asm volatile("" ::: "memory"); __builtin_amdgcn_s_barrier(); asm volatile("" ::: "memory"); } while (0)
    Unit cur, nxt; int ui = 0;
    if (!S.next(0, cur)) return;
    f32x4 acc[2][2][4][2];
#pragma unroll
    for (int a = 0; a < 2; ++a)
#pragma unroll
        for (int b = 0; b < 2; ++b)
#pragma unroll
            for (int m = 0; m < 4; ++m)
#pragma unroll
                for (int n = 0; n < 2; ++n) acc[a][b][m][n] = (f32x4){0.f, 0.f, 0.f, 0.f};
    bf16x8 At[4][2], B0[2][2], B1[2][2];
    const char* cA = cur.A; const char* cB = cur.B;
    PG8_AREADY(cur);
    PG8_STAGE(PG8_SB(0, 0), cB, voffB); PG8_STAGE(PG8_SB(0, 1), cB + hstepB, voffB); PG8_STAGE(PG8_SA(0, 0), cA, voffA); PG8_STAGE(PG8_SA(0, 1), cA + hstepA, voffA);
    if (wr == 1) PG8_BAR;
    PG8_WAIT_V(2); PG8_BAR;
    PG8_STAGE(PG8_SB(1, 0), cB + kstep, voffB); PG8_STAGE(PG8_SA(1, 0), cA + kstep, voffA); PG8_STAGE(PG8_SB(1, 1), cB + hstepB + kstep, voffB);
    PG8_WAIT_V(6); PG8_BAR;
    for (;;) {
        const bool has_next = S.next(ui + 1, nxt);
        const char* nA = has_next ? nxt.A : cA; const char* nB = has_next ? nxt.B : cB;
#pragma unroll 1
        for (int t = 0; t < nt; t += 2) {
            const bool last = (t == nt - 2);
            const char* a1 = cA + (size_t)(t + 1) * kstep;
            const char* a2 = last ? nA : cA + (size_t)(t + 2) * kstep; const char* b2 = last ? nB : cB + (size_t)(t + 2) * kstep;
            const char* a3 = a2 + kstep; const char* b3 = b2 + kstep;
            if (last && has_next) PG8_AREADY(nxt);
            PG8_LDB(B0, 0, 0); PG8_LDB(B1, 0, 1); PG8_SCHED; PG8_LDA(At, 0, 0); PG8_STAGE(PG8_SA(1, 1), a1 + hstepA, voffA);
            PG8_WAIT_V(8); PG8_WAIT_L(0); PG8_BAR; PG8_MMA(0, 0, At, B0); PG8_MMA(0, 1, At, B1); PG8_BAR; PG8_SCHED;
            PG8_LDA(At, 0, 1); PG8_STAGE(PG8_SB(0, 0), b2, voffB); PG8_STAGE(PG8_SB(0, 1), b2 + hstepB, voffB); PG8_STAGE(PG8_SA(0, 0), a2, voffA);
            PG8_WAIT_V(8); PG8_WAIT_L(0); PG8_BAR; PG8_MMA(1, 0, At, B0); PG8_MMA(1, 1, At, B1); PG8_BAR; PG8_SCHED;
            PG8_LDB(B0, 1, 0); PG8_LDB(B1, 1, 1); PG8_SCHED; PG8_LDA(At, 1, 0); PG8_STAGE(PG8_SA(0, 1), a2 + hstepA, voffA);
            PG8_WAIT_V(8); PG8_WAIT_L(0); PG8_BAR; PG8_MMA(0, 0, At, B0); PG8_MMA(0, 1, At, B1); PG8_BAR; PG8_SCHED;
            PG8_LDA(At, 1, 1); PG8_STAGE(PG8_SB(1, 0), b3, voffB); PG8_STAGE(PG8_SB(1, 1), b3 + hstepB, voffB); PG8_STAGE(PG8_SA(1, 0), a3, voffA);
            PG8_WAIT_V(8); PG8_WAIT_L(0); PG8_BAR; PG8_MMA(1, 0, At, B0); PG8_MMA(1, 1, At, B1); PG8_BAR; PG8_SCHED;
        }
        if constexpr (ALIGN_EPI) { if (wr == 0) PG8_BAR; }
        E(acc, cur, wr, wc, fr, fq);
        if (!has_next) break;
#pragma unroll
        for (int a = 0; a < 2; ++a)
#pragma unroll
            for (int b = 0; b < 2; ++b)
#pragma unroll
                for (int m = 0; m < 4; ++m)
#pragma unroll
                    for (int n = 0; n < 2; ++n) acc[a][b][m][n] = (f32x4){0.f, 0.f, 0.f, 0.f};
        cur = nxt; cA = nA; cB = nB; ++ui;
        if constexpr (ALIGN_EPI) { if (wr == 1) PG8_BAR; }
    }
    PG8_WAIT_V(0);
    if constexpr (!ALIGN_EPI) { if (wr == 0) PG8_BAR; }
    PG8_BAR;
#undef PG8_SA
#undef PG8_SB
#undef PG8_STAGE
#undef PG8_LDA
#undef PG8_LDB
#undef PG8_MMA
#undef PG8_WAIT_V
#undef PG8_WAIT_L
#undef PG8_BAR
#undef PG8_SCHED
#undef PG8_AREADY
}

template <class Epi, class Sched, bool ALIGN_EPI>
__device__ __forceinline__ void gemm_phase_ga(LAS unsigned char* lds, const int K, const int lda, const int ldb, const Sched& S, const Epi& E, const int* __restrict__ rowsrc, unsigned* tile_ready) {
    const int tid = threadIdx.x, wid = __builtin_amdgcn_readfirstlane(tid >> 6), lane = tid & 63, wr = wid >> 2, wc = wid & 3, fr = lane & 15, fq = lane >> 4;
    const int nt = K / BK;
    unsigned voffB[2]; int Rr[2], Cc[2];
#pragma unroll
    for (int i = 0; i < 2; ++i) { int R, C; stage_rc(tid * 16 + i * 8192, R, C); const int Rb = (R & ~31) + perm32(R & 31);
        Rr[i] = R; Cc[i] = C; voffB[i] = (unsigned)(Rb * ldb + C) * 2u; }
    unsigned vcur[2][2], vnxt[2][2];
#define PG8_GOFF(dst, unit) do { _Pragma("unroll") for (int h_ = 0; h_ < 2; ++h_) _Pragma("unroll") for (int i_ = 0; i_ < 2; ++i_) \
        dst[h_][i_] = (unsigned)(rowsrc[(unit).pm * BM + h_ * HALF + Rr[i_]] * lda + Cc[i_]) * 2u; } while (0)
    const size_t kstep = (size_t)(BK * 2);
    const size_t hstepB = (size_t)HALF * ldb * 2;
    const unsigned ldsw = (unsigned)wid * 1024u;
    const int aoff = lds_byte(wr * 64 + fr, fq * 8), boff = lds_byte(wc * 32 + fr, fq * 8);
#define PG8_SA(b, h) (((b) * 2 + (h)) * HTB)
#define PG8_SB(b, h) ((4 + (b) * 2 + (h)) * HTB)
#define PG8_STAGE(bufoff, gbase, voff) do { _Pragma("unroll") for (int _i = 0; _i < 2; ++_i) \
        __builtin_amdgcn_global_load_lds((const unsigned*)((const char*)(gbase) + (voff)[_i]), (LAS unsigned*)(lds + (bufoff) + ldsw + _i * 8192), 16, 0, 0); } while (0)
#define PG8_LDA(dst, b, h) do { _Pragma("unroll") for (int m = 0; m < 4; ++m) _Pragma("unroll") for (int k = 0; k < 2; ++k) dst[m][k] = *(const LAS bf16x8*)(lds + PG8_SA(b, h) + aoff + m * 2048 + k * 1024); } while (0)
#define PG8_LDB(dst, b, h) do { _Pragma("unroll") for (int n = 0; n < 2; ++n) _Pragma("unroll") for (int k = 0; k < 2; ++k) dst[n][k] = *(const LAS bf16x8*)(lds + PG8_SB(b, h) + boff + n * 2048 + k * 1024); } while (0)
#define PG8_MMA(ai, bj, At, Bt) do { __builtin_amdgcn_s_setprio(1); _Pragma("unroll") for (int m = 0; m < 4; ++m) _Pragma("unroll") for (int n = 0; n < 2; ++n) _Pragma("unroll") for (int k = 0; k < 2; ++k) \
        acc[ai][bj][m][n] = __builtin_amdgcn_mfma_f32_16x16x32_bf16(Bt[n][k], At[m][k], acc[ai][bj][m][n], 0, 0, 0); __builtin_amdgcn_s_setprio(0); } while (0)
#define PG8_WAIT_V(n) asm volatile("s_waitcnt vmcnt(" #n ")" ::: "memory")
#define PG8_WAIT_L(n) asm volatile("s_waitcnt lgkmcnt(" #n ")" ::: "memory")
#define PG8_BAR __builtin_amdgcn_s_barrier()
#define PG8_SCHED __builtin_amdgcn_sched_barrier(0)
    Unit cur, nxt; int ui = 0;
    if (!S.next(0, cur)) return;
    f32x4 acc[2][2][4][2];
#pragma unroll
    for (int a = 0; a < 2; ++a)
#pragma unroll
        for (int b = 0; b < 2; ++b)
#pragma unroll
            for (int m = 0; m < 4; ++m)
#pragma unroll
                for (int n = 0; n < 2; ++n) acc[a][b][m][n] = (f32x4){0.f, 0.f, 0.f, 0.f};
    bf16x8 At[4][2], B0[2][2], B1[2][2];
    const char* const cA = S.A; const char* cB = cur.B;
    PG8_GOFF(vcur, cur);
    PG8_STAGE(PG8_SB(0, 0), cB, voffB); PG8_STAGE(PG8_SB(0, 1), cB + hstepB, voffB); PG8_STAGE(PG8_SA(0, 0), cA, vcur[0]); PG8_STAGE(PG8_SA(0, 1), cA, vcur[1]);
    if (wr == 1) PG8_BAR;
    PG8_WAIT_V(2); PG8_BAR;
    PG8_STAGE(PG8_SB(1, 0), cB + kstep, voffB); PG8_STAGE(PG8_SA(1, 0), cA + kstep, vcur[0]); PG8_STAGE(PG8_SB(1, 1), cB + hstepB + kstep, voffB);
    PG8_WAIT_V(6); PG8_BAR;
    for (;;) {
        const bool has_next = S.next(ui + 1, nxt);
        const char* nB = has_next ? nxt.B : cB;
        if (has_next) PG8_GOFF(vnxt, nxt); else { _Pragma("unroll") for (int h_ = 0; h_ < 2; ++h_) _Pragma("unroll") for (int i_ = 0; i_ < 2; ++i_) vnxt[h_][i_] = vcur[h_][i_]; }
#pragma unroll 1
        for (int t = 0; t < nt; t += 2) {
            const bool last = (t == nt - 2);
            const char* a1 = cA + (size_t)(t + 1) * kstep;
            const char* a2 = last ? cA : cA + (size_t)(t + 2) * kstep; const char* b2 = last ? nB : cB + (size_t)(t + 2) * kstep;
            const char* a3 = a2 + kstep; const char* b3 = b2 + kstep;
            unsigned v2[2][2];
#pragma unroll
            for (int h_ = 0; h_ < 2; ++h_)
#pragma unroll
                for (int i_ = 0; i_ < 2; ++i_) v2[h_][i_] = last ? vnxt[h_][i_] : vcur[h_][i_];
            PG8_LDB(B0, 0, 0); PG8_LDB(B1, 0, 1); PG8_SCHED; PG8_LDA(At, 0, 0); PG8_STAGE(PG8_SA(1, 1), a1, vcur[1]);
            PG8_WAIT_V(8); PG8_WAIT_L(0); PG8_BAR; PG8_MMA(0, 0, At, B0); PG8_MMA(0, 1, At, B1); PG8_BAR; PG8_SCHED;
            PG8_LDA(At, 0, 1); PG8_STAGE(PG8_SB(0, 0), b2, voffB); PG8_STAGE(PG8_SB(0, 1), b2 + hstepB, voffB); PG8_STAGE(PG8_SA(0, 0), a2, v2[0]);
            PG8_WAIT_V(8); PG8_WAIT_L(0); PG8_BAR; PG8_MMA(1, 0, At, B0); PG8_MMA(1, 1, At, B1); PG8_BAR; PG8_SCHED;
            PG8_LDB(B0, 1, 0); PG8_LDB(B1, 1, 1); PG8_SCHED; PG8_LDA(At, 1, 0); PG8_STAGE(PG8_SA(0, 1), a2, v2[1]);
            PG8_WAIT_V(8); PG8_WAIT_L(0); PG8_BAR; PG8_MMA(0, 0, At, B0); PG8_MMA(0, 1, At, B1); PG8_BAR; PG8_SCHED;
            PG8_LDA(At, 1, 1); PG8_STAGE(PG8_SB(1, 0), b3, voffB); PG8_STAGE(PG8_SB(1, 1), b3 + hstepB, voffB); PG8_STAGE(PG8_SA(1, 0), a3, v2[0]);
            PG8_WAIT_V(8); PG8_WAIT_L(0); PG8_BAR; PG8_MMA(1, 0, At, B0); PG8_MMA(1, 1, At, B1); PG8_BAR; PG8_SCHED;
        }
        if constexpr (ALIGN_EPI) { if (wr == 0) PG8_BAR; }
        E(acc, cur, wr, wc, fr, fq);
        asm volatile("s_waitcnt vmcnt(0)" ::: "memory");
        if (lane == 0) __hip_atomic_fetch_add(tile_ready + cur.pm * 4, 1u, __ATOMIC_RELAXED, __HIP_MEMORY_SCOPE_AGENT);
        if (!has_next) break;
#pragma unroll
        for (int a = 0; a < 2; ++a)
#pragma unroll
            for (int b = 0; b < 2; ++b)
#pragma unroll
                for (int m = 0; m < 4; ++m)
#pragma unroll
                    for (int n = 0; n < 2; ++n) acc[a][b][m][n] = (f32x4){0.f, 0.f, 0.f, 0.f};
        cur = nxt; cB = nB; ++ui;
#pragma unroll
        for (int h_ = 0; h_ < 2; ++h_)
#pragma unroll
            for (int i_ = 0; i_ < 2; ++i_) vcur[h_][i_] = vnxt[h_][i_];
        if constexpr (ALIGN_EPI) { if (wr == 1) PG8_BAR; }
    }
    PG8_WAIT_V(0);
    if constexpr (!ALIGN_EPI) { if (wr == 0) PG8_BAR; }
    PG8_BAR;
#undef PG8_SA
#undef PG8_SB
#undef PG8_STAGE
#undef PG8_LDA
#undef PG8_LDB
#undef PG8_MMA
#undef PG8_WAIT_V
#undef PG8_WAIT_L
#undef PG8_BAR
#undef PG8_SCHED
#undef PG8_GOFF
}

struct Unit2 { int pm, pn; const char* A0; const char* B0; const char* A1; const char* B1; };
template <class Epi, class Sched, bool ALIGN_EPI, int NT0, int NT1>
__device__ __forceinline__ void gemm_phase2(LAS unsigned char* lds, const int lda, const int ldb, const Sched& S, const Epi& E) {
    const int tid = threadIdx.x, wid = __builtin_amdgcn_readfirstlane(tid >> 6), lane = tid & 63, wr = wid >> 2, wc = wid & 3, fr = lane & 15, fq = lane >> 4;
    unsigned voffA[2], voffB[2];
#pragma unroll
    for (int i = 0; i < 2; ++i) { int R, C; stage_rc(tid * 16 + i * 8192, R, C); const int Rb = (R & ~31) + perm32(R & 31);
        voffA[i] = (unsigned)(R * lda + C) * 2u; voffB[i] = (unsigned)(Rb * ldb + C) * 2u; }
    const size_t kstep = (size_t)(BK * 2);
    const size_t hstepA = (size_t)HALF * lda * 2, hstepB = (size_t)HALF * ldb * 2;
    const unsigned ldsw = (unsigned)wid * 1024u;
    const int aoff = lds_byte(wr * 64 + fr, fq * 8), boff = lds_byte(wc * 32 + fr, fq * 8);
#define PG8_SA(b, h) (((b) * 2 + (h)) * HTB)
#define PG8_SB(b, h) ((4 + (b) * 2 + (h)) * HTB)
#define PG8_STAGE(bufoff, gbase, voff) do { _Pragma("unroll") for (int _i = 0; _i < 2; ++_i) \
        __builtin_amdgcn_global_load_lds((const unsigned*)((const char*)(gbase) + (voff)[_i]), (LAS unsigned*)(lds + (bufoff) + ldsw + _i * 8192), 16, 0, 0); } while (0)
#define PG8_LDA(dst, b, h) do { _Pragma("unroll") for (int m = 0; m < 4; ++m) _Pragma("unroll") for (int k = 0; k < 2; ++k) dst[m][k] = *(const LAS bf16x8*)(lds + PG8_SA(b, h) + aoff + m * 2048 + k * 1024); } while (0)
#define PG8_LDB(dst, b, h) do { _Pragma("unroll") for (int n = 0; n < 2; ++n) _Pragma("unroll") for (int k = 0; k < 2; ++k) dst[n][k] = *(const LAS bf16x8*)(lds + PG8_SB(b, h) + boff + n * 2048 + k * 1024); } while (0)
#define PG8_MMA(ai, bj, At, Bt) do { __builtin_amdgcn_s_setprio(1); _Pragma("unroll") for (int m = 0; m < 4; ++m) _Pragma("unroll") for (int n = 0; n < 2; ++n) _Pragma("unroll") for (int k = 0; k < 2; ++k) \
        acc[ai][bj][m][n] = __builtin_amdgcn_mfma_f32_16x16x32_bf16(Bt[n][k], At[m][k], acc[ai][bj][m][n], 0, 0, 0); __builtin_amdgcn_s_setprio(0); } while (0)
#define PG8_WAIT_V(n) asm volatile("s_waitcnt vmcnt(" #n ")" ::: "memory")
#define PG8_WAIT_L(n) asm volatile("s_waitcnt lgkmcnt(" #n ")" ::: "memory")
#define PG8_BAR __builtin_amdgcn_s_barrier()
#define PG8_SCHED __builtin_amdgcn_sched_barrier(0)
#define PG8_KLOOP(NT, cA_, cB_, nA_, nB_) _Pragma("unroll 1") for (int t = 0; t < (NT); t += 2) { \
            const bool last = (t == (NT) - 2); \
            const char* a1 = (cA_) + (size_t)(t + 1) * kstep; \
            const char* a2 = last ? (nA_) : (cA_) + (size_t)(t + 2) * kstep; const char* b2 = last ? (nB_) : (cB_) + (size_t)(t + 2) * kstep; \
            const char* a3 = a2 + kstep; const char* b3 = b2 + kstep; \
            PG8_LDB(B0, 0, 0); PG8_LDB(B1, 0, 1); PG8_SCHED; PG8_LDA(At, 0, 0); PG8_STAGE(PG8_SA(1, 1), a1 + hstepA, voffA); \
            PG8_WAIT_V(8); PG8_WAIT_L(0); PG8_BAR; PG8_MMA(0, 0, At, B0); PG8_MMA(0, 1, At, B1); PG8_BAR; PG8_SCHED; \
            PG8_LDA(At, 0, 1); PG8_STAGE(PG8_SB(0, 0), b2, voffB); PG8_STAGE(PG8_SB(0, 1), b2 + hstepB, voffB); PG8_STAGE(PG8_SA(0, 0), a2, voffA); \
            PG8_WAIT_V(8); PG8_WAIT_L(0); PG8_BAR; PG8_MMA(1, 0, At, B0); PG8_MMA(1, 1, At, B1); PG8_BAR; PG8_SCHED; \
            PG8_LDB(B0, 1, 0); PG8_LDB(B1, 1, 1); PG8_SCHED; PG8_LDA(At, 1, 0); PG8_STAGE(PG8_SA(0, 1), a2 + hstepA, voffA); \
            PG8_WAIT_V(8); PG8_WAIT_L(0); PG8_BAR; PG8_MMA(0, 0, At, B0); PG8_MMA(0, 1, At, B1); PG8_BAR; PG8_SCHED; \
            PG8_LDA(At, 1, 1); PG8_STAGE(PG8_SB(1, 0), b3, voffB); PG8_STAGE(PG8_SB(1, 1), b3 + hstepB, voffB); PG8_STAGE(PG8_SA(1, 0), a3, voffA); \
            PG8_WAIT_V(8); PG8_WAIT_L(0); PG8_BAR; PG8_MMA(1, 0, At, B0); PG8_MMA(1, 1, At, B1); PG8_BAR; PG8_SCHED; }
    Unit2 cur, nxt; int ui = 0;
    if (!S.next(0, cur)) return;
    f32x4 acc[2][2][4][2];
#pragma unroll
    for (int a = 0; a < 2; ++a)
#pragma unroll
        for (int b = 0; b < 2; ++b)
#pragma unroll
            for (int m = 0; m < 4; ++m)
#pragma unroll
                for (int n = 0; n < 2; ++n) acc[a][b][m][n] = (f32x4){0.f, 0.f, 0.f, 0.f};
    bf16x8 At[4][2], B0[2][2], B1[2][2];
    {
        const char* cA = cur.A0; const char* cB = cur.B0;
        PG8_STAGE(PG8_SB(0, 0), cB, voffB); PG8_STAGE(PG8_SB(0, 1), cB + hstepB, voffB); PG8_STAGE(PG8_SA(0, 0), cA, voffA); PG8_STAGE(PG8_SA(0, 1), cA + hstepA, voffA);
        if (wr == 1) PG8_BAR;
        PG8_WAIT_V(2); PG8_BAR;
        PG8_STAGE(PG8_SB(1, 0), cB + kstep, voffB); PG8_STAGE(PG8_SA(1, 0), cA + kstep, voffA); PG8_STAGE(PG8_SB(1, 1), cB + hstepB + kstep, voffB);
        PG8_WAIT_V(6); PG8_BAR;
    }
    for (;;) {
        const bool has_next = S.next(ui + 1, nxt);
        const char* nA = has_next ? nxt.A0 : cur.A0; const char* nB = has_next ? nxt.B0 : cur.B0;
        PG8_KLOOP(NT0, cur.A0, cur.B0, cur.A1, cur.B1)
        E.mid(acc, cur, wr, wc, fr, fq);
        PG8_KLOOP(NT1, cur.A1, cur.B1, nA, nB)
        if constexpr (ALIGN_EPI) { if (wr == 0) PG8_BAR; }
        E.fin(acc, cur, wr, wc, fr, fq);
        if (!has_next) break;
#pragma unroll
        for (int a = 0; a < 2; ++a)
#pragma unroll
            for (int b = 0; b < 2; ++b)
#pragma unroll
                for (int m = 0; m < 4; ++m)
#pragma unroll
                    for (int n = 0; n < 2; ++n) acc[a][b][m][n] = (f32x4){0.f, 0.f, 0.f, 0.f};
        cur = nxt; ++ui;
        if constexpr (ALIGN_EPI) { if (wr == 1) PG8_BAR; }
    }
    PG8_WAIT_V(0);
    if constexpr (!ALIGN_EPI) { if (wr == 0) PG8_BAR; }
    PG8_BAR;
#undef PG8_KLOOP
#undef PG8_SA
#undef PG8_SB
#undef PG8_STAGE
#undef PG8_LDA
#undef PG8_LDB
#undef PG8_MMA
#undef PG8_WAIT_V
#undef PG8_WAIT_L
#undef PG8_BAR
#undef PG8_SCHED
}
struct BrSched {
    const char* A0; const char* B0; const char* A1; const char* B1; StaticOrder so;
    __device__ __forceinline__ bool next(int i, Unit2& u) const {
        int pm, pn; if (!so.next(i, pm, pn)) return false;
        u.pm = pm; u.pn = pn; u.A0 = A0 + (size_t)pm * BM * 512 * 2; u.B0 = B0 + (size_t)pn * BM * 512 * 2; u.A1 = A1 + (size_t)pm * BM * 512 * 2; u.B1 = B1 + (size_t)pn * BM * 512 * 2; return true;
    }
};
struct EpiBr {
    const bf16_t* COLS; bf16_t* MG;
    __device__ __forceinline__ void mid(f32x4 (&acc)[2][2][4][2], const Unit2& u, int wr, int wc, int fr, int fq) const {
#pragma unroll
        for (int ai = 0; ai < 2; ++ai) {
            u32x4 gaw[4][2], gbw[4][2];
#pragma unroll
            for (int m = 0; m < 4; ++m) { const size_t t = (size_t)u.pm * BM + ai * HALF + wr * 64 + m * 16 + fr;
#pragma unroll
                for (int bj = 0; bj < 2; ++bj) { const int col = u.pn * BM + bj * HALF + wc * 32 + 8 * fq;
                    gaw[m][bj] = *(const u32x4*)(COLS + t * INC + C_GA + col); gbw[m][bj] = *(const u32x4*)(COLS + t * INC + C_GB + col); } }
#pragma unroll
            for (int m = 0; m < 4; ++m)
#pragma unroll
                for (int bj = 0; bj < 2; ++bj) { float ga[8], gb[8]; unpack8(gaw[m][bj], ga); unpack8(gbw[m][bj], gb);
#pragma unroll
                    for (int n = 0; n < 2; ++n)
#pragma unroll
                        for (int k = 0; k < 4; ++k) { const float rt_ = sigmoidf_(ga[4 * n + k]) * (1.0f + __expf(-gb[4 * n + k]));
                            asm volatile("v_mul_f32 %0, %0, %1" : "+v"(acc[ai][bj][m][n][k]) : "v"(rt_)); } }
        }
    }
    __device__ __forceinline__ void fin(const f32x4 (&acc)[2][2][4][2], const Unit2& u, int wr, int wc, int fr, int fq) const {
        u32x4 gbw[2][4][2];
#pragma unroll
        for (int ai = 0; ai < 2; ++ai)
#pragma unroll
            for (int m = 0; m < 4; ++m) { const size_t t = (size_t)u.pm * BM + ai * HALF + wr * 64 + m * 16 + fr;
#pragma unroll
                for (int bj = 0; bj < 2; ++bj) { const int col = u.pn * BM + bj * HALF + wc * 32 + 8 * fq; gbw[ai][m][bj] = *(const u32x4*)(COLS + t * INC + C_GB + col); } }
#pragma unroll
        for (int ai = 0; ai < 2; ++ai)
#pragma unroll
            for (int m = 0; m < 4; ++m) { const size_t t = (size_t)u.pm * BM + ai * HALF + wr * 64 + m * 16 + fr;
#pragma unroll
                for (int bj = 0; bj < 2; ++bj) { const int col = u.pn * BM + bj * HALF + wc * 32 + 8 * fq; float gb[8], o[8]; unpack8(gbw[ai][m][bj], gb);
#pragma unroll
                    for (int n = 0; n < 2; ++n)
#pragma unroll
                        for (int k = 0; k < 4; ++k) o[4 * n + k] = acc[ai][bj][m][n][k] * sigmoidf_(gb[4 * n + k]);
                    *(u32x4*)(MG + t * DM + col) = pack8(o); } }
    }
};
}
using pg8::Unit;

struct F_Cols { bf16_t* C; int ldc; bf16_t* UG;
    __device__ __forceinline__ void operator()(const Unit& u, int r, int c, float (&v)[8]) const {
        const u32x4 w = pack8(v); const int t = u.pm * 256 + r;
        *(u32x4*)(C + (size_t)t * ldc + u.pn * 256 + c) = w;
        if (u.pn == 7) { const int g = c >> 4, c0 = c & 15, b = t >> 11, s = t & (SEQ - 1), ch = s >> 5, j = s & 31;
            *(u32x4*)(UG + ((size_t)g * S5ROWS + b * S5NCH + ch) * S5K + j * 16 + c0) = w; } } };
struct F_Lora { bf16_t* O; const float* w0; const float* a0;
    __device__ __forceinline__ void operator()(const Unit& u, int r, int c, float (&v)[8]) const {
        const int gc = u.pn * 256 + c; const int ty = u.pn >> 1;
        if (ty == 0) {
#pragma unroll
            for (int i = 0; i < 8; ++i) v[i] = 0.6065306597126334f * sigmoidf_(v[i] + w0[gc + i]);
        } else if (ty == 1) {
#pragma unroll
            for (int i = 0; i < 8; ++i) v[i] = sigmoidf_(v[i] + a0[gc - 512 + i]);
        }
        *(u32x4*)(O + (size_t)(u.pm * 256 + r) * 1536 + gc) = pack8(v); } };
struct F_S5a { float* E;
    __device__ __forceinline__ void operator()(const Unit& u, int r, int c, float (&v)[8]) const {
        if (c < 128) { float* p = E + ((size_t)u.aux * S5ROWS + u.pm * 256 + r) * 128 + c;
            *(f32x4*)p = (f32x4){v[0], v[1], v[2], v[3]}; *(f32x4*)(p + 4) = (f32x4){v[4], v[5], v[6], v[7]}; } } };
struct F_S5c { const bf16_t* COLS; const float* Dsk; bf16_t* Z;
    static constexpr int NB = 4; struct Pre { u32x4 uw; f32x4 d0, d1; };
    __device__ __forceinline__ void pre(const Unit& u, int r, int c, Pre& p) const {
        const int row = u.pm * 256 + r, col = u.pn * 256 + c; const int b = row >> 6, ch = row & 63, j = col >> 4, c0 = col & 15;
        const int t = b * SEQ + ch * S5L + j, chan = u.aux * 16 + c0;
        p.uw = *(const u32x4*)(COLS + (size_t)t * INC + C_U + chan); p.d0 = *(const f32x4*)(Dsk + chan); p.d1 = *(const f32x4*)(Dsk + chan + 4); }
    __device__ __forceinline__ void post(const Unit& u, int r, int c, float (&v)[8], const Pre& p) const {
        const int row = u.pm * 256 + r, col = u.pn * 256 + c; const int b = row >> 6, ch = row & 63, j = col >> 4, c0 = col & 15;
        const int t = b * SEQ + ch * S5L + j, chan = u.aux * 16 + c0;
        float uu[8]; unpack8(p.uw, uu);
#pragma unroll
        for (int i = 0; i < 8; ++i) v[i] = gelu_tanh(v[i] + ((i < 4) ? p.d0[i & 3] : p.d1[i & 3]) * uu[i]);
        *(u32x4*)(Z + (size_t)t * 256 + chan) = pack8(v); } };
struct F_Glu { const bf16_t* Z; const float* gb; bf16_t* O;
    static constexpr int NB = 4; struct Pre { u32x4 zw; f32x4 b0, b1; };
    __device__ __forceinline__ void pre(const Unit& u, int r, int c, Pre& p) const {
        const size_t t = (size_t)u.pm * 256 + r; p.zw = *(const u32x4*)(Z + t * 256 + c); p.b0 = *(const f32x4*)(gb + c); p.b1 = *(const f32x4*)(gb + c + 4); }
    __device__ __forceinline__ void post(const Unit& u, int r, int c, float (&v)[8], const Pre& p) const {
        const size_t t = (size_t)u.pm * 256 + r; float z[8]; unpack8(p.zw, z);
#pragma unroll
        for (int i = 0; i < 8; ++i) v[i] = z[i] * sigmoidf_(v[i] + ((i < 4) ? p.b0[i & 3] : p.b1[i & 3]));
        *(u32x4*)(O + t * 512 + c) = pack8(v); } };
struct F_BrA { const bf16_t* COLS; float* PART;
    __device__ __forceinline__ void operator()(const Unit& u, int r, int c, float (&v)[8]) const {
        const size_t t = (size_t)u.pm * 256 + r; const int col = u.pn * 256 + c; float g[8]; unpack8(*(const u32x4*)(COLS + t * INC + C_GA + col), g);
#pragma unroll
        for (int i = 0; i < 8; ++i) v[i] *= sigmoidf_(g[i]);
        float* p = PART + t * DM + col; *(f32x4*)p = (f32x4){v[0], v[1], v[2], v[3]}; *(f32x4*)(p + 4) = (f32x4){v[4], v[5], v[6], v[7]}; } };
struct F_BrB { const bf16_t* COLS; const float* PART; bf16_t* MG;
    __device__ __forceinline__ void operator()(const Unit& u, int r, int c, float (&v)[8]) const {
        const size_t t = (size_t)u.pm * 256 + r; const int col = u.pn * 256 + c; float g[8]; unpack8(*(const u32x4*)(COLS + t * INC + C_GB + col), g);
        const float* p = PART + t * DM + col; const f32x4 p0 = *(const f32x4*)p, p1 = *(const f32x4*)(p + 4);
        const float pp[8] = {p0[0], p0[1], p0[2], p0[3], p1[0], p1[1], p1[2], p1[3]};
#pragma unroll
        for (int i = 0; i < 8; ++i) v[i] = pp[i] + v[i] * sigmoidf_(g[i]);
        *(u32x4*)(MG + t * DM + col) = pack8(v); } };
struct F_Res { const float* X; bf16_t* O;
    __device__ __forceinline__ void operator()(const Unit& u, int r, int c, float (&v)[8]) const {
        const size_t o = ((size_t)u.pm * 256 + r) * DM + u.pn * 256 + c; const f32x4 x0 = *(const f32x4*)(X + o), x1 = *(const f32x4*)(X + o + 4);
        const float w[8] = {x0[0] + v[0], x0[1] + v[1], x0[2] + v[2], x0[3] + v[3], x1[0] + v[4], x1[1] + v[5], x1[2] + v[6], x1[3] + v[7]};
        *(u32x4*)(O + o) = pack8(w); } };
struct F_MoeDown { const float* ROWW; bf16_t* YM;
    static constexpr int NB = 16; struct Pre { float w; };
    __device__ __forceinline__ void pre(const Unit& u, int r, int c, Pre& p) const { p.w = ROWW[(size_t)u.pm * 256 + r]; }
    __device__ __forceinline__ void post(const Unit& u, int r, int c, float (&v)[8], const Pre& p) const {
        const size_t row = (size_t)u.pm * 256 + r;
#pragma unroll
        for (int i = 0; i < 8; ++i) v[i] *= p.w;
        *(u32x4*)(YM + row * DM + u.pn * 256 + c) = pack8(v); } };
struct F_PleG { bf16_t* G;
    __device__ __forceinline__ void operator()(const Unit& u, int r, int c, float (&v)[8]) const {
#pragma unroll
        for (int i = 0; i < 8; ++i) v[i] = sigmoidf_(v[i]);
        *(u32x4*)(G + ((size_t)u.pm * 256 + r) * DM + u.pn * 256 + c) = pack8(v); } };
struct F_PleP { const bf16_t* G; const bf16_t* HP; const float* SQ; bf16_t* XO;
    __device__ __forceinline__ void operator()(const Unit& u, int r, int c, float (&v)[8]) const {
        const size_t row = (size_t)u.pm * 256 + r, o = row * DM + u.pn * 256 + c; float g[8], x[8], w[8]; unpack8(*(const u32x4*)(G + o), g); unpack8(*(const u32x4*)(HP + o), x); const float sq = SQ[row];
#pragma unroll
        for (int i = 0; i < 8; ++i) w[i] = x[i] * sq + g[i] * v[i];
        *(u32x4*)(XO + o) = pack8(w); } };

enum { I_X = 0, I_P, I_MIXN, I_WIN, I_MU, I_W0, I_WUP, I_A0, I_AUP, I_GUP, I_KK, I_KA, I_RK, I_LNG, I_LNB, I_LRE, I_LIM, I_LDT, I_BRE, I_BIM, I_CRE, I_CIM, I_SD, I_GLUW, I_GLUB,
       I_WBA, I_WBB, I_WOUT, I_FFNN, I_RGW, I_RGB, I_REW, I_REB, I_EG, I_EU, I_ED, I_PLEN, I_PLEG, I_PLEP, I_FINN };

__device__ __forceinline__ void transpose_item(const float* __restrict__ W, int ldw, const float* __restrict__ kscale, int k0, int n0, bf16_t* WT, int ldt, int dst_row0, int dst_k0, LAS float* scr, int lane) {
#pragma unroll 2
    for (int i = 0; i < 32; ++i) { const int kk = 2 * i + (lane >> 5); float v = W[(size_t)(k0 + kk) * ldw + n0 + (lane & 31)]; if (kscale) v *= kscale[k0 + kk]; scr[kk * 33 + (lane & 31)] = v; }
    LDS_WAIT();
    const int c = lane & 7;
#pragma unroll
    for (int j = 0; j < 4; ++j) { const int n = (lane >> 3) + 8 * j; const LAS float* s = scr + (8 * c) * 33 + n;
        u32x4 o; o.x = pk2(s[0 * 33], s[1 * 33]); o.y = pk2(s[2 * 33], s[3 * 33]); o.z = pk2(s[4 * 33], s[5 * 33]); o.w = pk2(s[6 * 33], s[7 * 33]);
        *(u32x4*)(WT + (size_t)(dst_row0 + n) * ldt + dst_k0 + 8 * c) = o; }
    LDS_WAIT();
}

constexpr int N_WBA = 8 * 32, N_WBB = 4 * 32, N_WOUT = 16 * 32, N_WPG = 16 * 32, N_WPP = 4 * 32, N_GLU = 4 * 8, N_EG = 32 * 128, N_EU = 32 * 128, N_ED = 32 * 128;
constexpr int N_LATE = N_WBA + N_WBB + N_WOUT + N_WPG + N_WPP + N_GLU + N_EG + N_EU + N_ED;
struct TrDesc { const float* W; const float* ks; bf16_t* WT; int ldw, k0, n0, ldt, row0; };
__device__ __forceinline__ TrDesc late_desc(const Args& a, int r) {
    unsigned char* ws = a.ws; TrDesc d; d.ks = nullptr;
    if (r < N_WBA) { d.W = a.in[I_WBA]; d.ldw = 1024; d.k0 = 64 * (r / 32); d.n0 = 32 * (r % 32); d.WT = (bf16_t*)(ws + WS_WBA); d.ldt = 512; d.row0 = d.n0; return d; } r -= N_WBA;
    if (r < N_WBB) { d.W = a.in[I_WBB]; d.ldw = 1024; d.k0 = 64 * (r / 32); d.n0 = 32 * (r % 32); d.WT = (bf16_t*)(ws + WS_WBB); d.ldt = 512; d.row0 = d.n0; return d; } r -= N_WBB;
    if (r < N_WOUT) { d.W = a.in[I_WOUT]; d.ldw = 1024; d.k0 = 64 * (r / 32); d.n0 = 32 * (r % 32); d.WT = (bf16_t*)(ws + WS_WOUT); d.ldt = 1024; d.row0 = d.n0; return d; } r -= N_WOUT;
    if (r < N_WPG) { d.W = a.in[I_PLEG]; d.ks = a.in[I_PLEN]; d.ldw = 1024; d.k0 = 64 * (r / 32); d.n0 = 32 * (r % 32); d.WT = (bf16_t*)(ws + WS_WPG); d.ldt = 1024; d.row0 = d.n0; return d; } r -= N_WPG;
    if (r < N_WPP) { d.W = a.in[I_PLEP]; d.ldw = 1024; d.k0 = 64 * (r / 32); d.n0 = 32 * (r % 32); d.WT = (bf16_t*)(ws + WS_WPP); d.ldt = 256; d.row0 = d.n0; return d; } r -= N_WPP;
    if (r < N_GLU) { d.W = a.in[I_GLUW]; d.ldw = 256; d.k0 = 64 * (r / 8); d.n0 = 32 * (r % 8); d.WT = (bf16_t*)(ws + WS_WGLU); d.ldt = 256; d.row0 = d.n0; return d; } r -= N_GLU;
    if (r < N_EG + N_EU) { const int up = r >= N_EG ? 1 : 0; if (up) r -= N_EG; const int e = r / 128, q = r % 128; d.k0 = 64 * (q / 8); d.n0 = 32 * (q % 8);
        d.W = a.in[up ? I_EU : I_EG] + (size_t)e * 1024 * 256; d.ks = a.in[I_FFNN]; d.ldw = 256; d.WT = (bf16_t*)(ws + WS_WGU); d.ldt = 1024; d.row0 = e * 512 + (d.n0 / 128) * 256 + up * 128 + (d.n0 % 128); return d; } r -= N_EG + N_EU;
    { const int e = r / 128, q = r % 128; d.k0 = 64 * (q / 32); d.n0 = 32 * (q % 32); d.W = a.in[I_ED] + (size_t)e * 256 * 1024; d.ldw = 1024; d.WT = (bf16_t*)(ws + WS_WD) + (size_t)e * 1024 * 256; d.ldt = 256; d.row0 = d.n0; return d; }
}
__device__ __forceinline__ void tr_load(const TrDesc& d, float (&tv)[32], int lane) {
#pragma unroll
    for (int i = 0; i < 32; ++i) tv[i] = __builtin_nontemporal_load(d.W + (size_t)(d.k0 + 2 * i + (lane >> 5)) * d.ldw + d.n0 + (lane & 31));
}
__device__ __forceinline__ void tr_store(const TrDesc& d, const float (&tv)[32], LAS float* scr, int lane) {
#pragma unroll
    for (int i = 0; i < 32; ++i) scr[(2 * i + (lane >> 5)) * 33 + (lane & 31)] = tv[i];
    LDS_WAIT();
    const int c = lane & 7; float sc[8];
#pragma unroll
    for (int i = 0; i < 8; ++i) sc[i] = d.ks ? d.ks[d.k0 + 8 * c + i] : 1.0f;
#pragma unroll
    for (int j = 0; j < 4; ++j) { const int n = (lane >> 3) + 8 * j; const LAS float* s = scr + (8 * c) * 33 + n;
        u32x4 o; o.x = pk2(s[0 * 33] * sc[0], s[1 * 33] * sc[1]); o.y = pk2(s[2 * 33] * sc[2], s[3 * 33] * sc[3]); o.z = pk2(s[4 * 33] * sc[4], s[5 * 33] * sc[5]); o.w = pk2(s[6 * 33] * sc[6], s[7 * 33] * sc[7]);
        *(u32x4*)(d.WT + (size_t)(d.row0 + n) * d.ldt + d.k0 + 8 * c) = o; }
    LDS_WAIT();
}
__device__ __forceinline__ void dsincos_reduced(double x, double& s, double& c) {
    const double x2 = x * x;
    double ps = -1.0 / 1.307674368e12  ; ps = ps * x2 + 1.0 / 6227020800.0; ps = ps * x2 - 1.0 / 39916800.0; ps = ps * x2 + 1.0 / 362880.0; ps = ps * x2 - 1.0 / 5040.0; ps = ps * x2 + 1.0 / 120.0; ps = ps * x2 - 1.0 / 6.0;
    double hs = -1.0 / 1.21645100408832e17  ; hs = hs * x2 + 1.0 / 3.55687428096e14  ; ps = ((hs * x2) * x2 * x2 * x2 * x2 * x2 * x2) + ps;
    s = x + x * x2 * ps;
    double pc = 1.0 / 2.0922789888e13  ; pc = pc * x2 - 1.0 / 87178291200.0; pc = pc * x2 + 1.0 / 479001600.0; pc = pc * x2 - 1.0 / 3628800.0; pc = pc * x2 + 1.0 / 40320.0; pc = pc * x2 - 1.0 / 720.0; pc = pc * x2 + 1.0 / 24.0; pc = pc * x2 - 0.5;
    double hc = 1.0 / 2.43290200817664e18  ; hc = hc * x2 - 1.0 / 6.402373705728e15  ; pc = ((hc * x2) * x2 * x2 * x2 * x2 * x2 * x2 * x2) + pc;
    c = 1.0 + x2 * pc;
}
__device__ __forceinline__ double dexp_(double x) {
    const double ln2 = 0.6931471805599453094; const double kf = __builtin_rint(x * 1.4426950408889634074); const double r = x - kf * ln2;
    double t = 1.0 / 6227020800.0; t = t * r + 1.0 / 479001600.0; t = t * r + 1.0 / 39916800.0; t = t * r + 1.0 / 3628800.0; t = t * r + 1.0 / 362880.0; t = t * r + 1.0 / 40320.0; t = t * r + 1.0 / 5040.0;
    t = t * r + 1.0 / 720.0; t = t * r + 1.0 / 120.0; t = t * r + 1.0 / 24.0; t = t * r + 1.0 / 6.0; t = t * r + 0.5; t = t * r + 1.0; t = t * r + 1.0;
    const int ki = (int)kf; const long long bits = (long long)(1023 + ki) << 52;
    return t * __builtin_bit_cast(double, bits);
}

__device__ __forceinline__ void phase0(const Args& a, LAS unsigned char* lds) {
    const int tid = threadIdx.x, lane = tid & 63, wave = tid >> 6, G = gridDim.x;
    const int gw = blockIdx.x * 8 + wave, NGW = G * 8;
    unsigned char* ws = a.ws;
    LAS float* scr = (LAS float*)(lds + wave * 8704);
    float tv[32]; TrDesc td; const bool has_tr = gw < 16 * 128;
    { const int it = has_tr ? gw : 0; td.W = a.in[I_WIN]; td.ks = a.in[I_MIXN]; td.WT = (bf16_t*)(ws + WS_WIN); td.ldw = INC; td.k0 = 64 * (it / 128); td.n0 = 32 * (it % 128); td.ldt = 1024; td.row0 = td.n0; }
    if (has_tr) tr_load(td, tv, lane);
    const int gt = blockIdx.x * 512 + tid;
    float sv[8]; f32x4 sg0 = (f32x4){1.f, 1.f, 1.f, 1.f}, sg1 = sg0;
#pragma unroll
    for (int i = 0; i < 8; ++i) sv[i] = 0.f;
    if (gt < 1536 * 32) { const int n = gt >> 5, k0 = (gt & 31) * 8; const float* bp = nullptr;
        if (n < 512) { if (k0 < 64) bp = a.in[I_WUP] + k0 * 512 + n; }
        else if (n < 1024) { if (k0 >= 64 && k0 < 128) bp = a.in[I_AUP] + (k0 - 64) * 512 + (n - 512); }
        else { if (k0 >= 128) bp = a.in[I_GUP] + (k0 - 128) * 512 + (n - 1024); }
        if (bp) {
#pragma unroll
            for (int i = 0; i < 8; ++i) sv[i] = bp[i * 512]; }
    } else if (gt < 1536 * 32 + 48 * 128) { const int cc = gt - 1536 * 32, j = cc >> 7, k0 = (cc & 127) * 8;
        if (j < 36) { const float* bp = (j < 4) ? (a.in[I_RGW] + k0 * 4 + j) : (a.in[I_REW] + k0 * 32 + (j - 4)); const int st = (j < 4) ? 4 : 32;
#pragma unroll
            for (int i = 0; i < 8; ++i) sv[i] = bp[i * st];
            sg0 = *(const f32x4*)(a.in[I_FFNN] + k0); sg1 = *(const f32x4*)(a.in[I_FFNN] + k0 + 4); }
    }
    if (wave == 7 && blockIdx.x < 256) { const int vb = blockIdx.x;
        const int g = vb & 15, part = vb >> 4;
        LAS float* Pre = (LAS float*)(lds + 69632);
        LAS float* Pim = Pre + 33 * 64;
        LAS float* Bre = Pim + 33 * 64;
        LAS float* Bim = Bre + 64 * 16;
        LAS float* Cre = Bim + 64 * 16;
        LAS float* Cim = Cre + 16 * 64;
        {
            const int n = lane; const double lr = (double)a.in[I_LRE][g * 64 + n], li = (double)a.in[I_LIM][g * 64 + n];
            const double dt = dexp_((double)a.in[I_LDT][g]);
            const double mag = dexp_(lr * dt); double ang = li * dt; const double twopi = 6.283185307179586477; ang -= __builtin_rint(ang * 0.15915494309189533577) * twopi;
            double sn, cs; dsincos_reduced(ang, sn, cs);
            const double lre = mag * cs, lim = mag * sn;
            const double nr = lre - 1.0, ni = lim, den = lr * lr + li * li; const double rden = 1.0 / den;
            const double cfr = (nr * lr + ni * li) * rden, cfi = (ni * lr - nr * li) * rden;
            for (int c = 0; c < 16; ++c) { const double br = (double)a.in[I_BRE][(g * 64 + n) * 16 + c], bi = (double)a.in[I_BIM][(g * 64 + n) * 16 + c];
                Bre[n * 16 + c] = (float)(cfr * br - cfi * bi); Bim[n * 16 + c] = (float)(cfr * bi + cfi * br); }
            double pr = 1.0, pi = 0.0;
            for (int tau = 0; tau <= 32; ++tau) { Pre[tau * 64 + n] = (float)pr; Pim[tau * 64 + n] = (float)pi; const double t2 = pr * lre - pi * lim; pi = pr * lim + pi * lre; pr = t2; }
            if (part == 0) ((f32x2*)(ws + WS_LAML))[g * 64 + n] = (f32x2){Pre[32 * 64 + n], Pim[32 * 64 + n]};
        }
        for (int i = lane; i < 1024; i += 64) { Cre[i] = a.in[I_CRE][g * 1024 + i]; Cim[i] = a.in[I_CIM][g * 1024 + i]; }
    }
    {
        bf16_t* HN = (bf16_t*)a.out; LAS unsigned* rowctr = (LAS unsigned*)(lds + MISC_OFF + 96); const int rows_per = T / G, row0 = blockIdx.x * rows_per;
        for (;;) {
            unsigned pr = 0; if (lane == 0) pr = atomicAdd((unsigned*)rowctr, 1u); pr = __builtin_amdgcn_readfirstlane(pr);
            if ((int)(2 * pr) >= rows_per) break;
            const int m0 = row0 + 2 * (int)pr;
            f32x4 v[2][4]; float s[2] = {0.f, 0.f};
#pragma unroll
            for (int u = 0; u < 2; ++u) { const f32x4* xr = (const f32x4*)(a.in[I_X] + (size_t)(m0 + u) * DM) + lane;
#pragma unroll
                for (int j = 0; j < 4; ++j) v[u][j] = __builtin_nontemporal_load(xr + 64 * j); }
#pragma unroll
            for (int u = 0; u < 2; ++u) {
#pragma unroll
                for (int j = 0; j < 4; ++j) s[u] += (v[u][j][0] * v[u][j][0] + v[u][j][1] * v[u][j][1]) + (v[u][j][2] * v[u][j][2] + v[u][j][3] * v[u][j][3]);
                const float rs = 1.0f / sqrtf(wave_sum(s[u]) * (1.0f / DM) + 1e-6f);
                u32x2* o = (u32x2*)(HN + (size_t)(m0 + u) * DM) + lane;
#pragma unroll
                for (int j = 0; j < 4; ++j) { u32x2 w; w.x = pk2(v[u][j][0] * rs, v[u][j][1] * rs); w.y = pk2(v[u][j][2] * rs, v[u][j][3] * rs); o[64 * j] = w; }
            }
        }
    }
    if (gt < 73728) { ((int*)(ws + WS_TOK))[gt] = 0; ((float*)(ws + WS_RSROW))[gt] = 0.f; }
    if (has_tr) tr_store(td, tv, scr, lane);
    for (int it = gw + NGW; it < 16 * 128; it += NGW)
        transpose_item(a.in[I_WIN], INC, a.in[I_MIXN], 64 * (it / 128), 32 * (it % 128), (bf16_t*)(ws + WS_WIN), 1024, 32 * (it % 128), 64 * (it / 128), scr, lane);
    if (gt < 1536 * 32 + 48 * 128) {
        u32x4 o; o.x = pk2(sv[0] * sg0[0], sv[1] * sg0[1]); o.y = pk2(sv[2] * sg0[2], sv[3] * sg0[3]); o.z = pk2(sv[4] * sg1[0], sv[5] * sg1[1]); o.w = pk2(sv[6] * sg1[2], sv[7] * sg1[3]);
        if (gt < 1536 * 32) *(u32x4*)((bf16_t*)(ws + WS_WLORA) + (size_t)(gt >> 5) * 256 + (gt & 31) * 8) = o;
        else { const int cc = gt - 1536 * 32; *(u32x4*)((bf16_t*)(ws + WS_WR) + (size_t)(cc >> 7) * 1024 + (cc & 127) * 8) = o; }
    }
    for (int c = gt + G * 512; c < 1536 * 32 + 48 * 128; c += G * 512) {
        float v[8];
        if (c < 1536 * 32) { const int n = c >> 5, k0 = (c & 31) * 8;
#pragma unroll
            for (int i = 0; i < 8; ++i) { const int k = k0 + i; float x = 0.f;
                if (n < 512) { if (k < 64) x = a.in[I_WUP][k * 512 + n]; }
                else if (n < 1024) { if (k >= 64 && k < 128) x = a.in[I_AUP][(k - 64) * 512 + (n - 512)]; }
                else { if (k >= 128) x = a.in[I_GUP][(k - 128) * 512 + (n - 1024)]; }
                v[i] = x; }
            u32x4 o; o.x = pk2(v[0], v[1]); o.y = pk2(v[2], v[3]); o.z = pk2(v[4], v[5]); o.w = pk2(v[6], v[7]); *(u32x4*)((bf16_t*)(ws + WS_WLORA) + (size_t)n * 256 + k0) = o;
        } else { const int cc = c - 1536 * 32, j = cc >> 7, k0 = (cc & 127) * 8;
#pragma unroll
            for (int i = 0; i < 8; ++i) { const int k = k0 + i; float x = 0.f;
                if (j < 4) x = a.in[I_RGW][k * 4 + j] * a.in[I_FFNN][k]; else if (j < 36) x = a.in[I_REW][k * 32 + (j - 4)] * a.in[I_FFNN][k];
                v[i] = x; }
            u32x4 o; o.x = pk2(v[0], v[1]); o.y = pk2(v[2], v[3]); o.z = pk2(v[4], v[5]); o.w = pk2(v[6], v[7]); *(u32x4*)((bf16_t*)(ws + WS_WR) + (size_t)j * 1024 + k0) = o; }
    }
    for (int vb = blockIdx.x; vb < 256; vb += G) {
        __syncthreads();
        const int g = vb & 15, part = vb >> 4;
        LAS float* Pre = (LAS float*)(lds + 69632);
        LAS float* Pim = Pre + 33 * 64;
        LAS float* Bre = Pim + 33 * 64;
        LAS float* Bim = Bre + 64 * 16;
        LAS float* Cre = Bim + 64 * 16;
        LAS float* Cim = Cre + 16 * 64;
        if (vb != (int)blockIdx.x && tid < 64) {
            const int n = tid; const double lr = (double)a.in[I_LRE][g * 64 + n], li = (double)a.in[I_LIM][g * 64 + n];
            const double dt = dexp_((double)a.in[I_LDT][g]);
            const double mag = dexp_(lr * dt); double ang = li * dt; const double twopi = 6.283185307179586477; ang -= __builtin_rint(ang * 0.15915494309189533577) * twopi;
            double sn, cs; dsincos_reduced(ang, sn, cs);
            const double lre = mag * cs, lim = mag * sn;
            const double nr = lre - 1.0, ni = lim, den = lr * lr + li * li; const double rden = 1.0 / den;
            const double cfr = (nr * lr + ni * li) * rden, cfi = (ni * lr - nr * li) * rden;
            for (int c = 0; c < 16; ++c) { const double br = (double)a.in[I_BRE][(g * 64 + n) * 16 + c], bi = (double)a.in[I_BIM][(g * 64 + n) * 16 + c];
                Bre[n * 16 + c] = (float)(cfr * br - cfi * bi); Bim[n * 16 + c] = (float)(cfr * bi + cfi * br); }
            double pr = 1.0, pi = 0.0;
            for (int tau = 0; tau <= 32; ++tau) { Pre[tau * 64 + n] = (float)pr; Pim[tau * 64 + n] = (float)pi; const double t2 = pr * lre - pi * lim; pi = pr * lim + pi * lre; pr = t2; }
            if (part == 0) ((f32x2*)(ws + WS_LAML))[g * 64 + n] = (f32x2){Pre[32 * 64 + n], Pim[32 * 64 + n]};
        }
        if (vb != (int)blockIdx.x) for (int i = tid; i < 1024; i += 512) { Cre[i] = a.in[I_CRE][g * 1024 + i]; Cim[i] = a.in[I_CIM][g * 1024 + i]; }
        __syncthreads();
        float* KG = (float*)(ws + WS_KG) + (size_t)g * 32 * 256;
        { const int e = part * 512 + tid; const int tau = e >> 8, co = (e >> 4) & 15, ci = e & 15; float s = 0.f;
            for (int n = 0; n < 64; ++n) { const float pr = Pre[tau * 64 + n], pi = Pim[tau * 64 + n], br = Bre[n * 16 + ci], bi = Bim[n * 16 + ci];
                const float qr = pr * br - pi * bi, qi = pr * bi + pi * br; s += Cre[co * 64 + n] * qr - Cim[co * 64 + n] * qi; }
            KG[e] = s; }
        bf16_t* TZ = (bf16_t*)(ws + WS_TZ) + (size_t)g * S5N * S5K;
        { const int e = part * 512 + tid; const int row = e >> 4, m0 = (e & 15) * 8, j = row >> 4, co = row & 15; float v[8];
#pragma unroll
            for (int i = 0; i < 8; ++i) { const int m = m0 + i, n = m & 63; const float pr = Pre[(j + 1) * 64 + n], pi = Pim[(j + 1) * 64 + n], cr = Cre[co * 64 + n], ci = Cim[co * 64 + n];
                v[i] = (m < 64) ? (cr * pr - ci * pi) : -(cr * pi + ci * pr); }
            u32x4 o; o.x = pk2(v[0], v[1]); o.y = pk2(v[2], v[3]); o.z = pk2(v[4], v[5]); o.w = pk2(v[6], v[7]); *(u32x4*)(TZ + (size_t)row * S5K + 512 + m0) = o; }
        bf16_t* W1 = (bf16_t*)(ws + WS_W1) + (size_t)g * 256 * 512;
        for (int e = part * 1024 + tid; e < part * 1024 + 1024; e += 512) { const int m = e >> 6, s = (e & 63) >> 1, ci0 = (e & 1) * 8; float v[8];
#pragma unroll
            for (int i = 0; i < 8; ++i) { float x = 0.f;
                if (m < 128) { const int n = m & 63; const float pr = Pre[(31 - s) * 64 + n], pi = Pim[(31 - s) * 64 + n], br = Bre[n * 16 + ci0 + i], bi = Bim[n * 16 + ci0 + i];
                    x = (m < 64) ? (pr * br - pi * bi) : (pr * bi + pi * br); }
                v[i] = x; }
            u32x4 o; o.x = pk2(v[0], v[1]); o.y = pk2(v[2], v[3]); o.z = pk2(v[4], v[5]); o.w = pk2(v[6], v[7]); *(u32x4*)(W1 + (size_t)m * 512 + s * 16 + ci0) = o; }
    }
    __syncthreads();
}

__device__ __forceinline__ void phase2(const Args& a) {
    const int gt = blockIdx.x * 512 + threadIdx.x, NT = gridDim.x * 512;
    unsigned char* ws = a.ws;
    const bf16_t* COLS = (const bf16_t*)(ws + WS_A); bf16_t* LIN = (bf16_t*)(ws + WS_Z);
    const float* mu = a.in[I_MU];
    {
        const int q = gt & 31, c8 = q * 8, src = C_WD + c8; const f32x4 m0 = *(const f32x4*)(mu + src), m1 = *(const f32x4*)(mu + src + 4);
        for (int p0 = gt; p0 < T * 32; p0 += 4 * NT) {
            u32x4 cw[4], pw[4];
#pragma unroll
            for (int u = 0; u < 4; ++u) { const int p = p0 + u * NT; const int t = (p < T * 32) ? (p >> 5) : (p0 >> 5);
                cw[u] = *(const u32x4*)(COLS + (size_t)t * INC + src); pw[u] = ((t & (SEQ - 1)) != 0) ? *(const u32x4*)(COLS + (size_t)(t - 1) * INC + src) : (u32x4){0u, 0u, 0u, 0u}; }
#pragma unroll
            for (int u = 0; u < 4; ++u) { const int p = p0 + u * NT; const int t = (p < T * 32) ? (p >> 5) : (p0 >> 5); float cur[8], prv[8], o[8]; unpack8(cw[u], cur); unpack8(pw[u], prv);
#pragma unroll
                for (int i = 0; i < 8; ++i) { const float xs = cur[i] + (prv[i] - cur[i]) * ((i < 4) ? m0[i & 3] : m1[i & 3]); o[i] = (c8 < 64) ? tanhf_(xs) : ((c8 < 128) ? xs : sigmoidf_(xs)); }
                *(u32x4*)(LIN + (size_t)t * 256 + c8) = pack8(o); }
        }
    }
    const float* KG = (const float*)(ws + WS_KG); bf16_t* TZ = (bf16_t*)(ws + WS_TZ);
    for (int p = gt; p < 16 * 512 * 64; p += NT) {
        const int g = p >> 15, row = (p >> 6) & 511, kc = p & 63, j = row >> 4, co = row & 15, s = kc >> 1, ci0 = (kc & 1) * 8;
        u32x4 o = (u32x4){0u, 0u, 0u, 0u};
        if (s <= j) { const float* k = KG + (((size_t)g * 32 + (j - s)) * 16 + co) * 16 + ci0; const f32x4 k0 = *(const f32x4*)k, k1 = *(const f32x4*)(k + 4);
            o.x = pk2(k0[0], k0[1]); o.y = pk2(k0[2], k0[3]); o.z = pk2(k1[0], k1[1]); o.w = pk2(k1[2], k1[3]); }
        *(u32x4*)(TZ + ((size_t)g * S5N + row) * S5K + kc * 8) = o;
    }
}

__device__ __forceinline__ void phase4(const Args& a, LAS unsigned char* lds) {
    const int tid = threadIdx.x, lane = tid & 63, wave = tid >> 6;
    unsigned char* ws = a.ws;
    TSTART(4); TSTART(1);
    for (int item = blockIdx.x; item < 256; item += gridDim.x) {
        if (tid < 64) {
            const int b = item >> 4, g = item & 15, n = tid;
            const f32x2 lamL = ((const f32x2*)(ws + WS_LAML))[g * 64 + n];
            const float* E = (const float*)(ws + WS_E) + ((size_t)g * S5ROWS + b * S5NCH) * 128;
            bf16_t* UG = (bf16_t*)(ws + WS_UG) + ((size_t)g * S5ROWS + b * S5NCH) * S5K + 512;
            float xr = 0.f, xi = 0.f;
#pragma unroll 2
            for (int ch = 0; ch < S5NCH; ++ch) {
                UG[(size_t)ch * S5K + n] = (bf16_t)f2bf(xr); UG[(size_t)ch * S5K + 64 + n] = (bf16_t)f2bf(xi);
                const float er = E[ch * 128 + n], ei = E[ch * 128 + 64 + n];
                const float nr = lamL[0] * xr - lamL[1] * xi + er, ni = lamL[0] * xi + lamL[1] * xr + ei; xr = nr; xi = ni;
            }
        }
    }
    TSTOP(1);
    const bf16_t* COLS = (const bf16_t*)(ws + WS_A); const bf16_t* LORA = (const bf16_t*)a.out;
    float* Y = (float*)(ws + WS_B); float* BON = (float*)(ws + WS_BON);
    LAS float* VECF = (LAS float*)lds;
    LAS float* VKP = (LAS float*)(lds + 81920);
    LAS float* BETA = (LAS float*)(lds + 98304);
    LAS float* YST = (LAS float*)(lds + 98816);
    for (int item = blockIdx.x; item < 256; item += gridDim.x) {
        const int bh = item >> 1, half = item & 1, b = bh >> 3, h = bh & 7;
        const int pj = tid >> 4, pq = tid & 15, hc = h * 64 + 4 * pq;
        float mur[4], muk[4], muv[4], kk4[4], ka4[4], rk4[4];
#pragma unroll
        for (int i = 0; i < 4; ++i) { mur[i] = a.in[I_MU][C_R + hc + i]; muk[i] = a.in[I_MU][C_K + hc + i]; muv[i] = a.in[I_MU][C_V + hc + i];
            kk4[i] = a.in[I_KK][hc + i]; ka4[i] = a.in[I_KA][hc + i]; rk4[i] = a.in[I_RK][hc + i]; }
        const int rr = lane >> 4, cl = lane & 15;
        const bool vmine = (pq >> 3) == half;
        const int qv = pq & 7;
        u32x2 rc, rp, kc, kp, kn, vc, vp, e4, a4;
        const u32x2 zero2 = (u32x2){0u, 0u};
        __syncthreads();
#define WKV_LOAD(chunk) do { const int s_ = (chunk) * 32 + pj; const size_t t_ = (size_t)b * SEQ + s_; const bf16_t* cb_ = COLS + t_ * INC + hc; \
            rc = *(const u32x2*)(cb_ + C_R); kc = *(const u32x2*)(cb_ + C_K); vc = *(const u32x2*)(cb_ + C_V); \
            if (s_ > 0) { rp = *(const u32x2*)(cb_ - INC + C_R); kp = *(const u32x2*)(cb_ - INC + C_K); vp = *(const u32x2*)(cb_ - INC + C_V); } else { rp = zero2; kp = zero2; vp = zero2; } \
            if (s_ < SEQ - 1) kn = *(const u32x2*)(cb_ + INC + C_K); else kn = zero2; \
            e4 = *(const u32x2*)(LORA + t_ * 1536 + hc); a4 = *(const u32x2*)(LORA + t_ * 1536 + 512 + hc); } while (0)
#define WKV_PREP(chunk, bi) do { float r_[4], rq_[4], k_[4], kq_[4], kx_[4], v_[4], vq_[4], e_[4], aa_[4]; unpack4(rc, r_); unpack4(rp, rq_); unpack4(kc, k_); unpack4(kp, kq_); unpack4(kn, kx_); unpack4(vc, v_); unpack4(vp, vq_); unpack4(e4, e_); unpack4(a4, aa_); \
            float kkv_[4], kkn_[4], k2_[4], ss_ = 0.f, ssn_ = 0.f; \
            _Pragma("unroll") for (int i = 0; i < 4; ++i) { r_[i] += (rq_[i] - r_[i]) * mur[i]; kx_[i] += (k_[i] - kx_[i]) * muk[i]; k_[i] += (kq_[i] - k_[i]) * muk[i]; v_[i] += (vq_[i] - v_[i]) * muv[i]; \
                kkv_[i] = k_[i] * kk4[i]; ss_ += kkv_[i] * kkv_[i]; kkn_[i] = kx_[i] * kk4[i]; ssn_ += kkn_[i] * kkn_[i]; k2_[i] = k_[i] * (1.0f + (aa_[i] - 1.0f) * ka4[i]); } \
            ss_ = row16_sum(ss_); ssn_ = row16_sum(ssn_); \
            const float inv_ = __builtin_amdgcn_rsqf(fmaxf(ss_, 1e-24f)), invn_ = __builtin_amdgcn_rsqf(fmaxf(ssn_, 1e-24f)); \
            float bv_[4], an_[4], w_[4], cv_[4], bon_ = 0.f, beta_ = 0.f, kap_ = 0.f; \
            _Pragma("unroll") for (int i = 0; i < 4; ++i) { bv_[i] = kkv_[i] * inv_ * aa_[i]; an_[i] = -kkn_[i] * invn_; w_[i] = __expf(-e_[i]); cv_[i] = w_[i] * an_[i]; \
                bon_ += r_[i] * k2_[i] * rk4[i]; beta_ += bv_[i] * an_[i]; kap_ += k2_[i] * an_[i]; } \
            bon_ = row16_sum(bon_); beta_ = row16_sum(beta_); kap_ = row16_sum(kap_); \
            if (pq == 0 && half == 0) BON[((size_t)b * SEQ + (chunk) * 32 + pj) * 8 + h] = bon_; \
            LAS float* vf_ = VECF + (bi) * 10240 + pj * 64 + 4 * pq; \
            *(LAS f32x4*)vf_ = (f32x4){w_[0], w_[1], w_[2], w_[3]}; *(LAS f32x4*)(vf_ + 2048) = (f32x4){cv_[0], cv_[1], cv_[2], cv_[3]}; *(LAS f32x4*)(vf_ + 4096) = (f32x4){bv_[0], bv_[1], bv_[2], bv_[3]}; \
            *(LAS f32x4*)(vf_ + 6144) = (f32x4){k2_[0], k2_[1], k2_[2], k2_[3]}; *(LAS f32x4*)(vf_ + 8192) = (f32x4){r_[0], r_[1], r_[2], r_[3]}; \
            if (pq == 0) *(LAS f32x2*)(BETA + ((bi) * 32 + pj) * 2) = (f32x2){beta_, beta_}; \
            if (vmine) { LAS float* kp_ = VKP + ((((bi) * 32 + pj) * 4 + (qv >> 1)) * 4) * 4 + (qv & 1); \
                _Pragma("unroll") for (int i = 0; i < 4; ++i) { kp_[i * 4] = v_[i]; kp_[i * 4 + 2] = v_[i] * kap_; } } } while (0)
        WKV_LOAD(0); WKV_PREP(0, 0);
        __syncthreads();
        float ltv[32];
#pragma unroll
        for (int i = 0; i < 32; ++i) ltv[i] = 0.f;
        f32x2 Q0 = {0.f, 0.f}, Q1 = Q0, Q2 = Q0, Q3 = Q0, SA = Q0, YP = Q0; float yselA = 0.f, yselB = 0.f; const int clp = (cl + 1) & 15;
        for (int chunk = 0; chunk < SEQ / 32; ++chunk) {
            const int bi = chunk & 1;
            TSTART(3);
            if (chunk > 1) { const LAS float* ys = YST + (((chunk - 2) & 3) * 32 + pj) * 33 + 2 * pq;
                *(f32x2*)(Y + ((size_t)b * SEQ + (chunk - 2) * 32 + pj) * 512 + h * 64 + 32 * half + 2 * pq) = (f32x2){ys[0], ys[1]}; }
            if (chunk + 1 < SEQ / 32) WKV_LOAD(chunk + 1);
            TSTOP(3); TSTART(2);
            if (__builtin_amdgcn_readfirstlane(wave) < 4) {
            const LAS float* vecp = VECF + bi * 10240 + 4 * cl; const LAS float* vkp = VKP + ((bi * 32 * 4 + wave) * 4 + rr) * 4; const LAS float* btp = BETA + bi * 64;
            LAS float* ysp = YST + ((chunk & 3) * 32 + cl) * 33 + 8 * wave + rr;
            LAS float* ysp_prev = YST + (((chunk + 3) & 3) * 32 + 16 + cl) * 33 + 8 * wave + rr;
            f32x4 w4 = *(const LAS f32x4*)vecp, c4 = *(const LAS f32x4*)(vecp + 2048), b4 = *(const LAS f32x4*)(vecp + 4096), k4 = *(const LAS f32x4*)(vecp + 6144), r4 = *(const LAS f32x4*)(vecp + 8192);
            f32x4 vk = *(const LAS f32x4*)vkp; f32x2 be = *(const LAS f32x2*)btp;
#pragma unroll 2
            for (int j = 0; j < 32; ++j) {
                const int jn = (j + 1) & 31;
                const f32x4 w4n = *(const LAS f32x4*)(vecp + jn * 64), c4n = *(const LAS f32x4*)(vecp + 2048 + jn * 64), b4n = *(const LAS f32x4*)(vecp + 4096 + jn * 64);
                const f32x4 k4n = *(const LAS f32x4*)(vecp + 6144 + jn * 64), r4n = *(const LAS f32x4*)(vecp + 8192 + jn * 64), vkn = *(const LAS f32x4*)(vkp + jn * 64);
                const f32x2 ben = *(const LAS f32x2*)(btp + jn * 2);
                const f32x2 w01 = __builtin_shufflevector(w4, w4, 0, 1), w23 = __builtin_shufflevector(w4, w4, 2, 3), c01 = __builtin_shufflevector(c4, c4, 0, 1), c23 = __builtin_shufflevector(c4, c4, 2, 3);
                const f32x2 b01 = __builtin_shufflevector(b4, b4, 0, 1), b23 = __builtin_shufflevector(b4, b4, 2, 3), k01 = __builtin_shufflevector(k4, k4, 0, 1), k23 = __builtin_shufflevector(k4, k4, 2, 3);
                const f32x2 r01 = __builtin_shufflevector(r4, r4, 0, 1), r23 = __builtin_shufflevector(r4, r4, 2, 3), VP = __builtin_shufflevector(vk, vk, 0, 1), VK2 = __builtin_shufflevector(vk, vk, 2, 3);
                f32x2 YN;
                asm volatile(
                    "v_pk_mul_f32 v[250:251], %[Q0], %[c01] op_sel_hi:[1,0]\n\t"
                    "v_pk_mul_f32 %[Q0], %[Q0], %[w01] op_sel_hi:[1,0]\n\t"
                    "v_add_f32_dpp %[yA], %[yA], %[yA] quad_perm:[1,0,3,2] row_mask:0xf bank_mask:0xf bound_ctrl:1\n\t"
                    "v_pk_fma_f32 v[250:251], %[Q1], %[c01], v[250:251] op_sel:[0,1,0] op_sel_hi:[1,1,1]\n\t"
                    "v_pk_mul_f32 %[Q1], %[Q1], %[w01] op_sel:[0,1] op_sel_hi:[1,1]\n\t"
                    "v_add_f32_dpp %[yB], %[yB], %[yB] quad_perm:[1,0,3,2] row_mask:0xf bank_mask:0xf bound_ctrl:1\n\t"
                    "v_pk_fma_f32 v[250:251], %[Q2], %[c23], v[250:251] op_sel_hi:[1,0,1]\n\t"
                    "v_pk_mul_f32 %[Q2], %[Q2], %[w23] op_sel_hi:[1,0]\n\t"
                    "v_add_f32_dpp %[yA], %[yA], %[yA] quad_perm:[2,3,0,1] row_mask:0xf bank_mask:0xf bound_ctrl:1\n\t"
                    "v_pk_fma_f32 v[250:251], %[Q3], %[c23], v[250:251] op_sel:[0,1,0] op_sel_hi:[1,1,1]\n\t"
                    "v_pk_mul_f32 %[Q3], %[Q3], %[w23] op_sel:[0,1] op_sel_hi:[1,1]\n\t"
                    "v_add_f32_dpp %[yB], %[yB], %[yB] quad_perm:[2,3,0,1] row_mask:0xf bank_mask:0xf bound_ctrl:1\n\t"
                    "v_pk_fma_f32 %[Q0], %[VP], %[k01], %[Q0] op_sel_hi:[1,0,1]\n\t"
                    "v_add_f32_dpp v250, v250, v250 quad_perm:[1,0,3,2] row_mask:0xf bank_mask:0xf bound_ctrl:1\n\t"
                    "v_pk_fma_f32 %[Q1], %[VP], %[k01], %[Q1] op_sel:[0,1,0] op_sel_hi:[1,1,1]\n\t"
                    "v_add_f32_dpp v251, v251, v251 quad_perm:[1,0,3,2] row_mask:0xf bank_mask:0xf bound_ctrl:1\n\t"
                    "v_pk_fma_f32 %[Q2], %[VP], %[k23], %[Q2] op_sel_hi:[1,0,1]\n\t"
                    "v_add_f32_dpp %[yA], %[yA], %[yA] row_half_mirror row_mask:0xf bank_mask:0xf bound_ctrl:1\n\t"
                    "v_pk_fma_f32 %[Q3], %[VP], %[k23], %[Q3] op_sel:[0,1,0] op_sel_hi:[1,1,1]\n\t"
                    "v_add_f32_dpp v250, v250, v250 quad_perm:[2,3,0,1] row_mask:0xf bank_mask:0xf bound_ctrl:1\n\t"
                    "v_pk_fma_f32 %[Q0], %[SA], %[b01], %[Q0] op_sel_hi:[1,0,1]\n\t"
                    "v_add_f32_dpp v251, v251, v251 quad_perm:[2,3,0,1] row_mask:0xf bank_mask:0xf bound_ctrl:1\n\t"
                    "v_pk_fma_f32 %[Q1], %[SA], %[b01], %[Q1] op_sel:[0,1,0] op_sel_hi:[1,1,1]\n\t"
                    "v_add_f32_dpp %[yB], %[yB], %[yB] row_half_mirror row_mask:0xf bank_mask:0xf bound_ctrl:1\n\t"
                    "v_pk_fma_f32 %[Q2], %[SA], %[b23], %[Q2] op_sel_hi:[1,0,1]\n\t"
                    "v_add_f32_dpp v250, v250, v250 row_half_mirror row_mask:0xf bank_mask:0xf bound_ctrl:1\n\t"
                    "v_pk_fma_f32 %[Q3], %[SA], %[b23], %[Q3] op_sel:[0,1,0] op_sel_hi:[1,1,1]\n\t"
                    "v_add_f32_dpp v251, v251, v251 row_half_mirror row_mask:0xf bank_mask:0xf bound_ctrl:1\n\t"
                    "v_pk_mul_f32 %[YN], %[Q0], %[r01] op_sel_hi:[1,0]\n\t"
                    "v_add_f32_dpp %[yA], %[yA], %[yA] row_mirror row_mask:0xf bank_mask:0xf bound_ctrl:1\n\t"
                    "v_pk_fma_f32 %[YN], %[Q1], %[r01], %[YN] op_sel:[0,1,0] op_sel_hi:[1,1,1]\n\t"
                    "v_add_f32_dpp v250, v250, v250 row_mirror row_mask:0xf bank_mask:0xf bound_ctrl:1\n\t"
                    "v_add_f32_dpp %[yB], %[yB], %[yB] row_mirror row_mask:0xf bank_mask:0xf bound_ctrl:1\n\t"
                    "v_add_f32_dpp v251, v251, v251 row_mirror row_mask:0xf bank_mask:0xf bound_ctrl:1\n\t"
                    "v_pk_fma_f32 %[YN], %[Q2], %[r23], %[YN] op_sel_hi:[1,0,1]\n\t"
                    "s_nop 0\n\t"
                    "v_pk_fma_f32 %[YN], %[Q3], %[r23], %[YN] op_sel:[0,1,0] op_sel_hi:[1,1,1]\n\t"
                    "v_pk_add_f32 v[250:251], v[250:251], %[VK2]\n\t"
                    "s_nop 0\n\t"
                    "v_pk_fma_f32 %[SA], %[SA], %[be], v[250:251]\n\t"
                    : [Q0] "+v"(Q0), [Q1] "+v"(Q1), [Q2] "+v"(Q2), [Q3] "+v"(Q3), [SA] "+v"(SA), [YN] "=&v"(YN), [yA] "+v"(YP[0]), [yB] "+v"(YP[1])
                    : [c01] "v"(c01), [c23] "v"(c23), [w01] "v"(w01), [w23] "v"(w23), [k01] "v"(k01), [k23] "v"(k23), [b01] "v"(b01), [b23] "v"(b23), [r01] "v"(r01), [r23] "v"(r23),
                      [VP] "v"(VP), [VK2] "v"(VK2), [be] "v"(be)
                    : "v250", "v251");
                const bool mine = (j & 15) == clp;
                yselA = mine ? YP[0] : yselA; yselB = mine ? YP[1] : yselB;
                if ((j & 15) == 0) { LAS float* yq = (j == 0) ? ysp_prev : ysp; yq[0] = yselA; yq[4] = yselB; }
                YP = YN;
                w4 = w4n; c4 = c4n; b4 = b4n; k4 = k4n; r4 = r4n; vk = vkn; be = ben;
            }
            }
            else if (item < (int)gridDim.x) {
                const int wv4 = __builtin_amdgcn_readfirstlane(wave) - 4; LAS float* lscr = (LAS float*)(lds + (wv4 < 3 ? 131584 + wv4 * 8448 : 115712));
                const int lit_prev = (chunk - 1) * (int)(gridDim.x * 4) + (int)blockIdx.x * 4 + wv4, lit = lit_prev + (int)(gridDim.x * 4);
                if (chunk > 0 && lit_prev < N_LATE) { const TrDesc d = late_desc(a, lit_prev); tr_store(d, ltv, lscr, lane); }
                if (lit < N_LATE) { const TrDesc d = late_desc(a, lit); tr_load(d, ltv, lane); }
            }
            TSTOP(2); TSTART(3);
            if (chunk + 1 < SEQ / 32) WKV_PREP(chunk + 1, bi ^ 1);
            __syncthreads();
            TSTOP(3);
        }
        if (__builtin_amdgcn_readfirstlane(wave) < 4) {
            const float ya = row16_sum(YP[0]), yb = row16_sum(YP[1]);
            if (cl == 15) { yselA = ya; yselB = yb; }
            LAS float* yq = YST + ((((SEQ / 32) - 1) & 3) * 32 + 16 + cl) * 33 + 8 * wave + rr; yq[0] = yselA; yq[4] = yselB;
        }
        __syncthreads();
#pragma unroll
        for (int cc = SEQ / 32 - 2; cc < SEQ / 32; ++cc) { const LAS float* ys = YST + ((cc & 3) * 32 + pj) * 33 + 2 * pq;
            *(f32x2*)(Y + ((size_t)b * SEQ + cc * 32 + pj) * 512 + h * 64 + 32 * half + 2 * pq) = (f32x2){ys[0], ys[1]}; }
#undef WKV_LOAD
#undef WKV_PREP
    }
    TSTOP(4);
}


__device__ __forceinline__ void late_items_idle(const Args& a, LAS unsigned char* lds, int lo, int hi, int first_idle) {
    if ((int)blockIdx.x < first_idle) return;
    const int lane = threadIdx.x & 63, wave = __builtin_amdgcn_readfirstlane(threadIdx.x >> 6);
    float ltv[32]; LAS float* lscr = (LAS float*)(lds + wave * 16384);
    for (int it = lo + ((int)blockIdx.x - first_idle) * 8 + wave; it < hi; it += ((int)gridDim.x - first_idle) * 8) { const TrDesc d = late_desc(a, it); tr_load(d, ltv, lane); tr_store(d, ltv, lscr, lane); }
}

typedef float f32x16 __attribute__((ext_vector_type(16)));
template <int KSTEPS>
__device__ __forceinline__ f32x16 mm32(f32x16 acc, const LAS bf16_t* A, int lda, const LAS bf16_t* Bt, int ldb, int lane) {
    const int r = lane & 31, h = lane >> 5;
    const LAS bf16_t* ap = A + r * lda + 8 * h; const LAS bf16_t* bp = Bt + r * ldb + 8 * h;
#pragma unroll
    for (int ks = 0; ks < KSTEPS; ++ks) acc = __builtin_amdgcn_mfma_f32_32x32x16_bf16(*(const LAS bf16x8*)(ap + 16 * ks), *(const LAS bf16x8*)(bp + 16 * ks), acc, 0, 0, 0);
    return acc;
}
#define TROW(i, lane) (((i) & 3) + 8 * ((i) >> 2) + 4 * ((lane) >> 5))
__device__ __forceinline__ unsigned short bf1(float f) { return (unsigned short)f2bf(f); }

__device__ __forceinline__ void phase4c(const Args& a, LAS unsigned char* lds) {
    const int tid = threadIdx.x, lane = tid & 63, wave = __builtin_amdgcn_readfirstlane(tid >> 6);
    unsigned char* ws = a.ws;
    TSTART(4); TSTART(1);
    for (int item = blockIdx.x; item < 256; item += gridDim.x) {
        if (tid < 64) {
            const int b = item >> 4, g = item & 15, n = tid;
            const f32x2 lamL = ((const f32x2*)(ws + WS_LAML))[g * 64 + n];
            const float* E = (const float*)(ws + WS_E) + ((size_t)g * S5ROWS + b * S5NCH) * 128;
            bf16_t* UG = (bf16_t*)(ws + WS_UG) + ((size_t)g * S5ROWS + b * S5NCH) * S5K + 512;
            float xr = 0.f, xi = 0.f;
#pragma unroll 8
            for (int ch = 0; ch < S5NCH; ++ch) {
                UG[(size_t)ch * S5K + n] = (bf16_t)f2bf(xr); UG[(size_t)ch * S5K + 64 + n] = (bf16_t)f2bf(xi);
                const float er = E[ch * 128 + n], ei = E[ch * 128 + 64 + n];
                const float nr = lamL[0] * xr - lamL[1] * xi + er, ni = lamL[0] * xi + lamL[1] * xr + ei; xr = nr; xi = ni;
            }
        }
    }
    TSTOP(1);
    if (gridDim.x != 256) { late_items_idle(a, lds, 0, N_LATE, 0); __syncthreads(); }
    const bf16_t* COLS = (const bf16_t*)(ws + WS_A); const bf16_t* LORA = (const bf16_t*)a.out;
    float* Y = (float*)(ws + WS_B); float* BON = (float*)(ws + WS_BON);
    LAS float* CUM = (LAS float*)lds;
    LAS float* PS = (LAS float*)(lds + 8192);
    LAS bf16_t* AT = (LAS bf16_t*)(lds + 10240);
    LAS bf16_t* BT = (LAS bf16_t*)(lds + 14848);
    LAS bf16_t* KT = (LAS bf16_t*)(lds + 19456);
    LAS bf16_t* RT = (LAS bf16_t*)(lds + 24064);
    LAS bf16_t* BTt = (LAS bf16_t*)(lds + 28672);
    LAS bf16_t* VmT = (LAS bf16_t*)(lds + 33792);
    LAS float* NabT = (LAS float*)(lds + 36352);
    LAS float* Nak = (LAS float*)(lds + 40960);
    LAS bf16_t* MbrT = (LAS bf16_t*)(lds + 45184);
    LAS bf16_t* A2 = (LAS bf16_t*)(lds + 47744);
    LAS bf16_t* NT = (LAS bf16_t*)(lds + 52864);
    LAS bf16_t* WyT = (LAS bf16_t*)(lds + 55424);
    LAS bf16_t* WzT = (LAS bf16_t*)(lds + 57984);
    LAS bf16_t* R2T = (LAS bf16_t*)(lds + 63104);
    LAS bf16_t* PpT = (LAS bf16_t*)(lds + 67712);
    LAS float* GC = (LAS float*)(lds + 76928);
    LAS bf16_t* SBF = (LAS bf16_t*)(lds + 77184);
    LAS float* YST = (LAS float*)(lds + 86400);
    for (int item = blockIdx.x; item < 256; item += gridDim.x) {
        const int bh = item >> 1, half = item & 1, b = bh >> 3, h = bh & 7;
        const int pj = tid >> 4, pq = tid & 15, hc = h * 64 + 4 * pq;
        const bool vmine = (pq >> 3) == half;
        u32x2 rc, rp, kc, kp, vc, vp, e4, a4;
        const u32x2 zero2 = (u32x2){0u, 0u};
        f32x16 Sacc;
#pragma unroll
        for (int i = 0; i < 16; ++i) Sacc[i] = 0.f;
        __syncthreads();
        for (int i = tid; i < 2 * 32 * 72 / 2; i += 512) ((LAS unsigned*)SBF)[i] = 0u;
#define WKV_LOAD(chunk) do { const int s_ = (chunk) * 32 + pj; const size_t t_ = (size_t)b * SEQ + s_; const bf16_t* cb_ = COLS + t_ * INC + hc; \
            rc = *(const u32x2*)(cb_ + C_R); kc = *(const u32x2*)(cb_ + C_K); vc = *(const u32x2*)(cb_ + C_V); \
            if (s_ > 0) { rp = *(const u32x2*)(cb_ - INC + C_R); kp = *(const u32x2*)(cb_ - INC + C_K); vp = *(const u32x2*)(cb_ - INC + C_V); } else { rp = zero2; kp = zero2; vp = zero2; } \
            e4 = *(const u32x2*)(LORA + t_ * 1536 + hc); a4 = *(const u32x2*)(LORA + t_ * 1536 + 512 + hc); } while (0)
        WKV_LOAD(0);
        for (int chunk = 0; chunk < SEQ / 32; ++chunk) {
            const int bi = chunk & 1;
            int tid_l = tid; asm volatile("" : "+v"(tid_l));
            const int lane = tid_l & 63, pj = tid_l >> 4, pq = tid_l & 15, tid = tid_l; (void)tid;
            float r_[4], k_[4], v_[4], e_[4], aa_[4], kkn_[4], k2_[4];
            { float rq_[4], kq_[4], vq_[4];
                const f32x4 mur = *(const f32x4*)(a.in[I_MU] + C_R + hc), muk = *(const f32x4*)(a.in[I_MU] + C_K + hc), muv = *(const f32x4*)(a.in[I_MU] + C_V + hc);
                const f32x4 kk4 = *(const f32x4*)(a.in[I_KK] + hc), ka4 = *(const f32x4*)(a.in[I_KA] + hc), rk4 = *(const f32x4*)(a.in[I_RK] + hc); unpack4(rc, r_); unpack4(rp, rq_); unpack4(kc, k_); unpack4(kp, kq_); unpack4(vc, v_); unpack4(vp, vq_); unpack4(e4, e_); unpack4(a4, aa_);
                float ss_ = 0.f, bon_ = 0.f;
#pragma unroll
                for (int i = 0; i < 4; ++i) { r_[i] += (rq_[i] - r_[i]) * mur[i]; k_[i] += (kq_[i] - k_[i]) * muk[i]; v_[i] += (vq_[i] - v_[i]) * muv[i];
                    kkn_[i] = k_[i] * kk4[i]; ss_ += kkn_[i] * kkn_[i]; k2_[i] = k_[i] * (1.0f + (aa_[i] - 1.0f) * ka4[i]); bon_ += r_[i] * k2_[i] * rk4[i]; }
                ss_ = row16_sum(ss_); bon_ = row16_sum(bon_); const float inv_ = __builtin_amdgcn_rsqf(fmaxf(ss_, 1e-24f));
#pragma unroll
                for (int i = 0; i < 4; ++i) kkn_[i] *= inv_;
                if (pq == 0 && half == 0) BON[((size_t)b * SEQ + chunk * 32 + pj) * 8 + h] = bon_;
                *(LAS f32x4*)(CUM + pj * 64 + 4 * pq) = (f32x4){e_[0], e_[1], e_[2], e_[3]}; }
            if (chunk + 1 < SEQ / 32) WKV_LOAD(chunk + 1);
            __syncthreads();
            {
                const int col = tid & 63, qd = tid >> 6; float e0 = CUM[(4 * qd) * 64 + col], e1 = CUM[(4 * qd + 1) * 64 + col], e2 = CUM[(4 * qd + 2) * 64 + col], e3 = CUM[(4 * qd + 3) * 64 + col];
                e1 += e0; e2 += e1; e3 += e2; PS[qd * 64 + col] = e3;
                __syncthreads();
                float base = 0.f;
#pragma unroll
                for (int q2 = 0; q2 < 7; ++q2) base += (q2 < qd) ? PS[q2 * 64 + col] : 0.f;
                CUM[(4 * qd) * 64 + col] = base + e0; CUM[(4 * qd + 1) * 64 + col] = base + e1; CUM[(4 * qd + 2) * 64 + col] = base + e2; CUM[(4 * qd + 3) * 64 + col] = base + e3; }
            __syncthreads();
            {
                const f32x4 cm = *(const LAS f32x4*)(CUM + pj * 64 + 4 * pq); float at_[4], bt_[4], kt_[4], rt_[4], g_[4];
#pragma unroll
                for (int i = 0; i < 4; ++i) { const float g = __expf(-cm[i]), ig = __expf(cm[i]), gp = __expf(e_[i] - cm[i]); g_[i] = g;
                    at_[i] = -kkn_[i] * gp; bt_[i] = kkn_[i] * aa_[i] * ig; kt_[i] = k2_[i] * ig; rt_[i] = r_[i] * g; }
                *(LAS u32x2*)(AT + pj * 72 + 4 * pq) = (u32x2){cvt_pk_bf16(at_[0], at_[1]), cvt_pk_bf16(at_[2], at_[3])};
                *(LAS u32x2*)(BT + pj * 72 + 4 * pq) = (u32x2){cvt_pk_bf16(bt_[0], bt_[1]), cvt_pk_bf16(bt_[2], bt_[3])};
                *(LAS u32x2*)(KT + pj * 72 + 4 * pq) = (u32x2){cvt_pk_bf16(kt_[0], kt_[1]), cvt_pk_bf16(kt_[2], kt_[3])};
                *(LAS u32x2*)(RT + pj * 72 + 4 * pq) = (u32x2){cvt_pk_bf16(rt_[0], rt_[1]), cvt_pk_bf16(rt_[2], rt_[3])};
#pragma unroll
                for (int i = 0; i < 4; ++i) BTt[(4 * pq + i) * 40 + pj] = bf1(bt_[i]);
                if (vmine) {
#pragma unroll
                    for (int i = 0; i < 4; ++i) VmT[(4 * pq - 32 * half + i) * 40 + pj] = bf1(v_[i]); }
                if (pj == 31) *(LAS f32x4*)(GC + 4 * pq) = (f32x4){g_[0], g_[1], g_[2], g_[3]}; }
            __syncthreads();
            f32x16 accw;
#pragma unroll
            for (int i = 0; i < 16; ++i) accw[i] = 0.f;
            if (wave < 4) {
                f32x16 acc;
#pragma unroll
                for (int i = 0; i < 16; ++i) acc[i] = 0.f;
                acc = mm32<4>(acc, (wave & 1) ? KT : BT, 72, (wave & 2) ? RT : AT, 72, lane);
                const int t = lane & 31;
                if (wave == 0) {
#pragma unroll
                    for (int g4 = 0; g4 < 4; ++g4) { const int s0 = 8 * g4 + 4 * (lane >> 5);
#pragma unroll
                        for (int i = 0; i < 4; ++i) NabT[t * 36 + i * 8 + 2 * g4 + (lane >> 5)] = (s0 + i < t) ? acc[4 * g4 + i] : 0.f; }
                } else if (wave == 1) {
#pragma unroll
                    for (int i = 0; i < 16; ++i) { const int s = TROW(i, lane); Nak[s * 33 + t] = (s < t) ? acc[i] : 0.f; }
                } else if (wave == 2) {
#pragma unroll
                    for (int g4 = 0; g4 < 4; ++g4) { const int s0 = 8 * g4 + 4 * (lane >> 5); float o[4];
#pragma unroll
                        for (int i = 0; i < 4; ++i) o[i] = (s0 + i <= t) ? acc[4 * g4 + i] : 0.f;
                        *(LAS u32x2*)(MbrT + t * 40 + s0) = (u32x2){cvt_pk_bf16(o[0], o[1]), cvt_pk_bf16(o[2], o[3])}; }
                } else {
#pragma unroll
                    for (int i = 0; i < 16; ++i) { const int s = TROW(i, lane); accw[i] = (s <= t) ? acc[i] : 0.f; }
                }
            }
            __syncthreads();
            if (wave < 6) {
                const int q = lane & 3, rowi = ((wave & 3) * 64 + lane) >> 2; const bool isA = wave < 4;
                float xq0, xq1, xq2, xq3, xq4, xq5, xq6, xq7;
                if (isA) {
                    xq0 = __builtin_bit_cast(float, (unsigned)AT[(0 + q) * 72 + rowi] << 16);
                    xq1 = __builtin_bit_cast(float, (unsigned)AT[(4 + q) * 72 + rowi] << 16);
                    xq2 = __builtin_bit_cast(float, (unsigned)AT[(8 + q) * 72 + rowi] << 16);
                    xq3 = __builtin_bit_cast(float, (unsigned)AT[(12 + q) * 72 + rowi] << 16);
                    xq4 = __builtin_bit_cast(float, (unsigned)AT[(16 + q) * 72 + rowi] << 16);
                    xq5 = __builtin_bit_cast(float, (unsigned)AT[(20 + q) * 72 + rowi] << 16);
                    xq6 = __builtin_bit_cast(float, (unsigned)AT[(24 + q) * 72 + rowi] << 16);
                    xq7 = __builtin_bit_cast(float, (unsigned)AT[(28 + q) * 72 + rowi] << 16);
                } else {
                    xq0 = Nak[rowi * 33 + 0 + q];
                    xq1 = Nak[rowi * 33 + 4 + q];
                    xq2 = Nak[rowi * 33 + 8 + q];
                    xq3 = Nak[rowi * 33 + 12 + q];
                    xq4 = Nak[rowi * 33 + 16 + q];
                    xq5 = Nak[rowi * 33 + 20 + q];
                    xq6 = Nak[rowi * 33 + 24 + q];
                    xq7 = Nak[rowi * 33 + 28 + q];
                }
                const bool kq0 = q == 0, kq1 = q == 1, kq2 = q == 2, kq3 = q == 3;
                const LAS float* np_ = NabT + q * 8;
                f32x4 n1_0, n2_0, n3_0, n4_0, n5_0, n6_0, n7_0, n8_0, n9_0, n10_0, n11_0, n12_0, n13_0, n14_0, n15_0, n16_0, n17_0, n17_1, n18_0, n18_1, n19_0, n19_1, n20_0, n20_1, n21_0, n21_1, n22_0, n22_1, n23_0, n23_1, n24_0, n24_1, n25_0, n25_1, n26_0, n26_1, n27_0, n27_1, n28_0, n28_1, n29_0, n29_1, n30_0, n30_1, n31_0, n31_1;
                float pe1, pe2, pe3, pe4, pe5, pe6, pe7, pe8, pe9, pe10, pe11, pe12, pe13, pe14, pe15, pe16, pe17, pe18, pe19, pe20, pe21, pe22, pe23, pe24, pe25, pe26, pe27, pe28, pe29, pe30, pe31, pe32;
                n1_0 = *(const LAS f32x4*)(np_ + 1 * 36); n2_0 = *(const LAS f32x4*)(np_ + 2 * 36); pe1 = 0.f;
                { n3_0 = *(const LAS f32x4*)(np_ + 3 * 36); float p = pe1; asm("v_fmac_f32 %0, %1, %2" : "+v"(p) : "v"(xq0), "v"(n1_0[0])); p += dpp_f(p, 0); pe2 = 0.f; p += dpp_f(p, 1); xq0 = kq1 ? (xq0 + p) : xq0; asm volatile("" : "+v"(xq0), "+v"(np_) : "v"(n1_0)); }
                { n4_0 = *(const LAS f32x4*)(np_ + 4 * 36); float p = pe2; asm("v_fmac_f32 %0, %1, %2" : "+v"(p) : "v"(xq0), "v"(n2_0[0])); p += dpp_f(p, 0); pe3 = 0.f; p += dpp_f(p, 1); xq0 = kq2 ? (xq0 + p) : xq0; asm volatile("" : "+v"(xq0), "+v"(np_) : "v"(n2_0)); }
                { n5_0 = *(const LAS f32x4*)(np_ + 5 * 36); float p = pe3; asm("v_fmac_f32 %0, %1, %2" : "+v"(p) : "v"(xq0), "v"(n3_0[0])); p += dpp_f(p, 0); pe4 = 0.f; p += dpp_f(p, 1); xq0 = kq3 ? (xq0 + p) : xq0; asm volatile("" : "+v"(xq0), "+v"(np_) : "v"(n3_0)); }
                { n6_0 = *(const LAS f32x4*)(np_ + 6 * 36); float p = pe4; asm("v_fmac_f32 %0, %1, %2" : "+v"(p) : "v"(xq0), "v"(n4_0[0])); p += dpp_f(p, 0); pe5 = 0.f; asm("v_fmac_f32 %0, %1, %2" : "+v"(pe5) : "v"(xq0), "v"(n5_0[0])); p += dpp_f(p, 1); xq1 = kq0 ? (xq1 + p) : xq1; asm volatile("" : "+v"(xq1), "+v"(np_) : "v"(n4_0)); }
                { n7_0 = *(const LAS f32x4*)(np_ + 7 * 36); float p = pe5; asm("v_fmac_f32 %0, %1, %2" : "+v"(p) : "v"(xq1), "v"(n5_0[1])); p += dpp_f(p, 0); pe6 = 0.f; asm("v_fmac_f32 %0, %1, %2" : "+v"(pe6) : "v"(xq0), "v"(n6_0[0])); p += dpp_f(p, 1); xq1 = kq1 ? (xq1 + p) : xq1; asm volatile("" : "+v"(xq1), "+v"(np_) : "v"(n5_0)); }
                { n8_0 = *(const LAS f32x4*)(np_ + 8 * 36); float p = pe6; asm("v_fmac_f32 %0, %1, %2" : "+v"(p) : "v"(xq1), "v"(n6_0[1])); p += dpp_f(p, 0); pe7 = 0.f; asm("v_fmac_f32 %0, %1, %2" : "+v"(pe7) : "v"(xq0), "v"(n7_0[0])); p += dpp_f(p, 1); xq1 = kq2 ? (xq1 + p) : xq1; asm volatile("" : "+v"(xq1), "+v"(np_) : "v"(n6_0)); }
                { n9_0 = *(const LAS f32x4*)(np_ + 9 * 36); float p = pe7; asm("v_fmac_f32 %0, %1, %2" : "+v"(p) : "v"(xq1), "v"(n7_0[1])); p += dpp_f(p, 0); pe8 = 0.f; asm("v_fmac_f32 %0, %1, %2" : "+v"(pe8) : "v"(xq0), "v"(n8_0[0])); p += dpp_f(p, 1); xq1 = kq3 ? (xq1 + p) : xq1; asm volatile("" : "+v"(xq1), "+v"(np_) : "v"(n7_0)); }
                { n10_0 = *(const LAS f32x4*)(np_ + 10 * 36); float p = pe8; asm("v_fmac_f32 %0, %1, %2" : "+v"(p) : "v"(xq1), "v"(n8_0[1])); p += dpp_f(p, 0); pe9 = 0.f; asm("v_fmac_f32 %0, %1, %2" : "+v"(pe9) : "v"(xq0), "v"(n9_0[0])); asm("v_fmac_f32 %0, %1, %2" : "+v"(pe9) : "v"(xq1), "v"(n9_0[1])); p += dpp_f(p, 1); xq2 = kq0 ? (xq2 + p) : xq2; asm volatile("" : "+v"(xq2), "+v"(np_) : "v"(n8_0)); }
                { n11_0 = *(const LAS f32x4*)(np_ + 11 * 36); float p = pe9; asm("v_fmac_f32 %0, %1, %2" : "+v"(p) : "v"(xq2), "v"(n9_0[2])); p += dpp_f(p, 0); pe10 = 0.f; asm("v_fmac_f32 %0, %1, %2" : "+v"(pe10) : "v"(xq0), "v"(n10_0[0])); asm("v_fmac_f32 %0, %1, %2" : "+v"(pe10) : "v"(xq1), "v"(n10_0[1])); p += dpp_f(p, 1); xq2 = kq1 ? (xq2 + p) : xq2; asm volatile("" : "+v"(xq2), "+v"(np_) : "v"(n9_0)); }
                { n12_0 = *(const LAS f32x4*)(np_ + 12 * 36); float p = pe10; asm("v_fmac_f32 %0, %1, %2" : "+v"(p) : "v"(xq2), "v"(n10_0[2])); p += dpp_f(p, 0); pe11 = 0.f; asm("v_fmac_f32 %0, %1, %2" : "+v"(pe11) : "v"(xq0), "v"(n11_0[0])); asm("v_fmac_f32 %0, %1, %2" : "+v"(pe11) : "v"(xq1), "v"(n11_0[1])); p += dpp_f(p, 1); xq2 = kq2 ? (xq2 + p) : xq2; asm volatile("" : "+v"(xq2), "+v"(np_) : "v"(n10_0)); }
                { n13_0 = *(const LAS f32x4*)(np_ + 13 * 36); float p = pe11; asm("v_fmac_f32 %0, %1, %2" : "+v"(p) : "v"(xq2), "v"(n11_0[2])); p += dpp_f(p, 0); pe12 = 0.f; asm("v_fmac_f32 %0, %1, %2" : "+v"(pe12) : "v"(xq0), "v"(n12_0[0])); asm("v_fmac_f32 %0, %1, %2" : "+v"(pe12) : "v"(xq1), "v"(n12_0[1])); p += dpp_f(p, 1); xq2 = kq3 ? (xq2 + p) : xq2; asm volatile("" : "+v"(xq2), "+v"(np_) : "v"(n11_0)); }
                { n14_0 = *(const LAS f32x4*)(np_ + 14 * 36); float p = pe12; asm("v_fmac_f32 %0, %1, %2" : "+v"(p) : "v"(xq2), "v"(n12_0[2])); p += dpp_f(p, 0); pe13 = 0.f; asm("v_fmac_f32 %0, %1, %2" : "+v"(pe13) : "v"(xq0), "v"(n13_0[0])); asm("v_fmac_f32 %0, %1, %2" : "+v"(pe13) : "v"(xq1), "v"(n13_0[1])); asm("v_fmac_f32 %0, %1, %2" : "+v"(pe13) : "v"(xq2), "v"(n13_0[2])); p += dpp_f(p, 1); xq3 = kq0 ? (xq3 + p) : xq3; asm volatile("" : "+v"(xq3), "+v"(np_) : "v"(n12_0)); }
                { n15_0 = *(const LAS f32x4*)(np_ + 15 * 36); float p = pe13; asm("v_fmac_f32 %0, %1, %2" : "+v"(p) : "v"(xq3), "v"(n13_0[3])); p += dpp_f(p, 0); pe14 = 0.f; asm("v_fmac_f32 %0, %1, %2" : "+v"(pe14) : "v"(xq0), "v"(n14_0[0])); asm("v_fmac_f32 %0, %1, %2" : "+v"(pe14) : "v"(xq1), "v"(n14_0[1])); asm("v_fmac_f32 %0, %1, %2" : "+v"(pe14) : "v"(xq2), "v"(n14_0[2])); p += dpp_f(p, 1); xq3 = kq1 ? (xq3 + p) : xq3; asm volatile("" : "+v"(xq3), "+v"(np_) : "v"(n13_0)); }
                { n16_0 = *(const LAS f32x4*)(np_ + 16 * 36); float p = pe14; asm("v_fmac_f32 %0, %1, %2" : "+v"(p) : "v"(xq3), "v"(n14_0[3])); p += dpp_f(p, 0); pe15 = 0.f; asm("v_fmac_f32 %0, %1, %2" : "+v"(pe15) : "v"(xq0), "v"(n15_0[0])); asm("v_fmac_f32 %0, %1, %2" : "+v"(pe15) : "v"(xq1), "v"(n15_0[1])); asm("v_fmac_f32 %0, %1, %2" : "+v"(pe15) : "v"(xq2), "v"(n15_0[2])); p += dpp_f(p, 1); xq3 = kq2 ? (xq3 + p) : xq3; asm volatile("" : "+v"(xq3), "+v"(np_) : "v"(n14_0)); }
                { n17_0 = *(const LAS f32x4*)(np_ + 17 * 36); n17_1 = *(const LAS f32x4*)(np_ + 17 * 36 + 4); float p = pe15; asm("v_fmac_f32 %0, %1, %2" : "+v"(p) : "v"(xq3), "v"(n15_0[3])); p += dpp_f(p, 0); pe16 = 0.f; asm("v_fmac_f32 %0, %1, %2" : "+v"(pe16) : "v"(xq0), "v"(n16_0[0])); asm("v_fmac_f32 %0, %1, %2" : "+v"(pe16) : "v"(xq1), "v"(n16_0[1])); asm("v_fmac_f32 %0, %1, %2" : "+v"(pe16) : "v"(xq2), "v"(n16_0[2])); p += dpp_f(p, 1); xq3 = kq3 ? (xq3 + p) : xq3; asm volatile("" : "+v"(xq3), "+v"(np_) : "v"(n15_0)); }
                { n18_0 = *(const LAS f32x4*)(np_ + 18 * 36); n18_1 = *(const LAS f32x4*)(np_ + 18 * 36 + 4); float p = pe16; asm("v_fmac_f32 %0, %1, %2" : "+v"(p) : "v"(xq3), "v"(n16_0[3])); p += dpp_f(p, 0); pe17 = 0.f; asm("v_fmac_f32 %0, %1, %2" : "+v"(pe17) : "v"(xq0), "v"(n17_0[0])); asm("v_fmac_f32 %0, %1, %2" : "+v"(pe17) : "v"(xq1), "v"(n17_0[1])); asm("v_fmac_f32 %0, %1, %2" : "+v"(pe17) : "v"(xq2), "v"(n17_0[2])); asm("v_fmac_f32 %0, %1, %2" : "+v"(pe17) : "v"(xq3), "v"(n17_0[3])); p += dpp_f(p, 1); xq4 = kq0 ? (xq4 + p) : xq4; asm volatile("" : "+v"(xq4), "+v"(np_) : "v"(n16_0)); }
                { n19_0 = *(const LAS f32x4*)(np_ + 19 * 36); n19_1 = *(const LAS f32x4*)(np_ + 19 * 36 + 4); float p = pe17; asm("v_fmac_f32 %0, %1, %2" : "+v"(p) : "v"(xq4), "v"(n17_1[0])); p += dpp_f(p, 0); pe18 = 0.f; asm("v_fmac_f32 %0, %1, %2" : "+v"(pe18) : "v"(xq0), "v"(n18_0[0])); asm("v_fmac_f32 %0, %1, %2" : "+v"(pe18) : "v"(xq1), "v"(n18_0[1])); asm("v_fmac_f32 %0, %1, %2" : "+v"(pe18) : "v"(xq2), "v"(n18_0[2])); asm("v_fmac_f32 %0, %1, %2" : "+v"(pe18) : "v"(xq3), "v"(n18_0[3])); p += dpp_f(p, 1); xq4 = kq1 ? (xq4 + p) : xq4; asm volatile("" : "+v"(xq4), "+v"(np_) : "v"(n17_0), "v"(n17_1)); }
                { n20_0 = *(const LAS f32x4*)(np_ + 20 * 36); n20_1 = *(const LAS f32x4*)(np_ + 20 * 36 + 4); float p = pe18; asm("v_fmac_f32 %0, %1, %2" : "+v"(p) : "v"(xq4), "v"(n18_1[0])); p += dpp_f(p, 0); pe19 = 0.f; asm("v_fmac_f32 %0, %1, %2" : "+v"(pe19) : "v"(xq0), "v"(n19_0[0])); asm("v_fmac_f32 %0, %1, %2" : "+v"(pe19) : "v"(xq1), "v"(n19_0[1])); asm("v_fmac_f32 %0, %1, %2" : "+v"(pe19) : "v"(xq2), "v"(n19_0[2])); asm("v_fmac_f32 %0, %1, %2" : "+v"(pe19) : "v"(xq3), "v"(n19_0[3])); p += dpp_f(p, 1); xq4 = kq2 ? (xq4 + p) : xq4; asm volatile("" : "+v"(xq4), "+v"(np_) : "v"(n18_0), "v"(n18_1)); }
                { n21_0 = *(const LAS f32x4*)(np_ + 21 * 36); n21_1 = *(const LAS f32x4*)(np_ + 21 * 36 + 4); float p = pe19; asm("v_fmac_f32 %0, %1, %2" : "+v"(p) : "v"(xq4), "v"(n19_1[0])); p += dpp_f(p, 0); pe20 = 0.f; asm("v_fmac_f32 %0, %1, %2" : "+v"(pe20) : "v"(xq0), "v"(n20_0[0])); asm("v_fmac_f32 %0, %1, %2" : "+v"(pe20) : "v"(xq1), "v"(n20_0[1])); asm("v_fmac_f32 %0, %1, %2" : "+v"(pe20) : "v"(xq2), "v"(n20_0[2])); asm("v_fmac_f32 %0, %1, %2" : "+v"(pe20) : "v"(xq3), "v"(n20_0[3])); p += dpp_f(p, 1); xq4 = kq3 ? (xq4 + p) : xq4; asm volatile("" : "+v"(xq4), "+v"(np_) : "v"(n19_0), "v"(n19_1)); }
                { n22_0 = *(const LAS f32x4*)(np_ + 22 * 36); n22_1 = *(const LAS f32x4*)(np_ + 22 * 36 + 4); float p = pe20; asm("v_fmac_f32 %0, %1, %2" : "+v"(p) : "v"(xq4), "v"(n20_1[0])); p += dpp_f(p, 0); pe21 = 0.f; asm("v_fmac_f32 %0, %1, %2" : "+v"(pe21) : "v"(xq0), "v"(n21_0[0])); asm("v_fmac_f32 %0, %1, %2" : "+v"(pe21) : "v"(xq1), "v"(n21_0[1])); asm("v_fmac_f32 %0, %1, %2" : "+v"(pe21) : "v"(xq2), "v"(n21_0[2])); asm("v_fmac_f32 %0, %1, %2" : "+v"(pe21) : "v"(xq3), "v"(n21_0[3])); asm("v_fmac_f32 %0, %1, %2" : "+v"(pe21) : "v"(xq4), "v"(n21_1[0])); p += dpp_f(p, 1); xq5 = kq0 ? (xq5 + p) : xq5; asm volatile("" : "+v"(xq5), "+v"(np_) : "v"(n20_0), "v"(n20_1)); }
                { n23_0 = *(const LAS f32x4*)(np_ + 23 * 36); n23_1 = *(const LAS f32x4*)(np_ + 23 * 36 + 4); float p = pe21; asm("v_fmac_f32 %0, %1, %2" : "+v"(p) : "v"(xq5), "v"(n21_1[1])); p += dpp_f(p, 0); pe22 = 0.f; asm("v_fmac_f32 %0, %1, %2" : "+v"(pe22) : "v"(xq0), "v"(n22_0[0])); asm("v_fmac_f32 %0, %1, %2" : "+v"(pe22) : "v"(xq1), "v"(n22_0[1])); asm("v_fmac_f32 %0, %1, %2" : "+v"(pe22) : "v"(xq2), "v"(n22_0[2])); asm("v_fmac_f32 %0, %1, %2" : "+v"(pe22) : "v"(xq3), "v"(n22_0[3])); asm("v_fmac_f32 %0, %1, %2" : "+v"(pe22) : "v"(xq4), "v"(n22_1[0])); p += dpp_f(p, 1); xq5 = kq1 ? (xq5 + p) : xq5; asm volatile("" : "+v"(xq5), "+v"(np_) : "v"(n21_0), "v"(n21_1)); }
                { n24_0 = *(const LAS f32x4*)(np_ + 24 * 36); n24_1 = *(const LAS f32x4*)(np_ + 24 * 36 + 4); float p = pe22; asm("v_fmac_f32 %0, %1, %2" : "+v"(p) : "v"(xq5), "v"(n22_1[1])); p += dpp_f(p, 0); pe23 = 0.f; asm("v_fmac_f32 %0, %1, %2" : "+v"(pe23) : "v"(xq0), "v"(n23_0[0])); asm("v_fmac_f32 %0, %1, %2" : "+v"(pe23) : "v"(xq1), "v"(n23_0[1])); asm("v_fmac_f32 %0, %1, %2" : "+v"(pe23) : "v"(xq2), "v"(n23_0[2])); asm("v_fmac_f32 %0, %1, %2" : "+v"(pe23) : "v"(xq3), "v"(n23_0[3])); asm("v_fmac_f32 %0, %1, %2" : "+v"(pe23) : "v"(xq4), "v"(n23_1[0])); p += dpp_f(p, 1); xq5 = kq2 ? (xq5 + p) : xq5; asm volatile("" : "+v"(xq5), "+v"(np_) : "v"(n22_0), "v"(n22_1)); }
                { n25_0 = *(const LAS f32x4*)(np_ + 25 * 36); n25_1 = *(const LAS f32x4*)(np_ + 25 * 36 + 4); float p = pe23; asm("v_fmac_f32 %0, %1, %2" : "+v"(p) : "v"(xq5), "v"(n23_1[1])); p += dpp_f(p, 0); pe24 = 0.f; asm("v_fmac_f32 %0, %1, %2" : "+v"(pe24) : "v"(xq0), "v"(n24_0[0])); asm("v_fmac_f32 %0, %1, %2" : "+v"(pe24) : "v"(xq1), "v"(n24_0[1])); asm("v_fmac_f32 %0, %1, %2" : "+v"(pe24) : "v"(xq2), "v"(n24_0[2])); asm("v_fmac_f32 %0, %1, %2" : "+v"(pe24) : "v"(xq3), "v"(n24_0[3])); asm("v_fmac_f32 %0, %1, %2" : "+v"(pe24) : "v"(xq4), "v"(n24_1[0])); p += dpp_f(p, 1); xq5 = kq3 ? (xq5 + p) : xq5; asm volatile("" : "+v"(xq5), "+v"(np_) : "v"(n23_0), "v"(n23_1)); }
                { n26_0 = *(const LAS f32x4*)(np_ + 26 * 36); n26_1 = *(const LAS f32x4*)(np_ + 26 * 36 + 4); float p = pe24; asm("v_fmac_f32 %0, %1, %2" : "+v"(p) : "v"(xq5), "v"(n24_1[1])); p += dpp_f(p, 0); pe25 = 0.f; asm("v_fmac_f32 %0, %1, %2" : "+v"(pe25) : "v"(xq0), "v"(n25_0[0])); asm("v_fmac_f32 %0, %1, %2" : "+v"(pe25) : "v"(xq1), "v"(n25_0[1])); asm("v_fmac_f32 %0, %1, %2" : "+v"(pe25) : "v"(xq2), "v"(n25_0[2])); asm("v_fmac_f32 %0, %1, %2" : "+v"(pe25) : "v"(xq3), "v"(n25_0[3])); asm("v_fmac_f32 %0, %1, %2" : "+v"(pe25) : "v"(xq4), "v"(n25_1[0])); asm("v_fmac_f32 %0, %1, %2" : "+v"(pe25) : "v"(xq5), "v"(n25_1[1])); p += dpp_f(p, 1); xq6 = kq0 ? (xq6 + p) : xq6; asm volatile("" : "+v"(xq6), "+v"(np_) : "v"(n24_0), "v"(n24_1)); }
                { n27_0 = *(const LAS f32x4*)(np_ + 27 * 36); n27_1 = *(const LAS f32x4*)(np_ + 27 * 36 + 4); float p = pe25; asm("v_fmac_f32 %0, %1, %2" : "+v"(p) : "v"(xq6), "v"(n25_1[2])); p += dpp_f(p, 0); pe26 = 0.f; asm("v_fmac_f32 %0, %1, %2" : "+v"(pe26) : "v"(xq0), "v"(n26_0[0])); asm("v_fmac_f32 %0, %1, %2" : "+v"(pe26) : "v"(xq1), "v"(n26_0[1])); asm("v_fmac_f32 %0, %1, %2" : "+v"(pe26) : "v"(xq2), "v"(n26_0[2])); asm("v_fmac_f32 %0, %1, %2" : "+v"(pe26) : "v"(xq3), "v"(n26_0[3])); asm("v_fmac_f32 %0, %1, %2" : "+v"(pe26) : "v"(xq4), "v"(n26_1[0])); asm("v_fmac_f32 %0, %1, %2" : "+v"(pe26) : "v"(xq5), "v"(n26_1[1])); p += dpp_f(p, 1); xq6 = kq1 ? (xq6 + p) : xq6; asm volatile("" : "+v"(xq6), "+v"(np_) : "v"(n25_0), "v"(n25_1)); }
                { n28_0 = *(const LAS f32x4*)(np_ + 28 * 36); n28_1 = *(const LAS f32x4*)(np_ + 28 * 36 + 4); float p = pe26; asm("v_fmac_f32 %0, %1, %2" : "+v"(p) : "v"(xq6), "v"(n26_1[2])); p += dpp_f(p, 0); pe27 = 0.f; asm("v_fmac_f32 %0, %1, %2" : "+v"(pe27) : "v"(xq0), "v"(n27_0[0])); asm("v_fmac_f32 %0, %1, %2" : "+v"(pe27) : "v"(xq1), "v"(n27_0[1])); asm("v_fmac_f32 %0, %1, %2" : "+v"(pe27) : "v"(xq2), "v"(n27_0[2])); asm("v_fmac_f32 %0, %1, %2" : "+v"(pe27) : "v"(xq3), "v"(n27_0[3])); asm("v_fmac_f32 %0, %1, %2" : "+v"(pe27) : "v"(xq4), "v"(n27_1[0])); asm("v_fmac_f32 %0, %1, %2" : "+v"(pe27) : "v"(xq5), "v"(n27_1[1])); p += dpp_f(p, 1); xq6 = kq2 ? (xq6 + p) : xq6; asm volatile("" : "+v"(xq6), "+v"(np_) : "v"(n26_0), "v"(n26_1)); }
                { n29_0 = *(const LAS f32x4*)(np_ + 29 * 36); n29_1 = *(const LAS f32x4*)(np_ + 29 * 36 + 4); float p = pe27; asm("v_fmac_f32 %0, %1, %2" : "+v"(p) : "v"(xq6), "v"(n27_1[2])); p += dpp_f(p, 0); pe28 = 0.f; asm("v_fmac_f32 %0, %1, %2" : "+v"(pe28) : "v"(xq0), "v"(n28_0[0])); asm("v_fmac_f32 %0, %1, %2" : "+v"(pe28) : "v"(xq1), "v"(n28_0[1])); asm("v_fmac_f32 %0, %1, %2" : "+v"(pe28) : "v"(xq2), "v"(n28_0[2])); asm("v_fmac_f32 %0, %1, %2" : "+v"(pe28) : "v"(xq3), "v"(n28_0[3])); asm("v_fmac_f32 %0, %1, %2" : "+v"(pe28) : "v"(xq4), "v"(n28_1[0])); asm("v_fmac_f32 %0, %1, %2" : "+v"(pe28) : "v"(xq5), "v"(n28_1[1])); p += dpp_f(p, 1); xq6 = kq3 ? (xq6 + p) : xq6; asm volatile("" : "+v"(xq6), "+v"(np_) : "v"(n27_0), "v"(n27_1)); }
                { n30_0 = *(const LAS f32x4*)(np_ + 30 * 36); n30_1 = *(const LAS f32x4*)(np_ + 30 * 36 + 4); float p = pe28; asm("v_fmac_f32 %0, %1, %2" : "+v"(p) : "v"(xq6), "v"(n28_1[2])); p += dpp_f(p, 0); pe29 = 0.f; asm("v_fmac_f32 %0, %1, %2" : "+v"(pe29) : "v"(xq0), "v"(n29_0[0])); asm("v_fmac_f32 %0, %1, %2" : "+v"(pe29) : "v"(xq1), "v"(n29_0[1])); asm("v_fmac_f32 %0, %1, %2" : "+v"(pe29) : "v"(xq2), "v"(n29_0[2])); asm("v_fmac_f32 %0, %1, %2" : "+v"(pe29) : "v"(xq3), "v"(n29_0[3])); asm("v_fmac_f32 %0, %1, %2" : "+v"(pe29) : "v"(xq4), "v"(n29_1[0])); asm("v_fmac_f32 %0, %1, %2" : "+v"(pe29) : "v"(xq5), "v"(n29_1[1])); asm("v_fmac_f32 %0, %1, %2" : "+v"(pe29) : "v"(xq6), "v"(n29_1[2])); p += dpp_f(p, 1); xq7 = kq0 ? (xq7 + p) : xq7; asm volatile("" : "+v"(xq7), "+v"(np_) : "v"(n28_0), "v"(n28_1)); }
                { n31_0 = *(const LAS f32x4*)(np_ + 31 * 36); n31_1 = *(const LAS f32x4*)(np_ + 31 * 36 + 4); float p = pe29; asm("v_fmac_f32 %0, %1, %2" : "+v"(p) : "v"(xq7), "v"(n29_1[3])); p += dpp_f(p, 0); pe30 = 0.f; asm("v_fmac_f32 %0, %1, %2" : "+v"(pe30) : "v"(xq0), "v"(n30_0[0])); asm("v_fmac_f32 %0, %1, %2" : "+v"(pe30) : "v"(xq1), "v"(n30_0[1])); asm("v_fmac_f32 %0, %1, %2" : "+v"(pe30) : "v"(xq2), "v"(n30_0[2])); asm("v_fmac_f32 %0, %1, %2" : "+v"(pe30) : "v"(xq3), "v"(n30_0[3])); asm("v_fmac_f32 %0, %1, %2" : "+v"(pe30) : "v"(xq4), "v"(n30_1[0])); asm("v_fmac_f32 %0, %1, %2" : "+v"(pe30) : "v"(xq5), "v"(n30_1[1])); asm("v_fmac_f32 %0, %1, %2" : "+v"(pe30) : "v"(xq6), "v"(n30_1[2])); p += dpp_f(p, 1); xq7 = kq1 ? (xq7 + p) : xq7; asm volatile("" : "+v"(xq7), "+v"(np_) : "v"(n29_0), "v"(n29_1)); }
                { float p = pe30; asm("v_fmac_f32 %0, %1, %2" : "+v"(p) : "v"(xq7), "v"(n30_1[3])); p += dpp_f(p, 0); pe31 = 0.f; asm("v_fmac_f32 %0, %1, %2" : "+v"(pe31) : "v"(xq0), "v"(n31_0[0])); asm("v_fmac_f32 %0, %1, %2" : "+v"(pe31) : "v"(xq1), "v"(n31_0[1])); asm("v_fmac_f32 %0, %1, %2" : "+v"(pe31) : "v"(xq2), "v"(n31_0[2])); asm("v_fmac_f32 %0, %1, %2" : "+v"(pe31) : "v"(xq3), "v"(n31_0[3])); asm("v_fmac_f32 %0, %1, %2" : "+v"(pe31) : "v"(xq4), "v"(n31_1[0])); asm("v_fmac_f32 %0, %1, %2" : "+v"(pe31) : "v"(xq5), "v"(n31_1[1])); asm("v_fmac_f32 %0, %1, %2" : "+v"(pe31) : "v"(xq6), "v"(n31_1[2])); p += dpp_f(p, 1); xq7 = kq2 ? (xq7 + p) : xq7; asm volatile("" : "+v"(xq7), "+v"(np_) : "v"(n30_0), "v"(n30_1)); }
                { float p = pe31; asm("v_fmac_f32 %0, %1, %2" : "+v"(p) : "v"(xq7), "v"(n31_1[3])); p += dpp_f(p, 0); p += dpp_f(p, 1); xq7 = kq3 ? (xq7 + p) : xq7; asm volatile("" : "+v"(xq7), "+v"(np_) : "v"(n31_0), "v"(n31_1)); }
                LAS bf16_t* dst = isA ? (A2 + rowi * 40 + q) : (NT + rowi * 40 + q);
                dst[0] = bf1(xq0);
                dst[4] = bf1(xq1);
                dst[8] = bf1(xq2);
                dst[12] = bf1(xq3);
                dst[16] = bf1(xq4);
                dst[20] = bf1(xq5);
                dst[24] = bf1(xq6);
                dst[28] = bf1(xq7);
            }
            __syncthreads();
            {
                const int t = lane & 31; f32x16 acc;
#pragma unroll
                for (int i = 0; i < 16; ++i) acc[i] = 0.f;
                if (wave == 0 || wave == 1) {
                    acc = mm32<2>(acc, NT, 40, BTt + 32 * wave * 40, 40, lane); const int k = 32 * wave + t; const float gc = GC[k];
#pragma unroll
                    for (int g4 = 0; g4 < 4; ++g4) { const int s0 = 8 * g4 + 4 * (lane >> 5); float o[4];
#pragma unroll
                        for (int i = 0; i < 4; ++i) o[i] = (acc[4 * g4 + i] + __builtin_bit_cast(float, (unsigned)KT[(s0 + i) * 72 + k] << 16)) * gc;
                        *(LAS u32x2*)(WzT + k * 40 + s0) = (u32x2){cvt_pk_bf16(o[0], o[1]), cvt_pk_bf16(o[2], o[3])}; }
                } else if (wave == 2 || wave == 6) {
                    const int rh = (wave == 6) ? 1 : 0; acc = mm32<2>(acc, A2 + 32 * rh * 40, 40, MbrT, 40, lane);
#pragma unroll
                    for (int g4 = 0; g4 < 4; ++g4) { const int k0 = 32 * rh + 8 * g4 + 4 * (lane >> 5); float o[4]; const u32x2 rv = *(const LAS u32x2*)(RT + t * 72 + k0);
                        o[0] = acc[4 * g4] + bflo(rv.x); o[1] = acc[4 * g4 + 1] + bfhi(rv.x); o[2] = acc[4 * g4 + 2] + bflo(rv.y); o[3] = acc[4 * g4 + 3] + bfhi(rv.y);
                        *(LAS u32x2*)(R2T + t * 72 + k0) = (u32x2){cvt_pk_bf16(o[0], o[1]), cvt_pk_bf16(o[2], o[3])}; }
                } else {
                    if (wave == 3) { accw = mm32<2>(accw, NT, 40, MbrT, 40, lane);
#pragma unroll
                        for (int g4 = 0; g4 < 4; ++g4) { const int s0 = 8 * g4 + 4 * (lane >> 5);
                            *(LAS u32x2*)(WyT + t * 40 + s0) = (u32x2){cvt_pk_bf16(accw[4 * g4], accw[4 * g4 + 1]), cvt_pk_bf16(accw[4 * g4 + 2], accw[4 * g4 + 3])}; } }
                    const int pt = (wave == 3) ? 3 : (wave == 7 ? 2 : wave - 4);
                    const int rh = pt >> 1, ch = pt & 1; acc = mm32<2>(acc, A2 + 32 * rh * 40, 40, BTt + 32 * ch * 40, 40, lane); const int kp = 32 * ch + t; const float gc = GC[kp];
#pragma unroll
                    for (int g4 = 0; g4 < 4; ++g4) { const int k0 = 32 * rh + 8 * g4 + 4 * (lane >> 5);
                        *(LAS u32x2*)(PpT + kp * 72 + k0) = (u32x2){cvt_pk_bf16(acc[4 * g4] * gc, acc[4 * g4 + 1] * gc), cvt_pk_bf16(acc[4 * g4 + 2] * gc, acc[4 * g4 + 3] * gc)}; }
                }
            }
            __syncthreads();
            if (wave < 3) {
                const int t = lane & 31; const LAS bf16_t* Sb = SBF + bi * (32 * 72); f32x16 acc;
#pragma unroll
                for (int i = 0; i < 16; ++i) acc[i] = 0.f;
                if (wave < 2) {
                    acc = mm32<2>(acc, VmT, 40, WzT + 32 * wave * 40, 40, lane);
                    acc = mm32<4>(acc, Sb, 72, PpT + 32 * wave * 72, 72, lane);
                    const float gc = GC[32 * wave + t]; LAS bf16_t* Sn = SBF + (bi ^ 1) * (32 * 72);
#pragma unroll
                    for (int i = 0; i < 16; ++i) { Sacc[i] = fmaf(Sacc[i], gc, acc[i]); Sn[TROW(i, lane) * 72 + 32 * wave + t] = bf1(Sacc[i]); }
                } else {
                    acc = mm32<2>(acc, VmT, 40, WyT, 40, lane);
                    acc = mm32<4>(acc, Sb, 72, R2T, 72, lane);
#pragma unroll
                    for (int i = 0; i < 16; ++i) YST[t * 33 + TROW(i, lane)] = acc[i];
                }
            }
            __syncthreads();
            { const LAS float* ys = YST + pj * 33 + 2 * pq;
                *(f32x2*)(Y + ((size_t)b * SEQ + chunk * 32 + pj) * 512 + h * 64 + 32 * half + 2 * pq) = (f32x2){ys[0], ys[1]}; }
        }
#undef WKV_LOAD
    }
    TSTOP(4);
}


constexpr int STG_R_STRIDE = 10752;
__device__ __forceinline__ unsigned* w5_flag(const Args& a, int idx) { return (unsigned*)(a.ws + WS_CTL + 40960) + idx * 16; }
__device__ __forceinline__ void w5_wait_ge(unsigned* p, unsigned target) {
    unsigned sp = 0; while (__hip_atomic_load(p, __ATOMIC_RELAXED, __HIP_MEMORY_SCOPE_AGENT) < target) { __builtin_amdgcn_s_sleep(2); if (++sp > (1u << 22)) break; } }
__device__ __forceinline__ void w5_signal_add(unsigned* p, unsigned v) {
    asm volatile("s_waitcnt vmcnt(0)" ::: "memory"); __syncthreads();
    if (threadIdx.x == 0) { __builtin_amdgcn_fence(__ATOMIC_RELEASE, "agent"); asm volatile("s_waitcnt vmcnt(0)" ::: "memory"); __hip_atomic_fetch_add(p, v, __ATOMIC_RELAXED, __HIP_MEMORY_SCOPE_AGENT); }
}
__device__ __forceinline__ void w5_signal_add2(unsigned* p, unsigned v, unsigned* p2) {
    asm volatile("s_waitcnt vmcnt(0)" ::: "memory"); __syncthreads();
    if (threadIdx.x == 0) { __builtin_amdgcn_fence(__ATOMIC_RELEASE, "agent"); asm volatile("s_waitcnt vmcnt(0)" ::: "memory"); __hip_atomic_fetch_add(p, v, __ATOMIC_RELAXED, __HIP_MEMORY_SCOPE_AGENT); __hip_atomic_fetch_add(p2, 1u, __ATOMIC_RELAXED, __HIP_MEMORY_SCOPE_AGENT); }
}
__device__ __forceinline__ void w5_acquire_wait(unsigned* p, unsigned target) {
    if (threadIdx.x == 0) { w5_wait_ge(p, target); __builtin_amdgcn_fence(__ATOMIC_ACQUIRE, "agent"); asm volatile("s_waitcnt vmcnt(0)" ::: "memory"); }
    __syncthreads();
}
struct WSet { LAS float* CUM; LAS float* PS; LAS bf16_t* AT; LAS bf16_t* BT; LAS bf16_t* KT; LAS bf16_t* RT; LAS bf16_t* BTt; LAS bf16_t* ATt; LAS float* NabT; LAS bf16_t* Nakb; LAS bf16_t* MbrT; LAS bf16_t* Tb; LAS bf16_t* Ut; LAS bf16_t* Wt;
              LAS bf16_t* WyT; LAS bf16_t* WzT; LAS bf16_t* R2T; LAS bf16_t* PpT; LAS float* GC; };
constexpr int WSET_BYTES = 59136;
__device__ __forceinline__ WSet wset(LAS unsigned char* p) {
    WSet s; s.CUM = (LAS float*)p; s.PS = (LAS float*)(p + 8192); s.WyT = (LAS bf16_t*)p; s.WzT = (LAS bf16_t*)(p + 2560);
    s.AT = (LAS bf16_t*)(p + 10240); s.BT = (LAS bf16_t*)(p + 14848); s.PpT = (LAS bf16_t*)(p + 10240); s.KT = (LAS bf16_t*)(p + 19456); s.RT = (LAS bf16_t*)(p + 24064);
    s.BTt = (LAS bf16_t*)(p + 28672); s.ATt = (LAS bf16_t*)(p + 33792); s.NabT = (LAS float*)(p + 38912); s.R2T = (LAS bf16_t*)(p + 38912); s.Nakb = (LAS bf16_t*)(p + 43520); s.MbrT = (LAS bf16_t*)(p + 46080);
    s.Tb = (LAS bf16_t*)(p + 48640); s.Ut = (LAS bf16_t*)(p + 51200); s.Wt = (LAS bf16_t*)(p + 53760); s.GC = (LAS float*)(p + 58880); return s;
}
struct WRaw { u32x2 rc, rp, kc, kp, e4, a4; };
__device__ __forceinline__ void w5_load(WRaw& w, const bf16_t* COLS, const bf16_t* LORA, int b, int chunk, int pj, int hc) {
    const int s_ = chunk * 32 + pj; const size_t t_ = (size_t)b * SEQ + s_; const bf16_t* cb_ = COLS + t_ * INC + hc; const u32x2 z = (u32x2){0u, 0u};
    w.rc = *(const u32x2*)(cb_ + C_R); w.kc = *(const u32x2*)(cb_ + C_K);
    if (s_ > 0) { w.rp = *(const u32x2*)(cb_ - INC + C_R); w.kp = *(const u32x2*)(cb_ - INC + C_K); } else { w.rp = z; w.kp = z; }
    w.e4 = *(const u32x2*)(LORA + t_ * 1536 + hc); w.a4 = *(const u32x2*)(LORA + t_ * 1536 + 512 + hc);
}
struct WConst { f32x4 mur, muk, kk4, ka4, rk4; };
__device__ __forceinline__ void w5_prep_scale(const WConst& cst, const WRaw& w, const WSet& S, float* BON, int b, int h, int chunk, int pj, int pq, const float (&cm)[4]) {
    float r_[4], rq_[4], k_[4], kq_[4], e_[4], aa_[4], kkn_[4], k2_[4];
    const f32x4 mur = cst.mur, muk = cst.muk, kk4 = cst.kk4, ka4 = cst.ka4, rk4 = cst.rk4;
    unpack4(w.rc, r_); unpack4(w.rp, rq_); unpack4(w.kc, k_); unpack4(w.kp, kq_); unpack4(w.e4, e_); unpack4(w.a4, aa_);
    float ss_ = 0.f, bon_ = 0.f;
#pragma unroll
    for (int i = 0; i < 4; ++i) { r_[i] += (rq_[i] - r_[i]) * mur[i]; k_[i] += (kq_[i] - k_[i]) * muk[i];
        kkn_[i] = k_[i] * kk4[i]; ss_ += kkn_[i] * kkn_[i]; k2_[i] = k_[i] * (1.0f + (aa_[i] - 1.0f) * ka4[i]); bon_ += r_[i] * k2_[i] * rk4[i]; }
    ss_ = row16_sum(ss_); bon_ = row16_sum(bon_); const float inv_ = __builtin_amdgcn_rsqf(fmaxf(ss_, 1e-24f));
    if (pq == 0) BON[((size_t)b * SEQ + chunk * 32 + pj) * 8 + h] = bon_;
    float at_[4], bt_[4], kt_[4], rt_[4], g_[4];
#pragma unroll
    for (int i = 0; i < 4; ++i) { const float kn = kkn_[i] * inv_; const float g = __expf(-cm[i]), ig = __expf(cm[i]), gp = __expf(e_[i] - cm[i]); g_[i] = g;
        at_[i] = -kn * gp; bt_[i] = kn * aa_[i] * ig; kt_[i] = k2_[i] * ig; rt_[i] = r_[i] * g; }
    *(LAS u32x2*)(S.AT + pj * 72 + 4 * pq) = (u32x2){cvt_pk_bf16(at_[0], at_[1]), cvt_pk_bf16(at_[2], at_[3])};
    *(LAS u32x2*)(S.BT + pj * 72 + 4 * pq) = (u32x2){cvt_pk_bf16(bt_[0], bt_[1]), cvt_pk_bf16(bt_[2], bt_[3])};
    *(LAS u32x2*)(S.KT + pj * 72 + 4 * pq) = (u32x2){cvt_pk_bf16(kt_[0], kt_[1]), cvt_pk_bf16(kt_[2], kt_[3])};
    *(LAS u32x2*)(S.RT + pj * 72 + 4 * pq) = (u32x2){cvt_pk_bf16(rt_[0], rt_[1]), cvt_pk_bf16(rt_[2], rt_[3])};
#pragma unroll
    for (int i = 0; i < 4; ++i) { S.BTt[(4 * pq + i) * 40 + pj] = bf1(bt_[i]); S.ATt[(4 * pq + i) * 40 + pj] = bf1(at_[i]); }
    if (pj == 31) *(LAS f32x4*)(S.GC + 4 * pq) = (f32x4){g_[0], g_[1], g_[2], g_[3]};
}
__device__ __forceinline__ void w5_s1(const WSet& S, int tl, f32x16& accw, int lane) {
    f32x16 acc;
#pragma unroll
    for (int i = 0; i < 16; ++i) acc[i] = 0.f;
    const int t = lane & 31, hh = lane >> 5;
    if (tl == 1) {
        acc = mm32<4>(acc, S.AT, 72, S.KT, 72, lane);
#pragma unroll
        for (int g4 = 0; g4 < 4; ++g4) { const int t0 = 8 * g4 + 4 * hh; float o[4];
#pragma unroll
            for (int i = 0; i < 4; ++i) o[i] = (t < t0 + i) ? acc[4 * g4 + i] : 0.f;
            *(LAS u32x2*)(S.Nakb + t * 40 + t0) = (u32x2){cvt_pk_bf16(o[0], o[1]), cvt_pk_bf16(o[2], o[3])}; }
        return;
    }
    acc = mm32<4>(acc, (tl & 1) ? S.KT : S.BT, 72, (tl & 2) ? S.RT : S.AT, 72, lane);
    if (tl == 0) {
#pragma unroll
        for (int g4 = 0; g4 < 4; ++g4) { const int s0 = 8 * g4 + 4 * hh;
#pragma unroll
            for (int i = 0; i < 4; ++i) S.NabT[t * 36 + i * 8 + 2 * g4 + hh] = (s0 + i < t) ? acc[4 * g4 + i] : 0.f; }
    } else if (tl == 2) {
#pragma unroll
        for (int g4 = 0; g4 < 4; ++g4) { const int s0 = 8 * g4 + 4 * hh; float o[4];
#pragma unroll
            for (int i = 0; i < 4; ++i) o[i] = (s0 + i <= t) ? acc[4 * g4 + i] : 0.f;
            *(LAS u32x2*)(S.MbrT + t * 40 + s0) = (u32x2){cvt_pk_bf16(o[0], o[1]), cvt_pk_bf16(o[2], o[3])}; }
    } else {
#pragma unroll
        for (int i = 0; i < 16; ++i) { const int s = TROW(i, lane); accw[i] = (s <= t) ? acc[i] : 0.f; }
    }
}
__device__ __forceinline__ void w5_s2b(const WSet& S, int tl, int lane) {
    f32x16 acc;
#pragma unroll
    for (int i = 0; i < 16; ++i) acc[i] = 0.f;
    const int t = lane & 31, hh = lane >> 5;
    acc = mm32<2>(acc, S.Tb, 40, (tl == 0) ? S.MbrT : (S.BTt + 32 * (tl - 1) * 40), 40, lane);
    LAS bf16_t* o = (tl == 0) ? (S.Ut + t * 40) : (S.Wt + (32 * (tl - 1) + t) * 40);
#pragma unroll
    for (int g4 = 0; g4 < 4; ++g4) { const int s0 = 8 * g4 + 4 * hh;
        *(LAS u32x2*)(o + s0) = (u32x2){cvt_pk_bf16(acc[4 * g4], acc[4 * g4 + 1]), cvt_pk_bf16(acc[4 * g4 + 2], acc[4 * g4 + 3])}; }
}
__device__ __forceinline__ void w5_s3(const WSet& S, int role, f32x16& accw, int lane) {
    const int t = lane & 31, hh = lane >> 5; f32x16 acc;
#pragma unroll
    for (int i = 0; i < 16; ++i) acc[i] = 0.f;
    if (role == 0 || role == 1) {
        acc = mm32<2>(acc, S.Nakb, 40, S.Wt + 32 * role * 40, 40, lane); const int k = 32 * role + t; const float gc = S.GC[k];
#pragma unroll
        for (int g4 = 0; g4 < 4; ++g4) { const int s0 = 8 * g4 + 4 * hh; float o[4];
#pragma unroll
            for (int i = 0; i < 4; ++i) o[i] = (acc[4 * g4 + i] + __builtin_bit_cast(float, (unsigned)S.KT[(s0 + i) * 72 + k] << 16)) * gc;
            *(LAS u32x2*)(S.WzT + k * 40 + s0) = (u32x2){cvt_pk_bf16(o[0], o[1]), cvt_pk_bf16(o[2], o[3])}; }
    } else if (role == 2 || role == 6) {
        const int rh = (role == 6) ? 1 : 0; acc = mm32<2>(acc, S.ATt + 32 * rh * 40, 40, S.Ut, 40, lane);
#pragma unroll
        for (int g4 = 0; g4 < 4; ++g4) { const int k0 = 32 * rh + 8 * g4 + 4 * hh; float o[4]; const u32x2 rv = *(const LAS u32x2*)(S.RT + t * 72 + k0);
            o[0] = acc[4 * g4] + bflo(rv.x); o[1] = acc[4 * g4 + 1] + bfhi(rv.x); o[2] = acc[4 * g4 + 2] + bflo(rv.y); o[3] = acc[4 * g4 + 3] + bfhi(rv.y);
            *(LAS u32x2*)(S.R2T + t * 72 + k0) = (u32x2){cvt_pk_bf16(o[0], o[1]), cvt_pk_bf16(o[2], o[3])}; }
    } else {
        if (role == 3) { accw = mm32<2>(accw, S.Nakb, 40, S.Ut, 40, lane);
#pragma unroll
            for (int g4 = 0; g4 < 4; ++g4) { const int s0 = 8 * g4 + 4 * hh;
                *(LAS u32x2*)(S.WyT + t * 40 + s0) = (u32x2){cvt_pk_bf16(accw[4 * g4], accw[4 * g4 + 1]), cvt_pk_bf16(accw[4 * g4 + 2], accw[4 * g4 + 3])}; } }
        const int pt = (role == 3) ? 3 : (role == 7 ? 2 : role - 4);
        const int rh = pt >> 1, ch = pt & 1; acc = mm32<2>(acc, S.ATt + 32 * rh * 40, 40, S.Wt + 32 * ch * 40, 40, lane); const int kp = 32 * ch + t; const float gc = S.GC[kp];
#pragma unroll
        for (int g4 = 0; g4 < 4; ++g4) { const int k0 = 32 * rh + 8 * g4 + 4 * hh;
            *(LAS u32x2*)(S.PpT + kp * 72 + k0) = (u32x2){cvt_pk_bf16(acc[4 * g4] * gc, acc[4 * g4 + 1] * gc), cvt_pk_bf16(acc[4 * g4 + 2] * gc, acc[4 * g4 + 3] * gc)}; }
    }
}
__device__ __forceinline__ void w5_copyout(const WSet& S, unsigned char* gr, unsigned char* gp, int tid) {
    { const int row = tid >> 3, pc = tid & 7; *(u32x4*)(gp + row * 128 + pc * 16) = *(const LAS u32x4*)((const LAS unsigned char*)S.PpT + row * 144 + pc * 16); }
    if (tid < 256) { const int row = tid >> 3, pc = tid & 7; *(u32x4*)(gr + row * 128 + pc * 16) = *(const LAS u32x4*)((const LAS unsigned char*)S.R2T + row * 144 + pc * 16); }
    else { const int u = tid - 256, row = u >> 2, pc = u & 3; *(u32x4*)(gr + 4096 + row * 64 + pc * 16) = *(const LAS u32x4*)((const LAS unsigned char*)S.WzT + row * 80 + pc * 16); }
    if (tid < 128) { const int row = tid >> 2, pc = tid & 3; *(u32x4*)(gr + 8192 + row * 64 + pc * 16) = *(const LAS u32x4*)((const LAS unsigned char*)S.WyT + row * 80 + pc * 16); }
    else if (tid < 144) { const int pc = tid - 128; *(u32x4*)(gr + 10240 + pc * 16) = *(const LAS u32x4*)((const LAS unsigned char*)S.GC + pc * 16); }
}
__device__ __forceinline__ void wkv5a3(const Args& a, LAS unsigned char* lds, const int bh, const int chunk0, const int npairs, unsigned* cons) {
    const int tid = threadIdx.x, wave = __builtin_amdgcn_readfirstlane(tid >> 6);
    unsigned char* ws = a.ws;
    const bf16_t* COLS = (const bf16_t*)(ws + WS_A); const bf16_t* LORA = (const bf16_t*)a.out; float* BON = (float*)(ws + WS_BON);
    unsigned char* STG_R = ws + WS_RWKV; unsigned char* STG_P = (unsigned char*)a.out + 96 * MiB;
    const WSet SA = wset(lds), SB = wset(lds + WSET_BYTES);
    {
        const int b = bh >> 3, h = bh & 7;
        const int chunk_end = chunk0 + 2 * npairs;
        WRaw wa, wb; WConst cst;
        { const int hc0 = h * 64 + 4 * (tid & 15); cst.mur = *(const f32x4*)(a.in[I_MU] + C_R + hc0); cst.muk = *(const f32x4*)(a.in[I_MU] + C_K + hc0);
          cst.kk4 = *(const f32x4*)(a.in[I_KK] + hc0); cst.ka4 = *(const f32x4*)(a.in[I_KA] + hc0); cst.rk4 = *(const f32x4*)(a.in[I_RK] + hc0); }
        w5_load(wa, COLS, LORA, b, chunk0, tid >> 4, h * 64 + 4 * (tid & 15)); w5_load(wb, COLS, LORA, b, chunk0 + 1, tid >> 4, h * 64 + 4 * (tid & 15));
        __syncthreads();
        for (int chunk = chunk0; chunk < chunk_end; chunk += 2) {
            int tid_l = tid; asm volatile("" : "+v"(tid_l));
            const int lane = tid_l & 63, pj = tid_l >> 4, pq = tid_l & 15, tid = tid_l, hc = h * 64 + 4 * pq; (void)tid;
            float ca[4], cb[4]; unpack4(wa.e4, ca); unpack4(wb.e4, cb);
#pragma unroll
            for (int i = 0; i < 4; ++i) { float ta = __shfl_up(ca[i], 16), tb = __shfl_up(cb[i], 16); if (lane >= 16) { ca[i] += ta; cb[i] += tb; }
                ta = __shfl_up(ca[i], 32); tb = __shfl_up(cb[i], 32); if (lane >= 32) { ca[i] += ta; cb[i] += tb; } }
            if (lane >= 48) { *(LAS f32x4*)(SA.PS + wave * 64 + 4 * pq) = (f32x4){ca[0], ca[1], ca[2], ca[3]}; *(LAS f32x4*)(SB.PS + wave * 64 + 4 * pq) = (f32x4){cb[0], cb[1], cb[2], cb[3]}; }
            __syncthreads();
#pragma unroll
            for (int w2 = 0; w2 < 7; ++w2) { if (w2 < wave) { const f32x4 pa = *(const LAS f32x4*)(SA.PS + w2 * 64 + 4 * pq), pb = *(const LAS f32x4*)(SB.PS + w2 * 64 + 4 * pq);
#pragma unroll
                for (int i = 0; i < 4; ++i) { ca[i] += pa[i]; cb[i] += pb[i]; } } }
            w5_prep_scale(cst, wa, SA, BON, b, h, chunk, pj, pq, ca);
            w5_prep_scale(cst, wb, SB, BON, b, h, chunk + 1, pj, pq, cb);
            if (chunk + 2 < chunk_end) { w5_load(wa, COLS, LORA, b, chunk + 2, pj, hc); w5_load(wb, COLS, LORA, b, chunk + 3, pj, hc); }
            __syncthreads();
            f32x16 accw;
#pragma unroll
            for (int i = 0; i < 16; ++i) accw[i] = 0.f;
            if (wave < 4) w5_s1(SA, wave, accw, lane); else w5_s1(SB, wave - 4, accw, lane);
            __syncthreads();
            if (wave < 4) {
                const WSet& S_ = (wave >= 2) ? SB : SA;
                const int q = lane & 3, rowi = ((wave & 1) * 64 + lane) >> 2;
                float xq0, xq1, xq2, xq3, xq4, xq5, xq6, xq7;
                xq0 = (0 + q == rowi) ? 1.0f : 0.0f;
                xq1 = (4 + q == rowi) ? 1.0f : 0.0f;
                xq2 = (8 + q == rowi) ? 1.0f : 0.0f;
                xq3 = (12 + q == rowi) ? 1.0f : 0.0f;
                xq4 = (16 + q == rowi) ? 1.0f : 0.0f;
                xq5 = (20 + q == rowi) ? 1.0f : 0.0f;
                xq6 = (24 + q == rowi) ? 1.0f : 0.0f;
                xq7 = (28 + q == rowi) ? 1.0f : 0.0f;
                const bool kq0 = q == 0, kq1 = q == 1, kq2 = q == 2, kq3 = q == 3;
                const LAS float* np_ = S_.NabT + q * 8;
                f32x4 n1_0, n2_0, n3_0, n4_0, n5_0, n6_0, n7_0, n8_0, n9_0, n10_0, n11_0, n12_0, n13_0, n14_0, n15_0, n16_0, n17_0, n17_1, n18_0, n18_1, n19_0, n19_1, n20_0, n20_1, n21_0, n21_1, n22_0, n22_1, n23_0, n23_1, n24_0, n24_1, n25_0, n25_1, n26_0, n26_1, n27_0, n27_1, n28_0, n28_1, n29_0, n29_1, n30_0, n30_1, n31_0, n31_1;
                float pe1, pe2, pe3, pe4, pe5, pe6, pe7, pe8, pe9, pe10, pe11, pe12, pe13, pe14, pe15, pe16, pe17, pe18, pe19, pe20, pe21, pe22, pe23, pe24, pe25, pe26, pe27, pe28, pe29, pe30, pe31, pe32;
                n1_0 = *(const LAS f32x4*)(np_ + 1 * 36); n2_0 = *(const LAS f32x4*)(np_ + 2 * 36); pe1 = 0.f;
                { n3_0 = *(const LAS f32x4*)(np_ + 3 * 36); float p = pe1; asm("v_fmac_f32 %0, %1, %2" : "+v"(p) : "v"(xq0), "v"(n1_0[0])); p += dpp_f(p, 0); pe2 = 0.f; p += dpp_f(p, 1); xq0 = kq1 ? (xq0 + p) : xq0; asm volatile("" : "+v"(xq0), "+v"(np_) : "v"(n1_0)); }
                { n4_0 = *(const LAS f32x4*)(np_ + 4 * 36); float p = pe2; asm("v_fmac_f32 %0, %1, %2" : "+v"(p) : "v"(xq0), "v"(n2_0[0])); p += dpp_f(p, 0); pe3 = 0.f; p += dpp_f(p, 1); xq0 = kq2 ? (xq0 + p) : xq0; asm volatile("" : "+v"(xq0), "+v"(np_) : "v"(n2_0)); }
                { n5_0 = *(const LAS f32x4*)(np_ + 5 * 36); float p = pe3; asm("v_fmac_f32 %0, %1, %2" : "+v"(p) : "v"(xq0), "v"(n3_0[0])); p += dpp_f(p, 0); pe4 = 0.f; p += dpp_f(p, 1); xq0 = kq3 ? (xq0 + p) : xq0; asm volatile("" : "+v"(xq0), "+v"(np_) : "v"(n3_0)); }
                { n6_0 = *(const LAS f32x4*)(np_ + 6 * 36); float p = pe4; asm("v_fmac_f32 %0, %1, %2" : "+v"(p) : "v"(xq0), "v"(n4_0[0])); p += dpp_f(p, 0); pe5 = 0.f; asm("v_fmac_f32 %0, %1, %2" : "+v"(pe5) : "v"(xq0), "v"(n5_0[0])); p += dpp_f(p, 1); xq1 = kq0 ? (xq1 + p) : xq1; asm volatile("" : "+v"(xq1), "+v"(np_) : "v"(n4_0)); }
                { n7_0 = *(const LAS f32x4*)(np_ + 7 * 36); float p = pe5; asm("v_fmac_f32 %0, %1, %2" : "+v"(p) : "v"(xq1), "v"(n5_0[1])); p += dpp_f(p, 0); pe6 = 0.f; asm("v_fmac_f32 %0, %1, %2" : "+v"(pe6) : "v"(xq0), "v"(n6_0[0])); p += dpp_f(p, 1); xq1 = kq1 ? (xq1 + p) : xq1; asm volatile("" : "+v"(xq1), "+v"(np_) : "v"(n5_0)); }
                { n8_0 = *(const LAS f32x4*)(np_ + 8 * 36); float p = pe6; asm("v_fmac_f32 %0, %1, %2" : "+v"(p) : "v"(xq1), "v"(n6_0[1])); p += dpp_f(p, 0); pe7 = 0.f; asm("v_fmac_f32 %0, %1, %2" : "+v"(pe7) : "v"(xq0), "v"(n7_0[0])); p += dpp_f(p, 1); xq1 = kq2 ? (xq1 + p) : xq1; asm volatile("" : "+v"(xq1), "+v"(np_) : "v"(n6_0)); }
                { n9_0 = *(const LAS f32x4*)(np_ + 9 * 36); float p = pe7; asm("v_fmac_f32 %0, %1, %2" : "+v"(p) : "v"(xq1), "v"(n7_0[1])); p += dpp_f(p, 0); pe8 = 0.f; asm("v_fmac_f32 %0, %1, %2" : "+v"(pe8) : "v"(xq0), "v"(n8_0[0])); p += dpp_f(p, 1); xq1 = kq3 ? (xq1 + p) : xq1; asm volatile("" : "+v"(xq1), "+v"(np_) : "v"(n7_0)); }
                { n10_0 = *(const LAS f32x4*)(np_ + 10 * 36); float p = pe8; asm("v_fmac_f32 %0, %1, %2" : "+v"(p) : "v"(xq1), "v"(n8_0[1])); p += dpp_f(p, 0); pe9 = 0.f; asm("v_fmac_f32 %0, %1, %2" : "+v"(pe9) : "v"(xq0), "v"(n9_0[0])); asm("v_fmac_f32 %0, %1, %2" : "+v"(pe9) : "v"(xq1), "v"(n9_0[1])); p += dpp_f(p, 1); xq2 = kq0 ? (xq2 + p) : xq2; asm volatile("" : "+v"(xq2), "+v"(np_) : "v"(n8_0)); }
                { n11_0 = *(const LAS f32x4*)(np_ + 11 * 36); float p = pe9; asm("v_fmac_f32 %0, %1, %2" : "+v"(p) : "v"(xq2), "v"(n9_0[2])); p += dpp_f(p, 0); pe10 = 0.f; asm("v_fmac_f32 %0, %1, %2" : "+v"(pe10) : "v"(xq0), "v"(n10_0[0])); asm("v_fmac_f32 %0, %1, %2" : "+v"(pe10) : "v"(xq1), "v"(n10_0[1])); p += dpp_f(p, 1); xq2 = kq1 ? (xq2 + p) : xq2; asm volatile("" : "+v"(xq2), "+v"(np_) : "v"(n9_0)); }
                { n12_0 = *(const LAS f32x4*)(np_ + 12 * 36); float p = pe10; asm("v_fmac_f32 %0, %1, %2" : "+v"(p) : "v"(xq2), "v"(n10_0[2])); p += dpp_f(p, 0); pe11 = 0.f; asm("v_fmac_f32 %0, %1, %2" : "+v"(pe11) : "v"(xq0), "v"(n11_0[0])); asm("v_fmac_f32 %0, %1, %2" : "+v"(pe11) : "v"(xq1), "v"(n11_0[1])); p += dpp_f(p, 1); xq2 = kq2 ? (xq2 + p) : xq2; asm volatile("" : "+v"(xq2), "+v"(np_) : "v"(n10_0)); }
                { n13_0 = *(const LAS f32x4*)(np_ + 13 * 36); float p = pe11; asm("v_fmac_f32 %0, %1, %2" : "+v"(p) : "v"(xq2), "v"(n11_0[2])); p += dpp_f(p, 0); pe12 = 0.f; asm("v_fmac_f32 %0, %1, %2" : "+v"(pe12) : "v"(xq0), "v"(n12_0[0])); asm("v_fmac_f32 %0, %1, %2" : "+v"(pe12) : "v"(xq1), "v"(n12_0[1])); p += dpp_f(p, 1); xq2 = kq3 ? (xq2 + p) : xq2; asm volatile("" : "+v"(xq2), "+v"(np_) : "v"(n11_0)); }
                { n14_0 = *(const LAS f32x4*)(np_ + 14 * 36); float p = pe12; asm("v_fmac_f32 %0, %1, %2" : "+v"(p) : "v"(xq2), "v"(n12_0[2])); p += dpp_f(p, 0); pe13 = 0.f; asm("v_fmac_f32 %0, %1, %2" : "+v"(pe13) : "v"(xq0), "v"(n13_0[0])); asm("v_fmac_f32 %0, %1, %2" : "+v"(pe13) : "v"(xq1), "v"(n13_0[1])); asm("v_fmac_f32 %0, %1, %2" : "+v"(pe13) : "v"(xq2), "v"(n13_0[2])); p += dpp_f(p, 1); xq3 = kq0 ? (xq3 + p) : xq3; asm volatile("" : "+v"(xq3), "+v"(np_) : "v"(n12_0)); }
                { n15_0 = *(const LAS f32x4*)(np_ + 15 * 36); float p = pe13; asm("v_fmac_f32 %0, %1, %2" : "+v"(p) : "v"(xq3), "v"(n13_0[3])); p += dpp_f(p, 0); pe14 = 0.f; asm("v_fmac_f32 %0, %1, %2" : "+v"(pe14) : "v"(xq0), "v"(n14_0[0])); asm("v_fmac_f32 %0, %1, %2" : "+v"(pe14) : "v"(xq1), "v"(n14_0[1])); asm("v_fmac_f32 %0, %1, %2" : "+v"(pe14) : "v"(xq2), "v"(n14_0[2])); p += dpp_f(p, 1); xq3 = kq1 ? (xq3 + p) : xq3; asm volatile("" : "+v"(xq3), "+v"(np_) : "v"(n13_0)); }
                { n16_0 = *(const LAS f32x4*)(np_ + 16 * 36); float p = pe14; asm("v_fmac_f32 %0, %1, %2" : "+v"(p) : "v"(xq3), "v"(n14_0[3])); p += dpp_f(p, 0); pe15 = 0.f; asm("v_fmac_f32 %0, %1, %2" : "+v"(pe15) : "v"(xq0), "v"(n15_0[0])); asm("v_fmac_f32 %0, %1, %2" : "+v"(pe15) : "v"(xq1), "v"(n15_0[1])); asm("v_fmac_f32 %0, %1, %2" : "+v"(pe15) : "v"(xq2), "v"(n15_0[2])); p += dpp_f(p, 1); xq3 = kq2 ? (xq3 + p) : xq3; asm volatile("" : "+v"(xq3), "+v"(np_) : "v"(n14_0)); }
                { n17_0 = *(const LAS f32x4*)(np_ + 17 * 36); n17_1 = *(const LAS f32x4*)(np_ + 17 * 36 + 4); float p = pe15; asm("v_fmac_f32 %0, %1, %2" : "+v"(p) : "v"(xq3), "v"(n15_0[3])); p += dpp_f(p, 0); pe16 = 0.f; asm("v_fmac_f32 %0, %1, %2" : "+v"(pe16) : "v"(xq0), "v"(n16_0[0])); asm("v_fmac_f32 %0, %1, %2" : "+v"(pe16) : "v"(xq1), "v"(n16_0[1])); asm("v_fmac_f32 %0, %1, %2" : "+v"(pe16) : "v"(xq2), "v"(n16_0[2])); p += dpp_f(p, 1); xq3 = kq3 ? (xq3 + p) : xq3; asm volatile("" : "+v"(xq3), "+v"(np_) : "v"(n15_0)); }
                { n18_0 = *(const LAS f32x4*)(np_ + 18 * 36); n18_1 = *(const LAS f32x4*)(np_ + 18 * 36 + 4); float p = pe16; asm("v_fmac_f32 %0, %1, %2" : "+v"(p) : "v"(xq3), "v"(n16_0[3])); p += dpp_f(p, 0); pe17 = 0.f; asm("v_fmac_f32 %0, %1, %2" : "+v"(pe17) : "v"(xq0), "v"(n17_0[0])); asm("v_fmac_f32 %0, %1, %2" : "+v"(pe17) : "v"(xq1), "v"(n17_0[1])); asm("v_fmac_f32 %0, %1, %2" : "+v"(pe17) : "v"(xq2), "v"(n17_0[2])); asm("v_fmac_f32 %0, %1, %2" : "+v"(pe17) : "v"(xq3), "v"(n17_0[3])); p += dpp_f(p, 1); xq4 = kq0 ? (xq4 + p) : xq4; asm volatile("" : "+v"(xq4), "+v"(np_) : "v"(n16_0)); }
                { n19_0 = *(const LAS f32x4*)(np_ + 19 * 36); n19_1 = *(const LAS f32x4*)(np_ + 19 * 36 + 4); float p = pe17; asm("v_fmac_f32 %0, %1, %2" : "+v"(p) : "v"(xq4), "v"(n17_1[0])); p += dpp_f(p, 0); pe18 = 0.f; asm("v_fmac_f32 %0, %1, %2" : "+v"(pe18) : "v"(xq0), "v"(n18_0[0])); asm("v_fmac_f32 %0, %1, %2" : "+v"(pe18) : "v"(xq1), "v"(n18_0[1])); asm("v_fmac_f32 %0, %1, %2" : "+v"(pe18) : "v"(xq2), "v"(n18_0[2])); asm("v_fmac_f32 %0, %1, %2" : "+v"(pe18) : "v"(xq3), "v"(n18_0[3])); p += dpp_f(p, 1); xq4 = kq1 ? (xq4 + p) : xq4; asm volatile("" : "+v"(xq4), "+v"(np_) : "v"(n17_0), "v"(n17_1)); }
                { n20_0 = *(const LAS f32x4*)(np_ + 20 * 36); n20_1 = *(const LAS f32x4*)(np_ + 20 * 36 + 4); float p = pe18; asm("v_fmac_f32 %0, %1, %2" : "+v"(p) : "v"(xq4), "v"(n18_1[0])); p += dpp_f(p, 0); pe19 = 0.f; asm("v_fmac_f32 %0, %1, %2" : "+v"(pe19) : "v"(xq0), "v"(n19_0[0])); asm("v_fmac_f32 %0, %1, %2" : "+v"(pe19) : "v"(xq1), "v"(n19_0[1])); asm("v_fmac_f32 %0, %1, %2" : "+v"(pe19) : "v"(xq2), "v"(n19_0[2])); asm("v_fmac_f32 %0, %1, %2" : "+v"(pe19) : "v"(xq3), "v"(n19_0[3])); p += dpp_f(p, 1); xq4 = kq2 ? (xq4 + p) : xq4; asm volatile("" : "+v"(xq4), "+v"(np_) : "v"(n18_0), "v"(n18_1)); }
                { n21_0 = *(const LAS f32x4*)(np_ + 21 * 36); n21_1 = *(const LAS f32x4*)(np_ + 21 * 36 + 4); float p = pe19; asm("v_fmac_f32 %0, %1, %2" : "+v"(p) : "v"(xq4), "v"(n19_1[0])); p += dpp_f(p, 0); pe20 = 0.f; asm("v_fmac_f32 %0, %1, %2" : "+v"(pe20) : "v"(xq0), "v"(n20_0[0])); asm("v_fmac_f32 %0, %1, %2" : "+v"(pe20) : "v"(xq1), "v"(n20_0[1])); asm("v_fmac_f32 %0, %1, %2" : "+v"(pe20) : "v"(xq2), "v"(n20_0[2])); asm("v_fmac_f32 %0, %1, %2" : "+v"(pe20) : "v"(xq3), "v"(n20_0[3])); p += dpp_f(p, 1); xq4 = kq3 ? (xq4 + p) : xq4; asm volatile("" : "+v"(xq4), "+v"(np_) : "v"(n19_0), "v"(n19_1)); }
                { n22_0 = *(const LAS f32x4*)(np_ + 22 * 36); n22_1 = *(const LAS f32x4*)(np_ + 22 * 36 + 4); float p = pe20; asm("v_fmac_f32 %0, %1, %2" : "+v"(p) : "v"(xq4), "v"(n20_1[0])); p += dpp_f(p, 0); pe21 = 0.f; asm("v_fmac_f32 %0, %1, %2" : "+v"(pe21) : "v"(xq0), "v"(n21_0[0])); asm("v_fmac_f32 %0, %1, %2" : "+v"(pe21) : "v"(xq1), "v"(n21_0[1])); asm("v_fmac_f32 %0, %1, %2" : "+v"(pe21) : "v"(xq2), "v"(n21_0[2])); asm("v_fmac_f32 %0, %1, %2" : "+v"(pe21) : "v"(xq3), "v"(n21_0[3])); asm("v_fmac_f32 %0, %1, %2" : "+v"(pe21) : "v"(xq4), "v"(n21_1[0])); p += dpp_f(p, 1); xq5 = kq0 ? (xq5 + p) : xq5; asm volatile("" : "+v"(xq5), "+v"(np_) : "v"(n20_0), "v"(n20_1)); }
                { n23_0 = *(const LAS f32x4*)(np_ + 23 * 36); n23_1 = *(const LAS f32x4*)(np_ + 23 * 36 + 4); float p = pe21; asm("v_fmac_f32 %0, %1, %2" : "+v"(p) : "v"(xq5), "v"(n21_1[1])); p += dpp_f(p, 0); pe22 = 0.f; asm("v_fmac_f32 %0, %1, %2" : "+v"(pe22) : "v"(xq0), "v"(n22_0[0])); asm("v_fmac_f32 %0, %1, %2" : "+v"(pe22) : "v"(xq1), "v"(n22_0[1])); asm("v_fmac_f32 %0, %1, %2" : "+v"(pe22) : "v"(xq2), "v"(n22_0[2])); asm("v_fmac_f32 %0, %1, %2" : "+v"(pe22) : "v"(xq3), "v"(n22_0[3])); asm("v_fmac_f32 %0, %1, %2" : "+v"(pe22) : "v"(xq4), "v"(n22_1[0])); p += dpp_f(p, 1); xq5 = kq1 ? (xq5 + p) : xq5; asm volatile("" : "+v"(xq5), "+v"(np_) : "v"(n21_0), "v"(n21_1)); }
                { n24_0 = *(const LAS f32x4*)(np_ + 24 * 36); n24_1 = *(const LAS f32x4*)(np_ + 24 * 36 + 4); float p = pe22; asm("v_fmac_f32 %0, %1, %2" : "+v"(p) : "v"(xq5), "v"(n22_1[1])); p += dpp_f(p, 0); pe23 = 0.f; asm("v_fmac_f32 %0, %1, %2" : "+v"(pe23) : "v"(xq0), "v"(n23_0[0])); asm("v_fmac_f32 %0, %1, %2" : "+v"(pe23) : "v"(xq1), "v"(n23_0[1])); asm("v_fmac_f32 %0, %1, %2" : "+v"(pe23) : "v"(xq2), "v"(n23_0[2])); asm("v_fmac_f32 %0, %1, %2" : "+v"(pe23) : "v"(xq3), "v"(n23_0[3])); asm("v_fmac_f32 %0, %1, %2" : "+v"(pe23) : "v"(xq4), "v"(n23_1[0])); p += dpp_f(p, 1); xq5 = kq2 ? (xq5 + p) : xq5; asm volatile("" : "+v"(xq5), "+v"(np_) : "v"(n22_0), "v"(n22_1)); }
                { n25_0 = *(const LAS f32x4*)(np_ + 25 * 36); n25_1 = *(const LAS f32x4*)(np_ + 25 * 36 + 4); float p = pe23; asm("v_fmac_f32 %0, %1, %2" : "+v"(p) : "v"(xq5), "v"(n23_1[1])); p += dpp_f(p, 0); pe24 = 0.f; asm("v_fmac_f32 %0, %1, %2" : "+v"(pe24) : "v"(xq0), "v"(n24_0[0])); asm("v_fmac_f32 %0, %1, %2" : "+v"(pe24) : "v"(xq1), "v"(n24_0[1])); asm("v_fmac_f32 %0, %1, %2" : "+v"(pe24) : "v"(xq2), "v"(n24_0[2])); asm("v_fmac_f32 %0, %1, %2" : "+v"(pe24) : "v"(xq3), "v"(n24_0[3])); asm("v_fmac_f32 %0, %1, %2" : "+v"(pe24) : "v"(xq4), "v"(n24_1[0])); p += dpp_f(p, 1); xq5 = kq3 ? (xq5 + p) : xq5; asm volatile("" : "+v"(xq5), "+v"(np_) : "v"(n23_0), "v"(n23_1)); }
                { n26_0 = *(const LAS f32x4*)(np_ + 26 * 36); n26_1 = *(const LAS f32x4*)(np_ + 26 * 36 + 4); float p = pe24; asm("v_fmac_f32 %0, %1, %2" : "+v"(p) : "v"(xq5), "v"(n24_1[1])); p += dpp_f(p, 0); pe25 = 0.f; asm("v_fmac_f32 %0, %1, %2" : "+v"(pe25) : "v"(xq0), "v"(n25_0[0])); asm("v_fmac_f32 %0, %1, %2" : "+v"(pe25) : "v"(xq1), "v"(n25_0[1])); asm("v_fmac_f32 %0, %1, %2" : "+v"(pe25) : "v"(xq2), "v"(n25_0[2])); asm("v_fmac_f32 %0, %1, %2" : "+v"(pe25) : "v"(xq3), "v"(n25_0[3])); asm("v_fmac_f32 %0, %1, %2" : "+v"(pe25) : "v"(xq4), "v"(n25_1[0])); asm("v_fmac_f32 %0, %1, %2" : "+v"(pe25) : "v"(xq5), "v"(n25_1[1])); p += dpp_f(p, 1); xq6 = kq0 ? (xq6 + p) : xq6; asm volatile("" : "+v"(xq6), "+v"(np_) : "v"(n24_0), "v"(n24_1)); }
                { n27_0 = *(const LAS f32x4*)(np_ + 27 * 36); n27_1 = *(const LAS f32x4*)(np_ + 27 * 36 + 4); float p = pe25; asm("v_fmac_f32 %0, %1, %2" : "+v"(p) : "v"(xq6), "v"(n25_1[2])); p += dpp_f(p, 0); pe26 = 0.f; asm("v_fmac_f32 %0, %1, %2" : "+v"(pe26) : "v"(xq0), "v"(n26_0[0])); asm("v_fmac_f32 %0, %1, %2" : "+v"(pe26) : "v"(xq1), "v"(n26_0[1])); asm("v_fmac_f32 %0, %1, %2" : "+v"(pe26) : "v"(xq2), "v"(n26_0[2])); asm("v_fmac_f32 %0, %1, %2" : "+v"(pe26) : "v"(xq3), "v"(n26_0[3])); asm("v_fmac_f32 %0, %1, %2" : "+v"(pe26) : "v"(xq4), "v"(n26_1[0])); asm("v_fmac_f32 %0, %1, %2" : "+v"(pe26) : "v"(xq5), "v"(n26_1[1])); p += dpp_f(p, 1); xq6 = kq1 ? (xq6 + p) : xq6; asm volatile("" : "+v"(xq6), "+v"(np_) : "v"(n25_0), "v"(n25_1)); }
                { n28_0 = *(const LAS f32x4*)(np_ + 28 * 36); n28_1 = *(const LAS f32x4*)(np_ + 28 * 36 + 4); float p = pe26; asm("v_fmac_f32 %0, %1, %2" : "+v"(p) : "v"(xq6), "v"(n26_1[2])); p += dpp_f(p, 0); pe27 = 0.f; asm("v_fmac_f32 %0, %1, %2" : "+v"(pe27) : "v"(xq0), "v"(n27_0[0])); asm("v_fmac_f32 %0, %1, %2" : "+v"(pe27) : "v"(xq1), "v"(n27_0[1])); asm("v_fmac_f32 %0, %1, %2" : "+v"(pe27) : "v"(xq2), "v"(n27_0[2])); asm("v_fmac_f32 %0, %1, %2" : "+v"(pe27) : "v"(xq3), "v"(n27_0[3])); asm("v_fmac_f32 %0, %1, %2" : "+v"(pe27) : "v"(xq4), "v"(n27_1[0])); asm("v_fmac_f32 %0, %1, %2" : "+v"(pe27) : "v"(xq5), "v"(n27_1[1])); p += dpp_f(p, 1); xq6 = kq2 ? (xq6 + p) : xq6; asm volatile("" : "+v"(xq6), "+v"(np_) : "v"(n26_0), "v"(n26_1)); }
                { n29_0 = *(const LAS f32x4*)(np_ + 29 * 36); n29_1 = *(const LAS f32x4*)(np_ + 29 * 36 + 4); float p = pe27; asm("v_fmac_f32 %0, %1, %2" : "+v"(p) : "v"(xq6), "v"(n27_1[2])); p += dpp_f(p, 0); pe28 = 0.f; asm("v_fmac_f32 %0, %1, %2" : "+v"(pe28) : "v"(xq0), "v"(n28_0[0])); asm("v_fmac_f32 %0, %1, %2" : "+v"(pe28) : "v"(xq1), "v"(n28_0[1])); asm("v_fmac_f32 %0, %1, %2" : "+v"(pe28) : "v"(xq2), "v"(n28_0[2])); asm("v_fmac_f32 %0, %1, %2" : "+v"(pe28) : "v"(xq3), "v"(n28_0[3])); asm("v_fmac_f32 %0, %1, %2" : "+v"(pe28) : "v"(xq4), "v"(n28_1[0])); asm("v_fmac_f32 %0, %1, %2" : "+v"(pe28) : "v"(xq5), "v"(n28_1[1])); p += dpp_f(p, 1); xq6 = kq3 ? (xq6 + p) : xq6; asm volatile("" : "+v"(xq6), "+v"(np_) : "v"(n27_0), "v"(n27_1)); }
                { n30_0 = *(const LAS f32x4*)(np_ + 30 * 36); n30_1 = *(const LAS f32x4*)(np_ + 30 * 36 + 4); float p = pe28; asm("v_fmac_f32 %0, %1, %2" : "+v"(p) : "v"(xq6), "v"(n28_1[2])); p += dpp_f(p, 0); pe29 = 0.f; asm("v_fmac_f32 %0, %1, %2" : "+v"(pe29) : "v"(xq0), "v"(n29_0[0])); asm("v_fmac_f32 %0, %1, %2" : "+v"(pe29) : "v"(xq1), "v"(n29_0[1])); asm("v_fmac_f32 %0, %1, %2" : "+v"(pe29) : "v"(xq2), "v"(n29_0[2])); asm("v_fmac_f32 %0, %1, %2" : "+v"(pe29) : "v"(xq3), "v"(n29_0[3])); asm("v_fmac_f32 %0, %1, %2" : "+v"(pe29) : "v"(xq4), "v"(n29_1[0])); asm("v_fmac_f32 %0, %1, %2" : "+v"(pe29) : "v"(xq5), "v"(n29_1[1])); asm("v_fmac_f32 %0, %1, %2" : "+v"(pe29) : "v"(xq6), "v"(n29_1[2])); p += dpp_f(p, 1); xq7 = kq0 ? (xq7 + p) : xq7; asm volatile("" : "+v"(xq7), "+v"(np_) : "v"(n28_0), "v"(n28_1)); }
                { n31_0 = *(const LAS f32x4*)(np_ + 31 * 36); n31_1 = *(const LAS f32x4*)(np_ + 31 * 36 + 4); float p = pe29; asm("v_fmac_f32 %0, %1, %2" : "+v"(p) : "v"(xq7), "v"(n29_1[3])); p += dpp_f(p, 0); pe30 = 0.f; asm("v_fmac_f32 %0, %1, %2" : "+v"(pe30) : "v"(xq0), "v"(n30_0[0])); asm("v_fmac_f32 %0, %1, %2" : "+v"(pe30) : "v"(xq1), "v"(n30_0[1])); asm("v_fmac_f32 %0, %1, %2" : "+v"(pe30) : "v"(xq2), "v"(n30_0[2])); asm("v_fmac_f32 %0, %1, %2" : "+v"(pe30) : "v"(xq3), "v"(n30_0[3])); asm("v_fmac_f32 %0, %1, %2" : "+v"(pe30) : "v"(xq4), "v"(n30_1[0])); asm("v_fmac_f32 %0, %1, %2" : "+v"(pe30) : "v"(xq5), "v"(n30_1[1])); asm("v_fmac_f32 %0, %1, %2" : "+v"(pe30) : "v"(xq6), "v"(n30_1[2])); p += dpp_f(p, 1); xq7 = kq1 ? (xq7 + p) : xq7; asm volatile("" : "+v"(xq7), "+v"(np_) : "v"(n29_0), "v"(n29_1)); }
                { float p = pe30; asm("v_fmac_f32 %0, %1, %2" : "+v"(p) : "v"(xq7), "v"(n30_1[3])); p += dpp_f(p, 0); pe31 = 0.f; asm("v_fmac_f32 %0, %1, %2" : "+v"(pe31) : "v"(xq0), "v"(n31_0[0])); asm("v_fmac_f32 %0, %1, %2" : "+v"(pe31) : "v"(xq1), "v"(n31_0[1])); asm("v_fmac_f32 %0, %1, %2" : "+v"(pe31) : "v"(xq2), "v"(n31_0[2])); asm("v_fmac_f32 %0, %1, %2" : "+v"(pe31) : "v"(xq3), "v"(n31_0[3])); asm("v_fmac_f32 %0, %1, %2" : "+v"(pe31) : "v"(xq4), "v"(n31_1[0])); asm("v_fmac_f32 %0, %1, %2" : "+v"(pe31) : "v"(xq5), "v"(n31_1[1])); asm("v_fmac_f32 %0, %1, %2" : "+v"(pe31) : "v"(xq6), "v"(n31_1[2])); p += dpp_f(p, 1); xq7 = kq2 ? (xq7 + p) : xq7; asm volatile("" : "+v"(xq7), "+v"(np_) : "v"(n30_0), "v"(n30_1)); }
                { float p = pe31; asm("v_fmac_f32 %0, %1, %2" : "+v"(p) : "v"(xq7), "v"(n31_1[3])); p += dpp_f(p, 0); p += dpp_f(p, 1); xq7 = kq3 ? (xq7 + p) : xq7; asm volatile("" : "+v"(xq7), "+v"(np_) : "v"(n31_0), "v"(n31_1)); }
                LAS bf16_t* dst = S_.Tb + rowi * 40 + q;
                dst[0] = bf1(xq0);
                dst[4] = bf1(xq1);
                dst[8] = bf1(xq2);
                dst[12] = bf1(xq3);
                dst[16] = bf1(xq4);
                dst[20] = bf1(xq5);
                dst[24] = bf1(xq6);
                dst[28] = bf1(xq7);
            }
            __syncthreads();
            if (wave < 6) { if (wave < 3) w5_s2b(SA, wave, lane); else w5_s2b(SB, wave - 3, lane); }
            __syncthreads();
            w5_s3(SA, wave, accw, lane);
            w5_s3(SB, (wave + 4) & 7, accw, lane);
            if (cons != nullptr && tid == 0) w5_wait_ge(cons, (unsigned)((chunk & 31) + 2));
            __syncthreads();
            { const size_t idx = (size_t)bh * 32 + (chunk & 31);
              w5_copyout(SA, STG_R + idx * STG_R_STRIDE, STG_P + idx * 8192, tid);
              w5_copyout(SB, STG_R + (idx + 1) * STG_R_STRIDE, STG_P + (idx + 1) * 8192, tid); }
            __syncthreads();
        }
    }
}

__device__ __forceinline__ void wkv5a2(const Args& a, LAS unsigned char* lds, const int round) {
    for (int item = blockIdx.x; item < 256; item += gridDim.x) wkv5a3(a, lds, item >> 1, 32 * round + 16 * (item & 1), 8, nullptr);
}
__device__ __forceinline__ void wkv5b(const Args& a, LAS unsigned char* lds, const int round) {
    const int tid = threadIdx.x, lane = tid & 63, wave = __builtin_amdgcn_readfirstlane(tid >> 6);
    unsigned char* ws = a.ws;
    const bf16_t* COLS = (const bf16_t*)(ws + WS_A); float* Y = (float*)(ws + WS_B);
    const unsigned char* STG_R = ws + WS_RWKV; const unsigned char* STG_P = (const unsigned char*)a.out + 96 * MiB;
    constexpr int SET = 24576;
    LAS bf16_t* SBF = (LAS bf16_t*)(lds + 118272);
    LAS float* YST = (LAS float*)(lds + 127488);
    LAS float* SSAVE = (LAS float*)(lds + 135936);
    for (int item = blockIdx.x; item < 256; item += gridDim.x) {
        const int bh = item >> 1, half = item & 1, b = bh >> 3, h = bh & 7;
        const int pj = tid >> 4, pq = tid & 15;
        f32x16 Sacc;
#pragma unroll
        for (int i = 0; i < 16; ++i) Sacc[i] = 0.f;
        __syncthreads();
        if (round == 0) { for (int i = tid; i < 2 * 32 * 72 / 2; i += 512) ((LAS unsigned*)SBF)[i] = 0u; }
        else if (wave < 2) {
#pragma unroll
            for (int i = 0; i < 16; ++i) Sacc[i] = SSAVE[(wave * 16 + i) * 64 + lane]; }
        const f32x2 muv = *(const f32x2*)(a.in[I_MU] + C_V + h * 64 + 32 * half + 2 * pq);
        u32x4 gP, gA, gB; unsigned vcur, vprv;
#define W5_LOAD(chunk) do { const size_t idx_ = (size_t)bh * 32 + ((chunk) & 31); const unsigned char* gr_ = STG_R + idx_ * STG_R_STRIDE; const unsigned char* gp_ = STG_P + idx_ * 8192; \
            gP = *(const u32x4*)(gp_ + (tid >> 3) * 128 + (tid & 7) * 16); \
            gA = (tid < 256) ? *(const u32x4*)(gr_ + (tid >> 3) * 128 + (tid & 7) * 16) : *(const u32x4*)(gr_ + 4096 + ((tid - 256) >> 2) * 64 + ((tid - 256) & 3) * 16); \
            gB = (tid < 144) ? *(const u32x4*)(gr_ + 8192 + tid * 16) : (u32x4){0u, 0u, 0u, 0u}; \
            { const int s_ = (chunk) * 32 + pj; const bf16_t* cb_ = COLS + ((size_t)b * SEQ + s_) * INC + C_V + h * 64 + 32 * half + 2 * pq; vcur = *(const unsigned*)cb_; vprv = (s_ > 0) ? *(const unsigned*)(cb_ - INC) : 0u; } } while (0)
#define W5_STORE(setb) do { LAS unsigned char* sb_ = lds + 10240 + (setb) * SET; \
            *(LAS u32x4*)(sb_ + 12288 + (tid >> 3) * 144 + (tid & 7) * 16) = gP; \
            if (tid < 256) *(LAS u32x4*)(sb_ + 7680 + (tid >> 3) * 144 + (tid & 7) * 16) = gA; \
            else *(LAS u32x4*)(sb_ + 2560 + ((tid - 256) >> 2) * 80 + ((tid - 256) & 3) * 16) = gA; \
            if (tid < 128) *(LAS u32x4*)(sb_ + (tid >> 2) * 80 + (tid & 3) * 16) = gB; \
            else if (tid < 144) *(LAS u32x4*)(sb_ + 21504 + (tid - 128) * 16) = gB; \
            { const float c0_ = bflo(vcur), c1_ = bfhi(vcur), p0_ = bflo(vprv), p1_ = bfhi(vprv); LAS bf16_t* vm_ = (LAS bf16_t*)(sb_ + 21760); \
                vm_[(2 * pq) * 40 + pj] = bf1(c0_ + (p0_ - c0_) * muv[0]); vm_[(2 * pq + 1) * 40 + pj] = bf1(c1_ + (p1_ - c1_) * muv[1]); } } while (0)
        const int chunk0 = 32 * round;
        W5_LOAD(chunk0); W5_STORE(chunk0 & 1);
        __syncthreads();
        for (int chunk = chunk0; chunk < chunk0 + 32; ++chunk) {
            const int bi = chunk & 1;
            if (chunk + 1 < chunk0 + 32) W5_LOAD(chunk + 1);
            { LAS unsigned char* sb = lds + 10240 + bi * SET;
              LAS bf16_t* WyT = (LAS bf16_t*)sb; LAS bf16_t* WzT = (LAS bf16_t*)(sb + 2560); LAS bf16_t* R2T = (LAS bf16_t*)(sb + 7680); LAS bf16_t* PpT = (LAS bf16_t*)(sb + 12288);
              LAS float* GC = (LAS float*)(sb + 21504); LAS bf16_t* VmT = (LAS bf16_t*)(sb + 21760); LAS float* YSTc = YST + bi * (32 * 33);
            if (wave < 3) {
                const int t = lane & 31; const LAS bf16_t* Sb = SBF + bi * (32 * 72); f32x16 acc;
#pragma unroll
                for (int i = 0; i < 16; ++i) acc[i] = 0.f;
                if (wave < 2) {
                    acc = mm32<2>(acc, VmT, 40, WzT + 32 * wave * 40, 40, lane);
                    acc = mm32<4>(acc, Sb, 72, PpT + 32 * wave * 72, 72, lane);
                    const float gc = GC[32 * wave + t]; LAS bf16_t* Sn = SBF + (bi ^ 1) * (32 * 72);
#pragma unroll
                    for (int i = 0; i < 16; ++i) { Sacc[i] = fmaf(Sacc[i], gc, acc[i]); Sn[TROW(i, lane) * 72 + 32 * wave + t] = bf1(Sacc[i]); }
                } else {
                    acc = mm32<2>(acc, VmT, 40, WyT, 40, lane);
                    acc = mm32<4>(acc, Sb, 72, R2T, 72, lane);
#pragma unroll
                    for (int i = 0; i < 16; ++i) YSTc[t * 33 + TROW(i, lane)] = acc[i];
                }
            }
            }
            if (chunk + 1 < chunk0 + 32) W5_STORE(bi ^ 1);
            __syncthreads();
            { const LAS float* ys = YST + bi * (32 * 33) + pj * 33 + 2 * pq;
                *(f32x2*)(Y + ((size_t)b * SEQ + chunk * 32 + pj) * 512 + h * 64 + 32 * half + 2 * pq) = (f32x2){ys[0], ys[1]}; }
        }
        if (wave < 2) {
#pragma unroll
            for (int i = 0; i < 16; ++i) SSAVE[(wave * 16 + i) * 64 + lane] = Sacc[i]; }
#undef W5_LOAD
#undef W5_STORE
    }
}
__device__ __forceinline__ void wkv5b2(const Args& a, LAS unsigned char* lds, const int round) {
    const int tid = threadIdx.x, lane = tid & 63, wave = __builtin_amdgcn_readfirstlane(tid >> 6);
    unsigned char* ws = a.ws;
    const bf16_t* COLS = (const bf16_t*)(ws + WS_A); float* Y = (float*)(ws + WS_B); float* SSV = (float*)(ws + WS_S5O);
    const unsigned char* STG_R = ws + WS_RWKV; const unsigned char* STG_P = (const unsigned char*)a.out + 96 * MiB;
    constexpr int SET = 26880;
    LAS bf16_t* SBF = (LAS bf16_t*)(lds + 53760);
    LAS float* YST = (LAS float*)(lds + 72192);
    for (int item = blockIdx.x; item < 128; item += gridDim.x) {
        const int bh = item, b = bh >> 3, h = bh & 7;
        const int pj = tid >> 4, pq = tid & 15;
        const int half = (wave >> 1) & 1, kh = wave & 1;
        f32x16 Sacc;
#pragma unroll
        for (int i = 0; i < 16; ++i) Sacc[i] = 0.f;
        __syncthreads();
        if (round == 0) { for (int i = tid; i < 64 * 72 / 2; i += 512) ((LAS unsigned*)SBF)[i] = 0u; }
        else if (wave < 4) { const int t = lane & 31;
#pragma unroll
            for (int i = 0; i < 16; ++i) { Sacc[i] = SSV[(((size_t)bh * 4 + wave) * 16 + i) * 64 + lane]; SBF[(32 * half + TROW(i, lane)) * 72 + 32 * kh + t] = bf1(Sacc[i]); } }
        const f32x4 muv = *(const f32x4*)(a.in[I_MU] + C_V + h * 64 + 4 * pq);
        u32x4 gPA, gAA, gBA, gPB, gAB, gBB; u32x2 vcA, vpA, vcB, vpB;
#define W5_LOAD(R, chunk) do { const size_t idx_ = (size_t)bh * 32 + ((chunk) & 31); const unsigned char* gr_ = STG_R + idx_ * STG_R_STRIDE; const unsigned char* gp_ = STG_P + idx_ * 8192; \
            gP##R = *(const u32x4*)(gp_ + (tid >> 3) * 128 + (tid & 7) * 16); \
            gA##R = (tid < 256) ? *(const u32x4*)(gr_ + (tid >> 3) * 128 + (tid & 7) * 16) : *(const u32x4*)(gr_ + 4096 + ((tid - 256) >> 2) * 64 + ((tid - 256) & 3) * 16); \
            gB##R = (tid < 144) ? *(const u32x4*)(gr_ + 8192 + tid * 16) : (u32x4){0u, 0u, 0u, 0u}; \
            { const int s_ = (chunk) * 32 + pj; const bf16_t* cb_ = COLS + ((size_t)b * SEQ + s_) * INC + C_V + h * 64 + 4 * pq; vc##R = *(const u32x2*)cb_; vp##R = (s_ > 0) ? *(const u32x2*)(cb_ - INC) : (u32x2){0u, 0u}; } } while (0)
#define W5_STORE(R, setb) do { LAS unsigned char* sb_ = lds + (setb) * SET; \
            *(LAS u32x4*)(sb_ + 12288 + (tid >> 3) * 144 + (tid & 7) * 16) = gP##R; \
            if (tid < 256) *(LAS u32x4*)(sb_ + 7680 + (tid >> 3) * 144 + (tid & 7) * 16) = gA##R; \
            else *(LAS u32x4*)(sb_ + 2560 + ((tid - 256) >> 2) * 80 + ((tid - 256) & 3) * 16) = gA##R; \
            if (tid < 128) *(LAS u32x4*)(sb_ + (tid >> 2) * 80 + (tid & 3) * 16) = gB##R; \
            else if (tid < 144) *(LAS u32x4*)(sb_ + 21504 + (tid - 128) * 16) = gB##R; \
            { float c_[4], p_[4]; unpack4(vc##R, c_); unpack4(vp##R, p_); LAS bf16_t* vm_ = (LAS bf16_t*)(sb_ + 21760); \
              _Pragma("unroll") for (int i_ = 0; i_ < 4; ++i_) vm_[(4 * pq + i_) * 40 + pj] = bf1(c_[i_] + (p_[i_] - c_[i_]) * muv[i_]); } } while (0)
#define W5_STEP(chunk, RL, RS) do { const int bi = (chunk) & 1; \
            if ((chunk) + 2 < cend) W5_LOAD(RL, (chunk) + 2); \
            { LAS unsigned char* sb = lds + bi * SET; \
              LAS bf16_t* WyT = (LAS bf16_t*)sb; LAS bf16_t* WzT = (LAS bf16_t*)(sb + 2560); LAS bf16_t* R2T = (LAS bf16_t*)(sb + 7680); LAS bf16_t* PpT = (LAS bf16_t*)(sb + 12288); \
              LAS float* GC = (LAS float*)(sb + 21504); LAS bf16_t* VmT = (LAS bf16_t*)(sb + 21760); \
              if (wave < 6) { const int t = lane & 31; f32x16 acc; \
                _Pragma("unroll") for (int i = 0; i < 16; ++i) acc[i] = 0.f; \
                if (wave < 4) { const LAS bf16_t* Sb = SBF + bi * (64 * 72) + 32 * half * 72; \
                    acc = mm32<2>(acc, VmT + 32 * half * 40, 40, WzT + 32 * kh * 40, 40, lane); \
                    acc = mm32<4>(acc, Sb, 72, PpT + 32 * kh * 72, 72, lane); \
                    const float gc = GC[32 * kh + t]; LAS bf16_t* Sn = SBF + (bi ^ 1) * (64 * 72) + 32 * half * 72; \
                    _Pragma("unroll") for (int i = 0; i < 16; ++i) { Sacc[i] = fmaf(Sacc[i], gc, acc[i]); Sn[TROW(i, lane) * 72 + 32 * kh + t] = bf1(Sacc[i]); } \
                } else { const int yh = wave - 4; const LAS bf16_t* Sb = SBF + bi * (64 * 72) + 32 * yh * 72; LAS float* YSTc = YST + (bi * 2 + yh) * (32 * 33); \
                    acc = mm32<2>(acc, VmT + 32 * yh * 40, 40, WyT, 40, lane); \
                    acc = mm32<4>(acc, Sb, 72, R2T, 72, lane); \
                    _Pragma("unroll") for (int i = 0; i < 16; ++i) YSTc[t * 33 + TROW(i, lane)] = acc[i]; \
                } } } \
            if ((chunk) + 1 < cend) W5_STORE(RS, bi ^ 1); \
            __syncthreads(); \
            { const LAS float* ys = YST + (bi * 2 + (pq >> 3)) * (32 * 33) + pj * 33 + 4 * (pq & 7); \
                *(f32x4*)(Y + ((size_t)b * SEQ + (chunk) * 32 + pj) * 512 + h * 64 + 4 * pq) = (f32x4){ys[0], ys[1], ys[2], ys[3]}; } } while (0)
        const int chunk0 = 32 * round, cend = chunk0 + 32;
        W5_LOAD(A, chunk0); W5_LOAD(B, chunk0 + 1); W5_STORE(A, 0);
        __syncthreads();
        for (int chunk = chunk0; chunk < cend; chunk += 2) { W5_STEP(chunk, A, B); W5_STEP(chunk + 1, B, A); }
        if (wave < 4) {
#pragma unroll
            for (int i = 0; i < 16; ++i) SSV[(((size_t)bh * 4 + wave) * 16 + i) * 64 + lane] = Sacc[i]; }
#undef W5_LOAD
#undef W5_STORE
#undef W5_STEP
    }
}
__device__ __forceinline__ void wkv5b3(const Args& a, LAS unsigned char* lds, const int round) {
    const int tid = threadIdx.x, lane = tid & 63, wave = __builtin_amdgcn_readfirstlane(tid >> 6);
    unsigned char* ws = a.ws;
    const bf16_t* COLS = (const bf16_t*)(ws + WS_A); float* Y = (float*)(ws + WS_B); float* SSV = (float*)(ws + WS_S5O);
    const unsigned char* STG_R = ws + WS_RWKV; const unsigned char* STG_P = (const unsigned char*)a.out + 96 * MiB;
    constexpr int SET = 26880;
    LAS bf16_t* SBF = (LAS bf16_t*)(lds + 53760);
    for (int item = blockIdx.x; item < 128; item += gridDim.x) {
        const int bh = item, b = bh >> 3, h = bh & 7;
        const int t = lane & 31, hh = lane >> 5;
        const int half = (wave >> 1) & 1, kh = wave & 1;
        const int chunk0 = 32 * round, cend = chunk0 + 32;
        __syncthreads();
        if (wave >= 6) {
            const int u = tid - 384, pj = u >> 2, cq = u & 3;
            f32x4 mv0, mv1, mv2, mv3;
            { const float* mp = a.in[I_MU] + C_V + h * 64 + 16 * cq; mv0 = *(const f32x4*)mp; mv1 = *(const f32x4*)(mp + 4); mv2 = *(const f32x4*)(mp + 8); mv3 = *(const f32x4*)(mp + 12); }
            u32x4 p0A, p1A, p2A, p3A, r0A, r1A, z0A, z1A, y0A, gcA, c0A, c1A, q0A, q1A;
            u32x4 p0B, p1B, p2B, p3B, r0B, r1B, z0B, z1B, y0B, gcB, c0B, c1B, q0B, q1B;
#define W5_LOAD(R, chunk) do { const size_t idx_ = (size_t)bh * 32 + ((chunk) & 31); const unsigned char* gr_ = STG_R + idx_ * STG_R_STRIDE; const unsigned char* gp_ = STG_P + idx_ * 8192; \
                p0##R = *(const u32x4*)(gp_ + u * 16); p1##R = *(const u32x4*)(gp_ + 2048 + u * 16); p2##R = *(const u32x4*)(gp_ + 4096 + u * 16); p3##R = *(const u32x4*)(gp_ + 6144 + u * 16); \
                r0##R = *(const u32x4*)(gr_ + u * 16); r1##R = *(const u32x4*)(gr_ + 2048 + u * 16); z0##R = *(const u32x4*)(gr_ + 4096 + u * 16); z1##R = *(const u32x4*)(gr_ + 6144 + u * 16); \
                y0##R = *(const u32x4*)(gr_ + 8192 + u * 16); gc##R = (u < 16) ? *(const u32x4*)(gr_ + 10240 + u * 16) : (u32x4){0u, 0u, 0u, 0u}; \
                { const int s_ = (chunk) * 32 + pj; const bf16_t* cb_ = COLS + ((size_t)b * SEQ + s_) * INC + C_V + h * 64 + 16 * cq; c0##R = *(const u32x4*)cb_; c1##R = *(const u32x4*)(cb_ + 8); \
                  if (s_ > 0) { q0##R = *(const u32x4*)(cb_ - INC); q1##R = *(const u32x4*)(cb_ - INC + 8); } else { q0##R = (u32x4){0u, 0u, 0u, 0u}; q1##R = (u32x4){0u, 0u, 0u, 0u}; } } } while (0)
#define W5_PIECE8(base, p_) ((base) + ((p_) >> 3) * 144 + ((p_) & 7) * 16)
#define W5_PIECE4(base, p_) ((base) + ((p_) >> 2) * 80 + ((p_) & 3) * 16)
#define W5_VM(cv, qv, mv, off) do { float c_[8], q_[8]; unpack8(cv, c_); unpack8(qv, q_); \
                _Pragma("unroll") for (int i_ = 0; i_ < 8; ++i_) vm_[(16 * cq + (off) + i_) * 40 + pj] = bf1(c_[i_] + (q_[i_] - c_[i_]) * ((i_ < 4) ? mv##0[i_ & 3] : mv##1[i_ & 3])); } while (0)
#define W5_STORE(R, setb) do { LAS unsigned char* sb_ = lds + (setb) * SET; \
                *(LAS u32x4*)W5_PIECE8(sb_ + 12288, u) = p0##R; *(LAS u32x4*)W5_PIECE8(sb_ + 12288, u + 128) = p1##R; *(LAS u32x4*)W5_PIECE8(sb_ + 12288, u + 256) = p2##R; *(LAS u32x4*)W5_PIECE8(sb_ + 12288, u + 384) = p3##R; \
                *(LAS u32x4*)W5_PIECE8(sb_ + 7680, u) = r0##R; *(LAS u32x4*)W5_PIECE8(sb_ + 7680, u + 128) = r1##R; \
                *(LAS u32x4*)W5_PIECE4(sb_ + 2560, u) = z0##R; *(LAS u32x4*)W5_PIECE4(sb_ + 2560, u + 128) = z1##R; \
                *(LAS u32x4*)W5_PIECE4(sb_, u) = y0##R; if (u < 16) *(LAS u32x4*)(sb_ + 21504 + u * 16) = gc##R; \
                { LAS bf16_t* vm_ = (LAS bf16_t*)(sb_ + 21760); \
                  { float c_[8], q_[8]; unpack8(c0##R, c_); unpack8(q0##R, q_); \
                    _Pragma("unroll") for (int i_ = 0; i_ < 8; ++i_) vm_[(16 * cq + i_) * 40 + pj] = bf1(c_[i_] + (q_[i_] - c_[i_]) * ((i_ < 4) ? mv0[i_ & 3] : mv1[i_ & 3])); } \
                  { float c_[8], q_[8]; unpack8(c1##R, c_); unpack8(q1##R, q_); \
                    _Pragma("unroll") for (int i_ = 0; i_ < 8; ++i_) vm_[(16 * cq + 8 + i_) * 40 + pj] = bf1(c_[i_] + (q_[i_] - c_[i_]) * ((i_ < 4) ? mv2[i_ & 3] : mv3[i_ & 3])); } } } while (0)
            W5_LOAD(A, chunk0); W5_LOAD(B, chunk0 + 1); W5_STORE(A, 0);
            __syncthreads();
            for (int chunk = chunk0; chunk < cend; chunk += 2) {
                if (chunk + 2 < cend) W5_LOAD(A, chunk + 2);
                W5_STORE(B, 1);
                __syncthreads();
                if (chunk + 3 < cend) W5_LOAD(B, chunk + 3);
                if (chunk + 2 < cend) W5_STORE(A, 0);
                __syncthreads();
            }
#undef W5_LOAD
#undef W5_STORE
#undef W5_VM
#undef W5_PIECE8
#undef W5_PIECE4
        } else {
            f32x16 Sacc;
#pragma unroll
            for (int i = 0; i < 16; ++i) Sacc[i] = 0.f;
            if (wave < 4) {
                if (round != 0) {
#pragma unroll
                    for (int i = 0; i < 16; ++i) Sacc[i] = SSV[(((size_t)bh * 4 + wave) * 16 + i) * 64 + lane]; }
                LAS bf16_t* Sn = SBF + (32 * half + t) * 72 + 32 * kh;
#pragma unroll
                for (int g4 = 0; g4 < 4; ++g4) *(LAS u32x2*)(Sn + 8 * g4 + 4 * hh) = (u32x2){cvt_pk_bf16(Sacc[4 * g4], Sacc[4 * g4 + 1]), cvt_pk_bf16(Sacc[4 * g4 + 2], Sacc[4 * g4 + 3])};
            }
            __syncthreads();
            for (int chunk = chunk0; chunk < cend; ++chunk) {
                const int bi = chunk & 1; LAS unsigned char* sb = lds + bi * SET;
                LAS bf16_t* WyT = (LAS bf16_t*)sb; LAS bf16_t* WzT = (LAS bf16_t*)(sb + 2560); LAS bf16_t* R2T = (LAS bf16_t*)(sb + 7680); LAS bf16_t* PpT = (LAS bf16_t*)(sb + 12288);
                LAS float* GC = (LAS float*)(sb + 21504); LAS bf16_t* VmT = (LAS bf16_t*)(sb + 21760);
                f32x16 acc;
#pragma unroll
                for (int i = 0; i < 16; ++i) acc[i] = 0.f;
                if (wave < 4) {
                    const LAS bf16_t* Sb = SBF + bi * (64 * 72) + 32 * half * 72;
                    acc = mm32<2>(acc, WzT + 32 * kh * 40, 40, VmT + 32 * half * 40, 40, lane);
                    acc = mm32<4>(acc, PpT + 32 * kh * 72, 72, Sb, 72, lane);
                    LAS bf16_t* Sn = SBF + (bi ^ 1) * (64 * 72) + (32 * half + t) * 72 + 32 * kh;
#pragma unroll
                    for (int g4 = 0; g4 < 4; ++g4) { const int k0 = 8 * g4 + 4 * hh; const f32x4 gc4 = *(const LAS f32x4*)(GC + 32 * kh + k0);
#pragma unroll
                        for (int i = 0; i < 4; ++i) Sacc[4 * g4 + i] = fmaf(Sacc[4 * g4 + i], gc4[i], acc[4 * g4 + i]);
                        *(LAS u32x2*)(Sn + k0) = (u32x2){cvt_pk_bf16(Sacc[4 * g4], Sacc[4 * g4 + 1]), cvt_pk_bf16(Sacc[4 * g4 + 2], Sacc[4 * g4 + 3])}; }
                } else {
                    const int yh = wave - 4; const LAS bf16_t* Sb = SBF + bi * (64 * 72) + 32 * yh * 72;
                    acc = mm32<2>(acc, WyT, 40, VmT + 32 * yh * 40, 40, lane);
                    acc = mm32<4>(acc, R2T, 72, Sb, 72, lane);
                    float* yp = Y + ((size_t)b * SEQ + chunk * 32) * 512 + h * 64 + 32 * yh + t;
#pragma unroll
                    for (int i = 0; i < 16; ++i) yp[(size_t)TROW(i, lane) * 512] = acc[i];
                }
                __syncthreads();
            }
            if (wave < 4) {
#pragma unroll
                for (int i = 0; i < 16; ++i) SSV[(((size_t)bh * 4 + wave) * 16 + i) * 64 + lane] = Sacc[i]; }
        }
    }
}
__device__ __forceinline__ unsigned w5_img_src(int o) {
    if (o < 2560) { const int r = o / 80, c = o - r * 80; return (c < 64) ? (unsigned)(8192 + r * 64 + c) : 0u; }
    if (o < 7680) { const int o2 = o - 2560, r = o2 / 80, c = o2 - r * 80; return (c < 64) ? (unsigned)(4096 + r * 64 + c) : 0u; }
    if (o < 12288) { const int o2 = o - 7680, r = o2 / 144, c = o2 - r * 144; return (c < 128) ? (unsigned)(r * 128 + c) : 0u; }
    if (o < 21504) { const int o2 = o - 12288, r = o2 / 144, c = o2 - r * 144; return (c < 128) ? (unsigned)(r * 128 + c) : 0u; }
    return (unsigned)(10240 + (o - 21504));
}
__device__ __forceinline__ void wkv5b4x(const Args& a, LAS unsigned char* lds, const int round, const int bh, unsigned* cons) {
    const int tid = threadIdx.x, lane = tid & 63, wave = __builtin_amdgcn_readfirstlane(tid >> 6);
    unsigned char* ws = a.ws;
    const bf16_t* COLS = (const bf16_t*)(ws + WS_A); bf16_t* Y = (bf16_t*)(ws + WS_B); float* SSV = (float*)(ws + WS_S5O);
    const unsigned char* STG_R = ws + WS_RWKV; const unsigned char* STG_P = (const unsigned char*)a.out + 96 * MiB;
    constexpr int SETB = 31104;
    LAS bf16_t* YST = (LAS bf16_t*)(lds + 4 * SETB + 18432);
    LAS bf16_t* SBF = (LAS bf16_t*)(lds + 4 * SETB);
#define W5_BAR() do { asm volatile("s_waitcnt lgkmcnt(0)" ::: "memory"); __builtin_amdgcn_s_barrier(); asm volatile("" ::: "memory"); } while (0)
    {
        const int b = bh >> 3, h = bh & 7;
        const int t = lane & 31, hh = lane >> 5;
        const int half = (wave >> 1) & 1, kh = wave & 1;
        const int chunk0 = 32 * round;
        __syncthreads();
        if (wave >= 6) {
            const int u2 = tid - 384, pp = (u2 >> 3) & 15, cg = u2 & 7;
            const int j0 = (wave == 6) ? 0 : 9, nb = (wave == 6) ? 9 : 13;
            unsigned goff[13];
#pragma unroll
            for (int j = 0; j < 13; ++j) goff[j] = w5_img_src((j0 + j) * 1024 + lane * 16);
            f32x4 mva, mvb;
            { const float* mp = a.in[I_MU] + C_V + h * 64 + 8 * cg; mva = *(const f32x4*)mp; mvb = *(const f32x4*)(mp + 4); }
#define W5_ISSUE(i_) do { const int c_ = chunk0 + (i_); const size_t idx_ = (size_t)bh * 32 + (c_ & 31); const unsigned char* gr_ = STG_R + idx_ * STG_R_STRIDE; const unsigned char* gp_ = STG_P + idx_ * 8192; \
                LAS unsigned char* sb_ = lds + ((i_) & 3) * SETB; \
                if (wave == 6) { const unsigned char* vb_ = (const unsigned char*)(COLS + ((size_t)b * SEQ + (size_t)c_ * 32) * INC + C_V + h * 64) - (size_t)INC * 2; \
                    _Pragma("unroll") for (int j = 0; j < 5; ++j) { const int p_ = j * 64 + lane; \
                        if (p_ < 264) __builtin_amdgcn_global_load_lds((const unsigned*)(vb_ + (size_t)(p_ >> 3) * (INC * 2) + (p_ & 7) * 16), (LAS unsigned*)(sb_ + 26880 + j * 1024), 16, 0, 0); } } \
                _Pragma("unroll") for (int j = 0; j < 13; ++j) { if (j < nb) { const int jj = j0 + j; const unsigned char* base_ = (jj >= 12 && jj < 21) ? gp_ : gr_; \
                    if (jj < 21 || lane < 16) __builtin_amdgcn_global_load_lds((const unsigned*)(base_ + goff[j]), (LAS unsigned*)(sb_ + jj * 1024), 16, 0, 0); } } } while (0)
#define W5_CONV(i_) do { const int c_ = chunk0 + (i_); LAS unsigned char* sb_ = lds + ((i_) & 3) * SETB; const LAS unsigned char* rw_ = sb_ + 26880 + (2 * pp) * 128 + cg * 16; LAS bf16_t* vm_ = (LAS bf16_t*)(sb_ + 21760); \
                u32x4 q_ = *(const LAS u32x4*)rw_; const u32x4 c0_ = *(const LAS u32x4*)(rw_ + 128), c1_ = *(const LAS u32x4*)(rw_ + 256); \
                if (c_ * 32 + 2 * pp == 0) q_ = (u32x4){0u, 0u, 0u, 0u}; \
                float q8_[8], a8_[8], b8_[8]; unpack8(q_, q8_); unpack8(c0_, a8_); unpack8(c1_, b8_); \
                _Pragma("unroll") for (int e_ = 0; e_ < 8; ++e_) { const float m_ = (e_ < 4) ? mva[e_ & 3] : mvb[e_ & 3]; \
                    *(LAS unsigned*)(vm_ + (8 * cg + e_) * 40 + 2 * pp) = cvt_pk_bf16(a8_[e_] + (q8_[e_] - a8_[e_]) * m_, b8_[e_] + (a8_[e_] - b8_[e_]) * m_); } } while (0)
            W5_ISSUE(0); W5_ISSUE(1); W5_ISSUE(2);
            if (wave == 6) asm volatile("s_waitcnt vmcnt(37)" ::: "memory");
            W5_BAR();
            W5_CONV(0);
            if (wave == 6) asm volatile("s_waitcnt vmcnt(23)" ::: "memory"); else asm volatile("s_waitcnt vmcnt(26)" ::: "memory");
            W5_BAR();
            for (int i = 0; i < 32; ++i) {
                if (cons != nullptr && tid == 384) __hip_atomic_store(cons, (unsigned)(i + 1), __ATOMIC_RELAXED, __HIP_MEMORY_SCOPE_AGENT);
                if (i + 3 < 32) W5_ISSUE(i + 3);
                if (i + 1 < 32) W5_CONV(i + 1);
                if (i + 3 < 32) { if (wave == 6) asm volatile("s_waitcnt vmcnt(23)" ::: "memory"); else asm volatile("s_waitcnt vmcnt(26)" ::: "memory"); }
                else asm volatile("s_waitcnt vmcnt(0)" ::: "memory");
                W5_BAR();
            }
#undef W5_ISSUE
#undef W5_CONV
        } else {
            f32x16 Sacc;
#pragma unroll
            for (int i = 0; i < 16; ++i) Sacc[i] = 0.f;
            if (wave < 4) {
                if (round != 0) {
#pragma unroll
                    for (int i = 0; i < 16; ++i) Sacc[i] = SSV[(((size_t)bh * 4 + wave) * 16 + i) * 64 + lane]; }
                LAS bf16_t* Sn = SBF + (32 * half + t) * 72 + 32 * kh;
#pragma unroll
                for (int g4 = 0; g4 < 4; ++g4) *(LAS u32x2*)(Sn + 8 * g4 + 4 * hh) = (u32x2){cvt_pk_bf16(Sacc[4 * g4], Sacc[4 * g4 + 1]), cvt_pk_bf16(Sacc[4 * g4 + 2], Sacc[4 * g4 + 3])};
            }
            W5_BAR();
            W5_BAR();
            for (int i = 0; i < 32; ++i) {
                const int chunk = chunk0 + i, bi = i & 1; LAS unsigned char* sb = lds + (i & 3) * SETB;
                LAS bf16_t* WyT = (LAS bf16_t*)sb; LAS bf16_t* WzT = (LAS bf16_t*)(sb + 2560); LAS bf16_t* R2T = (LAS bf16_t*)(sb + 7680); LAS bf16_t* PpT = (LAS bf16_t*)(sb + 12288);
                LAS float* GC = (LAS float*)(sb + 21504); LAS bf16_t* VmT = (LAS bf16_t*)(sb + 21760);
                f32x16 acc;
#pragma unroll
                for (int k = 0; k < 16; ++k) acc[k] = 0.f;
                if (wave < 4) {
                    __builtin_amdgcn_s_setprio(2);
                    const LAS bf16_t* Sb = SBF + bi * (64 * 72) + 32 * half * 72;
                    acc = mm32<2>(acc, WzT + 32 * kh * 40, 40, VmT + 32 * half * 40, 40, lane);
                    acc = mm32<4>(acc, PpT + 32 * kh * 72, 72, Sb, 72, lane);
                    LAS bf16_t* Sn = SBF + (bi ^ 1) * (64 * 72) + (32 * half + t) * 72 + 32 * kh;
#pragma unroll
                    for (int g4 = 0; g4 < 4; ++g4) { const int k0 = 8 * g4 + 4 * hh; const f32x4 gc4 = *(const LAS f32x4*)(GC + 32 * kh + k0);
#pragma unroll
                        for (int k = 0; k < 4; ++k) Sacc[4 * g4 + k] = fmaf(Sacc[4 * g4 + k], gc4[k], acc[4 * g4 + k]);
                        *(LAS u32x2*)(Sn + k0) = (u32x2){cvt_pk_bf16(Sacc[4 * g4], Sacc[4 * g4 + 1]), cvt_pk_bf16(Sacc[4 * g4 + 2], Sacc[4 * g4 + 3])}; }
                    __builtin_amdgcn_s_setprio(0);
                } else {
                    const int yh = wave - 4; const LAS bf16_t* Sb = SBF + bi * (64 * 72) + 32 * yh * 72;
                    acc = mm32<2>(acc, WyT, 40, VmT + 32 * yh * 40, 40, lane);
                    acc = mm32<4>(acc, R2T, 72, Sb, 72, lane);
                    LAS bf16_t* ysw = YST + bi * (32 * 64) + 32 * yh + t;
#pragma unroll
                    for (int k = 0; k < 16; ++k) ysw[TROW(k, lane) * 64] = (bf16_t)(cvt_pk_bf16(acc[k], acc[k]) & 0xffffu);
                }
                W5_BAR();
                if (wave >= 4) { const int row = 16 * (wave - 4) + (lane >> 3), pc = lane & 7;
#pragma unroll
                    for (int j = 0; j < 2; ++j) *(u32x4*)(Y + ((size_t)b * SEQ + chunk * 32 + row + 8 * j) * 512 + h * 64 + pc * 8) = *(const LAS u32x4*)(YST + bi * (32 * 64) + (row + 8 * j) * 64 + pc * 8); }
            }
            if (wave < 4) {
#pragma unroll
                for (int i = 0; i < 16; ++i) SSV[(((size_t)bh * 4 + wave) * 16 + i) * 64 + lane] = Sacc[i]; }
        }
    }
#undef W5_BAR
}

__device__ __forceinline__ void wkv5b4(const Args& a, LAS unsigned char* lds, const int round) {
    for (int item = blockIdx.x; item < 128; item += gridDim.x) wkv5b4x(a, lds, round, item, nullptr);
}
__device__ __forceinline__ void phase4s(const Args& a, LAS unsigned char* lds, const XcdBarrier& bar) {
    const int tid = threadIdx.x;
    unsigned char* ws = a.ws;
    for (int item = blockIdx.x; item < 256; item += gridDim.x) {
        if (tid < 64) {
            const int b = item >> 4, g = item & 15, n = tid;
            const f32x2 lamL = ((const f32x2*)(ws + WS_LAML))[g * 64 + n];
            const float* E = (const float*)(ws + WS_E) + ((size_t)g * S5ROWS + b * S5NCH) * 128;
            bf16_t* UG = (bf16_t*)(ws + WS_UG) + ((size_t)g * S5ROWS + b * S5NCH) * S5K + 512;
            float xr = 0.f, xi = 0.f;
#pragma unroll 8
            for (int ch = 0; ch < S5NCH; ++ch) {
                UG[(size_t)ch * S5K + n] = (bf16_t)f2bf(xr); UG[(size_t)ch * S5K + 64 + n] = (bf16_t)f2bf(xi);
                const float er = E[ch * 128 + n], ei = E[ch * 128 + 64 + n];
                const float nr = lamL[0] * xr - lamL[1] * xi + er, ni = lamL[0] * xi + lamL[1] * xr + ei; xr = nr; xi = ni;
            }
        }
    }
    if (gridDim.x != 256) { late_items_idle(a, lds, 0, N_LATE, 0); __syncthreads(); }
    if (gridDim.x == 256) {
        const int h = blockIdx.x & 127; unsigned* ready0 = w5_flag(a, h); unsigned* ready1 = w5_flag(a, 128 + h); unsigned* cons = w5_flag(a, 256 + h);
        unsigned* first_done = (unsigned*)(a.ws + WS_CTL + 32768);
        if (blockIdx.x < 128) {
            wkv5a3(a, lds, h, 0, 8, nullptr); w5_signal_add2(ready0, 8u, first_done);
            w5_acquire_wait(ready0, 16u); wkv5b4x(a, lds, 0, h, cons);
            wkv5a3(a, lds, h, 48, 8, nullptr); w5_signal_add(ready1, 8u);
            w5_acquire_wait(ready1, 16u); wkv5b4x(a, lds, 1, h, nullptr);
        } else {
            wkv5a3(a, lds, h, 16, 8, nullptr); w5_signal_add2(ready0, 8u, first_done);
            wkv5a3(a, lds, h, 32, 8, cons); w5_signal_add(ready1, 8u);
        }
    } else {
        wkv5a2(a, lds, 0); xcd_barrier(bar);
        wkv5b4(a, lds, 0); xcd_barrier(bar);
        wkv5a2(a, lds, 1); xcd_barrier(bar);
        wkv5b4(a, lds, 1);
    }
}

__device__ __forceinline__ void phase5_post(const Args& a) {
    const int gt = blockIdx.x * 512 + threadIdx.x, NT = gridDim.x * 512;
    unsigned char* ws = a.ws;
    const bf16_t* COLS = (const bf16_t*)(ws + WS_A); const bf16_t* LORA = (const bf16_t*)a.out; const bf16_t* Y = (const bf16_t*)(ws + WS_B); const float* BON = (const float*)(ws + WS_BON);
    bf16_t* RO = (bf16_t*)(ws + WS_RWKV);
    const int hq = gt & 127, h = hq >> 4, q = hq & 15, hc = h * 64 + 4 * q;
    float lg[4], lb[4], muv[4];
#pragma unroll
    for (int i = 0; i < 4; ++i) { lg[i] = a.in[I_LNG][hc + i]; lb[i] = a.in[I_LNB][hc + i]; muv[i] = a.in[I_MU][C_V + hc + i]; }
    for (int p0 = gt; p0 < T * 128; p0 += 4 * NT) {
        u32x2 yw[4], vcw[4], vpw[4], gw[4]; float bon[4];
#pragma unroll
        for (int u = 0; u < 4; ++u) { const int t = (p0 + u * NT < T * 128) ? ((p0 + u * NT) >> 7) : (p0 >> 7);
            yw[u] = __builtin_nontemporal_load((const u32x2*)(Y + (size_t)t * 512 + hc)); vcw[u] = *(const u32x2*)(COLS + (size_t)t * INC + C_V + hc);
            vpw[u] = ((t & (SEQ - 1)) != 0) ? *(const u32x2*)(COLS + (size_t)(t - 1) * INC + C_V + hc) : (u32x2){0u, 0u};
            gw[u] = __builtin_nontemporal_load((const u32x2*)(LORA + (size_t)t * 1536 + 1024 + hc)); bon[u] = BON[(size_t)t * 8 + h]; }
#pragma unroll
        for (int u = 0; u < 4; ++u) { const int t = (p0 + u * NT < T * 128) ? ((p0 + u * NT) >> 7) : (p0 >> 7);
            float y4[4]; unpack4(yw[u], y4);
            float s = (y4[0] + y4[1]) + (y4[2] + y4[3]); s = row16_sum(s); const float mean = s * (1.0f / 64.0f);
            const float d0 = y4[0] - mean, d1 = y4[1] - mean, d2 = y4[2] - mean, d3 = y4[3] - mean;
            float qv = (d0 * d0 + d1 * d1) + (d2 * d2 + d3 * d3); qv = row16_sum(qv); const float rstd = 1.0f / sqrtf(qv * (1.0f / 64.0f) + 64e-5f);
            float vc[4], vp[4], g4[4]; unpack4(vcw[u], vc); unpack4(vpw[u], vp); unpack4(gw[u], g4);
            const float dd[4] = {d0, d1, d2, d3}; float o[4];
#pragma unroll
            for (int i = 0; i < 4; ++i) { const float v = vc[i] + (vp[i] - vc[i]) * muv[i]; o[i] = (dd[i] * rstd * lg[i] + lb[i] + bon[u] * v) * g4[i]; }
            u32x2 w; w.x = cvt_pk_bf16(o[0], o[1]); w.y = cvt_pk_bf16(o[2], o[3]); *(u32x2*)(RO + (size_t)t * 512 + hc) = w; }
    }
}

__device__ __forceinline__ void phase9(const Args& a, LAS unsigned char* lds) {
    const int tid = threadIdx.x, lane = tid & 63, wave = tid >> 6;
    unsigned char* ws = a.ws;
    const bf16_t* X1 = (const bf16_t*)a.out; const bf16_t* WR = (const bf16_t*)(ws + WS_WR);
    int4* ROUTE = (int4*)(ws + WS_ROUTE); int* BC = (int*)(ws + WS_BC);
    constexpr int WRP = 2064;
    LAS float* LG = (LAS float*)(lds + 99328) + wave * (16 * 49);
    LAS int* cnt = (LAS int*)(lds + 99328 + 8 * 16 * 49 * 4);
    __syncthreads();
    for (int i = tid; i < 48 * 128; i += 512) { const int r = i >> 7, cq = i & 127; *(LAS u32x4*)(lds + r * WRP + cq * 16) = *(const u32x4*)(WR + (size_t)r * DM + cq * 8); }
    for (int vb = blockIdx.x; vb < 256; vb += gridDim.x) {
        __syncthreads();
        if (tid < 32) cnt[tid] = 0;
        __syncthreads();
        const int t0 = vb * 128 + wave * 16;
        const int ar = lane & 15, aq = lane >> 4;
        f32x4 acc0 = (f32x4){0.f, 0.f, 0.f, 0.f}, acc1 = acc0, acc2 = acc0; float ssq = 0.f;
        const bf16_t* xrow = X1 + (size_t)(t0 + ar) * DM + 8 * aq;
        const LAS unsigned char* wrow = lds + ar * WRP + 16 * aq;
#pragma unroll 8
        for (int kb = 0; kb < 32; ++kb) {
            const u32x4 af = *(const u32x4*)(xrow + kb * 32); float xf[8]; unpack8(af, xf);
            ssq += (xf[0] * xf[0] + xf[1] * xf[1]) + (xf[2] * xf[2] + xf[3] * xf[3]) + (xf[4] * xf[4] + xf[5] * xf[5]) + (xf[6] * xf[6] + xf[7] * xf[7]);
            const bf16x8 A = __builtin_bit_cast(bf16x8, af);
            const bf16x8 B0 = *(const LAS bf16x8*)(wrow + kb * 64), B1 = *(const LAS bf16x8*)(wrow + 16 * WRP + kb * 64), B2 = *(const LAS bf16x8*)(wrow + 32 * WRP + kb * 64);
            acc0 = __builtin_amdgcn_mfma_f32_16x16x32_bf16(A, B0, acc0, 0, 0, 0);
            acc1 = __builtin_amdgcn_mfma_f32_16x16x32_bf16(A, B1, acc1, 0, 0, 0);
            acc2 = __builtin_amdgcn_mfma_f32_16x16x32_bf16(A, B2, acc2, 0, 0, 0);
        }
        ssq += __shfl_xor(ssq, 16); ssq += __shfl_xor(ssq, 32);
        const float rs = 1.0f / sqrtf(ssq * (1.0f / DM) + 1e-6f);
#pragma unroll
        for (int r = 0; r < 4; ++r) { const int row = aq * 4 + r; LG[row * 49 + ar] = acc0[r]; LG[row * 49 + 16 + ar] = acc1[r]; LG[row * 49 + 32 + ar] = acc2[r]; }
        LDS_WAIT();
        if (lane < 16) {
            const int t = t0 + lane; const LAS float* lg = LG + lane * 49;
            float gl[4]; float mx = -3.0e38f; int gi = 0;
#pragma unroll
            for (int j = 0; j < 4; ++j) { gl[j] = lg[j] * rs + a.in[I_RGB][j]; if (gl[j] > mx) { mx = gl[j]; gi = j; } }
            float den = 0.f;
#pragma unroll
            for (int j = 0; j < 4; ++j) den += __expf(gl[j] - mx);
            const float gp = 1.0f / den;
            float b1 = -3.0e38f, b2 = -3.0e38f; int i1 = 0, i2 = 0;
            for (int j = 0; j < 8; ++j) { const float v = lg[4 + gi * 8 + j] * rs + a.in[I_REB][gi * 8 + j];
                if (v > b1) { b2 = b1; i2 = i1; b1 = v; i1 = j; } else if (v > b2) { b2 = v; i2 = j; } }
            const float e2 = __expf(b2 - b1), w1 = gp / (1.0f + e2), w2 = gp * e2 / (1.0f + e2);
            const int e0 = gi * 8 + i1, e1 = gi * 8 + i2;
            const int s0 = atomicAdd((int*)&cnt[e0], 1), s1 = atomicAdd((int*)&cnt[e1], 1);
            int4 rt; rt.x = e0 | (e1 << 8); rt.y = s0 | (s1 << 16); rt.z = __builtin_bit_cast(int, w1); rt.w = __builtin_bit_cast(int, w2);
            ROUTE[t] = rt; ((float*)(ws + WS_RST))[t] = rs;
        }
        __syncthreads();
        if (tid < 32) BC[vb * 32 + tid] = cnt[tid];
    }
}

__device__ __forceinline__ void phase10(const Args& a, LAS unsigned char* lds) {
    const int tid = threadIdx.x, lane = tid & 63, wave = tid >> 6;
    unsigned char* ws = a.ws;
    const bf16_t* X1 = (const bf16_t*)a.out; const int4* ROUTE = (const int4*)(ws + WS_ROUTE); const int* BC = (const int*)(ws + WS_BC);
    bf16_t* HS = (bf16_t*)(ws + WS_A); float* ROWW = (float*)(ws + WS_ROWW); int2* POS = (int2*)(ws + WS_POS); int* OFF = (int*)(ws + WS_OFF); int* TOK = (int*)(ws + WS_TOK);
    LAS int* ptot = (LAS int*)lds;
    LAS int* pmine = ptot + 512;
    LAS int* base = pmine + 512;
    for (int vb = blockIdx.x; vb < 256; vb += gridDim.x) {
        __syncthreads();
        { const int e = tid & 31, part = tid >> 5; int st = 0, sm = 0;
            for (int k = 0; k < 16; ++k) { const int r = part * 16 + k; const int c = BC[r * 32 + e]; st += c; sm += (r < vb) ? c : 0; }
            ptot[part * 32 + e] = st; pmine[part * 32 + e] = sm; }
        __syncthreads();
        if (tid < 32) { int st = 0, sm = 0; for (int k = 0; k < 16; ++k) { st += ptot[k * 32 + tid]; sm += pmine[k * 32 + tid]; } ptot[tid] = (st + 255) & ~255; pmine[tid] = sm; }
        __syncthreads();
        if (tid < 32) { int off = 0; for (int k = 0; k < tid; ++k) off += ptot[k]; base[tid] = off + pmine[tid];
            if (vb == 0) { OFF[tid] = off; if (tid == 31) OFF[32] = off + ptot[31]; } }
        __syncthreads();
        if (vb == 0 && tid < 288) { int acc_ = 0, e = 0;
            for (int k = 0; k < 31; ++k) { acc_ += ptot[k]; e += (acc_ <= tid * 256) ? 1 : 0; }
            OFF[40 + tid] = e; }
        if (tid < 128) {
            const int t = vb * 128 + tid; const int4 rt = ROUTE[t]; const float rs = ((const float*)(ws + WS_RST))[t];
            const int e0 = rt.x & 255, e1 = (rt.x >> 8) & 255, p0 = base[e0] + (rt.y & 0xffff), p1 = base[e1] + ((rt.y >> 16) & 0xffff);
            ROWW[p0] = __builtin_bit_cast(float, rt.z); ROWW[p1] = __builtin_bit_cast(float, rt.w); POS[t] = make_int2(p0, p1); TOK[p0] = t; TOK[p1] = t;
            float* RSROW = (float*)(ws + WS_RSROW); RSROW[p0] = rs; RSROW[p1] = rs; }
    }
}

__device__ __forceinline__ void phase13(const Args& a) {
    const int tid = threadIdx.x, lane = tid & 63, wave = tid >> 6;
    const int gw = blockIdx.x * 8 + wave, NGW = gridDim.x * 8;
    unsigned char* ws = a.ws;
    const bf16_t* X = (const bf16_t*)a.out; float* SQ = (float*)(ws + WS_BON); const bf16_t* YM = (const bf16_t*)(ws + WS_A); const int2* POS = (const int2*)(ws + WS_POS); bf16_t* HP = (bf16_t*)(ws + WS_HP); bf16_t* P16 = (bf16_t*)(ws + WS_P16);
    for (int t0 = gw; t0 < T; t0 += 2 * NGW) {
        f32x4 v[2][4]; u32x2 ya[2][4], yb[2][4]; f32x4 pv[2];
#pragma unroll
        for (int u = 0; u < 2; ++u) { const int t = t0 + u * NGW; const int2 ps = POS[t];
            const u32x2* xr = (const u32x2*)(X + (size_t)t * DM) + lane; const u32x2* y0 = (const u32x2*)(YM + (size_t)ps.x * DM) + lane; const u32x2* y1 = (const u32x2*)(YM + (size_t)ps.y * DM) + lane;
#pragma unroll
            for (int j = 0; j < 4; ++j) { const u32x2 w = xr[64 * j]; v[u][j] = (f32x4){bflo(w.x), bfhi(w.x), bflo(w.y), bfhi(w.y)}; ya[u][j] = __builtin_nontemporal_load(y0 + 64 * j); yb[u][j] = __builtin_nontemporal_load(y1 + 64 * j); }
            pv[u] = __builtin_nontemporal_load((const f32x4*)(a.in[I_P] + (size_t)t * 256) + lane); }
#pragma unroll
        for (int u = 0; u < 2; ++u) { const int t = t0 + u * NGW; float s = 0.f;
#pragma unroll
            for (int j = 0; j < 4; ++j) { float a0[4], a1[4]; unpack4(ya[u][j], a0); unpack4(yb[u][j], a1);
                v[u][j][0] = (v[u][j][0] + a0[0]) + a1[0]; v[u][j][1] = (v[u][j][1] + a0[1]) + a1[1]; v[u][j][2] = (v[u][j][2] + a0[2]) + a1[2]; v[u][j][3] = (v[u][j][3] + a0[3]) + a1[3];
                s += (v[u][j][0] * v[u][j][0] + v[u][j][1] * v[u][j][1]) + (v[u][j][2] * v[u][j][2] + v[u][j][3] * v[u][j][3]); }
            const float sq = sqrtf(wave_sum(s) * (1.0f / DM) + 1e-6f), rs = 1.0f / sq;
            if (lane == 0) SQ[t] = sq;
            u32x2* o = (u32x2*)(HP + (size_t)t * DM) + lane;
#pragma unroll
            for (int j = 0; j < 4; ++j) { u32x2 w; w.x = pk2(v[u][j][0] * rs, v[u][j][1] * rs); w.y = pk2(v[u][j][2] * rs, v[u][j][3] * rs); o[64 * j] = w; }
            u32x2 w; w.x = pk2(pv[u][0], pv[u][1]); w.y = pk2(pv[u][2], pv[u][3]); *((u32x2*)(P16 + (size_t)t * 256) + lane) = w; }
    }
}
__device__ __forceinline__ void phase15(const Args& a, const bf16_t* XS) {
    const int tid = threadIdx.x, lane = tid & 63, wave = tid >> 6;
    const int gw = blockIdx.x * 8 + wave, NGW = gridDim.x * 8;
    float* X = a.out; const f32x4* gn = (const f32x4*)a.in[I_FINN] + lane;
    f32x4 g[4];
#pragma unroll
    for (int j = 0; j < 4; ++j) g[j] = gn[64 * j];
    for (int t0 = gw; t0 < T; t0 += 4 * NGW) {
        f32x4 v[4][4];
#pragma unroll
        for (int u = 0; u < 4; ++u) { const int tr = (t0 + u * NGW < T) ? (t0 + u * NGW) : t0; const u32x2* xs = (const u32x2*)(XS + (size_t)tr * DM) + lane;
#pragma unroll
            for (int j = 0; j < 4; ++j) { const u32x2 w = xs[64 * j]; v[u][j] = (f32x4){bflo(w.x), bfhi(w.x), bflo(w.y), bfhi(w.y)}; } }
#pragma unroll
        for (int u = 0; u < 4; ++u) { float s = 0.f;
#pragma unroll
            for (int j = 0; j < 4; ++j) s += (v[u][j][0] * v[u][j][0] + v[u][j][1] * v[u][j][1]) + (v[u][j][2] * v[u][j][2] + v[u][j][3] * v[u][j][3]);
            const float rs = 1.0f / sqrtf(wave_sum(s) * (1.0f / DM) + 1e-6f);
            const int tr = (t0 + u * NGW < T) ? (t0 + u * NGW) : t0; f32x4* xr = (f32x4*)(X + (size_t)tr * DM) + lane;
#pragma unroll
            for (int j = 0; j < 4; ++j) xr[64 * j] = (f32x4){v[u][j][0] * rs * g[j][0], v[u][j][1] * rs * g[j][1], v[u][j][2] * rs * g[j][2], v[u][j][3] * rs * g[j][3]}; }
    }
}

#ifdef PROBE
__device__ __forceinline__ void phase_probe(const Args& a) {
    const int gt = blockIdx.x * 512 + threadIdx.x, NT = gridDim.x * 512;
#if PROBE == 1
    const bf16_t* src = (const bf16_t*)(a.ws + WS_HP); const size_t n = (size_t)T * DM;
#elif PROBE == 2
    const bf16_t* src = (const bf16_t*)(a.ws + WS_WPG); const size_t n = (size_t)1024 * 1024;
#else
    const bf16_t* src = (const bf16_t*)(a.ws + WS_G); const size_t n = (size_t)T * DM;
#endif
    for (size_t i = gt; i < (size_t)T * DM; i += NT) a.out[i] = (i < n) ? __builtin_bit_cast(float, (unsigned)src[i] << 16) : 0.f;
}
#endif
__global__ void __launch_bounds__(512) mega_fwd(Args a) {
    extern __shared__ __attribute__((aligned(16))) unsigned char lds_raw[];
    LAS unsigned char* lds = (LAS unsigned char*)lds_raw;
    unsigned char* ws = a.ws;
    const int G = gridDim.x, c = blockIdx.x;
    const int lo = a.ph_lo, hi = a.ph_hi;
    if (threadIdx.x < 32) ((LAS unsigned*)(lds + MISC_OFF))[threadIdx.x] = 0u;
    __syncthreads();
    XcdBarrier bar; bar.bar = (unsigned*)(ws + WS_CTL) + 4096; bar.x = 0; bar.st = nullptr;
    if (hi - lo > 1) bar = xcd_barrier_post((unsigned*)(ws + WS_CTL) + 4096, (volatile LAS unsigned*)(lds + MISC_OFF));
#ifndef DUPMASK
#define DUPMASK 0
#endif
#ifndef PHMASK
#define PHMASK 0xFFFFF
#endif
#define IN(k) ((((PHMASK) >> (k)) & 1) && lo <= (k) && (k) < hi)
#define SEAM_MASK 0x5FBB7u
#define SEAM(k) do { if (IN(k) && IN((k) + 1)) { if (((SEAM_MASK >> (k)) & 1u) && !((k) == 7 && G == 256) && (k) != 14) { xcd_barrier(bar); } else __syncthreads(); } } while (0)
    bf16_t* COLS = (bf16_t*)(ws + WS_A);
    TSTART(100);
    if (IN(0)) for (int rep_ = 0; rep_ < (((DUPMASK) >> 0) & 1 ? 2 : 1); ++rep_) { phase0(a, lds); }
    SEAM(0);
    TSTOP(100);
    TSTART(101);
    if (IN(1)) for (int rep_ = 0; rep_ < (((DUPMASK) >> 1) & 1 ? 2 : 1); ++rep_) {
        pg8::DenseSched S; S.init(a.out, 1024, ws + WS_WIN, 1024, T, INC, G, c);
        pg8::EpiRow8<F_Cols> E{{COLS, INC, (bf16_t*)(ws + WS_UG)}};
        pg8::gemm_phase<pg8::EpiRow8<F_Cols>, pg8::DenseSched, true>(lds, 1024, 1024, 1024, S, E);
    }
    SEAM(1);
    TSTOP(101);
    TSTART(102);
    if (IN(2)) for (int rep_ = 0; rep_ < (((DUPMASK) >> 2) & 1 ? 2 : 1); ++rep_) { phase2(a); }
    SEAM(2);
    TSTOP(102);
    TSTART(103);
    if (IN(3)) for (int rep_ = 0; rep_ < (((DUPMASK) >> 3) & 1 ? 2 : 1); ++rep_) {
        pg8::LoraSched S{(const char*)(ws + WS_Z), (const char*)(ws + WS_WLORA), {}}; S.so.init(T, 1536, G, c);
        pg8::EpiRow8<F_Lora> E{{(bf16_t*)a.out, a.in[I_W0], a.in[I_A0]}};
        pg8::gemm_phase<pg8::EpiRow8<F_Lora>, pg8::LoraSched, true>(lds, 128, 256, 256, S, E);
    }
    SEAM(3);
    TSTOP(103);
    TSTART(104);
    if (IN(4)) for (int rep_ = 0; rep_ < (((DUPMASK) >> 4) & 1 ? 2 : 1); ++rep_) {
        pg8::GroupSched S{(const char*)(ws + WS_UG), (const char*)(ws + WS_W1), S5K, 512, 4, 1, 16, G, c, (size_t)S5ROWS * S5K * 2, (size_t)256 * 512 * 2};
        pg8::EpiRow8<F_S5a> E{{(float*)(ws + WS_E)}};
        pg8::gemm_phase<pg8::EpiRow8<F_S5a>, pg8::GroupSched, true>(lds, 512, S5K, 512, S, E);
        if (G == 256) { late_items_idle(a, lds, 0, 896, 64); late_items_idle(a, lds, 1536, 1568, 64); }
    }
    SEAM(4);
    TSTOP(104);
    TSTART(105);
    if (IN(5)) for (int rep_ = 0; rep_ < (((DUPMASK) >> 5) & 1 ? 2 : 1); ++rep_) {
#if WKV_CHUNKED == 2
        phase4s(a, lds, bar);
        if (G == 256 && blockIdx.x >= 128) {
            w5_acquire_wait((unsigned*)(ws + WS_CTL + 32768), 256u);
            pg8::GroupSched S{(const char*)(ws + WS_UG), (const char*)(ws + WS_TZ), S5K, S5K, 4, 2, 16, 128, (int)blockIdx.x - 128, (size_t)S5ROWS * S5K * 2, (size_t)S5N * S5K * 2};
            pg8::EpiRow8P<F_S5c> E{{COLS, a.in[I_SD], (bf16_t*)(ws + WS_B + 32 * MiB)}};
            pg8::gemm_phase<pg8::EpiRow8P<F_S5c>, pg8::GroupSched, true>(lds, S5K, S5K, S5K, S, E);
        }
#elif WKV_CHUNKED
        phase4c(a, lds);
#else
        phase4(a, lds);
#endif
    }
    SEAM(5);
    TSTOP(105);
    TSTART(106);
    if (IN(6)) for (int rep_ = 0; rep_ < (((DUPMASK) >> 6) & 1 ? 2 : 1); ++rep_) { phase5_post(a); }
    SEAM(6);
    TSTOP(106);
    TSTART(107);
    if (IN(7)) for (int rep_ = 0; rep_ < (((DUPMASK) >> 7) & 1 ? 2 : 1); ++rep_) {
        if (G == 256) late_items_idle(a, lds, 1568, N_LATE, 0);
        else {
            pg8::GroupSched S{(const char*)(ws + WS_UG), (const char*)(ws + WS_TZ), S5K, S5K, 4, 2, 16, G, c, (size_t)S5ROWS * S5K * 2, (size_t)S5N * S5K * 2};
            pg8::EpiRow8P<F_S5c> E{{COLS, a.in[I_SD], (bf16_t*)(ws + WS_Z)}};
            pg8::gemm_phase<pg8::EpiRow8P<F_S5c>, pg8::GroupSched, true>(lds, S5K, S5K, S5K, S, E);
        }
    }
    SEAM(7);
    TSTOP(107);
    TSTART(108);
    if (IN(8)) for (int rep_ = 0; rep_ < (((DUPMASK) >> 8) & 1 ? 2 : 1); ++rep_) {
        const unsigned char* zbuf = (G == 256) ? (ws + WS_B + 32 * MiB) : (ws + WS_Z);
        pg8::DenseSched S; S.init(zbuf, 256, ws + WS_WGLU, 256, T, 256, G, c);
        bf16_t* s5out = (G == 256) ? (bf16_t*)(ws + WS_Z) : (bf16_t*)a.out;
        pg8::EpiRow8P<F_Glu> E{{(const bf16_t*)zbuf, a.in[I_GLUB], s5out}};
        pg8::gemm_phase<pg8::EpiRow8P<F_Glu>, pg8::DenseSched, true>(lds, 256, 256, 256, S, E);
        if (G == 256) late_items_idle(a, lds, 896, 1536, 128);
    }
    SEAM(8);
    TSTOP(108);
    TSTART(109);
    if (IN(9)) for (int rep_ = 0; rep_ < (((DUPMASK) >> 9) & 1 ? 2 : 1); ++rep_) {
        pg8::BrSched S{(const char*)(ws + WS_RWKV), (const char*)(ws + WS_WBA), (G == 256) ? (const char*)(ws + WS_Z) : (const char*)a.out, (const char*)(ws + WS_WBB), {}}; S.so.init(T, DM, G, c);
        pg8::EpiBr E{COLS, (bf16_t*)(ws + WS_B)};
        pg8::gemm_phase2<pg8::EpiBr, pg8::BrSched, true, 8, 4>(lds, 512, 512, S, E);
    }
    SEAM(9);
    TSTOP(109);
    TSTART(110);
    SEAM(10);
    TSTOP(110);
    TSTART(111);
    if (IN(11)) for (int rep_ = 0; rep_ < (((DUPMASK) >> 11) & 1 ? 2 : 1); ++rep_) {
        pg8::DenseSched S; S.init(ws + WS_B, 1024, ws + WS_WOUT, 1024, T, DM, G, c);
        pg8::EpiRow8<F_Res> E{{a.in[I_X], (bf16_t*)a.out}};
        pg8::gemm_phase<pg8::EpiRow8<F_Res>, pg8::DenseSched, true>(lds, 1024, 1024, 1024, S, E);
    }
    SEAM(11);
    TSTOP(111);
    TSTART(112);
    if (IN(12)) for (int rep_ = 0; rep_ < (((DUPMASK) >> 12) & 1 ? 2 : 1); ++rep_) { phase9(a, lds); }
    SEAM(12);
    TSTOP(112);
    TSTART(113);
    if (IN(13)) for (int rep_ = 0; rep_ < (((DUPMASK) >> 13) & 1 ? 2 : 1); ++rep_) { phase10(a, lds); }
    SEAM(13);
    TSTOP(113);
    TSTART(114);
    if (IN(14)) for (int rep_ = 0; rep_ < (((DUPMASK) >> 14) & 1 ? 2 : 1); ++rep_) {
        pg8::MoeSched S{(const int*)(ws + WS_OFF), (const char*)a.out, (const char*)(ws + WS_WGU), 1024, 1024, 2, G, c, (size_t)512 * 1024 * 2, 0};
        pg8::EpiMoeUp E{(bf16_t*)(ws + WS_HID), (const float*)(ws + WS_RSROW)};
        pg8::gemm_phase_ga<pg8::EpiMoeUp, pg8::MoeSched, true>(lds, 1024, 1024, 1024, S, E, (const int*)(ws + WS_TOK), (unsigned*)(ws + WS_CTL + 33024));
    }
    SEAM(14);
    TSTOP(114);
    TSTART(115);
    if (IN(15)) for (int rep_ = 0; rep_ < (((DUPMASK) >> 15) & 1 ? 2 : 1); ++rep_) {
        pg8::MoeSched S{(const int*)(ws + WS_OFF), (const char*)(ws + WS_HID), (const char*)(ws + WS_WD), 256, 256, 4, G, c, (size_t)1024 * 256 * 2, 1};
        pg8::EpiRow8P<F_MoeDown> E{{(const float*)(ws + WS_ROWW), (bf16_t*)(ws + WS_A)}};
        pg8::gemm_phase_dn<pg8::EpiRow8P<F_MoeDown>, pg8::MoeSched, true>(lds, 256, 256, 256, S, E, (const unsigned*)(ws + WS_CTL + 33024), 16u);
    }
    SEAM(15);
    TSTOP(115);
    TSTART(116);
    if (IN(16)) for (int rep_ = 0; rep_ < (((DUPMASK) >> 16) & 1 ? 2 : 1); ++rep_) { phase13(a); }
    SEAM(16);
    TSTOP(116);
    TSTART(117);
    if (IN(17)) for (int rep_ = 0; rep_ < (((DUPMASK) >> 17) & 1 ? 2 : 1); ++rep_) {
        pg8::DenseSched S; S.init(ws + WS_HP, 1024, ws + WS_WPG, 1024, T, DM, G, c);
        pg8::EpiRow8<F_PleG> E{{(bf16_t*)(ws + WS_G)}};
        pg8::gemm_phase<pg8::EpiRow8<F_PleG>, pg8::DenseSched, true>(lds, 1024, 1024, 1024, S, E);
    }
    SEAM(17);
    TSTOP(117);
    TSTART(118);
    if (IN(18)) for (int rep_ = 0; rep_ < (((DUPMASK) >> 18) & 1 ? 2 : 1); ++rep_) {
        pg8::DenseSched S; S.init(ws + WS_P16, 256, ws + WS_WPP, 256, T, DM, G, c);
        pg8::EpiRow8<F_PleP> E{{(const bf16_t*)(ws + WS_G), (const bf16_t*)(ws + WS_HP), (const float*)(ws + WS_BON), (bf16_t*)(ws + WS_A)}};
        pg8::gemm_phase<pg8::EpiRow8<F_PleP>, pg8::DenseSched, true>(lds, 256, 256, 256, S, E);
    }
    SEAM(18);
    TSTOP(118);
#ifdef PROBE
    TSTART(119);
    if (IN(19)) for (int rep_ = 0; rep_ < (((DUPMASK) >> 19) & 1 ? 2 : 1); ++rep_) { phase_probe(a); }
#else
    TSTART(119);
    if (IN(19)) for (int rep_ = 0; rep_ < (((DUPMASK) >> 19) & 1 ? 2 : 1); ++rep_) { phase15(a, ((PHMASK >> 18) & 1) ? (const bf16_t*)(ws + WS_A) : (const bf16_t*)a.out); }
#endif
    TSTOP(119);
#if TIMER_SEL || TIMER_PHMASK
    if (blockIdx.x == 0 && threadIdx.x == 0) { const unsigned acc_ = ((volatile LAS unsigned*)(lds + MISC_OFF + 64))[0]; const unsigned long long t0_ = __builtin_amdgcn_s_memrealtime();
        while (__builtin_amdgcn_s_memrealtime() - t0_ < (unsigned long long)acc_ * TIMER_MULT) __builtin_amdgcn_s_sleep(8); }
#endif
#undef IN
#undef SEAM
}

extern "C" void kernel_launch(void* const* d_in, const int* in_sizes, int n_in, void* d_out, int out_size, void* d_ws, size_t ws_size, hipStream_t stream) {
    static int grid = 0;
    if (grid == 0) {
        if (n_in != 40 || out_size != T * DM || ws_size < WS_END) { fprintf(stderr, "kernel_launch: unexpected problem (n_in %d, out %d, ws %zu < %zu); nothing launched\n", n_in, out_size, ws_size, (size_t)WS_END); grid = -1; return; }
        int dev = 0, cus = 0, per_cu = 0;
        hipGetDevice(&dev); hipDeviceGetAttribute(&cus, hipDeviceAttributeMultiprocessorCount, dev);
        if (hipFuncSetAttribute((const void*)mega_fwd, hipFuncAttributeMaxDynamicSharedMemorySize, LDS_BYTES) != hipSuccess) { fprintf(stderr, "kernel_launch: hipFuncSetAttribute failed\n"); grid = -1; return; }
        if (hipOccupancyMaxActiveBlocksPerMultiprocessor(&per_cu, (const void*)mega_fwd, 512, LDS_BYTES) != hipSuccess || per_cu < 1) { fprintf(stderr, "kernel_launch: occupancy query says %d\n", per_cu); per_cu = 1; }
        (void)hipGetLastError();
        grid = cus * 1;
        if (grid > 256) grid = 256;
    }
    if (grid < 0) return;
    Args a{};
    for (int i = 0; i < 40; ++i) a.in[i] = (const float*)d_in[i];
    a.out = (float*)d_out; a.ws = (unsigned char*)d_ws;
#if MK_N_LAUNCHES == 1
    if (hipMemsetAsync((char*)d_ws + WS_CTL, 0, 65536, stream) != hipSuccess) { fprintf(stderr, "kernel_launch: memset failed\n"); return; }
    a.ph_lo = 0; a.ph_hi = NPHASE;
    void* kargs[] = {&a};
    hipError_t e = hipLaunchCooperativeKernel((const void*)mega_fwd, dim3(grid), dim3(512), kargs, LDS_BYTES, stream);
    if (e != hipSuccess) fprintf(stderr, "kernel_launch: cooperative launch failed: %s\n", hipGetErrorString(e));
#else
    for (int k = 0; k < NPHASE; ++k) {
        a.ph_lo = k; a.ph_hi = k + 1;
        hipLaunchKernelGGL(mega_fwd, dim3(grid), dim3(512), LDS_BYTES, stream, a);
    }
#endif
}
```
